# Optimizing an MI355X kernel written in HIP

```python
import jax, jax.numpy as jnp
from jax import lax
import numpy as np

D_MODEL = 1024
BATCH = 1
SEQ = 16384
DEPTH = 1

D_CONV = D_MODEL
CONV_W = 3
N_HEADS = 8
HEAD_DIM = 128
D_ATTN = N_HEADS * HEAD_DIM
MOBA_BLOCK = 256
MOBA_TOPK = 3
Q_CHUNK = 64
D_FF = 2816
EPS = 1e-6
D_IN = 3 * D_CONV + 3 * D_ATTN + 2 * D_MODEL

kernel_name = "hybrid_conv_moba_gated_block"


def rmsnorm(x, g):
    x32 = x.astype(jnp.float32)
    y = x32 * lax.rsqrt(jnp.mean(x32 * x32, axis=-1, keepdims=True) + EPS)
    return y.astype(x.dtype) * g


def causal_dwconv(x, w):
    s = x.shape[1]
    xp = jnp.pad(x, ((0, 0), (CONV_W - 1, 0), (0, 0)))
    y = w[0] * xp[:, 0:s]
    for j in range(1, CONV_W):
        y = y + w[j] * xp[:, j:j + s]
    return y


def moba_attention(q, k, v):
    b, h, s, hd = q.shape
    nb = -(-s // MOBA_BLOCK)
    s_pad = nb * MOBA_BLOCK
    pad = ((0, 0), (0, 0), (0, s_pad - s), (0, 0))
    kp = jnp.pad(k, pad)
    vp = jnp.pad(v, pad)
    kb = kp.reshape(b, h, nb, MOBA_BLOCK, hd)
    vb = vp.reshape(b, h, nb, MOBA_BLOCK, hd)
    kbar = jnp.mean(kb.astype(jnp.float32), axis=3).astype(k.dtype)
    n_sel = min(MOBA_TOPK, nb)
    scale = hd ** -0.5
    bidx = jnp.arange(b)[:, None, None, None]
    hidx = jnp.arange(h)[None, :, None, None]

    def one_chunk(c):
        q0 = c * Q_CHUNK
        qc = lax.dynamic_slice_in_dim(q, q0, Q_CHUNK, axis=2)
        qpos = q0 + jnp.arange(Q_CHUNK)
        cur = q0 // MOBA_BLOCK
        gate = jnp.einsum('bhqd,bhnd->bhqn', qc, kbar).astype(jnp.float32)
        gate = jnp.where(jnp.arange(nb) < cur, gate, -jnp.inf)
        _, idx = lax.top_k(gate, n_sel)
        valid = jnp.arange(n_sel) < cur
        kg = kb[bidx, hidx, idx]
        vg = vb[bidx, hidx, idx]
        s_sel = jnp.einsum('bhqd,bhqnld->bhqnl', qc, kg).astype(jnp.float32) * scale
        s_sel = jnp.where(valid[:, None], s_sel, -jnp.inf).reshape(b, h, Q_CHUNK, n_sel * MOBA_BLOCK)
        k_own = lax.dynamic_slice_in_dim(kp, cur * MOBA_BLOCK, MOBA_BLOCK, axis=2)
        v_own = lax.dynamic_slice_in_dim(vp, cur * MOBA_BLOCK, MOBA_BLOCK, axis=2)
        kpos = cur * MOBA_BLOCK + jnp.arange(MOBA_BLOCK)
        s_own = jnp.einsum('bhqd,bhkd->bhqk', qc, k_own).astype(jnp.float32) * scale
        s_own = jnp.where(kpos[None, :] <= qpos[:, None], s_own, -jnp.inf)
        p = jax.nn.softmax(jnp.concatenate([s_sel, s_own], axis=-1), axis=-1)
        p_sel = p[..., :n_sel * MOBA_BLOCK].reshape(b, h, Q_CHUNK, n_sel, MOBA_BLOCK).astype(v.dtype)
        p_own = p[..., n_sel * MOBA_BLOCK:].astype(v.dtype)
        return (jnp.einsum('bhqnl,bhqnld->bhqd', p_sel, vg)
                + jnp.einsum('bhqk,bhkd->bhqd', p_own, v_own))

    out = lax.map(one_chunk, jnp.arange(s // Q_CHUNK))
    return out.transpose(1, 2, 0, 3, 4).reshape(b, h, s, hd)


def setup_inputs(seed: int = 0) -> dict:
    key = jax.random.key(seed)
    ks = jax.random.split(key, 16)
    nrm = lambda k, shape, fan_in: jax.random.normal(k, shape, jnp.float32) * (fan_in ** -0.5)
    return {
        "x": jax.random.normal(ks[0], (BATCH, SEQ, D_MODEL), jnp.float32),
        "norm_mix": 1.0 + 0.02 * jax.random.normal(ks[1], (D_MODEL,), jnp.float32),
        "w_in": nrm(ks[2], (D_MODEL, D_IN), D_MODEL),
        "conv_a_w": nrm(ks[3], (CONV_W, D_CONV), CONV_W),
        "q_norm": 1.0 + 0.02 * jax.random.normal(ks[4], (HEAD_DIM,), jnp.float32),
        "k_norm": 1.0 + 0.02 * jax.random.normal(ks[5], (HEAD_DIM,), jnp.float32),
        "w_out_a": nrm(ks[6], (D_CONV, D_MODEL), D_CONV),
        "w_out_b": nrm(ks[7], (D_ATTN, D_MODEL), D_ATTN),
        "w_o": nrm(ks[8], (D_MODEL, D_MODEL), D_MODEL),
        "norm_ffn": 1.0 + 0.02 * jax.random.normal(ks[9], (D_MODEL,), jnp.float32),
        "w_up": nrm(ks[10], (D_MODEL, 2 * D_FF), D_MODEL),
        "ffn_conv_w": nrm(ks[11], (CONV_W, 2 * D_FF), CONV_W),
        "ffn_conv_b": 0.02 * jax.random.normal(ks[12], (2 * D_FF,), jnp.float32),
        "w_down": nrm(ks[13], (D_FF, D_MODEL), D_FF),
    }


def reference(x, norm_mix, w_in, conv_a_w, q_norm, k_norm, w_out_a, w_out_b, w_o,
              norm_ffn, w_up, ffn_conv_w, ffn_conv_b, w_down):
    b, s, _ = x.shape
    for _layer in range(DEPTH):
        xn = rmsnorm(x, norm_mix)
        z = xn @ w_in
        offs = np.cumsum([0, D_CONV, D_CONV, D_CONV, D_ATTN, D_ATTN, D_ATTN, D_MODEL, D_MODEL])
        bg, cg, xa, q, k, v, ga, gb = [z[..., offs[i]:offs[i + 1]] for i in range(8)]
        branch_a = (bg * causal_dwconv(cg * xa, conv_a_w)) @ w_out_a
        heads = lambda t: t.reshape(b, s, N_HEADS, HEAD_DIM).transpose(0, 2, 1, 3)
        qh = rmsnorm(heads(q), q_norm)
        kh = rmsnorm(heads(k), k_norm)
        o = moba_attention(qh, kh, heads(v))
        branch_b = o.transpose(0, 2, 1, 3).reshape(b, s, D_ATTN) @ w_out_b
        merged = jax.nn.sigmoid(ga) * branch_a + jax.nn.sigmoid(gb) * branch_b
        x = x + merged @ w_o
        hn = rmsnorm(x, norm_ffn)
        u = causal_dwconv(hn @ w_up, ffn_conv_w) + ffn_conv_b
        gate, val = u[..., :D_FF], u[..., D_FF:]
        x = x + (jax.nn.silu(gate) * val) @ w_down
    return x
```

```cpp
#include <hip/hip_runtime.h>
#include <cstdio>
#include <cstdint>
namespace pg8 {
#define PG8_LAS __attribute__((address_space(3)))
typedef unsigned short bf16_t;
typedef short bf16x8 __attribute__((ext_vector_type(8)));
typedef float f32x4 __attribute__((ext_vector_type(4)));
typedef unsigned u32x4 __attribute__((ext_vector_type(4)));
constexpr int BM = 256, BK = 64, HALF = 128, HTB = HALF * BK * 2  , STAGE_BYTES = 8 * HTB, NXCD = 8, WGM = 8;

__host__ __device__ __forceinline__ int lds_byte(int r, int c) { const int st = (r >> 4) * 2 + (c >> 5), rr = r & 15, cc = c & 31, ob = rr * 64 + cc * 2; return st * 1024 + (ob ^ (((ob >> 9) & 1) << 5)); }
__host__ __device__ __forceinline__ void stage_rc(int b, int& R, int& C) { const int st = b / 1024, sb = b % 1024, swz = sb ^ (((sb >> 9) & 1) << 5); R = (st >> 1) * 16 + swz / 64; C = (st & 1) * 32 + (swz % 64) / 2; }
__host__ __device__ __forceinline__ int perm32(int rho) { const int n = rho >> 4, i = rho & 15; return 8 * (i >> 2) + 4 * n + (i & 3); }


struct Unit { int pm, pn, sel; };
struct Gemm { const bf16_t* A0; const bf16_t* A1; const bf16_t* B0; const bf16_t* B1; int K; size_t a_tstep; };

struct StaticOrder {
    int nM, nN, nwg, G, c;
    __host__ __device__ void init(int nM_, int nN_, int G_, int c_) { nM = nM_; nN = nN_; nwg = nM * nN; G = G_; c = c_; }
    __host__ __device__ bool next(int i, Unit& u) const {
        const long L = (long)i * G + c; if (L >= nwg) return false;
        int wgid = (int)L; { const int q = nwg / NXCD, r = nwg % NXCD, xcd = wgid % NXCD, off = wgid / NXCD; wgid = (xcd < r ? xcd * (q + 1) : r * (q + 1) + (xcd - r) * q) + off; }
        const int nig = WGM * nN, gid = wgid / nig, fm = gid * WGM, gsz = (nM - fm) < WGM ? (nM - fm) : WGM;
        u.pm = fm + ((wgid % nig) % gsz); u.pn = (wgid % nig) / gsz; u.sel = 0; return true;
    }
    __device__ __forceinline__ void a_ready(const Unit&) const {}
    __device__ __forceinline__ void done(const Unit&) const {}
};
struct DualOrder {
    StaticOrder S;
    __host__ __device__ bool next(int i, Unit& u) const { const bool ok = S.next(i >> 1, u); u.sel = i & 1; return ok; }
    __device__ __forceinline__ void a_ready(const Unit&) const {}
    __device__ __forceinline__ void done(const Unit&) const {}
};

typedef __bf16 bf16x2_t_ __attribute__((ext_vector_type(2))); typedef float f32x2_t_ __attribute__((ext_vector_type(2)));
__device__ __forceinline__ unsigned cvt_pk_bf16(float lo, float hi) { const f32x2_t_ v = {lo, hi}; const bf16x2_t_ b = __builtin_convertvector(v, bf16x2_t_); return __builtin_bit_cast(unsigned, b); }
__device__ __forceinline__ float bf_lo(unsigned w) { return __uint_as_float(w << 16); }
__device__ __forceinline__ float bf_hi(unsigned w) { return __uint_as_float(w & 0xffff0000u); }
__device__ __forceinline__ float fast_sigmoid(float x) { return __builtin_amdgcn_rcpf(1.0f + __builtin_amdgcn_exp2f(-1.4426950408889634f * x)); }
__device__ __forceinline__ u32x4 pack8(const f32x4 a, const f32x4 b) { u32x4 w; w.x = cvt_pk_bf16(a[0], a[1]); w.y = cvt_pk_bf16(a[2], a[3]); w.z = cvt_pk_bf16(b[0], b[1]); w.w = cvt_pk_bf16(b[2], b[3]); return w; }

template <int CTRL> __device__ __forceinline__ float dpp_ror(float v) { return __builtin_bit_cast(float, __builtin_amdgcn_update_dpp(0, __builtin_bit_cast(int, v), CTRL, 0xf, 0xf, true)); }
constexpr int MROWS = 16384, DMODEL = 1024, DFF_ = 2816;

struct Epi1 {
    static constexpr bool PERM = true, AFTER_DRAIN = false;
    bf16_t *BG, *UU, *Q, *K, *VT, *SG; const float* rstdx;
    __device__ __forceinline__ void operator()(f32x4 (&acc)[2][2][4][2], const Unit& u, int wr, int wc, int fr, int fq) const {
        const int row0 = u.pm * BM + wr * 64 + fr, colw = wc * 32 + 8 * fq, pn = u.pn;
#pragma unroll
        for (int ai = 0; ai < 2; ++ai)
#pragma unroll
            for (int m = 0; m < 4; ++m) {
                const int r = row0 + ai * HALF + m * 16; const float rs = rstdx[r];
                f32x4 v[2][2];
#pragma unroll
                for (int bj = 0; bj < 2; ++bj)
#pragma unroll
                    for (int n = 0; n < 2; ++n) v[bj][n] = acc[ai][bj][m][n] * rs;
                if (pn < 4) {
#pragma unroll
                    for (int bj = 0; bj < 2; ++bj) *(u32x4*)(BG + (size_t)r * 1024 + pn * 256 + bj * 128 + colw) = pack8(v[bj][0], v[bj][1]);
                } else if (pn < 12) {
                    *(u32x4*)(UU + (size_t)r * 1024 + (pn - 4) * 128 + colw) = pack8(v[0][0] * v[1][0], v[0][1] * v[1][1]);
                } else if (pn < 20) {
                    bf16_t* dst = pn < 16 ? Q : K; const int cb = ((pn - 12) & 3) * 256;
#pragma unroll
                    for (int bj = 0; bj < 2; ++bj) *(u32x4*)(dst + (size_t)r * 1024 + cb + bj * 128 + colw) = pack8(v[bj][0], v[bj][1]);
                } else if (pn < 24) {
#pragma unroll
                    for (int bj = 0; bj < 2; ++bj) { const int h = (pn - 20) * 2 + bj; const u32x4 w = pack8(v[bj][0], v[bj][1]);
                        bf16_t* p = VT + ((size_t)(h * 128 + colw)) * MROWS + r;
                        p[0 * (size_t)MROWS] = (bf16_t)(w.x & 0xffffu); p[1 * (size_t)MROWS] = (bf16_t)(w.x >> 16); p[2 * (size_t)MROWS] = (bf16_t)(w.y & 0xffffu); p[3 * (size_t)MROWS] = (bf16_t)(w.y >> 16);
                        p[4 * (size_t)MROWS] = (bf16_t)(w.z & 0xffffu); p[5 * (size_t)MROWS] = (bf16_t)(w.z >> 16); p[6 * (size_t)MROWS] = (bf16_t)(w.w & 0xffffu); p[7 * (size_t)MROWS] = (bf16_t)(w.w >> 16); }
                } else {
#pragma unroll
                    for (int bj = 0; bj < 2; ++bj) { f32x4 a = v[bj][0], b = v[bj][1];
#pragma unroll
                        for (int e = 0; e < 4; ++e) { a[e] = fast_sigmoid(a[e]); b[e] = fast_sigmoid(b[e]); }
                        *(u32x4*)(SG + (size_t)r * 2048 + (pn - 24) * 256 + bj * 128 + colw) = pack8(a, b); }
                }
            }
    }
};
struct Epi4 {
    static constexpr bool PERM = true, AFTER_DRAIN = false;
    bf16_t* MG; const bf16_t* SG;
    __device__ __forceinline__ void operator()(f32x4 (&acc)[2][2][4][2], const Unit& u, int wr, int wc, int fr, int fq) const {
        const int row0 = u.pm * BM + wr * 64 + fr, col0 = u.pn * BM + wc * 32 + 8 * fq;
#pragma unroll
        for (int ai = 0; ai < 2; ++ai)
#pragma unroll
            for (int m = 0; m < 4; ++m) { const int r = row0 + ai * HALF + m * 16;
#pragma unroll
                for (int bj = 0; bj < 2; ++bj) { const int c = col0 + bj * HALF;
                    const u32x4 g = *(const u32x4*)(SG + (size_t)r * 2048 + u.sel * 1024 + c);
                    f32x4 a = acc[ai][bj][m][0], b = acc[ai][bj][m][1];
                    a[0] *= bf_lo(g.x); a[1] *= bf_hi(g.x); a[2] *= bf_lo(g.y); a[3] *= bf_hi(g.y); b[0] *= bf_lo(g.z); b[1] *= bf_hi(g.z); b[2] *= bf_lo(g.w); b[3] *= bf_hi(g.w);
                    bf16_t* dst = MG + (size_t)r * 1024 + c;
                    if (u.sel) { const u32x4 o = *(const u32x4*)dst;
                        a[0] += bf_lo(o.x); a[1] += bf_hi(o.x); a[2] += bf_lo(o.y); a[3] += bf_hi(o.y); b[0] += bf_lo(o.z); b[1] += bf_hi(o.z); b[2] += bf_lo(o.w); b[3] += bf_hi(o.w); }
                    *(u32x4*)dst = pack8(a, b); } }
    }
};
struct Epi5 {
    static constexpr bool PERM = true, AFTER_DRAIN = false;
    const float* X; float* OUT; bf16_t* HB; float* rowss;
    __device__ __forceinline__ void operator()(f32x4 (&acc)[2][2][4][2], const Unit& u, int wr, int wc, int fr, int fq) const {
        const int row0 = u.pm * BM + wr * 64 + fr, col0 = u.pn * BM + wc * 32 + 8 * fq;
#pragma unroll
        for (int ai = 0; ai < 2; ++ai)
#pragma unroll
            for (int m = 0; m < 4; ++m) { const int r = row0 + ai * HALF + m * 16; float ss = 0.f;
#pragma unroll
                for (int bj = 0; bj < 2; ++bj) { const size_t o = (size_t)r * 1024 + col0 + bj * HALF;
                    const f32x4 a = acc[ai][bj][m][0] + *(const f32x4*)(X + o), b = acc[ai][bj][m][1] + *(const f32x4*)(X + o + 4);
                    *(f32x4*)(OUT + o) = a; *(f32x4*)(OUT + o + 4) = b; *(u32x4*)(HB + o) = pack8(a, b);
                    ss += (a[0] * a[0] + a[1] * a[1]) + (a[2] * a[2] + a[3] * a[3]) + (b[0] * b[0] + b[1] * b[1]) + (b[2] * b[2] + b[3] * b[3]); }
                ss += __shfl_xor(ss, 16); ss += __shfl_xor(ss, 32);
                if (fq == 0) atomicAdd(rowss + r, ss); }
    }
};
struct Epi6 {
    static constexpr bool PERM = true, AFTER_DRAIN = false;
    bf16_t* ACT; const float* rowss; const float* cw; const float* cb; PG8_LAS float* halo;
    __device__ __forceinline__ void operator()(f32x4 (&acc)[2][2][4][2], const Unit& u, int wr, int wc, int fr, int fq) const {
        const int r0 = u.pm * 254 - 2, colw = wc * 32 + 8 * fq;
#pragma unroll
        for (int ai = 0; ai < 2; ++ai)
#pragma unroll
            for (int m = 0; m < 4; ++m) { int gr = r0 + ai * HALF + wr * 64 + m * 16 + fr; gr = gr < 0 ? 0 : (gr > MROWS - 1 ? MROWS - 1 : gr);
                const float rs = rsqrtf(rowss[gr] * (1.0f / 1024.0f) + 1e-6f);
#pragma unroll
                for (int bj = 0; bj < 2; ++bj)
#pragma unroll
                    for (int n = 0; n < 2; ++n) acc[ai][bj][m][n] *= rs; }
        if (fr >= 14) {
#pragma unroll
            for (int ai = 0; ai < 2; ++ai)
#pragma unroll
                for (int bj = 0; bj < 2; ++bj)
#pragma unroll
                    for (int n = 0; n < 2; ++n) *(PG8_LAS f32x4*)(halo + (((2 * ai + wr) * 2 + (fr - 14)) * 256 + bj * 128 + colw + 4 * n)) = acc[ai][bj][3][n];
        }
        asm volatile("s_waitcnt lgkmcnt(0)" ::: "memory"); __builtin_amdgcn_s_barrier(); asm volatile("" ::: "memory");
#pragma unroll
        for (int bj = 0; bj < 2; ++bj)
#pragma unroll
            for (int n = 0; n < 2; ++n) {
                const int col = bj * DFF_ + u.pn * 128 + colw + 4 * n;
                const f32x4 w0 = *(const f32x4*)(cw + col), w1 = *(const f32x4*)(cw + 2 * DFF_ + col), w2 = *(const f32x4*)(cw + 4 * DFF_ + col), bb = *(const f32x4*)(cb + col);
#pragma unroll
                for (int ai = 0; ai < 2; ++ai) {
                    const int s = 2 * ai + wr;
                    const int sm = s > 0 ? s - 1 : 0; const float hz = s > 0 ? 1.0f : 0.0f;
                    const f32x4 h2 = *(const PG8_LAS f32x4*)(halo + ((sm * 2 + 0) * 256 + bj * 128 + colw + 4 * n)) * hz, h1 = *(const PG8_LAS f32x4*)(halo + ((sm * 2 + 1) * 256 + bj * 128 + colw + 4 * n)) * hz;
                    f32x4 c1, c2;
#pragma unroll
                    for (int e = 0; e < 4; ++e) { float t = acc[ai][bj][3][n][e]; asm volatile("" : "+v"(t)); c1[e] = dpp_ror<0x121>(t); c2[e] = dpp_ror<0x122>(t); }
#pragma unroll
                    for (int mm = 0; mm < 4; ++mm) { const int m = 3 - mm;
                        const f32x4 cur = acc[ai][bj][m][n]; f32x4 l1, l2, p1, p2;
#pragma unroll
                        for (int e = 0; e < 4; ++e) {
                            if (m > 0) { float t = acc[ai][bj][m > 0 ? m - 1 : 0][n][e]; asm volatile("" : "+v"(t)); l1[e] = dpp_ror<0x121>(t); l2[e] = dpp_ror<0x122>(t); }
                            else { l1[e] = h1[e]; l2[e] = fr == 0 ? h2[e] : h1[e]; }
                            p1[e] = fr >= 1 ? c1[e] : l1[e]; p2[e] = fr >= 2 ? c2[e] : l2[e]; }
                        { f32x4 r_ = w0 * p2 + w1 * p1 + w2 * cur + bb; asm volatile("" : "+v"(r_)); acc[ai][bj][m][n] = r_; } c1 = l1; c2 = l2; }
                }
            }
#pragma unroll
        for (int ai = 0; ai < 2; ++ai)
#pragma unroll
            for (int m = 0; m < 4; ++m) { const int i = ai * HALF + wr * 64 + m * 16 + fr, gr = r0 + i;
                f32x4 a, b;
#pragma unroll
                for (int e = 0; e < 4; ++e) { const float g0 = acc[ai][0][m][0][e], g1 = acc[ai][0][m][1][e];
                    a[e] = g0 * fast_sigmoid(g0) * acc[ai][1][m][0][e]; b[e] = g1 * fast_sigmoid(g1) * acc[ai][1][m][1][e]; }
                if (i >= 2 && gr < MROWS) *(u32x4*)(ACT + (size_t)gr * DFF_ + u.pn * 128 + colw) = pack8(a, b); }
    }
};
struct Epi7 {
    static constexpr bool PERM = true, AFTER_DRAIN = false;
    float* OUT;
    __device__ __forceinline__ void operator()(f32x4 (&acc)[2][2][4][2], const Unit& u, int wr, int wc, int fr, int fq) const {
        const int row0 = u.pm * BM + wr * 64 + fr, col0 = u.pn * BM + wc * 32 + 8 * fq;
#pragma unroll
        for (int ai = 0; ai < 2; ++ai)
#pragma unroll
            for (int m = 0; m < 4; ++m) { const int r = row0 + ai * HALF + m * 16;
#pragma unroll
                for (int bj = 0; bj < 2; ++bj) { float* p = OUT + (size_t)r * 1024 + col0 + bj * HALF;
                    const f32x4 a = acc[ai][bj][m][0] + *(const f32x4*)p, b = acc[ai][bj][m][1] + *(const f32x4*)(p + 4);
                    *(f32x4*)p = a; *(f32x4*)(p + 4) = b; } }
    }
};
template <class Epi, class Sched, bool ALIGN_EPI = false, bool SP2 = false>
__device__ __forceinline__ void gemm_phase(PG8_LAS unsigned char* lds, const Gemm g, const Sched& S, const Epi& E) {
    const int tid = threadIdx.x, wid = __builtin_amdgcn_readfirstlane(tid >> 6), lane = tid & 63, wr = wid >> 2, wc = wid & 3, fr = lane & 15, fq = lane >> 4;
    const int K = g.K, nt = K / BK;
    unsigned voffA[2], voffB[2];
#pragma unroll
    for (int i = 0; i < 2; ++i) { int R, C; stage_rc(tid * 16 + i * 8192, R, C); const int Rb = Epi::PERM ? ((R & ~31) + perm32(R & 31)) : R;
        voffA[i] = (unsigned)(R * K + C) * 2u; voffB[i] = (unsigned)(Rb * K + C) * 2u; }
    const size_t kstep = (size_t)(BK * 2);
    const size_t hstep = (size_t)HALF * K * 2;
    const size_t tstep = 2 * hstep;
    const unsigned ldsw = (unsigned)wid * 1024u;
    const int aoff = lds_byte(wr * 64 + fr, fq * 8), boff = lds_byte(wc * 32 + fr, fq * 8);
#define PG8_SA(b, h) (((b) * 2 + (h)) * HTB)
#define PG8_SB(b, h) ((4 + (b) * 2 + (h)) * HTB)
#define PG8_STAGE(bufoff, gbase, voff) do { _Pragma("unroll") for (int _i = 0; _i < 2; ++_i) \
        __builtin_amdgcn_global_load_lds((const unsigned*)((const char*)(gbase) + (voff)[_i]), (PG8_LAS unsigned*)(lds + (bufoff) + ldsw + _i * 8192), 16, 0, 0); } while (0)
#define PG8_LDA(dst, b, h) do { _Pragma("unroll") for (int m = 0; m < 4; ++m) _Pragma("unroll") for (int k = 0; k < 2; ++k) dst[m][k] = *(const PG8_LAS bf16x8*)(lds + PG8_SA(b, h) + aoff + m * 2048 + k * 1024); } while (0)
#define PG8_LDB(dst, b, h) do { _Pragma("unroll") for (int n = 0; n < 2; ++n) _Pragma("unroll") for (int k = 0; k < 2; ++k) dst[n][k] = *(const PG8_LAS bf16x8*)(lds + PG8_SB(b, h) + boff + n * 2048 + k * 1024); } while (0)
#define PG8_MMA(ai, bj, At, Bt) do { __builtin_amdgcn_s_setprio(1); _Pragma("unroll") for (int m = 0; m < 4; ++m) _Pragma("unroll") for (int n = 0; n < 2; ++n) _Pragma("unroll") for (int k = 0; k < 2; ++k) \
        acc[ai][bj][m][n] = __builtin_amdgcn_mfma_f32_16x16x32_bf16(Bt[n][k], At[m][k], acc[ai][bj][m][n], 0, 0, 0); __builtin_amdgcn_s_setprio(0); } while (0)
#define PG8_WAIT_V(n) asm volatile("s_waitcnt vmcnt(" #n ")" ::: "memory")
#define PG8_WAIT_L(n) asm volatile("s_waitcnt lgkmcnt(" #n ")" ::: "memory")
#define PG8_BAR __builtin_amdgcn_s_barrier()
#define PG8_SCHED __builtin_amdgcn_sched_barrier(0)
    Unit cur, nxt; int ui = 0;
    if (!S.next(0, cur)) return;
    f32x4 acc[2][2][4][2];
#pragma unroll
    for (int a = 0; a < 2; ++a)
#pragma unroll
        for (int b = 0; b < 2; ++b)
#pragma unroll
            for (int m = 0; m < 4; ++m)
#pragma unroll
                for (int n = 0; n < 2; ++n) acc[a][b][m][n] = (f32x4){0.f, 0.f, 0.f, 0.f};
    bf16x8 At[4][2], B0[2][2], B1[2][2];
    const char* cA = (const char*)(cur.sel ? g.A1 : g.A0) + (size_t)cur.pm * g.a_tstep; const char* cB = (const char*)(cur.sel ? g.B1 : g.B0) + (size_t)cur.pn * tstep;
    S.a_ready(cur);
    if constexpr (SP2) {
        PG8_STAGE(PG8_SB(0, 0), cB, voffB); PG8_STAGE(PG8_SB(0, 1), cB + hstep, voffB); PG8_STAGE(PG8_SA(0, 0), cA, voffA); PG8_STAGE(PG8_SA(0, 1), cA + hstep, voffA);
        if (wr == 1) PG8_BAR;
        PG8_WAIT_V(2); PG8_BAR;
        PG8_STAGE(PG8_SB(1, 0), cB + kstep, voffB); PG8_STAGE(PG8_SA(1, 0), cA + kstep, voffA); PG8_STAGE(PG8_SB(1, 1), cB + hstep + kstep, voffB);
        PG8_WAIT_V(6); PG8_BAR;
    } else {
        PG8_STAGE(PG8_SB(0, 0), cB, voffB); PG8_STAGE(PG8_SA(0, 0), cA, voffA); PG8_STAGE(PG8_SB(0, 1), cB + hstep, voffB); PG8_STAGE(PG8_SA(0, 1), cA + hstep, voffA);
        if (wr == 1) PG8_BAR;
        PG8_WAIT_V(4); PG8_BAR;
        PG8_STAGE(PG8_SB(1, 0), cB + kstep, voffB); PG8_STAGE(PG8_SA(1, 0), cA + kstep, voffA); PG8_STAGE(PG8_SB(1, 1), cB + hstep + kstep, voffB);
        PG8_WAIT_V(6); PG8_BAR;
    }
    for (;;) {
        const bool has_next = S.next(ui + 1, nxt);
        const char* nA = has_next ? (const char*)(nxt.sel ? g.A1 : g.A0) + (size_t)nxt.pm * g.a_tstep : cA; const char* nB = has_next ? (const char*)(nxt.sel ? g.B1 : g.B0) + (size_t)nxt.pn * tstep : cB;
        for (int t = 0; t < nt; t += 2) {
            const bool last = (t == nt - 2);
            const char* a1 = cA + (size_t)(t + 1) * kstep;
            const char* a2 = last ? nA : cA + (size_t)(t + 2) * kstep; const char* b2 = last ? nB : cB + (size_t)(t + 2) * kstep;
            const char* a3 = a2 + kstep; const char* b3 = b2 + kstep;
            if (last && has_next) S.a_ready(nxt);
            if constexpr (SP2) {
            PG8_LDB(B0, 0, 0); PG8_LDB(B1, 0, 1); PG8_SCHED; PG8_LDA(At, 0, 0); PG8_STAGE(PG8_SA(1, 1), a1 + hstep, voffA);
            PG8_WAIT_V(8); PG8_WAIT_L(0); PG8_BAR; PG8_MMA(0, 0, At, B0); PG8_MMA(0, 1, At, B1); PG8_BAR; PG8_SCHED;
            PG8_LDA(At, 0, 1); PG8_STAGE(PG8_SB(0, 0), b2, voffB); PG8_STAGE(PG8_SB(0, 1), b2 + hstep, voffB); PG8_STAGE(PG8_SA(0, 0), a2, voffA);
            PG8_WAIT_V(8); PG8_WAIT_L(0); PG8_BAR; PG8_MMA(1, 0, At, B0); PG8_MMA(1, 1, At, B1); PG8_BAR; PG8_SCHED;
            PG8_LDB(B0, 1, 0); PG8_LDB(B1, 1, 1); PG8_SCHED; PG8_LDA(At, 1, 0); PG8_STAGE(PG8_SA(0, 1), a2 + hstep, voffA);
            PG8_WAIT_V(8); PG8_WAIT_L(0); PG8_BAR; PG8_MMA(0, 0, At, B0); PG8_MMA(0, 1, At, B1); PG8_BAR; PG8_SCHED;
            PG8_LDA(At, 1, 1); PG8_STAGE(PG8_SB(1, 0), b3, voffB); PG8_STAGE(PG8_SB(1, 1), b3 + hstep, voffB); PG8_STAGE(PG8_SA(1, 0), a3, voffA);
            PG8_WAIT_V(8); PG8_WAIT_L(0); PG8_BAR; PG8_MMA(1, 0, At, B0); PG8_MMA(1, 1, At, B1); PG8_BAR; PG8_SCHED;
            } else {
            PG8_LDB(B0, 0, 0); PG8_SCHED; PG8_LDA(At, 0, 0); PG8_STAGE(PG8_SA(1, 1), a1 + hstep, voffA);
            PG8_WAIT_L(8); PG8_BAR; PG8_WAIT_L(0); PG8_MMA(0, 0, At, B0); PG8_BAR; PG8_SCHED;
            PG8_LDB(B1, 0, 1); PG8_STAGE(PG8_SB(0, 0), b2, voffB);
            PG8_BAR; PG8_WAIT_L(0); PG8_MMA(0, 1, At, B1); PG8_BAR;
            PG8_LDA(At, 0, 1); PG8_STAGE(PG8_SA(0, 0), a2, voffA);
            PG8_BAR; PG8_WAIT_L(0); PG8_MMA(1, 0, At, B0); PG8_BAR; PG8_SCHED;
            PG8_STAGE(PG8_SB(0, 1), b2 + hstep, voffB);
            PG8_WAIT_V(6); PG8_BAR; PG8_MMA(1, 1, At, B1); PG8_BAR;
            PG8_LDB(B0, 1, 0); PG8_SCHED; PG8_LDA(At, 1, 0); PG8_STAGE(PG8_SA(0, 1), a2 + hstep, voffA);
            PG8_WAIT_L(8); PG8_BAR; PG8_WAIT_L(0); PG8_MMA(0, 0, At, B0); PG8_BAR; PG8_SCHED;
            PG8_LDB(B1, 1, 1); PG8_STAGE(PG8_SB(1, 0), b3, voffB);
            PG8_BAR; PG8_WAIT_L(0); PG8_MMA(0, 1, At, B1); PG8_BAR;
            PG8_LDA(At, 1, 1); PG8_STAGE(PG8_SA(1, 0), a3, voffA);
            PG8_BAR; PG8_WAIT_L(0); PG8_MMA(1, 0, At, B0); PG8_BAR; PG8_SCHED;
            PG8_STAGE(PG8_SB(1, 1), b3 + hstep, voffB);
            PG8_WAIT_V(6); PG8_BAR; PG8_MMA(1, 1, At, B1); PG8_BAR;
            }
        }
        if constexpr (ALIGN_EPI) { if (wr == 0) PG8_BAR; }
        if constexpr (!Epi::AFTER_DRAIN) { E(acc, cur, wr, wc, fr, fq); S.done(cur); }
        if (!has_next) break;
#pragma unroll
        for (int a = 0; a < 2; ++a)
#pragma unroll
            for (int b = 0; b < 2; ++b)
#pragma unroll
                for (int m = 0; m < 4; ++m)
#pragma unroll
                    for (int n = 0; n < 2; ++n) acc[a][b][m][n] = (f32x4){0.f, 0.f, 0.f, 0.f};
        cur = nxt; cA = nA; cB = nB; ++ui;
        if constexpr (ALIGN_EPI) { if (wr == 1) PG8_BAR; }
    }
    PG8_WAIT_V(0);
    if constexpr (!ALIGN_EPI) { if (wr == 0) PG8_BAR; }
    PG8_BAR;
    if constexpr (Epi::AFTER_DRAIN) { E.fused(acc, cur, wr, wc, fr, fq, lds, wid, lane); S.done(cur); }
#undef PG8_SA
#undef PG8_SB
#undef PG8_STAGE
#undef PG8_LDA
#undef PG8_LDB
#undef PG8_MMA
#undef PG8_WAIT_V
#undef PG8_WAIT_L
#undef PG8_BAR
#undef PG8_SCHED
}
}
#define GAS __attribute__((address_space(1)))
#define LAS __attribute__((address_space(3)))
typedef unsigned short bf16;
typedef unsigned v4u __attribute__((ext_vector_type(4)));
typedef float f32x4 __attribute__((ext_vector_type(4)));
typedef short bf16x8 __attribute__((ext_vector_type(8)));
typedef GAS unsigned gu32;
typedef GAS unsigned long long gu64;
#define RLX_AGENT __ATOMIC_RELAXED, __HIP_MEMORY_SCOPE_AGENT
#define LDS_WAIT() asm volatile("s_waitcnt lgkmcnt(0)" ::: "memory")
#define VM_WAIT() asm volatile("s_waitcnt vmcnt(0)" ::: "memory")
__device__ __forceinline__ unsigned long long rt() { return __builtin_amdgcn_s_memrealtime(); }
__device__ __forceinline__ unsigned f2bf(float f) { unsigned u = __builtin_bit_cast(unsigned, f); return (u + 0x7fffu + ((u >> 16) & 1u)) >> 16; }
__device__ __forceinline__ unsigned pk2(float lo, float hi) { return f2bf(lo) | (f2bf(hi) << 16); }

#define XB_TMO      128
#define XB_XCNT(j)  (256  + 64 * (j))
#define XB_XSUB(j)  (1280 + 64 * (j))
#define XB_XGEN(j)  (2304 + 64 * (j))
#define XB_TOP      3328
#define XB_TOPGEN   3392
#define XCD_BAR_WORDS 3456
#define XB_SPIN_CAP (1u << 18)

__device__ __forceinline__ unsigned xb_ld(unsigned* p)              { return __hip_atomic_load(p, __ATOMIC_RELAXED, __HIP_MEMORY_SCOPE_AGENT); }
__device__ __forceinline__ unsigned xb_add(unsigned* p, unsigned v) { return __hip_atomic_fetch_add(p, v, __ATOMIC_RELAXED, __HIP_MEMORY_SCOPE_AGENT); }
__device__ __forceinline__ unsigned xb_xcc_id() { return (unsigned)__builtin_amdgcn_s_getreg((3 << 11) | 20) & 0xFu; }
#define XB_SPIN(cond, bar) do { unsigned _sp = 0; while (cond) { __builtin_amdgcn_s_sleep(1); \
    if ((++_sp & 255u) == 0u) { if (xb_ld(&(bar)[XB_TMO])) break; if (_sp > XB_SPIN_CAP) { atomicAdd(&(bar)[XB_TMO], 1u); break; } } } } while (0)

struct XcdBarrier {
    unsigned* bar; unsigned x;
    volatile LAS unsigned* st;
};

__device__ __forceinline__ XcdBarrier xcd_barrier_post(unsigned* bar, volatile LAS unsigned* st) {
    XcdBarrier b; b.bar = bar; b.x = xb_xcc_id(); b.st = st;
    if (threadIdx.x == 0) (void)xb_add(&bar[XB_XCNT(b.x)], 1u);
    return b;
}
__device__ __forceinline__ void xcd_barrier_complete(unsigned* bar, unsigned x, unsigned& nloc, unsigned& nx) {
    const unsigned G = gridDim.x * gridDim.y * gridDim.z;
    unsigned sum, cnt, mine, sp = 0u;
    for (;;) {
        sum = 0u; cnt = 0u; mine = 0u;
#pragma unroll
        for (unsigned j = 0; j < 16; ++j) { const unsigned c = xb_ld(&bar[XB_XCNT(j)]); sum += c; cnt += (c > 0u) ? 1u : 0u; mine = (j == x) ? c : mine; }
        if (sum == G) break;
        __builtin_amdgcn_s_sleep(1);
        if ((++sp & 255u) == 0u) { if (xb_ld(&bar[XB_TMO])) break; if (sp > XB_SPIN_CAP) { atomicAdd(&bar[XB_TMO], 1u); break; } }
    }
    nloc = mine > 0u ? mine : 1u; nx = cnt > 0u ? cnt : 1u;
}

__device__ __forceinline__ void xcd_barrier(const XcdBarrier& b) {
    asm volatile("s_waitcnt vmcnt(0)" ::: "memory");
    __syncthreads();
    if (threadIdx.x == 0) {
        unsigned* bar = b.bar;
        __builtin_amdgcn_s_waitcnt(0);
        unsigned nloc = b.st[0], nx = b.st[1];
        if (nloc == 0u) { xcd_barrier_complete(bar, b.x, nloc, nx); b.st[0] = nloc; b.st[1] = nx; }
        const unsigned old = xb_add(&bar[XB_XSUB(b.x)], 1u);
        const unsigned gen = old / nloc;
        if (old + 1u == (gen + 1u) * nloc) {
            __builtin_amdgcn_fence(__ATOMIC_RELEASE, "agent");
            asm volatile("s_waitcnt vmcnt(0)" ::: "memory");
            const unsigned og = xb_add(&bar[XB_TOP], 1u);
            const unsigned tg = og / nx;
            if (og + 1u == (tg + 1u) * nx) xb_add(&bar[XB_TOPGEN], 1u);
            else XB_SPIN(xb_ld(&bar[XB_TOPGEN]) == tg, bar);
            __builtin_amdgcn_fence(__ATOMIC_ACQUIRE, "agent");
            xb_add(&bar[XB_XGEN(b.x)], 1u);
            asm volatile("s_waitcnt vmcnt(0)" ::: "memory");
        } else {
            XB_SPIN(xb_ld(&bar[XB_XGEN(b.x)]) == gen, bar);
            __builtin_amdgcn_fence(__ATOMIC_ACQUIRE, "agent");
            asm volatile("s_waitcnt vmcnt(0)" ::: "memory");
        }
    }
    __syncthreads();
}


constexpr int NWAVES = 8, NTHREADS = 512;
constexpr int M = 16384, D = 1024, NIN = 8192, DFF = 2816, NH = 8, HD = 128, NBLK = 64, BLK = 256;
constexpr float EPS = 1e-6f;
constexpr float C2 = 0.08838834764831845f * 1.4426950408889634f;
constexpr size_t MiB = 1u << 20;
constexpr size_t WS_CTL = 0, CTL_ZERO_BYTES = 256 * 1024;
constexpr int CW_BAR = 4096, CW_GCNT = 8192, CW_ROWSS = 16384;
constexpr size_t WS_KBAR = 1 * MiB, WS_RSTDX = 1 * MiB + 512 * 1024, WS_LPART = 2 * MiB;
constexpr size_t WS_WOA = 4 * MiB, WS_WOB = 6 * MiB, WS_WO = 8 * MiB;
constexpr size_t WS_Q = 10 * MiB, WS_K = 42 * MiB, WS_VT = 74 * MiB, WS_CA = 106 * MiB, WS_LIST = 138 * MiB, WS_WIN = 147 * MiB, WS_XB = 163 * MiB, WS_UU = 195 * MiB;
constexpr size_t WS_OPART = 147 * MiB;
constexpr size_t WS_WUP = 147 * MiB, WS_WDN = 159 * MiB, WS_MG = 165 * MiB, WS_HB = 198 * MiB;
constexpr size_t WS_ACT = 10 * MiB;
constexpr size_t WS_END = 256 * MiB;
constexpr int LDS_BYTES = 147456, MISC_OFF = 131072 + 320, HALO_OFF = 131072 + 1024, SCAN_OFF = 131072 + 1024;
__device__ __forceinline__ int list_off(int n) { return 256 * (63 * n - (n * (n - 1)) / 2); }
constexpr int LIST_PER_HEAD = 256 * 2016;

__device__ __forceinline__ float wave_sum(float v) {
#pragma unroll
    for (int o = 1; o < 64; o <<= 1) v += __shfl_xor(v, o);
    return v;
}
__device__ __forceinline__ void transpose_item(const float* W, int N, bf16* WT, int K, int k0, int col0, int row0, const float* ks, LAS float* scr, int lane) {
#pragma unroll 8
    for (int i = 0; i < 32; ++i) { const int kk = 2 * i + (lane >> 5); const float s = ks ? ks[k0 + kk] : 1.0f; scr[kk * 33 + (lane & 31)] = s * W[(size_t)(k0 + kk) * N + col0 + (lane & 31)]; }
    LDS_WAIT(); asm volatile("" ::: "memory");
    const int c = lane & 7;
#pragma unroll
    for (int j = 0; j < 4; ++j) { const int n = (lane >> 3) + 8 * j; const LAS float* s = scr + (8 * c) * 33 + n;
        v4u o; o.x = pk2(s[0 * 33], s[1 * 33]); o.y = pk2(s[2 * 33], s[3 * 33]); o.z = pk2(s[4 * 33], s[5 * 33]); o.w = pk2(s[6 * 33], s[7 * 33]);
        *(GAS v4u*)(WT + (size_t)(row0 + n) * K + k0 + 8 * c) = o; }
    LDS_WAIT(); asm volatile("" ::: "memory");
}
__device__ __forceinline__ int map_col(int mode, int R) {
    if (mode == 1) { if (R >= 1024 && R < 3072) { const int q = R - 1024; return 1024 + ((q >> 7) & 1) * 1024 + (q >> 8) * 128 + (q & 127); } return R; }
    if (mode == 2) return ((R >> 7) & 1) * DFF + (R >> 8) * 128 + (R & 127);
    return R;
}
__device__ __forceinline__ void convert_weight(const float* W, int K, int N, bf16* WT, const float* ks, int mode, LAS float* scr, int gw, int NGW, int lane) {
    const int nblk = N / 32, nitems = (K / 64) * nblk;
    for (int it = gw; it < nitems; it += NGW) { const int kb = it / nblk, nb = it % nblk; transpose_item(W, N, WT, K, 64 * kb, map_col(mode, 32 * nb), 32 * nb, ks, scr, lane); }
}

__device__ __forceinline__ void phase0(const float* x, const float* norm_mix, const float* w_in, const float* w_oa, const float* w_ob, const float* w_o, unsigned char* ws, LAS unsigned char* lds, int vcu, int G, int wave, int lane) {
    LAS float* scr = (LAS float*)(lds + wave * 16384);
    const int gw = vcu * NWAVES + wave, NGW = G * NWAVES;
    convert_weight(w_in, D, NIN, (bf16*)(ws + WS_WIN), norm_mix, 1, scr, gw, NGW, lane);
    convert_weight(w_oa, D, D, (bf16*)(ws + WS_WOA), nullptr, 0, scr, gw, NGW, lane);
    convert_weight(w_ob, D, D, (bf16*)(ws + WS_WOB), nullptr, 0, scr, gw, NGW, lane);
    convert_weight(w_o, D, D, (bf16*)(ws + WS_WO), nullptr, 0, scr, gw, NGW, lane);
    bf16* XB = (bf16*)(ws + WS_XB); float* rstdx = (float*)(ws + WS_RSTDX);
    for (int m = gw; m < M; m += NGW) {
        const GAS f32x4* xr = (const GAS f32x4*)(x + (size_t)m * D) + lane; f32x4 v[4]; float s = 0.f;
#pragma unroll
        for (int j = 0; j < 4; ++j) { v[j] = xr[64 * j]; s += (v[j].x * v[j].x + v[j].y * v[j].y) + (v[j].z * v[j].z + v[j].w * v[j].w); }
        s = wave_sum(s); if (lane == 0) rstdx[m] = rsqrtf(s * (1.f / D) + EPS);
        GAS unsigned long long* o8 = (GAS unsigned long long*)(XB + (size_t)m * D) + lane;
#pragma unroll
        for (int j = 0; j < 4; ++j) o8[64 * j] = (unsigned long long)pk2(v[j].x, v[j].y) | ((unsigned long long)pk2(v[j].z, v[j].w) << 32);
    }
}
__device__ __forceinline__ void phase2(const float* conv_a_w, const float* q_norm, const float* k_norm, unsigned char* ws, LAS unsigned char* lds, int G, int tid, int wave, int lane) {
    bf16* BG = (bf16*)(ws + WS_CA); const bf16* UU = (const bf16*)(ws + WS_UU);
    for (size_t idx = (size_t)blockIdx.x * NTHREADS + tid; idx < (size_t)M * 128; idx += (size_t)G * NTHREADS) {
        const int t = (int)(idx >> 7), cc = (int)(idx & 127) * 8; const size_t o = (size_t)t * 1024 + cc;
        const v4u b = *(const GAS v4u*)(BG + o), u0 = *(const GAS v4u*)(UU + o);
        v4u u1 = (v4u){0u, 0u, 0u, 0u}, u2 = u1; if (t >= 1) u1 = *(const GAS v4u*)(UU + o - 1024); if (t >= 2) u2 = *(const GAS v4u*)(UU + o - 2048);
        const f32x4 w0a = *(const GAS f32x4*)(conv_a_w + cc), w0b = *(const GAS f32x4*)(conv_a_w + cc + 4), w1a = *(const GAS f32x4*)(conv_a_w + 1024 + cc), w1b = *(const GAS f32x4*)(conv_a_w + 1024 + cc + 4),
                    w2a = *(const GAS f32x4*)(conv_a_w + 2048 + cc), w2b = *(const GAS f32x4*)(conv_a_w + 2048 + cc + 4);
        const unsigned bw[4] = {b.x, b.y, b.z, b.w}, a0[4] = {u0.x, u0.y, u0.z, u0.w}, a1[4] = {u1.x, u1.y, u1.z, u1.w}, a2[4] = {u2.x, u2.y, u2.z, u2.w};
        float r[8];
#pragma unroll
        for (int j = 0; j < 4; ++j) { const float wl0 = j < 2 ? w0a[2 * j] : w0b[2 * j - 4], wh0 = j < 2 ? w0a[2 * j + 1] : w0b[2 * j - 3], wl1 = j < 2 ? w1a[2 * j] : w1b[2 * j - 4], wh1 = j < 2 ? w1a[2 * j + 1] : w1b[2 * j - 3],
                                                  wl2 = j < 2 ? w2a[2 * j] : w2b[2 * j - 4], wh2 = j < 2 ? w2a[2 * j + 1] : w2b[2 * j - 3];
            r[2 * j] = pg8::bf_lo(bw[j]) * (wl0 * pg8::bf_lo(a2[j]) + wl1 * pg8::bf_lo(a1[j]) + wl2 * pg8::bf_lo(a0[j]));
            r[2 * j + 1] = pg8::bf_hi(bw[j]) * (wh0 * pg8::bf_hi(a2[j]) + wh1 * pg8::bf_hi(a1[j]) + wh2 * pg8::bf_hi(a0[j])); }
        v4u o4; o4.x = pk2(r[0], r[1]); o4.y = pk2(r[2], r[3]); o4.z = pk2(r[4], r[5]); o4.w = pk2(r[6], r[7]);
        *(GAS v4u*)(BG + o) = o4;
    }
    LAS float* red = (LAS float*)lds;
    float* kbar = (float*)(ws + WS_KBAR);
    for (int unit = blockIdx.x; unit < 2 * NBLK * NH; unit += G) {
        const int which = unit >> 9, n = (unit >> 3) & 63, h = unit & 7;
        bf16* buf = (bf16*)(ws + (which ? WS_K : WS_Q)); const float* wn = which ? k_norm : q_norm;
        const float g0 = wn[2 * lane] * (which ? 1.0f : C2), g1 = wn[2 * lane + 1] * (which ? 1.0f : C2);
        float k0 = 0.f, k1 = 0.f;
#pragma unroll 4
        for (int r = 0; r < 32; ++r) { const int t = n * BLK + wave * 32 + r; GAS unsigned* p = (GAS unsigned*)(buf + (size_t)t * 1024 + h * HD) + lane;
            const unsigned w = *p; const float x0 = pg8::bf_lo(w), x1 = pg8::bf_hi(w);
            const float ss = wave_sum(x0 * x0 + x1 * x1), rs = rsqrtf(ss * (1.f / HD) + EPS);
            const float y0 = x0 * rs * g0, y1 = x1 * rs * g1; *p = pk2(y0, y1); k0 += y0; k1 += y1; }
        if (which) {
            red[wave * 128 + 2 * lane] = k0; red[wave * 128 + 2 * lane + 1] = k1;
            __syncthreads();
            if (tid < 128) { float s = 0.f;
#pragma unroll
                for (int w = 0; w < 8; ++w) s += red[w * 128 + tid];
                kbar[(size_t)(h * NBLK + n) * HD + tid] = s * (1.f / BLK); }
            __syncthreads();
        }
    }
}
__device__ __forceinline__ void phase2d(unsigned char* ws, LAS unsigned char* lds, int G, int tid, int wave, int lane) {
    LAS unsigned* lcnt = (LAS unsigned*)(lds + 65536); LAS unsigned* lbase = lcnt + 128; LAS unsigned short* llist = (LAS unsigned short*)lds;
    const bf16* Q = (const bf16*)(ws + WS_Q); const float* kbar = (const float*)(ws + WS_KBAR);
    unsigned* gcnt = (unsigned*)(ws + WS_CTL) + CW_GCNT; unsigned short* glist = (unsigned short*)(ws + WS_LIST);
    const int half = wave >> 2, wv = wave & 3, th = tid & 255;
    for (int it = blockIdx.x; it < (NH * 63 + 1) / 2; it += G) {
        const int unit = 2 * it + half; const bool valid = unit < NH * 63; const int h = valid ? unit / 63 : 0, c = valid ? 1 + unit % 63 : 1;
        if (tid < 128) lcnt[tid] = 0u;
        __syncthreads();
        if (valid) {
            const int tl = wv * 64 + lane, t = c * BLK + tl;
            float q[128];
            { const GAS v4u* qp = (const GAS v4u*)(Q + (size_t)t * 1024 + h * HD);
#pragma unroll
              for (int j = 0; j < 16; ++j) { const v4u w = qp[j]; q[8 * j] = pg8::bf_lo(w.x); q[8 * j + 1] = pg8::bf_hi(w.x); q[8 * j + 2] = pg8::bf_lo(w.y); q[8 * j + 3] = pg8::bf_hi(w.y);
                  q[8 * j + 4] = pg8::bf_lo(w.z); q[8 * j + 5] = pg8::bf_hi(w.z); q[8 * j + 6] = pg8::bf_lo(w.w); q[8 * j + 7] = pg8::bf_hi(w.w); } }
            float v0 = -__builtin_inff(), v1 = v0, v2 = v0; int i0 = 0, i1 = 0, i2 = 0;
            for (int n = 0; n < c; ++n) {
                const float* kb = kbar + (size_t)(h * NBLK + n) * HD; float g = 0.f;
#pragma unroll
                for (int d = 0; d < 128; ++d) g = fmaf(q[d], kb[d], g);
                if (g > v0) { v2 = v1; i2 = i1; v1 = v0; i1 = i0; v0 = g; i0 = n; }
                else if (g > v1) { v2 = v1; i2 = i1; v1 = g; i1 = n; }
                else if (g > v2) { v2 = g; i2 = n; }
            }
            const int nsel = c < 3 ? c : 3;
            if (nsel > 0) { const unsigned p = __hip_atomic_fetch_add(&lcnt[half * 64 + i0], 1u, __ATOMIC_RELAXED, __HIP_MEMORY_SCOPE_WORKGROUP); llist[(half * 64 + i0) * 256 + p] = (unsigned short)((tl << 2) | 0); }
            if (nsel > 1) { const unsigned p = __hip_atomic_fetch_add(&lcnt[half * 64 + i1], 1u, __ATOMIC_RELAXED, __HIP_MEMORY_SCOPE_WORKGROUP); llist[(half * 64 + i1) * 256 + p] = (unsigned short)((tl << 2) | 1); }
            if (nsel > 2) { const unsigned p = __hip_atomic_fetch_add(&lcnt[half * 64 + i2], 1u, __ATOMIC_RELAXED, __HIP_MEMORY_SCOPE_WORKGROUP); llist[(half * 64 + i2) * 256 + p] = (unsigned short)((tl << 2) | 2); }
        }
        __syncthreads();
        if (valid && th < c) { const unsigned k = lcnt[half * 64 + th]; lbase[half * 64 + th] = k ? atomicAdd(gcnt + h * NBLK + th, k) : 0u; }
        __syncthreads();
        if (valid) {
            for (int n = wv; n < c; n += 4) { const unsigned k = lcnt[half * 64 + n], base = lbase[half * 64 + n];
                unsigned short* dst = glist + (size_t)h * LIST_PER_HEAD + list_off(n) + base;
                for (unsigned i = lane; i < k; i += 64) { const unsigned e = llist[(half * 64 + n) * 256 + i]; dst[i] = (unsigned short)((((unsigned)c * BLK + (e >> 2)) << 2) | (e & 3u)); } }
        }
        __syncthreads();
    }
}
__device__ __forceinline__ void stage_kv(const bf16* Kg, const bf16* Vt, int h, int n, LAS unsigned char* lds, int tid) {
#pragma unroll
    for (int i = 0; i < 8; ++i) { const int row = (tid >> 4) + 32 * i, ch = tid & 15;
        const v4u w = *(const GAS v4u*)(Kg + (size_t)(n * BLK + row) * 1024 + h * HD + ch * 8);
        const int sw = (((row >> 3) & 3) << 2) | (row & 3);
        *(LAS v4u*)(lds + row * 256 + ((ch ^ sw) << 4)) = w; }
#pragma unroll
    for (int i = 0; i < 8; ++i) { const int row = (tid >> 5) + 16 * i, ch = tid & 31;
        const v4u w = *(const GAS v4u*)(Vt + (size_t)(h * HD + row) * M + n * BLK + ch * 8);
        *(LAS v4u*)(lds + 65536 + row * 512 + ((ch ^ (row & 15)) << 4)) = w; }
}
template <bool CAUSAL>
__device__ __forceinline__ void attn_core(const LAS unsigned char* lds, const bf16* Q, int h, const int (&tq)[2], int wave, int fr, int fq, float B2, f32x4 (&O)[8][2], float (&l)[2]) {
    bf16x8 qf[2][4];
#pragma unroll
    for (int g = 0; g < 2; ++g)
#pragma unroll
        for (int ks = 0; ks < 4; ++ks) qf[g][ks] = *(const GAS bf16x8*)(Q + (size_t)tq[g] * 1024 + h * HD + ks * 32 + fq * 8);
#pragma unroll
    for (int dt = 0; dt < 8; ++dt) { O[dt][0] = (f32x4){0.f, 0.f, 0.f, 0.f}; O[dt][1] = O[dt][0]; }
    l[0] = 0.f; l[1] = 0.f;
    const int nch = CAUSAL ? wave + 1 : 8;
    const int krow = (fr >> 2) * 8 + (fr & 3);
    for (int c = 0; c < nch; ++c) {
        f32x4 s[2][2];
#pragma unroll
        for (int t = 0; t < 2; ++t) { s[t][0] = (f32x4){0.f, 0.f, 0.f, 0.f}; s[t][1] = s[t][0]; }
#pragma unroll
        for (int ks = 0; ks < 4; ++ks)
#pragma unroll
            for (int t = 0; t < 2; ++t) {
                const bf16x8 kf = *(const LAS bf16x8*)(lds + (c * 32 + krow + t * 4) * 256 + (((ks * 4 + fq) ^ fr) << 4));
                s[t][0] = __builtin_amdgcn_mfma_f32_16x16x32_bf16(kf, qf[0][ks], s[t][0], 0, 0, 0);
                s[t][1] = __builtin_amdgcn_mfma_f32_16x16x32_bf16(kf, qf[1][ks], s[t][1], 0, 0, 0);
            }
        bf16x8 pf[2];
#pragma unroll
        for (int g = 0; g < 2; ++g) {
            float p[8];
#pragma unroll
            for (int t = 0; t < 2; ++t)
#pragma unroll
                for (int i = 0; i < 4; ++i) { float e = __builtin_amdgcn_exp2f(s[t][g][i] - B2);
                    if (CAUSAL && c == wave) { const int kl = c * 32 + fq * 8 + t * 4 + i, ql = wave * 32 + g * 16 + fr; if (kl > ql) e = 0.f; }
                    p[t * 4 + i] = e; }
            l[g] += ((p[0] + p[1]) + (p[2] + p[3])) + ((p[4] + p[5]) + (p[6] + p[7]));
            v4u w; w.x = pg8::cvt_pk_bf16(p[0], p[1]); w.y = pg8::cvt_pk_bf16(p[2], p[3]); w.z = pg8::cvt_pk_bf16(p[4], p[5]); w.w = pg8::cvt_pk_bf16(p[6], p[7]);
            pf[g] = __builtin_bit_cast(bf16x8, w);
        }
#pragma unroll
        for (int dt = 0; dt < 8; ++dt) {
            const bf16x8 vf = *(const LAS bf16x8*)(lds + 65536 + (dt * 16 + fr) * 512 + (((c * 4 + fq) ^ fr) << 4));
            O[dt][0] = __builtin_amdgcn_mfma_f32_16x16x32_bf16(vf, pf[0], O[dt][0], 0, 0, 0);
            O[dt][1] = __builtin_amdgcn_mfma_f32_16x16x32_bf16(vf, pf[1], O[dt][1], 0, 0, 0);
        }
    }
    l[0] += __shfl_xor(l[0], 16); l[0] += __shfl_xor(l[0], 32); l[1] += __shfl_xor(l[1], 16); l[1] += __shfl_xor(l[1], 32);
}
__device__ __forceinline__ float score_bound(const float* q_norm, const float* k_norm, int lane) {
    float a = fmaxf(fabsf(q_norm[lane]), fabsf(q_norm[lane + 64])), b = fmaxf(fabsf(k_norm[lane]), fabsf(k_norm[lane + 64]));
#pragma unroll
    for (int o = 1; o < 64; o <<= 1) { a = fmaxf(a, __shfl_xor(a, o)); b = fmaxf(b, __shfl_xor(b, o)); }
    return 128.0f * a * b * C2 * 1.001f + 0.01f;
}
__device__ __forceinline__ void phase3a(const float* q_norm, const float* k_norm, unsigned char* ws, LAS unsigned char* lds, int G, int tid, int wave, int lane) {
    const int fr = lane & 15, fq = lane >> 4;
    LAS int* pre = (LAS int*)(lds + SCAN_OFF);
    const unsigned* gcnt = (const unsigned*)(ws + WS_CTL) + CW_GCNT; const unsigned short* glist = (const unsigned short*)(ws + WS_LIST);
    const bf16* Q = (const bf16*)(ws + WS_Q); const bf16* Kg = (const bf16*)(ws + WS_K); const bf16* Vt = (const bf16*)(ws + WS_VT);
    bf16* OP = (bf16*)(ws + WS_OPART); float* LP = (float*)(ws + WS_LPART);
    const float B2 = score_bound(q_norm, k_norm, lane);
    { const int cnt = (int)__hip_atomic_load(gcnt + tid, __ATOMIC_RELAXED, __HIP_MEMORY_SCOPE_AGENT); pre[tid + 1] = (cnt + 255) >> 8; if (tid == 0) pre[0] = 0; }
    __syncthreads();
    for (int o = 1; o < 512; o <<= 1) { const int v = pre[tid + 1] + ((tid + 1 - o) >= 1 ? pre[tid + 1 - o] : 0); __syncthreads(); pre[tid + 1] = v; __syncthreads(); }
    const int T = pre[512];
    const int i_lo = (int)(((long)blockIdx.x * T) / G), i_hi = (int)(((long)(blockIdx.x + 1) * T) / G);
    int staged = -1;
    for (int it = i_lo; it < i_hi; ++it) {
        int lo = 0, hi = 511;
        while (lo < hi) { const int mid = (lo + hi + 1) >> 1; if (pre[mid] <= it) lo = mid; else hi = mid - 1; }
        const int hn = lo, h = hn >> 6, n = hn & 63, tile = it - pre[hn];
        const int cnt = (int)__hip_atomic_load(gcnt + hn, __ATOMIC_RELAXED, __HIP_MEMORY_SCOPE_AGENT);
        if (hn != staged) { __syncthreads(); stage_kv(Kg, Vt, h, n, lds, tid); LDS_WAIT(); __syncthreads(); staged = hn; }
        const unsigned short* lst = glist + (size_t)h * LIST_PER_HEAD + list_off(n) + tile * 256;
        int tq[2], sj[2]; bool ok[2];
#pragma unroll
        for (int g = 0; g < 2; ++g) { const int qi = wave * 32 + g * 16 + fr; ok[g] = tile * 256 + qi < cnt; const unsigned e = ok[g] ? lst[qi] : 0u; tq[g] = (int)(e >> 2); sj[g] = (int)(e & 3u); }
        f32x4 O[8][2]; float l[2];
        attn_core<false>(lds, Q, h, tq, wave, fr, fq, B2, O, l);
#pragma unroll
        for (int g = 0; g < 2; ++g) if (ok[g]) {
            bf16* op = OP + ((size_t)sj[g] * M + tq[g]) * 1024 + h * HD + 4 * fq;
#pragma unroll
            for (int dt = 0; dt < 8; ++dt) { unsigned long long w = (unsigned long long)pg8::cvt_pk_bf16(O[dt][g][0], O[dt][g][1]) | ((unsigned long long)pg8::cvt_pk_bf16(O[dt][g][2], O[dt][g][3]) << 32);
                *(GAS unsigned long long*)(op + dt * 16) = w; }
            if (fq == 0) LP[((size_t)sj[g] * M + tq[g]) * NH + h] = l[g];
        }
    }
    __syncthreads();
}
__device__ __forceinline__ void phase3b(const float* q_norm, const float* k_norm, unsigned char* ws, LAS unsigned char* lds, int G, int tid, int wave, int lane) {
    const int fr = lane & 15, fq = lane >> 4;
    bf16* Q = (bf16*)(ws + WS_Q); const bf16* Kg = (const bf16*)(ws + WS_K); const bf16* Vt = (const bf16*)(ws + WS_VT);
    const bf16* OP = (const bf16*)(ws + WS_OPART); const float* LP = (const float*)(ws + WS_LPART);
    const float B2 = score_bound(q_norm, k_norm, lane);
    for (int unit = blockIdx.x; unit < NH * NBLK; unit += G) {
        const int h = unit >> 6, c = unit & 63;
        __syncthreads(); stage_kv(Kg, Vt, h, c, lds, tid); LDS_WAIT(); __syncthreads();
        int tq[2];
#pragma unroll
        for (int g = 0; g < 2; ++g) tq[g] = c * BLK + wave * 32 + g * 16 + fr;
        f32x4 O[8][2]; float l[2];
        attn_core<true>(lds, Q, h, tq, wave, fr, fq, B2, O, l);
        const int nsel = c < 3 ? c : 3;
#pragma unroll
        for (int g = 0; g < 2; ++g) {
            float lt = l[g];
            for (int j = 0; j < nsel; ++j) lt += LP[((size_t)j * M + tq[g]) * NH + h];
            const float inv = 1.0f / lt;
#pragma unroll
            for (int dt = 0; dt < 8; ++dt) { f32x4 o = O[dt][g];
                for (int j = 0; j < nsel; ++j) { const unsigned long long w = *(const GAS unsigned long long*)(OP + ((size_t)j * M + tq[g]) * 1024 + h * HD + dt * 16 + 4 * fq);
                    const unsigned wl = (unsigned)w, wh = (unsigned)(w >> 32); o[0] += pg8::bf_lo(wl); o[1] += pg8::bf_hi(wl); o[2] += pg8::bf_lo(wh); o[3] += pg8::bf_hi(wh); }
                o = o * inv;
                *(GAS unsigned long long*)(Q + (size_t)tq[g] * 1024 + h * HD + dt * 16 + 4 * fq) = (unsigned long long)pg8::cvt_pk_bf16(o[0], o[1]) | ((unsigned long long)pg8::cvt_pk_bf16(o[2], o[3]) << 32); }
        }
    }
    __syncthreads();
}

#ifndef MK_PER_PHASE
#define MK_PER_PHASE 0
#endif
constexpr int N_PHASES = 10;
struct Args { const float* in[14]; float* out; unsigned char* ws; int ph_lo, ph_hi; };
__global__ void __launch_bounds__(NTHREADS, 2) hybrid_fwd(Args args) {
    extern __shared__ __attribute__((aligned(16))) unsigned char lds_raw[];
    LAS unsigned char* lds = (LAS unsigned char*)lds_raw;
    volatile LAS unsigned* MISC = (volatile LAS unsigned*)(lds + MISC_OFF);
    const int tid = threadIdx.x, lane = tid & 63, wave = __builtin_amdgcn_readfirstlane(tid >> 6);
    const int G = gridDim.x; const int vcu = (G % 8 == 0) ? ((int)blockIdx.x % 8) * (G / 8) + (int)blockIdx.x / 8 : (int)blockIdx.x;
    unsigned char* ws = args.ws;
    gu32* ctl = (gu32*)(ws + WS_CTL);
    if (tid < 32) MISC[tid] = 0u;
    __syncthreads();
    const int lo = args.ph_lo, hi = args.ph_hi;
    XcdBarrier bar; bar.bar = (unsigned*)ctl + CW_BAR; bar.x = 0; bar.st = nullptr;
    if (hi - lo > 1) bar = xcd_barrier_post((unsigned*)ctl + CW_BAR, MISC + 8);
#ifndef PHASE_MASK
#define PHASE_MASK 0x3ff
#endif
#define IN(k) (((PHASE_MASK >> (k)) & 1) && lo <= (k) && (k) < hi)
#define SEAM(k) do { if (IN(k) && IN((k) + 1)) xcd_barrier(bar); } while (0)
    const float* x = args.in[0]; const float* norm_mix = args.in[1]; const float* w_in = args.in[2]; const float* conv_a_w = args.in[3]; const float* q_norm = args.in[4]; const float* k_norm = args.in[5];
    const float* w_oa = args.in[6]; const float* w_ob = args.in[7]; const float* w_o = args.in[8]; const float* norm_ffn = args.in[9]; const float* w_up = args.in[10]; const float* ffn_conv_w = args.in[11];
    const float* ffn_conv_b = args.in[12]; const float* w_down = args.in[13];
    float* out = args.out;
    float* rowss = (float*)((unsigned*)ctl + CW_ROWSS);
    const size_t TSTEP = (size_t)256 * 1024 * 2;

    if (IN(0)) { phase0(x, norm_mix, w_in, w_oa, w_ob, w_o, ws, lds, vcu, G, wave, lane); __syncthreads(); }
    SEAM(0);
    if (IN(1)) {
        pg8::Gemm g{(const bf16*)(ws + WS_XB), (const bf16*)(ws + WS_XB), (const bf16*)(ws + WS_WIN), (const bf16*)(ws + WS_WIN), D, TSTEP};
        pg8::StaticOrder S; S.init(M / 256, NIN / 256, G, (int)blockIdx.x);
        pg8::Epi1 E{(bf16*)(ws + WS_CA), (bf16*)(ws + WS_UU), (bf16*)(ws + WS_Q), (bf16*)(ws + WS_K), (bf16*)(ws + WS_VT), (bf16*)out, (const float*)(ws + WS_RSTDX)};
        pg8::gemm_phase<pg8::Epi1, pg8::StaticOrder, true, true>(lds, g, S, E);
    }
    SEAM(1);
    if (IN(2)) phase2(conv_a_w, q_norm, k_norm, ws, lds, G, tid, wave, lane);
    SEAM(2);
    if (IN(3)) phase2d(ws, lds, G, tid, wave, lane);
    SEAM(3);
    if (IN(4)) phase3a(q_norm, k_norm, ws, lds, G, tid, wave, lane);
    SEAM(4);
    if (IN(5)) phase3b(q_norm, k_norm, ws, lds, G, tid, wave, lane);
    SEAM(5);
    if (IN(6)) {
        { LAS float* scr = (LAS float*)(lds + wave * 16384); const int gw = vcu * NWAVES + wave, NGW = G * NWAVES;
          convert_weight(w_up, D, 2 * DFF, (bf16*)(ws + WS_WUP), norm_ffn, 2, scr, gw, NGW, lane);
          convert_weight(w_down, DFF, D, (bf16*)(ws + WS_WDN), nullptr, 0, scr, gw, NGW, lane);
          if (blockIdx.x == 0 && tid < 256) *(GAS v4u*)(ws + WS_HB - 4096 + tid * 16) = (v4u){0u, 0u, 0u, 0u};
          __syncthreads(); }
        pg8::Gemm g{(const bf16*)(ws + WS_CA), (const bf16*)(ws + WS_Q), (const bf16*)(ws + WS_WOA), (const bf16*)(ws + WS_WOB), D, TSTEP};
        pg8::DualOrder S; S.S.init(M / 256, D / 256, G, (int)blockIdx.x);
        pg8::Epi4 E{(bf16*)(ws + WS_MG), (const bf16*)out};
        pg8::gemm_phase<pg8::Epi4, pg8::DualOrder, true, true>(lds, g, S, E);
    }
    SEAM(6);
    if (IN(7)) {
        pg8::Gemm g{(const bf16*)(ws + WS_MG), (const bf16*)(ws + WS_MG), (const bf16*)(ws + WS_WO), (const bf16*)(ws + WS_WO), D, TSTEP};
        pg8::StaticOrder S; S.init(M / 256, D / 256, G, (int)blockIdx.x);
        pg8::Epi5 E{x, out, (bf16*)(ws + WS_HB), rowss};
        pg8::gemm_phase<pg8::Epi5, pg8::StaticOrder, true, true>(lds, g, S, E);
    }
    SEAM(7);
    if (IN(8)) {
        const bf16* hb2 = (const bf16*)(ws + WS_HB) - 2 * 1024;
        pg8::Gemm g{hb2, hb2, (const bf16*)(ws + WS_WUP), (const bf16*)(ws + WS_WUP), D, (size_t)254 * 1024 * 2};
        pg8::StaticOrder S; S.init(65, 22, G, (int)blockIdx.x);
        pg8::Epi6 E{(bf16*)(ws + WS_ACT), rowss, ffn_conv_w, ffn_conv_b, (PG8_LAS float*)(lds + HALO_OFF)};
        pg8::gemm_phase<pg8::Epi6, pg8::StaticOrder, true, true>(lds, g, S, E);
    }
    SEAM(8);
    if (IN(9)) {
        pg8::Gemm g{(const bf16*)(ws + WS_ACT), (const bf16*)(ws + WS_ACT), (const bf16*)(ws + WS_WDN), (const bf16*)(ws + WS_WDN), DFF, (size_t)256 * DFF * 2};
        pg8::StaticOrder S; S.init(M / 256, D / 256, G, (int)blockIdx.x);
        pg8::Epi7 E{out};
        pg8::gemm_phase<pg8::Epi7, pg8::StaticOrder, true, true>(lds, g, S, E);
    }
#undef IN
#undef SEAM
}

extern "C" void kernel_launch(void* const* d_in, const int* in_sizes, int n_in, void* d_out, int out_size, void* d_ws, size_t ws_size, hipStream_t stream) {
    static int grid = 0;
    if (grid == 0) {
        if (n_in != 14 || in_sizes[0] != M * D || out_size != M * D || ws_size < WS_END) { fprintf(stderr, "kernel_launch: unexpected shapes (n_in %d, in0 %d, out %d, ws %zu)\n", n_in, n_in > 0 ? in_sizes[0] : -1, out_size, ws_size); grid = -1; return; }
        int dev = 0, cus = 0, per_cu = 0;
        if (hipGetDevice(&dev) != hipSuccess || hipDeviceGetAttribute(&cus, hipDeviceAttributeMultiprocessorCount, dev) != hipSuccess) { grid = -1; return; }
        if (hipFuncSetAttribute((const void*)hybrid_fwd, hipFuncAttributeMaxDynamicSharedMemorySize, LDS_BYTES) != hipSuccess) { fprintf(stderr, "kernel_launch: hipFuncSetAttribute failed\n"); grid = -1; return; }
        if (hipOccupancyMaxActiveBlocksPerMultiprocessor(&per_cu, (const void*)hybrid_fwd, NTHREADS, LDS_BYTES) != hipSuccess || per_cu < 1) { fprintf(stderr, "kernel_launch: occupancy query says %d blocks per CU\n", per_cu); (void)hipGetLastError(); grid = -1; return; }
        grid = cus;
    }
    if (grid < 0) return;
    if (hipMemsetAsync((char*)d_ws + WS_CTL, 0, CTL_ZERO_BYTES, stream) != hipSuccess) { fprintf(stderr, "kernel_launch: memset failed\n"); return; }
    Args a{};
    for (int i = 0; i < 14; ++i) a.in[i] = (const float*)d_in[i];
    a.out = (float*)d_out; a.ws = (unsigned char*)d_ws;
#if MK_PER_PHASE
    for (int p = 0; p < N_PHASES; ++p) { a.ph_lo = p; a.ph_hi = p + 1; hipLaunchKernelGGL(hybrid_fwd, dim3(grid), dim3(NTHREADS), LDS_BYTES, stream, a); }
#else
    a.ph_lo = 0; a.ph_hi = N_PHASES;
    void* kargs[] = {&a};
    hipError_t e = hipLaunchCooperativeKernel((const void*)hybrid_fwd, dim3(grid), dim3(NTHREADS), kargs, LDS_BYTES, stream);
    if (e != hipSuccess) fprintf(stderr, "kernel_launch: cooperative launch failed: %s (grid %d)\n", hipGetErrorString(e), grid);
#endif
}
```

```cpp
#include <hip/hip_runtime.h>
#include <cstdio>
#include <cstdint>
namespace pg8 {
#define PG8_LAS __attribute__((address_space(3)))
typedef unsigned short bf16_t;
typedef short bf16x8 __attribute__((ext_vector_type(8)));
typedef float f32x4 __attribute__((ext_vector_type(4)));
typedef unsigned u32x4 __attribute__((ext_vector_type(4)));
constexpr int BM = 256, BK = 64, HALF = 128, HTB = HALF * BK * 2  , STAGE_BYTES = 8 * HTB, NXCD = 8, WGM = 8;

__host__ __device__ __forceinline__ int lds_byte(int r, int c) { const int st = (r >> 4) * 2 + (c >> 5), rr = r & 15, cc = c & 31, ob = rr * 64 + cc * 2; return st * 1024 + (ob ^ (((ob >> 9) & 1) << 5)); }
__host__ __device__ __forceinline__ void stage_rc(int b, int& R, int& C) { const int st = b / 1024, sb = b % 1024, swz = sb ^ (((sb >> 9) & 1) << 5); R = (st >> 1) * 16 + swz / 64; C = (st & 1) * 32 + (swz % 64) / 2; }
__host__ __device__ __forceinline__ int perm32(int rho) { const int n = rho >> 4, i = rho & 15; return 8 * (i >> 2) + 4 * n + (i & 3); }


struct Unit { int pm, pn, sel; };
struct Gemm { const bf16_t* A0; const bf16_t* A1; const bf16_t* B0; const bf16_t* B1; int K; size_t a_tstep; };

struct StaticOrder {
    int nM, nN, nwg, G, c;
    __host__ __device__ void init(int nM_, int nN_, int G_, int c_) { nM = nM_; nN = nN_; nwg = nM * nN; G = G_; c = c_; }
    __host__ __device__ bool next(int i, Unit& u) const {
        const long L = (long)i * G + c; if (L >= nwg) return false;
        int wgid = (int)L; { const int q = nwg / NXCD, r = nwg % NXCD, xcd = wgid % NXCD, off = wgid / NXCD; wgid = (xcd < r ? xcd * (q + 1) : r * (q + 1) + (xcd - r) * q) + off; }
        const int nig = WGM * nN, gid = wgid / nig, fm = gid * WGM, gsz = (nM - fm) < WGM ? (nM - fm) : WGM;
        u.pm = fm + ((wgid % nig) % gsz); u.pn = (wgid % nig) / gsz; u.sel = 0; return true;
    }
    __device__ __forceinline__ void a_ready(const Unit&) const {}
    __device__ __forceinline__ void done(const Unit&) const {}
};
struct DualOrder {
    StaticOrder S;
    __host__ __device__ bool next(int i, Unit& u) const { const bool ok = S.next(i >> 1, u); u.sel = i & 1; return ok; }
    __device__ __forceinline__ void a_ready(const Unit&) const {}
    __device__ __forceinline__ void done(const Unit&) const {}
};

typedef __bf16 bf16x2_t_ __attribute__((ext_vector_type(2))); typedef float f32x2_t_ __attribute__((ext_vector_type(2)));
__device__ __forceinline__ unsigned cvt_pk_bf16(float lo, float hi) { const f32x2_t_ v = {lo, hi}; const bf16x2_t_ b = __builtin_convertvector(v, bf16x2_t_); return __builtin_bit_cast(unsigned, b); }
__device__ __forceinline__ float bf_lo(unsigned w) { return __uint_as_float(w << 16); }
__device__ __forceinline__ float bf_hi(unsigned w) { return __uint_as_float(w & 0xffff0000u); }
__device__ __forceinline__ float fast_sigmoid(float x) { return __builtin_amdgcn_rcpf(1.0f + __builtin_amdgcn_exp2f(-1.4426950408889634f * x)); }
__device__ __forceinline__ u32x4 pack8(const f32x4 a, const f32x4 b) { u32x4 w; w.x = cvt_pk_bf16(a[0], a[1]); w.y = cvt_pk_bf16(a[2], a[3]); w.z = cvt_pk_bf16(b[0], b[1]); w.w = cvt_pk_bf16(b[2], b[3]); return w; }

template <int CTRL> __device__ __forceinline__ float dpp_shr(float old, float v) { return __builtin_bit_cast(float, __builtin_amdgcn_update_dpp(__builtin_bit_cast(int, old), __builtin_bit_cast(int, v), CTRL, 0xf, 0xf, false)); }
template <int CTRL> __device__ __forceinline__ float dpp_ror(float v) { return __builtin_bit_cast(float, __builtin_amdgcn_update_dpp(0, __builtin_bit_cast(int, v), CTRL, 0xf, 0xf, true)); }
constexpr int MROWS = 16384, DMODEL = 1024, DFF_ = 2816;

struct Epi1 {
    static constexpr bool PERM = true, AFTER_DRAIN = false;
    static __device__ __forceinline__ bool keep_acc(const Unit&) { return false; }
    bf16_t *BG, *UU, *Q, *K, *VT, *SG; const float* rstdx; const float *q_norm, *k_norm; float* kbar; PG8_LAS float* xl;
    __device__ __forceinline__ void operator()(f32x4 (&acc)[2][2][4][2], const Unit& u, int wr, int wc, int fr, int fq) const {
        const int row0 = u.pm * BM + wr * 64 + fr, colw = wc * 32 + 8 * fq, pn = u.pn;
        if (pn >= 12 && pn < 20) {
            const bool isK = pn >= 16; const float* wn = isK ? k_norm : q_norm; const float gs = isK ? 1.0f : 0.12751743074602357f;
            bf16_t* dst = isK ? K : Q; const int cb = ((pn - 12) & 3) * 256;
#pragma unroll
            for (int ai = 0; ai < 2; ++ai)
#pragma unroll
                for (int m = 0; m < 4; ++m) { const int rl = ai * HALF + wr * 64 + m * 16 + fr; const float rs = rstdx[u.pm * BM + rl];
#pragma unroll
                    for (int bj = 0; bj < 2; ++bj) { const f32x4 a = acc[ai][bj][m][0] * rs, b = acc[ai][bj][m][1] * rs; acc[ai][bj][m][0] = a; acc[ai][bj][m][1] = b;
                        float ss = (a[0] * a[0] + a[1] * a[1]) + (a[2] * a[2] + a[3] * a[3]) + (b[0] * b[0] + b[1] * b[1]) + (b[2] * b[2] + b[3] * b[3]);
                        ss += __shfl_xor(ss, 16); ss += __shfl_xor(ss, 32);
                        if (fq == 0) xl[(rl * 2 + bj) * 4 + wc] = ss; } }
            asm volatile("s_waitcnt lgkmcnt(0)" ::: "memory"); __builtin_amdgcn_s_barrier(); asm volatile("" ::: "memory");
            const f32x4 g0 = *(const f32x4*)(wn + colw) * gs, g1 = *(const f32x4*)(wn + colw + 4) * gs;
#pragma unroll
            for (int ai = 0; ai < 2; ++ai)
#pragma unroll
                for (int m = 0; m < 4; ++m) { const int rl = ai * HALF + wr * 64 + m * 16 + fr; const int r = u.pm * BM + rl;
#pragma unroll
                    for (int bj = 0; bj < 2; ++bj) { const f32x4 p = *(const PG8_LAS f32x4*)(xl + (rl * 2 + bj) * 4);
                        const float rn = rsqrtf(((p[0] + p[1]) + (p[2] + p[3])) * (1.0f / 128.0f) + 1e-6f);
                        const f32x4 a = acc[ai][bj][m][0] * rn * g0, b = acc[ai][bj][m][1] * rn * g1; acc[ai][bj][m][0] = a; acc[ai][bj][m][1] = b;
                        *(u32x4*)(dst + (size_t)r * 1024 + cb + bj * 128 + colw) = pack8(a, b); } }
            if (isK) {
                f32x4 cs[2][2];
#pragma unroll
                for (int bj = 0; bj < 2; ++bj)
#pragma unroll
                    for (int n = 0; n < 2; ++n) { f32x4 t = acc[0][bj][0][n];
#pragma unroll
                        for (int ai = 0; ai < 2; ++ai)
#pragma unroll
                            for (int m = 0; m < 4; ++m) if (ai + m > 0) t += acc[ai][bj][m][n];
                        cs[bj][n] = t; }
#pragma unroll
                for (int bj = 0; bj < 2; ++bj)
#pragma unroll
                    for (int n = 0; n < 2; ++n)
#pragma unroll
                        for (int e = 0; e < 4; ++e) { float v = cs[bj][n][e]; v += __shfl_xor(v, 1); v += __shfl_xor(v, 2); v += __shfl_xor(v, 4); v += __shfl_xor(v, 8); cs[bj][n][e] = v; }
                if (fr == 0) {
#pragma unroll
                    for (int bj = 0; bj < 2; ++bj) { *(PG8_LAS f32x4*)(xl + 2048 + wr * 256 + bj * 128 + colw) = cs[bj][0]; *(PG8_LAS f32x4*)(xl + 2048 + wr * 256 + bj * 128 + colw + 4) = cs[bj][1]; } }
                asm volatile("s_waitcnt lgkmcnt(0)" ::: "memory"); __builtin_amdgcn_s_barrier(); asm volatile("" ::: "memory");
                int t = threadIdx.x; asm volatile("" : "+v"(t));
                if (t < 256) kbar[((size_t)((pn - 16) * 2 + (t >> 7)) * 64 + u.pm) * 128 + (t & 127)] = (xl[2048 + t] + xl[2048 + 256 + t]) * (1.0f / 256.0f);
            }
            return;
        }
        if (pn >= 20 && pn < 24) {
            int tidv = threadIdx.x; asm volatile("" : "+v"(tidv));
            PG8_LAS unsigned char* T = (PG8_LAS unsigned char*)xl + (tidv >> 6) * 2304;
            const int lane = tidv & 63;
#pragma unroll
            for (int ai = 0; ai < 2; ++ai)
#pragma unroll
                for (int mp = 0; mp < 2; ++mp)
#pragma unroll
                    for (int bj = 0; bj < 2; ++bj) {
#pragma unroll
                        for (int mm = 0; mm < 2; ++mm) { const int m = 2 * mp + mm; const float rs = rstdx[u.pm * BM + ai * HALF + wr * 64 + m * 16 + fr];
                            const u32x4 w = pack8(acc[ai][bj][m][0] * rs, acc[ai][bj][m][1] * rs); const unsigned ww[4] = {w.x, w.y, w.z, w.w};
                            PG8_LAS unsigned char* tp = T + (8 * fq) * 72 + (16 * mm + fr) * 2;
#pragma unroll
                            for (int e = 0; e < 8; ++e) *(PG8_LAS unsigned short*)(tp + e * 72) = (unsigned short)((e & 1) ? (ww[e >> 1] >> 16) : (ww[e >> 1] & 0xffffu)); }
                        asm volatile("s_waitcnt lgkmcnt(0)" ::: "memory");
#pragma unroll
                        for (int rr = 0; rr < 2; ++rr) { const int q = lane + 64 * rr, d = q >> 2, tc = q & 3;
                            const unsigned long long x0 = *(const PG8_LAS unsigned long long*)(T + d * 72 + tc * 16), x1 = *(const PG8_LAS unsigned long long*)(T + d * 72 + tc * 16 + 8);
                            u32x4 o; o.x = (unsigned)x0; o.y = (unsigned)(x0 >> 32); o.z = (unsigned)x1; o.w = (unsigned)(x1 >> 32);
                            *(u32x4*)(VT + ((size_t)(((pn - 20) * 2 + bj) * 128 + 32 * wc + d)) * MROWS + u.pm * BM + ai * HALF + wr * 64 + 32 * mp + tc * 8) = o; }
                        asm volatile("s_waitcnt lgkmcnt(0)" ::: "memory");
                    }
            return;
        }
#pragma unroll
        for (int ai = 0; ai < 2; ++ai)
#pragma unroll
            for (int m = 0; m < 4; ++m) {
                const int r = row0 + ai * HALF + m * 16; const float rs = rstdx[r];
                f32x4 v[2][2];
#pragma unroll
                for (int bj = 0; bj < 2; ++bj)
#pragma unroll
                    for (int n = 0; n < 2; ++n) v[bj][n] = acc[ai][bj][m][n] * rs;
                if (pn < 4) {
#pragma unroll
                    for (int bj = 0; bj < 2; ++bj) *(u32x4*)(BG + (size_t)r * 1024 + pn * 256 + bj * 128 + colw) = pack8(v[bj][0], v[bj][1]);
                } else if (pn < 12) {
                    *(u32x4*)(UU + (size_t)r * 1024 + (pn - 4) * 128 + colw) = pack8(v[0][0] * v[1][0], v[0][1] * v[1][1]);
                } else {
                    f32x4 ra, rb, sa, sb;
#pragma unroll
                    for (int e = 0; e < 4; ++e) { const float ea0 = __builtin_amdgcn_exp2f(-1.4426950408889634f * v[0][0][e]), ea1 = __builtin_amdgcn_exp2f(-1.4426950408889634f * v[0][1][e]);
                        const float eb0 = __builtin_amdgcn_exp2f(-1.4426950408889634f * v[1][0][e]), eb1 = __builtin_amdgcn_exp2f(-1.4426950408889634f * v[1][1][e]);
                        ra[e] = (1.0f + eb0) * __builtin_amdgcn_rcpf(1.0f + ea0); rb[e] = (1.0f + eb1) * __builtin_amdgcn_rcpf(1.0f + ea1);
                        sa[e] = __builtin_amdgcn_rcpf(1.0f + eb0); sb[e] = __builtin_amdgcn_rcpf(1.0f + eb1); }
                    *(u32x4*)(SG + (size_t)r * 2048 + (pn - 24) * 128 + colw) = pack8(ra, rb);
                    *(u32x4*)(SG + (size_t)r * 2048 + 1024 + (pn - 24) * 128 + colw) = pack8(sa, sb);
                }
            }
    }
};
struct Epi4 {
    static constexpr bool PERM = true, AFTER_DRAIN = false;
    bf16_t* MG; const bf16_t* SG;
    static __device__ __forceinline__ bool keep_acc(const Unit& u) { return u.sel == 0; }
    __device__ __forceinline__ void operator()(f32x4 (&acc)[2][2][4][2], const Unit& u, int wr, int wc, int fr, int fq) const {
        const int row0 = u.pm * BM + wr * 64 + fr, col0 = u.pn * BM + wc * 32 + 8 * fq;
#pragma unroll
        for (int ai = 0; ai < 2; ++ai)
#pragma unroll
            for (int m = 0; m < 4; ++m) { const int r = row0 + ai * HALF + m * 16;
#pragma unroll
                for (int bj = 0; bj < 2; ++bj) { const int c = col0 + bj * HALF;
                    const u32x4 g = *(const u32x4*)(SG + (size_t)r * 2048 + u.sel * 1024 + c);
                    f32x4 a = acc[ai][bj][m][0], b = acc[ai][bj][m][1];
                    a[0] *= bf_lo(g.x); a[1] *= bf_hi(g.x); a[2] *= bf_lo(g.y); a[3] *= bf_hi(g.y); b[0] *= bf_lo(g.z); b[1] *= bf_hi(g.z); b[2] *= bf_lo(g.w); b[3] *= bf_hi(g.w);
                    if (u.sel) *(u32x4*)(MG + (size_t)r * 1024 + c) = pack8(a, b);
                    else { acc[ai][bj][m][0] = a; acc[ai][bj][m][1] = b; } } }
    }
};
struct Epi5 {
    static constexpr bool PERM = true, AFTER_DRAIN = false;
    static __device__ __forceinline__ bool keep_acc(const Unit&) { return false; }
    const float* X; float* OUT; bf16_t* HB; float* rowss;
    __device__ __forceinline__ void operator()(f32x4 (&acc)[2][2][4][2], const Unit& u, int wr, int wc, int fr, int fq) const {
        const int row0 = u.pm * BM + wr * 64 + fr, col0 = u.pn * BM + wc * 32 + 8 * fq;
#pragma unroll
        for (int ai = 0; ai < 2; ++ai)
#pragma unroll
            for (int m = 0; m < 4; ++m) { const int r = row0 + ai * HALF + m * 16; float ss = 0.f;
#pragma unroll
                for (int bj = 0; bj < 2; ++bj) { const size_t o = (size_t)r * 1024 + col0 + bj * HALF;
                    const f32x4 a = acc[ai][bj][m][0] + *(const f32x4*)(X + o), b = acc[ai][bj][m][1] + *(const f32x4*)(X + o + 4);
                    *(u32x4*)(HB + o) = pack8(a, b);
                    ss += (a[0] * a[0] + a[1] * a[1]) + (a[2] * a[2] + a[3] * a[3]) + (b[0] * b[0] + b[1] * b[1]) + (b[2] * b[2] + b[3] * b[3]); }
                ss += __shfl_xor(ss, 16); ss += __shfl_xor(ss, 32);
                if (fq == 0) atomicAdd(rowss + r, ss); }
    }
};
struct Epi6 {
    static constexpr bool PERM = true, AFTER_DRAIN = false;
    static __device__ __forceinline__ bool keep_acc(const Unit&) { return false; }
    bf16_t* ACT; const float* rowss; const float* cw; const float* cb; PG8_LAS float* halo;
    __device__ __forceinline__ void operator()(f32x4 (&acc)[2][2][4][2], const Unit& u, int wr, int wc, int fr, int fq) const {
        const int r0 = u.pm * 254 - 2, colw = wc * 32 + 8 * fq;
#pragma unroll
        for (int ai = 0; ai < 2; ++ai)
#pragma unroll
            for (int m = 0; m < 4; ++m) { int gr = r0 + ai * HALF + wr * 64 + m * 16 + fr; gr = gr < 0 ? 0 : (gr > MROWS - 1 ? MROWS - 1 : gr);
                const float rs = rsqrtf(rowss[gr] * (1.0f / 1024.0f) + 1e-6f);
#pragma unroll
                for (int bj = 0; bj < 2; ++bj)
#pragma unroll
                    for (int n = 0; n < 2; ++n) acc[ai][bj][m][n] *= rs; }
        if (fr >= 14) {
#pragma unroll
            for (int ai = 0; ai < 2; ++ai)
#pragma unroll
                for (int bj = 0; bj < 2; ++bj)
#pragma unroll
                    for (int n = 0; n < 2; ++n) *(PG8_LAS f32x4*)(halo + (((2 * ai + wr) * 2 + (fr - 14)) * 256 + bj * 128 + colw + 4 * n)) = acc[ai][bj][3][n];
        }
        f32x4 wn0, wn1, wn2, wnb;
        { const int col = u.pn * 128 + colw; wn0 = *(const f32x4*)(cw + col); wn1 = *(const f32x4*)(cw + 2 * DFF_ + col); wn2 = *(const f32x4*)(cw + 4 * DFF_ + col); wnb = *(const f32x4*)(cb + col); }
        asm volatile("s_waitcnt lgkmcnt(0)" ::: "memory"); __builtin_amdgcn_s_barrier(); asm volatile("" ::: "memory");
#pragma unroll
        for (int bj = 0; bj < 2; ++bj)
#pragma unroll
            for (int n = 0; n < 2; ++n) {
                const f32x4 w0 = wn0, w1 = wn1, w2 = wn2, bb = wnb;
                if (bj * 2 + n < 3) { const int k2 = bj * 2 + n + 1, col = (k2 >> 1) * DFF_ + u.pn * 128 + colw + 4 * (k2 & 1);
                    wn0 = *(const f32x4*)(cw + col); wn1 = *(const f32x4*)(cw + 2 * DFF_ + col); wn2 = *(const f32x4*)(cw + 4 * DFF_ + col); wnb = *(const f32x4*)(cb + col); }
#pragma unroll
                for (int ai = 0; ai < 2; ++ai) {
                    const int s = 2 * ai + wr;
                    const int sm = s > 0 ? s - 1 : 0; const float hz = s > 0 ? 1.0f : 0.0f;
                    const f32x4 h2 = *(const PG8_LAS f32x4*)(halo + ((sm * 2 + 0) * 256 + bj * 128 + colw + 4 * n)) * hz, h1 = *(const PG8_LAS f32x4*)(halo + ((sm * 2 + 1) * 256 + bj * 128 + colw + 4 * n)) * hz;
#pragma unroll
                    for (int mm = 0; mm < 4; ++mm) { const int m = 3 - mm;
                        f32x4 cur = acc[ai][bj][m][n]; asm volatile("" : "+v"(cur)); f32x4 p1, p2;
                        if (m > 0) { f32x4 lo = acc[ai][bj][m > 0 ? m - 1 : 0][n]; asm volatile("" : "+v"(lo));
#pragma unroll
                            for (int e = 0; e < 4; ++e) { p1[e] = dpp_shr<0x111>(dpp_ror<0x121>(lo[e]), cur[e]); p2[e] = dpp_shr<0x112>(dpp_ror<0x122>(lo[e]), cur[e]); } }
                        else {
#pragma unroll
                            for (int e = 0; e < 4; ++e) { p1[e] = dpp_shr<0x111>(h1[e], cur[e]); p2[e] = dpp_shr<0x112>(fr == 0 ? h2[e] : h1[e], cur[e]); } }
                        { f32x4 r_ = w0 * p2 + w1 * p1 + w2 * cur + bb; asm volatile("" : "+v"(r_)); acc[ai][bj][m][n] = r_; } }
                }
            }
#pragma unroll
        for (int ai = 0; ai < 2; ++ai)
#pragma unroll
            for (int m = 0; m < 4; ++m) { const int i = ai * HALF + wr * 64 + m * 16 + fr, gr = r0 + i;
                f32x4 a, b;
#pragma unroll
                for (int e = 0; e < 4; ++e) { const float g0 = acc[ai][0][m][0][e], g1 = acc[ai][0][m][1][e];
                    a[e] = g0 * fast_sigmoid(g0) * acc[ai][1][m][0][e]; b[e] = g1 * fast_sigmoid(g1) * acc[ai][1][m][1][e]; }
                if (i >= 2 && gr < MROWS) *(u32x4*)(ACT + (size_t)gr * DFF_ + u.pn * 128 + colw) = pack8(a, b); }
    }
};
struct Epi7 {
    static constexpr bool PERM = true, AFTER_DRAIN = false;
    static __device__ __forceinline__ bool keep_acc(const Unit&) { return false; }
    float* OUT; const bf16_t* HB;
    __device__ __forceinline__ void operator()(f32x4 (&acc)[2][2][4][2], const Unit& u, int wr, int wc, int fr, int fq) const {
        const int row0 = u.pm * BM + wr * 64 + fr, col0 = u.pn * BM + wc * 32 + 8 * fq;
#pragma unroll
        for (int ai = 0; ai < 2; ++ai)
#pragma unroll
            for (int m = 0; m < 4; ++m) { const int r = row0 + ai * HALF + m * 16;
#pragma unroll
                for (int bj = 0; bj < 2; ++bj) { const size_t o = (size_t)r * 1024 + col0 + bj * HALF; float* p = OUT + o; const u32x4 hw = *(const u32x4*)(HB + o);
                    f32x4 a = acc[ai][bj][m][0], b = acc[ai][bj][m][1];
                    a[0] += bf_lo(hw.x); a[1] += bf_hi(hw.x); a[2] += bf_lo(hw.y); a[3] += bf_hi(hw.y); b[0] += bf_lo(hw.z); b[1] += bf_hi(hw.z); b[2] += bf_lo(hw.w); b[3] += bf_hi(hw.w);
                    *(f32x4*)p = a; *(f32x4*)(p + 4) = b; } }
    }
};
template <class Epi, class Sched, bool ALIGN_EPI = false, bool SP2 = false>
__device__ __forceinline__ void gemm_phase(PG8_LAS unsigned char* lds, const Gemm g, const Sched& S, const Epi& E) {
    const int tid = threadIdx.x, wid = __builtin_amdgcn_readfirstlane(tid >> 6), lane = tid & 63, wr = wid >> 2, wc = wid & 3, fr = lane & 15, fq = lane >> 4;
    const int K = g.K, nt = K / BK;
    unsigned voffA[2], voffB[2];
#pragma unroll
    for (int i = 0; i < 2; ++i) { int R, C; stage_rc(tid * 16 + i * 8192, R, C); const int Rb = Epi::PERM ? ((R & ~31) + perm32(R & 31)) : R;
        voffA[i] = (unsigned)(R * K + C) * 2u; voffB[i] = (unsigned)(Rb * K + C) * 2u; }
    const size_t kstep = (size_t)(BK * 2);
    const size_t hstep = (size_t)HALF * K * 2;
    const size_t tstep = 2 * hstep;
    const unsigned ldsw = (unsigned)wid * 1024u;
    const int aoff = lds_byte(wr * 64 + fr, fq * 8), boff = lds_byte(wc * 32 + fr, fq * 8);
#define PG8_SA(b, h) (((b) * 2 + (h)) * HTB)
#define PG8_SB(b, h) ((4 + (b) * 2 + (h)) * HTB)
#define PG8_STAGE(bufoff, gbase, voff) do { _Pragma("unroll") for (int _i = 0; _i < 2; ++_i) \
        __builtin_amdgcn_global_load_lds((const unsigned*)((const char*)(gbase) + (voff)[_i]), (PG8_LAS unsigned*)(lds + (bufoff) + ldsw + _i * 8192), 16, 0, 0); } while (0)
#define PG8_LDA(dst, b, h) do { _Pragma("unroll") for (int m = 0; m < 4; ++m) _Pragma("unroll") for (int k = 0; k < 2; ++k) dst[m][k] = *(const PG8_LAS bf16x8*)(lds + PG8_SA(b, h) + aoff + m * 2048 + k * 1024); } while (0)
#define PG8_LDB(dst, b, h) do { _Pragma("unroll") for (int n = 0; n < 2; ++n) _Pragma("unroll") for (int k = 0; k < 2; ++k) dst[n][k] = *(const PG8_LAS bf16x8*)(lds + PG8_SB(b, h) + boff + n * 2048 + k * 1024); } while (0)
#define PG8_MMA(ai, bj, At, Bt) do { __builtin_amdgcn_s_setprio(1); _Pragma("unroll") for (int m = 0; m < 4; ++m) _Pragma("unroll") for (int n = 0; n < 2; ++n) _Pragma("unroll") for (int k = 0; k < 2; ++k) \
        acc[ai][bj][m][n] = __builtin_amdgcn_mfma_f32_16x16x32_bf16(Bt[n][k], At[m][k], acc[ai][bj][m][n], 0, 0, 0); __builtin_amdgcn_s_setprio(0); } while (0)
#define PG8_WAIT_V(n) asm volatile("s_waitcnt vmcnt(" #n ")" ::: "memory")
#define PG8_WAIT_L(n) asm volatile("s_waitcnt lgkmcnt(" #n ")" ::: "memory")
#define PG8_BAR __builtin_amdgcn_s_barrier()
#define PG8_SCHED __builtin_amdgcn_sched_barrier(0)
    Unit cur, nxt; int ui = 0;
    if (!S.next(0, cur)) return;
    f32x4 acc[2][2][4][2];
#pragma unroll
    for (int a = 0; a < 2; ++a)
#pragma unroll
        for (int b = 0; b < 2; ++b)
#pragma unroll
            for (int m = 0; m < 4; ++m)
#pragma unroll
                for (int n = 0; n < 2; ++n) acc[a][b][m][n] = (f32x4){0.f, 0.f, 0.f, 0.f};
    bf16x8 At[4][2], B0[2][2], B1[2][2];
    const char* cA = (const char*)(cur.sel ? g.A1 : g.A0) + (size_t)cur.pm * g.a_tstep; const char* cB = (const char*)(cur.sel ? g.B1 : g.B0) + (size_t)cur.pn * tstep;
    S.a_ready(cur);
    if constexpr (SP2) {
        PG8_STAGE(PG8_SB(0, 0), cB, voffB); PG8_STAGE(PG8_SB(0, 1), cB + hstep, voffB); PG8_STAGE(PG8_SA(0, 0), cA, voffA); PG8_STAGE(PG8_SA(0, 1), cA + hstep, voffA);
        if (wr == 1) PG8_BAR;
        PG8_WAIT_V(2); PG8_BAR;
        PG8_STAGE(PG8_SB(1, 0), cB + kstep, voffB); PG8_STAGE(PG8_SA(1, 0), cA + kstep, voffA); PG8_STAGE(PG8_SB(1, 1), cB + hstep + kstep, voffB);
        PG8_WAIT_V(6); PG8_BAR;
    } else {
        PG8_STAGE(PG8_SB(0, 0), cB, voffB); PG8_STAGE(PG8_SA(0, 0), cA, voffA); PG8_STAGE(PG8_SB(0, 1), cB + hstep, voffB); PG8_STAGE(PG8_SA(0, 1), cA + hstep, voffA);
        if (wr == 1) PG8_BAR;
        PG8_WAIT_V(4); PG8_BAR;
        PG8_STAGE(PG8_SB(1, 0), cB + kstep, voffB); PG8_STAGE(PG8_SA(1, 0), cA + kstep, voffA); PG8_STAGE(PG8_SB(1, 1), cB + hstep + kstep, voffB);
        PG8_WAIT_V(6); PG8_BAR;
    }
    for (;;) {
        const bool has_next = S.next(ui + 1, nxt);
        const char* nA = has_next ? (const char*)(nxt.sel ? g.A1 : g.A0) + (size_t)nxt.pm * g.a_tstep : cA; const char* nB = has_next ? (const char*)(nxt.sel ? g.B1 : g.B0) + (size_t)nxt.pn * tstep : cB;
        for (int t = 0; t < nt; t += 2) {
            const bool last = (t == nt - 2);
            const char* a1 = cA + (size_t)(t + 1) * kstep;
            const char* a2 = last ? nA : cA + (size_t)(t + 2) * kstep; const char* b2 = last ? nB : cB + (size_t)(t + 2) * kstep;
            const char* a3 = a2 + kstep; const char* b3 = b2 + kstep;
            if (last && has_next) S.a_ready(nxt);
            if constexpr (SP2) {
            PG8_LDB(B0, 0, 0); PG8_LDB(B1, 0, 1); PG8_SCHED; PG8_LDA(At, 0, 0); PG8_STAGE(PG8_SA(1, 1), a1 + hstep, voffA);
            PG8_WAIT_V(8); PG8_WAIT_L(0); PG8_BAR; PG8_MMA(0, 0, At, B0); PG8_MMA(0, 1, At, B1); PG8_BAR; PG8_SCHED;
            PG8_LDA(At, 0, 1); PG8_STAGE(PG8_SB(0, 0), b2, voffB); PG8_STAGE(PG8_SB(0, 1), b2 + hstep, voffB); PG8_STAGE(PG8_SA(0, 0), a2, voffA);
            PG8_WAIT_V(8); PG8_WAIT_L(0); PG8_BAR; PG8_MMA(1, 0, At, B0); PG8_MMA(1, 1, At, B1); PG8_BAR; PG8_SCHED;
            PG8_LDB(B0, 1, 0); PG8_LDB(B1, 1, 1); PG8_SCHED; PG8_LDA(At, 1, 0); PG8_STAGE(PG8_SA(0, 1), a2 + hstep, voffA);
            PG8_WAIT_V(8); PG8_WAIT_L(0); PG8_BAR; PG8_MMA(0, 0, At, B0); PG8_MMA(0, 1, At, B1); PG8_BAR; PG8_SCHED;
            PG8_LDA(At, 1, 1); PG8_STAGE(PG8_SB(1, 0), b3, voffB); PG8_STAGE(PG8_SB(1, 1), b3 + hstep, voffB); PG8_STAGE(PG8_SA(1, 0), a3, voffA);
            PG8_WAIT_V(8); PG8_WAIT_L(0); PG8_BAR; PG8_MMA(1, 0, At, B0); PG8_MMA(1, 1, At, B1); PG8_BAR; PG8_SCHED;
            } else {
            PG8_LDB(B0, 0, 0); PG8_SCHED; PG8_LDA(At, 0, 0); PG8_STAGE(PG8_SA(1, 1), a1 + hstep, voffA);
            PG8_WAIT_L(8); PG8_BAR; PG8_WAIT_L(0); PG8_MMA(0, 0, At, B0); PG8_BAR; PG8_SCHED;
            PG8_LDB(B1, 0, 1); PG8_STAGE(PG8_SB(0, 0), b2, voffB);
            PG8_BAR; PG8_WAIT_L(0); PG8_MMA(0, 1, At, B1); PG8_BAR;
            PG8_LDA(At, 0, 1); PG8_STAGE(PG8_SA(0, 0), a2, voffA);
            PG8_BAR; PG8_WAIT_L(0); PG8_MMA(1, 0, At, B0); PG8_BAR; PG8_SCHED;
            PG8_STAGE(PG8_SB(0, 1), b2 + hstep, voffB);
            PG8_WAIT_V(6); PG8_BAR; PG8_MMA(1, 1, At, B1); PG8_BAR;
            PG8_LDB(B0, 1, 0); PG8_SCHED; PG8_LDA(At, 1, 0); PG8_STAGE(PG8_SA(0, 1), a2 + hstep, voffA);
            PG8_WAIT_L(8); PG8_BAR; PG8_WAIT_L(0); PG8_MMA(0, 0, At, B0); PG8_BAR; PG8_SCHED;
            PG8_LDB(B1, 1, 1); PG8_STAGE(PG8_SB(1, 0), b3, voffB);
            PG8_BAR; PG8_WAIT_L(0); PG8_MMA(0, 1, At, B1); PG8_BAR;
            PG8_LDA(At, 1, 1); PG8_STAGE(PG8_SA(1, 0), a3, voffA);
            PG8_BAR; PG8_WAIT_L(0); PG8_MMA(1, 0, At, B0); PG8_BAR; PG8_SCHED;
            PG8_STAGE(PG8_SB(1, 1), b3 + hstep, voffB);
            PG8_WAIT_V(6); PG8_BAR; PG8_MMA(1, 1, At, B1); PG8_BAR;
            }
        }
        if constexpr (ALIGN_EPI) { if (wr == 0) PG8_BAR; }
        if constexpr (!Epi::AFTER_DRAIN) { E(acc, cur, wr, wc, fr, fq); S.done(cur); }
        if (!has_next) break;
        if (!Epi::keep_acc(cur)) {
#pragma unroll
        for (int a = 0; a < 2; ++a)
#pragma unroll
            for (int b = 0; b < 2; ++b)
#pragma unroll
                for (int m = 0; m < 4; ++m)
#pragma unroll
                    for (int n = 0; n < 2; ++n) acc[a][b][m][n] = (f32x4){0.f, 0.f, 0.f, 0.f}; }
        cur = nxt; cA = nA; cB = nB; ++ui;
        if constexpr (ALIGN_EPI) { if (wr == 1) PG8_BAR; }
    }
    PG8_WAIT_V(0);
    if constexpr (!ALIGN_EPI) { if (wr == 0) PG8_BAR; }
    PG8_BAR;
    if constexpr (Epi::AFTER_DRAIN) { E.fused(acc, cur, wr, wc, fr, fq, lds, wid, lane); S.done(cur); }
#undef PG8_SA
#undef PG8_SB
#undef PG8_STAGE
#undef PG8_LDA
#undef PG8_LDB
#undef PG8_MMA
#undef PG8_WAIT_V
#undef PG8_WAIT_L
#undef PG8_BAR
#undef PG8_SCHED
}
}
#define GAS __attribute__((address_space(1)))
#define LAS __attribute__((address_space(3)))
typedef unsigned short bf16;
typedef unsigned v4u __attribute__((ext_vector_type(4)));
typedef float f32x4 __attribute__((ext_vector_type(4)));
typedef short bf16x8 __attribute__((ext_vector_type(8)));
typedef GAS unsigned gu32;
typedef GAS unsigned long long gu64;
#define RLX_AGENT __ATOMIC_RELAXED, __HIP_MEMORY_SCOPE_AGENT
#define LDS_WAIT() asm volatile("s_waitcnt lgkmcnt(0)" ::: "memory")
#define VM_WAIT() asm volatile("s_waitcnt vmcnt(0)" ::: "memory")
__device__ __forceinline__ unsigned long long rt() { return __builtin_amdgcn_s_memrealtime(); }
__device__ __forceinline__ unsigned f2bf(float f) { unsigned u = __builtin_bit_cast(unsigned, f); return (u + 0x7fffu + ((u >> 16) & 1u)) >> 16; }
__device__ __forceinline__ unsigned pk2(float lo, float hi) { return f2bf(lo) | (f2bf(hi) << 16); }

#define XB_TMO      128
#define XB_XCNT(j)  (256  + 64 * (j))
#define XB_XSUB(j)  (1280 + 64 * (j))
#define XB_XGEN(j)  (2304 + 64 * (j))
#define XB_TOP      3328
#define XB_TOPGEN   3392
#define XCD_BAR_WORDS 3456
#define XB_SPIN_CAP (1u << 18)

__device__ __forceinline__ unsigned xb_ld(unsigned* p)              { return __hip_atomic_load(p, __ATOMIC_RELAXED, __HIP_MEMORY_SCOPE_AGENT); }
__device__ __forceinline__ unsigned xb_add(unsigned* p, unsigned v) { return __hip_atomic_fetch_add(p, v, __ATOMIC_RELAXED, __HIP_MEMORY_SCOPE_AGENT); }
__device__ __forceinline__ unsigned xb_xcc_id() { return (unsigned)__builtin_amdgcn_s_getreg((3 << 11) | 20) & 0xFu; }
#define XB_SPIN(cond, bar) do { unsigned _sp = 0; while (cond) { __builtin_amdgcn_s_sleep(1); \
    if ((++_sp & 255u) == 0u) { if (xb_ld(&(bar)[XB_TMO])) break; if (_sp > XB_SPIN_CAP) { atomicAdd(&(bar)[XB_TMO], 1u); break; } } } } while (0)

struct XcdBarrier {
    unsigned* bar; unsigned x;
    volatile LAS unsigned* st;
};

__device__ __forceinline__ XcdBarrier xcd_barrier_post(unsigned* bar, volatile LAS unsigned* st) {
    XcdBarrier b; b.bar = bar; b.x = xb_xcc_id(); b.st = st;
    if (threadIdx.x == 0) (void)xb_add(&bar[XB_XCNT(b.x)], 1u);
    return b;
}
__device__ __forceinline__ void xcd_barrier_complete(unsigned* bar, unsigned x, unsigned& nloc, unsigned& nx) {
    const unsigned G = gridDim.x * gridDim.y * gridDim.z;
    unsigned sum, cnt, mine, sp = 0u;
    for (;;) {
        sum = 0u; cnt = 0u; mine = 0u;
#pragma unroll
        for (unsigned j = 0; j < 16; ++j) { const unsigned c = xb_ld(&bar[XB_XCNT(j)]); sum += c; cnt += (c > 0u) ? 1u : 0u; mine = (j == x) ? c : mine; }
        if (sum == G) break;
        __builtin_amdgcn_s_sleep(1);
        if ((++sp & 255u) == 0u) { if (xb_ld(&bar[XB_TMO])) break; if (sp > XB_SPIN_CAP) { atomicAdd(&bar[XB_TMO], 1u); break; } }
    }
    nloc = mine > 0u ? mine : 1u; nx = cnt > 0u ? cnt : 1u;
}

__device__ __forceinline__ void xcd_barrier(const XcdBarrier& b) {
    asm volatile("s_waitcnt vmcnt(0)" ::: "memory");
    __syncthreads();
    if (threadIdx.x == 0) {
        unsigned* bar = b.bar;
        __builtin_amdgcn_s_waitcnt(0);
        unsigned nloc = b.st[0], nx = b.st[1];
        if (nloc == 0u) { xcd_barrier_complete(bar, b.x, nloc, nx); b.st[0] = nloc; b.st[1] = nx; }
        const unsigned old = xb_add(&bar[XB_XSUB(b.x)], 1u);
        const unsigned gen = old / nloc;
        if (old + 1u == (gen + 1u) * nloc) {
            __builtin_amdgcn_fence(__ATOMIC_RELEASE, "agent");
            asm volatile("s_waitcnt vmcnt(0)" ::: "memory");
            const unsigned og = xb_add(&bar[XB_TOP], 1u);
            const unsigned tg = og / nx;
            if (og + 1u == (tg + 1u) * nx) xb_add(&bar[XB_TOPGEN], 1u);
            else XB_SPIN(xb_ld(&bar[XB_TOPGEN]) == tg, bar);
            __builtin_amdgcn_fence(__ATOMIC_ACQUIRE, "agent");
            xb_add(&bar[XB_XGEN(b.x)], 1u);
            asm volatile("s_waitcnt vmcnt(0)" ::: "memory");
        } else {
            XB_SPIN(xb_ld(&bar[XB_XGEN(b.x)]) == gen, bar);
            __builtin_amdgcn_fence(__ATOMIC_ACQUIRE, "agent");
            asm volatile("s_waitcnt vmcnt(0)" ::: "memory");
        }
    }
    __syncthreads();
}


constexpr int NWAVES = 8, NTHREADS = 512;
constexpr int M = 16384, D = 1024, NIN = 8192, DFF = 2816, NH = 8, HD = 128, NBLK = 64, BLK = 256;
constexpr float EPS = 1e-6f;
constexpr float C2 = 0.08838834764831845f * 1.4426950408889634f;
constexpr size_t MiB = 1u << 20;
constexpr size_t WS_CTL = 0, CTL_ZERO_BYTES = 256 * 1024;
constexpr int CW_BAR = 4096, CW_GCNT = 8192, CW_ROWSS = 16384;
constexpr size_t WS_KBAR = 1 * MiB, WS_RSTDX = 1 * MiB + 512 * 1024, WS_LPART = 2 * MiB;
constexpr size_t WS_WOA = 4 * MiB, WS_WOB = 6 * MiB, WS_WO = 8 * MiB;
constexpr size_t WS_Q = 10 * MiB, WS_K = 42 * MiB, WS_VT = 74 * MiB, WS_CA = 106 * MiB, WS_LIST = 138 * MiB, WS_WIN = 147 * MiB, WS_XB = 163 * MiB, WS_UU = 195 * MiB;
constexpr size_t WS_OPART = 147 * MiB;
constexpr size_t WS_WUP = 243 * MiB, WS_WDN = 138 * MiB, WS_MG = 165 * MiB, WS_HB = 198 * MiB;
constexpr size_t WS_ACT = 10 * MiB;
constexpr size_t WS_END = 256 * MiB;
constexpr int LDS_BYTES = 163840, MISC_OFF = 131072 + 320, HALO_OFF = 131072 + 1024, SCAN_OFF = 131072 + 1024;
__device__ __forceinline__ int list_off(int n) { return 256 * (63 * n - (n * (n - 1)) / 2); }
constexpr int LIST_PER_HEAD = 256 * 2016;

__device__ __forceinline__ float wave_sum(float v) {
#pragma unroll
    for (int o = 1; o < 64; o <<= 1) v += __shfl_xor(v, o);
    return v;
}
__device__ __forceinline__ void transpose_item(const float* W, int N, bf16* WT, int K, int k0, int col0, int row0, const float* ks, LAS float* scr, int lane) {
#pragma unroll 8
    for (int i = 0; i < 32; ++i) { const int kk = 2 * i + (lane >> 5); const float s = ks ? ks[k0 + kk] : 1.0f; scr[kk * 33 + (lane & 31)] = s * W[(size_t)(k0 + kk) * N + col0 + (lane & 31)]; }
    LDS_WAIT(); asm volatile("" ::: "memory");
    const int c = lane & 7;
#pragma unroll
    for (int j = 0; j < 4; ++j) { const int n = (lane >> 3) + 8 * j; const LAS float* s = scr + (8 * c) * 33 + n;
        v4u o; o.x = pk2(s[0 * 33], s[1 * 33]); o.y = pk2(s[2 * 33], s[3 * 33]); o.z = pk2(s[4 * 33], s[5 * 33]); o.w = pk2(s[6 * 33], s[7 * 33]);
        *(GAS v4u*)(WT + (size_t)(row0 + n) * K + k0 + 8 * c) = o; }
    LDS_WAIT(); asm volatile("" ::: "memory");
}
__device__ __forceinline__ int map_col(int mode, int R) {
    if (mode == 1) { if (R >= 1024 && R < 3072) { const int q = R - 1024; return 1024 + ((q >> 7) & 1) * 1024 + (q >> 8) * 128 + (q & 127); }
                     if (R >= 6144) { const int q = R - 6144; return 6144 + ((q >> 7) & 1) * 1024 + (q >> 8) * 128 + (q & 127); } return R; }
    if (mode == 2) return ((R >> 7) & 1) * DFF + (R >> 8) * 128 + (R & 127);
    return R;
}
__device__ __forceinline__ void convert_weight(const float* W, int K, int N, bf16* WT, const float* ks, int mode, LAS float* scr, int gw, int NGW, int lane) {
    const int nblk = N / 32, nitems = (K / 64) * nblk;
    for (int it = gw; it < nitems; it += NGW) { const int kb = it / nblk, nb = it % nblk; transpose_item(W, N, WT, K, 64 * kb, map_col(mode, 32 * nb), 32 * nb, ks, scr, lane); }
}

__device__ __forceinline__ void phase0(const float* x, const float* norm_mix, const float* w_in, const float* w_oa, const float* w_ob, const float* w_o, const float* w_up, const float* norm_ffn, unsigned char* ws, LAS unsigned char* lds, int vcu, int G, int wave, int lane) {
    LAS float* scr = (LAS float*)(lds + wave * 16384);
    const int gw = vcu * NWAVES + wave, NGW = G * NWAVES;
    convert_weight(w_in, D, NIN, (bf16*)(ws + WS_WIN), norm_mix, 1, scr, gw, NGW, lane);
    convert_weight(w_oa, D, D, (bf16*)(ws + WS_WOA), nullptr, 0, scr, gw, NGW, lane);
    convert_weight(w_ob, D, D, (bf16*)(ws + WS_WOB), nullptr, 0, scr, gw, NGW, lane);
    convert_weight(w_o, D, D, (bf16*)(ws + WS_WO), nullptr, 0, scr, gw, NGW, lane);
    convert_weight(w_up, D, 2 * DFF, (bf16*)(ws + WS_WUP), norm_ffn, 2, scr, gw, NGW, lane);
    bf16* XB = (bf16*)(ws + WS_XB); float* rstdx = (float*)(ws + WS_RSTDX);
    for (int m = gw; m < M; m += NGW) {
        const GAS f32x4* xr = (const GAS f32x4*)(x + (size_t)m * D) + lane; f32x4 v[4]; float s = 0.f;
#pragma unroll
        for (int j = 0; j < 4; ++j) { v[j] = xr[64 * j]; s += (v[j].x * v[j].x + v[j].y * v[j].y) + (v[j].z * v[j].z + v[j].w * v[j].w); }
        s = wave_sum(s); if (lane == 0) rstdx[m] = rsqrtf(s * (1.f / D) + EPS);
        GAS unsigned long long* o8 = (GAS unsigned long long*)(XB + (size_t)m * D) + lane;
#pragma unroll
        for (int j = 0; j < 4; ++j) o8[64 * j] = (unsigned long long)pk2(v[j].x, v[j].y) | ((unsigned long long)pk2(v[j].z, v[j].w) << 32);
    }
}
__device__ __forceinline__ void phase2(const float* conv_a_w, unsigned char* ws, int G, int tid, bf16* __restrict__ CAout) {
    const bf16* __restrict__ BG = (const bf16*)(ws + WS_CA); const bf16* __restrict__ UU = (const bf16*)(ws + WS_UU);
    for (int item = blockIdx.x * NTHREADS + tid; item < 128 * (M / 16); item += G * NTHREADS) {
        const int cc = (item & 127) * 8, t0 = (item >> 7) * 16;
        float w0[8], w1[8], w2[8], um2[8], um1[8];
#pragma unroll
        for (int j = 0; j < 2; ++j) { const f32x4 a = *(const GAS f32x4*)(conv_a_w + cc + 4 * j), b = *(const GAS f32x4*)(conv_a_w + 1024 + cc + 4 * j), c = *(const GAS f32x4*)(conv_a_w + 2048 + cc + 4 * j);
#pragma unroll
            for (int e = 0; e < 4; ++e) { w0[4 * j + e] = a[e]; w1[4 * j + e] = b[e]; w2[4 * j + e] = c[e]; } }
        { v4u a = (v4u){0u, 0u, 0u, 0u}, b = a; if (t0 >= 2) { a = *(const GAS v4u*)(UU + (size_t)(t0 - 2) * 1024 + cc); b = *(const GAS v4u*)(UU + (size_t)(t0 - 1) * 1024 + cc); }
          const unsigned aw[4] = {a.x, a.y, a.z, a.w}, bw[4] = {b.x, b.y, b.z, b.w};
#pragma unroll
          for (int j = 0; j < 4; ++j) { um2[2 * j] = pg8::bf_lo(aw[j]); um2[2 * j + 1] = pg8::bf_hi(aw[j]); um1[2 * j] = pg8::bf_lo(bw[j]); um1[2 * j + 1] = pg8::bf_hi(bw[j]); } }
#pragma unroll 4
        for (int i = 0; i < 16; ++i) { const size_t o = (size_t)(t0 + i) * 1024 + cc;
            const v4u u = *(const GAS v4u*)(UU + o), b = *(const GAS v4u*)(BG + o); const unsigned uw[4] = {u.x, u.y, u.z, u.w}, bw[4] = {b.x, b.y, b.z, b.w};
            float r[8];
#pragma unroll
            for (int j = 0; j < 4; ++j) { const float u0 = pg8::bf_lo(uw[j]), u1 = pg8::bf_hi(uw[j]);
                r[2 * j] = pg8::bf_lo(bw[j]) * (w0[2 * j] * um2[2 * j] + w1[2 * j] * um1[2 * j] + w2[2 * j] * u0);
                r[2 * j + 1] = pg8::bf_hi(bw[j]) * (w0[2 * j + 1] * um2[2 * j + 1] + w1[2 * j + 1] * um1[2 * j + 1] + w2[2 * j + 1] * u1);
                um2[2 * j] = um1[2 * j]; um2[2 * j + 1] = um1[2 * j + 1]; um1[2 * j] = u0; um1[2 * j + 1] = u1; }
            v4u o4; o4.x = pk2(r[0], r[1]); o4.y = pk2(r[2], r[3]); o4.z = pk2(r[4], r[5]); o4.w = pk2(r[6], r[7]);
            *(GAS v4u*)(CAout + o) = o4; }
    }
}
__device__ __forceinline__ bool top_better(float v, int n, float cv, int cn) { return v > cv || (v == cv && n < cn); }
__device__ __forceinline__ void top3_insert(float v, int n, float (&tv)[3], int (&ti)[3]) {
    if (top_better(v, n, tv[0], ti[0])) { tv[2] = tv[1]; ti[2] = ti[1]; tv[1] = tv[0]; ti[1] = ti[0]; tv[0] = v; ti[0] = n; }
    else if (top_better(v, n, tv[1], ti[1])) { tv[2] = tv[1]; ti[2] = ti[1]; tv[1] = v; ti[1] = n; }
    else if (top_better(v, n, tv[2], ti[2])) { tv[2] = v; ti[2] = n; }
}
__device__ __forceinline__ void phase2d(unsigned char* ws, LAS unsigned char* lds, int G, int tid, int wave, int lane, unsigned* gcnt, unsigned short* glist) {
    LAS unsigned* lcnt = (LAS unsigned*)(lds + 32768); LAS unsigned* lbase = lcnt + 64; LAS unsigned short* llist = (LAS unsigned short*)lds;
    const bf16* Q = (const bf16*)(ws + WS_Q); const float* kbar = (const float*)(ws + WS_KBAR);
    const int fr = lane & 15, fq = lane >> 4;
    for (int unit = blockIdx.x; unit < NH * 63; unit += G) {
        const int h = unit / 63, c = 1 + unit % 63;
        if (tid < 64) lcnt[tid] = 0u;
        __syncthreads();
        bf16x8 qf[2][4];
#pragma unroll
        for (int g = 0; g < 2; ++g)
#pragma unroll
            for (int ks = 0; ks < 4; ++ks) qf[g][ks] = *(const GAS bf16x8*)(Q + (size_t)(c * BLK + wave * 32 + g * 16 + fr) * 1024 + h * HD + ks * 32 + fq * 8);
        float tv[2][3]; int ti[2][3];
#pragma unroll
        for (int g = 0; g < 2; ++g)
#pragma unroll
            for (int j = 0; j < 3; ++j) { tv[g][j] = -__builtin_inff(); ti[g][j] = 1 << 20; }
        const int ntile = (c + 15) >> 4;
        for (int tile = 0; tile < ntile; ++tile) {
            f32x4 s0 = (f32x4){0.f, 0.f, 0.f, 0.f}, s1 = s0;
#pragma unroll
            for (int ks = 0; ks < 4; ++ks) {
                const float* kp = kbar + ((size_t)(h * NBLK + tile * 16 + fr) * HD + ks * 32 + fq * 8);
                const f32x4 a = *(const GAS f32x4*)kp, b = *(const GAS f32x4*)(kp + 4);
                const v4u hw = pg8::pack8(a, b);
                f32x4 ra, rb; ra[0] = a[0] - pg8::bf_lo(hw.x); ra[1] = a[1] - pg8::bf_hi(hw.x); ra[2] = a[2] - pg8::bf_lo(hw.y); ra[3] = a[3] - pg8::bf_hi(hw.y);
                rb[0] = b[0] - pg8::bf_lo(hw.z); rb[1] = b[1] - pg8::bf_hi(hw.z); rb[2] = b[2] - pg8::bf_lo(hw.w); rb[3] = b[3] - pg8::bf_hi(hw.w);
                const v4u lw = pg8::pack8(ra, rb);
                const bf16x8 hi = __builtin_bit_cast(bf16x8, hw), lo = __builtin_bit_cast(bf16x8, lw);
                s0 = __builtin_amdgcn_mfma_f32_16x16x32_bf16(hi, qf[0][ks], s0, 0, 0, 0); s0 = __builtin_amdgcn_mfma_f32_16x16x32_bf16(lo, qf[0][ks], s0, 0, 0, 0);
                s1 = __builtin_amdgcn_mfma_f32_16x16x32_bf16(hi, qf[1][ks], s1, 0, 0, 0); s1 = __builtin_amdgcn_mfma_f32_16x16x32_bf16(lo, qf[1][ks], s1, 0, 0, 0);
            }
#pragma unroll
            for (int i = 0; i < 4; ++i) { const int n = tile * 16 + 4 * fq + i;
                top3_insert(n < c ? s0[i] : -__builtin_inff(), n, tv[0], ti[0]); top3_insert(n < c ? s1[i] : -__builtin_inff(), n, tv[1], ti[1]); }
        }
#pragma unroll
        for (int off = 16; off <= 32; off <<= 1)
#pragma unroll
            for (int g = 0; g < 2; ++g) { float pv[3]; int pi[3];
#pragma unroll
                for (int j = 0; j < 3; ++j) { pv[j] = __shfl_xor(tv[g][j], off); pi[j] = __shfl_xor(ti[g][j], off); }
#pragma unroll
                for (int j = 0; j < 3; ++j) top3_insert(pv[j], pi[j], tv[g], ti[g]); }
        const int nsel = c < 3 ? c : 3;
        if (fq == 0) {
#pragma unroll
            for (int g = 0; g < 2; ++g) { const int tl = wave * 32 + g * 16 + fr;
#pragma unroll
                for (int j = 0; j < 3; ++j) if (j < nsel) { const int n = ti[g][j]; const unsigned pp = __hip_atomic_fetch_add(&lcnt[n], 1u, __ATOMIC_RELAXED, __HIP_MEMORY_SCOPE_WORKGROUP); llist[n * 256 + pp] = (unsigned short)((tl << 2) | j); } }
        }
        __syncthreads();
        if (tid < c) { const unsigned k = lcnt[tid]; lbase[tid] = k ? atomicAdd(gcnt + h * NBLK + tid, k) : 0u; }
        __syncthreads();
        for (int n = wave; n < c; n += NWAVES) { const unsigned k = lcnt[n], base = lbase[n];
            unsigned short* dst = glist + (size_t)h * LIST_PER_HEAD + list_off(n) + base;
            for (unsigned i = lane; i < k; i += 64) { const unsigned e = llist[n * 256 + i]; dst[i] = (unsigned short)((((unsigned)c * BLK + (e >> 2)) << 2) | (e & 3u)); } }
        __syncthreads();
    }
}
__device__ __forceinline__ void stage_kv(const bf16* Kg, const bf16* Vt, int h, int n, LAS unsigned char* lds, int tid) {
#pragma unroll
    for (int i = 0; i < 8; ++i) { const int row = (tid >> 4) + 32 * i, ch = tid & 15;
        const v4u w = *(const GAS v4u*)(Kg + (size_t)(n * BLK + row) * 1024 + h * HD + ch * 8);
        const int sw = (((row >> 3) & 3) << 2) | (row & 3);
        *(LAS v4u*)(lds + row * 256 + ((ch ^ sw) << 4)) = w; }
#pragma unroll
    for (int i = 0; i < 8; ++i) { const int row = (tid >> 5) + 16 * i, ch = tid & 31;
        const v4u w = *(const GAS v4u*)(Vt + (size_t)(h * HD + row) * M + n * BLK + ch * 8);
        *(LAS v4u*)(lds + 65536 + row * 512 + ((ch ^ ((((row >> 3) & 3) << 2) | (row & 3))) << 4)) = w; }
}
template <bool CAUSAL, int MODE = 0>
__device__ __forceinline__ void attn_core(const LAS unsigned char* lds, const bf16* Q, int h, const int (&tq)[2], int wave, int fr, int fq, float B2, f32x4 (&O)[8][2], float (&l)[2]) {
    bf16x8 qf[2][4];
#pragma unroll
    for (int g = 0; g < 2; ++g)
#pragma unroll
        for (int ks = 0; ks < 4; ++ks) qf[g][ks] = *(const GAS bf16x8*)(Q + (size_t)tq[g] * 1024 + h * HD + ks * 32 + fq * 8);
#pragma unroll
    for (int dt = 0; dt < 8; ++dt) { O[dt][0] = (f32x4){0.f, 0.f, 0.f, 0.f}; O[dt][1] = O[dt][0]; }
    l[0] = 0.f; l[1] = 0.f;
    const int nch = CAUSAL ? wave + 1 : 8;
    const int krow = (fr >> 2) * 8 + (fr & 3);
    bf16x8 kf[4][2];
#pragma unroll
    for (int ks = 0; ks < 4; ++ks)
#pragma unroll
        for (int t = 0; t < 2; ++t) kf[ks][t] = *(const LAS bf16x8*)(lds + (krow + t * 4) * 256 + (((ks * 4 + fq) ^ fr) << 4));
#pragma unroll 2
    for (int c = 0; c < nch; ++c) {
        f32x4 s[2][2];
#pragma unroll
        for (int t = 0; t < 2; ++t) { s[t][0] = (f32x4){-B2, -B2, -B2, -B2}; s[t][1] = s[t][0]; }
        bf16x8 vf[8];
#pragma unroll
        for (int dt = 0; dt < 8; ++dt) vf[dt] = *(const LAS bf16x8*)(lds + 65536 + ((dt >> 1) * 32 + (fr >> 2) * 8 + (dt & 1) * 4 + (fr & 3)) * 512 + (((c * 4 + fq) ^ fr) << 4));
#pragma unroll
        for (int ks = 0; ks < 4; ++ks)
#pragma unroll
            for (int t = 0; t < 2; ++t) {
                if (MODE != 2 || ks == 0) {
                s[t][0] = __builtin_amdgcn_mfma_f32_16x16x32_bf16(kf[ks][t], qf[0][ks], s[t][0], 0, 0, 0);
                s[t][1] = __builtin_amdgcn_mfma_f32_16x16x32_bf16(kf[ks][t], qf[1][ks], s[t][1], 0, 0, 0); }
            }
        __builtin_amdgcn_sched_barrier(0);
        { const int cn = (c + 1 < nch) ? c + 1 : c;
#pragma unroll
          for (int ks = 0; ks < 4; ++ks)
#pragma unroll
              for (int t = 0; t < 2; ++t) kf[ks][t] = *(const LAS bf16x8*)(lds + (cn * 32 + krow + t * 4) * 256 + (((ks * 4 + fq) ^ fr) << 4)); }
        bf16x8 pf[2];
#pragma unroll
        for (int g = 0; g < 2; ++g) {
            float p[8];
#pragma unroll
            for (int t = 0; t < 2; ++t)
#pragma unroll
                for (int i = 0; i < 4; ++i) { float e = MODE == 1 ? s[t][g][i] : __builtin_amdgcn_exp2f(s[t][g][i]);
                    if (CAUSAL && c == wave) { const int kl = c * 32 + fq * 8 + t * 4 + i, ql = wave * 32 + g * 16 + fr; if (kl > ql) e = 0.f; }
                    p[t * 4 + i] = e; }
            l[g] += ((p[0] + p[1]) + (p[2] + p[3])) + ((p[4] + p[5]) + (p[6] + p[7]));
            v4u w; w.x = pg8::cvt_pk_bf16(p[0], p[1]); w.y = pg8::cvt_pk_bf16(p[2], p[3]); w.z = pg8::cvt_pk_bf16(p[4], p[5]); w.w = pg8::cvt_pk_bf16(p[6], p[7]);
            pf[g] = __builtin_bit_cast(bf16x8, w);
        }
#pragma unroll
        for (int dt = 0; dt < 8; ++dt) {
            if (MODE != 3 || dt == 0) {
            O[dt][0] = __builtin_amdgcn_mfma_f32_16x16x32_bf16(vf[dt], pf[0], O[dt][0], 0, 0, 0);
            O[dt][1] = __builtin_amdgcn_mfma_f32_16x16x32_bf16(vf[dt], pf[1], O[dt][1], 0, 0, 0); }
        }
    }
    l[0] += __shfl_xor(l[0], 16); l[0] += __shfl_xor(l[0], 32); l[1] += __shfl_xor(l[1], 16); l[1] += __shfl_xor(l[1], 32);
}
__device__ __forceinline__ float score_bound(const float* q_norm, const float* k_norm, int lane) {
    float a = fmaxf(fabsf(q_norm[lane]), fabsf(q_norm[lane + 64])), b = fmaxf(fabsf(k_norm[lane]), fabsf(k_norm[lane + 64]));
#pragma unroll
    for (int o = 1; o < 64; o <<= 1) { a = fmaxf(a, __shfl_xor(a, o)); b = fmaxf(b, __shfl_xor(b, o)); }
    return 128.0f * a * b * C2 * 1.001f + 0.01f;
}
template <int MODE>
__device__ __forceinline__ void phase3a(const float* q_norm, const float* k_norm, unsigned char* ws, LAS unsigned char* lds, int G, int tid, int wave, int lane) {
    const int fr = lane & 15, fq = lane >> 4;
    LAS int* pre = (LAS int*)(lds + SCAN_OFF);
    LAS int* cntl = (LAS int*)(lds + SCAN_OFF + 2080);
    const unsigned* gcnt = (const unsigned*)(ws + WS_CTL) + CW_GCNT; const unsigned short* glist = (const unsigned short*)(ws + WS_LIST);
    const bf16* Q = (const bf16*)(ws + WS_Q); const bf16* Kg = (const bf16*)(ws + WS_K); const bf16* Vt = (const bf16*)(ws + WS_VT);
    bf16* OP = (bf16*)(ws + WS_OPART); float* LP = (float*)(ws + WS_LPART);
    const float B2 = score_bound(q_norm, k_norm, lane);
    { const int cnt = (int)__hip_atomic_load(gcnt + tid, __ATOMIC_RELAXED, __HIP_MEMORY_SCOPE_AGENT); pre[tid + 1] = (cnt + 255) >> 8; cntl[tid] = cnt; if (tid == 0) pre[0] = 0; }
    __syncthreads();
    for (int o = 1; o < 512; o <<= 1) { const int v = pre[tid + 1] + ((tid + 1 - o) >= 1 ? pre[tid + 1 - o] : 0); __syncthreads(); pre[tid + 1] = v; __syncthreads(); }
    const int T = pre[512];
    const int vb = (G % 8 == 0) ? ((int)blockIdx.x % 8) * (G / 8) + (int)blockIdx.x / 8 : (int)blockIdx.x;
    const int i_lo = (int)(((long)vb * T) / G), i_hi = (int)(((long)(vb + 1) * T) / G);
    int staged = -1;
#define P3A_DECODE(IT, HN, TILE) do { int lo_ = 0, hi_ = 511; while (lo_ < hi_) { const int mid_ = (lo_ + hi_ + 1) >> 1; if (pre[mid_] <= (IT)) lo_ = mid_; else hi_ = mid_ - 1; } HN = lo_; TILE = (IT) - pre[lo_]; } while (0)
    unsigned en[2] = {0u, 0u}; bool okn[2] = {false, false};
    if (i_lo < i_hi) { int hn, tile; P3A_DECODE(i_lo, hn, tile); const int cnt = cntl[hn]; const unsigned short* lst = glist + (size_t)(hn >> 6) * LIST_PER_HEAD + list_off(hn & 63) + tile * 256;
#pragma unroll
        for (int g = 0; g < 2; ++g) { const int qi = wave * 32 + g * 16 + fr; okn[g] = tile * 256 + qi < cnt; en[g] = okn[g] ? lst[qi] : 0u; } }
    for (int it = i_lo; it < i_hi; ++it) {
        int hn, tile; P3A_DECODE(it, hn, tile); const int h = hn >> 6, n = hn & 63;
        int tq[2], sj[2]; bool ok[2];
#pragma unroll
        for (int g = 0; g < 2; ++g) { ok[g] = okn[g]; tq[g] = (int)(en[g] >> 2); sj[g] = (int)(en[g] & 3u); }
        if (it + 1 < i_hi) { int hn2, tile2; P3A_DECODE(it + 1, hn2, tile2); const int cnt2 = cntl[hn2]; const unsigned short* lst2 = glist + (size_t)(hn2 >> 6) * LIST_PER_HEAD + list_off(hn2 & 63) + tile2 * 256;
#pragma unroll
            for (int g = 0; g < 2; ++g) { const int qi = wave * 32 + g * 16 + fr; okn[g] = tile2 * 256 + qi < cnt2; en[g] = okn[g] ? lst2[qi] : 0u; } }
        if (hn != staged) { __syncthreads(); stage_kv(Kg, Vt, h, n, lds, tid); LDS_WAIT(); __syncthreads(); staged = hn; }
        f32x4 O[8][2]; float l[2];
        attn_core<false, MODE>(lds, Q, h, tq, wave, fr, fq, B2, O, l);
#pragma unroll
        for (int g = 0; g < 2; ++g) if (ok[g]) {
            bf16* op = OP + ((size_t)sj[g] * M + tq[g]) * 1024 + h * HD + 8 * fq;
#pragma unroll
            for (int j = 0; j < 4; ++j) *(GAS v4u*)(op + j * 32) = pg8::pack8(O[2 * j][g], O[2 * j + 1][g]);
            if (fq == 0) LP[((size_t)sj[g] * M + tq[g]) * NH + h] = l[g];
        }
    }
#undef P3A_DECODE
    __syncthreads();
}
__device__ __forceinline__ void phase3b(const float* q_norm, const float* k_norm, unsigned char* ws, LAS unsigned char* lds, int G, int tid, int wave, int lane, bf16* Oout) {
    const int fr = lane & 15, fq = lane >> 4;
    bf16* Q = (bf16*)(ws + WS_Q); const bf16* Kg = (const bf16*)(ws + WS_K); const bf16* Vt = (const bf16*)(ws + WS_VT);
    const bf16* OP = (const bf16*)(ws + WS_OPART); const float* LP = (const float*)(ws + WS_LPART);
    const float B2 = score_bound(q_norm, k_norm, lane);
    for (int unit = blockIdx.x; unit < NH * NBLK; unit += G) {
        const int h = unit >> 6, c = unit & 63;
        __syncthreads(); stage_kv(Kg, Vt, h, c, lds, tid); LDS_WAIT(); __syncthreads();
        int tq[2];
#pragma unroll
        for (int g = 0; g < 2; ++g) tq[g] = c * BLK + wave * 32 + g * 16 + fr;
        f32x4 O[8][2]; float l[2];
        attn_core<true>(lds, Q, h, tq, wave, fr, fq, B2, O, l);
        const int nsel = c < 3 ? c : 3;
#pragma unroll
        for (int g = 0; g < 2; ++g) {
            float lp[3];
#pragma unroll
            for (int j = 0; j < 3; ++j) lp[j] = LP[((size_t)j * M + tq[g]) * NH + h];
            v4u w[3][4];
#pragma unroll
            for (int j = 0; j < 3; ++j)
#pragma unroll
                for (int k = 0; k < 4; ++k) w[j][k] = *(const GAS v4u*)(OP + ((size_t)j * M + tq[g]) * 1024 + h * HD + k * 32 + 8 * fq);
            float lt = l[g];
#pragma unroll
            for (int j = 0; j < 3; ++j) lt += j < nsel ? lp[j] : 0.f;
            const float inv = 1.0f / lt;
#pragma unroll
            for (int k = 0; k < 4; ++k) { f32x4 oa = O[2 * k][g], ob = O[2 * k + 1][g];
#pragma unroll
                for (int j = 0; j < 3; ++j) if (j < nsel) { const v4u x = w[j][k];
                    oa[0] += pg8::bf_lo(x.x); oa[1] += pg8::bf_hi(x.x); oa[2] += pg8::bf_lo(x.y); oa[3] += pg8::bf_hi(x.y); ob[0] += pg8::bf_lo(x.z); ob[1] += pg8::bf_hi(x.z); ob[2] += pg8::bf_lo(x.w); ob[3] += pg8::bf_hi(x.w); }
                *(GAS v4u*)(Oout + (size_t)tq[g] * 1024 + h * HD + k * 32 + 8 * fq) = pg8::pack8(oa * inv, ob * inv); }
        }
    }
    __syncthreads();
}

#ifndef MK_PER_PHASE
#define MK_PER_PHASE 0
#endif
#ifndef MK_DUP
#define MK_DUP -1
#endif
constexpr int N_PHASES = 9;
struct Args { const float* in[14]; float* out; unsigned char* ws; int ph_lo, ph_hi; };
__global__ void __launch_bounds__(NTHREADS, 2) hybrid_fwd(Args args) {
    extern __shared__ __attribute__((aligned(16))) unsigned char lds_raw[];
    LAS unsigned char* lds = (LAS unsigned char*)lds_raw;
    volatile LAS unsigned* MISC = (volatile LAS unsigned*)(lds + MISC_OFF);
    const int tid = threadIdx.x, lane = tid & 63, wave = __builtin_amdgcn_readfirstlane(tid >> 6);
    const int G = gridDim.x; const int vcu = (G % 8 == 0) ? ((int)blockIdx.x % 8) * (G / 8) + (int)blockIdx.x / 8 : (int)blockIdx.x;
    unsigned char* ws = args.ws;
    gu32* ctl = (gu32*)(ws + WS_CTL);
    if (tid < 32) MISC[tid] = 0u;
    __syncthreads();
    const int lo = args.ph_lo, hi = args.ph_hi;
    XcdBarrier bar; bar.bar = (unsigned*)ctl + CW_BAR; bar.x = 0; bar.st = nullptr;
    if (hi - lo > 1) bar = xcd_barrier_post((unsigned*)ctl + CW_BAR, MISC + 8);
#ifndef PHASE_MASK
#define PHASE_MASK 0x1ff
#endif
#define IN(k) (((PHASE_MASK >> (k)) & 1) && lo <= (k) && (k) < hi)
#define SEAM(k) do { if (IN(k) && IN((k) + 1)) xcd_barrier(bar); } while (0)
    const float* x = args.in[0]; const float* norm_mix = args.in[1]; const float* w_in = args.in[2]; const float* conv_a_w = args.in[3]; const float* q_norm = args.in[4]; const float* k_norm = args.in[5];
    const float* w_oa = args.in[6]; const float* w_ob = args.in[7]; const float* w_o = args.in[8]; const float* norm_ffn = args.in[9]; const float* w_up = args.in[10]; const float* ffn_conv_w = args.in[11];
    const float* ffn_conv_b = args.in[12]; const float* w_down = args.in[13];
    float* out = args.out;
    float* rowss = (float*)((unsigned*)ctl + CW_ROWSS);
    const size_t TSTEP = (size_t)256 * 1024 * 2;

    if (IN(0)) { phase0(x, norm_mix, w_in, w_oa, w_ob, w_o, w_up, norm_ffn, ws, lds, vcu, G, wave, lane); __syncthreads(); }
    SEAM(0);
    if (IN(1)) {
        pg8::Gemm g{(const bf16*)(ws + WS_XB), (const bf16*)(ws + WS_XB), (const bf16*)(ws + WS_WIN), (const bf16*)(ws + WS_WIN), D, TSTEP};
        pg8::StaticOrder S; S.init(M / 256, NIN / 256, G, (int)blockIdx.x);
        pg8::Epi1 E{(bf16*)(ws + WS_CA), (bf16*)(ws + WS_UU), (bf16*)(ws + WS_Q), (bf16*)(ws + WS_K), (bf16*)(ws + WS_VT), (bf16*)out, (const float*)(ws + WS_RSTDX), q_norm, k_norm, (float*)(ws + WS_KBAR), (PG8_LAS float*)(lds + HALO_OFF)};
        pg8::gemm_phase<pg8::Epi1, pg8::StaticOrder, true, true>(lds, g, S, E);
    }
    SEAM(1);
    if (IN(2)) { phase2d(ws, lds, G, tid, wave, lane, (unsigned*)(ws + WS_CTL) + CW_GCNT, (unsigned short*)(ws + WS_LIST));
        phase2(conv_a_w, ws, G, tid, (bf16*)(ws + WS_CA)); __syncthreads(); }
#if MK_DUP == 21
    if (IN(2)) { phase2d(ws, lds, G, tid, wave, lane, (unsigned*)(ws + WS_CTL) + CW_GCNT + 512, (unsigned short*)(ws + WS_WIN)); }
#endif
#if MK_DUP == 22
    if (IN(2)) { phase2(conv_a_w, ws, G, tid, (bf16*)(ws + WS_XB)); }
#endif
    SEAM(2);
#if MK_DUP >= 30 && MK_DUP <= 35
    if (IN(3)) phase3a<MK_DUP - 30>(q_norm, k_norm, ws, lds, G, tid, wave, lane);
#endif
    if (IN(3)) phase3a<0>(q_norm, k_norm, ws, lds, G, tid, wave, lane);
    SEAM(3);
    if (IN(4)) { phase3b(q_norm, k_norm, ws, lds, G, tid, wave, lane, (bf16*)(ws + WS_Q));
#if MK_DUP == 4
        phase3b(q_norm, k_norm, ws, lds, G, tid, wave, lane, (bf16*)(ws + WS_OPART));
#endif
        convert_weight(w_down, DFF, D, (bf16*)(ws + WS_WDN), nullptr, 0, (LAS float*)(lds + wave * 16384), vcu * NWAVES + wave, G * NWAVES, lane); __syncthreads(); }
    SEAM(4);
    if (IN(5)) {
        { LAS float* scr = (LAS float*)(lds + wave * 16384); const int gw = vcu * NWAVES + wave, NGW = G * NWAVES;
          if (blockIdx.x == 0 && tid < 256) *(GAS v4u*)(ws + WS_HB - 4096 + tid * 16) = (v4u){0u, 0u, 0u, 0u};
          __syncthreads(); }
        pg8::Gemm g{(const bf16*)(ws + WS_CA), (const bf16*)(ws + WS_Q), (const bf16*)(ws + WS_WOA), (const bf16*)(ws + WS_WOB), D, TSTEP};
        pg8::DualOrder S; S.S.init(M / 256, D / 256, G, (int)blockIdx.x);
        pg8::Epi4 E{(bf16*)(ws + WS_MG), (const bf16*)out};
        pg8::gemm_phase<pg8::Epi4, pg8::DualOrder, true, true>(lds, g, S, E);
    }
    SEAM(5);
    if (IN(6)) {
        pg8::Gemm g{(const bf16*)(ws + WS_MG), (const bf16*)(ws + WS_MG), (const bf16*)(ws + WS_WO), (const bf16*)(ws + WS_WO), D, TSTEP};
        pg8::StaticOrder S; S.init(M / 256, D / 256, G, (int)blockIdx.x);
        pg8::Epi5 E{x, out, (bf16*)(ws + WS_HB), rowss};
        pg8::gemm_phase<pg8::Epi5, pg8::StaticOrder, true, true>(lds, g, S, E);
#if MK_DUP == 6
        { pg8::Epi5 E2{x, (float*)(ws + WS_Q), (bf16*)(ws + WS_VT), (float*)(ws + WS_CA)}; pg8::gemm_phase<pg8::Epi5, pg8::StaticOrder, true, true>(lds, g, S, E2); }
#endif
    }
    SEAM(6);
    if (IN(7)) {
        const bf16* hb2 = (const bf16*)(ws + WS_HB) - 2 * 1024;
        pg8::Gemm g{hb2, hb2, (const bf16*)(ws + WS_WUP), (const bf16*)(ws + WS_WUP), D, (size_t)254 * 1024 * 2};
        pg8::StaticOrder S; S.init(65, 22, G, (int)blockIdx.x);
        pg8::Epi6 E{(bf16*)(ws + WS_ACT), rowss, ffn_conv_w, ffn_conv_b, (PG8_LAS float*)(lds + HALO_OFF)};
        pg8::gemm_phase<pg8::Epi6, pg8::StaticOrder, true, true>(lds, g, S, E);
    }
    SEAM(7);
    if (IN(8)) {
        pg8::Gemm g{(const bf16*)(ws + WS_ACT), (const bf16*)(ws + WS_ACT), (const bf16*)(ws + WS_WDN), (const bf16*)(ws + WS_WDN), DFF, (size_t)256 * DFF * 2};
        pg8::StaticOrder S; S.init(M / 256, D / 256, G, (int)blockIdx.x);
        pg8::Epi7 E{out, (const bf16*)(ws + WS_HB)};
        pg8::gemm_phase<pg8::Epi7, pg8::StaticOrder, true, true>(lds, g, S, E);
#if MK_DUP == 8
        { pg8::Epi7 E2{(float*)(ws + WS_MG), (const bf16*)(ws + WS_HB)}; pg8::gemm_phase<pg8::Epi7, pg8::StaticOrder, true, true>(lds, g, S, E2); }
#endif
    }
#undef IN
#undef SEAM
}

extern "C" void kernel_launch(void* const* d_in, const int* in_sizes, int n_in, void* d_out, int out_size, void* d_ws, size_t ws_size, hipStream_t stream) {
    static int grid = 0;
    if (grid == 0) {
        if (n_in != 14 || in_sizes[0] != M * D || out_size != M * D || ws_size < WS_END) { fprintf(stderr, "kernel_launch: unexpected shapes (n_in %d, in0 %d, out %d, ws %zu)\n", n_in, n_in > 0 ? in_sizes[0] : -1, out_size, ws_size); grid = -1; return; }
        int dev = 0, cus = 0, per_cu = 0;
        if (hipGetDevice(&dev) != hipSuccess || hipDeviceGetAttribute(&cus, hipDeviceAttributeMultiprocessorCount, dev) != hipSuccess) { grid = -1; return; }
        if (hipFuncSetAttribute((const void*)hybrid_fwd, hipFuncAttributeMaxDynamicSharedMemorySize, LDS_BYTES) != hipSuccess) { fprintf(stderr, "kernel_launch: hipFuncSetAttribute failed\n"); grid = -1; return; }
        if (hipOccupancyMaxActiveBlocksPerMultiprocessor(&per_cu, (const void*)hybrid_fwd, NTHREADS, LDS_BYTES) != hipSuccess || per_cu < 1) { fprintf(stderr, "kernel_launch: occupancy query says %d blocks per CU\n", per_cu); (void)hipGetLastError(); grid = -1; return; }
        grid = cus;
    }
    if (grid < 0) return;
    if (hipMemsetAsync((char*)d_ws + WS_CTL, 0, CTL_ZERO_BYTES, stream) != hipSuccess) { fprintf(stderr, "kernel_launch: memset failed\n"); return; }
    Args a{};
    for (int i = 0; i < 14; ++i) a.in[i] = (const float*)d_in[i];
    a.out = (float*)d_out; a.ws = (unsigned char*)d_ws;
#if MK_PER_PHASE
    for (int p = 0; p < N_PHASES; ++p) { a.ph_lo = p; a.ph_hi = p + 1; hipLaunchKernelGGL(hybrid_fwd, dim3(grid), dim3(NTHREADS), LDS_BYTES, stream, a); }
#else
    a.ph_lo = 0; a.ph_hi = N_PHASES;
    void* kargs[] = {&a};
    hipError_t e = hipLaunchCooperativeKernel((const void*)hybrid_fwd, dim3(grid), dim3(NTHREADS), kargs, LDS_BYTES, stream);
    if (e != hipSuccess) fprintf(stderr, "kernel_launch: cooperative launch failed: %s (grid %d)\n", hipGetErrorString(e), grid);
#endif
}
```

```cpp
#include <hip/hip_runtime.h>
#include <cstdio>
#include <cstdint>
namespace pg8 {
#define PG8_LAS __attribute__((address_space(3)))
typedef unsigned short bf16_t;
typedef short bf16x8 __attribute__((ext_vector_type(8)));
typedef float f32x4 __attribute__((ext_vector_type(4)));
typedef unsigned u32x4 __attribute__((ext_vector_type(4)));
constexpr int BM = 256, BK = 64, HALF = 128, HTB = HALF * BK * 2  , STAGE_BYTES = 8 * HTB, NXCD = 8, WGM = 8;

__host__ __device__ __forceinline__ int lds_byte(int r, int c) { const int st = (r >> 4) * 2 + (c >> 5), rr = r & 15, cc = c & 31, ob = rr * 64 + cc * 2; return st * 1024 + (ob ^ (((ob >> 9) & 1) << 5)); }
__host__ __device__ __forceinline__ void stage_rc(int b, int& R, int& C) { const int st = b / 1024, sb = b % 1024, swz = sb ^ (((sb >> 9) & 1) << 5); R = (st >> 1) * 16 + swz / 64; C = (st & 1) * 32 + (swz % 64) / 2; }
__host__ __device__ __forceinline__ int perm32(int rho) { const int n = rho >> 4, i = rho & 15; return 8 * (i >> 2) + 4 * n + (i & 3); }


struct Unit { int pm, pn, sel; };
struct Gemm { const bf16_t* A0; const bf16_t* A1; const bf16_t* B0; const bf16_t* B1; int K; size_t a_tstep; };

struct StaticOrder {
    int nM, nN, nwg, G, c;
    __host__ __device__ void init(int nM_, int nN_, int G_, int c_) { nM = nM_; nN = nN_; nwg = nM * nN; G = G_; c = c_; }
    __host__ __device__ bool next(int i, Unit& u) const {
        const long L = (long)i * G + c; if (L >= nwg) return false;
        int wgid = (int)L; { const int q = nwg / NXCD, r = nwg % NXCD, xcd = wgid % NXCD, off = wgid / NXCD; wgid = (xcd < r ? xcd * (q + 1) : r * (q + 1) + (xcd - r) * q) + off; }
        const int nig = WGM * nN, gid = wgid / nig, fm = gid * WGM, gsz = (nM - fm) < WGM ? (nM - fm) : WGM;
        u.pm = fm + ((wgid % nig) % gsz); u.pn = (wgid % nig) / gsz; u.sel = 0; return true;
    }
    __device__ __forceinline__ void a_ready(const Unit&) const {}
    __device__ __forceinline__ void done(const Unit&) const {}
};
struct DualOrder {
    StaticOrder S;
    __host__ __device__ bool next(int i, Unit& u) const { const bool ok = S.next(i >> 1, u); u.sel = i & 1; return ok; }
    __device__ __forceinline__ void a_ready(const Unit&) const {}
    __device__ __forceinline__ void done(const Unit&) const {}
};

typedef __bf16 bf16x2_t_ __attribute__((ext_vector_type(2))); typedef float f32x2_t_ __attribute__((ext_vector_type(2)));
__device__ __forceinline__ unsigned cvt_pk_bf16(float lo, float hi) { const f32x2_t_ v = {lo, hi}; const bf16x2_t_ b = __builtin_convertvector(v, bf16x2_t_); return __builtin_bit_cast(unsigned, b); }
__device__ __forceinline__ float bf_lo(unsigned w) { return __uint_as_float(w << 16); }
__device__ __forceinline__ float bf_hi(unsigned w) { return __uint_as_float(w & 0xffff0000u); }
__device__ __forceinline__ float fast_sigmoid(float x) { return __builtin_amdgcn_rcpf(1.0f + __builtin_amdgcn_exp2f(-1.4426950408889634f * x)); }
__device__ __forceinline__ u32x4 pack8(const f32x4 a, const f32x4 b) { u32x4 w; w.x = cvt_pk_bf16(a[0], a[1]); w.y = cvt_pk_bf16(a[2], a[3]); w.z = cvt_pk_bf16(b[0], b[1]); w.w = cvt_pk_bf16(b[2], b[3]); return w; }

template <int CTRL> __device__ __forceinline__ float dpp_shr(float old, float v) { return __builtin_bit_cast(float, __builtin_amdgcn_update_dpp(__builtin_bit_cast(int, old), __builtin_bit_cast(int, v), CTRL, 0xf, 0xf, false)); }
template <int CTRL> __device__ __forceinline__ float dpp_ror(float v) { return __builtin_bit_cast(float, __builtin_amdgcn_update_dpp(0, __builtin_bit_cast(int, v), CTRL, 0xf, 0xf, true)); }
constexpr int MROWS = 16384, DMODEL = 1024, DFF_ = 2816;

struct Epi1 {
    static constexpr bool PERM = true, AFTER_DRAIN = false;
    static __device__ __forceinline__ bool keep_acc(const Unit&) { return false; }
    bf16_t *BG, *UU, *Q, *K, *VT, *SG; const float* rstdx; const float *q_norm, *k_norm; float* kbar; PG8_LAS float* xl;
    __device__ __forceinline__ void operator()(f32x4 (&acc)[2][2][4][2], const Unit& u, int wr, int wc, int fr, int fq) const {
        const int row0 = u.pm * BM + wr * 64 + fr, colw = wc * 32 + 8 * fq, pn = u.pn;
        if (pn >= 12 && pn < 20) {
            const bool isK = pn >= 16; const float* wn = isK ? k_norm : q_norm; const float gs = isK ? 1.0f : 0.12751743074602357f;
            bf16_t* dst = isK ? K : Q; const int cb = ((pn - 12) & 3) * 256;
#pragma unroll
            for (int ai = 0; ai < 2; ++ai)
#pragma unroll
                for (int m = 0; m < 4; ++m) { const int rl = ai * HALF + wr * 64 + m * 16 + fr; const float rs = rstdx[u.pm * BM + rl];
#pragma unroll
                    for (int bj = 0; bj < 2; ++bj) { const f32x4 a = acc[ai][bj][m][0] * rs, b = acc[ai][bj][m][1] * rs; acc[ai][bj][m][0] = a; acc[ai][bj][m][1] = b;
                        float ss = (a[0] * a[0] + a[1] * a[1]) + (a[2] * a[2] + a[3] * a[3]) + (b[0] * b[0] + b[1] * b[1]) + (b[2] * b[2] + b[3] * b[3]);
                        ss += __shfl_xor(ss, 16); ss += __shfl_xor(ss, 32);
                        if (fq == 0) xl[(rl * 2 + bj) * 4 + wc] = ss; } }
            asm volatile("s_waitcnt lgkmcnt(0)" ::: "memory"); __builtin_amdgcn_s_barrier(); asm volatile("" ::: "memory");
            const f32x4 g0 = *(const f32x4*)(wn + colw) * gs, g1 = *(const f32x4*)(wn + colw + 4) * gs;
#pragma unroll
            for (int ai = 0; ai < 2; ++ai)
#pragma unroll
                for (int m = 0; m < 4; ++m) { const int rl = ai * HALF + wr * 64 + m * 16 + fr; const int r = u.pm * BM + rl;
#pragma unroll
                    for (int bj = 0; bj < 2; ++bj) { const f32x4 p = *(const PG8_LAS f32x4*)(xl + (rl * 2 + bj) * 4);
                        const float rn = rsqrtf(((p[0] + p[1]) + (p[2] + p[3])) * (1.0f / 128.0f) + 1e-6f);
                        const f32x4 a = acc[ai][bj][m][0] * rn * g0, b = acc[ai][bj][m][1] * rn * g1; acc[ai][bj][m][0] = a; acc[ai][bj][m][1] = b;
                        *(u32x4*)(dst + (size_t)r * 1024 + cb + bj * 128 + colw) = pack8(a, b); } }
            if (isK) {
                f32x4 cs[2][2];
#pragma unroll
                for (int bj = 0; bj < 2; ++bj)
#pragma unroll
                    for (int n = 0; n < 2; ++n) { f32x4 t = acc[0][bj][0][n];
#pragma unroll
                        for (int ai = 0; ai < 2; ++ai)
#pragma unroll
                            for (int m = 0; m < 4; ++m) if (ai + m > 0) t += acc[ai][bj][m][n];
                        cs[bj][n] = t; }
#pragma unroll
                for (int bj = 0; bj < 2; ++bj)
#pragma unroll
                    for (int n = 0; n < 2; ++n)
#pragma unroll
                        for (int e = 0; e < 4; ++e) { float v = cs[bj][n][e]; v += __shfl_xor(v, 1); v += __shfl_xor(v, 2); v += __shfl_xor(v, 4); v += __shfl_xor(v, 8); cs[bj][n][e] = v; }
                if (fr == 0) {
#pragma unroll
                    for (int bj = 0; bj < 2; ++bj) { *(PG8_LAS f32x4*)(xl + 2048 + wr * 256 + bj * 128 + colw) = cs[bj][0]; *(PG8_LAS f32x4*)(xl + 2048 + wr * 256 + bj * 128 + colw + 4) = cs[bj][1]; } }
                asm volatile("s_waitcnt lgkmcnt(0)" ::: "memory"); __builtin_amdgcn_s_barrier(); asm volatile("" ::: "memory");
                int t = threadIdx.x; asm volatile("" : "+v"(t));
                if (t < 256) kbar[((size_t)((pn - 16) * 2 + (t >> 7)) * 64 + u.pm) * 128 + (t & 127)] = (xl[2048 + t] + xl[2048 + 256 + t]) * (1.0f / 256.0f);
            }
            return;
        }
        if (pn >= 20 && pn < 24) {
            int tidv = threadIdx.x; asm volatile("" : "+v"(tidv));
            PG8_LAS unsigned char* T = (PG8_LAS unsigned char*)xl + (tidv >> 6) * 2304;
            const int lane = tidv & 63;
#pragma unroll
            for (int ai = 0; ai < 2; ++ai)
#pragma unroll
                for (int mp = 0; mp < 2; ++mp)
#pragma unroll
                    for (int bj = 0; bj < 2; ++bj) {
#pragma unroll
                        for (int mm = 0; mm < 2; ++mm) { const int m = 2 * mp + mm; const float rs = rstdx[u.pm * BM + ai * HALF + wr * 64 + m * 16 + fr];
                            const u32x4 w = pack8(acc[ai][bj][m][0] * rs, acc[ai][bj][m][1] * rs); const unsigned ww[4] = {w.x, w.y, w.z, w.w};
                            PG8_LAS unsigned char* tp = T + (8 * fq) * 72 + (16 * mm + fr) * 2;
#pragma unroll
                            for (int e = 0; e < 8; ++e) *(PG8_LAS unsigned short*)(tp + e * 72) = (unsigned short)((e & 1) ? (ww[e >> 1] >> 16) : (ww[e >> 1] & 0xffffu)); }
                        asm volatile("s_waitcnt lgkmcnt(0)" ::: "memory");
#pragma unroll
                        for (int rr = 0; rr < 2; ++rr) { const int q = lane + 64 * rr, d = q >> 2, tc = q & 3;
                            const unsigned long long x0 = *(const PG8_LAS unsigned long long*)(T + d * 72 + tc * 16), x1 = *(const PG8_LAS unsigned long long*)(T + d * 72 + tc * 16 + 8);
                            u32x4 o; o.x = (unsigned)x0; o.y = (unsigned)(x0 >> 32); o.z = (unsigned)x1; o.w = (unsigned)(x1 >> 32);
                            *(u32x4*)(VT + ((size_t)(((pn - 20) * 2 + bj) * 128 + 32 * wc + d)) * MROWS + u.pm * BM + ai * HALF + wr * 64 + 32 * mp + tc * 8) = o; }
                        asm volatile("s_waitcnt lgkmcnt(0)" ::: "memory");
                    }
            return;
        }
#pragma unroll
        for (int ai = 0; ai < 2; ++ai)
#pragma unroll
            for (int m = 0; m < 4; ++m) {
                const int r = row0 + ai * HALF + m * 16; const float rs = rstdx[r];
                f32x4 v[2][2];
#pragma unroll
                for (int bj = 0; bj < 2; ++bj)
#pragma unroll
                    for (int n = 0; n < 2; ++n) v[bj][n] = acc[ai][bj][m][n] * rs;
                if (pn < 4) {
#pragma unroll
                    for (int bj = 0; bj < 2; ++bj) *(u32x4*)(BG + (size_t)r * 1024 + pn * 256 + bj * 128 + colw) = pack8(v[bj][0], v[bj][1]);
                } else if (pn < 12) {
                    *(u32x4*)(UU + (size_t)r * 1024 + (pn - 4) * 128 + colw) = pack8(v[0][0] * v[1][0], v[0][1] * v[1][1]);
                } else {
                    f32x4 ra, rb, sa, sb;
#pragma unroll
                    for (int e = 0; e < 4; ++e) { const float ea0 = __builtin_amdgcn_exp2f(-1.4426950408889634f * v[0][0][e]), ea1 = __builtin_amdgcn_exp2f(-1.4426950408889634f * v[0][1][e]);
                        const float eb0 = __builtin_amdgcn_exp2f(-1.4426950408889634f * v[1][0][e]), eb1 = __builtin_amdgcn_exp2f(-1.4426950408889634f * v[1][1][e]);
                        ra[e] = (1.0f + eb0) * __builtin_amdgcn_rcpf(1.0f + ea0); rb[e] = (1.0f + eb1) * __builtin_amdgcn_rcpf(1.0f + ea1);
                        sa[e] = __builtin_amdgcn_rcpf(1.0f + eb0); sb[e] = __builtin_amdgcn_rcpf(1.0f + eb1); }
                    *(u32x4*)(SG + (size_t)r * 2048 + (pn - 24) * 128 + colw) = pack8(ra, rb);
                    *(u32x4*)(SG + (size_t)r * 2048 + 1024 + (pn - 24) * 128 + colw) = pack8(sa, sb);
                }
            }
    }
};
struct Epi4 {
    static constexpr bool PERM = true, AFTER_DRAIN = false;
    bf16_t* MG; const bf16_t* SG;
    static __device__ __forceinline__ bool keep_acc(const Unit& u) { return u.sel == 0; }
    __device__ __forceinline__ void operator()(f32x4 (&acc)[2][2][4][2], const Unit& u, int wr, int wc, int fr, int fq) const {
        const int row0 = u.pm * BM + wr * 64 + fr, col0 = u.pn * BM + wc * 32 + 8 * fq;
#pragma unroll
        for (int ai = 0; ai < 2; ++ai)
#pragma unroll
            for (int m = 0; m < 4; ++m) { const int r = row0 + ai * HALF + m * 16;
#pragma unroll
                for (int bj = 0; bj < 2; ++bj) { const int c = col0 + bj * HALF;
                    const u32x4 g = *(const u32x4*)(SG + (size_t)r * 2048 + u.sel * 1024 + c);
                    f32x4 a = acc[ai][bj][m][0], b = acc[ai][bj][m][1];
                    a[0] *= bf_lo(g.x); a[1] *= bf_hi(g.x); a[2] *= bf_lo(g.y); a[3] *= bf_hi(g.y); b[0] *= bf_lo(g.z); b[1] *= bf_hi(g.z); b[2] *= bf_lo(g.w); b[3] *= bf_hi(g.w);
                    if (u.sel) *(u32x4*)(MG + (size_t)r * 1024 + c) = pack8(a, b);
                    else { acc[ai][bj][m][0] = a; acc[ai][bj][m][1] = b; } } }
    }
};
struct Epi5 {
    static constexpr bool PERM = true, AFTER_DRAIN = false;
    static __device__ __forceinline__ bool keep_acc(const Unit&) { return false; }
    const float* X; float* OUT; bf16_t* HB; float* rowss;
    __device__ __forceinline__ void operator()(f32x4 (&acc)[2][2][4][2], const Unit& u, int wr, int wc, int fr, int fq) const {
        const int row0 = u.pm * BM + wr * 64 + fr, col0 = u.pn * BM + wc * 32 + 8 * fq;
#pragma unroll
        for (int ai = 0; ai < 2; ++ai)
#pragma unroll
            for (int m = 0; m < 4; ++m) { const int r = row0 + ai * HALF + m * 16; float ss = 0.f;
#pragma unroll
                for (int bj = 0; bj < 2; ++bj) { const size_t o = (size_t)r * 1024 + col0 + bj * HALF;
                    const f32x4 a = acc[ai][bj][m][0] + *(const f32x4*)(X + o), b = acc[ai][bj][m][1] + *(const f32x4*)(X + o + 4);
                    *(u32x4*)(HB + o) = pack8(a, b);
                    ss += (a[0] * a[0] + a[1] * a[1]) + (a[2] * a[2] + a[3] * a[3]) + (b[0] * b[0] + b[1] * b[1]) + (b[2] * b[2] + b[3] * b[3]); }
                ss += __shfl_xor(ss, 16); ss += __shfl_xor(ss, 32);
                if (fq == 0) atomicAdd(rowss + r, ss); }
    }
};
struct Epi6 {
    static constexpr bool PERM = true, AFTER_DRAIN = false;
    static __device__ __forceinline__ bool keep_acc(const Unit&) { return false; }
    bf16_t* ACT; const float* rowss; const float* cw; const float* cb; PG8_LAS float* halo;
    __device__ __forceinline__ void operator()(f32x4 (&acc)[2][2][4][2], const Unit& u, int wr, int wc, int fr, int fq) const {
        const int r0 = u.pm * 254 - 2, colw = wc * 32 + 8 * fq;
#pragma unroll
        for (int ai = 0; ai < 2; ++ai)
#pragma unroll
            for (int m = 0; m < 4; ++m) { int gr = r0 + ai * HALF + wr * 64 + m * 16 + fr; gr = gr < 0 ? 0 : (gr > MROWS - 1 ? MROWS - 1 : gr);
                const float rs = rsqrtf(rowss[gr] * (1.0f / 1024.0f) + 1e-6f);
#pragma unroll
                for (int bj = 0; bj < 2; ++bj)
#pragma unroll
                    for (int n = 0; n < 2; ++n) acc[ai][bj][m][n] *= rs; }
        if (fr >= 14) {
#pragma unroll
            for (int ai = 0; ai < 2; ++ai)
#pragma unroll
                for (int bj = 0; bj < 2; ++bj)
#pragma unroll
                    for (int n = 0; n < 2; ++n) *(PG8_LAS f32x4*)(halo + (((2 * ai + wr) * 2 + (fr - 14)) * 256 + bj * 128 + colw + 4 * n)) = acc[ai][bj][3][n];
        }
        f32x4 wn0, wn1, wn2, wnb;
        { const int col = u.pn * 128 + colw; wn0 = *(const f32x4*)(cw + col); wn1 = *(const f32x4*)(cw + 2 * DFF_ + col); wn2 = *(const f32x4*)(cw + 4 * DFF_ + col); wnb = *(const f32x4*)(cb + col); }
        asm volatile("s_waitcnt lgkmcnt(0)" ::: "memory"); __builtin_amdgcn_s_barrier(); asm volatile("" ::: "memory");
#pragma unroll
        for (int bj = 0; bj < 2; ++bj)
#pragma unroll
            for (int n = 0; n < 2; ++n) {
                const f32x4 w0 = wn0, w1 = wn1, w2 = wn2, bb = wnb;
                if (bj * 2 + n < 3) { const int k2 = bj * 2 + n + 1, col = (k2 >> 1) * DFF_ + u.pn * 128 + colw + 4 * (k2 & 1);
                    wn0 = *(const f32x4*)(cw + col); wn1 = *(const f32x4*)(cw + 2 * DFF_ + col); wn2 = *(const f32x4*)(cw + 4 * DFF_ + col); wnb = *(const f32x4*)(cb + col); }
#pragma unroll
                for (int ai = 0; ai < 2; ++ai) {
                    const int s = 2 * ai + wr;
                    const int sm = s > 0 ? s - 1 : 0; const float hz = s > 0 ? 1.0f : 0.0f;
                    const f32x4 h2 = *(const PG8_LAS f32x4*)(halo + ((sm * 2 + 0) * 256 + bj * 128 + colw + 4 * n)) * hz, h1 = *(const PG8_LAS f32x4*)(halo + ((sm * 2 + 1) * 256 + bj * 128 + colw + 4 * n)) * hz;
#pragma unroll
                    for (int mm = 0; mm < 4; ++mm) { const int m = 3 - mm;
                        f32x4 cur = acc[ai][bj][m][n]; asm volatile("" : "+v"(cur)); f32x4 p1, p2;
                        if (m > 0) { f32x4 lo = acc[ai][bj][m > 0 ? m - 1 : 0][n]; asm volatile("" : "+v"(lo));
#pragma unroll
                            for (int e = 0; e < 4; ++e) { p1[e] = dpp_shr<0x111>(dpp_ror<0x121>(lo[e]), cur[e]); p2[e] = dpp_shr<0x112>(dpp_ror<0x122>(lo[e]), cur[e]); } }
                        else {
#pragma unroll
                            for (int e = 0; e < 4; ++e) { p1[e] = dpp_shr<0x111>(h1[e], cur[e]); p2[e] = dpp_shr<0x112>(fr == 0 ? h2[e] : h1[e], cur[e]); } }
                        { f32x4 r_ = w0 * p2 + w1 * p1 + w2 * cur + bb; asm volatile("" : "+v"(r_)); acc[ai][bj][m][n] = r_; } }
                }
            }
#pragma unroll
        for (int ai = 0; ai < 2; ++ai)
#pragma unroll
            for (int m = 0; m < 4; ++m) { const int i = ai * HALF + wr * 64 + m * 16 + fr, gr = r0 + i;
                f32x4 a, b;
#pragma unroll
                for (int e = 0; e < 4; ++e) { const float g0 = acc[ai][0][m][0][e], g1 = acc[ai][0][m][1][e];
                    a[e] = g0 * fast_sigmoid(g0) * acc[ai][1][m][0][e]; b[e] = g1 * fast_sigmoid(g1) * acc[ai][1][m][1][e]; }
                if (i >= 2 && gr < MROWS) *(u32x4*)(ACT + (size_t)gr * DFF_ + u.pn * 128 + colw) = pack8(a, b); }
    }
};
struct Epi7 {
    static constexpr bool PERM = true, AFTER_DRAIN = false;
    static __device__ __forceinline__ bool keep_acc(const Unit&) { return false; }
    float* OUT; const bf16_t* HB;
    __device__ __forceinline__ void operator()(f32x4 (&acc)[2][2][4][2], const Unit& u, int wr, int wc, int fr, int fq) const {
        const int row0 = u.pm * BM + wr * 64 + fr, col0 = u.pn * BM + wc * 32 + 8 * fq;
#pragma unroll
        for (int ai = 0; ai < 2; ++ai)
#pragma unroll
            for (int m = 0; m < 4; ++m) { const int r = row0 + ai * HALF + m * 16;
#pragma unroll
                for (int bj = 0; bj < 2; ++bj) { const size_t o = (size_t)r * 1024 + col0 + bj * HALF; float* p = OUT + o; const u32x4 hw = *(const u32x4*)(HB + o);
                    f32x4 a = acc[ai][bj][m][0], b = acc[ai][bj][m][1];
                    a[0] += bf_lo(hw.x); a[1] += bf_hi(hw.x); a[2] += bf_lo(hw.y); a[3] += bf_hi(hw.y); b[0] += bf_lo(hw.z); b[1] += bf_hi(hw.z); b[2] += bf_lo(hw.w); b[3] += bf_hi(hw.w);
                    *(f32x4*)p = a; *(f32x4*)(p + 4) = b; } }
    }
};
template <class Epi, class Sched, bool ALIGN_EPI = false, bool SP2 = false>
__device__ __forceinline__ void gemm_phase(PG8_LAS unsigned char* lds, const Gemm g, const Sched& S, const Epi& E) {
    const int tid = threadIdx.x, wid = __builtin_amdgcn_readfirstlane(tid >> 6), lane = tid & 63, wr = wid >> 2, wc = wid & 3, fr = lane & 15, fq = lane >> 4;
    const int K = g.K, nt = K / BK;
    unsigned voffA[2], voffB[2];
#pragma unroll
    for (int i = 0; i < 2; ++i) { int R, C; stage_rc(tid * 16 + i * 8192, R, C); const int Rb = Epi::PERM ? ((R & ~31) + perm32(R & 31)) : R;
        voffA[i] = (unsigned)(R * K + C) * 2u; voffB[i] = (unsigned)(Rb * K + C) * 2u; }
    const size_t kstep = (size_t)(BK * 2);
    const size_t hstep = (size_t)HALF * K * 2;
    const size_t tstep = 2 * hstep;
    const unsigned ldsw = (unsigned)wid * 1024u;
    const int aoff = lds_byte(wr * 64 + fr, fq * 8), boff = lds_byte(wc * 32 + fr, fq * 8);
#define PG8_SA(b, h) (((b) * 2 + (h)) * HTB)
#define PG8_SB(b, h) ((4 + (b) * 2 + (h)) * HTB)
#define PG8_STAGE(bufoff, gbase, voff) do { _Pragma("unroll") for (int _i = 0; _i < 2; ++_i) \
        __builtin_amdgcn_global_load_lds((const unsigned*)((const char*)(gbase) + (voff)[_i]), (PG8_LAS unsigned*)(lds + (bufoff) + ldsw + _i * 8192), 16, 0, 0); } while (0)
#define PG8_LDA(dst, b, h) do { _Pragma("unroll") for (int m = 0; m < 4; ++m) _Pragma("unroll") for (int k = 0; k < 2; ++k) dst[m][k] = *(const PG8_LAS bf16x8*)(lds + PG8_SA(b, h) + aoff + m * 2048 + k * 1024); } while (0)
#define PG8_LDB(dst, b, h) do { _Pragma("unroll") for (int n = 0; n < 2; ++n) _Pragma("unroll") for (int k = 0; k < 2; ++k) dst[n][k] = *(const PG8_LAS bf16x8*)(lds + PG8_SB(b, h) + boff + n * 2048 + k * 1024); } while (0)
#define PG8_MMA(ai, bj, At, Bt) do { __builtin_amdgcn_s_setprio(1); _Pragma("unroll") for (int m = 0; m < 4; ++m) _Pragma("unroll") for (int n = 0; n < 2; ++n) _Pragma("unroll") for (int k = 0; k < 2; ++k) \
        acc[ai][bj][m][n] = __builtin_amdgcn_mfma_f32_16x16x32_bf16(Bt[n][k], At[m][k], acc[ai][bj][m][n], 0, 0, 0); __builtin_amdgcn_s_setprio(0); } while (0)
#define PG8_WAIT_V(n) asm volatile("s_waitcnt vmcnt(" #n ")" ::: "memory")
#define PG8_WAIT_L(n) asm volatile("s_waitcnt lgkmcnt(" #n ")" ::: "memory")
#define PG8_BAR __builtin_amdgcn_s_barrier()
#define PG8_SCHED __builtin_amdgcn_sched_barrier(0)
    Unit cur, nxt; int ui = 0;
    if (!S.next(0, cur)) return;
    f32x4 acc[2][2][4][2];
#pragma unroll
    for (int a = 0; a < 2; ++a)
#pragma unroll
        for (int b = 0; b < 2; ++b)
#pragma unroll
            for (int m = 0; m < 4; ++m)
#pragma unroll
                for (int n = 0; n < 2; ++n) acc[a][b][m][n] = (f32x4){0.f, 0.f, 0.f, 0.f};
    bf16x8 At[4][2], B0[2][2], B1[2][2];
    const char* cA = (const char*)(cur.sel ? g.A1 : g.A0) + (size_t)cur.pm * g.a_tstep; const char* cB = (const char*)(cur.sel ? g.B1 : g.B0) + (size_t)cur.pn * tstep;
    S.a_ready(cur);
    if constexpr (SP2) {
        PG8_STAGE(PG8_SB(0, 0), cB, voffB); PG8_STAGE(PG8_SB(0, 1), cB + hstep, voffB); PG8_STAGE(PG8_SA(0, 0), cA, voffA); PG8_STAGE(PG8_SA(0, 1), cA + hstep, voffA);
        if (wr == 1) PG8_BAR;
        PG8_WAIT_V(2); PG8_BAR;
        PG8_STAGE(PG8_SB(1, 0), cB + kstep, voffB); PG8_STAGE(PG8_SA(1, 0), cA + kstep, voffA); PG8_STAGE(PG8_SB(1, 1), cB + hstep + kstep, voffB);
        PG8_WAIT_V(6); PG8_BAR;
    } else {
        PG8_STAGE(PG8_SB(0, 0), cB, voffB); PG8_STAGE(PG8_SA(0, 0), cA, voffA); PG8_STAGE(PG8_SB(0, 1), cB + hstep, voffB); PG8_STAGE(PG8_SA(0, 1), cA + hstep, voffA);
        if (wr == 1) PG8_BAR;
        PG8_WAIT_V(4); PG8_BAR;
        PG8_STAGE(PG8_SB(1, 0), cB + kstep, voffB); PG8_STAGE(PG8_SA(1, 0), cA + kstep, voffA); PG8_STAGE(PG8_SB(1, 1), cB + hstep + kstep, voffB);
        PG8_WAIT_V(6); PG8_BAR;
    }
    for (;;) {
        const bool has_next = S.next(ui + 1, nxt);
        const char* nA = has_next ? (const char*)(nxt.sel ? g.A1 : g.A0) + (size_t)nxt.pm * g.a_tstep : cA; const char* nB = has_next ? (const char*)(nxt.sel ? g.B1 : g.B0) + (size_t)nxt.pn * tstep : cB;
        for (int t = 0; t < nt; t += 2) {
            const bool last = (t == nt - 2);
            const char* a1 = cA + (size_t)(t + 1) * kstep;
            const char* a2 = last ? nA : cA + (size_t)(t + 2) * kstep; const char* b2 = last ? nB : cB + (size_t)(t + 2) * kstep;
            const char* a3 = a2 + kstep; const char* b3 = b2 + kstep;
            if (last && has_next) S.a_ready(nxt);
            if constexpr (SP2) {
            PG8_LDB(B0, 0, 0); PG8_LDB(B1, 0, 1); PG8_SCHED; PG8_LDA(At, 0, 0); PG8_STAGE(PG8_SA(1, 1), a1 + hstep, voffA);
            PG8_WAIT_V(8); PG8_WAIT_L(0); PG8_BAR; PG8_MMA(0, 0, At, B0); PG8_MMA(0, 1, At, B1); PG8_BAR; PG8_SCHED;
            PG8_LDA(At, 0, 1); PG8_STAGE(PG8_SB(0, 0), b2, voffB); PG8_STAGE(PG8_SB(0, 1), b2 + hstep, voffB); PG8_STAGE(PG8_SA(0, 0), a2, voffA);
            PG8_WAIT_V(8); PG8_WAIT_L(0); PG8_BAR; PG8_MMA(1, 0, At, B0); PG8_MMA(1, 1, At, B1); PG8_BAR; PG8_SCHED;
            PG8_LDB(B0, 1, 0); PG8_LDB(B1, 1, 1); PG8_SCHED; PG8_LDA(At, 1, 0); PG8_STAGE(PG8_SA(0, 1), a2 + hstep, voffA);
            PG8_WAIT_V(8); PG8_WAIT_L(0); PG8_BAR; PG8_MMA(0, 0, At, B0); PG8_MMA(0, 1, At, B1); PG8_BAR; PG8_SCHED;
            PG8_LDA(At, 1, 1); PG8_STAGE(PG8_SB(1, 0), b3, voffB); PG8_STAGE(PG8_SB(1, 1), b3 + hstep, voffB); PG8_STAGE(PG8_SA(1, 0), a3, voffA);
            PG8_WAIT_V(8); PG8_WAIT_L(0); PG8_BAR; PG8_MMA(1, 0, At, B0); PG8_MMA(1, 1, At, B1); PG8_BAR; PG8_SCHED;
            } else {
            PG8_LDB(B0, 0, 0); PG8_SCHED; PG8_LDA(At, 0, 0); PG8_STAGE(PG8_SA(1, 1), a1 + hstep, voffA);
            PG8_WAIT_L(8); PG8_BAR; PG8_WAIT_L(0); PG8_MMA(0, 0, At, B0); PG8_BAR; PG8_SCHED;
            PG8_LDB(B1, 0, 1); PG8_STAGE(PG8_SB(0, 0), b2, voffB);
            PG8_BAR; PG8_WAIT_L(0); PG8_MMA(0, 1, At, B1); PG8_BAR;
            PG8_LDA(At, 0, 1); PG8_STAGE(PG8_SA(0, 0), a2, voffA);
            PG8_BAR; PG8_WAIT_L(0); PG8_MMA(1, 0, At, B0); PG8_BAR; PG8_SCHED;
            PG8_STAGE(PG8_SB(0, 1), b2 + hstep, voffB);
            PG8_WAIT_V(6); PG8_BAR; PG8_MMA(1, 1, At, B1); PG8_BAR;
            PG8_LDB(B0, 1, 0); PG8_SCHED; PG8_LDA(At, 1, 0); PG8_STAGE(PG8_SA(0, 1), a2 + hstep, voffA);
            PG8_WAIT_L(8); PG8_BAR; PG8_WAIT_L(0); PG8_MMA(0, 0, At, B0); PG8_BAR; PG8_SCHED;
            PG8_LDB(B1, 1, 1); PG8_STAGE(PG8_SB(1, 0), b3, voffB);
            PG8_BAR; PG8_WAIT_L(0); PG8_MMA(0, 1, At, B1); PG8_BAR;
            PG8_LDA(At, 1, 1); PG8_STAGE(PG8_SA(1, 0), a3, voffA);
            PG8_BAR; PG8_WAIT_L(0); PG8_MMA(1, 0, At, B0); PG8_BAR; PG8_SCHED;
            PG8_STAGE(PG8_SB(1, 1), b3 + hstep, voffB);
            PG8_WAIT_V(6); PG8_BAR; PG8_MMA(1, 1, At, B1); PG8_BAR;
            }
        }
        if constexpr (ALIGN_EPI) { if (wr == 0) PG8_BAR; }
        if constexpr (!Epi::AFTER_DRAIN) { E(acc, cur, wr, wc, fr, fq); S.done(cur); }
        if (!has_next) break;
        if (!Epi::keep_acc(cur)) {
#pragma unroll
        for (int a = 0; a < 2; ++a)
#pragma unroll
            for (int b = 0; b < 2; ++b)
#pragma unroll
                for (int m = 0; m < 4; ++m)
#pragma unroll
                    for (int n = 0; n < 2; ++n) acc[a][b][m][n] = (f32x4){0.f, 0.f, 0.f, 0.f}; }
        cur = nxt; cA = nA; cB = nB; ++ui;
        if constexpr (ALIGN_EPI) { if (wr == 1) PG8_BAR; }
    }
    PG8_WAIT_V(0);
    if constexpr (!ALIGN_EPI) { if (wr == 0) PG8_BAR; }
    PG8_BAR;
    if constexpr (Epi::AFTER_DRAIN) { E.fused(acc, cur, wr, wc, fr, fq, lds, wid, lane); S.done(cur); }
#undef PG8_SA
#undef PG8_SB
#undef PG8_STAGE
#undef PG8_LDA
#undef PG8_LDB
#undef PG8_MMA
#undef PG8_WAIT_V
#undef PG8_WAIT_L
#undef PG8_BAR
#undef PG8_SCHED
}
}
#define GAS __attribute__((address_space(1)))
#define LAS __attribute__((address_space(3)))
typedef unsigned short bf16;
typedef unsigned v4u __attribute__((ext_vector_type(4)));
typedef float f32x4 __attribute__((ext_vector_type(4)));
typedef short bf16x8 __attribute__((ext_vector_type(8)));
typedef GAS unsigned gu32;
typedef GAS unsigned long long gu64;
#define RLX_AGENT __ATOMIC_RELAXED, __HIP_MEMORY_SCOPE_AGENT
#define LDS_WAIT() asm volatile("s_waitcnt lgkmcnt(0)" ::: "memory")
#define VM_WAIT() asm volatile("s_waitcnt vmcnt(0)" ::: "memory")
__device__ __forceinline__ unsigned long long rt() { return __builtin_amdgcn_s_memrealtime(); }
__device__ __forceinline__ unsigned f2bf(float f) { unsigned u = __builtin_bit_cast(unsigned, f); return (u + 0x7fffu + ((u >> 16) & 1u)) >> 16; }
__device__ __forceinline__ unsigned pk2(float lo, float hi) { return f2bf(lo) | (f2bf(hi) << 16); }

#define XB_TMO      128
#define XB_XCNT(j)  (256  + 64 * (j))
#define XB_XSUB(j)  (1280 + 64 * (j))
#define XB_XGEN(j)  (2304 + 64 * (j))
#define XB_TOP      3328
#define XB_TOPGEN   3392
#define XCD_BAR_WORDS 3456
#define XB_SPIN_CAP (1u << 18)

__device__ __forceinline__ unsigned xb_ld(unsigned* p)              { return __hip_atomic_load(p, __ATOMIC_RELAXED, __HIP_MEMORY_SCOPE_AGENT); }
__device__ __forceinline__ unsigned xb_add(unsigned* p, unsigned v) { return __hip_atomic_fetch_add(p, v, __ATOMIC_RELAXED, __HIP_MEMORY_SCOPE_AGENT); }
__device__ __forceinline__ unsigned xb_xcc_id() { return (unsigned)__builtin_amdgcn_s_getreg((3 << 11) | 20) & 0xFu; }
#define XB_SPIN(cond, bar) do { unsigned _sp = 0; while (cond) { __builtin_amdgcn_s_sleep(1); \
    if ((++_sp & 255u) == 0u) { if (xb_ld(&(bar)[XB_TMO])) break; if (_sp > XB_SPIN_CAP) { atomicAdd(&(bar)[XB_TMO], 1u); break; } } } } while (0)

struct XcdBarrier {
    unsigned* bar; unsigned x;
    volatile LAS unsigned* st;
};

__device__ __forceinline__ XcdBarrier xcd_barrier_post(unsigned* bar, volatile LAS unsigned* st) {
    XcdBarrier b; b.bar = bar; b.x = xb_xcc_id(); b.st = st;
    if (threadIdx.x == 0) (void)xb_add(&bar[XB_XCNT(b.x)], 1u);
    return b;
}
__device__ __forceinline__ void xcd_barrier_complete(unsigned* bar, unsigned x, unsigned& nloc, unsigned& nx) {
    const unsigned G = gridDim.x * gridDim.y * gridDim.z;
    unsigned sum, cnt, mine, sp = 0u;
    for (;;) {
        sum = 0u; cnt = 0u; mine = 0u;
#pragma unroll
        for (unsigned j = 0; j < 16; ++j) { const unsigned c = xb_ld(&bar[XB_XCNT(j)]); sum += c; cnt += (c > 0u) ? 1u : 0u; mine = (j == x) ? c : mine; }
        if (sum == G) break;
        __builtin_amdgcn_s_sleep(1);
        if ((++sp & 255u) == 0u) { if (xb_ld(&bar[XB_TMO])) break; if (sp > XB_SPIN_CAP) { atomicAdd(&bar[XB_TMO], 1u); break; } }
    }
    nloc = mine > 0u ? mine : 1u; nx = cnt > 0u ? cnt : 1u;
}

__device__ __forceinline__ void xcd_barrier(const XcdBarrier& b) {
    asm volatile("s_waitcnt vmcnt(0)" ::: "memory");
    __syncthreads();
    if (threadIdx.x == 0) {
        unsigned* bar = b.bar;
        __builtin_amdgcn_s_waitcnt(0);
        unsigned nloc = b.st[0], nx = b.st[1];
        if (nloc == 0u) { xcd_barrier_complete(bar, b.x, nloc, nx); b.st[0] = nloc; b.st[1] = nx; }
        const unsigned old = xb_add(&bar[XB_XSUB(b.x)], 1u);
        const unsigned gen = old / nloc;
        if (old + 1u == (gen + 1u) * nloc) {
            __builtin_amdgcn_fence(__ATOMIC_RELEASE, "agent");
            asm volatile("s_waitcnt vmcnt(0)" ::: "memory");
            const unsigned og = xb_add(&bar[XB_TOP], 1u);
            const unsigned tg = og / nx;
            if (og + 1u == (tg + 1u) * nx) xb_add(&bar[XB_TOPGEN], 1u);
            else XB_SPIN(xb_ld(&bar[XB_TOPGEN]) == tg, bar);
            __builtin_amdgcn_fence(__ATOMIC_ACQUIRE, "agent");
            xb_add(&bar[XB_XGEN(b.x)], 1u);
            asm volatile("s_waitcnt vmcnt(0)" ::: "memory");
        } else {
            XB_SPIN(xb_ld(&bar[XB_XGEN(b.x)]) == gen, bar);
            __builtin_amdgcn_fence(__ATOMIC_ACQUIRE, "agent");
            asm volatile("s_waitcnt vmcnt(0)" ::: "memory");
        }
    }
    __syncthreads();
}


constexpr int NWAVES = 8, NTHREADS = 512;
constexpr int M = 16384, D = 1024, NIN = 8192, DFF = 2816, NH = 8, HD = 128, NBLK = 64, BLK = 256;
constexpr float EPS = 1e-6f;
constexpr float C2 = 0.08838834764831845f * 1.4426950408889634f;
constexpr size_t MiB = 1u << 20;
constexpr size_t WS_CTL = 0, CTL_ZERO_BYTES = 256 * 1024;
constexpr int CW_BAR = 4096, CW_GCNT = 8192, CW_ROWSS = 16384;
constexpr size_t WS_KBAR = 1 * MiB, WS_RSTDX = 1 * MiB + 512 * 1024, WS_LPART = 2 * MiB;
constexpr size_t WS_WOA = 4 * MiB, WS_WOB = 6 * MiB, WS_WO = 8 * MiB;
constexpr size_t WS_Q = 10 * MiB, WS_K = 42 * MiB, WS_VT = 74 * MiB, WS_CA = 106 * MiB, WS_LIST = 138 * MiB, WS_WIN = 147 * MiB, WS_XB = 163 * MiB, WS_UU = 195 * MiB;
constexpr size_t WS_OPART = 147 * MiB;
constexpr size_t WS_WUP = 243 * MiB, WS_WDN = 138 * MiB, WS_MG = 165 * MiB, WS_HB = 198 * MiB;
constexpr size_t WS_ACT = 10 * MiB;
constexpr size_t WS_END = 256 * MiB;
constexpr int LDS_BYTES = 163840, MISC_OFF = 131072 + 320, HALO_OFF = 131072 + 1024, SCAN_OFF = 131072 + 1024;
__device__ __forceinline__ int list_off(int n) { return 256 * (63 * n - (n * (n - 1)) / 2); }
constexpr int LIST_PER_HEAD = 256 * 2016;

__device__ __forceinline__ float wave_sum(float v) {
#pragma unroll
    for (int o = 1; o < 64; o <<= 1) v += __shfl_xor(v, o);
    return v;
}
__device__ __forceinline__ void transpose_item(const float* W, int N, bf16* WT, int K, int k0, int col0, int row0, const float* ks, LAS float* scr, int lane) {
#pragma unroll 8
    for (int i = 0; i < 32; ++i) { const int kk = 2 * i + (lane >> 5); const float s = ks ? ks[k0 + kk] : 1.0f; scr[kk * 33 + (lane & 31)] = s * W[(size_t)(k0 + kk) * N + col0 + (lane & 31)]; }
    LDS_WAIT(); asm volatile("" ::: "memory");
    const int c = lane & 7;
#pragma unroll
    for (int j = 0; j < 4; ++j) { const int n = (lane >> 3) + 8 * j; const LAS float* s = scr + (8 * c) * 33 + n;
        v4u o; o.x = pk2(s[0 * 33], s[1 * 33]); o.y = pk2(s[2 * 33], s[3 * 33]); o.z = pk2(s[4 * 33], s[5 * 33]); o.w = pk2(s[6 * 33], s[7 * 33]);
        *(GAS v4u*)(WT + (size_t)(row0 + n) * K + k0 + 8 * c) = o; }
    LDS_WAIT(); asm volatile("" ::: "memory");
}
__device__ __forceinline__ int map_col(int mode, int R) {
    if (mode == 1) { if (R >= 1024 && R < 3072) { const int q = R - 1024; return 1024 + ((q >> 7) & 1) * 1024 + (q >> 8) * 128 + (q & 127); }
                     if (R >= 6144) { const int q = R - 6144; return 6144 + ((q >> 7) & 1) * 1024 + (q >> 8) * 128 + (q & 127); } return R; }
    if (mode == 2) return ((R >> 7) & 1) * DFF + (R >> 8) * 128 + (R & 127);
    return R;
}
__device__ __forceinline__ void convert_weight(const float* W, int K, int N, bf16* WT, const float* ks, int mode, LAS float* scr, int gw, int NGW, int lane) {
    const int nblk = N / 32, nitems = (K / 64) * nblk;
    for (int it = gw; it < nitems; it += NGW) { const int kb = it / nblk, nb = it % nblk; transpose_item(W, N, WT, K, 64 * kb, map_col(mode, 32 * nb), 32 * nb, ks, scr, lane); }
}

__device__ __forceinline__ void phase0(const float* x, const float* norm_mix, const float* w_in, const float* w_oa, const float* w_ob, const float* w_o, const float* w_up, const float* norm_ffn, unsigned char* ws, LAS unsigned char* lds, int vcu, int G, int wave, int lane) {
    LAS float* scr = (LAS float*)(lds + wave * 16384);
    const int gw = vcu * NWAVES + wave, NGW = G * NWAVES;
    convert_weight(w_in, D, NIN, (bf16*)(ws + WS_WIN), norm_mix, 1, scr, gw, NGW, lane);
    convert_weight(w_oa, D, D, (bf16*)(ws + WS_WOA), nullptr, 0, scr, gw, NGW, lane);
    convert_weight(w_ob, D, D, (bf16*)(ws + WS_WOB), nullptr, 0, scr, gw, NGW, lane);
    convert_weight(w_o, D, D, (bf16*)(ws + WS_WO), nullptr, 0, scr, gw, NGW, lane);
    convert_weight(w_up, D, 2 * DFF, (bf16*)(ws + WS_WUP), norm_ffn, 2, scr, gw, NGW, lane);
    bf16* XB = (bf16*)(ws + WS_XB); float* rstdx = (float*)(ws + WS_RSTDX);
    for (int m = gw; m < M; m += NGW) {
        const GAS f32x4* xr = (const GAS f32x4*)(x + (size_t)m * D) + lane; f32x4 v[4]; float s = 0.f;
#pragma unroll
        for (int j = 0; j < 4; ++j) { v[j] = xr[64 * j]; s += (v[j].x * v[j].x + v[j].y * v[j].y) + (v[j].z * v[j].z + v[j].w * v[j].w); }
        s = wave_sum(s); if (lane == 0) rstdx[m] = rsqrtf(s * (1.f / D) + EPS);
        GAS unsigned long long* o8 = (GAS unsigned long long*)(XB + (size_t)m * D) + lane;
#pragma unroll
        for (int j = 0; j < 4; ++j) o8[64 * j] = (unsigned long long)pk2(v[j].x, v[j].y) | ((unsigned long long)pk2(v[j].z, v[j].w) << 32);
    }
}
__device__ __forceinline__ void phase2(const float* conv_a_w, unsigned char* ws, int G, int tid, bf16* __restrict__ CAout) {
    const bf16* __restrict__ BG = (const bf16*)(ws + WS_CA); const bf16* __restrict__ UU = (const bf16*)(ws + WS_UU);
    for (int item = blockIdx.x * NTHREADS + tid; item < 128 * (M / 16); item += G * NTHREADS) {
        const int cc = (item & 127) * 8, t0 = (item >> 7) * 16;
        float w0[8], w1[8], w2[8], um2[8], um1[8];
#pragma unroll
        for (int j = 0; j < 2; ++j) { const f32x4 a = *(const GAS f32x4*)(conv_a_w + cc + 4 * j), b = *(const GAS f32x4*)(conv_a_w + 1024 + cc + 4 * j), c = *(const GAS f32x4*)(conv_a_w + 2048 + cc + 4 * j);
#pragma unroll
            for (int e = 0; e < 4; ++e) { w0[4 * j + e] = a[e]; w1[4 * j + e] = b[e]; w2[4 * j + e] = c[e]; } }
        { v4u a = (v4u){0u, 0u, 0u, 0u}, b = a; if (t0 >= 2) { a = *(const GAS v4u*)(UU + (size_t)(t0 - 2) * 1024 + cc); b = *(const GAS v4u*)(UU + (size_t)(t0 - 1) * 1024 + cc); }
          const unsigned aw[4] = {a.x, a.y, a.z, a.w}, bw[4] = {b.x, b.y, b.z, b.w};
#pragma unroll
          for (int j = 0; j < 4; ++j) { um2[2 * j] = pg8::bf_lo(aw[j]); um2[2 * j + 1] = pg8::bf_hi(aw[j]); um1[2 * j] = pg8::bf_lo(bw[j]); um1[2 * j + 1] = pg8::bf_hi(bw[j]); } }
#pragma unroll 4
        for (int i = 0; i < 16; ++i) { const size_t o = (size_t)(t0 + i) * 1024 + cc;
            const v4u u = *(const GAS v4u*)(UU + o), b = *(const GAS v4u*)(BG + o); const unsigned uw[4] = {u.x, u.y, u.z, u.w}, bw[4] = {b.x, b.y, b.z, b.w};
            float r[8];
#pragma unroll
            for (int j = 0; j < 4; ++j) { const float u0 = pg8::bf_lo(uw[j]), u1 = pg8::bf_hi(uw[j]);
                r[2 * j] = pg8::bf_lo(bw[j]) * (w0[2 * j] * um2[2 * j] + w1[2 * j] * um1[2 * j] + w2[2 * j] * u0);
                r[2 * j + 1] = pg8::bf_hi(bw[j]) * (w0[2 * j + 1] * um2[2 * j + 1] + w1[2 * j + 1] * um1[2 * j + 1] + w2[2 * j + 1] * u1);
                um2[2 * j] = um1[2 * j]; um2[2 * j + 1] = um1[2 * j + 1]; um1[2 * j] = u0; um1[2 * j + 1] = u1; }
            v4u o4; o4.x = pk2(r[0], r[1]); o4.y = pk2(r[2], r[3]); o4.z = pk2(r[4], r[5]); o4.w = pk2(r[6], r[7]);
            *(GAS v4u*)(CAout + o) = o4; }
    }
}
__device__ __forceinline__ bool top_better(float v, int n, float cv, int cn) { return v > cv || (v == cv && n < cn); }
__device__ __forceinline__ void top3_insert(float v, int n, float (&tv)[3], int (&ti)[3]) {
    if (top_better(v, n, tv[0], ti[0])) { tv[2] = tv[1]; ti[2] = ti[1]; tv[1] = tv[0]; ti[1] = ti[0]; tv[0] = v; ti[0] = n; }
    else if (top_better(v, n, tv[1], ti[1])) { tv[2] = tv[1]; ti[2] = ti[1]; tv[1] = v; ti[1] = n; }
    else if (top_better(v, n, tv[2], ti[2])) { tv[2] = v; ti[2] = n; }
}
__device__ __forceinline__ void phase2d(unsigned char* ws, LAS unsigned char* lds, int G, int tid, int wave, int lane, unsigned* gcnt, unsigned short* glist) {
    LAS unsigned* lcnt = (LAS unsigned*)(lds + 32768); LAS unsigned* lbase = lcnt + 64; LAS unsigned short* llist = (LAS unsigned short*)lds;
    const bf16* Q = (const bf16*)(ws + WS_Q); const float* kbar = (const float*)(ws + WS_KBAR);
    const int fr = lane & 15, fq = lane >> 4;
    for (int unit = blockIdx.x; unit < NH * 63; unit += G) {
        const int h = unit / 63, c = 1 + unit % 63;
        if (tid < 64) lcnt[tid] = 0u;
        __syncthreads();
        bf16x8 qf[2][4];
#pragma unroll
        for (int g = 0; g < 2; ++g)
#pragma unroll
            for (int ks = 0; ks < 4; ++ks) qf[g][ks] = *(const GAS bf16x8*)(Q + (size_t)(c * BLK + wave * 32 + g * 16 + fr) * 1024 + h * HD + ks * 32 + fq * 8);
        float tv[2][3]; int ti[2][3];
#pragma unroll
        for (int g = 0; g < 2; ++g)
#pragma unroll
            for (int j = 0; j < 3; ++j) { tv[g][j] = -__builtin_inff(); ti[g][j] = 1 << 20; }
        const int ntile = (c + 15) >> 4;
        for (int tile = 0; tile < ntile; ++tile) {
            f32x4 s0 = (f32x4){0.f, 0.f, 0.f, 0.f}, s1 = s0;
#pragma unroll
            for (int ks = 0; ks < 4; ++ks) {
                const float* kp = kbar + ((size_t)(h * NBLK + tile * 16 + fr) * HD + ks * 32 + fq * 8);
                const f32x4 a = *(const GAS f32x4*)kp, b = *(const GAS f32x4*)(kp + 4);
                const v4u hw = pg8::pack8(a, b);
                f32x4 ra, rb; ra[0] = a[0] - pg8::bf_lo(hw.x); ra[1] = a[1] - pg8::bf_hi(hw.x); ra[2] = a[2] - pg8::bf_lo(hw.y); ra[3] = a[3] - pg8::bf_hi(hw.y);
                rb[0] = b[0] - pg8::bf_lo(hw.z); rb[1] = b[1] - pg8::bf_hi(hw.z); rb[2] = b[2] - pg8::bf_lo(hw.w); rb[3] = b[3] - pg8::bf_hi(hw.w);
                const v4u lw = pg8::pack8(ra, rb);
                const bf16x8 hi = __builtin_bit_cast(bf16x8, hw), lo = __builtin_bit_cast(bf16x8, lw);
                s0 = __builtin_amdgcn_mfma_f32_16x16x32_bf16(hi, qf[0][ks], s0, 0, 0, 0); s0 = __builtin_amdgcn_mfma_f32_16x16x32_bf16(lo, qf[0][ks], s0, 0, 0, 0);
                s1 = __builtin_amdgcn_mfma_f32_16x16x32_bf16(hi, qf[1][ks], s1, 0, 0, 0); s1 = __builtin_amdgcn_mfma_f32_16x16x32_bf16(lo, qf[1][ks], s1, 0, 0, 0);
            }
#pragma unroll
            for (int i = 0; i < 4; ++i) { const int n = tile * 16 + 4 * fq + i;
                top3_insert(n < c ? s0[i] : -__builtin_inff(), n, tv[0], ti[0]); top3_insert(n < c ? s1[i] : -__builtin_inff(), n, tv[1], ti[1]); }
        }
#pragma unroll
        for (int off = 16; off <= 32; off <<= 1)
#pragma unroll
            for (int g = 0; g < 2; ++g) { float pv[3]; int pi[3];
#pragma unroll
                for (int j = 0; j < 3; ++j) { pv[j] = __shfl_xor(tv[g][j], off); pi[j] = __shfl_xor(ti[g][j], off); }
#pragma unroll
                for (int j = 0; j < 3; ++j) top3_insert(pv[j], pi[j], tv[g], ti[g]); }
        const int nsel = c < 3 ? c : 3;
        if (fq == 0) {
#pragma unroll
            for (int g = 0; g < 2; ++g) { const int tl = wave * 32 + g * 16 + fr;
#pragma unroll
                for (int j = 0; j < 3; ++j) if (j < nsel) { const int n = ti[g][j]; const unsigned pp = __hip_atomic_fetch_add(&lcnt[n], 1u, __ATOMIC_RELAXED, __HIP_MEMORY_SCOPE_WORKGROUP); llist[n * 256 + pp] = (unsigned short)((tl << 2) | j); } }
        }
        __syncthreads();
        if (tid < c) { const unsigned k = lcnt[tid]; lbase[tid] = k ? atomicAdd(gcnt + h * NBLK + tid, k) : 0u; }
        __syncthreads();
        for (int n = wave; n < c; n += NWAVES) { const unsigned k = lcnt[n], base = lbase[n];
            unsigned short* dst = glist + (size_t)h * LIST_PER_HEAD + list_off(n) + base;
            for (unsigned i = lane; i < k; i += 64) { const unsigned e = llist[n * 256 + i]; dst[i] = (unsigned short)((((unsigned)c * BLK + (e >> 2)) << 2) | (e & 3u)); } }
        __syncthreads();
    }
}
__device__ __forceinline__ void stage_kv(const bf16* Kg, const bf16* Vt, int h, int n, LAS unsigned char* lds, int tid) {
#pragma unroll
    for (int i = 0; i < 8; ++i) { const int row = (tid >> 4) + 32 * i, ch = tid & 15;
        const v4u w = *(const GAS v4u*)(Kg + (size_t)(n * BLK + row) * 1024 + h * HD + ch * 8);
        const int sw = (((row >> 3) & 3) << 2) | (row & 3);
        *(LAS v4u*)(lds + row * 256 + ((ch ^ sw) << 4)) = w; }
#pragma unroll
    for (int i = 0; i < 8; ++i) { const int row = (tid >> 5) + 16 * i, ch = tid & 31;
        const v4u w = *(const GAS v4u*)(Vt + (size_t)(h * HD + row) * M + n * BLK + ch * 8);
        *(LAS v4u*)(lds + 65536 + row * 512 + ((ch ^ ((((row >> 3) & 3) << 2) | (row & 3))) << 4)) = w; }
}
template <bool CAUSAL, int MODE = 0>
__device__ __forceinline__ void attn_core(const LAS unsigned char* lds, const bf16* Q, int h, const int (&tq)[2], int wave, int fr, int fq, float B2, f32x4 (&O)[8][2], float (&l)[2]) {
    bf16x8 qf[2][4];
#pragma unroll
    for (int g = 0; g < 2; ++g)
#pragma unroll
        for (int ks = 0; ks < 4; ++ks) qf[g][ks] = *(const GAS bf16x8*)(Q + (size_t)tq[g] * 1024 + h * HD + ks * 32 + fq * 8);
#pragma unroll
    for (int dt = 0; dt < 8; ++dt) { O[dt][0] = (f32x4){0.f, 0.f, 0.f, 0.f}; O[dt][1] = O[dt][0]; }
    l[0] = 0.f; l[1] = 0.f;
    const int nch = CAUSAL ? wave + 1 : 8;
    const int krow = (fr >> 2) * 8 + (fr & 3);
    bf16x8 kf[4][2];
#pragma unroll
    for (int ks = 0; ks < 4; ++ks)
#pragma unroll
        for (int t = 0; t < 2; ++t) kf[ks][t] = *(const LAS bf16x8*)(lds + (krow + t * 4) * 256 + (((ks * 4 + fq) ^ fr) << 4));
#pragma unroll 2
    for (int c = 0; c < nch; ++c) {
        f32x4 s[2][2];
#pragma unroll
        for (int t = 0; t < 2; ++t) { s[t][0] = (f32x4){-B2, -B2, -B2, -B2}; s[t][1] = s[t][0]; }
        bf16x8 vf[8];
#pragma unroll
        for (int dt = 0; dt < 8; ++dt) vf[dt] = *(const LAS bf16x8*)(lds + 65536 + ((dt >> 1) * 32 + (fr >> 2) * 8 + (dt & 1) * 4 + (fr & 3)) * 512 + (((c * 4 + fq) ^ fr) << 4));
#pragma unroll
        for (int ks = 0; ks < 4; ++ks)
#pragma unroll
            for (int t = 0; t < 2; ++t) {
                if (MODE != 2 || ks == 0) {
                s[t][0] = __builtin_amdgcn_mfma_f32_16x16x32_bf16(kf[ks][t], qf[0][ks], s[t][0], 0, 0, 0);
                s[t][1] = __builtin_amdgcn_mfma_f32_16x16x32_bf16(kf[ks][t], qf[1][ks], s[t][1], 0, 0, 0); }
            }
        __builtin_amdgcn_sched_barrier(0);
        { const int cn = (c + 1 < nch) ? c + 1 : c;
#pragma unroll
          for (int ks = 0; ks < 4; ++ks)
#pragma unroll
              for (int t = 0; t < 2; ++t) kf[ks][t] = *(const LAS bf16x8*)(lds + (cn * 32 + krow + t * 4) * 256 + (((ks * 4 + fq) ^ fr) << 4)); }
        bf16x8 pf[2];
#pragma unroll
        for (int g = 0; g < 2; ++g) {
            float p[8];
#pragma unroll
            for (int t = 0; t < 2; ++t)
#pragma unroll
                for (int i = 0; i < 4; ++i) { float e = MODE == 1 ? s[t][g][i] : __builtin_amdgcn_exp2f(s[t][g][i]);
                    if (CAUSAL && c == wave) { const int kl = c * 32 + fq * 8 + t * 4 + i, ql = wave * 32 + g * 16 + fr; if (kl > ql) e = 0.f; }
                    p[t * 4 + i] = e; }
            l[g] += ((p[0] + p[1]) + (p[2] + p[3])) + ((p[4] + p[5]) + (p[6] + p[7]));
            v4u w; w.x = pg8::cvt_pk_bf16(p[0], p[1]); w.y = pg8::cvt_pk_bf16(p[2], p[3]); w.z = pg8::cvt_pk_bf16(p[4], p[5]); w.w = pg8::cvt_pk_bf16(p[6], p[7]);
            pf[g] = __builtin_bit_cast(bf16x8, w);
        }
#pragma unroll
        for (int dt = 0; dt < 8; ++dt) {
            if (MODE != 3 || dt == 0) {
            O[dt][0] = __builtin_amdgcn_mfma_f32_16x16x32_bf16(vf[dt], pf[0], O[dt][0], 0, 0, 0);
            O[dt][1] = __builtin_amdgcn_mfma_f32_16x16x32_bf16(vf[dt], pf[1], O[dt][1], 0, 0, 0); }
        }
    }
    l[0] += __shfl_xor(l[0], 16); l[0] += __shfl_xor(l[0], 32); l[1] += __shfl_xor(l[1], 16); l[1] += __shfl_xor(l[1], 32);
}
__device__ __forceinline__ float score_bound(const float* q_norm, const float* k_norm, int lane) {
    float a = fmaxf(fabsf(q_norm[lane]), fabsf(q_norm[lane + 64])), b = fmaxf(fabsf(k_norm[lane]), fabsf(k_norm[lane + 64]));
#pragma unroll
    for (int o = 1; o < 64; o <<= 1) { a = fmaxf(a, __shfl_xor(a, o)); b = fmaxf(b, __shfl_xor(b, o)); }
    return 128.0f * a * b * C2 * 1.001f + 0.01f;
}
template <int MODE>
__device__ __forceinline__ void phase3a(const float* q_norm, const float* k_norm, unsigned char* ws, LAS unsigned char* lds, int G, int tid, int wave, int lane) {
    const int fr = lane & 15, fq = lane >> 4;
    LAS int* pre = (LAS int*)(lds + SCAN_OFF);
    LAS int* cntl = (LAS int*)(lds + SCAN_OFF + 2080);
    const unsigned* gcnt = (const unsigned*)(ws + WS_CTL) + CW_GCNT; const unsigned short* glist = (const unsigned short*)(ws + WS_LIST);
    const bf16* Q = (const bf16*)(ws + WS_Q); const bf16* Kg = (const bf16*)(ws + WS_K); const bf16* Vt = (const bf16*)(ws + WS_VT);
    bf16* OP = (bf16*)(ws + WS_OPART); float* LP = (float*)(ws + WS_LPART);
    const float B2 = score_bound(q_norm, k_norm, lane);
    { const int cnt = (int)__hip_atomic_load(gcnt + tid, __ATOMIC_RELAXED, __HIP_MEMORY_SCOPE_AGENT); pre[tid + 1] = (cnt + 255) >> 8; cntl[tid] = cnt; if (tid == 0) pre[0] = 0; }
    __syncthreads();
    for (int o = 1; o < 512; o <<= 1) { const int v = pre[tid + 1] + ((tid + 1 - o) >= 1 ? pre[tid + 1 - o] : 0); __syncthreads(); pre[tid + 1] = v; __syncthreads(); }
    const int T = pre[512];
    const int i_lo = (int)(((long)blockIdx.x * T) / G), i_hi = (int)(((long)(blockIdx.x + 1) * T) / G);
    int staged = -1;
#define P3A_DECODE(IT, HN, TILE) do { int lo_ = 0, hi_ = 511; while (lo_ < hi_) { const int mid_ = (lo_ + hi_ + 1) >> 1; if (pre[mid_] <= (IT)) lo_ = mid_; else hi_ = mid_ - 1; } HN = lo_; TILE = (IT) - pre[lo_]; } while (0)
    unsigned en[2] = {0u, 0u}; bool okn[2] = {false, false};
    if (i_lo < i_hi) { int hn, tile; P3A_DECODE(i_lo, hn, tile); const int cnt = cntl[hn]; const unsigned short* lst = glist + (size_t)(hn >> 6) * LIST_PER_HEAD + list_off(hn & 63) + tile * 256;
#pragma unroll
        for (int g = 0; g < 2; ++g) { const int qi = wave * 32 + g * 16 + fr; okn[g] = tile * 256 + qi < cnt; en[g] = okn[g] ? lst[qi] : 0u; } }
    for (int it = i_lo; it < i_hi; ++it) {
        int hn, tile; P3A_DECODE(it, hn, tile); const int h = hn >> 6, n = hn & 63;
        int tq[2], sj[2]; bool ok[2];
#pragma unroll
        for (int g = 0; g < 2; ++g) { ok[g] = okn[g]; tq[g] = (int)(en[g] >> 2); sj[g] = (int)(en[g] & 3u); }
        if (it + 1 < i_hi) { int hn2, tile2; P3A_DECODE(it + 1, hn2, tile2); const int cnt2 = cntl[hn2]; const unsigned short* lst2 = glist + (size_t)(hn2 >> 6) * LIST_PER_HEAD + list_off(hn2 & 63) + tile2 * 256;
#pragma unroll
            for (int g = 0; g < 2; ++g) { const int qi = wave * 32 + g * 16 + fr; okn[g] = tile2 * 256 + qi < cnt2; en[g] = okn[g] ? lst2[qi] : 0u; } }
        if (hn != staged) { __syncthreads(); stage_kv(Kg, Vt, h, n, lds, tid); LDS_WAIT(); __syncthreads(); staged = hn; }
        f32x4 O[8][2]; float l[2];
        attn_core<false, MODE>(lds, Q, h, tq, wave, fr, fq, B2, O, l);
#pragma unroll
        for (int g = 0; g < 2; ++g) if (ok[g]) {
            bf16* op = OP + ((size_t)sj[g] * M + tq[g]) * 1024 + h * HD + 8 * fq;
#pragma unroll
            for (int j = 0; j < 4; ++j) *(GAS v4u*)(op + j * 32) = pg8::pack8(O[2 * j][g], O[2 * j + 1][g]);
            if (fq == 0) LP[((size_t)sj[g] * M + tq[g]) * NH + h] = l[g];
        }
    }
#undef P3A_DECODE
    __syncthreads();
}
__device__ __forceinline__ void phase3b(const float* q_norm, const float* k_norm, unsigned char* ws, LAS unsigned char* lds, int G, int tid, int wave, int lane, bf16* Oout) {
    const int fr = lane & 15, fq = lane >> 4;
    bf16* Q = (bf16*)(ws + WS_Q); const bf16* Kg = (const bf16*)(ws + WS_K); const bf16* Vt = (const bf16*)(ws + WS_VT);
    const bf16* OP = (const bf16*)(ws + WS_OPART); const float* LP = (const float*)(ws + WS_LPART);
    const float B2 = score_bound(q_norm, k_norm, lane);
    for (int unit = blockIdx.x; unit < NH * NBLK; unit += G) {
        const int h = unit >> 6, c = unit & 63;
        __syncthreads(); stage_kv(Kg, Vt, h, c, lds, tid); LDS_WAIT(); __syncthreads();
        int tq[2];
#pragma unroll
        for (int g = 0; g < 2; ++g) tq[g] = c * BLK + wave * 32 + g * 16 + fr;
        f32x4 O[8][2]; float l[2];
        attn_core<true>(lds, Q, h, tq, wave, fr, fq, B2, O, l);
        const int nsel = c < 3 ? c : 3;
#pragma unroll
        for (int g = 0; g < 2; ++g) {
            float lp[3];
#pragma unroll
            for (int j = 0; j < 3; ++j) lp[j] = LP[((size_t)j * M + tq[g]) * NH + h];
            v4u w[3][4];
#pragma unroll
            for (int j = 0; j < 3; ++j)
#pragma unroll
                for (int k = 0; k < 4; ++k) w[j][k] = *(const GAS v4u*)(OP + ((size_t)j * M + tq[g]) * 1024 + h * HD + k * 32 + 8 * fq);
            float lt = l[g];
#pragma unroll
            for (int j = 0; j < 3; ++j) lt += j < nsel ? lp[j] : 0.f;
            const float inv = 1.0f / lt;
#pragma unroll
            for (int k = 0; k < 4; ++k) { f32x4 oa = O[2 * k][g], ob = O[2 * k + 1][g];
#pragma unroll
                for (int j = 0; j < 3; ++j) if (j < nsel) { const v4u x = w[j][k];
                    oa[0] += pg8::bf_lo(x.x); oa[1] += pg8::bf_hi(x.x); oa[2] += pg8::bf_lo(x.y); oa[3] += pg8::bf_hi(x.y); ob[0] += pg8::bf_lo(x.z); ob[1] += pg8::bf_hi(x.z); ob[2] += pg8::bf_lo(x.w); ob[3] += pg8::bf_hi(x.w); }
                *(GAS v4u*)(Oout + (size_t)tq[g] * 1024 + h * HD + k * 32 + 8 * fq) = pg8::pack8(oa * inv, ob * inv); }
        }
    }
    __syncthreads();
}

#ifndef MK_PER_PHASE
#define MK_PER_PHASE 0
#endif
#ifndef MK_DUP
#define MK_DUP -1
#endif
constexpr int N_PHASES = 9;
struct Args { const float* in[14]; float* out; unsigned char* ws; int ph_lo, ph_hi; };
__global__ void __launch_bounds__(NTHREADS, 2) hybrid_fwd(Args args) {
    extern __shared__ __attribute__((aligned(16))) unsigned char lds_raw[];
    LAS unsigned char* lds = (LAS unsigned char*)lds_raw;
    volatile LAS unsigned* MISC = (volatile LAS unsigned*)(lds + MISC_OFF);
    const int tid = threadIdx.x, lane = tid & 63, wave = __builtin_amdgcn_readfirstlane(tid >> 6);
    const int G = gridDim.x; const int vcu = (G % 8 == 0) ? ((int)blockIdx.x % 8) * (G / 8) + (int)blockIdx.x / 8 : (int)blockIdx.x;
    unsigned char* ws = args.ws;
    gu32* ctl = (gu32*)(ws + WS_CTL);
    if (tid < 32) MISC[tid] = 0u;
    __syncthreads();
    const int lo = args.ph_lo, hi = args.ph_hi;
    XcdBarrier bar; bar.bar = (unsigned*)ctl + CW_BAR; bar.x = 0; bar.st = nullptr;
    if (hi - lo > 1) bar = xcd_barrier_post((unsigned*)ctl + CW_BAR, MISC + 8);
#ifndef PHASE_MASK
#define PHASE_MASK 0x1ff
#endif
#define IN(k) (((PHASE_MASK >> (k)) & 1) && lo <= (k) && (k) < hi)
#define SEAM(k) do { if (IN(k) && IN((k) + 1)) xcd_barrier(bar); } while (0)
    const float* x = args.in[0]; const float* norm_mix = args.in[1]; const float* w_in = args.in[2]; const float* conv_a_w = args.in[3]; const float* q_norm = args.in[4]; const float* k_norm = args.in[5];
    const float* w_oa = args.in[6]; const float* w_ob = args.in[7]; const float* w_o = args.in[8]; const float* norm_ffn = args.in[9]; const float* w_up = args.in[10]; const float* ffn_conv_w = args.in[11];
    const float* ffn_conv_b = args.in[12]; const float* w_down = args.in[13];
    float* out = args.out;
    float* rowss = (float*)((unsigned*)ctl + CW_ROWSS);
    const size_t TSTEP = (size_t)256 * 1024 * 2;

    if (IN(0)) { phase0(x, norm_mix, w_in, w_oa, w_ob, w_o, w_up, norm_ffn, ws, lds, vcu, G, wave, lane); __syncthreads(); }
    SEAM(0);
    if (IN(1)) {
        pg8::Gemm g{(const bf16*)(ws + WS_XB), (const bf16*)(ws + WS_XB), (const bf16*)(ws + WS_WIN), (const bf16*)(ws + WS_WIN), D, TSTEP};
        pg8::StaticOrder S; S.init(M / 256, NIN / 256, G, (int)blockIdx.x);
        pg8::Epi1 E{(bf16*)(ws + WS_CA), (bf16*)(ws + WS_UU), (bf16*)(ws + WS_Q), (bf16*)(ws + WS_K), (bf16*)(ws + WS_VT), (bf16*)out, (const float*)(ws + WS_RSTDX), q_norm, k_norm, (float*)(ws + WS_KBAR), (PG8_LAS float*)(lds + HALO_OFF)};
        pg8::gemm_phase<pg8::Epi1, pg8::StaticOrder, true, true>(lds, g, S, E);
    }
    SEAM(1);
    if (IN(2)) { phase2d(ws, lds, G, tid, wave, lane, (unsigned*)(ws + WS_CTL) + CW_GCNT, (unsigned short*)(ws + WS_LIST));
        phase2(conv_a_w, ws, G, tid, (bf16*)(ws + WS_CA)); __syncthreads(); }
#if MK_DUP == 21
    if (IN(2)) { phase2d(ws, lds, G, tid, wave, lane, (unsigned*)(ws + WS_CTL) + CW_GCNT + 512, (unsigned short*)(ws + WS_WIN)); }
#endif
#if MK_DUP == 22
    if (IN(2)) { phase2(conv_a_w, ws, G, tid, (bf16*)(ws + WS_XB)); }
#endif
    SEAM(2);
#if MK_DUP >= 30 && MK_DUP <= 35
    if (IN(3)) phase3a<MK_DUP - 30>(q_norm, k_norm, ws, lds, G, tid, wave, lane);
#endif
    if (IN(3)) phase3a<0>(q_norm, k_norm, ws, lds, G, tid, wave, lane);
    SEAM(3);
    if (IN(4)) { phase3b(q_norm, k_norm, ws, lds, G, tid, wave, lane, (bf16*)(ws + WS_Q));
#if MK_DUP == 4
        phase3b(q_norm, k_norm, ws, lds, G, tid, wave, lane, (bf16*)(ws + WS_OPART));
#endif
        convert_weight(w_down, DFF, D, (bf16*)(ws + WS_WDN), nullptr, 0, (LAS float*)(lds + wave * 16384), vcu * NWAVES + wave, G * NWAVES, lane); __syncthreads(); }
    SEAM(4);
    if (IN(5)) {
        { LAS float* scr = (LAS float*)(lds + wave * 16384); const int gw = vcu * NWAVES + wave, NGW = G * NWAVES;
          if (blockIdx.x == 0 && tid < 256) *(GAS v4u*)(ws + WS_HB - 4096 + tid * 16) = (v4u){0u, 0u, 0u, 0u};
          __syncthreads(); }
        pg8::Gemm g{(const bf16*)(ws + WS_CA), (const bf16*)(ws + WS_Q), (const bf16*)(ws + WS_WOA), (const bf16*)(ws + WS_WOB), D, TSTEP};
        pg8::DualOrder S; S.S.init(M / 256, D / 256, G, (int)blockIdx.x);
        pg8::Epi4 E{(bf16*)(ws + WS_MG), (const bf16*)out};
        pg8::gemm_phase<pg8::Epi4, pg8::DualOrder, true, true>(lds, g, S, E);
    }
    SEAM(5);
    if (IN(6)) {
        pg8::Gemm g{(const bf16*)(ws + WS_MG), (const bf16*)(ws + WS_MG), (const bf16*)(ws + WS_WO), (const bf16*)(ws + WS_WO), D, TSTEP};
        pg8::StaticOrder S; S.init(M / 256, D / 256, G, (int)blockIdx.x);
        pg8::Epi5 E{x, out, (bf16*)(ws + WS_HB), rowss};
        pg8::gemm_phase<pg8::Epi5, pg8::StaticOrder, true, true>(lds, g, S, E);
#if MK_DUP == 6
        { pg8::Epi5 E2{x, (float*)(ws + WS_Q), (bf16*)(ws + WS_VT), (float*)(ws + WS_CA)}; pg8::gemm_phase<pg8::Epi5, pg8::StaticOrder, true, true>(lds, g, S, E2); }
#endif
    }
    SEAM(6);
    if (IN(7)) {
        const bf16* hb2 = (const bf16*)(ws + WS_HB) - 2 * 1024;
        pg8::Gemm g{hb2, hb2, (const bf16*)(ws + WS_WUP), (const bf16*)(ws + WS_WUP), D, (size_t)254 * 1024 * 2};
        pg8::StaticOrder S; S.init(65, 22, G, (int)blockIdx.x);
        pg8::Epi6 E{(bf16*)(ws + WS_ACT), rowss, ffn_conv_w, ffn_conv_b, (PG8_LAS float*)(lds + HALO_OFF)};
        pg8::gemm_phase<pg8::Epi6, pg8::StaticOrder, true, true>(lds, g, S, E);
    }
    SEAM(7);
    if (IN(8)) {
        pg8::Gemm g{(const bf16*)(ws + WS_ACT), (const bf16*)(ws + WS_ACT), (const bf16*)(ws + WS_WDN), (const bf16*)(ws + WS_WDN), DFF, (size_t)256 * DFF * 2};
        pg8::StaticOrder S; S.init(M / 256, D / 256, G, (int)blockIdx.x);
        pg8::Epi7 E{out, (const bf16*)(ws + WS_HB)};
        pg8::gemm_phase<pg8::Epi7, pg8::StaticOrder, true, true>(lds, g, S, E);
#if MK_DUP == 8
        { pg8::Epi7 E2{(float*)(ws + WS_MG), (const bf16*)(ws + WS_HB)}; pg8::gemm_phase<pg8::Epi7, pg8::StaticOrder, true, true>(lds, g, S, E2); }
#endif
    }
#undef IN
#undef SEAM
}

extern "C" void kernel_launch(void* const* d_in, const int* in_sizes, int n_in, void* d_out, int out_size, void* d_ws, size_t ws_size, hipStream_t stream) {
    static int grid = 0;
    if (grid == 0) {
        if (n_in != 14 || in_sizes[0] != M * D || out_size != M * D || ws_size < WS_END) { fprintf(stderr, "kernel_launch: unexpected shapes (n_in %d, in0 %d, out %d, ws %zu)\n", n_in, n_in > 0 ? in_sizes[0] : -1, out_size, ws_size); grid = -1; return; }
        int dev = 0, cus = 0, per_cu = 0;
        if (hipGetDevice(&dev) != hipSuccess || hipDeviceGetAttribute(&cus, hipDeviceAttributeMultiprocessorCount, dev) != hipSuccess) { grid = -1; return; }
        if (hipFuncSetAttribute((const void*)hybrid_fwd, hipFuncAttributeMaxDynamicSharedMemorySize, LDS_BYTES) != hipSuccess) { fprintf(stderr, "kernel_launch: hipFuncSetAttribute failed\n"); grid = -1; return; }
        if (hipOccupancyMaxActiveBlocksPerMultiprocessor(&per_cu, (const void*)hybrid_fwd, NTHREADS, LDS_BYTES) != hipSuccess || per_cu < 1) { fprintf(stderr, "kernel_launch: occupancy query says %d blocks per CU\n", per_cu); (void)hipGetLastError(); grid = -1; return; }
        grid = cus;
    }
    if (grid < 0) return;
    if (hipMemsetAsync((char*)d_ws + WS_CTL, 0, CTL_ZERO_BYTES, stream) != hipSuccess) { fprintf(stderr, "kernel_launch: memset failed\n"); return; }
    Args a{};
    for (int i = 0; i < 14; ++i) a.in[i] = (const float*)d_in[i];
    a.out = (float*)d_out; a.ws = (unsigned char*)d_ws;
#if MK_PER_PHASE
    for (int p = 0; p < N_PHASES; ++p) { a.ph_lo = p; a.ph_hi = p + 1; hipLaunchKernelGGL(hybrid_fwd, dim3(grid), dim3(NTHREADS), LDS_BYTES, stream, a); }
#else
    a.ph_lo = 0; a.ph_hi = N_PHASES;
    void* kargs[] = {&a};
    hipError_t e = hipLaunchCooperativeKernel((const void*)hybrid_fwd, dim3(grid), dim3(NTHREADS), kargs, LDS_BYTES, stream);
    if (e != hipSuccess) fprintf(stderr, "kernel_launch: cooperative launch failed: %s (grid %d)\n", hipGetErrorString(e), grid);
#endif
}
```

```cpp
#include <hip/hip_runtime.h>
#include <cstdio>
#include <cstdint>
namespace pg8 {
#define PG8_LAS __attribute__((address_space(3)))
typedef unsigned short bf16_t;
typedef short bf16x8 __attribute__((ext_vector_type(8)));
typedef float f32x4 __attribute__((ext_vector_type(4)));
typedef unsigned u32x4 __attribute__((ext_vector_type(4)));
constexpr int BM = 256, BK = 64, HALF = 128, HTB = HALF * BK * 2  , STAGE_BYTES = 8 * HTB, NXCD = 8, WGM = 8;

__host__ __device__ __forceinline__ int lds_byte(int r, int c) { const int st = (r >> 4) * 2 + (c >> 5), rr = r & 15, cc = c & 31, ob = rr * 64 + cc * 2; return st * 1024 + (ob ^ (((ob >> 9) & 1) << 5)); }
__host__ __device__ __forceinline__ void stage_rc(int b, int& R, int& C) { const int st = b / 1024, sb = b % 1024, swz = sb ^ (((sb >> 9) & 1) << 5); R = (st >> 1) * 16 + swz / 64; C = (st & 1) * 32 + (swz % 64) / 2; }
__host__ __device__ __forceinline__ int perm32(int rho) { const int n = rho >> 4, i = rho & 15; return 8 * (i >> 2) + 4 * n + (i & 3); }


struct Unit { int pm, pn, sel; };
struct Gemm { const bf16_t* A0; const bf16_t* A1; const bf16_t* B0; const bf16_t* B1; int K; size_t a_tstep; };

struct StaticOrder {
    int nM, nN, nwg, G, c;
    __host__ __device__ void init(int nM_, int nN_, int G_, int c_) { nM = nM_; nN = nN_; nwg = nM * nN; G = G_; c = c_; }
    __host__ __device__ bool next(int i, Unit& u) const {
        const long L = (long)i * G + c; if (L >= nwg) return false;
        int wgid = (int)L; { const int q = nwg / NXCD, r = nwg % NXCD, xcd = wgid % NXCD, off = wgid / NXCD; wgid = (xcd < r ? xcd * (q + 1) : r * (q + 1) + (xcd - r) * q) + off; }
        const int nig = WGM * nN, gid = wgid / nig, fm = gid * WGM, gsz = (nM - fm) < WGM ? (nM - fm) : WGM;
        u.pm = fm + ((wgid % nig) % gsz); u.pn = (wgid % nig) / gsz; u.sel = 0; return true;
    }
    __device__ __forceinline__ void a_ready(const Unit&) const {}
    __device__ __forceinline__ void done(const Unit&) const {}
};
struct DualOrder {
    StaticOrder S;
    __host__ __device__ bool next(int i, Unit& u) const { const bool ok = S.next(i >> 1, u); u.sel = i & 1; return ok; }
    __device__ __forceinline__ void a_ready(const Unit&) const {}
    __device__ __forceinline__ void done(const Unit&) const {}
};

typedef __bf16 bf16x2_t_ __attribute__((ext_vector_type(2))); typedef float f32x2_t_ __attribute__((ext_vector_type(2)));
__device__ __forceinline__ unsigned cvt_pk_bf16(float lo, float hi) { const f32x2_t_ v = {lo, hi}; const bf16x2_t_ b = __builtin_convertvector(v, bf16x2_t_); return __builtin_bit_cast(unsigned, b); }
__device__ __forceinline__ float bf_lo(unsigned w) { return __uint_as_float(w << 16); }
__device__ __forceinline__ float bf_hi(unsigned w) { return __uint_as_float(w & 0xffff0000u); }
__device__ __forceinline__ float fast_sigmoid(float x) { return __builtin_amdgcn_rcpf(1.0f + __builtin_amdgcn_exp2f(-1.4426950408889634f * x)); }
__device__ __forceinline__ u32x4 pack8(const f32x4 a, const f32x4 b) { u32x4 w; w.x = cvt_pk_bf16(a[0], a[1]); w.y = cvt_pk_bf16(a[2], a[3]); w.z = cvt_pk_bf16(b[0], b[1]); w.w = cvt_pk_bf16(b[2], b[3]); return w; }

template <int CTRL> __device__ __forceinline__ float dpp_shr(float old, float v) { return __builtin_bit_cast(float, __builtin_amdgcn_update_dpp(__builtin_bit_cast(int, old), __builtin_bit_cast(int, v), CTRL, 0xf, 0xf, false)); }
template <int CTRL> __device__ __forceinline__ float dpp_ror(float v) { return __builtin_bit_cast(float, __builtin_amdgcn_update_dpp(0, __builtin_bit_cast(int, v), CTRL, 0xf, 0xf, true)); }
constexpr int MROWS = 16384, DMODEL = 1024, DFF_ = 2816;

struct Epi1 {
    static constexpr bool PERM = true, AFTER_DRAIN = false;
    static __device__ __forceinline__ bool keep_acc(const Unit&) { return false; }
    bf16_t *BG, *UU, *Q, *K, *VT, *SG; const float* rstdx; const float *q_norm, *k_norm; float* kbar; PG8_LAS float* xl;
    __device__ __forceinline__ void operator()(f32x4 (&acc)[2][2][4][2], const Unit& u, int wr, int wc, int fr, int fq) const {
        const int row0 = u.pm * BM + wr * 64 + fr, colw = wc * 32 + 8 * fq, pn = u.pn;
        if (pn >= 12 && pn < 20) {
            const bool isK = pn >= 16; const float* wn = isK ? k_norm : q_norm; const float gs = isK ? 1.0f : 0.12751743074602357f;
            bf16_t* dst = isK ? K : Q; const int cb = ((pn - 12) & 3) * 256;
#pragma unroll
            for (int ai = 0; ai < 2; ++ai)
#pragma unroll
                for (int m = 0; m < 4; ++m) { const int rl = ai * HALF + wr * 64 + m * 16 + fr; const float rs = rstdx[u.pm * BM + rl];
#pragma unroll
                    for (int bj = 0; bj < 2; ++bj) { const f32x4 a = acc[ai][bj][m][0] * rs, b = acc[ai][bj][m][1] * rs; acc[ai][bj][m][0] = a; acc[ai][bj][m][1] = b;
                        float ss = (a[0] * a[0] + a[1] * a[1]) + (a[2] * a[2] + a[3] * a[3]) + (b[0] * b[0] + b[1] * b[1]) + (b[2] * b[2] + b[3] * b[3]);
                        ss += __shfl_xor(ss, 16); ss += __shfl_xor(ss, 32);
                        if (fq == 0) xl[(rl * 2 + bj) * 4 + wc] = ss; } }
            asm volatile("s_waitcnt lgkmcnt(0)" ::: "memory"); __builtin_amdgcn_s_barrier(); asm volatile("" ::: "memory");
            const f32x4 g0 = *(const f32x4*)(wn + colw) * gs, g1 = *(const f32x4*)(wn + colw + 4) * gs;
#pragma unroll
            for (int ai = 0; ai < 2; ++ai)
#pragma unroll
                for (int m = 0; m < 4; ++m) { const int rl = ai * HALF + wr * 64 + m * 16 + fr; const int r = u.pm * BM + rl;
#pragma unroll
                    for (int bj = 0; bj < 2; ++bj) { const f32x4 p = *(const PG8_LAS f32x4*)(xl + (rl * 2 + bj) * 4);
                        const float rn = rsqrtf(((p[0] + p[1]) + (p[2] + p[3])) * (1.0f / 128.0f) + 1e-6f);
                        const f32x4 a = acc[ai][bj][m][0] * rn * g0, b = acc[ai][bj][m][1] * rn * g1; acc[ai][bj][m][0] = a; acc[ai][bj][m][1] = b;
                        *(u32x4*)(dst + (size_t)r * 1024 + cb + bj * 128 + colw) = pack8(a, b); } }
            if (isK) {
                f32x4 cs[2][2];
#pragma unroll
                for (int bj = 0; bj < 2; ++bj)
#pragma unroll
                    for (int n = 0; n < 2; ++n) { f32x4 t = acc[0][bj][0][n];
#pragma unroll
                        for (int ai = 0; ai < 2; ++ai)
#pragma unroll
                            for (int m = 0; m < 4; ++m) if (ai + m > 0) t += acc[ai][bj][m][n];
                        cs[bj][n] = t; }
#pragma unroll
                for (int bj = 0; bj < 2; ++bj)
#pragma unroll
                    for (int n = 0; n < 2; ++n)
#pragma unroll
                        for (int e = 0; e < 4; ++e) { float v = cs[bj][n][e]; v += __shfl_xor(v, 1); v += __shfl_xor(v, 2); v += __shfl_xor(v, 4); v += __shfl_xor(v, 8); cs[bj][n][e] = v; }
                if (fr == 0) {
#pragma unroll
                    for (int bj = 0; bj < 2; ++bj) { *(PG8_LAS f32x4*)(xl + 2048 + wr * 256 + bj * 128 + colw) = cs[bj][0]; *(PG8_LAS f32x4*)(xl + 2048 + wr * 256 + bj * 128 + colw + 4) = cs[bj][1]; } }
                asm volatile("s_waitcnt lgkmcnt(0)" ::: "memory"); __builtin_amdgcn_s_barrier(); asm volatile("" ::: "memory");
                int t = threadIdx.x; asm volatile("" : "+v"(t));
                if (t < 256) kbar[((size_t)((pn - 16) * 2 + (t >> 7)) * 64 + u.pm) * 128 + (t & 127)] = (xl[2048 + t] + xl[2048 + 256 + t]) * (1.0f / 256.0f);
            }
            return;
        }
        if (pn >= 20 && pn < 24) {
            int tidv = threadIdx.x; asm volatile("" : "+v"(tidv));
            PG8_LAS unsigned char* T = (PG8_LAS unsigned char*)xl + (tidv >> 6) * 2304;
            const int lane = tidv & 63;
#pragma unroll
            for (int ai = 0; ai < 2; ++ai)
#pragma unroll
                for (int mp = 0; mp < 2; ++mp)
#pragma unroll
                    for (int bj = 0; bj < 2; ++bj) {
#pragma unroll
                        for (int mm = 0; mm < 2; ++mm) { const int m = 2 * mp + mm; const float rs = rstdx[u.pm * BM + ai * HALF + wr * 64 + m * 16 + fr];
                            const u32x4 w = pack8(acc[ai][bj][m][0] * rs, acc[ai][bj][m][1] * rs); const unsigned ww[4] = {w.x, w.y, w.z, w.w};
                            PG8_LAS unsigned char* tp = T + (8 * fq) * 72 + (16 * mm + fr) * 2;
#pragma unroll
                            for (int e = 0; e < 8; ++e) *(PG8_LAS unsigned short*)(tp + e * 72) = (unsigned short)((e & 1) ? (ww[e >> 1] >> 16) : (ww[e >> 1] & 0xffffu)); }
                        asm volatile("s_waitcnt lgkmcnt(0)" ::: "memory");
#pragma unroll
                        for (int rr = 0; rr < 2; ++rr) { const int q = lane + 64 * rr, d = q >> 2, tc = q & 3;
                            const unsigned long long x0 = *(const PG8_LAS unsigned long long*)(T + d * 72 + tc * 16), x1 = *(const PG8_LAS unsigned long long*)(T + d * 72 + tc * 16 + 8);
                            u32x4 o; o.x = (unsigned)x0; o.y = (unsigned)(x0 >> 32); o.z = (unsigned)x1; o.w = (unsigned)(x1 >> 32);
                            *(u32x4*)(VT + ((size_t)(((pn - 20) * 2 + bj) * 128 + 32 * wc + d)) * MROWS + u.pm * BM + ai * HALF + wr * 64 + 32 * mp + tc * 8) = o; }
                        asm volatile("s_waitcnt lgkmcnt(0)" ::: "memory");
                    }
            return;
        }
#pragma unroll
        for (int ai = 0; ai < 2; ++ai)
#pragma unroll
            for (int m = 0; m < 4; ++m) {
                const int r = row0 + ai * HALF + m * 16; const float rs = rstdx[r];
                f32x4 v[2][2];
#pragma unroll
                for (int bj = 0; bj < 2; ++bj)
#pragma unroll
                    for (int n = 0; n < 2; ++n) v[bj][n] = acc[ai][bj][m][n] * rs;
                if (pn < 4) {
#pragma unroll
                    for (int bj = 0; bj < 2; ++bj) *(u32x4*)(BG + (size_t)r * 1024 + pn * 256 + bj * 128 + colw) = pack8(v[bj][0], v[bj][1]);
                } else if (pn < 12) {
                    *(u32x4*)(UU + (size_t)r * 1024 + (pn - 4) * 128 + colw) = pack8(v[0][0] * v[1][0], v[0][1] * v[1][1]);
                } else {
                    f32x4 ra, rb, sa, sb;
#pragma unroll
                    for (int e = 0; e < 4; ++e) { const float ea0 = __builtin_amdgcn_exp2f(-1.4426950408889634f * v[0][0][e]), ea1 = __builtin_amdgcn_exp2f(-1.4426950408889634f * v[0][1][e]);
                        const float eb0 = __builtin_amdgcn_exp2f(-1.4426950408889634f * v[1][0][e]), eb1 = __builtin_amdgcn_exp2f(-1.4426950408889634f * v[1][1][e]);
                        ra[e] = (1.0f + eb0) * __builtin_amdgcn_rcpf(1.0f + ea0); rb[e] = (1.0f + eb1) * __builtin_amdgcn_rcpf(1.0f + ea1);
                        sa[e] = __builtin_amdgcn_rcpf(1.0f + eb0); sb[e] = __builtin_amdgcn_rcpf(1.0f + eb1); }
                    *(u32x4*)(SG + (size_t)r * 2048 + (pn - 24) * 128 + colw) = pack8(ra, rb);
                    *(u32x4*)(SG + (size_t)r * 2048 + 1024 + (pn - 24) * 128 + colw) = pack8(sa, sb);
                }
            }
    }
};
struct Epi4 {
    static constexpr bool PERM = true, AFTER_DRAIN = false;
    bf16_t* MG; const bf16_t* SG;
    static __device__ __forceinline__ bool keep_acc(const Unit& u) { return u.sel == 0; }
    __device__ __forceinline__ void operator()(f32x4 (&acc)[2][2][4][2], const Unit& u, int wr, int wc, int fr, int fq) const {
        const int row0 = u.pm * BM + wr * 64 + fr, col0 = u.pn * BM + wc * 32 + 8 * fq;
#pragma unroll
        for (int ai = 0; ai < 2; ++ai)
#pragma unroll
            for (int m = 0; m < 4; ++m) { const int r = row0 + ai * HALF + m * 16;
#pragma unroll
                for (int bj = 0; bj < 2; ++bj) { const int c = col0 + bj * HALF;
                    const u32x4 g = *(const u32x4*)(SG + (size_t)r * 2048 + u.sel * 1024 + c);
                    f32x4 a = acc[ai][bj][m][0], b = acc[ai][bj][m][1];
                    a[0] *= bf_lo(g.x); a[1] *= bf_hi(g.x); a[2] *= bf_lo(g.y); a[3] *= bf_hi(g.y); b[0] *= bf_lo(g.z); b[1] *= bf_hi(g.z); b[2] *= bf_lo(g.w); b[3] *= bf_hi(g.w);
                    if (u.sel) *(u32x4*)(MG + (size_t)r * 1024 + c) = pack8(a, b);
                    else { acc[ai][bj][m][0] = a; acc[ai][bj][m][1] = b; } } }
    }
};
struct Epi5 {
    static constexpr bool PERM = true, AFTER_DRAIN = false;
    static __device__ __forceinline__ bool keep_acc(const Unit&) { return false; }
    const float* X; float* OUT; bf16_t* HB; float* rowss;
    __device__ __forceinline__ void operator()(f32x4 (&acc)[2][2][4][2], const Unit& u, int wr, int wc, int fr, int fq) const {
        const int row0 = u.pm * BM + wr * 64 + fr, col0 = u.pn * BM + wc * 32 + 8 * fq;
#pragma unroll
        for (int ai = 0; ai < 2; ++ai)
#pragma unroll
            for (int m = 0; m < 4; ++m) { const int r = row0 + ai * HALF + m * 16; float ss = 0.f;
#pragma unroll
                for (int bj = 0; bj < 2; ++bj) { const size_t o = (size_t)r * 1024 + col0 + bj * HALF;
                    const f32x4 a = acc[ai][bj][m][0] + *(const f32x4*)(X + o), b = acc[ai][bj][m][1] + *(const f32x4*)(X + o + 4);
                    *(u32x4*)(HB + o) = pack8(a, b);
                    ss += (a[0] * a[0] + a[1] * a[1]) + (a[2] * a[2] + a[3] * a[3]) + (b[0] * b[0] + b[1] * b[1]) + (b[2] * b[2] + b[3] * b[3]); }
                ss += __shfl_xor(ss, 16); ss += __shfl_xor(ss, 32);
                if (fq == 0) atomicAdd(rowss + r, ss); }
    }
};
struct Epi6 {
    static constexpr bool PERM = true, AFTER_DRAIN = false;
    static __device__ __forceinline__ bool keep_acc(const Unit&) { return false; }
    bf16_t* ACT; const float* rowss; const float* cw; const float* cb; PG8_LAS float* halo;
    __device__ __forceinline__ void operator()(f32x4 (&acc)[2][2][4][2], const Unit& u, int wr, int wc, int fr, int fq) const {
        const int r0 = u.pm * 254 - 2, colw = wc * 32 + 8 * fq;
#pragma unroll
        for (int ai = 0; ai < 2; ++ai)
#pragma unroll
            for (int m = 0; m < 4; ++m) { int gr = r0 + ai * HALF + wr * 64 + m * 16 + fr; gr = gr < 0 ? 0 : (gr > MROWS - 1 ? MROWS - 1 : gr);
                const float rs = rsqrtf(rowss[gr] * (1.0f / 1024.0f) + 1e-6f);
#pragma unroll
                for (int bj = 0; bj < 2; ++bj)
#pragma unroll
                    for (int n = 0; n < 2; ++n) acc[ai][bj][m][n] *= rs; }
        if (fr >= 14) {
#pragma unroll
            for (int ai = 0; ai < 2; ++ai)
#pragma unroll
                for (int bj = 0; bj < 2; ++bj)
#pragma unroll
                    for (int n = 0; n < 2; ++n) *(PG8_LAS f32x4*)(halo + (((2 * ai + wr) * 2 + (fr - 14)) * 256 + bj * 128 + colw + 4 * n)) = acc[ai][bj][3][n];
        }
        f32x4 wn0, wn1, wn2, wnb;
        { const int col = u.pn * 128 + colw; wn0 = *(const f32x4*)(cw + col); wn1 = *(const f32x4*)(cw + 2 * DFF_ + col); wn2 = *(const f32x4*)(cw + 4 * DFF_ + col); wnb = *(const f32x4*)(cb + col); }
        asm volatile("s_waitcnt lgkmcnt(0)" ::: "memory"); __builtin_amdgcn_s_barrier(); asm volatile("" ::: "memory");
#pragma unroll
        for (int bj = 0; bj < 2; ++bj)
#pragma unroll
            for (int n = 0; n < 2; ++n) {
                const f32x4 w0 = wn0, w1 = wn1, w2 = wn2, bb = wnb;
                if (bj * 2 + n < 3) { const int k2 = bj * 2 + n + 1, col = (k2 >> 1) * DFF_ + u.pn * 128 + colw + 4 * (k2 & 1);
                    wn0 = *(const f32x4*)(cw + col); wn1 = *(const f32x4*)(cw + 2 * DFF_ + col); wn2 = *(const f32x4*)(cw + 4 * DFF_ + col); wnb = *(const f32x4*)(cb + col); }
#pragma unroll
                for (int ai = 0; ai < 2; ++ai) {
                    const int s = 2 * ai + wr;
                    const int sm = s > 0 ? s - 1 : 0; const float hz = s > 0 ? 1.0f : 0.0f;
                    const f32x4 h2 = *(const PG8_LAS f32x4*)(halo + ((sm * 2 + 0) * 256 + bj * 128 + colw + 4 * n)) * hz, h1 = *(const PG8_LAS f32x4*)(halo + ((sm * 2 + 1) * 256 + bj * 128 + colw + 4 * n)) * hz;
#pragma unroll
                    for (int mm = 0; mm < 4; ++mm) { const int m = 3 - mm;
                        f32x4 cur = acc[ai][bj][m][n]; asm volatile("" : "+v"(cur)); f32x4 p1, p2;
                        if (m > 0) { f32x4 lo = acc[ai][bj][m > 0 ? m - 1 : 0][n]; asm volatile("" : "+v"(lo));
#pragma unroll
                            for (int e = 0; e < 4; ++e) { p1[e] = dpp_shr<0x111>(dpp_ror<0x121>(lo[e]), cur[e]); p2[e] = dpp_shr<0x112>(dpp_ror<0x122>(lo[e]), cur[e]); } }
                        else {
#pragma unroll
                            for (int e = 0; e < 4; ++e) { p1[e] = dpp_shr<0x111>(h1[e], cur[e]); p2[e] = dpp_shr<0x112>(fr == 0 ? h2[e] : h1[e], cur[e]); } }
                        { f32x4 r_ = w0 * p2 + w1 * p1 + w2 * cur + bb; asm volatile("" : "+v"(r_)); acc[ai][bj][m][n] = r_; } }
                }
            }
#pragma unroll
        for (int ai = 0; ai < 2; ++ai)
#pragma unroll
            for (int m = 0; m < 4; ++m) { const int i = ai * HALF + wr * 64 + m * 16 + fr, gr = r0 + i;
                f32x4 a, b;
#pragma unroll
                for (int e = 0; e < 4; ++e) { const float g0 = acc[ai][0][m][0][e], g1 = acc[ai][0][m][1][e];
                    a[e] = g0 * fast_sigmoid(g0) * acc[ai][1][m][0][e]; b[e] = g1 * fast_sigmoid(g1) * acc[ai][1][m][1][e]; }
                if (i >= 2 && gr < MROWS) *(u32x4*)(ACT + (size_t)gr * DFF_ + u.pn * 128 + colw) = pack8(a, b); }
    }
};
struct Epi7 {
    static constexpr bool PERM = true, AFTER_DRAIN = false;
    static __device__ __forceinline__ bool keep_acc(const Unit&) { return false; }
    float* OUT; const bf16_t* HB;
    __device__ __forceinline__ void operator()(f32x4 (&acc)[2][2][4][2], const Unit& u, int wr, int wc, int fr, int fq) const {
        const int row0 = u.pm * BM + wr * 64 + fr, col0 = u.pn * BM + wc * 32 + 8 * fq;
#pragma unroll
        for (int ai = 0; ai < 2; ++ai)
#pragma unroll
            for (int m = 0; m < 4; ++m) { const int r = row0 + ai * HALF + m * 16;
#pragma unroll
                for (int bj = 0; bj < 2; ++bj) { const size_t o = (size_t)r * 1024 + col0 + bj * HALF; float* p = OUT + o; const u32x4 hw = *(const u32x4*)(HB + o);
                    f32x4 a = acc[ai][bj][m][0], b = acc[ai][bj][m][1];
                    a[0] += bf_lo(hw.x); a[1] += bf_hi(hw.x); a[2] += bf_lo(hw.y); a[3] += bf_hi(hw.y); b[0] += bf_lo(hw.z); b[1] += bf_hi(hw.z); b[2] += bf_lo(hw.w); b[3] += bf_hi(hw.w);
                    *(f32x4*)p = a; *(f32x4*)(p + 4) = b; } }
    }
};
template <class Epi, class Sched, bool ALIGN_EPI = false, bool SP2 = false>
__device__ __forceinline__ void gemm_phase(PG8_LAS unsigned char* lds, const Gemm g, const Sched& S, const Epi& E) {
    const int tid = threadIdx.x, wid = __builtin_amdgcn_readfirstlane(tid >> 6), lane = tid & 63, wr = wid >> 2, wc = wid & 3, fr = lane & 15, fq = lane >> 4;
    const int K = g.K, nt = K / BK;
    unsigned voffA[2], voffB[2];
#pragma unroll
    for (int i = 0; i < 2; ++i) { int R, C; stage_rc(tid * 16 + i * 8192, R, C); const int Rb = Epi::PERM ? ((R & ~31) + perm32(R & 31)) : R;
        voffA[i] = (unsigned)(R * K + C) * 2u; voffB[i] = (unsigned)(Rb * K + C) * 2u; }
    const size_t kstep = (size_t)(BK * 2);
    const size_t hstep = (size_t)HALF * K * 2;
    const size_t tstep = 2 * hstep;
    const unsigned ldsw = (unsigned)wid * 1024u;
    const int aoff = lds_byte(wr * 64 + fr, fq * 8), boff = lds_byte(wc * 32 + fr, fq * 8);
#define PG8_SA(b, h) (((b) * 2 + (h)) * HTB)
#define PG8_SB(b, h) ((4 + (b) * 2 + (h)) * HTB)
#define PG8_STAGE(bufoff, gbase, voff) do { _Pragma("unroll") for (int _i = 0; _i < 2; ++_i) \
        __builtin_amdgcn_global_load_lds((const unsigned*)((const char*)(gbase) + (voff)[_i]), (PG8_LAS unsigned*)(lds + (bufoff) + ldsw + _i * 8192), 16, 0, 0); } while (0)
#define PG8_LDA(dst, b, h) do { _Pragma("unroll") for (int m = 0; m < 4; ++m) _Pragma("unroll") for (int k = 0; k < 2; ++k) dst[m][k] = *(const PG8_LAS bf16x8*)(lds + PG8_SA(b, h) + aoff + m * 2048 + k * 1024); } while (0)
#define PG8_LDB(dst, b, h) do { _Pragma("unroll") for (int n = 0; n < 2; ++n) _Pragma("unroll") for (int k = 0; k < 2; ++k) dst[n][k] = *(const PG8_LAS bf16x8*)(lds + PG8_SB(b, h) + boff + n * 2048 + k * 1024); } while (0)
#define PG8_MMA(ai, bj, At, Bt) do { __builtin_amdgcn_s_setprio(1); _Pragma("unroll") for (int m = 0; m < 4; ++m) _Pragma("unroll") for (int n = 0; n < 2; ++n) _Pragma("unroll") for (int k = 0; k < 2; ++k) \
        acc[ai][bj][m][n] = __builtin_amdgcn_mfma_f32_16x16x32_bf16(Bt[n][k], At[m][k], acc[ai][bj][m][n], 0, 0, 0); __builtin_amdgcn_s_setprio(0); } while (0)
#define PG8_WAIT_V(n) asm volatile("s_waitcnt vmcnt(" #n ")" ::: "memory")
#define PG8_WAIT_L(n) asm volatile("s_waitcnt lgkmcnt(" #n ")" ::: "memory")
#define PG8_BAR __builtin_amdgcn_s_barrier()
#define PG8_SCHED __builtin_amdgcn_sched_barrier(0)
    Unit cur, nxt; int ui = 0;
    if (!S.next(0, cur)) return;
    f32x4 acc[2][2][4][2];
#pragma unroll
    for (int a = 0; a < 2; ++a)
#pragma unroll
        for (int b = 0; b < 2; ++b)
#pragma unroll
            for (int m = 0; m < 4; ++m)
#pragma unroll
                for (int n = 0; n < 2; ++n) acc[a][b][m][n] = (f32x4){0.f, 0.f, 0.f, 0.f};
    bf16x8 At[4][2], B0[2][2], B1[2][2];
    const char* cA = (const char*)(cur.sel ? g.A1 : g.A0) + (size_t)cur.pm * g.a_tstep; const char* cB = (const char*)(cur.sel ? g.B1 : g.B0) + (size_t)cur.pn * tstep;
    S.a_ready(cur);
    if constexpr (SP2) {
        PG8_STAGE(PG8_SB(0, 0), cB, voffB); PG8_STAGE(PG8_SB(0, 1), cB + hstep, voffB); PG8_STAGE(PG8_SA(0, 0), cA, voffA); PG8_STAGE(PG8_SA(0, 1), cA + hstep, voffA);
        if (wr == 1) PG8_BAR;
        PG8_WAIT_V(2); PG8_BAR;
        PG8_STAGE(PG8_SB(1, 0), cB + kstep, voffB); PG8_STAGE(PG8_SA(1, 0), cA + kstep, voffA); PG8_STAGE(PG8_SB(1, 1), cB + hstep + kstep, voffB);
        PG8_WAIT_V(6); PG8_BAR;
    } else {
        PG8_STAGE(PG8_SB(0, 0), cB, voffB); PG8_STAGE(PG8_SA(0, 0), cA, voffA); PG8_STAGE(PG8_SB(0, 1), cB + hstep, voffB); PG8_STAGE(PG8_SA(0, 1), cA + hstep, voffA);
        if (wr == 1) PG8_BAR;
        PG8_WAIT_V(4); PG8_BAR;
        PG8_STAGE(PG8_SB(1, 0), cB + kstep, voffB); PG8_STAGE(PG8_SA(1, 0), cA + kstep, voffA); PG8_STAGE(PG8_SB(1, 1), cB + hstep + kstep, voffB);
        PG8_WAIT_V(6); PG8_BAR;
    }
    for (;;) {
        const bool has_next = S.next(ui + 1, nxt);
        const char* nA = has_next ? (const char*)(nxt.sel ? g.A1 : g.A0) + (size_t)nxt.pm * g.a_tstep : cA; const char* nB = has_next ? (const char*)(nxt.sel ? g.B1 : g.B0) + (size_t)nxt.pn * tstep : cB;
        for (int t = 0; t < nt; t += 2) {
            const bool last = (t == nt - 2);
            const char* a1 = cA + (size_t)(t + 1) * kstep;
            const char* a2 = last ? nA : cA + (size_t)(t + 2) * kstep; const char* b2 = last ? nB : cB + (size_t)(t + 2) * kstep;
            const char* a3 = a2 + kstep; const char* b3 = b2 + kstep;
            if (last && has_next) S.a_ready(nxt);
            if constexpr (SP2) {
            PG8_LDB(B0, 0, 0); PG8_LDB(B1, 0, 1); PG8_SCHED; PG8_LDA(At, 0, 0); PG8_STAGE(PG8_SA(1, 1), a1 + hstep, voffA);
            PG8_WAIT_V(8); PG8_WAIT_L(0); PG8_BAR; PG8_MMA(0, 0, At, B0); PG8_MMA(0, 1, At, B1); PG8_BAR; PG8_SCHED;
            PG8_LDA(At, 0, 1); PG8_STAGE(PG8_SB(0, 0), b2, voffB); PG8_STAGE(PG8_SB(0, 1), b2 + hstep, voffB); PG8_STAGE(PG8_SA(0, 0), a2, voffA);
            PG8_WAIT_V(8); PG8_WAIT_L(0); PG8_BAR; PG8_MMA(1, 0, At, B0); PG8_MMA(1, 1, At, B1); PG8_BAR; PG8_SCHED;
            PG8_LDB(B0, 1, 0); PG8_LDB(B1, 1, 1); PG8_SCHED; PG8_LDA(At, 1, 0); PG8_STAGE(PG8_SA(0, 1), a2 + hstep, voffA);
            PG8_WAIT_V(8); PG8_WAIT_L(0); PG8_BAR; PG8_MMA(0, 0, At, B0); PG8_MMA(0, 1, At, B1); PG8_BAR; PG8_SCHED;
            PG8_LDA(At, 1, 1); PG8_STAGE(PG8_SB(1, 0), b3, voffB); PG8_STAGE(PG8_SB(1, 1), b3 + hstep, voffB); PG8_STAGE(PG8_SA(1, 0), a3, voffA);
            PG8_WAIT_V(8); PG8_WAIT_L(0); PG8_BAR; PG8_MMA(1, 0, At, B0); PG8_MMA(1, 1, At, B1); PG8_BAR; PG8_SCHED;
            } else {
            PG8_LDB(B0, 0, 0); PG8_SCHED; PG8_LDA(At, 0, 0); PG8_STAGE(PG8_SA(1, 1), a1 + hstep, voffA);
            PG8_WAIT_L(8); PG8_BAR; PG8_WAIT_L(0); PG8_MMA(0, 0, At, B0); PG8_BAR; PG8_SCHED;
            PG8_LDB(B1, 0, 1); PG8_STAGE(PG8_SB(0, 0), b2, voffB);
            PG8_BAR; PG8_WAIT_L(0); PG8_MMA(0, 1, At, B1); PG8_BAR;
            PG8_LDA(At, 0, 1); PG8_STAGE(PG8_SA(0, 0), a2, voffA);
            PG8_BAR; PG8_WAIT_L(0); PG8_MMA(1, 0, At, B0); PG8_BAR; PG8_SCHED;
            PG8_STAGE(PG8_SB(0, 1), b2 + hstep, voffB);
            PG8_WAIT_V(6); PG8_BAR; PG8_MMA(1, 1, At, B1); PG8_BAR;
            PG8_LDB(B0, 1, 0); PG8_SCHED; PG8_LDA(At, 1, 0); PG8_STAGE(PG8_SA(0, 1), a2 + hstep, voffA);
            PG8_WAIT_L(8); PG8_BAR; PG8_WAIT_L(0); PG8_MMA(0, 0, At, B0); PG8_BAR; PG8_SCHED;
            PG8_LDB(B1, 1, 1); PG8_STAGE(PG8_SB(1, 0), b3, voffB);
            PG8_BAR; PG8_WAIT_L(0); PG8_MMA(0, 1, At, B1); PG8_BAR;
            PG8_LDA(At, 1, 1); PG8_STAGE(PG8_SA(1, 0), a3, voffA);
            PG8_BAR; PG8_WAIT_L(0); PG8_MMA(1, 0, At, B0); PG8_BAR; PG8_SCHED;
            PG8_STAGE(PG8_SB(1, 1), b3 + hstep, voffB);
            PG8_WAIT_V(6); PG8_BAR; PG8_MMA(1, 1, At, B1); PG8_BAR;
            }
        }
        if constexpr (ALIGN_EPI) { if (wr == 0) PG8_BAR; }
        if constexpr (!Epi::AFTER_DRAIN) { E(acc, cur, wr, wc, fr, fq); S.done(cur); }
        if (!has_next) break;
        if (!Epi::keep_acc(cur)) {
#pragma unroll
        for (int a = 0; a < 2; ++a)
#pragma unroll
            for (int b = 0; b < 2; ++b)
#pragma unroll
                for (int m = 0; m < 4; ++m)
#pragma unroll
                    for (int n = 0; n < 2; ++n) acc[a][b][m][n] = (f32x4){0.f, 0.f, 0.f, 0.f}; }
        cur = nxt; cA = nA; cB = nB; ++ui;
        if constexpr (ALIGN_EPI) { if (wr == 1) PG8_BAR; }
    }
    PG8_WAIT_V(0);
    if constexpr (!ALIGN_EPI) { if (wr == 0) PG8_BAR; }
    PG8_BAR;
    if constexpr (Epi::AFTER_DRAIN) { E.fused(acc, cur, wr, wc, fr, fq, lds, wid, lane); S.done(cur); }
#undef PG8_SA
#undef PG8_SB
#undef PG8_STAGE
#undef PG8_LDA
#undef PG8_LDB
#undef PG8_MMA
#undef PG8_WAIT_V
#undef PG8_WAIT_L
#undef PG8_BAR
#undef PG8_SCHED
}
}
#define GAS __attribute__((address_space(1)))
#define LAS __attribute__((address_space(3)))
typedef unsigned short bf16;
typedef unsigned v4u __attribute__((ext_vector_type(4)));
typedef float f32x4 __attribute__((ext_vector_type(4)));
typedef short bf16x8 __attribute__((ext_vector_type(8)));
typedef GAS unsigned gu32;
typedef GAS unsigned long long gu64;
#define RLX_AGENT __ATOMIC_RELAXED, __HIP_MEMORY_SCOPE_AGENT
#define LDS_WAIT() asm volatile("s_waitcnt lgkmcnt(0)" ::: "memory")
#define VM_WAIT() asm volatile("s_waitcnt vmcnt(0)" ::: "memory")
__device__ __forceinline__ unsigned long long rt() { return __builtin_amdgcn_s_memrealtime(); }
__device__ __forceinline__ unsigned f2bf(float f) { unsigned u = __builtin_bit_cast(unsigned, f); return (u + 0x7fffu + ((u >> 16) & 1u)) >> 16; }
__device__ __forceinline__ unsigned pk2(float lo, float hi) { return f2bf(lo) | (f2bf(hi) << 16); }

#define XB_TMO      128
#define XB_XCNT(j)  (256  + 64 * (j))
#define XB_XSUB(j)  (1280 + 64 * (j))
#define XB_XGEN(j)  (2304 + 64 * (j))
#define XB_TOP      3328
#define XB_TOPGEN   3392
#define XCD_BAR_WORDS 3456
#define XB_SPIN_CAP (1u << 18)

__device__ __forceinline__ unsigned xb_ld(unsigned* p)              { return __hip_atomic_load(p, __ATOMIC_RELAXED, __HIP_MEMORY_SCOPE_AGENT); }
__device__ __forceinline__ unsigned xb_add(unsigned* p, unsigned v) { return __hip_atomic_fetch_add(p, v, __ATOMIC_RELAXED, __HIP_MEMORY_SCOPE_AGENT); }
__device__ __forceinline__ unsigned xb_xcc_id() { return (unsigned)__builtin_amdgcn_s_getreg((3 << 11) | 20) & 0xFu; }
#define XB_SPIN(cond, bar) do { unsigned _sp = 0; while (cond) { __builtin_amdgcn_s_sleep(1); \
    if ((++_sp & 255u) == 0u) { if (xb_ld(&(bar)[XB_TMO])) break; if (_sp > XB_SPIN_CAP) { atomicAdd(&(bar)[XB_TMO], 1u); break; } } } } while (0)

struct XcdBarrier {
    unsigned* bar; unsigned x;
    volatile LAS unsigned* st;
};

__device__ __forceinline__ XcdBarrier xcd_barrier_post(unsigned* bar, volatile LAS unsigned* st) {
    XcdBarrier b; b.bar = bar; b.x = xb_xcc_id(); b.st = st;
    if (threadIdx.x == 0) (void)xb_add(&bar[XB_XCNT(b.x)], 1u);
    return b;
}
__device__ __forceinline__ void xcd_barrier_complete(unsigned* bar, unsigned x, unsigned& nloc, unsigned& nx) {
    const unsigned G = gridDim.x * gridDim.y * gridDim.z;
    unsigned sum, cnt, mine, sp = 0u;
    for (;;) {
        sum = 0u; cnt = 0u; mine = 0u;
#pragma unroll
        for (unsigned j = 0; j < 16; ++j) { const unsigned c = xb_ld(&bar[XB_XCNT(j)]); sum += c; cnt += (c > 0u) ? 1u : 0u; mine = (j == x) ? c : mine; }
        if (sum == G) break;
        __builtin_amdgcn_s_sleep(1);
        if ((++sp & 255u) == 0u) { if (xb_ld(&bar[XB_TMO])) break; if (sp > XB_SPIN_CAP) { atomicAdd(&bar[XB_TMO], 1u); break; } }
    }
    nloc = mine > 0u ? mine : 1u; nx = cnt > 0u ? cnt : 1u;
}

__device__ __forceinline__ void xcd_barrier(const XcdBarrier& b) {
    asm volatile("s_waitcnt vmcnt(0)" ::: "memory");
    __syncthreads();
    if (threadIdx.x == 0) {
        unsigned* bar = b.bar;
        __builtin_amdgcn_s_waitcnt(0);
        unsigned nloc = b.st[0], nx = b.st[1];
        if (nloc == 0u) { xcd_barrier_complete(bar, b.x, nloc, nx); b.st[0] = nloc; b.st[1] = nx; }
        const unsigned old = xb_add(&bar[XB_XSUB(b.x)], 1u);
        const unsigned gen = old / nloc;
        if (old + 1u == (gen + 1u) * nloc) {
            __builtin_amdgcn_fence(__ATOMIC_RELEASE, "agent");
            asm volatile("s_waitcnt vmcnt(0)" ::: "memory");
            const unsigned og = xb_add(&bar[XB_TOP], 1u);
            const unsigned tg = og / nx;
            if (og + 1u == (tg + 1u) * nx) xb_add(&bar[XB_TOPGEN], 1u);
            else XB_SPIN(xb_ld(&bar[XB_TOPGEN]) == tg, bar);
            __builtin_amdgcn_fence(__ATOMIC_ACQUIRE, "agent");
            xb_add(&bar[XB_XGEN(b.x)], 1u);
            asm volatile("s_waitcnt vmcnt(0)" ::: "memory");
        } else {
            XB_SPIN(xb_ld(&bar[XB_XGEN(b.x)]) == gen, bar);
            __builtin_amdgcn_fence(__ATOMIC_ACQUIRE, "agent");
            asm volatile("s_waitcnt vmcnt(0)" ::: "memory");
        }
    }
    __syncthreads();
}


constexpr int NWAVES = 8, NTHREADS = 512;
constexpr int M = 16384, D = 1024, NIN = 8192, DFF = 2816, NH = 8, HD = 128, NBLK = 64, BLK = 256;
constexpr float EPS = 1e-6f;
constexpr float C2 = 0.08838834764831845f * 1.4426950408889634f;
constexpr size_t MiB = 1u << 20;
constexpr size_t WS_CTL = 0, CTL_ZERO_BYTES = 256 * 1024;
constexpr int CW_BAR = 4096, CW_GCNT = 8192, CW_ROWSS = 16384;
constexpr size_t WS_KBAR = 1 * MiB, WS_RSTDX = 1 * MiB + 512 * 1024, WS_LPART = 2 * MiB;
constexpr size_t WS_WOA = 4 * MiB, WS_WOB = 6 * MiB, WS_WO = 8 * MiB;
constexpr size_t WS_Q = 10 * MiB, WS_K = 42 * MiB, WS_VT = 74 * MiB, WS_CA = 106 * MiB, WS_LIST = 138 * MiB, WS_WIN = 147 * MiB, WS_XB = 163 * MiB, WS_UU = 195 * MiB;
constexpr size_t WS_OPART = 147 * MiB;
constexpr size_t WS_WUP = 243 * MiB, WS_WDN = 138 * MiB, WS_MG = 165 * MiB, WS_HB = 198 * MiB;
constexpr size_t WS_ACT = 10 * MiB;
constexpr size_t WS_END = 256 * MiB;
constexpr int LDS_BYTES = 163840, MISC_OFF = 131072 + 320, HALO_OFF = 131072 + 1024, SCAN_OFF = 131072 + 1024;
__device__ __forceinline__ int list_off(int n) { return 256 * (63 * n - (n * (n - 1)) / 2); }
constexpr int LIST_PER_HEAD = 256 * 2016;

__device__ __forceinline__ float wave_sum(float v) {
#pragma unroll
    for (int o = 1; o < 64; o <<= 1) v += __shfl_xor(v, o);
    return v;
}
__device__ __forceinline__ void transpose_item(const float* W, int N, bf16* WT, int K, int k0, int col0, int row0, const float* ks, LAS float* scr, int lane) {
#pragma unroll 8
    for (int i = 0; i < 32; ++i) { const int kk = 2 * i + (lane >> 5); const float s = ks ? ks[k0 + kk] : 1.0f; scr[kk * 33 + (lane & 31)] = s * W[(size_t)(k0 + kk) * N + col0 + (lane & 31)]; }
    LDS_WAIT(); asm volatile("" ::: "memory");
    const int c = lane & 7;
#pragma unroll
    for (int j = 0; j < 4; ++j) { const int n = (lane >> 3) + 8 * j; const LAS float* s = scr + (8 * c) * 33 + n;
        v4u o; o.x = pk2(s[0 * 33], s[1 * 33]); o.y = pk2(s[2 * 33], s[3 * 33]); o.z = pk2(s[4 * 33], s[5 * 33]); o.w = pk2(s[6 * 33], s[7 * 33]);
        *(GAS v4u*)(WT + (size_t)(row0 + n) * K + k0 + 8 * c) = o; }
    LDS_WAIT(); asm volatile("" ::: "memory");
}
__device__ __forceinline__ int map_col(int mode, int R) {
    if (mode == 1) { if (R >= 1024 && R < 3072) { const int q = R - 1024; return 1024 + ((q >> 7) & 1) * 1024 + (q >> 8) * 128 + (q & 127); }
                     if (R >= 6144) { const int q = R - 6144; return 6144 + ((q >> 7) & 1) * 1024 + (q >> 8) * 128 + (q & 127); } return R; }
    if (mode == 2) return ((R >> 7) & 1) * DFF + (R >> 8) * 128 + (R & 127);
    return R;
}
__device__ __forceinline__ void convert_weight(const float* W, int K, int N, bf16* WT, const float* ks, int mode, LAS float* scr, int gw, int NGW, int lane) {
    const int nblk = N / 32, nitems = (K / 64) * nblk;
    for (int it = gw; it < nitems; it += NGW) { const int kb = it / nblk, nb = it % nblk; transpose_item(W, N, WT, K, 64 * kb, map_col(mode, 32 * nb), 32 * nb, ks, scr, lane); }
}

__device__ __forceinline__ void phase0(const float* x, const float* norm_mix, const float* w_in, const float* w_oa, const float* w_ob, const float* w_o, const float* w_up, const float* norm_ffn, unsigned char* ws, LAS unsigned char* lds, int vcu, int G, int wave, int lane) {
    LAS float* scr = (LAS float*)(lds + wave * 16384);
    const int gw = vcu * NWAVES + wave, NGW = G * NWAVES;
    convert_weight(w_in, D, NIN, (bf16*)(ws + WS_WIN), norm_mix, 1, scr, gw, NGW, lane);
    convert_weight(w_oa, D, D, (bf16*)(ws + WS_WOA), nullptr, 0, scr, gw, NGW, lane);
    convert_weight(w_ob, D, D, (bf16*)(ws + WS_WOB), nullptr, 0, scr, gw, NGW, lane);
    convert_weight(w_o, D, D, (bf16*)(ws + WS_WO), nullptr, 0, scr, gw, NGW, lane);
    convert_weight(w_up, D, 2 * DFF, (bf16*)(ws + WS_WUP), norm_ffn, 2, scr, gw, NGW, lane);
    bf16* XB = (bf16*)(ws + WS_XB); float* rstdx = (float*)(ws + WS_RSTDX);
    for (int m = gw; m < M; m += NGW) {
        const GAS f32x4* xr = (const GAS f32x4*)(x + (size_t)m * D) + lane; f32x4 v[4]; float s = 0.f;
#pragma unroll
        for (int j = 0; j < 4; ++j) { v[j] = xr[64 * j]; s += (v[j].x * v[j].x + v[j].y * v[j].y) + (v[j].z * v[j].z + v[j].w * v[j].w); }
        s = wave_sum(s); if (lane == 0) rstdx[m] = rsqrtf(s * (1.f / D) + EPS);
        GAS unsigned long long* o8 = (GAS unsigned long long*)(XB + (size_t)m * D) + lane;
#pragma unroll
        for (int j = 0; j < 4; ++j) o8[64 * j] = (unsigned long long)pk2(v[j].x, v[j].y) | ((unsigned long long)pk2(v[j].z, v[j].w) << 32);
    }
}
__device__ __forceinline__ void phase2(const float* conv_a_w, unsigned char* ws, int G, int tid, bf16* __restrict__ CAout) {
    const bf16* __restrict__ BG = (const bf16*)(ws + WS_CA); const bf16* __restrict__ UU = (const bf16*)(ws + WS_UU);
    for (int item = blockIdx.x * NTHREADS + tid; item < 128 * (M / 16); item += G * NTHREADS) {
        const int cc = (item & 127) * 8, t0 = (item >> 7) * 16;
        float w0[8], w1[8], w2[8], um2[8], um1[8];
#pragma unroll
        for (int j = 0; j < 2; ++j) { const f32x4 a = *(const GAS f32x4*)(conv_a_w + cc + 4 * j), b = *(const GAS f32x4*)(conv_a_w + 1024 + cc + 4 * j), c = *(const GAS f32x4*)(conv_a_w + 2048 + cc + 4 * j);
#pragma unroll
            for (int e = 0; e < 4; ++e) { w0[4 * j + e] = a[e]; w1[4 * j + e] = b[e]; w2[4 * j + e] = c[e]; } }
        { v4u a = (v4u){0u, 0u, 0u, 0u}, b = a; if (t0 >= 2) { a = *(const GAS v4u*)(UU + (size_t)(t0 - 2) * 1024 + cc); b = *(const GAS v4u*)(UU + (size_t)(t0 - 1) * 1024 + cc); }
          const unsigned aw[4] = {a.x, a.y, a.z, a.w}, bw[4] = {b.x, b.y, b.z, b.w};
#pragma unroll
          for (int j = 0; j < 4; ++j) { um2[2 * j] = pg8::bf_lo(aw[j]); um2[2 * j + 1] = pg8::bf_hi(aw[j]); um1[2 * j] = pg8::bf_lo(bw[j]); um1[2 * j + 1] = pg8::bf_hi(bw[j]); } }
#pragma unroll 4
        for (int i = 0; i < 16; ++i) { const size_t o = (size_t)(t0 + i) * 1024 + cc;
            const v4u u = *(const GAS v4u*)(UU + o), b = *(const GAS v4u*)(BG + o); const unsigned uw[4] = {u.x, u.y, u.z, u.w}, bw[4] = {b.x, b.y, b.z, b.w};
            float r[8];
#pragma unroll
            for (int j = 0; j < 4; ++j) { const float u0 = pg8::bf_lo(uw[j]), u1 = pg8::bf_hi(uw[j]);
                r[2 * j] = pg8::bf_lo(bw[j]) * (w0[2 * j] * um2[2 * j] + w1[2 * j] * um1[2 * j] + w2[2 * j] * u0);
                r[2 * j + 1] = pg8::bf_hi(bw[j]) * (w0[2 * j + 1] * um2[2 * j + 1] + w1[2 * j + 1] * um1[2 * j + 1] + w2[2 * j + 1] * u1);
                um2[2 * j] = um1[2 * j]; um2[2 * j + 1] = um1[2 * j + 1]; um1[2 * j] = u0; um1[2 * j + 1] = u1; }
            v4u o4; o4.x = pk2(r[0], r[1]); o4.y = pk2(r[2], r[3]); o4.z = pk2(r[4], r[5]); o4.w = pk2(r[6], r[7]);
            *(GAS v4u*)(CAout + o) = o4; }
    }
}
__device__ __forceinline__ bool top_better(float v, int n, float cv, int cn) { return v > cv || (v == cv && n < cn); }
__device__ __forceinline__ void top3_insert(float v, int n, float (&tv)[3], int (&ti)[3]) {
    if (top_better(v, n, tv[0], ti[0])) { tv[2] = tv[1]; ti[2] = ti[1]; tv[1] = tv[0]; ti[1] = ti[0]; tv[0] = v; ti[0] = n; }
    else if (top_better(v, n, tv[1], ti[1])) { tv[2] = tv[1]; ti[2] = ti[1]; tv[1] = v; ti[1] = n; }
    else if (top_better(v, n, tv[2], ti[2])) { tv[2] = v; ti[2] = n; }
}
__device__ __forceinline__ void phase2d(unsigned char* ws, LAS unsigned char* lds, int G, int tid, int wave, int lane, unsigned* gcnt, unsigned short* glist) {
    LAS unsigned* lcnt = (LAS unsigned*)(lds + 32768); LAS unsigned* lbase = lcnt + 64; LAS unsigned short* llist = (LAS unsigned short*)lds;
    const bf16* Q = (const bf16*)(ws + WS_Q); const float* kbar = (const float*)(ws + WS_KBAR);
    const int fr = lane & 15, fq = lane >> 4;
    for (int unit = blockIdx.x; unit < NH * 63; unit += G) {
        const int h = unit / 63, c = 1 + unit % 63;
        if (tid < 64) lcnt[tid] = 0u;
        __syncthreads();
        bf16x8 qf[2][4];
#pragma unroll
        for (int g = 0; g < 2; ++g)
#pragma unroll
            for (int ks = 0; ks < 4; ++ks) qf[g][ks] = *(const GAS bf16x8*)(Q + (size_t)(c * BLK + wave * 32 + g * 16 + fr) * 1024 + h * HD + ks * 32 + fq * 8);
        float tv[2][3]; int ti[2][3];
#pragma unroll
        for (int g = 0; g < 2; ++g)
#pragma unroll
            for (int j = 0; j < 3; ++j) { tv[g][j] = -__builtin_inff(); ti[g][j] = 1 << 20; }
        const int ntile = (c + 15) >> 4;
        for (int tile = 0; tile < ntile; ++tile) {
            f32x4 s0 = (f32x4){0.f, 0.f, 0.f, 0.f}, s1 = s0;
#pragma unroll
            for (int ks = 0; ks < 4; ++ks) {
                const float* kp = kbar + ((size_t)(h * NBLK + tile * 16 + fr) * HD + ks * 32 + fq * 8);
                const f32x4 a = *(const GAS f32x4*)kp, b = *(const GAS f32x4*)(kp + 4);
                const v4u hw = pg8::pack8(a, b);
                f32x4 ra, rb; ra[0] = a[0] - pg8::bf_lo(hw.x); ra[1] = a[1] - pg8::bf_hi(hw.x); ra[2] = a[2] - pg8::bf_lo(hw.y); ra[3] = a[3] - pg8::bf_hi(hw.y);
                rb[0] = b[0] - pg8::bf_lo(hw.z); rb[1] = b[1] - pg8::bf_hi(hw.z); rb[2] = b[2] - pg8::bf_lo(hw.w); rb[3] = b[3] - pg8::bf_hi(hw.w);
                const v4u lw = pg8::pack8(ra, rb);
                const bf16x8 hi = __builtin_bit_cast(bf16x8, hw), lo = __builtin_bit_cast(bf16x8, lw);
                s0 = __builtin_amdgcn_mfma_f32_16x16x32_bf16(hi, qf[0][ks], s0, 0, 0, 0); s0 = __builtin_amdgcn_mfma_f32_16x16x32_bf16(lo, qf[0][ks], s0, 0, 0, 0);
                s1 = __builtin_amdgcn_mfma_f32_16x16x32_bf16(hi, qf[1][ks], s1, 0, 0, 0); s1 = __builtin_amdgcn_mfma_f32_16x16x32_bf16(lo, qf[1][ks], s1, 0, 0, 0);
            }
#pragma unroll
            for (int i = 0; i < 4; ++i) { const int n = tile * 16 + 4 * fq + i;
                top3_insert(n < c ? s0[i] : -__builtin_inff(), n, tv[0], ti[0]); top3_insert(n < c ? s1[i] : -__builtin_inff(), n, tv[1], ti[1]); }
        }
#pragma unroll
        for (int off = 16; off <= 32; off <<= 1)
#pragma unroll
            for (int g = 0; g < 2; ++g) { float pv[3]; int pi[3];
#pragma unroll
                for (int j = 0; j < 3; ++j) { pv[j] = __shfl_xor(tv[g][j], off); pi[j] = __shfl_xor(ti[g][j], off); }
#pragma unroll
                for (int j = 0; j < 3; ++j) top3_insert(pv[j], pi[j], tv[g], ti[g]); }
        const int nsel = c < 3 ? c : 3;
        if (fq == 0) {
#pragma unroll
            for (int g = 0; g < 2; ++g) { const int tl = wave * 32 + g * 16 + fr;
#pragma unroll
                for (int j = 0; j < 3; ++j) if (j < nsel) { const int n = ti[g][j]; const unsigned pp = __hip_atomic_fetch_add(&lcnt[n], 1u, __ATOMIC_RELAXED, __HIP_MEMORY_SCOPE_WORKGROUP); llist[n * 256 + pp] = (unsigned short)((tl << 2) | j); } }
        }
        __syncthreads();
        if (tid < c) { const unsigned k = lcnt[tid]; lbase[tid] = k ? atomicAdd(gcnt + h * NBLK + tid, k) : 0u; }
        __syncthreads();
        for (int n = wave; n < c; n += NWAVES) { const unsigned k = lcnt[n], base = lbase[n];
            unsigned short* dst = glist + (size_t)h * LIST_PER_HEAD + list_off(n) + base;
            for (unsigned i = lane; i < k; i += 64) { const unsigned e = llist[n * 256 + i]; dst[i] = (unsigned short)((((unsigned)c * BLK + (e >> 2)) << 2) | (e & 3u)); } }
        __syncthreads();
    }
}
__device__ __forceinline__ void stage_kv(const bf16* Kg, const bf16* Vt, int h, int n, LAS unsigned char* lds, int tid) {
#pragma unroll
    for (int i = 0; i < 8; ++i) { const int row = (tid >> 4) + 32 * i, ch = tid & 15;
        const v4u w = *(const GAS v4u*)(Kg + (size_t)(n * BLK + row) * 1024 + h * HD + ch * 8);
        const int sw = (((row >> 3) & 3) << 2) | (row & 3);
        *(LAS v4u*)(lds + row * 256 + ((ch ^ sw) << 4)) = w; }
#pragma unroll
    for (int i = 0; i < 8; ++i) { const int row = (tid >> 5) + 16 * i, ch = tid & 31;
        const v4u w = *(const GAS v4u*)(Vt + (size_t)(h * HD + row) * M + n * BLK + ch * 8);
        *(LAS v4u*)(lds + 65536 + row * 512 + ((ch ^ ((((row >> 4) & 3) << 2) | (row & 3))) << 4)) = w; }
}
template <bool CAUSAL, int MODE = 0>
__device__ __forceinline__ void attn_core(const LAS unsigned char* lds, const bf16* Q, int h, const int (&tq)[2], int wave, int fr, int fq, float B2, f32x4 (&O)[8][2], float (&l)[2]) {
    bf16x8 qf[2][4];
#pragma unroll
    for (int g = 0; g < 2; ++g)
#pragma unroll
        for (int ks = 0; ks < 4; ++ks) qf[g][ks] = *(const GAS bf16x8*)(Q + (size_t)tq[g] * 1024 + h * HD + ks * 32 + fq * 8);
#pragma unroll
    for (int dt = 0; dt < 8; ++dt) { O[dt][0] = (f32x4){0.f, 0.f, 0.f, 0.f}; O[dt][1] = O[dt][0]; }
    l[0] = 0.f; l[1] = 0.f;
    const int nch = CAUSAL ? wave + 1 : 8;
    const int krow = (fr >> 2) * 8 + (fr & 3);
    bf16x8 kf[4][2];
#pragma unroll
    for (int ks = 0; ks < 4; ++ks)
#pragma unroll
        for (int t = 0; t < 2; ++t) kf[ks][t] = *(const LAS bf16x8*)(lds + (krow + t * 4) * 256 + (((ks * 4 + fq) ^ fr) << 4));
#pragma unroll 2
    for (int c = 0; c < nch; ++c) {
        f32x4 s[2][2];
#pragma unroll
        for (int t = 0; t < 2; ++t) { s[t][0] = (f32x4){-B2, -B2, -B2, -B2}; s[t][1] = s[t][0]; }
        bf16x8 vf[8];
#pragma unroll
        for (int dt = 0; dt < 8; ++dt) vf[dt] = *(const LAS bf16x8*)(lds + 65536 + ((dt >> 2) * 64 + (fr >> 2) * 16 + (dt & 3) * 4 + (fr & 3)) * 512 + (((c * 4 + fq) ^ fr) << 4));
#pragma unroll
        for (int ks = 0; ks < 4; ++ks)
#pragma unroll
            for (int t = 0; t < 2; ++t) {
                if (MODE != 2 || ks == 0) {
                s[t][0] = __builtin_amdgcn_mfma_f32_16x16x32_bf16(kf[ks][t], qf[0][ks], s[t][0], 0, 0, 0);
                s[t][1] = __builtin_amdgcn_mfma_f32_16x16x32_bf16(kf[ks][t], qf[1][ks], s[t][1], 0, 0, 0); }
            }
        __builtin_amdgcn_sched_barrier(0);
        { const int cn = (c + 1 < nch) ? c + 1 : c;
#pragma unroll
          for (int ks = 0; ks < 4; ++ks)
#pragma unroll
              for (int t = 0; t < 2; ++t) kf[ks][t] = *(const LAS bf16x8*)(lds + (cn * 32 + krow + t * 4) * 256 + (((ks * 4 + fq) ^ fr) << 4)); }
        bf16x8 pf[2];
#pragma unroll
        for (int g = 0; g < 2; ++g) {
            float p[8];
#pragma unroll
            for (int t = 0; t < 2; ++t)
#pragma unroll
                for (int i = 0; i < 4; ++i) { float e = MODE == 1 ? s[t][g][i] : __builtin_amdgcn_exp2f(s[t][g][i]);
                    if (CAUSAL && c == wave) { const int kl = c * 32 + fq * 8 + t * 4 + i, ql = wave * 32 + g * 16 + fr; if (kl > ql) e = 0.f; }
                    p[t * 4 + i] = e; }
            l[g] += ((p[0] + p[1]) + (p[2] + p[3])) + ((p[4] + p[5]) + (p[6] + p[7]));
            v4u w; w.x = pg8::cvt_pk_bf16(p[0], p[1]); w.y = pg8::cvt_pk_bf16(p[2], p[3]); w.z = pg8::cvt_pk_bf16(p[4], p[5]); w.w = pg8::cvt_pk_bf16(p[6], p[7]);
            pf[g] = __builtin_bit_cast(bf16x8, w);
        }
#pragma unroll
        for (int dt = 0; dt < 8; ++dt) {
            if (MODE != 3 || dt == 0) {
            O[dt][0] = __builtin_amdgcn_mfma_f32_16x16x32_bf16(vf[dt], pf[0], O[dt][0], 0, 0, 0);
            O[dt][1] = __builtin_amdgcn_mfma_f32_16x16x32_bf16(vf[dt], pf[1], O[dt][1], 0, 0, 0); }
        }
    }
    l[0] += __shfl_xor(l[0], 16); l[0] += __shfl_xor(l[0], 32); l[1] += __shfl_xor(l[1], 16); l[1] += __shfl_xor(l[1], 32);
}
__device__ __forceinline__ float score_bound(const float* q_norm, const float* k_norm, int lane) {
    float a = fmaxf(fabsf(q_norm[lane]), fabsf(q_norm[lane + 64])), b = fmaxf(fabsf(k_norm[lane]), fabsf(k_norm[lane + 64]));
#pragma unroll
    for (int o = 1; o < 64; o <<= 1) { a = fmaxf(a, __shfl_xor(a, o)); b = fmaxf(b, __shfl_xor(b, o)); }
    return 128.0f * a * b * C2 * 1.001f + 0.01f;
}
template <int MODE>
__device__ __forceinline__ void phase3a(const float* q_norm, const float* k_norm, unsigned char* ws, LAS unsigned char* lds, int G, int tid, int wave, int lane) {
    const int fr = lane & 15, fq = lane >> 4;
    LAS int* pre = (LAS int*)(lds + SCAN_OFF);
    LAS int* cntl = (LAS int*)(lds + SCAN_OFF + 2080);
    const unsigned* gcnt = (const unsigned*)(ws + WS_CTL) + CW_GCNT; const unsigned short* glist = (const unsigned short*)(ws + WS_LIST);
    const bf16* Q = (const bf16*)(ws + WS_Q); const bf16* Kg = (const bf16*)(ws + WS_K); const bf16* Vt = (const bf16*)(ws + WS_VT);
    unsigned char* OP = ws + WS_OPART; float* LP = (float*)(ws + WS_LPART);
    const float B2 = score_bound(q_norm, k_norm, lane);
    { const int cnt = (int)__hip_atomic_load(gcnt + tid, __ATOMIC_RELAXED, __HIP_MEMORY_SCOPE_AGENT); pre[tid + 1] = (cnt + 255) >> 8; cntl[tid] = cnt; if (tid == 0) pre[0] = 0; }
    __syncthreads();
    for (int o = 1; o < 512; o <<= 1) { const int v = pre[tid + 1] + ((tid + 1 - o) >= 1 ? pre[tid + 1 - o] : 0); __syncthreads(); pre[tid + 1] = v; __syncthreads(); }
    const int T = pre[512];
    const int i_lo = (int)(((long)blockIdx.x * T) / G), i_hi = (int)(((long)(blockIdx.x + 1) * T) / G);
    int staged = -1;
#define P3A_DECODE(IT, HN, TILE) do { int lo_ = 0, hi_ = 511; while (lo_ < hi_) { const int mid_ = (lo_ + hi_ + 1) >> 1; if (pre[mid_] <= (IT)) lo_ = mid_; else hi_ = mid_ - 1; } HN = lo_; TILE = (IT) - pre[lo_]; } while (0)
    unsigned en[2] = {0u, 0u}; bool okn[2] = {false, false};
    if (i_lo < i_hi) { int hn, tile; P3A_DECODE(i_lo, hn, tile); const int cnt = cntl[hn]; const unsigned short* lst = glist + (size_t)(hn >> 6) * LIST_PER_HEAD + list_off(hn & 63) + tile * 256;
#pragma unroll
        for (int g = 0; g < 2; ++g) { const int qi = wave * 32 + g * 16 + fr; okn[g] = tile * 256 + qi < cnt; en[g] = okn[g] ? lst[qi] : 0u; } }
    for (int it = i_lo; it < i_hi; ++it) {
        int hn, tile; P3A_DECODE(it, hn, tile); const int h = hn >> 6, n = hn & 63;
        int tq[2], sj[2]; bool ok[2];
#pragma unroll
        for (int g = 0; g < 2; ++g) { ok[g] = okn[g]; tq[g] = (int)(en[g] >> 2); sj[g] = (int)(en[g] & 3u); }
        if (it + 1 < i_hi) { int hn2, tile2; P3A_DECODE(it + 1, hn2, tile2); const int cnt2 = cntl[hn2]; const unsigned short* lst2 = glist + (size_t)(hn2 >> 6) * LIST_PER_HEAD + list_off(hn2 & 63) + tile2 * 256;
#pragma unroll
            for (int g = 0; g < 2; ++g) { const int qi = wave * 32 + g * 16 + fr; okn[g] = tile2 * 256 + qi < cnt2; en[g] = okn[g] ? lst2[qi] : 0u; } }
        if (hn != staged) { __syncthreads(); stage_kv(Kg, Vt, h, n, lds, tid); LDS_WAIT(); __syncthreads(); staged = hn; }
        f32x4 O[8][2]; float l[2];
        attn_core<false, MODE>(lds, Q, h, tq, wave, fr, fq, B2, O, l);
#pragma unroll
        for (int g = 0; g < 2; ++g) if (ok[g]) {
            unsigned char* op = OP + ((size_t)sj[g] * M + tq[g]) * 1024 + h * HD + 16 * fq;
            const float sc = 16.0f / l[g];
#pragma unroll
            for (int j = 0; j < 2; ++j) { v4u w;
                { int t = 0; t = __builtin_amdgcn_cvt_pk_fp8_f32(O[4 * j][g][0] * sc, O[4 * j][g][1] * sc, t, false); t = __builtin_amdgcn_cvt_pk_fp8_f32(O[4 * j][g][2] * sc, O[4 * j][g][3] * sc, t, true); w.x = (unsigned)t; }
                { int t = 0; t = __builtin_amdgcn_cvt_pk_fp8_f32(O[4 * j + 1][g][0] * sc, O[4 * j + 1][g][1] * sc, t, false); t = __builtin_amdgcn_cvt_pk_fp8_f32(O[4 * j + 1][g][2] * sc, O[4 * j + 1][g][3] * sc, t, true); w.y = (unsigned)t; }
                { int t = 0; t = __builtin_amdgcn_cvt_pk_fp8_f32(O[4 * j + 2][g][0] * sc, O[4 * j + 2][g][1] * sc, t, false); t = __builtin_amdgcn_cvt_pk_fp8_f32(O[4 * j + 2][g][2] * sc, O[4 * j + 2][g][3] * sc, t, true); w.z = (unsigned)t; }
                { int t = 0; t = __builtin_amdgcn_cvt_pk_fp8_f32(O[4 * j + 3][g][0] * sc, O[4 * j + 3][g][1] * sc, t, false); t = __builtin_amdgcn_cvt_pk_fp8_f32(O[4 * j + 3][g][2] * sc, O[4 * j + 3][g][3] * sc, t, true); w.w = (unsigned)t; }
                *(GAS v4u*)(op + j * 64) = w; }
            if (fq == 0) LP[((size_t)sj[g] * M + tq[g]) * NH + h] = l[g];
        }
    }
#undef P3A_DECODE
    __syncthreads();
}
__device__ __forceinline__ void phase3b(const float* q_norm, const float* k_norm, unsigned char* ws, LAS unsigned char* lds, int G, int tid, int wave, int lane, bf16* Oout) {
    const int fr = lane & 15, fq = lane >> 4;
    bf16* Q = (bf16*)(ws + WS_Q); const bf16* Kg = (const bf16*)(ws + WS_K); const bf16* Vt = (const bf16*)(ws + WS_VT);
    const unsigned char* OP = ws + WS_OPART; const float* LP = (const float*)(ws + WS_LPART);
    const float B2 = score_bound(q_norm, k_norm, lane);
    for (int unit = blockIdx.x; unit < NH * NBLK; unit += G) {
        const int h = unit >> 6, c = unit & 63;
        __syncthreads(); stage_kv(Kg, Vt, h, c, lds, tid); LDS_WAIT(); __syncthreads();
        int tq[2];
#pragma unroll
        for (int g = 0; g < 2; ++g) tq[g] = c * BLK + wave * 32 + g * 16 + fr;
        f32x4 O[8][2]; float l[2];
        attn_core<true>(lds, Q, h, tq, wave, fr, fq, B2, O, l);
        const int nsel = c < 3 ? c : 3;
#pragma unroll
        for (int g = 0; g < 2; ++g) {
            float lp[3];
#pragma unroll
            for (int j = 0; j < 3; ++j) lp[j] = LP[((size_t)j * M + tq[g]) * NH + h];
            v4u w[3][2];
#pragma unroll
            for (int j = 0; j < 3; ++j)
#pragma unroll
                for (int k = 0; k < 2; ++k) w[j][k] = *(const GAS v4u*)(OP + ((size_t)j * M + tq[g]) * 1024 + h * HD + k * 64 + 16 * fq);
            float lt = l[g]; float ls[3];
#pragma unroll
            for (int j = 0; j < 3; ++j) { ls[j] = j < nsel ? lp[j] * (1.0f / 16.0f) : 0.f; lt += j < nsel ? lp[j] : 0.f; }
            const float inv = 1.0f / lt;
#pragma unroll
            for (int k = 0; k < 2; ++k) {
                f32x4 o[4];
#pragma unroll
                for (int q = 0; q < 4; ++q) o[q] = O[4 * k + q][g];
#pragma unroll
                for (int j = 0; j < 3; ++j) if (j < nsel) { const unsigned xw[4] = {w[j][k].x, w[j][k].y, w[j][k].z, w[j][k].w};
#pragma unroll
                    for (int q = 0; q < 4; ++q) { const pg8::f32x2_t_ lo = __builtin_amdgcn_cvt_pk_f32_fp8((int)xw[q], false), hi = __builtin_amdgcn_cvt_pk_f32_fp8((int)xw[q], true);
                        o[q][0] += lo[0] * ls[j]; o[q][1] += lo[1] * ls[j]; o[q][2] += hi[0] * ls[j]; o[q][3] += hi[1] * ls[j]; } }
                bf16* dst = Oout + (size_t)tq[g] * 1024 + h * HD + k * 64 + 16 * fq;
                *(GAS v4u*)dst = pg8::pack8(o[0] * inv, o[1] * inv); *(GAS v4u*)(dst + 8) = pg8::pack8(o[2] * inv, o[3] * inv); }
        }
    }
    __syncthreads();
}

#ifndef MK_PER_PHASE
#define MK_PER_PHASE 0
#endif
#ifndef MK_DUP
#define MK_DUP -1
#endif
constexpr int N_PHASES = 9;
struct Args { const float* in[14]; float* out; unsigned char* ws; int ph_lo, ph_hi; };
__global__ void __launch_bounds__(NTHREADS, 2) hybrid_fwd(Args args) {
    extern __shared__ __attribute__((aligned(16))) unsigned char lds_raw[];
    LAS unsigned char* lds = (LAS unsigned char*)lds_raw;
    volatile LAS unsigned* MISC = (volatile LAS unsigned*)(lds + MISC_OFF);
    const int tid = threadIdx.x, lane = tid & 63, wave = __builtin_amdgcn_readfirstlane(tid >> 6);
    const int G = gridDim.x; const int vcu = (G % 8 == 0) ? ((int)blockIdx.x % 8) * (G / 8) + (int)blockIdx.x / 8 : (int)blockIdx.x;
    unsigned char* ws = args.ws;
    gu32* ctl = (gu32*)(ws + WS_CTL);
    if (tid < 32) MISC[tid] = 0u;
    __syncthreads();
    const int lo = args.ph_lo, hi = args.ph_hi;
    XcdBarrier bar; bar.bar = (unsigned*)ctl + CW_BAR; bar.x = 0; bar.st = nullptr;
    if (hi - lo > 1) bar = xcd_barrier_post((unsigned*)ctl + CW_BAR, MISC + 8);
#ifndef PHASE_MASK
#define PHASE_MASK 0x1ff
#endif
#define IN(k) (((PHASE_MASK >> (k)) & 1) && lo <= (k) && (k) < hi)
#define SEAM(k) do { if (IN(k) && IN((k) + 1)) xcd_barrier(bar); } while (0)
    const float* x = args.in[0]; const float* norm_mix = args.in[1]; const float* w_in = args.in[2]; const float* conv_a_w = args.in[3]; const float* q_norm = args.in[4]; const float* k_norm = args.in[5];
    const float* w_oa = args.in[6]; const float* w_ob = args.in[7]; const float* w_o = args.in[8]; const float* norm_ffn = args.in[9]; const float* w_up = args.in[10]; const float* ffn_conv_w = args.in[11];
    const float* ffn_conv_b = args.in[12]; const float* w_down = args.in[13];
    float* out = args.out;
    float* rowss = (float*)((unsigned*)ctl + CW_ROWSS);
    const size_t TSTEP = (size_t)256 * 1024 * 2;

    if (IN(0)) { phase0(x, norm_mix, w_in, w_oa, w_ob, w_o, w_up, norm_ffn, ws, lds, vcu, G, wave, lane); __syncthreads(); }
    SEAM(0);
    if (IN(1)) {
        pg8::Gemm g{(const bf16*)(ws + WS_XB), (const bf16*)(ws + WS_XB), (const bf16*)(ws + WS_WIN), (const bf16*)(ws + WS_WIN), D, TSTEP};
        pg8::StaticOrder S; S.init(M / 256, NIN / 256, G, (int)blockIdx.x);
        pg8::Epi1 E{(bf16*)(ws + WS_CA), (bf16*)(ws + WS_UU), (bf16*)(ws + WS_Q), (bf16*)(ws + WS_K), (bf16*)(ws + WS_VT), (bf16*)out, (const float*)(ws + WS_RSTDX), q_norm, k_norm, (float*)(ws + WS_KBAR), (PG8_LAS float*)(lds + HALO_OFF)};
        pg8::gemm_phase<pg8::Epi1, pg8::StaticOrder, true, true>(lds, g, S, E);
    }
    SEAM(1);
    if (IN(2)) { phase2d(ws, lds, G, tid, wave, lane, (unsigned*)(ws + WS_CTL) + CW_GCNT, (unsigned short*)(ws + WS_LIST));
        phase2(conv_a_w, ws, G, tid, (bf16*)(ws + WS_CA)); __syncthreads(); }
#if MK_DUP == 21
    if (IN(2)) { phase2d(ws, lds, G, tid, wave, lane, (unsigned*)(ws + WS_CTL) + CW_GCNT + 512, (unsigned short*)(ws + WS_WIN)); }
#endif
#if MK_DUP == 22
    if (IN(2)) { phase2(conv_a_w, ws, G, tid, (bf16*)(ws + WS_XB)); }
#endif
    SEAM(2);
#if MK_DUP >= 30 && MK_DUP <= 35
    if (IN(3)) phase3a<MK_DUP - 30>(q_norm, k_norm, ws, lds, G, tid, wave, lane);
#endif
    if (IN(3)) phase3a<0>(q_norm, k_norm, ws, lds, G, tid, wave, lane);
    SEAM(3);
    if (IN(4)) { phase3b(q_norm, k_norm, ws, lds, G, tid, wave, lane, (bf16*)(ws + WS_Q));
#if MK_DUP == 4
        phase3b(q_norm, k_norm, ws, lds, G, tid, wave, lane, (bf16*)(ws + WS_OPART));
#endif
        convert_weight(w_down, DFF, D, (bf16*)(ws + WS_WDN), nullptr, 0, (LAS float*)(lds + wave * 16384), vcu * NWAVES + wave, G * NWAVES, lane); __syncthreads(); }
    SEAM(4);
    if (IN(5)) {
        { LAS float* scr = (LAS float*)(lds + wave * 16384); const int gw = vcu * NWAVES + wave, NGW = G * NWAVES;
          if (blockIdx.x == 0 && tid < 256) *(GAS v4u*)(ws + WS_HB - 4096 + tid * 16) = (v4u){0u, 0u, 0u, 0u};
          __syncthreads(); }
        pg8::Gemm g{(const bf16*)(ws + WS_CA), (const bf16*)(ws + WS_Q), (const bf16*)(ws + WS_WOA), (const bf16*)(ws + WS_WOB), D, TSTEP};
        pg8::DualOrder S; S.S.init(M / 256, D / 256, G, (int)blockIdx.x);
        pg8::Epi4 E{(bf16*)(ws + WS_MG), (const bf16*)out};
        pg8::gemm_phase<pg8::Epi4, pg8::DualOrder, true, true>(lds, g, S, E);
    }
    SEAM(5);
    if (IN(6)) {
        pg8::Gemm g{(const bf16*)(ws + WS_MG), (const bf16*)(ws + WS_MG), (const bf16*)(ws + WS_WO), (const bf16*)(ws + WS_WO), D, TSTEP};
        pg8::StaticOrder S; S.init(M / 256, D / 256, G, (int)blockIdx.x);
        pg8::Epi5 E{x, out, (bf16*)(ws + WS_HB), rowss};
        pg8::gemm_phase<pg8::Epi5, pg8::StaticOrder, true, true>(lds, g, S, E);
#if MK_DUP == 6
        { pg8::Epi5 E2{x, (float*)(ws + WS_Q), (bf16*)(ws + WS_VT), (float*)(ws + WS_CA)}; pg8::gemm_phase<pg8::Epi5, pg8::StaticOrder, true, true>(lds, g, S, E2); }
#endif
    }
    SEAM(6);
    if (IN(7)) {
        const bf16* hb2 = (const bf16*)(ws + WS_HB) - 2 * 1024;
        pg8::Gemm g{hb2, hb2, (const bf16*)(ws + WS_WUP), (const bf16*)(ws + WS_WUP), D, (size_t)254 * 1024 * 2};
        pg8::StaticOrder S; S.init(65, 22, G, (int)blockIdx.x);
        pg8::Epi6 E{(bf16*)(ws + WS_ACT), rowss, ffn_conv_w, ffn_conv_b, (PG8_LAS float*)(lds + HALO_OFF)};
        pg8::gemm_phase<pg8::Epi6, pg8::StaticOrder, true, true>(lds, g, S, E);
    }
    SEAM(7);
    if (IN(8)) {
        pg8::Gemm g{(const bf16*)(ws + WS_ACT), (const bf16*)(ws + WS_ACT), (const bf16*)(ws + WS_WDN), (const bf16*)(ws + WS_WDN), DFF, (size_t)256 * DFF * 2};
        pg8::StaticOrder S; S.init(M / 256, D / 256, G, (int)blockIdx.x);
        pg8::Epi7 E{out, (const bf16*)(ws + WS_HB)};
        pg8::gemm_phase<pg8::Epi7, pg8::StaticOrder, true, true>(lds, g, S, E);
#if MK_DUP == 8
        { pg8::Epi7 E2{(float*)(ws + WS_MG), (const bf16*)(ws + WS_HB)}; pg8::gemm_phase<pg8::Epi7, pg8::StaticOrder, true, true>(lds, g, S, E2); }
#endif
    }
#undef IN
#undef SEAM
}

extern "C" void kernel_launch(void* const* d_in, const int* in_sizes, int n_in, void* d_out, int out_size, void* d_ws, size_t ws_size, hipStream_t stream) {
    static int grid = 0;
    if (grid == 0) {
        if (n_in != 14 || in_sizes[0] != M * D || out_size != M * D || ws_size < WS_END) { fprintf(stderr, "kernel_launch: unexpected shapes (n_in %d, in0 %d, out %d, ws %zu)\n", n_in, n_in > 0 ? in_sizes[0] : -1, out_size, ws_size); grid = -1; return; }
        int dev = 0, cus = 0, per_cu = 0;
        if (hipGetDevice(&dev) != hipSuccess || hipDeviceGetAttribute(&cus, hipDeviceAttributeMultiprocessorCount, dev) != hipSuccess) { grid = -1; return; }
        if (hipFuncSetAttribute((const void*)hybrid_fwd, hipFuncAttributeMaxDynamicSharedMemorySize, LDS_BYTES) != hipSuccess) { fprintf(stderr, "kernel_launch: hipFuncSetAttribute failed\n"); grid = -1; return; }
        if (hipOccupancyMaxActiveBlocksPerMultiprocessor(&per_cu, (const void*)hybrid_fwd, NTHREADS, LDS_BYTES) != hipSuccess || per_cu < 1) { fprintf(stderr, "kernel_launch: occupancy query says %d blocks per CU\n", per_cu); (void)hipGetLastError(); grid = -1; return; }
        grid = cus;
    }
    if (grid < 0) return;
    if (hipMemsetAsync((char*)d_ws + WS_CTL, 0, CTL_ZERO_BYTES, stream) != hipSuccess) { fprintf(stderr, "kernel_launch: memset failed\n"); return; }
    Args a{};
    for (int i = 0; i < 14; ++i) a.in[i] = (const float*)d_in[i];
    a.out = (float*)d_out; a.ws = (unsigned char*)d_ws;
#if MK_PER_PHASE
    for (int p = 0; p < N_PHASES; ++p) { a.ph_lo = p; a.ph_hi = p + 1; hipLaunchKernelGGL(hybrid_fwd, dim3(grid), dim3(NTHREADS), LDS_BYTES, stream, a); }
#else
    a.ph_lo = 0; a.ph_hi = N_PHASES;
    void* kargs[] = {&a};
    hipError_t e = hipLaunchCooperativeKernel((const void*)hybrid_fwd, dim3(grid), dim3(NTHREADS), kargs, LDS_BYTES, stream);
    if (e != hipSuccess) fprintf(stderr, "kernel_launch: cooperative launch failed: %s (grid %d)\n", hipGetErrorString(e), grid);
#endif
}
```

```cpp
#include <hip/hip_runtime.h>
#include <cstdio>
#include <cstdint>
namespace pg8 {
#define PG8_LAS __attribute__((address_space(3)))
typedef unsigned short bf16_t;
typedef short bf16x8 __attribute__((ext_vector_type(8)));
typedef float f32x4 __attribute__((ext_vector_type(4)));
typedef unsigned u32x4 __attribute__((ext_vector_type(4)));
constexpr int BM = 256, BK = 64, HALF = 128, HTB = HALF * BK * 2  , STAGE_BYTES = 8 * HTB, NXCD = 8, WGM = 8;

__host__ __device__ __forceinline__ int lds_byte(int r, int c) { const int st = (r >> 4) * 2 + (c >> 5), rr = r & 15, cc = c & 31, ob = rr * 64 + cc * 2; return st * 1024 + (ob ^ (((ob >> 9) & 1) << 5)); }
__host__ __device__ __forceinline__ void stage_rc(int b, int& R, int& C) { const int st = b / 1024, sb = b % 1024, swz = sb ^ (((sb >> 9) & 1) << 5); R = (st >> 1) * 16 + swz / 64; C = (st & 1) * 32 + (swz % 64) / 2; }
__host__ __device__ __forceinline__ int perm32(int rho) { const int n = rho >> 4, i = rho & 15; return 8 * (i >> 2) + 4 * n + (i & 3); }


struct Unit { int pm, pn, sel; };
struct Gemm { const bf16_t* A0; const bf16_t* A1; const bf16_t* B0; const bf16_t* B1; int K; size_t a_tstep; };

struct StaticOrder {
    int nM, nN, nwg, G, c;
    __host__ __device__ void init(int nM_, int nN_, int G_, int c_) { nM = nM_; nN = nN_; nwg = nM * nN; G = G_; c = c_; }
    __host__ __device__ bool next(int i, Unit& u) const {
        const long L = (long)i * G + c; if (L >= nwg) return false;
        int wgid = (int)L; { const int q = nwg / NXCD, r = nwg % NXCD, xcd = wgid % NXCD, off = wgid / NXCD; wgid = (xcd < r ? xcd * (q + 1) : r * (q + 1) + (xcd - r) * q) + off; }
        const int nig = WGM * nN, gid = wgid / nig, fm = gid * WGM, gsz = (nM - fm) < WGM ? (nM - fm) : WGM;
        u.pm = fm + ((wgid % nig) % gsz); u.pn = (wgid % nig) / gsz; u.sel = 0; return true;
    }
    __device__ __forceinline__ void a_ready(const Unit&) const {}
    __device__ __forceinline__ void done(const Unit&) const {}
};
struct DualOrder {
    StaticOrder S;
    __host__ __device__ bool next(int i, Unit& u) const { const bool ok = S.next(i >> 1, u); u.sel = i & 1; return ok; }
    __device__ __forceinline__ void a_ready(const Unit&) const {}
    __device__ __forceinline__ void done(const Unit&) const {}
};

typedef __bf16 bf16x2_t_ __attribute__((ext_vector_type(2))); typedef float f32x2_t_ __attribute__((ext_vector_type(2)));
__device__ __forceinline__ unsigned cvt_pk_bf16(float lo, float hi) { const f32x2_t_ v = {lo, hi}; const bf16x2_t_ b = __builtin_convertvector(v, bf16x2_t_); return __builtin_bit_cast(unsigned, b); }
__device__ __forceinline__ float bf_lo(unsigned w) { return __uint_as_float(w << 16); }
__device__ __forceinline__ float bf_hi(unsigned w) { return __uint_as_float(w & 0xffff0000u); }
__device__ __forceinline__ float fast_sigmoid(float x) { return __builtin_amdgcn_rcpf(1.0f + __builtin_amdgcn_exp2f(-1.4426950408889634f * x)); }
__device__ __forceinline__ u32x4 pack8(const f32x4 a, const f32x4 b) { u32x4 w; w.x = cvt_pk_bf16(a[0], a[1]); w.y = cvt_pk_bf16(a[2], a[3]); w.z = cvt_pk_bf16(b[0], b[1]); w.w = cvt_pk_bf16(b[2], b[3]); return w; }

template <int CTRL> __device__ __forceinline__ float dpp_shr(float old, float v) { return __builtin_bit_cast(float, __builtin_amdgcn_update_dpp(__builtin_bit_cast(int, old), __builtin_bit_cast(int, v), CTRL, 0xf, 0xf, false)); }
template <int CTRL> __device__ __forceinline__ float dpp_ror(float v) { return __builtin_bit_cast(float, __builtin_amdgcn_update_dpp(0, __builtin_bit_cast(int, v), CTRL, 0xf, 0xf, true)); }
constexpr int MROWS = 16384, DMODEL = 1024, DFF_ = 2816;

struct Epi1 {
    static constexpr bool PERM = true, AFTER_DRAIN = false;
    static __device__ __forceinline__ bool keep_acc(const Unit&) { return false; }
    bf16_t *BG, *UU, *Q, *K, *VT, *SG; const float* rstdx; const float *q_norm, *k_norm; float* kbar; PG8_LAS float* xl;
    __device__ __forceinline__ void operator()(f32x4 (&acc)[2][2][4][2], const Unit& u, int wr, int wc, int fr, int fq) const {
        const int row0 = u.pm * BM + wr * 64 + fr, colw = wc * 32 + 8 * fq, pn = u.pn;
        if (pn >= 12 && pn < 20) {
            const bool isK = pn >= 16; const float* wn = isK ? k_norm : q_norm; const float gs = isK ? 1.0f : 0.12751743074602357f;
            bf16_t* dst = isK ? K : Q; const int cb = ((pn - 12) & 3) * 256;
#pragma unroll
            for (int ai = 0; ai < 2; ++ai)
#pragma unroll
                for (int m = 0; m < 4; ++m) { const int rl = ai * HALF + wr * 64 + m * 16 + fr; const float rs = rstdx[u.pm * BM + rl];
#pragma unroll
                    for (int bj = 0; bj < 2; ++bj) { const f32x4 a = acc[ai][bj][m][0] * rs, b = acc[ai][bj][m][1] * rs; acc[ai][bj][m][0] = a; acc[ai][bj][m][1] = b;
                        float ss = (a[0] * a[0] + a[1] * a[1]) + (a[2] * a[2] + a[3] * a[3]) + (b[0] * b[0] + b[1] * b[1]) + (b[2] * b[2] + b[3] * b[3]);
                        ss += __shfl_xor(ss, 16); ss += __shfl_xor(ss, 32);
                        if (fq == 0) xl[(rl * 2 + bj) * 4 + wc] = ss; } }
            asm volatile("s_waitcnt lgkmcnt(0)" ::: "memory"); __builtin_amdgcn_s_barrier(); asm volatile("" ::: "memory");
            const f32x4 g0 = *(const f32x4*)(wn + colw) * gs, g1 = *(const f32x4*)(wn + colw + 4) * gs;
#pragma unroll
            for (int ai = 0; ai < 2; ++ai)
#pragma unroll
                for (int m = 0; m < 4; ++m) { const int rl = ai * HALF + wr * 64 + m * 16 + fr; const int r = u.pm * BM + rl;
#pragma unroll
                    for (int bj = 0; bj < 2; ++bj) { const f32x4 p = *(const PG8_LAS f32x4*)(xl + (rl * 2 + bj) * 4);
                        const float rn = rsqrtf(((p[0] + p[1]) + (p[2] + p[3])) * (1.0f / 128.0f) + 1e-6f);
                        const f32x4 a = acc[ai][bj][m][0] * rn * g0, b = acc[ai][bj][m][1] * rn * g1; acc[ai][bj][m][0] = a; acc[ai][bj][m][1] = b;
                        *(u32x4*)(dst + (size_t)r * 1024 + cb + bj * 128 + colw) = pack8(a, b); } }
            if (isK) {
                f32x4 cs[2][2];
#pragma unroll
                for (int bj = 0; bj < 2; ++bj)
#pragma unroll
                    for (int n = 0; n < 2; ++n) { f32x4 t = acc[0][bj][0][n];
#pragma unroll
                        for (int ai = 0; ai < 2; ++ai)
#pragma unroll
                            for (int m = 0; m < 4; ++m) if (ai + m > 0) t += acc[ai][bj][m][n];
                        cs[bj][n] = t; }
#pragma unroll
                for (int bj = 0; bj < 2; ++bj)
#pragma unroll
                    for (int n = 0; n < 2; ++n)
#pragma unroll
                        for (int e = 0; e < 4; ++e) { float v = cs[bj][n][e]; v += __shfl_xor(v, 1); v += __shfl_xor(v, 2); v += __shfl_xor(v, 4); v += __shfl_xor(v, 8); cs[bj][n][e] = v; }
                if (fr == 0) {
#pragma unroll
                    for (int bj = 0; bj < 2; ++bj) { *(PG8_LAS f32x4*)(xl + 2048 + wr * 256 + bj * 128 + colw) = cs[bj][0]; *(PG8_LAS f32x4*)(xl + 2048 + wr * 256 + bj * 128 + colw + 4) = cs[bj][1]; } }
                asm volatile("s_waitcnt lgkmcnt(0)" ::: "memory"); __builtin_amdgcn_s_barrier(); asm volatile("" ::: "memory");
                int t = threadIdx.x; asm volatile("" : "+v"(t));
                if (t < 256) kbar[((size_t)((pn - 16) * 2 + (t >> 7)) * 64 + u.pm) * 128 + (t & 127)] = (xl[2048 + t] + xl[2048 + 256 + t]) * (1.0f / 256.0f);
            }
            return;
        }
        if (pn >= 20 && pn < 24) {
            int tidv = threadIdx.x; asm volatile("" : "+v"(tidv));
            PG8_LAS unsigned char* T = (PG8_LAS unsigned char*)xl + (tidv >> 6) * 2304;
            const int lane = tidv & 63;
#pragma unroll
            for (int ai = 0; ai < 2; ++ai)
#pragma unroll
                for (int mp = 0; mp < 2; ++mp)
#pragma unroll
                    for (int bj = 0; bj < 2; ++bj) {
#pragma unroll
                        for (int mm = 0; mm < 2; ++mm) { const int m = 2 * mp + mm; const float rs = rstdx[u.pm * BM + ai * HALF + wr * 64 + m * 16 + fr];
                            const u32x4 w = pack8(acc[ai][bj][m][0] * rs, acc[ai][bj][m][1] * rs); const unsigned ww[4] = {w.x, w.y, w.z, w.w};
                            PG8_LAS unsigned char* tp = T + (8 * fq) * 72 + (16 * mm + fr) * 2;
#pragma unroll
                            for (int e = 0; e < 8; ++e) *(PG8_LAS unsigned short*)(tp + e * 72) = (unsigned short)((e & 1) ? (ww[e >> 1] >> 16) : (ww[e >> 1] & 0xffffu)); }
                        asm volatile("s_waitcnt lgkmcnt(0)" ::: "memory");
#pragma unroll
                        for (int rr = 0; rr < 2; ++rr) { const int q = lane + 64 * rr, d = q >> 2, tc = q & 3;
                            const unsigned long long x0 = *(const PG8_LAS unsigned long long*)(T + d * 72 + tc * 16), x1 = *(const PG8_LAS unsigned long long*)(T + d * 72 + tc * 16 + 8);
                            u32x4 o; o.x = (unsigned)x0; o.y = (unsigned)(x0 >> 32); o.z = (unsigned)x1; o.w = (unsigned)(x1 >> 32);
                            *(u32x4*)(VT + ((size_t)(((pn - 20) * 2 + bj) * 128 + 32 * wc + d)) * MROWS + u.pm * BM + ai * HALF + wr * 64 + 32 * mp + tc * 8) = o; }
                        asm volatile("s_waitcnt lgkmcnt(0)" ::: "memory");
                    }
            return;
        }
#pragma unroll
        for (int ai = 0; ai < 2; ++ai)
#pragma unroll
            for (int m = 0; m < 4; ++m) {
                const int r = row0 + ai * HALF + m * 16; const float rs = rstdx[r];
                f32x4 v[2][2];
#pragma unroll
                for (int bj = 0; bj < 2; ++bj)
#pragma unroll
                    for (int n = 0; n < 2; ++n) v[bj][n] = acc[ai][bj][m][n] * rs;
                if (pn < 4) {
#pragma unroll
                    for (int bj = 0; bj < 2; ++bj) *(u32x4*)(BG + (size_t)r * 1024 + pn * 256 + bj * 128 + colw) = pack8(v[bj][0], v[bj][1]);
                } else if (pn < 12) {
                    *(u32x4*)(UU + (size_t)r * 1024 + (pn - 4) * 128 + colw) = pack8(v[0][0] * v[1][0], v[0][1] * v[1][1]);
                } else {
                    f32x4 ra, rb, sa, sb;
#pragma unroll
                    for (int e = 0; e < 4; ++e) { const float ea0 = __builtin_amdgcn_exp2f(-1.4426950408889634f * v[0][0][e]), ea1 = __builtin_amdgcn_exp2f(-1.4426950408889634f * v[0][1][e]);
                        const float eb0 = __builtin_amdgcn_exp2f(-1.4426950408889634f * v[1][0][e]), eb1 = __builtin_amdgcn_exp2f(-1.4426950408889634f * v[1][1][e]);
                        ra[e] = (1.0f + eb0) * __builtin_amdgcn_rcpf(1.0f + ea0); rb[e] = (1.0f + eb1) * __builtin_amdgcn_rcpf(1.0f + ea1);
                        sa[e] = __builtin_amdgcn_rcpf(1.0f + eb0); sb[e] = __builtin_amdgcn_rcpf(1.0f + eb1); }
                    *(u32x4*)(SG + (size_t)r * 2048 + (pn - 24) * 128 + colw) = pack8(ra, rb);
                    *(u32x4*)(SG + (size_t)r * 2048 + 1024 + (pn - 24) * 128 + colw) = pack8(sa, sb);
                }
            }
    }
};
struct Epi4 {
    static constexpr bool PERM = true, AFTER_DRAIN = false;
    bf16_t* MG; const bf16_t* SG;
    static __device__ __forceinline__ bool keep_acc(const Unit& u) { return u.sel == 0; }
    __device__ __forceinline__ void operator()(f32x4 (&acc)[2][2][4][2], const Unit& u, int wr, int wc, int fr, int fq) const {
        const int row0 = u.pm * BM + wr * 64 + fr, col0 = u.pn * BM + wc * 32 + 8 * fq;
#pragma unroll
        for (int ai = 0; ai < 2; ++ai)
#pragma unroll
            for (int m = 0; m < 4; ++m) { const int r = row0 + ai * HALF + m * 16;
#pragma unroll
                for (int bj = 0; bj < 2; ++bj) { const int c = col0 + bj * HALF;
                    const u32x4 g = *(const u32x4*)(SG + (size_t)r * 2048 + u.sel * 1024 + c);
                    f32x4 a = acc[ai][bj][m][0], b = acc[ai][bj][m][1];
                    a[0] *= bf_lo(g.x); a[1] *= bf_hi(g.x); a[2] *= bf_lo(g.y); a[3] *= bf_hi(g.y); b[0] *= bf_lo(g.z); b[1] *= bf_hi(g.z); b[2] *= bf_lo(g.w); b[3] *= bf_hi(g.w);
                    if (u.sel) *(u32x4*)(MG + (size_t)r * 1024 + c) = pack8(a, b);
                    else { acc[ai][bj][m][0] = a; acc[ai][bj][m][1] = b; } } }
    }
};
struct Epi5 {
    static constexpr bool PERM = true, AFTER_DRAIN = false;
    static __device__ __forceinline__ bool keep_acc(const Unit&) { return false; }
    const float* X; float* OUT; bf16_t* HB; float* rowss;
    __device__ __forceinline__ void operator()(f32x4 (&acc)[2][2][4][2], const Unit& u, int wr, int wc, int fr, int fq) const {
        const int row0 = u.pm * BM + wr * 64 + fr, col0 = u.pn * BM + wc * 32 + 8 * fq;
#pragma unroll
        for (int ai = 0; ai < 2; ++ai)
#pragma unroll
            for (int m = 0; m < 4; ++m) { const int r = row0 + ai * HALF + m * 16; float ss = 0.f;
#pragma unroll
                for (int bj = 0; bj < 2; ++bj) { const size_t o = (size_t)r * 1024 + col0 + bj * HALF;
                    const f32x4 a = acc[ai][bj][m][0] + *(const f32x4*)(X + o), b = acc[ai][bj][m][1] + *(const f32x4*)(X + o + 4);
                    *(u32x4*)(HB + o) = pack8(a, b);
                    ss += (a[0] * a[0] + a[1] * a[1]) + (a[2] * a[2] + a[3] * a[3]) + (b[0] * b[0] + b[1] * b[1]) + (b[2] * b[2] + b[3] * b[3]); }
                ss += __shfl_xor(ss, 16); ss += __shfl_xor(ss, 32);
                if (fq == 0) atomicAdd(rowss + r, ss); }
    }
};
struct Epi6 {
    static constexpr bool PERM = true, AFTER_DRAIN = false;
    static __device__ __forceinline__ bool keep_acc(const Unit&) { return false; }
    bf16_t* ACT; const float* rowss; const float* cw; const float* cb; PG8_LAS float* halo;
    __device__ __forceinline__ void operator()(f32x4 (&acc)[2][2][4][2], const Unit& u, int wr, int wc, int fr, int fq) const {
        const int r0 = u.pm * 254 - 2, colw = wc * 32 + 8 * fq;
#pragma unroll
        for (int ai = 0; ai < 2; ++ai)
#pragma unroll
            for (int m = 0; m < 4; ++m) { int gr = r0 + ai * HALF + wr * 64 + m * 16 + fr; gr = gr < 0 ? 0 : (gr > MROWS - 1 ? MROWS - 1 : gr);
                const float rs = rsqrtf(rowss[gr] * (1.0f / 1024.0f) + 1e-6f);
#pragma unroll
                for (int bj = 0; bj < 2; ++bj)
#pragma unroll
                    for (int n = 0; n < 2; ++n) acc[ai][bj][m][n] *= rs; }
        if (fr >= 14) {
#pragma unroll
            for (int ai = 0; ai < 2; ++ai)
#pragma unroll
                for (int bj = 0; bj < 2; ++bj)
#pragma unroll
                    for (int n = 0; n < 2; ++n) *(PG8_LAS f32x4*)(halo + (((2 * ai + wr) * 2 + (fr - 14)) * 256 + bj * 128 + colw + 4 * n)) = acc[ai][bj][3][n];
        }
        f32x4 wn0, wn1, wn2, wnb;
        { const int col = u.pn * 128 + colw; wn0 = *(const f32x4*)(cw + col); wn1 = *(const f32x4*)(cw + 2 * DFF_ + col); wn2 = *(const f32x4*)(cw + 4 * DFF_ + col); wnb = *(const f32x4*)(cb + col); }
        asm volatile("s_waitcnt lgkmcnt(0)" ::: "memory"); __builtin_amdgcn_s_barrier(); asm volatile("" ::: "memory");
#pragma unroll
        for (int bj = 0; bj < 2; ++bj)
#pragma unroll
            for (int n = 0; n < 2; ++n) {
                const f32x4 w0 = wn0, w1 = wn1, w2 = wn2, bb = wnb;
                if (bj * 2 + n < 3) { const int k2 = bj * 2 + n + 1, col = (k2 >> 1) * DFF_ + u.pn * 128 + colw + 4 * (k2 & 1);
                    wn0 = *(const f32x4*)(cw + col); wn1 = *(const f32x4*)(cw + 2 * DFF_ + col); wn2 = *(const f32x4*)(cw + 4 * DFF_ + col); wnb = *(const f32x4*)(cb + col); }
#pragma unroll
                for (int ai = 0; ai < 2; ++ai) {
                    const int s = 2 * ai + wr;
                    const int sm = s > 0 ? s - 1 : 0; const float hz = s > 0 ? 1.0f : 0.0f;
                    const f32x4 h2 = *(const PG8_LAS f32x4*)(halo + ((sm * 2 + 0) * 256 + bj * 128 + colw + 4 * n)) * hz, h1 = *(const PG8_LAS f32x4*)(halo + ((sm * 2 + 1) * 256 + bj * 128 + colw + 4 * n)) * hz;
#pragma unroll
                    for (int mm = 0; mm < 4; ++mm) { const int m = 3 - mm;
                        f32x4 cur = acc[ai][bj][m][n]; asm volatile("" : "+v"(cur)); f32x4 p1, p2;
                        if (m > 0) { f32x4 lo = acc[ai][bj][m > 0 ? m - 1 : 0][n]; asm volatile("" : "+v"(lo));
#pragma unroll
                            for (int e = 0; e < 4; ++e) { p1[e] = dpp_shr<0x111>(dpp_ror<0x121>(lo[e]), cur[e]); p2[e] = dpp_shr<0x112>(dpp_ror<0x122>(lo[e]), cur[e]); } }
                        else {
#pragma unroll
                            for (int e = 0; e < 4; ++e) { p1[e] = dpp_shr<0x111>(h1[e], cur[e]); p2[e] = dpp_shr<0x112>(fr == 0 ? h2[e] : h1[e], cur[e]); } }
                        { f32x4 r_ = w0 * p2 + w1 * p1 + w2 * cur + bb; asm volatile("" : "+v"(r_)); acc[ai][bj][m][n] = r_; } }
                }
            }
#pragma unroll
        for (int ai = 0; ai < 2; ++ai)
#pragma unroll
            for (int m = 0; m < 4; ++m) { const int i = ai * HALF + wr * 64 + m * 16 + fr, gr = r0 + i;
                f32x4 a, b;
#pragma unroll
                for (int e = 0; e < 4; ++e) { const float g0 = acc[ai][0][m][0][e], g1 = acc[ai][0][m][1][e];
                    a[e] = g0 * fast_sigmoid(g0) * acc[ai][1][m][0][e]; b[e] = g1 * fast_sigmoid(g1) * acc[ai][1][m][1][e]; }
                if (i >= 2 && gr < MROWS) *(u32x4*)(ACT + (size_t)gr * DFF_ + u.pn * 128 + colw) = pack8(a, b); }
    }
};
struct Epi7 {
    static constexpr bool PERM = true, AFTER_DRAIN = false;
    static __device__ __forceinline__ bool keep_acc(const Unit&) { return false; }
    float* OUT; const bf16_t* HB;
    __device__ __forceinline__ void operator()(f32x4 (&acc)[2][2][4][2], const Unit& u, int wr, int wc, int fr, int fq) const {
        const int row0 = u.pm * BM + wr * 64 + fr, col0 = u.pn * BM + wc * 32 + 8 * fq;
#pragma unroll
        for (int ai = 0; ai < 2; ++ai)
#pragma unroll
            for (int m = 0; m < 4; ++m) { const int r = row0 + ai * HALF + m * 16;
#pragma unroll
                for (int bj = 0; bj < 2; ++bj) { const size_t o = (size_t)r * 1024 + col0 + bj * HALF; float* p = OUT + o; const u32x4 hw = *(const u32x4*)(HB + o);
                    f32x4 a = acc[ai][bj][m][0], b = acc[ai][bj][m][1];
                    a[0] += bf_lo(hw.x); a[1] += bf_hi(hw.x); a[2] += bf_lo(hw.y); a[3] += bf_hi(hw.y); b[0] += bf_lo(hw.z); b[1] += bf_hi(hw.z); b[2] += bf_lo(hw.w); b[3] += bf_hi(hw.w);
                    *(f32x4*)p = a; *(f32x4*)(p + 4) = b; } }
    }
};
template <class Epi, class Sched, bool ALIGN_EPI = false, bool SP2 = false>
__device__ __forceinline__ void gemm_phase(PG8_LAS unsigned char* lds, const Gemm g, const Sched& S, const Epi& E) {
    const int tid = threadIdx.x, wid = __builtin_amdgcn_readfirstlane(tid >> 6), lane = tid & 63, wr = wid >> 2, wc = wid & 3, fr = lane & 15, fq = lane >> 4;
    const int K = g.K, nt = K / BK;
    unsigned voffA[2], voffB[2];
#pragma unroll
    for (int i = 0; i < 2; ++i) { int R, C; stage_rc(tid * 16 + i * 8192, R, C); const int Rb = Epi::PERM ? ((R & ~31) + perm32(R & 31)) : R;
        voffA[i] = (unsigned)(R * K + C) * 2u; voffB[i] = (unsigned)(Rb * K + C) * 2u; }
    const size_t kstep = (size_t)(BK * 2);
    const size_t hstep = (size_t)HALF * K * 2;
    const size_t tstep = 2 * hstep;
    const unsigned ldsw = (unsigned)wid * 1024u;
    const int aoff = lds_byte(wr * 64 + fr, fq * 8), boff = lds_byte(wc * 32 + fr, fq * 8);
#define PG8_SA(b, h) (((b) * 2 + (h)) * HTB)
#define PG8_SB(b, h) ((4 + (b) * 2 + (h)) * HTB)
#define PG8_STAGE(bufoff, gbase, voff) do { _Pragma("unroll") for (int _i = 0; _i < 2; ++_i) \
        __builtin_amdgcn_global_load_lds((const unsigned*)((const char*)(gbase) + (voff)[_i]), (PG8_LAS unsigned*)(lds + (bufoff) + ldsw + _i * 8192), 16, 0, 0); } while (0)
#define PG8_LDA(dst, b, h) do { _Pragma("unroll") for (int m = 0; m < 4; ++m) _Pragma("unroll") for (int k = 0; k < 2; ++k) dst[m][k] = *(const PG8_LAS bf16x8*)(lds + PG8_SA(b, h) + aoff + m * 2048 + k * 1024); } while (0)
#define PG8_LDB(dst, b, h) do { _Pragma("unroll") for (int n = 0; n < 2; ++n) _Pragma("unroll") for (int k = 0; k < 2; ++k) dst[n][k] = *(const PG8_LAS bf16x8*)(lds + PG8_SB(b, h) + boff + n * 2048 + k * 1024); } while (0)
#define PG8_MMA(ai, bj, At, Bt) do { __builtin_amdgcn_s_setprio(1); _Pragma("unroll") for (int m = 0; m < 4; ++m) _Pragma("unroll") for (int n = 0; n < 2; ++n) _Pragma("unroll") for (int k = 0; k < 2; ++k) \
        acc[ai][bj][m][n] = __builtin_amdgcn_mfma_f32_16x16x32_bf16(Bt[n][k], At[m][k], acc[ai][bj][m][n], 0, 0, 0); __builtin_amdgcn_s_setprio(0); } while (0)
#define PG8_WAIT_V(n) asm volatile("s_waitcnt vmcnt(" #n ")" ::: "memory")
#define PG8_WAIT_L(n) asm volatile("s_waitcnt lgkmcnt(" #n ")" ::: "memory")
#define PG8_BAR __builtin_amdgcn_s_barrier()
#define PG8_SCHED __builtin_amdgcn_sched_barrier(0)
    Unit cur, nxt; int ui = 0;
    if (!S.next(0, cur)) return;
    f32x4 acc[2][2][4][2];
#pragma unroll
    for (int a = 0; a < 2; ++a)
#pragma unroll
        for (int b = 0; b < 2; ++b)
#pragma unroll
            for (int m = 0; m < 4; ++m)
#pragma unroll
                for (int n = 0; n < 2; ++n) acc[a][b][m][n] = (f32x4){0.f, 0.f, 0.f, 0.f};
    bf16x8 At[4][2], B0[2][2], B1[2][2];
    const char* cA = (const char*)(cur.sel ? g.A1 : g.A0) + (size_t)cur.pm * g.a_tstep; const char* cB = (const char*)(cur.sel ? g.B1 : g.B0) + (size_t)cur.pn * tstep;
    S.a_ready(cur);
    if constexpr (SP2) {
        PG8_STAGE(PG8_SB(0, 0), cB, voffB); PG8_STAGE(PG8_SB(0, 1), cB + hstep, voffB); PG8_STAGE(PG8_SA(0, 0), cA, voffA); PG8_STAGE(PG8_SA(0, 1), cA + hstep, voffA);
        if (wr == 1) PG8_BAR;
        PG8_WAIT_V(2); PG8_BAR;
        PG8_STAGE(PG8_SB(1, 0), cB + kstep, voffB); PG8_STAGE(PG8_SA(1, 0), cA + kstep, voffA); PG8_STAGE(PG8_SB(1, 1), cB + hstep + kstep, voffB);
        PG8_WAIT_V(6); PG8_BAR;
    } else {
        PG8_STAGE(PG8_SB(0, 0), cB, voffB); PG8_STAGE(PG8_SA(0, 0), cA, voffA); PG8_STAGE(PG8_SB(0, 1), cB + hstep, voffB); PG8_STAGE(PG8_SA(0, 1), cA + hstep, voffA);
        if (wr == 1) PG8_BAR;
        PG8_WAIT_V(4); PG8_BAR;
        PG8_STAGE(PG8_SB(1, 0), cB + kstep, voffB); PG8_STAGE(PG8_SA(1, 0), cA + kstep, voffA); PG8_STAGE(PG8_SB(1, 1), cB + hstep + kstep, voffB);
        PG8_WAIT_V(6); PG8_BAR;
    }
    for (;;) {
        const bool has_next = S.next(ui + 1, nxt);
        const char* nA = has_next ? (const char*)(nxt.sel ? g.A1 : g.A0) + (size_t)nxt.pm * g.a_tstep : cA; const char* nB = has_next ? (const char*)(nxt.sel ? g.B1 : g.B0) + (size_t)nxt.pn * tstep : cB;
        for (int t = 0; t < nt; t += 2) {
            const bool last = (t == nt - 2);
            const char* a1 = cA + (size_t)(t + 1) * kstep;
            const char* a2 = last ? nA : cA + (size_t)(t + 2) * kstep; const char* b2 = last ? nB : cB + (size_t)(t + 2) * kstep;
            const char* a3 = a2 + kstep; const char* b3 = b2 + kstep;
            if (last && has_next) S.a_ready(nxt);
            if constexpr (SP2) {
            PG8_LDB(B0, 0, 0); PG8_LDB(B1, 0, 1); PG8_SCHED; PG8_LDA(At, 0, 0); PG8_STAGE(PG8_SA(1, 1), a1 + hstep, voffA);
            PG8_WAIT_V(8); PG8_WAIT_L(0); PG8_BAR; PG8_MMA(0, 0, At, B0); PG8_MMA(0, 1, At, B1); PG8_BAR; PG8_SCHED;
            PG8_LDA(At, 0, 1); PG8_STAGE(PG8_SB(0, 0), b2, voffB); PG8_STAGE(PG8_SB(0, 1), b2 + hstep, voffB); PG8_STAGE(PG8_SA(0, 0), a2, voffA);
            PG8_WAIT_V(8); PG8_WAIT_L(0); PG8_BAR; PG8_MMA(1, 0, At, B0); PG8_MMA(1, 1, At, B1); PG8_BAR; PG8_SCHED;
            PG8_LDB(B0, 1, 0); PG8_LDB(B1, 1, 1); PG8_SCHED; PG8_LDA(At, 1, 0); PG8_STAGE(PG8_SA(0, 1), a2 + hstep, voffA);
            PG8_WAIT_V(8); PG8_WAIT_L(0); PG8_BAR; PG8_MMA(0, 0, At, B0); PG8_MMA(0, 1, At, B1); PG8_BAR; PG8_SCHED;
            PG8_LDA(At, 1, 1); PG8_STAGE(PG8_SB(1, 0), b3, voffB); PG8_STAGE(PG8_SB(1, 1), b3 + hstep, voffB); PG8_STAGE(PG8_SA(1, 0), a3, voffA);
            PG8_WAIT_V(8); PG8_WAIT_L(0); PG8_BAR; PG8_MMA(1, 0, At, B0); PG8_MMA(1, 1, At, B1); PG8_BAR; PG8_SCHED;
            } else {
            PG8_LDB(B0, 0, 0); PG8_SCHED; PG8_LDA(At, 0, 0); PG8_STAGE(PG8_SA(1, 1), a1 + hstep, voffA);
            PG8_WAIT_L(8); PG8_BAR; PG8_WAIT_L(0); PG8_MMA(0, 0, At, B0); PG8_BAR; PG8_SCHED;
            PG8_LDB(B1, 0, 1); PG8_STAGE(PG8_SB(0, 0), b2, voffB);
            PG8_BAR; PG8_WAIT_L(0); PG8_MMA(0, 1, At, B1); PG8_BAR;
            PG8_LDA(At, 0, 1); PG8_STAGE(PG8_SA(0, 0), a2, voffA);
            PG8_BAR; PG8_WAIT_L(0); PG8_MMA(1, 0, At, B0); PG8_BAR; PG8_SCHED;
            PG8_STAGE(PG8_SB(0, 1), b2 + hstep, voffB);
            PG8_WAIT_V(6); PG8_BAR; PG8_MMA(1, 1, At, B1); PG8_BAR;
            PG8_LDB(B0, 1, 0); PG8_SCHED; PG8_LDA(At, 1, 0); PG8_STAGE(PG8_SA(0, 1), a2 + hstep, voffA);
            PG8_WAIT_L(8); PG8_BAR; PG8_WAIT_L(0); PG8_MMA(0, 0, At, B0); PG8_BAR; PG8_SCHED;
            PG8_LDB(B1, 1, 1); PG8_STAGE(PG8_SB(1, 0), b3, voffB);
            PG8_BAR; PG8_WAIT_L(0); PG8_MMA(0, 1, At, B1); PG8_BAR;
            PG8_LDA(At, 1, 1); PG8_STAGE(PG8_SA(1, 0), a3, voffA);
            PG8_BAR; PG8_WAIT_L(0); PG8_MMA(1, 0, At, B0); PG8_BAR; PG8_SCHED;
            PG8_STAGE(PG8_SB(1, 1), b3 + hstep, voffB);
            PG8_WAIT_V(6); PG8_BAR; PG8_MMA(1, 1, At, B1); PG8_BAR;
            }
        }
        if constexpr (ALIGN_EPI) { if (wr == 0) PG8_BAR; }
        if constexpr (!Epi::AFTER_DRAIN) { E(acc, cur, wr, wc, fr, fq); S.done(cur); }
        if (!has_next) break;
        if (!Epi::keep_acc(cur)) {
#pragma unroll
        for (int a = 0; a < 2; ++a)
#pragma unroll
            for (int b = 0; b < 2; ++b)
#pragma unroll
                for (int m = 0; m < 4; ++m)
#pragma unroll
                    for (int n = 0; n < 2; ++n) acc[a][b][m][n] = (f32x4){0.f, 0.f, 0.f, 0.f}; }
        cur = nxt; cA = nA; cB = nB; ++ui;
        if constexpr (ALIGN_EPI) { if (wr == 1) PG8_BAR; }
    }
    PG8_WAIT_V(0);
    if constexpr (!ALIGN_EPI) { if (wr == 0) PG8_BAR; }
    PG8_BAR;
    if constexpr (Epi::AFTER_DRAIN) { E.fused(acc, cur, wr, wc, fr, fq, lds, wid, lane); S.done(cur); }
#undef PG8_SA
#undef PG8_SB
#undef PG8_STAGE
#undef PG8_LDA
#undef PG8_LDB
#undef PG8_MMA
#undef PG8_WAIT_V
#undef PG8_WAIT_L
#undef PG8_BAR
#undef PG8_SCHED
}
}
#define GAS __attribute__((address_space(1)))
#define LAS __attribute__((address_space(3)))
typedef unsigned short bf16;
typedef unsigned v4u __attribute__((ext_vector_type(4)));
typedef float f32x4 __attribute__((ext_vector_type(4)));
typedef short bf16x8 __attribute__((ext_vector_type(8)));
typedef GAS unsigned gu32;
typedef GAS unsigned long long gu64;
#define RLX_AGENT __ATOMIC_RELAXED, __HIP_MEMORY_SCOPE_AGENT
#define LDS_WAIT() asm volatile("s_waitcnt lgkmcnt(0)" ::: "memory")
#define VM_WAIT() asm volatile("s_waitcnt vmcnt(0)" ::: "memory")
__device__ __forceinline__ unsigned long long rt() { return __builtin_amdgcn_s_memrealtime(); }
__device__ __forceinline__ unsigned f2bf(float f) { unsigned u = __builtin_bit_cast(unsigned, f); return (u + 0x7fffu + ((u >> 16) & 1u)) >> 16; }
__device__ __forceinline__ unsigned pk2(float lo, float hi) { return f2bf(lo) | (f2bf(hi) << 16); }

#define XB_TMO      128
#define XB_XCNT(j)  (256  + 64 * (j))
#define XB_XSUB(j)  (1280 + 64 * (j))
#define XB_XGEN(j)  (2304 + 64 * (j))
#define XB_TOP      3328
#define XB_TOPGEN   3392
#define XCD_BAR_WORDS 3456
#define XB_SPIN_CAP (1u << 18)

__device__ __forceinline__ unsigned xb_ld(unsigned* p)              { return __hip_atomic_load(p, __ATOMIC_RELAXED, __HIP_MEMORY_SCOPE_AGENT); }
__device__ __forceinline__ unsigned xb_add(unsigned* p, unsigned v) { return __hip_atomic_fetch_add(p, v, __ATOMIC_RELAXED, __HIP_MEMORY_SCOPE_AGENT); }
__device__ __forceinline__ unsigned xb_xcc_id() { return (unsigned)__builtin_amdgcn_s_getreg((3 << 11) | 20) & 0xFu; }
#define XB_SPIN(cond, bar) do { unsigned _sp = 0; while (cond) { __builtin_amdgcn_s_sleep(1); \
    if ((++_sp & 255u) == 0u) { if (xb_ld(&(bar)[XB_TMO])) break; if (_sp > XB_SPIN_CAP) { atomicAdd(&(bar)[XB_TMO], 1u); break; } } } } while (0)

struct XcdBarrier {
    unsigned* bar; unsigned x;
    volatile LAS unsigned* st;
};

__device__ __forceinline__ XcdBarrier xcd_barrier_post(unsigned* bar, volatile LAS unsigned* st) {
    XcdBarrier b; b.bar = bar; b.x = xb_xcc_id(); b.st = st;
    if (threadIdx.x == 0) (void)xb_add(&bar[XB_XCNT(b.x)], 1u);
    return b;
}
__device__ __forceinline__ void xcd_barrier_complete(unsigned* bar, unsigned x, unsigned& nloc, unsigned& nx) {
    const unsigned G = gridDim.x * gridDim.y * gridDim.z;
    unsigned sum, cnt, mine, sp = 0u;
    for (;;) {
        sum = 0u; cnt = 0u; mine = 0u;
#pragma unroll
        for (unsigned j = 0; j < 16; ++j) { const unsigned c = xb_ld(&bar[XB_XCNT(j)]); sum += c; cnt += (c > 0u) ? 1u : 0u; mine = (j == x) ? c : mine; }
        if (sum == G) break;
        __builtin_amdgcn_s_sleep(1);
        if ((++sp & 255u) == 0u) { if (xb_ld(&bar[XB_TMO])) break; if (sp > XB_SPIN_CAP) { atomicAdd(&bar[XB_TMO], 1u); break; } }
    }
    nloc = mine > 0u ? mine : 1u; nx = cnt > 0u ? cnt : 1u;
}

__device__ __forceinline__ void xcd_barrier(const XcdBarrier& b) {
    asm volatile("s_waitcnt vmcnt(0)" ::: "memory");
    __syncthreads();
    if (threadIdx.x == 0) {
        unsigned* bar = b.bar;
        __builtin_amdgcn_s_waitcnt(0);
        unsigned nloc = b.st[0], nx = b.st[1];
        if (nloc == 0u) { xcd_barrier_complete(bar, b.x, nloc, nx); b.st[0] = nloc; b.st[1] = nx; }
        const unsigned old = xb_add(&bar[XB_XSUB(b.x)], 1u);
        const unsigned gen = old / nloc;
        if (old + 1u == (gen + 1u) * nloc) {
            __builtin_amdgcn_fence(__ATOMIC_RELEASE, "agent");
            asm volatile("s_waitcnt vmcnt(0)" ::: "memory");
            const unsigned og = xb_add(&bar[XB_TOP], 1u);
            const unsigned tg = og / nx;
            if (og + 1u == (tg + 1u) * nx) xb_add(&bar[XB_TOPGEN], 1u);
            else XB_SPIN(xb_ld(&bar[XB_TOPGEN]) == tg, bar);
            __builtin_amdgcn_fence(__ATOMIC_ACQUIRE, "agent");
            xb_add(&bar[XB_XGEN(b.x)], 1u);
            asm volatile("s_waitcnt vmcnt(0)" ::: "memory");
        } else {
            XB_SPIN(xb_ld(&bar[XB_XGEN(b.x)]) == gen, bar);
            __builtin_amdgcn_fence(__ATOMIC_ACQUIRE, "agent");
            asm volatile("s_waitcnt vmcnt(0)" ::: "memory");
        }
    }
    __syncthreads();
}


constexpr int NWAVES = 8, NTHREADS = 512;
constexpr int M = 16384, D = 1024, NIN = 8192, DFF = 2816, NH = 8, HD = 128, NBLK = 64, BLK = 256;
constexpr float EPS = 1e-6f;
constexpr float C2 = 0.08838834764831845f * 1.4426950408889634f;
constexpr size_t MiB = 1u << 20;
constexpr size_t WS_CTL = 0, CTL_ZERO_BYTES = 256 * 1024;
constexpr int CW_BAR = 4096, CW_GCNT = 8192, CW_ROWSS = 16384;
constexpr size_t WS_KBAR = 1 * MiB, WS_RSTDX = 1 * MiB + 512 * 1024, WS_LPART = 2 * MiB;
constexpr size_t WS_WOA = 4 * MiB, WS_WOB = 6 * MiB, WS_WO = 8 * MiB;
constexpr size_t WS_Q = 10 * MiB, WS_K = 42 * MiB, WS_VT = 74 * MiB, WS_CA = 106 * MiB, WS_LIST = 138 * MiB, WS_WIN = 147 * MiB, WS_XB = 163 * MiB, WS_UU = 195 * MiB;
constexpr size_t WS_OPART = 147 * MiB;
constexpr size_t WS_WUP = 243 * MiB, WS_WDN = 138 * MiB, WS_MG = 165 * MiB, WS_HB = 198 * MiB;
constexpr size_t WS_ACT = 10 * MiB;
constexpr size_t WS_END = 256 * MiB;
constexpr int LDS_BYTES = 163840, MISC_OFF = 131072 + 320, HALO_OFF = 131072 + 1024, SCAN_OFF = 131072 + 1024;
__device__ __forceinline__ int list_off(int n) { return 256 * (63 * n - (n * (n - 1)) / 2); }
constexpr int LIST_PER_HEAD = 256 * 2016;

__device__ __forceinline__ float wave_sum(float v) {
#pragma unroll
    for (int o = 1; o < 64; o <<= 1) v += __shfl_xor(v, o);
    return v;
}
__device__ __forceinline__ void transpose_item(const float* W, int N, bf16* WT, int K, int k0, int col0, int row0, const float* ks, LAS float* scr, int lane) {
#pragma unroll 8
    for (int i = 0; i < 32; ++i) { const int kk = 2 * i + (lane >> 5); const float s = ks ? ks[k0 + kk] : 1.0f; scr[kk * 33 + (lane & 31)] = s * W[(size_t)(k0 + kk) * N + col0 + (lane & 31)]; }
    LDS_WAIT(); asm volatile("" ::: "memory");
    const int c = lane & 7;
#pragma unroll
    for (int j = 0; j < 4; ++j) { const int n = (lane >> 3) + 8 * j; const LAS float* s = scr + (8 * c) * 33 + n;
        v4u o; o.x = pk2(s[0 * 33], s[1 * 33]); o.y = pk2(s[2 * 33], s[3 * 33]); o.z = pk2(s[4 * 33], s[5 * 33]); o.w = pk2(s[6 * 33], s[7 * 33]);
        *(GAS v4u*)(WT + (size_t)(row0 + n) * K + k0 + 8 * c) = o; }
    LDS_WAIT(); asm volatile("" ::: "memory");
}
__device__ __forceinline__ int map_col(int mode, int R) {
    if (mode == 1) { if (R >= 1024 && R < 3072) { const int q = R - 1024; return 1024 + ((q >> 7) & 1) * 1024 + (q >> 8) * 128 + (q & 127); }
                     if (R >= 6144) { const int q = R - 6144; return 6144 + ((q >> 7) & 1) * 1024 + (q >> 8) * 128 + (q & 127); } return R; }
    if (mode == 2) return ((R >> 7) & 1) * DFF + (R >> 8) * 128 + (R & 127);
    return R;
}
__device__ __forceinline__ void convert_weight(const float* W, int K, int N, bf16* WT, const float* ks, int mode, LAS float* scr, int gw, int NGW, int lane) {
    const int nblk = N / 32, nitems = (K / 64) * nblk;
    for (int it = gw; it < nitems; it += NGW) { const int kb = it / nblk, nb = it % nblk; transpose_item(W, N, WT, K, 64 * kb, map_col(mode, 32 * nb), 32 * nb, ks, scr, lane); }
}

__device__ __forceinline__ void phase0(const float* x, const float* norm_mix, const float* w_in, const float* w_oa, const float* w_ob, const float* w_o, const float* w_up, const float* norm_ffn, unsigned char* ws, LAS unsigned char* lds, int vcu, int G, int wave, int lane) {
    LAS float* scr = (LAS float*)(lds + wave * 16384);
    const int gw = vcu * NWAVES + wave, NGW = G * NWAVES;
    convert_weight(w_in, D, NIN, (bf16*)(ws + WS_WIN), norm_mix, 1, scr, gw, NGW, lane);
    convert_weight(w_oa, D, D, (bf16*)(ws + WS_WOA), nullptr, 0, scr, gw, NGW, lane);
    convert_weight(w_ob, D, D, (bf16*)(ws + WS_WOB), nullptr, 0, scr, gw, NGW, lane);
    convert_weight(w_o, D, D, (bf16*)(ws + WS_WO), nullptr, 0, scr, gw, NGW, lane);
    convert_weight(w_up, D, 2 * DFF, (bf16*)(ws + WS_WUP), norm_ffn, 2, scr, gw, NGW, lane);
    bf16* XB = (bf16*)(ws + WS_XB); float* rstdx = (float*)(ws + WS_RSTDX);
    for (int m = gw; m < M; m += NGW) {
        const GAS f32x4* xr = (const GAS f32x4*)(x + (size_t)m * D) + lane; f32x4 v[4]; float s = 0.f;
#pragma unroll
        for (int j = 0; j < 4; ++j) { v[j] = xr[64 * j]; s += (v[j].x * v[j].x + v[j].y * v[j].y) + (v[j].z * v[j].z + v[j].w * v[j].w); }
        s = wave_sum(s); if (lane == 0) rstdx[m] = rsqrtf(s * (1.f / D) + EPS);
        GAS unsigned long long* o8 = (GAS unsigned long long*)(XB + (size_t)m * D) + lane;
#pragma unroll
        for (int j = 0; j < 4; ++j) o8[64 * j] = (unsigned long long)pk2(v[j].x, v[j].y) | ((unsigned long long)pk2(v[j].z, v[j].w) << 32);
    }
}
__device__ __forceinline__ void phase2(const float* conv_a_w, unsigned char* ws, int G, int tid, bf16* __restrict__ CAout) {
    const bf16* __restrict__ BG = (const bf16*)(ws + WS_CA); const bf16* __restrict__ UU = (const bf16*)(ws + WS_UU);
    for (int item = blockIdx.x * NTHREADS + tid; item < 128 * (M / 16); item += G * NTHREADS) {
        const int cc = (item & 127) * 8, t0 = (item >> 7) * 16;
        float w0[8], w1[8], w2[8], um2[8], um1[8];
#pragma unroll
        for (int j = 0; j < 2; ++j) { const f32x4 a = *(const GAS f32x4*)(conv_a_w + cc + 4 * j), b = *(const GAS f32x4*)(conv_a_w + 1024 + cc + 4 * j), c = *(const GAS f32x4*)(conv_a_w + 2048 + cc + 4 * j);
#pragma unroll
            for (int e = 0; e < 4; ++e) { w0[4 * j + e] = a[e]; w1[4 * j + e] = b[e]; w2[4 * j + e] = c[e]; } }
        { v4u a = (v4u){0u, 0u, 0u, 0u}, b = a; if (t0 >= 2) { a = *(const GAS v4u*)(UU + (size_t)(t0 - 2) * 1024 + cc); b = *(const GAS v4u*)(UU + (size_t)(t0 - 1) * 1024 + cc); }
          const unsigned aw[4] = {a.x, a.y, a.z, a.w}, bw[4] = {b.x, b.y, b.z, b.w};
#pragma unroll
          for (int j = 0; j < 4; ++j) { um2[2 * j] = pg8::bf_lo(aw[j]); um2[2 * j + 1] = pg8::bf_hi(aw[j]); um1[2 * j] = pg8::bf_lo(bw[j]); um1[2 * j + 1] = pg8::bf_hi(bw[j]); } }
#pragma unroll 4
        for (int i = 0; i < 16; ++i) { const size_t o = (size_t)(t0 + i) * 1024 + cc;
            const v4u u = *(const GAS v4u*)(UU + o), b = *(const GAS v4u*)(BG + o); const unsigned uw[4] = {u.x, u.y, u.z, u.w}, bw[4] = {b.x, b.y, b.z, b.w};
            float r[8];
#pragma unroll
            for (int j = 0; j < 4; ++j) { const float u0 = pg8::bf_lo(uw[j]), u1 = pg8::bf_hi(uw[j]);
                r[2 * j] = pg8::bf_lo(bw[j]) * (w0[2 * j] * um2[2 * j] + w1[2 * j] * um1[2 * j] + w2[2 * j] * u0);
                r[2 * j + 1] = pg8::bf_hi(bw[j]) * (w0[2 * j + 1] * um2[2 * j + 1] + w1[2 * j + 1] * um1[2 * j + 1] + w2[2 * j + 1] * u1);
                um2[2 * j] = um1[2 * j]; um2[2 * j + 1] = um1[2 * j + 1]; um1[2 * j] = u0; um1[2 * j + 1] = u1; }
            v4u o4; o4.x = pk2(r[0], r[1]); o4.y = pk2(r[2], r[3]); o4.z = pk2(r[4], r[5]); o4.w = pk2(r[6], r[7]);
            *(GAS v4u*)(CAout + o) = o4; }
    }
}
__device__ __forceinline__ bool top_better(float v, int n, float cv, int cn) { return v > cv || (v == cv && n < cn); }
__device__ __forceinline__ void top3_insert(float v, int n, float (&tv)[3], int (&ti)[3]) {
    if (top_better(v, n, tv[0], ti[0])) { tv[2] = tv[1]; ti[2] = ti[1]; tv[1] = tv[0]; ti[1] = ti[0]; tv[0] = v; ti[0] = n; }
    else if (top_better(v, n, tv[1], ti[1])) { tv[2] = tv[1]; ti[2] = ti[1]; tv[1] = v; ti[1] = n; }
    else if (top_better(v, n, tv[2], ti[2])) { tv[2] = v; ti[2] = n; }
}
__device__ __forceinline__ void phase2d(unsigned char* ws, LAS unsigned char* lds, int G, int tid, int wave, int lane, unsigned* gcnt, unsigned short* glist) {
    LAS unsigned* lcnt = (LAS unsigned*)(lds + 32768); LAS unsigned* lbase = lcnt + 64; LAS unsigned short* llist = (LAS unsigned short*)lds;
    const bf16* Q = (const bf16*)(ws + WS_Q); const float* kbar = (const float*)(ws + WS_KBAR);
    const int fr = lane & 15, fq = lane >> 4;
    for (int unit = blockIdx.x; unit < NH * 63; unit += G) {
        const int h = unit / 63, c = 1 + unit % 63;
        if (tid < 64) lcnt[tid] = 0u;
        __syncthreads();
        bf16x8 qf[2][4];
#pragma unroll
        for (int g = 0; g < 2; ++g)
#pragma unroll
            for (int ks = 0; ks < 4; ++ks) qf[g][ks] = *(const GAS bf16x8*)(Q + (size_t)(c * BLK + wave * 32 + g * 16 + fr) * 1024 + h * HD + ks * 32 + fq * 8);
        float tv[2][3]; int ti[2][3];
#pragma unroll
        for (int g = 0; g < 2; ++g)
#pragma unroll
            for (int j = 0; j < 3; ++j) { tv[g][j] = -__builtin_inff(); ti[g][j] = 1 << 20; }
        const int ntile = (c + 15) >> 4;
        for (int tile = 0; tile < ntile; ++tile) {
            f32x4 s0 = (f32x4){0.f, 0.f, 0.f, 0.f}, s1 = s0;
#pragma unroll
            for (int ks = 0; ks < 4; ++ks) {
                const float* kp = kbar + ((size_t)(h * NBLK + tile * 16 + fr) * HD + ks * 32 + fq * 8);
                const f32x4 a = *(const GAS f32x4*)kp, b = *(const GAS f32x4*)(kp + 4);
                const v4u hw = pg8::pack8(a, b);
                f32x4 ra, rb; ra[0] = a[0] - pg8::bf_lo(hw.x); ra[1] = a[1] - pg8::bf_hi(hw.x); ra[2] = a[2] - pg8::bf_lo(hw.y); ra[3] = a[3] - pg8::bf_hi(hw.y);
                rb[0] = b[0] - pg8::bf_lo(hw.z); rb[1] = b[1] - pg8::bf_hi(hw.z); rb[2] = b[2] - pg8::bf_lo(hw.w); rb[3] = b[3] - pg8::bf_hi(hw.w);
                const v4u lw = pg8::pack8(ra, rb);
                const bf16x8 hi = __builtin_bit_cast(bf16x8, hw), lo = __builtin_bit_cast(bf16x8, lw);
                s0 = __builtin_amdgcn_mfma_f32_16x16x32_bf16(hi, qf[0][ks], s0, 0, 0, 0); s0 = __builtin_amdgcn_mfma_f32_16x16x32_bf16(lo, qf[0][ks], s0, 0, 0, 0);
                s1 = __builtin_amdgcn_mfma_f32_16x16x32_bf16(hi, qf[1][ks], s1, 0, 0, 0); s1 = __builtin_amdgcn_mfma_f32_16x16x32_bf16(lo, qf[1][ks], s1, 0, 0, 0);
            }
#pragma unroll
            for (int i = 0; i < 4; ++i) { const int n = tile * 16 + 4 * fq + i;
                top3_insert(n < c ? s0[i] : -__builtin_inff(), n, tv[0], ti[0]); top3_insert(n < c ? s1[i] : -__builtin_inff(), n, tv[1], ti[1]); }
        }
#pragma unroll
        for (int off = 16; off <= 32; off <<= 1)
#pragma unroll
            for (int g = 0; g < 2; ++g) { float pv[3]; int pi[3];
#pragma unroll
                for (int j = 0; j < 3; ++j) { pv[j] = __shfl_xor(tv[g][j], off); pi[j] = __shfl_xor(ti[g][j], off); }
#pragma unroll
                for (int j = 0; j < 3; ++j) top3_insert(pv[j], pi[j], tv[g], ti[g]); }
        const int nsel = c < 3 ? c : 3;
        if (fq == 0) {
#pragma unroll
            for (int g = 0; g < 2; ++g) { const int tl = wave * 32 + g * 16 + fr;
#pragma unroll
                for (int j = 0; j < 3; ++j) if (j < nsel) { const int n = ti[g][j]; const unsigned pp = __hip_atomic_fetch_add(&lcnt[n], 1u, __ATOMIC_RELAXED, __HIP_MEMORY_SCOPE_WORKGROUP); llist[n * 256 + pp] = (unsigned short)((tl << 2) | j); } }
        }
        __syncthreads();
        if (tid < c) { const unsigned k = lcnt[tid]; lbase[tid] = k ? atomicAdd(gcnt + h * NBLK + tid, k) : 0u; }
        __syncthreads();
        for (int n = wave; n < c; n += NWAVES) { const unsigned k = lcnt[n], base = lbase[n];
            unsigned short* dst = glist + (size_t)h * LIST_PER_HEAD + list_off(n) + base;
            for (unsigned i = lane; i < k; i += 64) { const unsigned e = llist[n * 256 + i]; dst[i] = (unsigned short)((((unsigned)c * BLK + (e >> 2)) << 2) | (e & 3u)); } }
        __syncthreads();
    }
}
__device__ __forceinline__ void stage_kv(const bf16* Kg, const bf16* Vt, int h, int n, LAS unsigned char* lds, int tid) {
#pragma unroll
    for (int i = 0; i < 8; ++i) { const int row = (tid >> 4) + 32 * i, ch = tid & 15;
        const v4u w = *(const GAS v4u*)(Kg + (size_t)(n * BLK + row) * 1024 + h * HD + ch * 8);
        const int sw = (((row >> 3) & 3) << 2) | (row & 3);
        *(LAS v4u*)(lds + row * 256 + ((ch ^ sw) << 4)) = w; }
#pragma unroll
    for (int i = 0; i < 8; ++i) { const int row = (tid >> 5) + 16 * i, ch = tid & 31;
        const v4u w = *(const GAS v4u*)(Vt + (size_t)(h * HD + row) * M + n * BLK + ch * 8);
        *(LAS v4u*)(lds + 65536 + row * 512 + ((ch ^ ((((row >> 4) & 3) << 2) | (row & 3))) << 4)) = w; }
}
template <bool CAUSAL, int MODE = 0>
__device__ __forceinline__ void attn_core(const LAS unsigned char* lds, const bf16* Q, int h, const int (&tq)[2], int wave, int fr, int fq, float B2, f32x4 (&O)[8][2], float (&l)[2]) {
    bf16x8 qf[2][4];
#pragma unroll
    for (int g = 0; g < 2; ++g)
#pragma unroll
        for (int ks = 0; ks < 4; ++ks) qf[g][ks] = *(const GAS bf16x8*)(Q + (size_t)tq[g] * 1024 + h * HD + ks * 32 + fq * 8);
#pragma unroll
    for (int dt = 0; dt < 8; ++dt) { O[dt][0] = (f32x4){0.f, 0.f, 0.f, 0.f}; O[dt][1] = O[dt][0]; }
    l[0] = 0.f; l[1] = 0.f;
    const int nch = CAUSAL ? wave + 1 : 8;
    const int krow = (fr >> 2) * 8 + (fr & 3);
    bf16x8 kf[4][2];
#pragma unroll
    for (int ks = 0; ks < 4; ++ks)
#pragma unroll
        for (int t = 0; t < 2; ++t) kf[ks][t] = *(const LAS bf16x8*)(lds + (krow + t * 4) * 256 + (((ks * 4 + fq) ^ fr) << 4));
#pragma unroll 2
    for (int c = 0; c < nch; ++c) {
        f32x4 s[2][2];
#pragma unroll
        for (int t = 0; t < 2; ++t) { s[t][0] = (f32x4){-B2, -B2, -B2, -B2}; s[t][1] = s[t][0]; }
        bf16x8 vf[8];
#pragma unroll
        for (int dt = 0; dt < 8; ++dt) vf[dt] = *(const LAS bf16x8*)(lds + 65536 + ((dt >> 2) * 64 + (fr >> 2) * 16 + (dt & 3) * 4 + (fr & 3)) * 512 + (((c * 4 + fq) ^ fr) << 4));
#pragma unroll
        for (int ks = 0; ks < 4; ++ks)
#pragma unroll
            for (int t = 0; t < 2; ++t) {
                if (MODE != 2 || ks == 0) {
                s[t][0] = __builtin_amdgcn_mfma_f32_16x16x32_bf16(kf[ks][t], qf[0][ks], s[t][0], 0, 0, 0);
                s[t][1] = __builtin_amdgcn_mfma_f32_16x16x32_bf16(kf[ks][t], qf[1][ks], s[t][1], 0, 0, 0); }
            }
        __builtin_amdgcn_sched_barrier(0);
        { const int cn = (c + 1 < nch) ? c + 1 : c;
#pragma unroll
          for (int ks = 0; ks < 4; ++ks)
#pragma unroll
              for (int t = 0; t < 2; ++t) kf[ks][t] = *(const LAS bf16x8*)(lds + (cn * 32 + krow + t * 4) * 256 + (((ks * 4 + fq) ^ fr) << 4)); }
        bf16x8 pf[2];
#pragma unroll
        for (int g = 0; g < 2; ++g) {
            float p[8];
#pragma unroll
            for (int t = 0; t < 2; ++t)
#pragma unroll
                for (int i = 0; i < 4; ++i) { float e = MODE == 1 ? s[t][g][i] : __builtin_amdgcn_exp2f(s[t][g][i]);
                    if (CAUSAL && c == wave) { const int kl = c * 32 + fq * 8 + t * 4 + i, ql = wave * 32 + g * 16 + fr; if (kl > ql) e = 0.f; }
                    p[t * 4 + i] = e; }
            l[g] += ((p[0] + p[1]) + (p[2] + p[3])) + ((p[4] + p[5]) + (p[6] + p[7]));
            v4u w; w.x = pg8::cvt_pk_bf16(p[0], p[1]); w.y = pg8::cvt_pk_bf16(p[2], p[3]); w.z = pg8::cvt_pk_bf16(p[4], p[5]); w.w = pg8::cvt_pk_bf16(p[6], p[7]);
            pf[g] = __builtin_bit_cast(bf16x8, w);
        }
#pragma unroll
        for (int dt = 0; dt < 8; ++dt) {
            if (MODE != 3 || dt == 0) {
            O[dt][0] = __builtin_amdgcn_mfma_f32_16x16x32_bf16(vf[dt], pf[0], O[dt][0], 0, 0, 0);
            O[dt][1] = __builtin_amdgcn_mfma_f32_16x16x32_bf16(vf[dt], pf[1], O[dt][1], 0, 0, 0); }
        }
    }
    l[0] += __shfl_xor(l[0], 16); l[0] += __shfl_xor(l[0], 32); l[1] += __shfl_xor(l[1], 16); l[1] += __shfl_xor(l[1], 32);
}
__device__ __forceinline__ float score_bound(const float* q_norm, const float* k_norm, int lane) {
    float a = fmaxf(fabsf(q_norm[lane]), fabsf(q_norm[lane + 64])), b = fmaxf(fabsf(k_norm[lane]), fabsf(k_norm[lane + 64]));
#pragma unroll
    for (int o = 1; o < 64; o <<= 1) { a = fmaxf(a, __shfl_xor(a, o)); b = fmaxf(b, __shfl_xor(b, o)); }
    return 128.0f * a * b * C2 * 1.001f + 0.01f;
}
template <int MODE>
__device__ __forceinline__ void phase3a(const float* q_norm, const float* k_norm, unsigned char* ws, LAS unsigned char* lds, int G, int tid, int wave, int lane) {
    const int fr = lane & 15, fq = lane >> 4;
    LAS int* pre = (LAS int*)(lds + SCAN_OFF);
    LAS int* cntl = (LAS int*)(lds + SCAN_OFF + 2080);
    const unsigned* gcnt = (const unsigned*)(ws + WS_CTL) + CW_GCNT; const unsigned short* glist = (const unsigned short*)(ws + WS_LIST);
    const bf16* Q = (const bf16*)(ws + WS_Q); const bf16* Kg = (const bf16*)(ws + WS_K); const bf16* Vt = (const bf16*)(ws + WS_VT);
    unsigned char* OP = ws + WS_OPART; float* LP = (float*)(ws + WS_LPART);
    const float B2 = score_bound(q_norm, k_norm, lane);
    { const int cnt = (int)__hip_atomic_load(gcnt + tid, __ATOMIC_RELAXED, __HIP_MEMORY_SCOPE_AGENT); pre[tid + 1] = (cnt + 255) >> 8; cntl[tid] = cnt; if (tid == 0) pre[0] = 0; }
    __syncthreads();
    for (int o = 1; o < 512; o <<= 1) { const int v = pre[tid + 1] + ((tid + 1 - o) >= 1 ? pre[tid + 1 - o] : 0); __syncthreads(); pre[tid + 1] = v; __syncthreads(); }
    const int T = pre[512];
    const int i_lo = (int)(((long)blockIdx.x * T) / G), i_hi = (int)(((long)(blockIdx.x + 1) * T) / G);
    int staged = -1;
#define P3A_DECODE(IT, HN, TILE) do { int lo_ = 0, hi_ = 511; while (lo_ < hi_) { const int mid_ = (lo_ + hi_ + 1) >> 1; if (pre[mid_] <= (IT)) lo_ = mid_; else hi_ = mid_ - 1; } HN = lo_; TILE = (IT) - pre[lo_]; } while (0)
    unsigned en[2] = {0u, 0u}; bool okn[2] = {false, false};
    if (i_lo < i_hi) { int hn, tile; P3A_DECODE(i_lo, hn, tile); const int cnt = cntl[hn]; const unsigned short* lst = glist + (size_t)(hn >> 6) * LIST_PER_HEAD + list_off(hn & 63) + tile * 256;
#pragma unroll
        for (int g = 0; g < 2; ++g) { const int qi = wave * 32 + g * 16 + fr; okn[g] = tile * 256 + qi < cnt; en[g] = okn[g] ? lst[qi] : 0u; } }
    for (int it = i_lo; it < i_hi; ++it) {
        int hn, tile; P3A_DECODE(it, hn, tile); const int h = hn >> 6, n = hn & 63;
        int tq[2], sj[2]; bool ok[2];
#pragma unroll
        for (int g = 0; g < 2; ++g) { ok[g] = okn[g]; tq[g] = (int)(en[g] >> 2); sj[g] = (int)(en[g] & 3u); }
        if (it + 1 < i_hi) { int hn2, tile2; P3A_DECODE(it + 1, hn2, tile2); const int cnt2 = cntl[hn2]; const unsigned short* lst2 = glist + (size_t)(hn2 >> 6) * LIST_PER_HEAD + list_off(hn2 & 63) + tile2 * 256;
#pragma unroll
            for (int g = 0; g < 2; ++g) { const int qi = wave * 32 + g * 16 + fr; okn[g] = tile2 * 256 + qi < cnt2; en[g] = okn[g] ? lst2[qi] : 0u; } }
        if (hn != staged) { __syncthreads(); stage_kv(Kg, Vt, h, n, lds, tid); LDS_WAIT(); __syncthreads(); staged = hn; }
        f32x4 O[8][2]; float l[2];
        attn_core<false, MODE>(lds, Q, h, tq, wave, fr, fq, B2, O, l);
#pragma unroll
        for (int g = 0; g < 2; ++g) if (ok[g]) {
            unsigned char* op = OP + ((size_t)sj[g] * M + tq[g]) * 1024 + h * HD + 16 * fq;
            const float sc = 16.0f / l[g];
#pragma unroll
            for (int j = 0; j < 2; ++j) { v4u w;
                { int t = 0; t = __builtin_amdgcn_cvt_pk_fp8_f32(O[4 * j][g][0] * sc, O[4 * j][g][1] * sc, t, false); t = __builtin_amdgcn_cvt_pk_fp8_f32(O[4 * j][g][2] * sc, O[4 * j][g][3] * sc, t, true); w.x = (unsigned)t; }
                { int t = 0; t = __builtin_amdgcn_cvt_pk_fp8_f32(O[4 * j + 1][g][0] * sc, O[4 * j + 1][g][1] * sc, t, false); t = __builtin_amdgcn_cvt_pk_fp8_f32(O[4 * j + 1][g][2] * sc, O[4 * j + 1][g][3] * sc, t, true); w.y = (unsigned)t; }
                { int t = 0; t = __builtin_amdgcn_cvt_pk_fp8_f32(O[4 * j + 2][g][0] * sc, O[4 * j + 2][g][1] * sc, t, false); t = __builtin_amdgcn_cvt_pk_fp8_f32(O[4 * j + 2][g][2] * sc, O[4 * j + 2][g][3] * sc, t, true); w.z = (unsigned)t; }
                { int t = 0; t = __builtin_amdgcn_cvt_pk_fp8_f32(O[4 * j + 3][g][0] * sc, O[4 * j + 3][g][1] * sc, t, false); t = __builtin_amdgcn_cvt_pk_fp8_f32(O[4 * j + 3][g][2] * sc, O[4 * j + 3][g][3] * sc, t, true); w.w = (unsigned)t; }
                *(GAS v4u*)(op + j * 64) = w; }
            if (fq == 0) LP[((size_t)sj[g] * M + tq[g]) * NH + h] = l[g];
        }
    }
#undef P3A_DECODE
    __syncthreads();
}
__device__ __forceinline__ void phase3b(const float* q_norm, const float* k_norm, unsigned char* ws, LAS unsigned char* lds, int G, int tid, int wave, int lane, bf16* Oout) {
    const int fr = lane & 15, fq = lane >> 4;
    bf16* Q = (bf16*)(ws + WS_Q); const bf16* Kg = (const bf16*)(ws + WS_K); const bf16* Vt = (const bf16*)(ws + WS_VT);
    const unsigned char* OP = ws + WS_OPART; const float* LP = (const float*)(ws + WS_LPART);
    const float B2 = score_bound(q_norm, k_norm, lane);
    for (int unit = blockIdx.x; unit < NH * NBLK; unit += G) {
        const int h = unit >> 6, c = unit & 63;
        __syncthreads(); stage_kv(Kg, Vt, h, c, lds, tid); LDS_WAIT(); __syncthreads();
        int tq[2];
#pragma unroll
        for (int g = 0; g < 2; ++g) tq[g] = c * BLK + wave * 32 + g * 16 + fr;
        f32x4 O[8][2]; float l[2];
        attn_core<true>(lds, Q, h, tq, wave, fr, fq, B2, O, l);
        const int nsel = c < 3 ? c : 3;
#pragma unroll
        for (int g = 0; g < 2; ++g) {
            float lp[3];
#pragma unroll
            for (int j = 0; j < 3; ++j) lp[j] = LP[((size_t)j * M + tq[g]) * NH + h];
            v4u w[3][2];
#pragma unroll
            for (int j = 0; j < 3; ++j)
#pragma unroll
                for (int k = 0; k < 2; ++k) w[j][k] = *(const GAS v4u*)(OP + ((size_t)j * M + tq[g]) * 1024 + h * HD + k * 64 + 16 * fq);
            float lt = l[g]; float ls[3];
#pragma unroll
            for (int j = 0; j < 3; ++j) { ls[j] = j < nsel ? lp[j] * (1.0f / 16.0f) : 0.f; lt += j < nsel ? lp[j] : 0.f; }
            const float inv = 1.0f / lt;
#pragma unroll
            for (int k = 0; k < 2; ++k) {
                f32x4 o[4];
#pragma unroll
                for (int q = 0; q < 4; ++q) o[q] = O[4 * k + q][g];
#pragma unroll
                for (int j = 0; j < 3; ++j) if (j < nsel) { const unsigned xw[4] = {w[j][k].x, w[j][k].y, w[j][k].z, w[j][k].w};
#pragma unroll
                    for (int q = 0; q < 4; ++q) { const pg8::f32x2_t_ lo = __builtin_amdgcn_cvt_pk_f32_fp8((int)xw[q], false), hi = __builtin_amdgcn_cvt_pk_f32_fp8((int)xw[q], true);
                        o[q][0] += lo[0] * ls[j]; o[q][1] += lo[1] * ls[j]; o[q][2] += hi[0] * ls[j]; o[q][3] += hi[1] * ls[j]; } }
                bf16* dst = Oout + (size_t)tq[g] * 1024 + h * HD + k * 64 + 16 * fq;
                *(GAS v4u*)dst = pg8::pack8(o[0] * inv, o[1] * inv); *(GAS v4u*)(dst + 8) = pg8::pack8(o[2] * inv, o[3] * inv); }
        }
    }
    __syncthreads();
}

#ifndef MK_PER_PHASE
#define MK_PER_PHASE 0
#endif
#ifndef MK_DUP
#define MK_DUP -1
#endif
constexpr int N_PHASES = 9;
struct Args { const float* in[14]; float* out; unsigned char* ws; int ph_lo, ph_hi; };
__global__ void __launch_bounds__(NTHREADS, 2) hybrid_fwd(Args args) {
    extern __shared__ __attribute__((aligned(16))) unsigned char lds_raw[];
    LAS unsigned char* lds = (LAS unsigned char*)lds_raw;
    volatile LAS unsigned* MISC = (volatile LAS unsigned*)(lds + MISC_OFF);
    const int tid = threadIdx.x, lane = tid & 63, wave = __builtin_amdgcn_readfirstlane(tid >> 6);
    const int G = gridDim.x; const int vcu = (G % 8 == 0) ? ((int)blockIdx.x % 8) * (G / 8) + (int)blockIdx.x / 8 : (int)blockIdx.x;
    unsigned char* ws = args.ws;
    gu32* ctl = (gu32*)(ws + WS_CTL);
    if (tid < 32) MISC[tid] = 0u;
    __syncthreads();
    const int lo = args.ph_lo, hi = args.ph_hi;
    XcdBarrier bar; bar.bar = (unsigned*)ctl + CW_BAR; bar.x = 0; bar.st = nullptr;
    if (hi - lo > 1) bar = xcd_barrier_post((unsigned*)ctl + CW_BAR, MISC + 8);
#ifndef PHASE_MASK
#define PHASE_MASK 0x1ff
#endif
#define IN(k) (((PHASE_MASK >> (k)) & 1) && lo <= (k) && (k) < hi)
#define SEAM(k) do { if (IN(k) && IN((k) + 1)) xcd_barrier(bar); } while (0)
    const float* x = args.in[0]; const float* norm_mix = args.in[1]; const float* w_in = args.in[2]; const float* conv_a_w = args.in[3]; const float* q_norm = args.in[4]; const float* k_norm = args.in[5];
    const float* w_oa = args.in[6]; const float* w_ob = args.in[7]; const float* w_o = args.in[8]; const float* norm_ffn = args.in[9]; const float* w_up = args.in[10]; const float* ffn_conv_w = args.in[11];
    const float* ffn_conv_b = args.in[12]; const float* w_down = args.in[13];
    float* out = args.out;
    float* rowss = (float*)((unsigned*)ctl + CW_ROWSS);
    const size_t TSTEP = (size_t)256 * 1024 * 2;

    if (IN(0)) { phase0(x, norm_mix, w_in, w_oa, w_ob, w_o, w_up, norm_ffn, ws, lds, vcu, G, wave, lane); __syncthreads(); }
    SEAM(0);
    if (IN(1)) {
        pg8::Gemm g{(const bf16*)(ws + WS_XB), (const bf16*)(ws + WS_XB), (const bf16*)(ws + WS_WIN), (const bf16*)(ws + WS_WIN), D, TSTEP};
        pg8::StaticOrder S; S.init(M / 256, NIN / 256, G, (int)blockIdx.x);
        pg8::Epi1 E{(bf16*)(ws + WS_CA), (bf16*)(ws + WS_UU), (bf16*)(ws + WS_Q), (bf16*)(ws + WS_K), (bf16*)(ws + WS_VT), (bf16*)out, (const float*)(ws + WS_RSTDX), q_norm, k_norm, (float*)(ws + WS_KBAR), (PG8_LAS float*)(lds + HALO_OFF)};
        pg8::gemm_phase<pg8::Epi1, pg8::StaticOrder, true, true>(lds, g, S, E);
    }
    SEAM(1);
    if (IN(2)) { phase2d(ws, lds, G, tid, wave, lane, (unsigned*)(ws + WS_CTL) + CW_GCNT, (unsigned short*)(ws + WS_LIST));
        phase2(conv_a_w, ws, G, tid, (bf16*)(ws + WS_CA)); __syncthreads(); }
#if MK_DUP == 21
    if (IN(2)) { phase2d(ws, lds, G, tid, wave, lane, (unsigned*)(ws + WS_CTL) + CW_GCNT + 512, (unsigned short*)(ws + WS_WIN)); }
#endif
#if MK_DUP == 22
    if (IN(2)) { phase2(conv_a_w, ws, G, tid, (bf16*)(ws + WS_XB)); }
#endif
    SEAM(2);
#if MK_DUP >= 30 && MK_DUP <= 35
    if (IN(3)) phase3a<MK_DUP - 30>(q_norm, k_norm, ws, lds, G, tid, wave, lane);
#endif
    if (IN(3)) phase3a<0>(q_norm, k_norm, ws, lds, G, tid, wave, lane);
    SEAM(3);
    if (IN(4)) { phase3b(q_norm, k_norm, ws, lds, G, tid, wave, lane, (bf16*)(ws + WS_Q));
#if MK_DUP == 4
        phase3b(q_norm, k_norm, ws, lds, G, tid, wave, lane, (bf16*)(ws + WS_OPART));
#endif
        }
    SEAM(4);
    if (IN(5)) {
        { LAS float* scr = (LAS float*)(lds + wave * 16384); const int gw = vcu * NWAVES + wave, NGW = G * NWAVES;
          if (blockIdx.x == 0 && tid < 256) *(GAS v4u*)(ws + WS_HB - 4096 + tid * 16) = (v4u){0u, 0u, 0u, 0u};
          __syncthreads(); }
        pg8::Gemm g{(const bf16*)(ws + WS_CA), (const bf16*)(ws + WS_Q), (const bf16*)(ws + WS_WOA), (const bf16*)(ws + WS_WOB), D, TSTEP};
        pg8::DualOrder S; S.S.init(M / 256, D / 256, G, (int)blockIdx.x);
        pg8::Epi4 E{(bf16*)(ws + WS_MG), (const bf16*)out};
        pg8::gemm_phase<pg8::Epi4, pg8::DualOrder, true, true>(lds, g, S, E);
    }
    SEAM(5);
    if (IN(6)) {
        pg8::Gemm g{(const bf16*)(ws + WS_MG), (const bf16*)(ws + WS_MG), (const bf16*)(ws + WS_WO), (const bf16*)(ws + WS_WO), D, TSTEP};
        pg8::StaticOrder S; S.init(M / 256, D / 256, G, (int)blockIdx.x);
        pg8::Epi5 E{x, out, (bf16*)(ws + WS_HB), rowss};
        pg8::gemm_phase<pg8::Epi5, pg8::StaticOrder, true, true>(lds, g, S, E);
#if MK_DUP == 6
        { pg8::Epi5 E2{x, (float*)(ws + WS_Q), (bf16*)(ws + WS_VT), (float*)(ws + WS_CA)}; pg8::gemm_phase<pg8::Epi5, pg8::StaticOrder, true, true>(lds, g, S, E2); }
#endif
    }
    SEAM(6);
    if (IN(7)) {
        const bf16* hb2 = (const bf16*)(ws + WS_HB) - 2 * 1024;
        pg8::Gemm g{hb2, hb2, (const bf16*)(ws + WS_WUP), (const bf16*)(ws + WS_WUP), D, (size_t)254 * 1024 * 2};
        pg8::StaticOrder S; S.init(65, 22, G, (int)blockIdx.x);
        pg8::Epi6 E{(bf16*)(ws + WS_ACT), rowss, ffn_conv_w, ffn_conv_b, (PG8_LAS float*)(lds + HALO_OFF)};
        pg8::gemm_phase<pg8::Epi6, pg8::StaticOrder, true, true>(lds, g, S, E);
        { const int nwg = 65 * 22, full = nwg % G, nidle = full ? G - full : G, idx = full ? (int)blockIdx.x - full : (int)blockIdx.x;
          if (idx >= 0) convert_weight(w_down, DFF, D, (bf16*)(ws + WS_WDN), nullptr, 0, (LAS float*)(lds + wave * 16384), idx * NWAVES + wave, nidle * NWAVES, lane);
          __syncthreads(); }
    }
    SEAM(7);
    if (IN(8)) {
        pg8::Gemm g{(const bf16*)(ws + WS_ACT), (const bf16*)(ws + WS_ACT), (const bf16*)(ws + WS_WDN), (const bf16*)(ws + WS_WDN), DFF, (size_t)256 * DFF * 2};
        pg8::StaticOrder S; S.init(M / 256, D / 256, G, (int)blockIdx.x);
        pg8::Epi7 E{out, (const bf16*)(ws + WS_HB)};
        pg8::gemm_phase<pg8::Epi7, pg8::StaticOrder, true, true>(lds, g, S, E);
#if MK_DUP == 8
        { pg8::Epi7 E2{(float*)(ws + WS_MG), (const bf16*)(ws + WS_HB)}; pg8::gemm_phase<pg8::Epi7, pg8::StaticOrder, true, true>(lds, g, S, E2); }
#endif
    }
#undef IN
#undef SEAM
}

extern "C" void kernel_launch(void* const* d_in, const int* in_sizes, int n_in, void* d_out, int out_size, void* d_ws, size_t ws_size, hipStream_t stream) {
    static int grid = 0;
    if (grid == 0) {
        if (n_in != 14 || in_sizes[0] != M * D || out_size != M * D || ws_size < WS_END) { fprintf(stderr, "kernel_launch: unexpected shapes (n_in %d, in0 %d, out %d, ws %zu)\n", n_in, n_in > 0 ? in_sizes[0] : -1, out_size, ws_size); grid = -1; return; }
        int dev = 0, cus = 0, per_cu = 0;
        if (hipGetDevice(&dev) != hipSuccess || hipDeviceGetAttribute(&cus, hipDeviceAttributeMultiprocessorCount, dev) != hipSuccess) { grid = -1; return; }
        if (hipFuncSetAttribute((const void*)hybrid_fwd, hipFuncAttributeMaxDynamicSharedMemorySize, LDS_BYTES) != hipSuccess) { fprintf(stderr, "kernel_launch: hipFuncSetAttribute failed\n"); grid = -1; return; }
        if (hipOccupancyMaxActiveBlocksPerMultiprocessor(&per_cu, (const void*)hybrid_fwd, NTHREADS, LDS_BYTES) != hipSuccess || per_cu < 1) { fprintf(stderr, "kernel_launch: occupancy query says %d blocks per CU\n", per_cu); (void)hipGetLastError(); grid = -1; return; }
        grid = cus;
    }
    if (grid < 0) return;
    if (hipMemsetAsync((char*)d_ws + WS_CTL, 0, CTL_ZERO_BYTES, stream) != hipSuccess) { fprintf(stderr, "kernel_launch: memset failed\n"); return; }
    Args a{};
    for (int i = 0; i < 14; ++i) a.in[i] = (const float*)d_in[i];
    a.out = (float*)d_out; a.ws = (unsigned char*)d_ws;
#if MK_PER_PHASE
    for (int p = 0; p < N_PHASES; ++p) { a.ph_lo = p; a.ph_hi = p + 1; hipLaunchKernelGGL(hybrid_fwd, dim3(grid), dim3(NTHREADS), LDS_BYTES, stream, a); }
#else
    a.ph_lo = 0; a.ph_hi = N_PHASES;
    void* kargs[] = {&a};
    hipError_t e = hipLaunchCooperativeKernel((const void*)hybrid_fwd, dim3(grid), dim3(NTHREADS), kargs, LDS_BYTES, stream);
    if (e != hipSuccess) fprintf(stderr, "kernel_launch: cooperative launch failed: %s (grid %d)\n", hipGetErrorString(e), grid);
#endif
}
```

```cpp
#include <hip/hip_runtime.h>
#include <cstdio>
#include <cstdint>
namespace pg8 {
#define PG8_LAS __attribute__((address_space(3)))
typedef unsigned short bf16_t;
typedef short bf16x8 __attribute__((ext_vector_type(8)));
typedef float f32x4 __attribute__((ext_vector_type(4)));
typedef unsigned u32x4 __attribute__((ext_vector_type(4)));
constexpr int BM = 256, BK = 64, HALF = 128, HTB = HALF * BK * 2  , STAGE_BYTES = 8 * HTB, NXCD = 8, WGM = 8;

__host__ __device__ __forceinline__ int lds_byte(int r, int c) { const int st = (r >> 4) * 2 + (c >> 5), rr = r & 15, cc = c & 31, ob = rr * 64 + cc * 2; return st * 1024 + (ob ^ (((ob >> 9) & 1) << 5)); }
__host__ __device__ __forceinline__ void stage_rc(int b, int& R, int& C) { const int st = b / 1024, sb = b % 1024, swz = sb ^ (((sb >> 9) & 1) << 5); R = (st >> 1) * 16 + swz / 64; C = (st & 1) * 32 + (swz % 64) / 2; }
__host__ __device__ __forceinline__ int perm32(int rho) { const int n = rho >> 4, i = rho & 15; return 8 * (i >> 2) + 4 * n + (i & 3); }


struct Unit { int pm, pn, sel; };
struct Gemm { const bf16_t* A0; const bf16_t* A1; const bf16_t* B0; const bf16_t* B1; int K; size_t a_tstep; };

struct StaticOrder {
    int nM, nN, nwg, G, c;
    __host__ __device__ void init(int nM_, int nN_, int G_, int c_) { nM = nM_; nN = nN_; nwg = nM * nN; G = G_; c = c_; }
    __host__ __device__ bool next(int i, Unit& u) const {
        const long L = (long)i * G + c; if (L >= nwg) return false;
        int wgid = (int)L; { const int q = nwg / NXCD, r = nwg % NXCD, xcd = wgid % NXCD, off = wgid / NXCD; wgid = (xcd < r ? xcd * (q + 1) : r * (q + 1) + (xcd - r) * q) + off; }
        const int nig = WGM * nN, gid = wgid / nig, fm = gid * WGM, gsz = (nM - fm) < WGM ? (nM - fm) : WGM;
        u.pm = fm + ((wgid % nig) % gsz); u.pn = (wgid % nig) / gsz; u.sel = 0; return true;
    }
    __device__ __forceinline__ void a_ready(const Unit&) const {}
    __device__ __forceinline__ void done(const Unit&) const {}
};
struct DualOrder {
    StaticOrder S;
    __host__ __device__ bool next(int i, Unit& u) const { const bool ok = S.next(i >> 1, u); u.sel = i & 1; return ok; }
    __device__ __forceinline__ void a_ready(const Unit&) const {}
    __device__ __forceinline__ void done(const Unit&) const {}
};

typedef __bf16 bf16x2_t_ __attribute__((ext_vector_type(2))); typedef float f32x2_t_ __attribute__((ext_vector_type(2)));
__device__ __forceinline__ unsigned cvt_pk_bf16(float lo, float hi) { const f32x2_t_ v = {lo, hi}; const bf16x2_t_ b = __builtin_convertvector(v, bf16x2_t_); return __builtin_bit_cast(unsigned, b); }
__device__ __forceinline__ float bf_lo(unsigned w) { return __uint_as_float(w << 16); }
__device__ __forceinline__ float bf_hi(unsigned w) { return __uint_as_float(w & 0xffff0000u); }
__device__ __forceinline__ float fast_sigmoid(float x) { return __builtin_amdgcn_rcpf(1.0f + __builtin_amdgcn_exp2f(-1.4426950408889634f * x)); }
__device__ __forceinline__ u32x4 pack8(const f32x4 a, const f32x4 b) { u32x4 w; w.x = cvt_pk_bf16(a[0], a[1]); w.y = cvt_pk_bf16(a[2], a[3]); w.z = cvt_pk_bf16(b[0], b[1]); w.w = cvt_pk_bf16(b[2], b[3]); return w; }

template <int CTRL> __device__ __forceinline__ float dpp_shr(float old, float v) { return __builtin_bit_cast(float, __builtin_amdgcn_update_dpp(__builtin_bit_cast(int, old), __builtin_bit_cast(int, v), CTRL, 0xf, 0xf, false)); }
template <int CTRL> __device__ __forceinline__ float dpp_ror(float v) { return __builtin_bit_cast(float, __builtin_amdgcn_update_dpp(0, __builtin_bit_cast(int, v), CTRL, 0xf, 0xf, true)); }
constexpr int MROWS = 16384, DMODEL = 1024, DFF_ = 2816;

struct Epi1 {
    static constexpr bool PERM = true, AFTER_DRAIN = false;
    static __device__ __forceinline__ bool keep_acc(const Unit&) { return false; }
    bf16_t *BG, *UU, *Q, *K, *VT, *SG; const float* rstdx; const float *q_norm, *k_norm; float* kbar; PG8_LAS float* xl;
    __device__ __forceinline__ void operator()(f32x4 (&acc)[2][2][4][2], const Unit& u, int wr, int wc, int fr, int fq) const {
        const int row0 = u.pm * BM + wr * 64 + fr, colw = wc * 32 + 8 * fq, pn = u.pn;
        if (pn >= 12 && pn < 20) {
            const bool isK = pn >= 16; const float* wn = isK ? k_norm : q_norm; const float gs = isK ? 1.0f : 0.12751743074602357f;
            bf16_t* dst = isK ? K : Q; const int cb = ((pn - 12) & 3) * 256;
#pragma unroll
            for (int ai = 0; ai < 2; ++ai)
#pragma unroll
                for (int m = 0; m < 4; ++m) { const int rl = ai * HALF + wr * 64 + m * 16 + fr; const float rs = rstdx[u.pm * BM + rl];
#pragma unroll
                    for (int bj = 0; bj < 2; ++bj) { const f32x4 a = acc[ai][bj][m][0] * rs, b = acc[ai][bj][m][1] * rs; acc[ai][bj][m][0] = a; acc[ai][bj][m][1] = b;
                        float ss = (a[0] * a[0] + a[1] * a[1]) + (a[2] * a[2] + a[3] * a[3]) + (b[0] * b[0] + b[1] * b[1]) + (b[2] * b[2] + b[3] * b[3]);
                        ss += __shfl_xor(ss, 16); ss += __shfl_xor(ss, 32);
                        if (fq == 0) xl[(rl * 2 + bj) * 4 + wc] = ss; } }
            asm volatile("s_waitcnt lgkmcnt(0)" ::: "memory"); __builtin_amdgcn_s_barrier(); asm volatile("" ::: "memory");
            const f32x4 g0 = *(const f32x4*)(wn + colw) * gs, g1 = *(const f32x4*)(wn + colw + 4) * gs;
#pragma unroll
            for (int ai = 0; ai < 2; ++ai)
#pragma unroll
                for (int m = 0; m < 4; ++m) { const int rl = ai * HALF + wr * 64 + m * 16 + fr; const int r = u.pm * BM + rl;
#pragma unroll
                    for (int bj = 0; bj < 2; ++bj) { const f32x4 p = *(const PG8_LAS f32x4*)(xl + (rl * 2 + bj) * 4);
                        const float rn = rsqrtf(((p[0] + p[1]) + (p[2] + p[3])) * (1.0f / 128.0f) + 1e-6f);
                        const f32x4 a = acc[ai][bj][m][0] * rn * g0, b = acc[ai][bj][m][1] * rn * g1; acc[ai][bj][m][0] = a; acc[ai][bj][m][1] = b;
                        *(u32x4*)(dst + (size_t)r * 1024 + cb + bj * 128 + colw) = pack8(a, b); } }
            if (isK) {
                f32x4 cs[2][2];
#pragma unroll
                for (int bj = 0; bj < 2; ++bj)
#pragma unroll
                    for (int n = 0; n < 2; ++n) { f32x4 t = acc[0][bj][0][n];
#pragma unroll
                        for (int ai = 0; ai < 2; ++ai)
#pragma unroll
                            for (int m = 0; m < 4; ++m) if (ai + m > 0) t += acc[ai][bj][m][n];
                        cs[bj][n] = t; }
#pragma unroll
                for (int bj = 0; bj < 2; ++bj)
#pragma unroll
                    for (int n = 0; n < 2; ++n)
#pragma unroll
                        for (int e = 0; e < 4; ++e) { float v = cs[bj][n][e]; v += __shfl_xor(v, 1); v += __shfl_xor(v, 2); v += __shfl_xor(v, 4); v += __shfl_xor(v, 8); cs[bj][n][e] = v; }
                if (fr == 0) {
#pragma unroll
                    for (int bj = 0; bj < 2; ++bj) { *(PG8_LAS f32x4*)(xl + 2048 + wr * 256 + bj * 128 + colw) = cs[bj][0]; *(PG8_LAS f32x4*)(xl + 2048 + wr * 256 + bj * 128 + colw + 4) = cs[bj][1]; } }
                asm volatile("s_waitcnt lgkmcnt(0)" ::: "memory"); __builtin_amdgcn_s_barrier(); asm volatile("" ::: "memory");
                int t = threadIdx.x; asm volatile("" : "+v"(t));
                if (t < 256) kbar[((size_t)((pn - 16) * 2 + (t >> 7)) * 64 + u.pm) * 128 + (t & 127)] = (xl[2048 + t] + xl[2048 + 256 + t]) * (1.0f / 256.0f);
            }
            return;
        }
        if (pn >= 20 && pn < 24) {
            int tidv = threadIdx.x; asm volatile("" : "+v"(tidv));
            PG8_LAS unsigned char* T = (PG8_LAS unsigned char*)xl + (tidv >> 6) * 2304;
            const int lane = tidv & 63;
#pragma unroll
            for (int ai = 0; ai < 2; ++ai)
#pragma unroll
                for (int mp = 0; mp < 2; ++mp)
#pragma unroll
                    for (int bj = 0; bj < 2; ++bj) {
#pragma unroll
                        for (int mm = 0; mm < 2; ++mm) { const int m = 2 * mp + mm; const float rs = rstdx[u.pm * BM + ai * HALF + wr * 64 + m * 16 + fr];
                            const u32x4 w = pack8(acc[ai][bj][m][0] * rs, acc[ai][bj][m][1] * rs); const unsigned ww[4] = {w.x, w.y, w.z, w.w};
                            PG8_LAS unsigned char* tp = T + (8 * fq) * 72 + (16 * mm + fr) * 2;
#pragma unroll
                            for (int e = 0; e < 8; ++e) *(PG8_LAS unsigned short*)(tp + e * 72) = (unsigned short)((e & 1) ? (ww[e >> 1] >> 16) : (ww[e >> 1] & 0xffffu)); }
                        asm volatile("s_waitcnt lgkmcnt(0)" ::: "memory");
#pragma unroll
                        for (int rr = 0; rr < 2; ++rr) { const int q = lane + 64 * rr, d = q >> 2, tc = q & 3;
                            const unsigned long long x0 = *(const PG8_LAS unsigned long long*)(T + d * 72 + tc * 16), x1 = *(const PG8_LAS unsigned long long*)(T + d * 72 + tc * 16 + 8);
                            u32x4 o; o.x = (unsigned)x0; o.y = (unsigned)(x0 >> 32); o.z = (unsigned)x1; o.w = (unsigned)(x1 >> 32);
                            *(u32x4*)(VT + ((size_t)(((pn - 20) * 2 + bj) * 128 + 32 * wc + d)) * MROWS + u.pm * BM + ai * HALF + wr * 64 + 32 * mp + tc * 8) = o; }
                        asm volatile("s_waitcnt lgkmcnt(0)" ::: "memory");
                    }
            return;
        }
#pragma unroll
        for (int ai = 0; ai < 2; ++ai)
#pragma unroll
            for (int m = 0; m < 4; ++m) {
                const int r = row0 + ai * HALF + m * 16; const float rs = rstdx[r];
                f32x4 v[2][2];
#pragma unroll
                for (int bj = 0; bj < 2; ++bj)
#pragma unroll
                    for (int n = 0; n < 2; ++n) v[bj][n] = acc[ai][bj][m][n] * rs;
                if (pn < 4) {
#pragma unroll
                    for (int bj = 0; bj < 2; ++bj) *(u32x4*)(BG + (size_t)r * 1024 + pn * 256 + bj * 128 + colw) = pack8(v[bj][0], v[bj][1]);
                } else if (pn < 12) {
                    *(u32x4*)(UU + (size_t)r * 1024 + (pn - 4) * 128 + colw) = pack8(v[0][0] * v[1][0], v[0][1] * v[1][1]);
                } else {
                    f32x4 ra, rb, sa, sb;
#pragma unroll
                    for (int e = 0; e < 4; ++e) { const float ea0 = __builtin_amdgcn_exp2f(-1.4426950408889634f * v[0][0][e]), ea1 = __builtin_amdgcn_exp2f(-1.4426950408889634f * v[0][1][e]);
                        const float eb0 = __builtin_amdgcn_exp2f(-1.4426950408889634f * v[1][0][e]), eb1 = __builtin_amdgcn_exp2f(-1.4426950408889634f * v[1][1][e]);
                        ra[e] = (1.0f + eb0) * __builtin_amdgcn_rcpf(1.0f + ea0); rb[e] = (1.0f + eb1) * __builtin_amdgcn_rcpf(1.0f + ea1);
                        sa[e] = __builtin_amdgcn_rcpf(1.0f + eb0); sb[e] = __builtin_amdgcn_rcpf(1.0f + eb1); }
                    *(u32x4*)(SG + (size_t)r * 2048 + (pn - 24) * 128 + colw) = pack8(ra, rb);
                    *(u32x4*)(SG + (size_t)r * 2048 + 1024 + (pn - 24) * 128 + colw) = pack8(sa, sb);
                }
            }
    }
};
struct Epi4 {
    static constexpr bool PERM = true, AFTER_DRAIN = false;
    bf16_t* MG; const bf16_t* SG;
    static __device__ __forceinline__ bool keep_acc(const Unit& u) { return u.sel == 0; }
    __device__ __forceinline__ void operator()(f32x4 (&acc)[2][2][4][2], const Unit& u, int wr, int wc, int fr, int fq) const {
        const int row0 = u.pm * BM + wr * 64 + fr, col0 = u.pn * BM + wc * 32 + 8 * fq;
#pragma unroll
        for (int ai = 0; ai < 2; ++ai)
#pragma unroll
            for (int m = 0; m < 4; ++m) { const int r = row0 + ai * HALF + m * 16;
#pragma unroll
                for (int bj = 0; bj < 2; ++bj) { const int c = col0 + bj * HALF;
                    const u32x4 g = *(const u32x4*)(SG + (size_t)r * 2048 + u.sel * 1024 + c);
                    f32x4 a = acc[ai][bj][m][0], b = acc[ai][bj][m][1];
                    a[0] *= bf_lo(g.x); a[1] *= bf_hi(g.x); a[2] *= bf_lo(g.y); a[3] *= bf_hi(g.y); b[0] *= bf_lo(g.z); b[1] *= bf_hi(g.z); b[2] *= bf_lo(g.w); b[3] *= bf_hi(g.w);
                    if (u.sel) *(u32x4*)(MG + (size_t)r * 1024 + c) = pack8(a, b);
                    else { acc[ai][bj][m][0] = a; acc[ai][bj][m][1] = b; } } }
    }
};
struct Epi5 {
    static constexpr bool PERM = true, AFTER_DRAIN = false;
    static __device__ __forceinline__ bool keep_acc(const Unit&) { return false; }
    const float* X; float* OUT; bf16_t* HB; float* rowss;
    __device__ __forceinline__ void operator()(f32x4 (&acc)[2][2][4][2], const Unit& u, int wr, int wc, int fr, int fq) const {
        const int row0 = u.pm * BM + wr * 64 + fr, col0 = u.pn * BM + wc * 32 + 8 * fq;
#pragma unroll
        for (int ai = 0; ai < 2; ++ai)
#pragma unroll
            for (int m = 0; m < 4; ++m) { const int r = row0 + ai * HALF + m * 16; float ss = 0.f;
#pragma unroll
                for (int bj = 0; bj < 2; ++bj) { const size_t o = (size_t)r * 1024 + col0 + bj * HALF;
                    const f32x4 a = acc[ai][bj][m][0] + *(const f32x4*)(X + o), b = acc[ai][bj][m][1] + *(const f32x4*)(X + o + 4);
                    *(u32x4*)(HB + o) = pack8(a, b);
                    ss += (a[0] * a[0] + a[1] * a[1]) + (a[2] * a[2] + a[3] * a[3]) + (b[0] * b[0] + b[1] * b[1]) + (b[2] * b[2] + b[3] * b[3]); }
                ss += __shfl_xor(ss, 16); ss += __shfl_xor(ss, 32);
                if (fq == 0) atomicAdd(rowss + r, ss); }
    }
};
struct Epi6 {
    static constexpr bool PERM = true, AFTER_DRAIN = false;
    static __device__ __forceinline__ bool keep_acc(const Unit&) { return false; }
    bf16_t* ACT; const float* rowss; const float* cw; const float* cb; PG8_LAS float* halo;
    __device__ __forceinline__ void operator()(f32x4 (&acc)[2][2][4][2], const Unit& u, int wr, int wc, int fr, int fq) const {
        const int r0 = u.pm * 254 - 2, colw = wc * 32 + 8 * fq;
#pragma unroll
        for (int ai = 0; ai < 2; ++ai)
#pragma unroll
            for (int m = 0; m < 4; ++m) { int gr = r0 + ai * HALF + wr * 64 + m * 16 + fr; gr = gr < 0 ? 0 : (gr > MROWS - 1 ? MROWS - 1 : gr);
                const float rs = rsqrtf(rowss[gr] * (1.0f / 1024.0f) + 1e-6f);
#pragma unroll
                for (int bj = 0; bj < 2; ++bj)
#pragma unroll
                    for (int n = 0; n < 2; ++n) acc[ai][bj][m][n] *= rs; }
        if (fr >= 14) {
#pragma unroll
            for (int ai = 0; ai < 2; ++ai)
#pragma unroll
                for (int bj = 0; bj < 2; ++bj)
#pragma unroll
                    for (int n = 0; n < 2; ++n) *(PG8_LAS f32x4*)(halo + (((2 * ai + wr) * 2 + (fr - 14)) * 256 + bj * 128 + colw + 4 * n)) = acc[ai][bj][3][n];
        }
        f32x4 wn0, wn1, wn2, wnb;
        { const int col = u.pn * 128 + colw; wn0 = *(const f32x4*)(cw + col); wn1 = *(const f32x4*)(cw + 2 * DFF_ + col); wn2 = *(const f32x4*)(cw + 4 * DFF_ + col); wnb = *(const f32x4*)(cb + col); }
        asm volatile("s_waitcnt lgkmcnt(0)" ::: "memory"); __builtin_amdgcn_s_barrier(); asm volatile("" ::: "memory");
#pragma unroll
        for (int bj = 0; bj < 2; ++bj)
#pragma unroll
            for (int n = 0; n < 2; ++n) {
                const f32x4 w0 = wn0, w1 = wn1, w2 = wn2, bb = wnb;
                if (bj * 2 + n < 3) { const int k2 = bj * 2 + n + 1, col = (k2 >> 1) * DFF_ + u.pn * 128 + colw + 4 * (k2 & 1);
                    wn0 = *(const f32x4*)(cw + col); wn1 = *(const f32x4*)(cw + 2 * DFF_ + col); wn2 = *(const f32x4*)(cw + 4 * DFF_ + col); wnb = *(const f32x4*)(cb + col); }
#pragma unroll
                for (int ai = 0; ai < 2; ++ai) {
                    const int s = 2 * ai + wr;
                    const int sm = s > 0 ? s - 1 : 0; const float hz = s > 0 ? 1.0f : 0.0f;
                    const f32x4 h2 = *(const PG8_LAS f32x4*)(halo + ((sm * 2 + 0) * 256 + bj * 128 + colw + 4 * n)) * hz, h1 = *(const PG8_LAS f32x4*)(halo + ((sm * 2 + 1) * 256 + bj * 128 + colw + 4 * n)) * hz;
#pragma unroll
                    for (int mm = 0; mm < 4; ++mm) { const int m = 3 - mm;
                        f32x4 cur = acc[ai][bj][m][n]; asm volatile("" : "+v"(cur)); f32x4 p1, p2;
                        if (m > 0) { f32x4 lo = acc[ai][bj][m > 0 ? m - 1 : 0][n]; asm volatile("" : "+v"(lo));
#pragma unroll
                            for (int e = 0; e < 4; ++e) { p1[e] = dpp_shr<0x111>(dpp_ror<0x121>(lo[e]), cur[e]); p2[e] = dpp_shr<0x112>(dpp_ror<0x122>(lo[e]), cur[e]); } }
                        else {
#pragma unroll
                            for (int e = 0; e < 4; ++e) { p1[e] = dpp_shr<0x111>(h1[e], cur[e]); p2[e] = dpp_shr<0x112>(fr == 0 ? h2[e] : h1[e], cur[e]); } }
                        { f32x4 r_ = w0 * p2 + w1 * p1 + w2 * cur + bb; asm volatile("" : "+v"(r_)); acc[ai][bj][m][n] = r_; } }
                }
            }
#pragma unroll
        for (int ai = 0; ai < 2; ++ai)
#pragma unroll
            for (int m = 0; m < 4; ++m) { const int i = ai * HALF + wr * 64 + m * 16 + fr, gr = r0 + i;
                f32x4 a, b;
#pragma unroll
                for (int e = 0; e < 4; ++e) { const float g0 = acc[ai][0][m][0][e], g1 = acc[ai][0][m][1][e];
                    a[e] = g0 * fast_sigmoid(g0) * acc[ai][1][m][0][e]; b[e] = g1 * fast_sigmoid(g1) * acc[ai][1][m][1][e]; }
                if (i >= 2 && gr < MROWS) *(u32x4*)(ACT + (size_t)gr * DFF_ + u.pn * 128 + colw) = pack8(a, b); }
    }
};
struct Epi7 {
    static constexpr bool PERM = true, AFTER_DRAIN = false;
    static __device__ __forceinline__ bool keep_acc(const Unit&) { return false; }
    float* OUT; const bf16_t* HB;
    __device__ __forceinline__ void operator()(f32x4 (&acc)[2][2][4][2], const Unit& u, int wr, int wc, int fr, int fq) const {
        const int row0 = u.pm * BM + wr * 64 + fr, col0 = u.pn * BM + wc * 32 + 8 * fq;
#pragma unroll
        for (int ai = 0; ai < 2; ++ai)
#pragma unroll
            for (int m = 0; m < 4; ++m) { const int r = row0 + ai * HALF + m * 16;
#pragma unroll
                for (int bj = 0; bj < 2; ++bj) { const size_t o = (size_t)r * 1024 + col0 + bj * HALF; float* p = OUT + o; const u32x4 hw = *(const u32x4*)(HB + o);
                    f32x4 a = acc[ai][bj][m][0], b = acc[ai][bj][m][1];
                    a[0] += bf_lo(hw.x); a[1] += bf_hi(hw.x); a[2] += bf_lo(hw.y); a[3] += bf_hi(hw.y); b[0] += bf_lo(hw.z); b[1] += bf_hi(hw.z); b[2] += bf_lo(hw.w); b[3] += bf_hi(hw.w);
                    *(f32x4*)p = a; *(f32x4*)(p + 4) = b; } }
    }
};
template <class Epi, class Sched, bool ALIGN_EPI = false, bool SP2 = false>
__device__ __forceinline__ void gemm_phase(PG8_LAS unsigned char* lds, const Gemm g, const Sched& S, const Epi& E) {
    const int tid = threadIdx.x, wid = __builtin_amdgcn_readfirstlane(tid >> 6), lane = tid & 63, wr = wid >> 2, wc = wid & 3, fr = lane & 15, fq = lane >> 4;
    const int K = g.K, nt = K / BK;
    unsigned voffA[2], voffB[2];
#pragma unroll
    for (int i = 0; i < 2; ++i) { int R, C; stage_rc(tid * 16 + i * 8192, R, C); const int Rb = Epi::PERM ? ((R & ~31) + perm32(R & 31)) : R;
        voffA[i] = (unsigned)(R * K + C) * 2u; voffB[i] = (unsigned)(Rb * K + C) * 2u; }
    const size_t kstep = (size_t)(BK * 2);
    const size_t hstep = (size_t)HALF * K * 2;
    const size_t tstep = 2 * hstep;
    const unsigned ldsw = (unsigned)wid * 1024u;
    const int aoff = lds_byte(wr * 64 + fr, fq * 8), boff = lds_byte(wc * 32 + fr, fq * 8);
#define PG8_SA(b, h) (((b) * 2 + (h)) * HTB)
#define PG8_SB(b, h) ((4 + (b) * 2 + (h)) * HTB)
#define PG8_STAGE(bufoff, gbase, voff) do { _Pragma("unroll") for (int _i = 0; _i < 2; ++_i) \
        __builtin_amdgcn_global_load_lds((const unsigned*)((const char*)(gbase) + (voff)[_i]), (PG8_LAS unsigned*)(lds + (bufoff) + ldsw + _i * 8192), 16, 0, 0); } while (0)
#define PG8_LDA(dst, b, h) do { _Pragma("unroll") for (int m = 0; m < 4; ++m) _Pragma("unroll") for (int k = 0; k < 2; ++k) dst[m][k] = *(const PG8_LAS bf16x8*)(lds + PG8_SA(b, h) + aoff + m * 2048 + k * 1024); } while (0)
#define PG8_LDB(dst, b, h) do { _Pragma("unroll") for (int n = 0; n < 2; ++n) _Pragma("unroll") for (int k = 0; k < 2; ++k) dst[n][k] = *(const PG8_LAS bf16x8*)(lds + PG8_SB(b, h) + boff + n * 2048 + k * 1024); } while (0)
#define PG8_MMA(ai, bj, At, Bt) do { __builtin_amdgcn_s_setprio(1); _Pragma("unroll") for (int m = 0; m < 4; ++m) _Pragma("unroll") for (int n = 0; n < 2; ++n) _Pragma("unroll") for (int k = 0; k < 2; ++k) \
        acc[ai][bj][m][n] = __builtin_amdgcn_mfma_f32_16x16x32_bf16(Bt[n][k], At[m][k], acc[ai][bj][m][n], 0, 0, 0); __builtin_amdgcn_s_setprio(0); } while (0)
#define PG8_WAIT_V(n) asm volatile("s_waitcnt vmcnt(" #n ")" ::: "memory")
#define PG8_WAIT_L(n) asm volatile("s_waitcnt lgkmcnt(" #n ")" ::: "memory")
#define PG8_BAR __builtin_amdgcn_s_barrier()
#define PG8_SCHED __builtin_amdgcn_sched_barrier(0)
    Unit cur, nxt; int ui = 0;
    if (!S.next(0, cur)) return;
    f32x4 acc[2][2][4][2];
#pragma unroll
    for (int a = 0; a < 2; ++a)
#pragma unroll
        for (int b = 0; b < 2; ++b)
#pragma unroll
            for (int m = 0; m < 4; ++m)
#pragma unroll
                for (int n = 0; n < 2; ++n) acc[a][b][m][n] = (f32x4){0.f, 0.f, 0.f, 0.f};
    bf16x8 At[4][2], B0[2][2], B1[2][2];
    const char* cA = (const char*)(cur.sel ? g.A1 : g.A0) + (size_t)cur.pm * g.a_tstep; const char* cB = (const char*)(cur.sel ? g.B1 : g.B0) + (size_t)cur.pn * tstep;
    S.a_ready(cur);
    if constexpr (SP2) {
        PG8_STAGE(PG8_SB(0, 0), cB, voffB); PG8_STAGE(PG8_SB(0, 1), cB + hstep, voffB); PG8_STAGE(PG8_SA(0, 0), cA, voffA); PG8_STAGE(PG8_SA(0, 1), cA + hstep, voffA);
        if (wr == 1) PG8_BAR;
        PG8_WAIT_V(2); PG8_BAR;
        PG8_STAGE(PG8_SB(1, 0), cB + kstep, voffB); PG8_STAGE(PG8_SA(1, 0), cA + kstep, voffA); PG8_STAGE(PG8_SB(1, 1), cB + hstep + kstep, voffB);
        PG8_WAIT_V(6); PG8_BAR;
    } else {
        PG8_STAGE(PG8_SB(0, 0), cB, voffB); PG8_STAGE(PG8_SA(0, 0), cA, voffA); PG8_STAGE(PG8_SB(0, 1), cB + hstep, voffB); PG8_STAGE(PG8_SA(0, 1), cA + hstep, voffA);
        if (wr == 1) PG8_BAR;
        PG8_WAIT_V(4); PG8_BAR;
        PG8_STAGE(PG8_SB(1, 0), cB + kstep, voffB); PG8_STAGE(PG8_SA(1, 0), cA + kstep, voffA); PG8_STAGE(PG8_SB(1, 1), cB + hstep + kstep, voffB);
        PG8_WAIT_V(6); PG8_BAR;
    }
    for (;;) {
        const bool has_next = S.next(ui + 1, nxt);
        const char* nA = has_next ? (const char*)(nxt.sel ? g.A1 : g.A0) + (size_t)nxt.pm * g.a_tstep : cA; const char* nB = has_next ? (const char*)(nxt.sel ? g.B1 : g.B0) + (size_t)nxt.pn * tstep : cB;
        for (int t = 0; t < nt; t += 2) {
            const bool last = (t == nt - 2);
            const char* a1 = cA + (size_t)(t + 1) * kstep;
            const char* a2 = last ? nA : cA + (size_t)(t + 2) * kstep; const char* b2 = last ? nB : cB + (size_t)(t + 2) * kstep;
            const char* a3 = a2 + kstep; const char* b3 = b2 + kstep;
            if (last && has_next) S.a_ready(nxt);
            if constexpr (SP2) {
            PG8_LDB(B0, 0, 0); PG8_LDB(B1, 0, 1); PG8_SCHED; PG8_LDA(At, 0, 0); PG8_STAGE(PG8_SA(1, 1), a1 + hstep, voffA);
            PG8_WAIT_V(8); PG8_WAIT_L(0); PG8_BAR; PG8_MMA(0, 0, At, B0); PG8_MMA(0, 1, At, B1); PG8_BAR; PG8_SCHED;
            PG8_LDA(At, 0, 1); PG8_STAGE(PG8_SB(0, 0), b2, voffB); PG8_STAGE(PG8_SB(0, 1), b2 + hstep, voffB); PG8_STAGE(PG8_SA(0, 0), a2, voffA);
            PG8_WAIT_V(8); PG8_WAIT_L(0); PG8_BAR; PG8_MMA(1, 0, At, B0); PG8_MMA(1, 1, At, B1); PG8_BAR; PG8_SCHED;
            PG8_LDB(B0, 1, 0); PG8_LDB(B1, 1, 1); PG8_SCHED; PG8_LDA(At, 1, 0); PG8_STAGE(PG8_SA(0, 1), a2 + hstep, voffA);
            PG8_WAIT_V(8); PG8_WAIT_L(0); PG8_BAR; PG8_MMA(0, 0, At, B0); PG8_MMA(0, 1, At, B1); PG8_BAR; PG8_SCHED;
            PG8_LDA(At, 1, 1); PG8_STAGE(PG8_SB(1, 0), b3, voffB); PG8_STAGE(PG8_SB(1, 1), b3 + hstep, voffB); PG8_STAGE(PG8_SA(1, 0), a3, voffA);
            PG8_WAIT_V(8); PG8_WAIT_L(0); PG8_BAR; PG8_MMA(1, 0, At, B0); PG8_MMA(1, 1, At, B1); PG8_BAR; PG8_SCHED;
            } else {
            PG8_LDB(B0, 0, 0); PG8_SCHED; PG8_LDA(At, 0, 0); PG8_STAGE(PG8_SA(1, 1), a1 + hstep, voffA);
            PG8_WAIT_L(8); PG8_BAR; PG8_WAIT_L(0); PG8_MMA(0, 0, At, B0); PG8_BAR; PG8_SCHED;
            PG8_LDB(B1, 0, 1); PG8_STAGE(PG8_SB(0, 0), b2, voffB);
            PG8_BAR; PG8_WAIT_L(0); PG8_MMA(0, 1, At, B1); PG8_BAR;
            PG8_LDA(At, 0, 1); PG8_STAGE(PG8_SA(0, 0), a2, voffA);
            PG8_BAR; PG8_WAIT_L(0); PG8_MMA(1, 0, At, B0); PG8_BAR; PG8_SCHED;
            PG8_STAGE(PG8_SB(0, 1), b2 + hstep, voffB);
            PG8_WAIT_V(6); PG8_BAR; PG8_MMA(1, 1, At, B1); PG8_BAR;
            PG8_LDB(B0, 1, 0); PG8_SCHED; PG8_LDA(At, 1, 0); PG8_STAGE(PG8_SA(0, 1), a2 + hstep, voffA);
            PG8_WAIT_L(8); PG8_BAR; PG8_WAIT_L(0); PG8_MMA(0, 0, At, B0); PG8_BAR; PG8_SCHED;
            PG8_LDB(B1, 1, 1); PG8_STAGE(PG8_SB(1, 0), b3, voffB);
            PG8_BAR; PG8_WAIT_L(0); PG8_MMA(0, 1, At, B1); PG8_BAR;
            PG8_LDA(At, 1, 1); PG8_STAGE(PG8_SA(1, 0), a3, voffA);
            PG8_BAR; PG8_WAIT_L(0); PG8_MMA(1, 0, At, B0); PG8_BAR; PG8_SCHED;
            PG8_STAGE(PG8_SB(1, 1), b3 + hstep, voffB);
            PG8_WAIT_V(6); PG8_BAR; PG8_MMA(1, 1, At, B1); PG8_BAR;
            }
        }
        if constexpr (ALIGN_EPI) { if (wr == 0) PG8_BAR; }
        if constexpr (!Epi::AFTER_DRAIN) { E(acc, cur, wr, wc, fr, fq); S.done(cur); }
        if (!has_next) break;
        if (!Epi::keep_acc(cur)) {
#pragma unroll
        for (int a = 0; a < 2; ++a)
#pragma unroll
            for (int b = 0; b < 2; ++b)
#pragma unroll
                for (int m = 0; m < 4; ++m)
#pragma unroll
                    for (int n = 0; n < 2; ++n) acc[a][b][m][n] = (f32x4){0.f, 0.f, 0.f, 0.f}; }
        cur = nxt; cA = nA; cB = nB; ++ui;
        if constexpr (ALIGN_EPI) { if (wr == 1) PG8_BAR; }
    }
    PG8_WAIT_V(0);
    if constexpr (!ALIGN_EPI) { if (wr == 0) PG8_BAR; }
    PG8_BAR;
    if constexpr (Epi::AFTER_DRAIN) { E.fused(acc, cur, wr, wc, fr, fq, lds, wid, lane); S.done(cur); }
#undef PG8_SA
#undef PG8_SB
#undef PG8_STAGE
#undef PG8_LDA
#undef PG8_LDB
#undef PG8_MMA
#undef PG8_WAIT_V
#undef PG8_WAIT_L
#undef PG8_BAR
#undef PG8_SCHED
}
}
#define GAS __attribute__((address_space(1)))
#define LAS __attribute__((address_space(3)))
typedef unsigned short bf16;
typedef unsigned v4u __attribute__((ext_vector_type(4)));
typedef float f32x4 __attribute__((ext_vector_type(4)));
typedef short bf16x8 __attribute__((ext_vector_type(8)));
typedef GAS unsigned gu32;
typedef GAS unsigned long long gu64;
#define RLX_AGENT __ATOMIC_RELAXED, __HIP_MEMORY_SCOPE_AGENT
#define LDS_WAIT() asm volatile("s_waitcnt lgkmcnt(0)" ::: "memory")
#define VM_WAIT() asm volatile("s_waitcnt vmcnt(0)" ::: "memory")
__device__ __forceinline__ unsigned long long rt() { return __builtin_amdgcn_s_memrealtime(); }
__device__ __forceinline__ unsigned f2bf(float f) { unsigned u = __builtin_bit_cast(unsigned, f); return (u + 0x7fffu + ((u >> 16) & 1u)) >> 16; }
__device__ __forceinline__ unsigned pk2(float lo, float hi) { return f2bf(lo) | (f2bf(hi) << 16); }

#define XB_TMO      128
#define XB_XCNT(j)  (256  + 64 * (j))
#define XB_XSUB(j)  (1280 + 64 * (j))
#define XB_XGEN(j)  (2304 + 64 * (j))
#define XB_TOP      3328
#define XB_TOPGEN   3392
#define XCD_BAR_WORDS 3456
#define XB_SPIN_CAP (1u << 18)

__device__ __forceinline__ unsigned xb_ld(unsigned* p)              { return __hip_atomic_load(p, __ATOMIC_RELAXED, __HIP_MEMORY_SCOPE_AGENT); }
__device__ __forceinline__ unsigned xb_add(unsigned* p, unsigned v) { return __hip_atomic_fetch_add(p, v, __ATOMIC_RELAXED, __HIP_MEMORY_SCOPE_AGENT); }
__device__ __forceinline__ unsigned xb_xcc_id() { return (unsigned)__builtin_amdgcn_s_getreg((3 << 11) | 20) & 0xFu; }
#define XB_SPIN(cond, bar) do { unsigned _sp = 0; while (cond) { __builtin_amdgcn_s_sleep(1); \
    if ((++_sp & 255u) == 0u) { if (xb_ld(&(bar)[XB_TMO])) break; if (_sp > XB_SPIN_CAP) { atomicAdd(&(bar)[XB_TMO], 1u); break; } } } } while (0)

struct XcdBarrier {
    unsigned* bar; unsigned x;
    volatile LAS unsigned* st;
};

__device__ __forceinline__ XcdBarrier xcd_barrier_post(unsigned* bar, volatile LAS unsigned* st) {
    XcdBarrier b; b.bar = bar; b.x = xb_xcc_id(); b.st = st;
    if (threadIdx.x == 0) (void)xb_add(&bar[XB_XCNT(b.x)], 1u);
    return b;
}
__device__ __forceinline__ void xcd_barrier_complete(unsigned* bar, unsigned x, unsigned& nloc, unsigned& nx) {
    const unsigned G = gridDim.x * gridDim.y * gridDim.z;
    unsigned sum, cnt, mine, sp = 0u;
    for (;;) {
        sum = 0u; cnt = 0u; mine = 0u;
#pragma unroll
        for (unsigned j = 0; j < 16; ++j) { const unsigned c = xb_ld(&bar[XB_XCNT(j)]); sum += c; cnt += (c > 0u) ? 1u : 0u; mine = (j == x) ? c : mine; }
        if (sum == G) break;
        __builtin_amdgcn_s_sleep(1);
        if ((++sp & 255u) == 0u) { if (xb_ld(&bar[XB_TMO])) break; if (sp > XB_SPIN_CAP) { atomicAdd(&bar[XB_TMO], 1u); break; } }
    }
    nloc = mine > 0u ? mine : 1u; nx = cnt > 0u ? cnt : 1u;
}

__device__ __forceinline__ void xcd_barrier(const XcdBarrier& b) {
    asm volatile("s_waitcnt vmcnt(0)" ::: "memory");
    __syncthreads();
    if (threadIdx.x == 0) {
        unsigned* bar = b.bar;
        __builtin_amdgcn_s_waitcnt(0);
        unsigned nloc = b.st[0], nx = b.st[1];
        if (nloc == 0u) { xcd_barrier_complete(bar, b.x, nloc, nx); b.st[0] = nloc; b.st[1] = nx; }
        const unsigned old = xb_add(&bar[XB_XSUB(b.x)], 1u);
        const unsigned gen = old / nloc;
        if (old + 1u == (gen + 1u) * nloc) {
            __builtin_amdgcn_fence(__ATOMIC_RELEASE, "agent");
            asm volatile("s_waitcnt vmcnt(0)" ::: "memory");
            const unsigned og = xb_add(&bar[XB_TOP], 1u);
            const unsigned tg = og / nx;
            if (og + 1u == (tg + 1u) * nx) xb_add(&bar[XB_TOPGEN], 1u);
            else XB_SPIN(xb_ld(&bar[XB_TOPGEN]) == tg, bar);
            __builtin_amdgcn_fence(__ATOMIC_ACQUIRE, "agent");
            xb_add(&bar[XB_XGEN(b.x)], 1u);
            asm volatile("s_waitcnt vmcnt(0)" ::: "memory");
        } else {
            XB_SPIN(xb_ld(&bar[XB_XGEN(b.x)]) == gen, bar);
            __builtin_amdgcn_fence(__ATOMIC_ACQUIRE, "agent");
            asm volatile("s_waitcnt vmcnt(0)" ::: "memory");
        }
    }
    __syncthreads();
}


constexpr int NWAVES = 8, NTHREADS = 512;
constexpr int M = 16384, D = 1024, NIN = 8192, DFF = 2816, NH = 8, HD = 128, NBLK = 64, BLK = 256;
constexpr float EPS = 1e-6f;
constexpr float C2 = 0.08838834764831845f * 1.4426950408889634f;
constexpr size_t MiB = 1u << 20;
constexpr size_t WS_CTL = 0, CTL_ZERO_BYTES = 256 * 1024;
constexpr int CW_BAR = 4096, CW_GCNT = 8192, CW_ROWSS = 16384;
constexpr size_t WS_KBAR = 1 * MiB, WS_RSTDX = 1 * MiB + 512 * 1024, WS_LPART = 2 * MiB;
constexpr size_t WS_WOA = 4 * MiB, WS_WOB = 6 * MiB, WS_WO = 8 * MiB;
constexpr size_t WS_Q = 10 * MiB, WS_K = 42 * MiB, WS_VT = 74 * MiB, WS_CA = 106 * MiB, WS_LIST = 138 * MiB, WS_WIN = 147 * MiB, WS_XB = 163 * MiB, WS_UU = 195 * MiB;
constexpr size_t WS_OPART = 147 * MiB;
constexpr size_t WS_WUP = 243 * MiB, WS_WDN = 138 * MiB, WS_MG = 165 * MiB, WS_HB = 198 * MiB;
constexpr size_t WS_ACT = 10 * MiB;
constexpr size_t WS_END = 256 * MiB;
constexpr int LDS_BYTES = 163840, MISC_OFF = 131072 + 320, HALO_OFF = 131072 + 1024, SCAN_OFF = 131072 + 1024;
__device__ __forceinline__ int list_off(int n) { return 256 * (63 * n - (n * (n - 1)) / 2); }
constexpr int LIST_PER_HEAD = 256 * 2016;

__device__ __forceinline__ float wave_sum(float v) {
#pragma unroll
    for (int o = 1; o < 64; o <<= 1) v += __shfl_xor(v, o);
    return v;
}
__device__ __forceinline__ void transpose_item(const float* W, int N, bf16* WT, int K, int k0, int col0, int row0, const float* ks, LAS float* scr, int lane) {
    float wv[32];
#pragma unroll
    for (int i = 0; i < 32; ++i) wv[i] = W[(size_t)(k0 + 2 * i + (lane >> 5)) * N + col0 + (lane & 31)];
#pragma unroll
    for (int i = 0; i < 32; ++i) { const int kk = 2 * i + (lane >> 5); const float s = ks ? ks[k0 + kk] : 1.0f; scr[kk * 33 + (lane & 31)] = s * wv[i]; }
    LDS_WAIT(); asm volatile("" ::: "memory");
    const int c = lane & 7;
#pragma unroll
    for (int j = 0; j < 4; ++j) { const int n = (lane >> 3) + 8 * j; const LAS float* s = scr + (8 * c) * 33 + n;
        v4u o; o.x = pk2(s[0 * 33], s[1 * 33]); o.y = pk2(s[2 * 33], s[3 * 33]); o.z = pk2(s[4 * 33], s[5 * 33]); o.w = pk2(s[6 * 33], s[7 * 33]);
        *(GAS v4u*)(WT + (size_t)(row0 + n) * K + k0 + 8 * c) = o; }
    LDS_WAIT(); asm volatile("" ::: "memory");
}
__device__ __forceinline__ int map_col(int mode, int R) {
    if (mode == 1) { if (R >= 1024 && R < 3072) { const int q = R - 1024; return 1024 + ((q >> 7) & 1) * 1024 + (q >> 8) * 128 + (q & 127); }
                     if (R >= 6144) { const int q = R - 6144; return 6144 + ((q >> 7) & 1) * 1024 + (q >> 8) * 128 + (q & 127); } return R; }
    if (mode == 2) return ((R >> 7) & 1) * DFF + (R >> 8) * 128 + (R & 127);
    return R;
}
__device__ __forceinline__ void convert_weight(const float* W, int K, int N, bf16* WT, const float* ks, int mode, LAS float* scr, int gw, int NGW, int lane) {
    const int nblk = N / 32, nitems = (K / 64) * nblk;
    for (int it = gw; it < nitems; it += NGW) { const int kb = it / nblk, nb = it % nblk; transpose_item(W, N, WT, K, 64 * kb, map_col(mode, 32 * nb), 32 * nb, ks, scr, lane); }
}

__device__ __forceinline__ void phase0(const float* x, const float* norm_mix, const float* w_in, const float* w_oa, const float* w_ob, const float* w_o, const float* w_up, const float* norm_ffn, unsigned char* ws, LAS unsigned char* lds, int vcu, int G, int wave, int lane) {
    LAS float* scr = (LAS float*)(lds + wave * 16384);
    const int gw = vcu * NWAVES + wave, NGW = G * NWAVES;
    convert_weight(w_in, D, NIN, (bf16*)(ws + WS_WIN), norm_mix, 1, scr, gw, NGW, lane);
    convert_weight(w_oa, D, D, (bf16*)(ws + WS_WOA), nullptr, 0, scr, gw, NGW, lane);
    convert_weight(w_ob, D, D, (bf16*)(ws + WS_WOB), nullptr, 0, scr, gw, NGW, lane);
    convert_weight(w_o, D, D, (bf16*)(ws + WS_WO), nullptr, 0, scr, gw, NGW, lane);
    convert_weight(w_up, D, 2 * DFF, (bf16*)(ws + WS_WUP), norm_ffn, 2, scr, gw, NGW, lane);
    bf16* XB = (bf16*)(ws + WS_XB); float* rstdx = (float*)(ws + WS_RSTDX);
    for (int m = gw; m < M; m += NGW) {
        const GAS f32x4* xr = (const GAS f32x4*)(x + (size_t)m * D) + lane; f32x4 v[4]; float s = 0.f;
#pragma unroll
        for (int j = 0; j < 4; ++j) { v[j] = xr[64 * j]; s += (v[j].x * v[j].x + v[j].y * v[j].y) + (v[j].z * v[j].z + v[j].w * v[j].w); }
        s = wave_sum(s); if (lane == 0) rstdx[m] = rsqrtf(s * (1.f / D) + EPS);
        GAS unsigned long long* o8 = (GAS unsigned long long*)(XB + (size_t)m * D) + lane;
#pragma unroll
        for (int j = 0; j < 4; ++j) o8[64 * j] = (unsigned long long)pk2(v[j].x, v[j].y) | ((unsigned long long)pk2(v[j].z, v[j].w) << 32);
    }
}
__device__ __forceinline__ void phase2(const float* conv_a_w, unsigned char* ws, int G, int tid, bf16* __restrict__ CAout) {
    const bf16* __restrict__ BG = (const bf16*)(ws + WS_CA); const bf16* __restrict__ UU = (const bf16*)(ws + WS_UU);
    for (int item = blockIdx.x * NTHREADS + tid; item < 128 * (M / 16); item += G * NTHREADS) {
        const int cc = (item & 127) * 8, t0 = (item >> 7) * 16;
        float w0[8], w1[8], w2[8], um2[8], um1[8];
#pragma unroll
        for (int j = 0; j < 2; ++j) { const f32x4 a = *(const GAS f32x4*)(conv_a_w + cc + 4 * j), b = *(const GAS f32x4*)(conv_a_w + 1024 + cc + 4 * j), c = *(const GAS f32x4*)(conv_a_w + 2048 + cc + 4 * j);
#pragma unroll
            for (int e = 0; e < 4; ++e) { w0[4 * j + e] = a[e]; w1[4 * j + e] = b[e]; w2[4 * j + e] = c[e]; } }
        { v4u a = (v4u){0u, 0u, 0u, 0u}, b = a; if (t0 >= 2) { a = *(const GAS v4u*)(UU + (size_t)(t0 - 2) * 1024 + cc); b = *(const GAS v4u*)(UU + (size_t)(t0 - 1) * 1024 + cc); }
          const unsigned aw[4] = {a.x, a.y, a.z, a.w}, bw[4] = {b.x, b.y, b.z, b.w};
#pragma unroll
          for (int j = 0; j < 4; ++j) { um2[2 * j] = pg8::bf_lo(aw[j]); um2[2 * j + 1] = pg8::bf_hi(aw[j]); um1[2 * j] = pg8::bf_lo(bw[j]); um1[2 * j + 1] = pg8::bf_hi(bw[j]); } }
#pragma unroll 4
        for (int i = 0; i < 16; ++i) { const size_t o = (size_t)(t0 + i) * 1024 + cc;
            const v4u u = *(const GAS v4u*)(UU + o), b = *(const GAS v4u*)(BG + o); const unsigned uw[4] = {u.x, u.y, u.z, u.w}, bw[4] = {b.x, b.y, b.z, b.w};
            float r[8];
#pragma unroll
            for (int j = 0; j < 4; ++j) { const float u0 = pg8::bf_lo(uw[j]), u1 = pg8::bf_hi(uw[j]);
                r[2 * j] = pg8::bf_lo(bw[j]) * (w0[2 * j] * um2[2 * j] + w1[2 * j] * um1[2 * j] + w2[2 * j] * u0);
                r[2 * j + 1] = pg8::bf_hi(bw[j]) * (w0[2 * j + 1] * um2[2 * j + 1] + w1[2 * j + 1] * um1[2 * j + 1] + w2[2 * j + 1] * u1);
                um2[2 * j] = um1[2 * j]; um2[2 * j + 1] = um1[2 * j + 1]; um1[2 * j] = u0; um1[2 * j + 1] = u1; }
            v4u o4; o4.x = pk2(r[0], r[1]); o4.y = pk2(r[2], r[3]); o4.z = pk2(r[4], r[5]); o4.w = pk2(r[6], r[7]);
            *(GAS v4u*)(CAout + o) = o4; }
    }
}
__device__ __forceinline__ bool top_better(float v, int n, float cv, int cn) { return v > cv || (v == cv && n < cn); }
__device__ __forceinline__ void top3_insert(float v, int n, float (&tv)[3], int (&ti)[3]) {
    if (top_better(v, n, tv[0], ti[0])) { tv[2] = tv[1]; ti[2] = ti[1]; tv[1] = tv[0]; ti[1] = ti[0]; tv[0] = v; ti[0] = n; }
    else if (top_better(v, n, tv[1], ti[1])) { tv[2] = tv[1]; ti[2] = ti[1]; tv[1] = v; ti[1] = n; }
    else if (top_better(v, n, tv[2], ti[2])) { tv[2] = v; ti[2] = n; }
}
__device__ __forceinline__ void phase2d(unsigned char* ws, LAS unsigned char* lds, int G, int tid, int wave, int lane, unsigned* gcnt, unsigned short* glist) {
    LAS unsigned* lcnt = (LAS unsigned*)(lds + 32768); LAS unsigned* lbase = lcnt + 64; LAS unsigned short* llist = (LAS unsigned short*)lds;
    const bf16* Q = (const bf16*)(ws + WS_Q); const float* kbar = (const float*)(ws + WS_KBAR);
    const int fr = lane & 15, fq = lane >> 4;
    for (int unit = blockIdx.x; unit < NH * 63; unit += G) {
        const int h = unit / 63, c = 1 + unit % 63;
        if (tid < 64) lcnt[tid] = 0u;
        __syncthreads();
        bf16x8 qf[2][4];
#pragma unroll
        for (int g = 0; g < 2; ++g)
#pragma unroll
            for (int ks = 0; ks < 4; ++ks) qf[g][ks] = *(const GAS bf16x8*)(Q + (size_t)(c * BLK + wave * 32 + g * 16 + fr) * 1024 + h * HD + ks * 32 + fq * 8);
        float tv[2][3]; int ti[2][3];
#pragma unroll
        for (int g = 0; g < 2; ++g)
#pragma unroll
            for (int j = 0; j < 3; ++j) { tv[g][j] = -__builtin_inff(); ti[g][j] = 1 << 20; }
        const int ntile = (c + 15) >> 4;
        for (int tile = 0; tile < ntile; ++tile) {
            f32x4 s0 = (f32x4){0.f, 0.f, 0.f, 0.f}, s1 = s0;
#pragma unroll
            for (int ks = 0; ks < 4; ++ks) {
                const float* kp = kbar + ((size_t)(h * NBLK + tile * 16 + fr) * HD + ks * 32 + fq * 8);
                const f32x4 a = *(const GAS f32x4*)kp, b = *(const GAS f32x4*)(kp + 4);
                const v4u hw = pg8::pack8(a, b);
                f32x4 ra, rb; ra[0] = a[0] - pg8::bf_lo(hw.x); ra[1] = a[1] - pg8::bf_hi(hw.x); ra[2] = a[2] - pg8::bf_lo(hw.y); ra[3] = a[3] - pg8::bf_hi(hw.y);
                rb[0] = b[0] - pg8::bf_lo(hw.z); rb[1] = b[1] - pg8::bf_hi(hw.z); rb[2] = b[2] - pg8::bf_lo(hw.w); rb[3] = b[3] - pg8::bf_hi(hw.w);
                const v4u lw = pg8::pack8(ra, rb);
                const bf16x8 hi = __builtin_bit_cast(bf16x8, hw), lo = __builtin_bit_cast(bf16x8, lw);
                s0 = __builtin_amdgcn_mfma_f32_16x16x32_bf16(hi, qf[0][ks], s0, 0, 0, 0); s0 = __builtin_amdgcn_mfma_f32_16x16x32_bf16(lo, qf[0][ks], s0, 0, 0, 0);
                s1 = __builtin_amdgcn_mfma_f32_16x16x32_bf16(hi, qf[1][ks], s1, 0, 0, 0); s1 = __builtin_amdgcn_mfma_f32_16x16x32_bf16(lo, qf[1][ks], s1, 0, 0, 0);
            }
#pragma unroll
            for (int i = 0; i < 4; ++i) { const int n = tile * 16 + 4 * fq + i;
                top3_insert(n < c ? s0[i] : -__builtin_inff(), n, tv[0], ti[0]); top3_insert(n < c ? s1[i] : -__builtin_inff(), n, tv[1], ti[1]); }
        }
#pragma unroll
        for (int off = 16; off <= 32; off <<= 1)
#pragma unroll
            for (int g = 0; g < 2; ++g) { float pv[3]; int pi[3];
#pragma unroll
                for (int j = 0; j < 3; ++j) { pv[j] = __shfl_xor(tv[g][j], off); pi[j] = __shfl_xor(ti[g][j], off); }
#pragma unroll
                for (int j = 0; j < 3; ++j) top3_insert(pv[j], pi[j], tv[g], ti[g]); }
        const int nsel = c < 3 ? c : 3;
        if (fq == 0) {
#pragma unroll
            for (int g = 0; g < 2; ++g) { const int tl = wave * 32 + g * 16 + fr;
#pragma unroll
                for (int j = 0; j < 3; ++j) if (j < nsel) { const int n = ti[g][j]; const unsigned pp = __hip_atomic_fetch_add(&lcnt[n], 1u, __ATOMIC_RELAXED, __HIP_MEMORY_SCOPE_WORKGROUP); llist[n * 256 + pp] = (unsigned short)((tl << 2) | j); } }
        }
        __syncthreads();
        if (tid < c) { const unsigned k = lcnt[tid]; lbase[tid] = k ? atomicAdd(gcnt + h * NBLK + tid, k) : 0u; }
        __syncthreads();
        for (int n = wave; n < c; n += NWAVES) { const unsigned k = lcnt[n], base = lbase[n];
            unsigned short* dst = glist + (size_t)h * LIST_PER_HEAD + list_off(n) + base;
            for (unsigned i = lane; i < k; i += 64) { const unsigned e = llist[n * 256 + i]; dst[i] = (unsigned short)((((unsigned)c * BLK + (e >> 2)) << 2) | (e & 3u)); } }
        __syncthreads();
    }
}
__device__ __forceinline__ void stage_kv(const bf16* Kg, const bf16* Vt, int h, int n, LAS unsigned char* lds, int tid) {
#pragma unroll
    for (int i = 0; i < 8; ++i) { const int row = (tid >> 4) + 32 * i, ch = tid & 15;
        const v4u w = *(const GAS v4u*)(Kg + (size_t)(n * BLK + row) * 1024 + h * HD + ch * 8);
        const int sw = (((row >> 3) & 3) << 2) | (row & 3);
        *(LAS v4u*)(lds + row * 256 + ((ch ^ sw) << 4)) = w; }
#pragma unroll
    for (int i = 0; i < 8; ++i) { const int row = (tid >> 5) + 16 * i, ch = tid & 31;
        const v4u w = *(const GAS v4u*)(Vt + (size_t)(h * HD + row) * M + n * BLK + ch * 8);
        *(LAS v4u*)(lds + 65536 + row * 512 + ((ch ^ ((((row >> 4) & 3) << 2) | (row & 3))) << 4)) = w; }
}
template <bool CAUSAL, int MODE = 0>
__device__ __forceinline__ void attn_core(const LAS unsigned char* lds, const bf16* Q, int h, const int (&tq)[2], int wave, int fr, int fq, float B2, f32x4 (&O)[8][2], float (&l)[2]) {
    bf16x8 qf[2][4];
#pragma unroll
    for (int g = 0; g < 2; ++g)
#pragma unroll
        for (int ks = 0; ks < 4; ++ks) qf[g][ks] = *(const GAS bf16x8*)(Q + (size_t)tq[g] * 1024 + h * HD + ks * 32 + fq * 8);
#pragma unroll
    for (int dt = 0; dt < 8; ++dt) { O[dt][0] = (f32x4){0.f, 0.f, 0.f, 0.f}; O[dt][1] = O[dt][0]; }
    l[0] = 0.f; l[1] = 0.f;
    const int nch = CAUSAL ? wave + 1 : 8;
    const int krow = (fr >> 2) * 8 + (fr & 3);
    bf16x8 kf[4][2];
#pragma unroll
    for (int ks = 0; ks < 4; ++ks)
#pragma unroll
        for (int t = 0; t < 2; ++t) kf[ks][t] = *(const LAS bf16x8*)(lds + (krow + t * 4) * 256 + (((ks * 4 + fq) ^ fr) << 4));
#pragma unroll 2
    for (int c = 0; c < nch; ++c) {
        f32x4 s[2][2];
#pragma unroll
        for (int t = 0; t < 2; ++t) { s[t][0] = (f32x4){-B2, -B2, -B2, -B2}; s[t][1] = s[t][0]; }
        bf16x8 vf[8];
#pragma unroll
        for (int dt = 0; dt < 8; ++dt) vf[dt] = *(const LAS bf16x8*)(lds + 65536 + ((dt >> 2) * 64 + (fr >> 2) * 16 + (dt & 3) * 4 + (fr & 3)) * 512 + (((c * 4 + fq) ^ fr) << 4));
#pragma unroll
        for (int ks = 0; ks < 4; ++ks)
#pragma unroll
            for (int t = 0; t < 2; ++t) {
                if (MODE != 2 || ks == 0) {
                s[t][0] = __builtin_amdgcn_mfma_f32_16x16x32_bf16(kf[ks][t], qf[0][ks], s[t][0], 0, 0, 0);
                s[t][1] = __builtin_amdgcn_mfma_f32_16x16x32_bf16(kf[ks][t], qf[1][ks], s[t][1], 0, 0, 0); }
            }
        __builtin_amdgcn_sched_barrier(0);
        { const int cn = (c + 1 < nch) ? c + 1 : c;
#pragma unroll
          for (int ks = 0; ks < 4; ++ks)
#pragma unroll
              for (int t = 0; t < 2; ++t) kf[ks][t] = *(const LAS bf16x8*)(lds + (cn * 32 + krow + t * 4) * 256 + (((ks * 4 + fq) ^ fr) << 4)); }
        bf16x8 pf[2];
#pragma unroll
        for (int g = 0; g < 2; ++g) {
            float p[8];
#pragma unroll
            for (int t = 0; t < 2; ++t)
#pragma unroll
                for (int i = 0; i < 4; ++i) { float e = MODE == 1 ? s[t][g][i] : __builtin_amdgcn_exp2f(s[t][g][i]);
                    if (CAUSAL && c == wave) { const int kl = c * 32 + fq * 8 + t * 4 + i, ql = wave * 32 + g * 16 + fr; if (kl > ql) e = 0.f; }
                    p[t * 4 + i] = e; }
            l[g] += ((p[0] + p[1]) + (p[2] + p[3])) + ((p[4] + p[5]) + (p[6] + p[7]));
            v4u w; w.x = pg8::cvt_pk_bf16(p[0], p[1]); w.y = pg8::cvt_pk_bf16(p[2], p[3]); w.z = pg8::cvt_pk_bf16(p[4], p[5]); w.w = pg8::cvt_pk_bf16(p[6], p[7]);
            pf[g] = __builtin_bit_cast(bf16x8, w);
        }
#pragma unroll
        for (int dt = 0; dt < 8; ++dt) {
            if (MODE != 3 || dt == 0) {
            O[dt][0] = __builtin_amdgcn_mfma_f32_16x16x32_bf16(vf[dt], pf[0], O[dt][0], 0, 0, 0);
            O[dt][1] = __builtin_amdgcn_mfma_f32_16x16x32_bf16(vf[dt], pf[1], O[dt][1], 0, 0, 0); }
        }
    }
    l[0] += __shfl_xor(l[0], 16); l[0] += __shfl_xor(l[0], 32); l[1] += __shfl_xor(l[1], 16); l[1] += __shfl_xor(l[1], 32);
}
__device__ __forceinline__ float score_bound(const float* q_norm, const float* k_norm, int lane) {
    float a = fmaxf(fabsf(q_norm[lane]), fabsf(q_norm[lane + 64])), b = fmaxf(fabsf(k_norm[lane]), fabsf(k_norm[lane + 64]));
#pragma unroll
    for (int o = 1; o < 64; o <<= 1) { a = fmaxf(a, __shfl_xor(a, o)); b = fmaxf(b, __shfl_xor(b, o)); }
    return 128.0f * a * b * C2 * 1.001f + 0.01f;
}
template <int MODE>
__device__ __forceinline__ void phase3a(const float* q_norm, const float* k_norm, unsigned char* ws, LAS unsigned char* lds, int G, int tid, int wave, int lane) {
    const int fr = lane & 15, fq = lane >> 4;
    LAS int* pre = (LAS int*)(lds + SCAN_OFF);
    LAS int* cntl = (LAS int*)(lds + SCAN_OFF + 2080);
    const unsigned* gcnt = (const unsigned*)(ws + WS_CTL) + CW_GCNT; const unsigned short* glist = (const unsigned short*)(ws + WS_LIST);
    const bf16* Q = (const bf16*)(ws + WS_Q); const bf16* Kg = (const bf16*)(ws + WS_K); const bf16* Vt = (const bf16*)(ws + WS_VT);
    unsigned char* OP = ws + WS_OPART; float* LP = (float*)(ws + WS_LPART);
    const float B2 = score_bound(q_norm, k_norm, lane);
    { const int cnt = (int)__hip_atomic_load(gcnt + tid, __ATOMIC_RELAXED, __HIP_MEMORY_SCOPE_AGENT); pre[tid + 1] = (cnt + 255) >> 8; cntl[tid] = cnt; if (tid == 0) pre[0] = 0; }
    __syncthreads();
    for (int o = 1; o < 512; o <<= 1) { const int v = pre[tid + 1] + ((tid + 1 - o) >= 1 ? pre[tid + 1 - o] : 0); __syncthreads(); pre[tid + 1] = v; __syncthreads(); }
    const int T = pre[512];
    const int i_lo = (int)(((long)blockIdx.x * T) / G), i_hi = (int)(((long)(blockIdx.x + 1) * T) / G);
    int staged = -1;
#define P3A_DECODE(IT, HN, TILE) do { int lo_ = 0, hi_ = 511; while (lo_ < hi_) { const int mid_ = (lo_ + hi_ + 1) >> 1; if (pre[mid_] <= (IT)) lo_ = mid_; else hi_ = mid_ - 1; } HN = lo_; TILE = (IT) - pre[lo_]; } while (0)
    unsigned en[2] = {0u, 0u}; bool okn[2] = {false, false};
    if (i_lo < i_hi) { int hn, tile; P3A_DECODE(i_lo, hn, tile); const int cnt = cntl[hn]; const unsigned short* lst = glist + (size_t)(hn >> 6) * LIST_PER_HEAD + list_off(hn & 63) + tile * 256;
#pragma unroll
        for (int g = 0; g < 2; ++g) { const int qi = wave * 32 + g * 16 + fr; okn[g] = tile * 256 + qi < cnt; en[g] = okn[g] ? lst[qi] : 0u; } }
    for (int it = i_lo; it < i_hi; ++it) {
        int hn, tile; P3A_DECODE(it, hn, tile); const int h = hn >> 6, n = hn & 63;
        int tq[2], sj[2]; bool ok[2];
#pragma unroll
        for (int g = 0; g < 2; ++g) { ok[g] = okn[g]; tq[g] = (int)(en[g] >> 2); sj[g] = (int)(en[g] & 3u); }
        if (it + 1 < i_hi) { int hn2, tile2; P3A_DECODE(it + 1, hn2, tile2); const int cnt2 = cntl[hn2]; const unsigned short* lst2 = glist + (size_t)(hn2 >> 6) * LIST_PER_HEAD + list_off(hn2 & 63) + tile2 * 256;
#pragma unroll
            for (int g = 0; g < 2; ++g) { const int qi = wave * 32 + g * 16 + fr; okn[g] = tile2 * 256 + qi < cnt2; en[g] = okn[g] ? lst2[qi] : 0u; } }
        if (hn != staged) { __syncthreads(); stage_kv(Kg, Vt, h, n, lds, tid); LDS_WAIT(); __syncthreads(); staged = hn; }
        f32x4 O[8][2]; float l[2];
        attn_core<false, MODE>(lds, Q, h, tq, wave, fr, fq, B2, O, l);
#pragma unroll
        for (int g = 0; g < 2; ++g) if (ok[g]) {
            unsigned char* op = OP + ((size_t)sj[g] * M + tq[g]) * 1024 + h * HD + 16 * fq;
            const float sc = 16.0f / l[g];
#pragma unroll
            for (int j = 0; j < 2; ++j) { v4u w;
                { int t = 0; t = __builtin_amdgcn_cvt_pk_fp8_f32(O[4 * j][g][0] * sc, O[4 * j][g][1] * sc, t, false); t = __builtin_amdgcn_cvt_pk_fp8_f32(O[4 * j][g][2] * sc, O[4 * j][g][3] * sc, t, true); w.x = (unsigned)t; }
                { int t = 0; t = __builtin_amdgcn_cvt_pk_fp8_f32(O[4 * j + 1][g][0] * sc, O[4 * j + 1][g][1] * sc, t, false); t = __builtin_amdgcn_cvt_pk_fp8_f32(O[4 * j + 1][g][2] * sc, O[4 * j + 1][g][3] * sc, t, true); w.y = (unsigned)t; }
                { int t = 0; t = __builtin_amdgcn_cvt_pk_fp8_f32(O[4 * j + 2][g][0] * sc, O[4 * j + 2][g][1] * sc, t, false); t = __builtin_amdgcn_cvt_pk_fp8_f32(O[4 * j + 2][g][2] * sc, O[4 * j + 2][g][3] * sc, t, true); w.z = (unsigned)t; }
                { int t = 0; t = __builtin_amdgcn_cvt_pk_fp8_f32(O[4 * j + 3][g][0] * sc, O[4 * j + 3][g][1] * sc, t, false); t = __builtin_amdgcn_cvt_pk_fp8_f32(O[4 * j + 3][g][2] * sc, O[4 * j + 3][g][3] * sc, t, true); w.w = (unsigned)t; }
                *(GAS v4u*)(op + j * 64) = w; }
            if (fq == 0) LP[((size_t)sj[g] * M + tq[g]) * NH + h] = l[g];
        }
    }
#undef P3A_DECODE
    __syncthreads();
}
__device__ __forceinline__ void phase3b(const float* q_norm, const float* k_norm, unsigned char* ws, LAS unsigned char* lds, int G, int tid, int wave, int lane, bf16* Oout) {
    const int fr = lane & 15, fq = lane >> 4;
    bf16* Q = (bf16*)(ws + WS_Q); const bf16* Kg = (const bf16*)(ws + WS_K); const bf16* Vt = (const bf16*)(ws + WS_VT);
    const unsigned char* OP = ws + WS_OPART; const float* LP = (const float*)(ws + WS_LPART);
    const float B2 = score_bound(q_norm, k_norm, lane);
    for (int unit = blockIdx.x; unit < NH * NBLK; unit += G) {
        const int h = unit >> 6, c = unit & 63;
        __syncthreads(); stage_kv(Kg, Vt, h, c, lds, tid); LDS_WAIT(); __syncthreads();
        int tq[2];
#pragma unroll
        for (int g = 0; g < 2; ++g) tq[g] = c * BLK + wave * 32 + g * 16 + fr;
        f32x4 O[8][2]; float l[2];
        attn_core<true>(lds, Q, h, tq, wave, fr, fq, B2, O, l);
        const int nsel = c < 3 ? c : 3;
#pragma unroll
        for (int g = 0; g < 2; ++g) {
            float lp[3];
#pragma unroll
            for (int j = 0; j < 3; ++j) lp[j] = LP[((size_t)j * M + tq[g]) * NH + h];
            v4u w[3][2];
#pragma unroll
            for (int j = 0; j < 3; ++j)
#pragma unroll
                for (int k = 0; k < 2; ++k) w[j][k] = *(const GAS v4u*)(OP + ((size_t)j * M + tq[g]) * 1024 + h * HD + k * 64 + 16 * fq);
            float lt = l[g]; float ls[3];
#pragma unroll
            for (int j = 0; j < 3; ++j) { ls[j] = j < nsel ? lp[j] * (1.0f / 16.0f) : 0.f; lt += j < nsel ? lp[j] : 0.f; }
            const float inv = 1.0f / lt;
#pragma unroll
            for (int k = 0; k < 2; ++k) {
                f32x4 o[4];
#pragma unroll
                for (int q = 0; q < 4; ++q) o[q] = O[4 * k + q][g];
#pragma unroll
                for (int j = 0; j < 3; ++j) if (j < nsel) { const unsigned xw[4] = {w[j][k].x, w[j][k].y, w[j][k].z, w[j][k].w};
#pragma unroll
                    for (int q = 0; q < 4; ++q) { const pg8::f32x2_t_ lo = __builtin_amdgcn_cvt_pk_f32_fp8((int)xw[q], false), hi = __builtin_amdgcn_cvt_pk_f32_fp8((int)xw[q], true);
                        o[q][0] += lo[0] * ls[j]; o[q][1] += lo[1] * ls[j]; o[q][2] += hi[0] * ls[j]; o[q][3] += hi[1] * ls[j]; } }
                bf16* dst = Oout + (size_t)tq[g] * 1024 + h * HD + k * 64 + 16 * fq;
                *(GAS v4u*)dst = pg8::pack8(o[0] * inv, o[1] * inv); *(GAS v4u*)(dst + 8) = pg8::pack8(o[2] * inv, o[3] * inv); }
        }
    }
    __syncthreads();
}

#ifndef MK_PER_PHASE
#define MK_PER_PHASE 0
#endif
#ifndef MK_DUP
#define MK_DUP -1
#endif
constexpr int N_PHASES = 9;
struct Args { const float* in[14]; float* out; unsigned char* ws; int ph_lo, ph_hi; };
__global__ void __launch_bounds__(NTHREADS, 2) hybrid_fwd(Args args) {
    extern __shared__ __attribute__((aligned(16))) unsigned char lds_raw[];
    LAS unsigned char* lds = (LAS unsigned char*)lds_raw;
    volatile LAS unsigned* MISC = (volatile LAS unsigned*)(lds + MISC_OFF);
    const int tid = threadIdx.x, lane = tid & 63, wave = __builtin_amdgcn_readfirstlane(tid >> 6);
    const int G = gridDim.x; const int vcu = (G % 8 == 0) ? ((int)blockIdx.x % 8) * (G / 8) + (int)blockIdx.x / 8 : (int)blockIdx.x;
    unsigned char* ws = args.ws;
    gu32* ctl = (gu32*)(ws + WS_CTL);
    if (tid < 32) MISC[tid] = 0u;
    __syncthreads();
    const int lo = args.ph_lo, hi = args.ph_hi;
    XcdBarrier bar; bar.bar = (unsigned*)ctl + CW_BAR; bar.x = 0; bar.st = nullptr;
    if (hi - lo > 1) bar = xcd_barrier_post((unsigned*)ctl + CW_BAR, MISC + 8);
#ifndef PHASE_MASK
#define PHASE_MASK 0x1ff
#endif
#define IN(k) (((PHASE_MASK >> (k)) & 1) && lo <= (k) && (k) < hi)
#define SEAM(k) do { if (IN(k) && IN((k) + 1)) xcd_barrier(bar); } while (0)
    const float* x = args.in[0]; const float* norm_mix = args.in[1]; const float* w_in = args.in[2]; const float* conv_a_w = args.in[3]; const float* q_norm = args.in[4]; const float* k_norm = args.in[5];
    const float* w_oa = args.in[6]; const float* w_ob = args.in[7]; const float* w_o = args.in[8]; const float* norm_ffn = args.in[9]; const float* w_up = args.in[10]; const float* ffn_conv_w = args.in[11];
    const float* ffn_conv_b = args.in[12]; const float* w_down = args.in[13];
    float* out = args.out;
    float* rowss = (float*)((unsigned*)ctl + CW_ROWSS);
    const size_t TSTEP = (size_t)256 * 1024 * 2;

    if (IN(0)) { phase0(x, norm_mix, w_in, w_oa, w_ob, w_o, w_up, norm_ffn, ws, lds, vcu, G, wave, lane); __syncthreads(); }
    SEAM(0);
    if (IN(1)) {
        pg8::Gemm g{(const bf16*)(ws + WS_XB), (const bf16*)(ws + WS_XB), (const bf16*)(ws + WS_WIN), (const bf16*)(ws + WS_WIN), D, TSTEP};
        pg8::StaticOrder S; S.init(M / 256, NIN / 256, G, (int)blockIdx.x);
        pg8::Epi1 E{(bf16*)(ws + WS_CA), (bf16*)(ws + WS_UU), (bf16*)(ws + WS_Q), (bf16*)(ws + WS_K), (bf16*)(ws + WS_VT), (bf16*)out, (const float*)(ws + WS_RSTDX), q_norm, k_norm, (float*)(ws + WS_KBAR), (PG8_LAS float*)(lds + HALO_OFF)};
        pg8::gemm_phase<pg8::Epi1, pg8::StaticOrder, true, true>(lds, g, S, E);
    }
    SEAM(1);
    if (IN(2)) { phase2d(ws, lds, G, tid, wave, lane, (unsigned*)(ws + WS_CTL) + CW_GCNT, (unsigned short*)(ws + WS_LIST));
        phase2(conv_a_w, ws, G, tid, (bf16*)(ws + WS_CA)); __syncthreads(); }
#if MK_DUP == 21
    if (IN(2)) { phase2d(ws, lds, G, tid, wave, lane, (unsigned*)(ws + WS_CTL) + CW_GCNT + 512, (unsigned short*)(ws + WS_WIN)); }
#endif
#if MK_DUP == 22
    if (IN(2)) { phase2(conv_a_w, ws, G, tid, (bf16*)(ws + WS_XB)); }
#endif
    SEAM(2);
#if MK_DUP >= 30 && MK_DUP <= 35
    if (IN(3)) phase3a<MK_DUP - 30>(q_norm, k_norm, ws, lds, G, tid, wave, lane);
#endif
    if (IN(3)) phase3a<0>(q_norm, k_norm, ws, lds, G, tid, wave, lane);
    SEAM(3);
    if (IN(4)) { phase3b(q_norm, k_norm, ws, lds, G, tid, wave, lane, (bf16*)(ws + WS_Q));
#if MK_DUP == 4
        phase3b(q_norm, k_norm, ws, lds, G, tid, wave, lane, (bf16*)(ws + WS_OPART));
#endif
        }
    SEAM(4);
    if (IN(5)) {
        { LAS float* scr = (LAS float*)(lds + wave * 16384); const int gw = vcu * NWAVES + wave, NGW = G * NWAVES;
          if (blockIdx.x == 0 && tid < 256) *(GAS v4u*)(ws + WS_HB - 4096 + tid * 16) = (v4u){0u, 0u, 0u, 0u};
          __syncthreads(); }
        pg8::Gemm g{(const bf16*)(ws + WS_CA), (const bf16*)(ws + WS_Q), (const bf16*)(ws + WS_WOA), (const bf16*)(ws + WS_WOB), D, TSTEP};
        pg8::DualOrder S; S.S.init(M / 256, D / 256, G, (int)blockIdx.x);
        pg8::Epi4 E{(bf16*)(ws + WS_MG), (const bf16*)out};
        pg8::gemm_phase<pg8::Epi4, pg8::DualOrder, true, true>(lds, g, S, E);
    }
    SEAM(5);
    if (IN(6)) {
        pg8::Gemm g{(const bf16*)(ws + WS_MG), (const bf16*)(ws + WS_MG), (const bf16*)(ws + WS_WO), (const bf16*)(ws + WS_WO), D, TSTEP};
        pg8::StaticOrder S; S.init(M / 256, D / 256, G, (int)blockIdx.x);
        pg8::Epi5 E{x, out, (bf16*)(ws + WS_HB), rowss};
        pg8::gemm_phase<pg8::Epi5, pg8::StaticOrder, true, true>(lds, g, S, E);
#if MK_DUP == 6
        { pg8::Epi5 E2{x, (float*)(ws + WS_Q), (bf16*)(ws + WS_VT), (float*)(ws + WS_CA)}; pg8::gemm_phase<pg8::Epi5, pg8::StaticOrder, true, true>(lds, g, S, E2); }
#endif
    }
    SEAM(6);
    if (IN(7)) {
        const bf16* hb2 = (const bf16*)(ws + WS_HB) - 2 * 1024;
        pg8::Gemm g{hb2, hb2, (const bf16*)(ws + WS_WUP), (const bf16*)(ws + WS_WUP), D, (size_t)254 * 1024 * 2};
        pg8::StaticOrder S; S.init(65, 22, G, (int)blockIdx.x);
        pg8::Epi6 E{(bf16*)(ws + WS_ACT), rowss, ffn_conv_w, ffn_conv_b, (PG8_LAS float*)(lds + HALO_OFF)};
        pg8::gemm_phase<pg8::Epi6, pg8::StaticOrder, true, true>(lds, g, S, E);
        { const int nwg = 65 * 22, full = nwg % G, nidle = full ? G - full : G, idx = full ? (int)blockIdx.x - full : (int)blockIdx.x;
          if (idx >= 0) convert_weight(w_down, DFF, D, (bf16*)(ws + WS_WDN), nullptr, 0, (LAS float*)(lds + wave * 16384), idx * NWAVES + wave, nidle * NWAVES, lane);
          __syncthreads(); }
    }
    SEAM(7);
    if (IN(8)) {
        pg8::Gemm g{(const bf16*)(ws + WS_ACT), (const bf16*)(ws + WS_ACT), (const bf16*)(ws + WS_WDN), (const bf16*)(ws + WS_WDN), DFF, (size_t)256 * DFF * 2};
        pg8::StaticOrder S; S.init(M / 256, D / 256, G, (int)blockIdx.x);
        pg8::Epi7 E{out, (const bf16*)(ws + WS_HB)};
        pg8::gemm_phase<pg8::Epi7, pg8::StaticOrder, true, true>(lds, g, S, E);
#if MK_DUP == 8
        { pg8::Epi7 E2{(float*)(ws + WS_MG), (const bf16*)(ws + WS_HB)}; pg8::gemm_phase<pg8::Epi7, pg8::StaticOrder, true, true>(lds, g, S, E2); }
#endif
    }
#undef IN
#undef SEAM
}

extern "C" void kernel_launch(void* const* d_in, const int* in_sizes, int n_in, void* d_out, int out_size, void* d_ws, size_t ws_size, hipStream_t stream) {
    static int grid = 0;
    if (grid == 0) {
        if (n_in != 14 || in_sizes[0] != M * D || out_size != M * D || ws_size < WS_END) { fprintf(stderr, "kernel_launch: unexpected shapes (n_in %d, in0 %d, out %d, ws %zu)\n", n_in, n_in > 0 ? in_sizes[0] : -1, out_size, ws_size); grid = -1; return; }
        int dev = 0, cus = 0, per_cu = 0;
        if (hipGetDevice(&dev) != hipSuccess || hipDeviceGetAttribute(&cus, hipDeviceAttributeMultiprocessorCount, dev) != hipSuccess) { grid = -1; return; }
        if (hipFuncSetAttribute((const void*)hybrid_fwd, hipFuncAttributeMaxDynamicSharedMemorySize, LDS_BYTES) != hipSuccess) { fprintf(stderr, "kernel_launch: hipFuncSetAttribute failed\n"); grid = -1; return; }
        if (hipOccupancyMaxActiveBlocksPerMultiprocessor(&per_cu, (const void*)hybrid_fwd, NTHREADS, LDS_BYTES) != hipSuccess || per_cu < 1) { fprintf(stderr, "kernel_launch: occupancy query says %d blocks per CU\n", per_cu); (void)hipGetLastError(); grid = -1; return; }
        grid = cus;
    }
    if (grid < 0) return;
    if (hipMemsetAsync((char*)d_ws + WS_CTL, 0, CTL_ZERO_BYTES, stream) != hipSuccess) { fprintf(stderr, "kernel_launch: memset failed\n"); return; }
    Args a{};
    for (int i = 0; i < 14; ++i) a.in[i] = (const float*)d_in[i];
    a.out = (float*)d_out; a.ws = (unsigned char*)d_ws;
#if MK_PER_PHASE
    for (int p = 0; p < N_PHASES; ++p) { a.ph_lo = p; a.ph_hi = p + 1; hipLaunchKernelGGL(hybrid_fwd, dim3(grid), dim3(NTHREADS), LDS_BYTES, stream, a); }
#else
    a.ph_lo = 0; a.ph_hi = N_PHASES;
    void* kargs[] = {&a};
    hipError_t e = hipLaunchCooperativeKernel((const void*)hybrid_fwd, dim3(grid), dim3(NTHREADS), kargs, LDS_BYTES, stream);
    if (e != hipSuccess) fprintf(stderr, "kernel_launch: cooperative launch failed: %s (grid %d)\n", hipGetErrorString(e), grid);
#endif
}
```

```cpp
#include <hip/hip_runtime.h>
#include <cstdio>
#include <cstdint>
namespace pg8 {
#define PG8_LAS __attribute__((address_space(3)))
typedef unsigned short bf16_t;
typedef short bf16x8 __attribute__((ext_vector_type(8)));
typedef float f32x4 __attribute__((ext_vector_type(4)));
typedef unsigned u32x4 __attribute__((ext_vector_type(4)));
constexpr int BM = 256, BK = 64, HALF = 128, HTB = HALF * BK * 2  , STAGE_BYTES = 8 * HTB, NXCD = 8, WGM = 8;

__host__ __device__ __forceinline__ int lds_byte(int r, int c) { const int st = (r >> 4) * 2 + (c >> 5), rr = r & 15, cc = c & 31, ob = rr * 64 + cc * 2; return st * 1024 + (ob ^ (((ob >> 9) & 1) << 5)); }
__host__ __device__ __forceinline__ void stage_rc(int b, int& R, int& C) { const int st = b / 1024, sb = b % 1024, swz = sb ^ (((sb >> 9) & 1) << 5); R = (st >> 1) * 16 + swz / 64; C = (st & 1) * 32 + (swz % 64) / 2; }
__host__ __device__ __forceinline__ int perm32(int rho) { const int n = rho >> 4, i = rho & 15; return 8 * (i >> 2) + 4 * n + (i & 3); }


struct Unit { int pm, pn, sel; };
struct Gemm { const bf16_t* A0; const bf16_t* A1; const bf16_t* B0; const bf16_t* B1; int K; size_t a_tstep; };

struct StaticOrder {
    int nM, nN, nwg, G, c;
    __host__ __device__ void init(int nM_, int nN_, int G_, int c_) { nM = nM_; nN = nN_; nwg = nM * nN; G = G_; c = c_; }
    __host__ __device__ bool next(int i, Unit& u) const {
        const long L = (long)i * G + c; if (L >= nwg) return false;
        int wgid = (int)L; { const int q = nwg / NXCD, r = nwg % NXCD, xcd = wgid % NXCD, off = wgid / NXCD; wgid = (xcd < r ? xcd * (q + 1) : r * (q + 1) + (xcd - r) * q) + off; }
        const int nig = WGM * nN, gid = wgid / nig, fm = gid * WGM, gsz = (nM - fm) < WGM ? (nM - fm) : WGM;
        u.pm = fm + ((wgid % nig) % gsz); u.pn = (wgid % nig) / gsz; u.sel = 0; return true;
    }
    __device__ __forceinline__ void a_ready(const Unit&) const {}
    __device__ __forceinline__ void done(const Unit&) const {}
};
struct DualOrder {
    StaticOrder S;
    __host__ __device__ bool next(int i, Unit& u) const { const bool ok = S.next(i >> 1, u); u.sel = i & 1; return ok; }
    __device__ __forceinline__ void a_ready(const Unit&) const {}
    __device__ __forceinline__ void done(const Unit&) const {}
};

typedef __bf16 bf16x2_t_ __attribute__((ext_vector_type(2))); typedef float f32x2_t_ __attribute__((ext_vector_type(2)));
__device__ __forceinline__ unsigned cvt_pk_bf16(float lo, float hi) { const f32x2_t_ v = {lo, hi}; const bf16x2_t_ b = __builtin_convertvector(v, bf16x2_t_); return __builtin_bit_cast(unsigned, b); }
__device__ __forceinline__ float bf_lo(unsigned w) { return __uint_as_float(w << 16); }
__device__ __forceinline__ float bf_hi(unsigned w) { return __uint_as_float(w & 0xffff0000u); }
__device__ __forceinline__ float fast_sigmoid(float x) { return __builtin_amdgcn_rcpf(1.0f + __builtin_amdgcn_exp2f(-1.4426950408889634f * x)); }
__device__ __forceinline__ u32x4 pack8(const f32x4 a, const f32x4 b) { u32x4 w; w.x = cvt_pk_bf16(a[0], a[1]); w.y = cvt_pk_bf16(a[2], a[3]); w.z = cvt_pk_bf16(b[0], b[1]); w.w = cvt_pk_bf16(b[2], b[3]); return w; }

template <int CTRL> __device__ __forceinline__ float dpp_shr(float old, float v) { return __builtin_bit_cast(float, __builtin_amdgcn_update_dpp(__builtin_bit_cast(int, old), __builtin_bit_cast(int, v), CTRL, 0xf, 0xf, false)); }
template <int CTRL> __device__ __forceinline__ float dpp_ror(float v) { return __builtin_bit_cast(float, __builtin_amdgcn_update_dpp(0, __builtin_bit_cast(int, v), CTRL, 0xf, 0xf, true)); }
constexpr int MROWS = 16384, DMODEL = 1024, DFF_ = 2816;

struct Epi1 {
    static constexpr bool PERM = true, AFTER_DRAIN = false;
    static __device__ __forceinline__ bool keep_acc(const Unit&) { return false; }
    bf16_t *BG, *UU, *Q, *K, *VT, *SG; const float* rstdx; const float *q_norm, *k_norm; float* kbar; PG8_LAS float* xl;
    __device__ __forceinline__ void operator()(f32x4 (&acc)[2][2][4][2], const Unit& u, int wr, int wc, int fr, int fq) const {
        const int row0 = u.pm * BM + wr * 64 + fr, colw = wc * 32 + 8 * fq, pn = u.pn;
        if (pn >= 12 && pn < 20) {
            const bool isK = pn >= 16; const float* wn = isK ? k_norm : q_norm; const float gs = isK ? 1.0f : 0.12751743074602357f;
            bf16_t* dst = isK ? K : Q; const int cb = ((pn - 12) & 3) * 256;
#pragma unroll
            for (int ai = 0; ai < 2; ++ai)
#pragma unroll
                for (int m = 0; m < 4; ++m) { const int rl = ai * HALF + wr * 64 + m * 16 + fr; const float rs = rstdx[u.pm * BM + rl];
#pragma unroll
                    for (int bj = 0; bj < 2; ++bj) { const f32x4 a = acc[ai][bj][m][0] * rs, b = acc[ai][bj][m][1] * rs; acc[ai][bj][m][0] = a; acc[ai][bj][m][1] = b;
                        float ss = (a[0] * a[0] + a[1] * a[1]) + (a[2] * a[2] + a[3] * a[3]) + (b[0] * b[0] + b[1] * b[1]) + (b[2] * b[2] + b[3] * b[3]);
                        ss += __shfl_xor(ss, 16); ss += __shfl_xor(ss, 32);
                        if (fq == 0) xl[(rl * 2 + bj) * 4 + wc] = ss; } }
            asm volatile("s_waitcnt lgkmcnt(0)" ::: "memory"); __builtin_amdgcn_s_barrier(); asm volatile("" ::: "memory");
            const f32x4 g0 = *(const f32x4*)(wn + colw) * gs, g1 = *(const f32x4*)(wn + colw + 4) * gs;
#pragma unroll
            for (int ai = 0; ai < 2; ++ai)
#pragma unroll
                for (int m = 0; m < 4; ++m) { const int rl = ai * HALF + wr * 64 + m * 16 + fr; const int r = u.pm * BM + rl;
#pragma unroll
                    for (int bj = 0; bj < 2; ++bj) { const f32x4 p = *(const PG8_LAS f32x4*)(xl + (rl * 2 + bj) * 4);
                        const float rn = rsqrtf(((p[0] + p[1]) + (p[2] + p[3])) * (1.0f / 128.0f) + 1e-6f);
                        const f32x4 a = acc[ai][bj][m][0] * rn * g0, b = acc[ai][bj][m][1] * rn * g1; acc[ai][bj][m][0] = a; acc[ai][bj][m][1] = b;
                        *(u32x4*)(dst + (size_t)r * 1024 + cb + bj * 128 + colw) = pack8(a, b); } }
            if (isK) {
                f32x4 cs[2][2];
#pragma unroll
                for (int bj = 0; bj < 2; ++bj)
#pragma unroll
                    for (int n = 0; n < 2; ++n) { f32x4 t = acc[0][bj][0][n];
#pragma unroll
                        for (int ai = 0; ai < 2; ++ai)
#pragma unroll
                            for (int m = 0; m < 4; ++m) if (ai + m > 0) t += acc[ai][bj][m][n];
                        cs[bj][n] = t; }
#pragma unroll
                for (int bj = 0; bj < 2; ++bj)
#pragma unroll
                    for (int n = 0; n < 2; ++n)
#pragma unroll
                        for (int e = 0; e < 4; ++e) { float v = cs[bj][n][e]; v += __shfl_xor(v, 1); v += __shfl_xor(v, 2); v += __shfl_xor(v, 4); v += __shfl_xor(v, 8); cs[bj][n][e] = v; }
                if (fr == 0) {
#pragma unroll
                    for (int bj = 0; bj < 2; ++bj) { *(PG8_LAS f32x4*)(xl + 2048 + wr * 256 + bj * 128 + colw) = cs[bj][0]; *(PG8_LAS f32x4*)(xl + 2048 + wr * 256 + bj * 128 + colw + 4) = cs[bj][1]; } }
                asm volatile("s_waitcnt lgkmcnt(0)" ::: "memory"); __builtin_amdgcn_s_barrier(); asm volatile("" ::: "memory");
                int t = threadIdx.x; asm volatile("" : "+v"(t));
                if (t < 256) kbar[((size_t)((pn - 16) * 2 + (t >> 7)) * 64 + u.pm) * 128 + (t & 127)] = (xl[2048 + t] + xl[2048 + 256 + t]) * (1.0f / 256.0f);
            }
            return;
        }
        if (pn >= 20 && pn < 24) {
            int tidv = threadIdx.x; asm volatile("" : "+v"(tidv));
            PG8_LAS unsigned char* T = (PG8_LAS unsigned char*)xl + (tidv >> 6) * 2304;
            const int lane = tidv & 63;
            float rsv[2][4];
#pragma unroll
            for (int ai = 0; ai < 2; ++ai)
#pragma unroll
                for (int m = 0; m < 4; ++m) rsv[ai][m] = rstdx[u.pm * BM + ai * HALF + wr * 64 + m * 16 + fr];
#pragma unroll
            for (int ai = 0; ai < 2; ++ai)
#pragma unroll
                for (int mp = 0; mp < 2; ++mp)
#pragma unroll
                    for (int bj = 0; bj < 2; ++bj) {
#pragma unroll
                        for (int mm = 0; mm < 2; ++mm) { const int m = 2 * mp + mm; const float rs = rsv[ai][m];
                            const u32x4 w = pack8(acc[ai][bj][m][0] * rs, acc[ai][bj][m][1] * rs); const unsigned ww[4] = {w.x, w.y, w.z, w.w};
                            PG8_LAS unsigned char* tp = T + (8 * fq) * 72 + (16 * mm + fr) * 2;
#pragma unroll
                            for (int e = 0; e < 8; ++e) *(PG8_LAS unsigned short*)(tp + e * 72) = (unsigned short)((e & 1) ? (ww[e >> 1] >> 16) : (ww[e >> 1] & 0xffffu)); }
                        asm volatile("s_waitcnt lgkmcnt(0)" ::: "memory");
#pragma unroll
                        for (int rr = 0; rr < 2; ++rr) { const int q = lane + 64 * rr, d = q >> 2, tc = q & 3;
                            const unsigned long long x0 = *(const PG8_LAS unsigned long long*)(T + d * 72 + tc * 16), x1 = *(const PG8_LAS unsigned long long*)(T + d * 72 + tc * 16 + 8);
                            u32x4 o; o.x = (unsigned)x0; o.y = (unsigned)(x0 >> 32); o.z = (unsigned)x1; o.w = (unsigned)(x1 >> 32);
                            *(u32x4*)(VT + ((size_t)(((pn - 20) * 2 + bj) * 128 + 32 * wc + d)) * MROWS + u.pm * BM + ai * HALF + wr * 64 + 32 * mp + tc * 8) = o; }
                        asm volatile("s_waitcnt lgkmcnt(0)" ::: "memory");
                    }
            return;
        }
#pragma unroll
        for (int ai = 0; ai < 2; ++ai)
#pragma unroll
            for (int m = 0; m < 4; ++m) {
                const int r = row0 + ai * HALF + m * 16; const float rs = rstdx[r];
                f32x4 v[2][2];
#pragma unroll
                for (int bj = 0; bj < 2; ++bj)
#pragma unroll
                    for (int n = 0; n < 2; ++n) v[bj][n] = acc[ai][bj][m][n] * rs;
                if (pn < 4) {
#pragma unroll
                    for (int bj = 0; bj < 2; ++bj) *(u32x4*)(BG + (size_t)r * 1024 + pn * 256 + bj * 128 + colw) = pack8(v[bj][0], v[bj][1]);
                } else if (pn < 12) {
                    *(u32x4*)(UU + (size_t)r * 1024 + (pn - 4) * 128 + colw) = pack8(v[0][0] * v[1][0], v[0][1] * v[1][1]);
                } else {
                    f32x4 ra, rb, sa, sb;
#pragma unroll
                    for (int e = 0; e < 4; ++e) { const float ea0 = __builtin_amdgcn_exp2f(-1.4426950408889634f * v[0][0][e]), ea1 = __builtin_amdgcn_exp2f(-1.4426950408889634f * v[0][1][e]);
                        const float eb0 = __builtin_amdgcn_exp2f(-1.4426950408889634f * v[1][0][e]), eb1 = __builtin_amdgcn_exp2f(-1.4426950408889634f * v[1][1][e]);
                        ra[e] = (1.0f + eb0) * __builtin_amdgcn_rcpf(1.0f + ea0); rb[e] = (1.0f + eb1) * __builtin_amdgcn_rcpf(1.0f + ea1);
                        sa[e] = __builtin_amdgcn_rcpf(1.0f + eb0); sb[e] = __builtin_amdgcn_rcpf(1.0f + eb1); }
                    *(u32x4*)(SG + (size_t)r * 2048 + (pn - 24) * 128 + colw) = pack8(ra, rb);
                    *(u32x4*)(SG + (size_t)r * 2048 + 1024 + (pn - 24) * 128 + colw) = pack8(sa, sb);
                }
            }
    }
};
struct Epi4 {
    static constexpr bool PERM = true, AFTER_DRAIN = false;
    bf16_t* MG; const bf16_t* SG;
    static __device__ __forceinline__ bool keep_acc(const Unit& u) { return u.sel == 0; }
    __device__ __forceinline__ void operator()(f32x4 (&acc)[2][2][4][2], const Unit& u, int wr, int wc, int fr, int fq) const {
        const int row0 = u.pm * BM + wr * 64 + fr, col0 = u.pn * BM + wc * 32 + 8 * fq;
#pragma unroll
        for (int ai = 0; ai < 2; ++ai) {
            u32x4 g[4][2];
#pragma unroll
            for (int m = 0; m < 4; ++m)
#pragma unroll
                for (int bj = 0; bj < 2; ++bj) g[m][bj] = *(const u32x4*)(SG + (size_t)(row0 + ai * HALF + m * 16) * 2048 + u.sel * 1024 + col0 + bj * HALF);
#pragma unroll
            for (int m = 0; m < 4; ++m) { const int r = row0 + ai * HALF + m * 16;
#pragma unroll
                for (int bj = 0; bj < 2; ++bj) { const int c = col0 + bj * HALF; const u32x4 gg = g[m][bj];
                    f32x4 a = acc[ai][bj][m][0], b = acc[ai][bj][m][1];
                    a[0] *= bf_lo(gg.x); a[1] *= bf_hi(gg.x); a[2] *= bf_lo(gg.y); a[3] *= bf_hi(gg.y); b[0] *= bf_lo(gg.z); b[1] *= bf_hi(gg.z); b[2] *= bf_lo(gg.w); b[3] *= bf_hi(gg.w);
                    if (u.sel) *(u32x4*)(MG + (size_t)r * 1024 + c) = pack8(a, b);
                    else { acc[ai][bj][m][0] = a; acc[ai][bj][m][1] = b; } } }
        }
    }
};
struct Epi5 {
    static constexpr bool PERM = true, AFTER_DRAIN = false;
    static __device__ __forceinline__ bool keep_acc(const Unit&) { return false; }
    const float* X; float* OUT; bf16_t* HB; float* rowss;
    __device__ __forceinline__ void operator()(f32x4 (&acc)[2][2][4][2], const Unit& u, int wr, int wc, int fr, int fq) const {
        const int row0 = u.pm * BM + wr * 64 + fr, col0 = u.pn * BM + wc * 32 + 8 * fq;
#pragma unroll
        for (int ai = 0; ai < 2; ++ai) {
            f32x4 xv[4][2][2];
#pragma unroll
            for (int m = 0; m < 4; ++m)
#pragma unroll
                for (int bj = 0; bj < 2; ++bj) { const size_t o = (size_t)(row0 + ai * HALF + m * 16) * 1024 + col0 + bj * HALF; xv[m][bj][0] = *(const f32x4*)(X + o); xv[m][bj][1] = *(const f32x4*)(X + o + 4); }
#pragma unroll
            for (int m = 0; m < 4; ++m) { const int r = row0 + ai * HALF + m * 16; float ss = 0.f;
#pragma unroll
                for (int bj = 0; bj < 2; ++bj) { const size_t o = (size_t)r * 1024 + col0 + bj * HALF;
                    const f32x4 a = acc[ai][bj][m][0] + xv[m][bj][0], b = acc[ai][bj][m][1] + xv[m][bj][1];
                    *(u32x4*)(HB + o) = pack8(a, b);
                    ss += (a[0] * a[0] + a[1] * a[1]) + (a[2] * a[2] + a[3] * a[3]) + (b[0] * b[0] + b[1] * b[1]) + (b[2] * b[2] + b[3] * b[3]); }
                ss += __shfl_xor(ss, 16); ss += __shfl_xor(ss, 32);
                if (fq == 0) atomicAdd(rowss + r, ss); }
        }
    }
};
struct Epi6 {
    static constexpr bool PERM = true, AFTER_DRAIN = false;
    static __device__ __forceinline__ bool keep_acc(const Unit&) { return false; }
    bf16_t* ACT; const float* rowss; const float* cw; const float* cb; PG8_LAS float* halo;
    __device__ __forceinline__ void operator()(f32x4 (&acc)[2][2][4][2], const Unit& u, int wr, int wc, int fr, int fq) const {
        const int r0 = u.pm * 254 - 2, colw = wc * 32 + 8 * fq;
#pragma unroll
        for (int ai = 0; ai < 2; ++ai)
#pragma unroll
            for (int m = 0; m < 4; ++m) { int gr = r0 + ai * HALF + wr * 64 + m * 16 + fr; gr = gr < 0 ? 0 : (gr > MROWS - 1 ? MROWS - 1 : gr);
                const float rs = rsqrtf(rowss[gr] * (1.0f / 1024.0f) + 1e-6f);
#pragma unroll
                for (int bj = 0; bj < 2; ++bj)
#pragma unroll
                    for (int n = 0; n < 2; ++n) acc[ai][bj][m][n] *= rs; }
        if (fr >= 14) {
#pragma unroll
            for (int ai = 0; ai < 2; ++ai)
#pragma unroll
                for (int bj = 0; bj < 2; ++bj)
#pragma unroll
                    for (int n = 0; n < 2; ++n) *(PG8_LAS f32x4*)(halo + (((2 * ai + wr) * 2 + (fr - 14)) * 256 + bj * 128 + colw + 4 * n)) = acc[ai][bj][3][n];
        }
        f32x4 wn0, wn1, wn2, wnb;
        { const int col = u.pn * 128 + colw; wn0 = *(const f32x4*)(cw + col); wn1 = *(const f32x4*)(cw + 2 * DFF_ + col); wn2 = *(const f32x4*)(cw + 4 * DFF_ + col); wnb = *(const f32x4*)(cb + col); }
        asm volatile("s_waitcnt lgkmcnt(0)" ::: "memory"); __builtin_amdgcn_s_barrier(); asm volatile("" ::: "memory");
#pragma unroll
        for (int bj = 0; bj < 2; ++bj)
#pragma unroll
            for (int n = 0; n < 2; ++n) {
                const f32x4 w0 = wn0, w1 = wn1, w2 = wn2, bb = wnb;
                if (bj * 2 + n < 3) { const int k2 = bj * 2 + n + 1, col = (k2 >> 1) * DFF_ + u.pn * 128 + colw + 4 * (k2 & 1);
                    wn0 = *(const f32x4*)(cw + col); wn1 = *(const f32x4*)(cw + 2 * DFF_ + col); wn2 = *(const f32x4*)(cw + 4 * DFF_ + col); wnb = *(const f32x4*)(cb + col); }
#pragma unroll
                for (int ai = 0; ai < 2; ++ai) {
                    const int s = 2 * ai + wr;
                    const int sm = s > 0 ? s - 1 : 0; const float hz = s > 0 ? 1.0f : 0.0f;
                    const f32x4 h2 = *(const PG8_LAS f32x4*)(halo + ((sm * 2 + 0) * 256 + bj * 128 + colw + 4 * n)) * hz, h1 = *(const PG8_LAS f32x4*)(halo + ((sm * 2 + 1) * 256 + bj * 128 + colw + 4 * n)) * hz;
#pragma unroll
                    for (int mm = 0; mm < 4; ++mm) { const int m = 3 - mm;
                        f32x4 cur = acc[ai][bj][m][n]; asm volatile("" : "+v"(cur)); f32x4 p1, p2;
                        if (m > 0) { f32x4 lo = acc[ai][bj][m > 0 ? m - 1 : 0][n]; asm volatile("" : "+v"(lo));
#pragma unroll
                            for (int e = 0; e < 4; ++e) { p1[e] = dpp_shr<0x111>(dpp_ror<0x121>(lo[e]), cur[e]); p2[e] = dpp_shr<0x112>(dpp_ror<0x122>(lo[e]), cur[e]); } }
                        else {
#pragma unroll
                            for (int e = 0; e < 4; ++e) { p1[e] = dpp_shr<0x111>(h1[e], cur[e]); p2[e] = dpp_shr<0x112>(fr == 0 ? h2[e] : h1[e], cur[e]); } }
                        { f32x4 r_ = w0 * p2 + w1 * p1 + w2 * cur + bb; asm volatile("" : "+v"(r_)); acc[ai][bj][m][n] = r_; } }
                }
            }
#pragma unroll
        for (int ai = 0; ai < 2; ++ai)
#pragma unroll
            for (int m = 0; m < 4; ++m) { const int i = ai * HALF + wr * 64 + m * 16 + fr, gr = r0 + i;
                f32x4 a, b;
#pragma unroll
                for (int e = 0; e < 4; ++e) { const float g0 = acc[ai][0][m][0][e], g1 = acc[ai][0][m][1][e];
                    a[e] = g0 * fast_sigmoid(g0) * acc[ai][1][m][0][e]; b[e] = g1 * fast_sigmoid(g1) * acc[ai][1][m][1][e]; }
                if (i >= 2 && gr < MROWS) *(u32x4*)(ACT + (size_t)gr * DFF_ + u.pn * 128 + colw) = pack8(a, b); }
    }
};
struct Epi7 {
    static constexpr bool PERM = true, AFTER_DRAIN = false;
    static __device__ __forceinline__ bool keep_acc(const Unit&) { return false; }
    float* OUT; const bf16_t* HB;
    __device__ __forceinline__ void operator()(f32x4 (&acc)[2][2][4][2], const Unit& u, int wr, int wc, int fr, int fq) const {
        const int row0 = u.pm * BM + wr * 64 + fr, col0 = u.pn * BM + wc * 32 + 8 * fq;
#pragma unroll
        for (int ai = 0; ai < 2; ++ai) {
            u32x4 hv[4][2];
#pragma unroll
            for (int m = 0; m < 4; ++m)
#pragma unroll
                for (int bj = 0; bj < 2; ++bj) hv[m][bj] = *(const u32x4*)(HB + (size_t)(row0 + ai * HALF + m * 16) * 1024 + col0 + bj * HALF);
#pragma unroll
            for (int m = 0; m < 4; ++m) { const int r = row0 + ai * HALF + m * 16;
#pragma unroll
                for (int bj = 0; bj < 2; ++bj) { const size_t o = (size_t)r * 1024 + col0 + bj * HALF; float* p = OUT + o; const u32x4 hw = hv[m][bj];
                    f32x4 a = acc[ai][bj][m][0], b = acc[ai][bj][m][1];
                    a[0] += bf_lo(hw.x); a[1] += bf_hi(hw.x); a[2] += bf_lo(hw.y); a[3] += bf_hi(hw.y); b[0] += bf_lo(hw.z); b[1] += bf_hi(hw.z); b[2] += bf_lo(hw.w); b[3] += bf_hi(hw.w);
                    *(f32x4*)p = a; *(f32x4*)(p + 4) = b; } }
        }
    }
};
template <class Epi, class Sched, bool ALIGN_EPI = false, bool SP2 = false>
__device__ __forceinline__ void gemm_phase(PG8_LAS unsigned char* lds, const Gemm g, const Sched& S, const Epi& E) {
    const int tid = threadIdx.x, wid = __builtin_amdgcn_readfirstlane(tid >> 6), lane = tid & 63, wr = wid >> 2, wc = wid & 3, fr = lane & 15, fq = lane >> 4;
    const int K = g.K, nt = K / BK;
    unsigned voffA[2], voffB[2];
#pragma unroll
    for (int i = 0; i < 2; ++i) { int R, C; stage_rc(tid * 16 + i * 8192, R, C); const int Rb = Epi::PERM ? ((R & ~31) + perm32(R & 31)) : R;
        voffA[i] = (unsigned)(R * K + C) * 2u; voffB[i] = (unsigned)(Rb * K + C) * 2u; }
    const size_t kstep = (size_t)(BK * 2);
    const size_t hstep = (size_t)HALF * K * 2;
    const size_t tstep = 2 * hstep;
    const unsigned ldsw = (unsigned)wid * 1024u;
    const int aoff = lds_byte(wr * 64 + fr, fq * 8), boff = lds_byte(wc * 32 + fr, fq * 8);
#define PG8_SA(b, h) (((b) * 2 + (h)) * HTB)
#define PG8_SB(b, h) ((4 + (b) * 2 + (h)) * HTB)
#define PG8_STAGE(bufoff, gbase, voff) do { _Pragma("unroll") for (int _i = 0; _i < 2; ++_i) \
        __builtin_amdgcn_global_load_lds((const unsigned*)((const char*)(gbase) + (voff)[_i]), (PG8_LAS unsigned*)(lds + (bufoff) + ldsw + _i * 8192), 16, 0, 0); } while (0)
#define PG8_LDA(dst, b, h) do { _Pragma("unroll") for (int m = 0; m < 4; ++m) _Pragma("unroll") for (int k = 0; k < 2; ++k) dst[m][k] = *(const PG8_LAS bf16x8*)(lds + PG8_SA(b, h) + aoff + m * 2048 + k * 1024); } while (0)
#define PG8_LDB(dst, b, h) do { _Pragma("unroll") for (int n = 0; n < 2; ++n) _Pragma("unroll") for (int k = 0; k < 2; ++k) dst[n][k] = *(const PG8_LAS bf16x8*)(lds + PG8_SB(b, h) + boff + n * 2048 + k * 1024); } while (0)
#define PG8_MMA(ai, bj, At, Bt) do { __builtin_amdgcn_s_setprio(1); _Pragma("unroll") for (int m = 0; m < 4; ++m) _Pragma("unroll") for (int n = 0; n < 2; ++n) _Pragma("unroll") for (int k = 0; k < 2; ++k) \
        acc[ai][bj][m][n] = __builtin_amdgcn_mfma_f32_16x16x32_bf16(Bt[n][k], At[m][k], acc[ai][bj][m][n], 0, 0, 0); __builtin_amdgcn_s_setprio(0); } while (0)
#define PG8_WAIT_V(n) asm volatile("s_waitcnt vmcnt(" #n ")" ::: "memory")
#define PG8_WAIT_L(n) asm volatile("s_waitcnt lgkmcnt(" #n ")" ::: "memory")
#define PG8_BAR __builtin_amdgcn_s_barrier()
#define PG8_SCHED __builtin_amdgcn_sched_barrier(0)
    Unit cur, nxt; int ui = 0;
    if (!S.next(0, cur)) return;
    f32x4 acc[2][2][4][2];
#pragma unroll
    for (int a = 0; a < 2; ++a)
#pragma unroll
        for (int b = 0; b < 2; ++b)
#pragma unroll
            for (int m = 0; m < 4; ++m)
#pragma unroll
                for (int n = 0; n < 2; ++n) acc[a][b][m][n] = (f32x4){0.f, 0.f, 0.f, 0.f};
    bf16x8 At[4][2], B0[2][2], B1[2][2];
    const char* cA = (const char*)(cur.sel ? g.A1 : g.A0) + (size_t)cur.pm * g.a_tstep; const char* cB = (const char*)(cur.sel ? g.B1 : g.B0) + (size_t)cur.pn * tstep;
    S.a_ready(cur);
    if constexpr (SP2) {
        PG8_STAGE(PG8_SB(0, 0), cB, voffB); PG8_STAGE(PG8_SB(0, 1), cB + hstep, voffB); PG8_STAGE(PG8_SA(0, 0), cA, voffA); PG8_STAGE(PG8_SA(0, 1), cA + hstep, voffA);
        if (wr == 1) PG8_BAR;
        PG8_WAIT_V(2); PG8_BAR;
        PG8_STAGE(PG8_SB(1, 0), cB + kstep, voffB); PG8_STAGE(PG8_SA(1, 0), cA + kstep, voffA); PG8_STAGE(PG8_SB(1, 1), cB + hstep + kstep, voffB);
        PG8_WAIT_V(6); PG8_BAR;
    } else {
        PG8_STAGE(PG8_SB(0, 0), cB, voffB); PG8_STAGE(PG8_SA(0, 0), cA, voffA); PG8_STAGE(PG8_SB(0, 1), cB + hstep, voffB); PG8_STAGE(PG8_SA(0, 1), cA + hstep, voffA);
        if (wr == 1) PG8_BAR;
        PG8_WAIT_V(4); PG8_BAR;
        PG8_STAGE(PG8_SB(1, 0), cB + kstep, voffB); PG8_STAGE(PG8_SA(1, 0), cA + kstep, voffA); PG8_STAGE(PG8_SB(1, 1), cB + hstep + kstep, voffB);
        PG8_WAIT_V(6); PG8_BAR;
    }
    for (;;) {
        const bool has_next = S.next(ui + 1, nxt);
        const char* nA = has_next ? (const char*)(nxt.sel ? g.A1 : g.A0) + (size_t)nxt.pm * g.a_tstep : cA; const char* nB = has_next ? (const char*)(nxt.sel ? g.B1 : g.B0) + (size_t)nxt.pn * tstep : cB;
        for (int t = 0; t < nt; t += 2) {
            const bool last = (t == nt - 2);
            const char* a1 = cA + (size_t)(t + 1) * kstep;
            const char* a2 = last ? nA : cA + (size_t)(t + 2) * kstep; const char* b2 = last ? nB : cB + (size_t)(t + 2) * kstep;
            const char* a3 = a2 + kstep; const char* b3 = b2 + kstep;
            if (last && has_next) S.a_ready(nxt);
            if constexpr (SP2) {
            PG8_LDB(B0, 0, 0); PG8_LDB(B1, 0, 1); PG8_SCHED; PG8_LDA(At, 0, 0); PG8_STAGE(PG8_SA(1, 1), a1 + hstep, voffA);
            PG8_WAIT_V(8); PG8_WAIT_L(0); PG8_BAR; PG8_MMA(0, 0, At, B0); PG8_MMA(0, 1, At, B1); PG8_BAR; PG8_SCHED;
            PG8_LDA(At, 0, 1); PG8_STAGE(PG8_SB(0, 0), b2, voffB); PG8_STAGE(PG8_SB(0, 1), b2 + hstep, voffB); PG8_STAGE(PG8_SA(0, 0), a2, voffA);
            PG8_WAIT_V(8); PG8_WAIT_L(0); PG8_BAR; PG8_MMA(1, 0, At, B0); PG8_MMA(1, 1, At, B1); PG8_BAR; PG8_SCHED;
            PG8_LDB(B0, 1, 0); PG8_LDB(B1, 1, 1); PG8_SCHED; PG8_LDA(At, 1, 0); PG8_STAGE(PG8_SA(0, 1), a2 + hstep, voffA);
            PG8_WAIT_V(8); PG8_WAIT_L(0); PG8_BAR; PG8_MMA(0, 0, At, B0); PG8_MMA(0, 1, At, B1); PG8_BAR; PG8_SCHED;
            PG8_LDA(At, 1, 1); PG8_STAGE(PG8_SB(1, 0), b3, voffB); PG8_STAGE(PG8_SB(1, 1), b3 + hstep, voffB); PG8_STAGE(PG8_SA(1, 0), a3, voffA);
            PG8_WAIT_V(8); PG8_WAIT_L(0); PG8_BAR; PG8_MMA(1, 0, At, B0); PG8_MMA(1, 1, At, B1); PG8_BAR; PG8_SCHED;
            } else {
            PG8_LDB(B0, 0, 0); PG8_SCHED; PG8_LDA(At, 0, 0); PG8_STAGE(PG8_SA(1, 1), a1 + hstep, voffA);
            PG8_WAIT_L(8); PG8_BAR; PG8_WAIT_L(0); PG8_MMA(0, 0, At, B0); PG8_BAR; PG8_SCHED;
            PG8_LDB(B1, 0, 1); PG8_STAGE(PG8_SB(0, 0), b2, voffB);
            PG8_BAR; PG8_WAIT_L(0); PG8_MMA(0, 1, At, B1); PG8_BAR;
            PG8_LDA(At, 0, 1); PG8_STAGE(PG8_SA(0, 0), a2, voffA);
            PG8_BAR; PG8_WAIT_L(0); PG8_MMA(1, 0, At, B0); PG8_BAR; PG8_SCHED;
            PG8_STAGE(PG8_SB(0, 1), b2 + hstep, voffB);
            PG8_WAIT_V(6); PG8_BAR; PG8_MMA(1, 1, At, B1); PG8_BAR;
            PG8_LDB(B0, 1, 0); PG8_SCHED; PG8_LDA(At, 1, 0); PG8_STAGE(PG8_SA(0, 1), a2 + hstep, voffA);
            PG8_WAIT_L(8); PG8_BAR; PG8_WAIT_L(0); PG8_MMA(0, 0, At, B0); PG8_BAR; PG8_SCHED;
            PG8_LDB(B1, 1, 1); PG8_STAGE(PG8_SB(1, 0), b3, voffB);
            PG8_BAR; PG8_WAIT_L(0); PG8_MMA(0, 1, At, B1); PG8_BAR;
            PG8_LDA(At, 1, 1); PG8_STAGE(PG8_SA(1, 0), a3, voffA);
            PG8_BAR; PG8_WAIT_L(0); PG8_MMA(1, 0, At, B0); PG8_BAR; PG8_SCHED;
            PG8_STAGE(PG8_SB(1, 1), b3 + hstep, voffB);
            PG8_WAIT_V(6); PG8_BAR; PG8_MMA(1, 1, At, B1); PG8_BAR;
            }
        }
        if constexpr (ALIGN_EPI) { if (wr == 0) PG8_BAR; }
        if constexpr (!Epi::AFTER_DRAIN) { E(acc, cur, wr, wc, fr, fq); S.done(cur); }
        if (!has_next) break;
        if (!Epi::keep_acc(cur)) {
#pragma unroll
        for (int a = 0; a < 2; ++a)
#pragma unroll
            for (int b = 0; b < 2; ++b)
#pragma unroll
                for (int m = 0; m < 4; ++m)
#pragma unroll
                    for (int n = 0; n < 2; ++n) acc[a][b][m][n] = (f32x4){0.f, 0.f, 0.f, 0.f}; }
        cur = nxt; cA = nA; cB = nB; ++ui;
        if constexpr (ALIGN_EPI) { if (wr == 1) PG8_BAR; }
    }
    PG8_WAIT_V(0);
    if constexpr (!ALIGN_EPI) { if (wr == 0) PG8_BAR; }
    PG8_BAR;
    if constexpr (Epi::AFTER_DRAIN) { E.fused(acc, cur, wr, wc, fr, fq, lds, wid, lane); S.done(cur); }
#undef PG8_SA
#undef PG8_SB
#undef PG8_STAGE
#undef PG8_LDA
#undef PG8_LDB
#undef PG8_MMA
#undef PG8_WAIT_V
#undef PG8_WAIT_L
#undef PG8_BAR
#undef PG8_SCHED
}
}
#define GAS __attribute__((address_space(1)))
#define LAS __attribute__((address_space(3)))
typedef unsigned short bf16;
typedef unsigned v4u __attribute__((ext_vector_type(4)));
typedef float f32x4 __attribute__((ext_vector_type(4)));
typedef short bf16x8 __attribute__((ext_vector_type(8)));
typedef GAS unsigned gu32;
typedef GAS unsigned long long gu64;
#define RLX_AGENT __ATOMIC_RELAXED, __HIP_MEMORY_SCOPE_AGENT
#define LDS_WAIT() asm volatile("s_waitcnt lgkmcnt(0)" ::: "memory")
#define VM_WAIT() asm volatile("s_waitcnt vmcnt(0)" ::: "memory")
__device__ __forceinline__ unsigned long long rt() { return __builtin_amdgcn_s_memrealtime(); }
__device__ __forceinline__ unsigned f2bf(float f) { unsigned u = __builtin_bit_cast(unsigned, f); return (u + 0x7fffu + ((u >> 16) & 1u)) >> 16; }
__device__ __forceinline__ unsigned pk2(float lo, float hi) { return f2bf(lo) | (f2bf(hi) << 16); }

#define XB_TMO      128
#define XB_XCNT(j)  (256  + 64 * (j))
#define XB_XSUB(j)  (1280 + 64 * (j))
#define XB_XGEN(j)  (2304 + 64 * (j))
#define XB_TOP      3328
#define XB_TOPGEN   3392
#define XCD_BAR_WORDS 3456
#define XB_SPIN_CAP (1u << 18)

__device__ __forceinline__ unsigned xb_ld(unsigned* p)              { return __hip_atomic_load(p, __ATOMIC_RELAXED, __HIP_MEMORY_SCOPE_AGENT); }
__device__ __forceinline__ unsigned xb_add(unsigned* p, unsigned v) { return __hip_atomic_fetch_add(p, v, __ATOMIC_RELAXED, __HIP_MEMORY_SCOPE_AGENT); }
__device__ __forceinline__ unsigned xb_xcc_id() { return (unsigned)__builtin_amdgcn_s_getreg((3 << 11) | 20) & 0xFu; }
#define XB_SPIN(cond, bar) do { unsigned _sp = 0; while (cond) { __builtin_amdgcn_s_sleep(1); \
    if ((++_sp & 255u) == 0u) { if (xb_ld(&(bar)[XB_TMO])) break; if (_sp > XB_SPIN_CAP) { atomicAdd(&(bar)[XB_TMO], 1u); break; } } } } while (0)

struct XcdBarrier {
    unsigned* bar; unsigned x;
    volatile LAS unsigned* st;
};

__device__ __forceinline__ XcdBarrier xcd_barrier_post(unsigned* bar, volatile LAS unsigned* st) {
    XcdBarrier b; b.bar = bar; b.x = xb_xcc_id(); b.st = st;
    if (threadIdx.x == 0) (void)xb_add(&bar[XB_XCNT(b.x)], 1u);
    return b;
}
__device__ __forceinline__ void xcd_barrier_complete(unsigned* bar, unsigned x, unsigned& nloc, unsigned& nx) {
    const unsigned G = gridDim.x * gridDim.y * gridDim.z;
    unsigned sum, cnt, mine, sp = 0u;
    for (;;) {
        sum = 0u; cnt = 0u; mine = 0u;
#pragma unroll
        for (unsigned j = 0; j < 16; ++j) { const unsigned c = xb_ld(&bar[XB_XCNT(j)]); sum += c; cnt += (c > 0u) ? 1u : 0u; mine = (j == x) ? c : mine; }
        if (sum == G) break;
        __builtin_amdgcn_s_sleep(1);
        if ((++sp & 255u) == 0u) { if (xb_ld(&bar[XB_TMO])) break; if (sp > XB_SPIN_CAP) { atomicAdd(&bar[XB_TMO], 1u); break; } }
    }
    nloc = mine > 0u ? mine : 1u; nx = cnt > 0u ? cnt : 1u;
}

__device__ __forceinline__ void xcd_barrier(const XcdBarrier& b) {
    asm volatile("s_waitcnt vmcnt(0)" ::: "memory");
    __syncthreads();
    if (threadIdx.x == 0) {
        unsigned* bar = b.bar;
        __builtin_amdgcn_s_waitcnt(0);
        unsigned nloc = b.st[0], nx = b.st[1];
        if (nloc == 0u) { xcd_barrier_complete(bar, b.x, nloc, nx); b.st[0] = nloc; b.st[1] = nx; }
        const unsigned old = xb_add(&bar[XB_XSUB(b.x)], 1u);
        const unsigned gen = old / nloc;
        if (old + 1u == (gen + 1u) * nloc) {
            __builtin_amdgcn_fence(__ATOMIC_RELEASE, "agent");
            asm volatile("s_waitcnt vmcnt(0)" ::: "memory");
            const unsigned og = xb_add(&bar[XB_TOP], 1u);
            const unsigned tg = og / nx;
            if (og + 1u == (tg + 1u) * nx) xb_add(&bar[XB_TOPGEN], 1u);
            else XB_SPIN(xb_ld(&bar[XB_TOPGEN]) == tg, bar);
            __builtin_amdgcn_fence(__ATOMIC_ACQUIRE, "agent");
            xb_add(&bar[XB_XGEN(b.x)], 1u);
            asm volatile("s_waitcnt vmcnt(0)" ::: "memory");
        } else {
            XB_SPIN(xb_ld(&bar[XB_XGEN(b.x)]) == gen, bar);
            __builtin_amdgcn_fence(__ATOMIC_ACQUIRE, "agent");
            asm volatile("s_waitcnt vmcnt(0)" ::: "memory");
        }
    }
    __syncthreads();
}


constexpr int NWAVES = 8, NTHREADS = 512;
constexpr int M = 16384, D = 1024, NIN = 8192, DFF = 2816, NH = 8, HD = 128, NBLK = 64, BLK = 256;
constexpr float EPS = 1e-6f;
constexpr float C2 = 0.08838834764831845f * 1.4426950408889634f;
constexpr size_t MiB = 1u << 20;
constexpr size_t WS_CTL = 0, CTL_ZERO_BYTES = 256 * 1024;
constexpr int CW_BAR = 4096, CW_GCNT = 8192, CW_ROWSS = 16384;
constexpr size_t WS_KBAR = 1 * MiB, WS_RSTDX = 1 * MiB + 512 * 1024, WS_LPART = 2 * MiB;
constexpr size_t WS_WOA = 4 * MiB, WS_WOB = 6 * MiB, WS_WO = 8 * MiB;
constexpr size_t WS_Q = 10 * MiB, WS_K = 42 * MiB, WS_VT = 74 * MiB, WS_CA = 106 * MiB, WS_LIST = 138 * MiB, WS_WIN = 147 * MiB, WS_XB = 163 * MiB, WS_UU = 195 * MiB;
constexpr size_t WS_OPART = 147 * MiB;
constexpr size_t WS_WUP = 243 * MiB, WS_WDN = 138 * MiB, WS_MG = 165 * MiB, WS_HB = 198 * MiB;
constexpr size_t WS_ACT = 10 * MiB;
constexpr size_t WS_END = 256 * MiB;
constexpr int LDS_BYTES = 163840, MISC_OFF = 131072 + 320, HALO_OFF = 131072 + 1024, SCAN_OFF = 131072 + 1024;
__device__ __forceinline__ int list_off(int n) { return 256 * (63 * n - (n * (n - 1)) / 2); }
constexpr int LIST_PER_HEAD = 256 * 2016;

__device__ __forceinline__ float wave_sum(float v) {
#pragma unroll
    for (int o = 1; o < 64; o <<= 1) v += __shfl_xor(v, o);
    return v;
}
__device__ __forceinline__ void transpose_item(const float* W, int N, bf16* WT, int K, int k0, int col0, int row0, const float* ks, LAS float* scr, int lane) {
    float wv[32];
#pragma unroll
    for (int i = 0; i < 32; ++i) wv[i] = W[(size_t)(k0 + 2 * i + (lane >> 5)) * N + col0 + (lane & 31)];
#pragma unroll
    for (int i = 0; i < 32; ++i) { const int kk = 2 * i + (lane >> 5); const float s = ks ? ks[k0 + kk] : 1.0f; scr[kk * 33 + (lane & 31)] = s * wv[i]; }
    LDS_WAIT(); asm volatile("" ::: "memory");
    const int c = lane & 7;
#pragma unroll
    for (int j = 0; j < 4; ++j) { const int n = (lane >> 3) + 8 * j; const LAS float* s = scr + (8 * c) * 33 + n;
        v4u o; o.x = pk2(s[0 * 33], s[1 * 33]); o.y = pk2(s[2 * 33], s[3 * 33]); o.z = pk2(s[4 * 33], s[5 * 33]); o.w = pk2(s[6 * 33], s[7 * 33]);
        *(GAS v4u*)(WT + (size_t)(row0 + n) * K + k0 + 8 * c) = o; }
    LDS_WAIT(); asm volatile("" ::: "memory");
}
__device__ __forceinline__ int map_col(int mode, int R) {
    if (mode == 1) { if (R >= 1024 && R < 3072) { const int q = R - 1024; return 1024 + ((q >> 7) & 1) * 1024 + (q >> 8) * 128 + (q & 127); }
                     if (R >= 6144) { const int q = R - 6144; return 6144 + ((q >> 7) & 1) * 1024 + (q >> 8) * 128 + (q & 127); } return R; }
    if (mode == 2) return ((R >> 7) & 1) * DFF + (R >> 8) * 128 + (R & 127);
    return R;
}
__device__ __forceinline__ void convert_weight(const float* W, int K, int N, bf16* WT, const float* ks, int mode, LAS float* scr, int gw, int NGW, int lane) {
    const int nblk = N / 32, nitems = (K / 64) * nblk;
    for (int it = gw; it < nitems; it += NGW) { const int kb = it / nblk, nb = it % nblk; transpose_item(W, N, WT, K, 64 * kb, map_col(mode, 32 * nb), 32 * nb, ks, scr, lane); }
}

__device__ __forceinline__ void phase0(const float* x, const float* norm_mix, const float* w_in, const float* w_oa, const float* w_ob, const float* w_o, const float* w_up, const float* norm_ffn, unsigned char* ws, LAS unsigned char* lds, int vcu, int G, int wave, int lane) {
    LAS float* scr = (LAS float*)(lds + wave * 16384);
    const int gw = vcu * NWAVES + wave, NGW = G * NWAVES;
    convert_weight(w_in, D, NIN, (bf16*)(ws + WS_WIN), norm_mix, 1, scr, gw, NGW, lane);
    convert_weight(w_oa, D, D, (bf16*)(ws + WS_WOA), nullptr, 0, scr, gw, NGW, lane);
    convert_weight(w_ob, D, D, (bf16*)(ws + WS_WOB), nullptr, 0, scr, gw, NGW, lane);
    convert_weight(w_o, D, D, (bf16*)(ws + WS_WO), nullptr, 0, scr, gw, NGW, lane);
    convert_weight(w_up, D, 2 * DFF, (bf16*)(ws + WS_WUP), norm_ffn, 2, scr, gw, NGW, lane);
    bf16* XB = (bf16*)(ws + WS_XB); float* rstdx = (float*)(ws + WS_RSTDX);
    for (int m = gw; m < M; m += NGW) {
        const GAS f32x4* xr = (const GAS f32x4*)(x + (size_t)m * D) + lane; f32x4 v[4]; float s = 0.f;
#pragma unroll
        for (int j = 0; j < 4; ++j) { v[j] = xr[64 * j]; s += (v[j].x * v[j].x + v[j].y * v[j].y) + (v[j].z * v[j].z + v[j].w * v[j].w); }
        s = wave_sum(s); if (lane == 0) rstdx[m] = rsqrtf(s * (1.f / D) + EPS);
        GAS unsigned long long* o8 = (GAS unsigned long long*)(XB + (size_t)m * D) + lane;
#pragma unroll
        for (int j = 0; j < 4; ++j) o8[64 * j] = (unsigned long long)pk2(v[j].x, v[j].y) | ((unsigned long long)pk2(v[j].z, v[j].w) << 32);
    }
}
__device__ __forceinline__ void phase2(const float* conv_a_w, unsigned char* ws, int G, int tid, bf16* __restrict__ CAout) {
    const bf16* __restrict__ BG = (const bf16*)(ws + WS_CA); const bf16* __restrict__ UU = (const bf16*)(ws + WS_UU);
    for (int item = blockIdx.x * NTHREADS + tid; item < 128 * (M / 16); item += G * NTHREADS) {
        const int cc = (item & 127) * 8, t0 = (item >> 7) * 16;
        float w0[8], w1[8], w2[8], um2[8], um1[8];
#pragma unroll
        for (int j = 0; j < 2; ++j) { const f32x4 a = *(const GAS f32x4*)(conv_a_w + cc + 4 * j), b = *(const GAS f32x4*)(conv_a_w + 1024 + cc + 4 * j), c = *(const GAS f32x4*)(conv_a_w + 2048 + cc + 4 * j);
#pragma unroll
            for (int e = 0; e < 4; ++e) { w0[4 * j + e] = a[e]; w1[4 * j + e] = b[e]; w2[4 * j + e] = c[e]; } }
        { v4u a = (v4u){0u, 0u, 0u, 0u}, b = a; if (t0 >= 2) { a = *(const GAS v4u*)(UU + (size_t)(t0 - 2) * 1024 + cc); b = *(const GAS v4u*)(UU + (size_t)(t0 - 1) * 1024 + cc); }
          const unsigned aw[4] = {a.x, a.y, a.z, a.w}, bw[4] = {b.x, b.y, b.z, b.w};
#pragma unroll
          for (int j = 0; j < 4; ++j) { um2[2 * j] = pg8::bf_lo(aw[j]); um2[2 * j + 1] = pg8::bf_hi(aw[j]); um1[2 * j] = pg8::bf_lo(bw[j]); um1[2 * j + 1] = pg8::bf_hi(bw[j]); } }
#pragma unroll 4
        for (int i = 0; i < 16; ++i) { const size_t o = (size_t)(t0 + i) * 1024 + cc;
            const v4u u = *(const GAS v4u*)(UU + o), b = *(const GAS v4u*)(BG + o); const unsigned uw[4] = {u.x, u.y, u.z, u.w}, bw[4] = {b.x, b.y, b.z, b.w};
            float r[8];
#pragma unroll
            for (int j = 0; j < 4; ++j) { const float u0 = pg8::bf_lo(uw[j]), u1 = pg8::bf_hi(uw[j]);
                r[2 * j] = pg8::bf_lo(bw[j]) * (w0[2 * j] * um2[2 * j] + w1[2 * j] * um1[2 * j] + w2[2 * j] * u0);
                r[2 * j + 1] = pg8::bf_hi(bw[j]) * (w0[2 * j + 1] * um2[2 * j + 1] + w1[2 * j + 1] * um1[2 * j + 1] + w2[2 * j + 1] * u1);
                um2[2 * j] = um1[2 * j]; um2[2 * j + 1] = um1[2 * j + 1]; um1[2 * j] = u0; um1[2 * j + 1] = u1; }
            v4u o4; o4.x = pk2(r[0], r[1]); o4.y = pk2(r[2], r[3]); o4.z = pk2(r[4], r[5]); o4.w = pk2(r[6], r[7]);
            *(GAS v4u*)(CAout + o) = o4; }
    }
}
__device__ __forceinline__ bool top_better(float v, int n, float cv, int cn) { return v > cv || (v == cv && n < cn); }
__device__ __forceinline__ void top3_insert(float v, int n, float (&tv)[3], int (&ti)[3]) {
    if (top_better(v, n, tv[0], ti[0])) { tv[2] = tv[1]; ti[2] = ti[1]; tv[1] = tv[0]; ti[1] = ti[0]; tv[0] = v; ti[0] = n; }
    else if (top_better(v, n, tv[1], ti[1])) { tv[2] = tv[1]; ti[2] = ti[1]; tv[1] = v; ti[1] = n; }
    else if (top_better(v, n, tv[2], ti[2])) { tv[2] = v; ti[2] = n; }
}
__device__ __forceinline__ void phase2d(unsigned char* ws, LAS unsigned char* lds, int G, int tid, int wave, int lane, unsigned* gcnt, unsigned short* glist) {
    LAS unsigned* lcnt = (LAS unsigned*)(lds + 32768); LAS unsigned* lbase = lcnt + 64; LAS unsigned short* llist = (LAS unsigned short*)lds;
    const bf16* Q = (const bf16*)(ws + WS_Q); const float* kbar = (const float*)(ws + WS_KBAR);
    const int fr = lane & 15, fq = lane >> 4;
    for (int unit = blockIdx.x; unit < NH * 63; unit += G) {
        const int h = unit / 63, c = 1 + unit % 63;
        if (tid < 64) lcnt[tid] = 0u;
        __syncthreads();
        bf16x8 qf[2][4];
#pragma unroll
        for (int g = 0; g < 2; ++g)
#pragma unroll
            for (int ks = 0; ks < 4; ++ks) qf[g][ks] = *(const GAS bf16x8*)(Q + (size_t)(c * BLK + wave * 32 + g * 16 + fr) * 1024 + h * HD + ks * 32 + fq * 8);
        float tv[2][3]; int ti[2][3];
#pragma unroll
        for (int g = 0; g < 2; ++g)
#pragma unroll
            for (int j = 0; j < 3; ++j) { tv[g][j] = -__builtin_inff(); ti[g][j] = 1 << 20; }
        const int ntile = (c + 15) >> 4;
        for (int tile = 0; tile < ntile; ++tile) {
            f32x4 s0 = (f32x4){0.f, 0.f, 0.f, 0.f}, s1 = s0;
#pragma unroll
            for (int ks = 0; ks < 4; ++ks) {
                const float* kp = kbar + ((size_t)(h * NBLK + tile * 16 + fr) * HD + ks * 32 + fq * 8);
                const f32x4 a = *(const GAS f32x4*)kp, b = *(const GAS f32x4*)(kp + 4);
                const v4u hw = pg8::pack8(a, b);
                f32x4 ra, rb; ra[0] = a[0] - pg8::bf_lo(hw.x); ra[1] = a[1] - pg8::bf_hi(hw.x); ra[2] = a[2] - pg8::bf_lo(hw.y); ra[3] = a[3] - pg8::bf_hi(hw.y);
                rb[0] = b[0] - pg8::bf_lo(hw.z); rb[1] = b[1] - pg8::bf_hi(hw.z); rb[2] = b[2] - pg8::bf_lo(hw.w); rb[3] = b[3] - pg8::bf_hi(hw.w);
                const v4u lw = pg8::pack8(ra, rb);
                const bf16x8 hi = __builtin_bit_cast(bf16x8, hw), lo = __builtin_bit_cast(bf16x8, lw);
                s0 = __builtin_amdgcn_mfma_f32_16x16x32_bf16(hi, qf[0][ks], s0, 0, 0, 0); s0 = __builtin_amdgcn_mfma_f32_16x16x32_bf16(lo, qf[0][ks], s0, 0, 0, 0);
                s1 = __builtin_amdgcn_mfma_f32_16x16x32_bf16(hi, qf[1][ks], s1, 0, 0, 0); s1 = __builtin_amdgcn_mfma_f32_16x16x32_bf16(lo, qf[1][ks], s1, 0, 0, 0);
            }
#pragma unroll
            for (int i = 0; i < 4; ++i) { const int n = tile * 16 + 4 * fq + i;
                top3_insert(n < c ? s0[i] : -__builtin_inff(), n, tv[0], ti[0]); top3_insert(n < c ? s1[i] : -__builtin_inff(), n, tv[1], ti[1]); }
        }
#pragma unroll
        for (int off = 16; off <= 32; off <<= 1)
#pragma unroll
            for (int g = 0; g < 2; ++g) { float pv[3]; int pi[3];
#pragma unroll
                for (int j = 0; j < 3; ++j) { pv[j] = __shfl_xor(tv[g][j], off); pi[j] = __shfl_xor(ti[g][j], off); }
#pragma unroll
                for (int j = 0; j < 3; ++j) top3_insert(pv[j], pi[j], tv[g], ti[g]); }
        const int nsel = c < 3 ? c : 3;
        if (fq == 0) {
#pragma unroll
            for (int g = 0; g < 2; ++g) { const int tl = wave * 32 + g * 16 + fr;
#pragma unroll
                for (int j = 0; j < 3; ++j) if (j < nsel) { const int n = ti[g][j]; const unsigned pp = __hip_atomic_fetch_add(&lcnt[n], 1u, __ATOMIC_RELAXED, __HIP_MEMORY_SCOPE_WORKGROUP); llist[n * 256 + pp] = (unsigned short)((tl << 2) | j); } }
        }
        __syncthreads();
        if (tid < c) { const unsigned k = lcnt[tid]; lbase[tid] = k ? atomicAdd(gcnt + h * NBLK + tid, k) : 0u; }
        __syncthreads();
        for (int n = wave; n < c; n += NWAVES) { const unsigned k = lcnt[n], base = lbase[n];
            unsigned short* dst = glist + (size_t)h * LIST_PER_HEAD + list_off(n) + base;
            for (unsigned i = lane; i < k; i += 64) { const unsigned e = llist[n * 256 + i]; dst[i] = (unsigned short)((((unsigned)c * BLK + (e >> 2)) << 2) | (e & 3u)); } }
        __syncthreads();
    }
}
__device__ __forceinline__ void stage_kv(const bf16* Kg, const bf16* Vt, int h, int n, LAS unsigned char* lds, int tid) {
    v4u kw[8], vw[8];
#pragma unroll
    for (int i = 0; i < 8; ++i) { const int row = (tid >> 4) + 32 * i, ch = tid & 15; kw[i] = *(const GAS v4u*)(Kg + (size_t)(n * BLK + row) * 1024 + h * HD + ch * 8); }
#pragma unroll
    for (int i = 0; i < 8; ++i) { const int row = (tid >> 5) + 16 * i, ch = tid & 31; vw[i] = *(const GAS v4u*)(Vt + (size_t)(h * HD + row) * M + n * BLK + ch * 8); }
#pragma unroll
    for (int i = 0; i < 8; ++i) { const int row = (tid >> 4) + 32 * i, ch = tid & 15; const int sw = (((row >> 3) & 3) << 2) | (row & 3);
        *(LAS v4u*)(lds + row * 256 + ((ch ^ sw) << 4)) = kw[i]; }
#pragma unroll
    for (int i = 0; i < 8; ++i) { const int row = (tid >> 5) + 16 * i, ch = tid & 31;
        *(LAS v4u*)(lds + 65536 + row * 512 + ((ch ^ ((((row >> 4) & 3) << 2) | (row & 3))) << 4)) = vw[i]; }
}
template <bool CAUSAL, int MODE = 0>
__device__ __forceinline__ void attn_core(const LAS unsigned char* lds, const bf16* Q, int h, const int (&tq)[2], int wave, int fr, int fq, float B2, f32x4 (&O)[8][2], float (&l)[2]) {
    bf16x8 qf[2][4];
#pragma unroll
    for (int g = 0; g < 2; ++g)
#pragma unroll
        for (int ks = 0; ks < 4; ++ks) qf[g][ks] = *(const GAS bf16x8*)(Q + (size_t)tq[g] * 1024 + h * HD + ks * 32 + fq * 8);
#pragma unroll
    for (int dt = 0; dt < 8; ++dt) { O[dt][0] = (f32x4){0.f, 0.f, 0.f, 0.f}; O[dt][1] = O[dt][0]; }
    l[0] = 0.f; l[1] = 0.f;
    const int nch = CAUSAL ? wave + 1 : 8;
    const int krow = (fr >> 2) * 8 + (fr & 3);
    bf16x8 kf[4][2];
#pragma unroll
    for (int ks = 0; ks < 4; ++ks)
#pragma unroll
        for (int t = 0; t < 2; ++t) kf[ks][t] = *(const LAS bf16x8*)(lds + (krow + t * 4) * 256 + (((ks * 4 + fq) ^ fr) << 4));
#pragma unroll 2
    for (int c = 0; c < nch; ++c) {
        f32x4 s[2][2];
#pragma unroll
        for (int t = 0; t < 2; ++t) { s[t][0] = (f32x4){-B2, -B2, -B2, -B2}; s[t][1] = s[t][0]; }
        bf16x8 vf[8];
#pragma unroll
        for (int dt = 0; dt < 8; ++dt) vf[dt] = *(const LAS bf16x8*)(lds + 65536 + ((dt >> 2) * 64 + (fr >> 2) * 16 + (dt & 3) * 4 + (fr & 3)) * 512 + (((c * 4 + fq) ^ fr) << 4));
#pragma unroll
        for (int ks = 0; ks < 4; ++ks)
#pragma unroll
            for (int t = 0; t < 2; ++t) {
                if (MODE != 2 || ks == 0) {
                s[t][0] = __builtin_amdgcn_mfma_f32_16x16x32_bf16(kf[ks][t], qf[0][ks], s[t][0], 0, 0, 0);
                s[t][1] = __builtin_amdgcn_mfma_f32_16x16x32_bf16(kf[ks][t], qf[1][ks], s[t][1], 0, 0, 0); }
            }
        __builtin_amdgcn_sched_barrier(0);
        { const int cn = (c + 1 < nch) ? c + 1 : c;
#pragma unroll
          for (int ks = 0; ks < 4; ++ks)
#pragma unroll
              for (int t = 0; t < 2; ++t) kf[ks][t] = *(const LAS bf16x8*)(lds + (cn * 32 + krow + t * 4) * 256 + (((ks * 4 + fq) ^ fr) << 4)); }
        bf16x8 pf[2];
#pragma unroll
        for (int g = 0; g < 2; ++g) {
            float p[8];
#pragma unroll
            for (int t = 0; t < 2; ++t)
#pragma unroll
                for (int i = 0; i < 4; ++i) { float e = MODE == 1 ? s[t][g][i] : __builtin_amdgcn_exp2f(s[t][g][i]);
                    if (CAUSAL && c == wave) { const int kl = c * 32 + fq * 8 + t * 4 + i, ql = wave * 32 + g * 16 + fr; if (kl > ql) e = 0.f; }
                    p[t * 4 + i] = e; }
            l[g] += ((p[0] + p[1]) + (p[2] + p[3])) + ((p[4] + p[5]) + (p[6] + p[7]));
            v4u w; w.x = pg8::cvt_pk_bf16(p[0], p[1]); w.y = pg8::cvt_pk_bf16(p[2], p[3]); w.z = pg8::cvt_pk_bf16(p[4], p[5]); w.w = pg8::cvt_pk_bf16(p[6], p[7]);
            pf[g] = __builtin_bit_cast(bf16x8, w);
        }
#pragma unroll
        for (int dt = 0; dt < 8; ++dt) {
            if (MODE != 3 || dt == 0) {
            O[dt][0] = __builtin_amdgcn_mfma_f32_16x16x32_bf16(vf[dt], pf[0], O[dt][0], 0, 0, 0);
            O[dt][1] = __builtin_amdgcn_mfma_f32_16x16x32_bf16(vf[dt], pf[1], O[dt][1], 0, 0, 0); }
        }
    }
    l[0] += __shfl_xor(l[0], 16); l[0] += __shfl_xor(l[0], 32); l[1] += __shfl_xor(l[1], 16); l[1] += __shfl_xor(l[1], 32);
}
__device__ __forceinline__ float score_bound(const float* q_norm, const float* k_norm, int lane) {
    float a = fmaxf(fabsf(q_norm[lane]), fabsf(q_norm[lane + 64])), b = fmaxf(fabsf(k_norm[lane]), fabsf(k_norm[lane + 64]));
#pragma unroll
    for (int o = 1; o < 64; o <<= 1) { a = fmaxf(a, __shfl_xor(a, o)); b = fmaxf(b, __shfl_xor(b, o)); }
    return 128.0f * a * b * C2 * 1.001f + 0.01f;
}
template <int MODE>
__device__ __forceinline__ void phase3a(const float* q_norm, const float* k_norm, unsigned char* ws, LAS unsigned char* lds, int G, int tid, int wave, int lane) {
    const int fr = lane & 15, fq = lane >> 4;
    LAS int* pre = (LAS int*)(lds + SCAN_OFF);
    LAS int* cntl = (LAS int*)(lds + SCAN_OFF + 2080);
    const unsigned* gcnt = (const unsigned*)(ws + WS_CTL) + CW_GCNT; const unsigned short* glist = (const unsigned short*)(ws + WS_LIST);
    const bf16* Q = (const bf16*)(ws + WS_Q); const bf16* Kg = (const bf16*)(ws + WS_K); const bf16* Vt = (const bf16*)(ws + WS_VT);
    unsigned char* OP = ws + WS_OPART; float* LP = (float*)(ws + WS_LPART);
    const float B2 = score_bound(q_norm, k_norm, lane);
    { const int cnt = (int)__hip_atomic_load(gcnt + tid, __ATOMIC_RELAXED, __HIP_MEMORY_SCOPE_AGENT); pre[tid + 1] = (cnt + 255) >> 8; cntl[tid] = cnt; if (tid == 0) pre[0] = 0; }
    __syncthreads();
    for (int o = 1; o < 512; o <<= 1) { const int v = pre[tid + 1] + ((tid + 1 - o) >= 1 ? pre[tid + 1 - o] : 0); __syncthreads(); pre[tid + 1] = v; __syncthreads(); }
    const int T = pre[512];
    const int i_lo = (int)(((long)blockIdx.x * T) / G), i_hi = (int)(((long)(blockIdx.x + 1) * T) / G);
    int staged = -1;
#define P3A_DECODE(IT, HN, TILE) do { int lo_ = 0, hi_ = 511; while (lo_ < hi_) { const int mid_ = (lo_ + hi_ + 1) >> 1; if (pre[mid_] <= (IT)) lo_ = mid_; else hi_ = mid_ - 1; } HN = lo_; TILE = (IT) - pre[lo_]; } while (0)
    unsigned en[2] = {0u, 0u}; bool okn[2] = {false, false};
    if (i_lo < i_hi) { int hn, tile; P3A_DECODE(i_lo, hn, tile); const int cnt = cntl[hn]; const unsigned short* lst = glist + (size_t)(hn >> 6) * LIST_PER_HEAD + list_off(hn & 63) + tile * 256;
#pragma unroll
        for (int g = 0; g < 2; ++g) { const int qi = wave * 32 + g * 16 + fr; okn[g] = tile * 256 + qi < cnt; en[g] = okn[g] ? lst[qi] : 0u; } }
    for (int it = i_lo; it < i_hi; ++it) {
        int hn, tile; P3A_DECODE(it, hn, tile); const int h = hn >> 6, n = hn & 63;
        int tq[2], sj[2]; bool ok[2];
#pragma unroll
        for (int g = 0; g < 2; ++g) { ok[g] = okn[g]; tq[g] = (int)(en[g] >> 2); sj[g] = (int)(en[g] & 3u); }
        if (it + 1 < i_hi) { int hn2, tile2; P3A_DECODE(it + 1, hn2, tile2); const int cnt2 = cntl[hn2]; const unsigned short* lst2 = glist + (size_t)(hn2 >> 6) * LIST_PER_HEAD + list_off(hn2 & 63) + tile2 * 256;
#pragma unroll
            for (int g = 0; g < 2; ++g) { const int qi = wave * 32 + g * 16 + fr; okn[g] = tile2 * 256 + qi < cnt2; en[g] = okn[g] ? lst2[qi] : 0u; } }
        if (hn != staged) { __syncthreads(); stage_kv(Kg, Vt, h, n, lds, tid); LDS_WAIT(); __syncthreads(); staged = hn; }
        f32x4 O[8][2]; float l[2];
        attn_core<false, MODE>(lds, Q, h, tq, wave, fr, fq, B2, O, l);
#pragma unroll
        for (int g = 0; g < 2; ++g) if (ok[g]) {
            unsigned char* op = OP + ((size_t)sj[g] * M + tq[g]) * 1024 + h * HD + 16 * fq;
            const float sc = 16.0f / l[g];
#pragma unroll
            for (int j = 0; j < 2; ++j) { v4u w;
                { int t = 0; t = __builtin_amdgcn_cvt_pk_fp8_f32(O[4 * j][g][0] * sc, O[4 * j][g][1] * sc, t, false); t = __builtin_amdgcn_cvt_pk_fp8_f32(O[4 * j][g][2] * sc, O[4 * j][g][3] * sc, t, true); w.x = (unsigned)t; }
                { int t = 0; t = __builtin_amdgcn_cvt_pk_fp8_f32(O[4 * j + 1][g][0] * sc, O[4 * j + 1][g][1] * sc, t, false); t = __builtin_amdgcn_cvt_pk_fp8_f32(O[4 * j + 1][g][2] * sc, O[4 * j + 1][g][3] * sc, t, true); w.y = (unsigned)t; }
                { int t = 0; t = __builtin_amdgcn_cvt_pk_fp8_f32(O[4 * j + 2][g][0] * sc, O[4 * j + 2][g][1] * sc, t, false); t = __builtin_amdgcn_cvt_pk_fp8_f32(O[4 * j + 2][g][2] * sc, O[4 * j + 2][g][3] * sc, t, true); w.z = (unsigned)t; }
                { int t = 0; t = __builtin_amdgcn_cvt_pk_fp8_f32(O[4 * j + 3][g][0] * sc, O[4 * j + 3][g][1] * sc, t, false); t = __builtin_amdgcn_cvt_pk_fp8_f32(O[4 * j + 3][g][2] * sc, O[4 * j + 3][g][3] * sc, t, true); w.w = (unsigned)t; }
                *(GAS v4u*)(op + j * 64) = w; }
            if (fq == 0) LP[((size_t)sj[g] * M + tq[g]) * NH + h] = l[g];
        }
    }
#undef P3A_DECODE
    __syncthreads();
}
__device__ __forceinline__ void phase3b(const float* q_norm, const float* k_norm, unsigned char* ws, LAS unsigned char* lds, int G, int tid, int wave, int lane, bf16* Oout) {
    const int fr = lane & 15, fq = lane >> 4;
    bf16* Q = (bf16*)(ws + WS_Q); const bf16* Kg = (const bf16*)(ws + WS_K); const bf16* Vt = (const bf16*)(ws + WS_VT);
    const unsigned char* OP = ws + WS_OPART; const float* LP = (const float*)(ws + WS_LPART);
    const float B2 = score_bound(q_norm, k_norm, lane);
    for (int unit = blockIdx.x; unit < NH * NBLK; unit += G) {
        const int h = unit >> 6, c = unit & 63;
        __syncthreads(); stage_kv(Kg, Vt, h, c, lds, tid); LDS_WAIT(); __syncthreads();
        int tq[2];
#pragma unroll
        for (int g = 0; g < 2; ++g) tq[g] = c * BLK + wave * 32 + g * 16 + fr;
        f32x4 O[8][2]; float l[2];
        attn_core<true>(lds, Q, h, tq, wave, fr, fq, B2, O, l);
        const int nsel = c < 3 ? c : 3;
#pragma unroll
        for (int g = 0; g < 2; ++g) {
            float lp[3];
#pragma unroll
            for (int j = 0; j < 3; ++j) lp[j] = LP[((size_t)j * M + tq[g]) * NH + h];
            v4u w[3][2];
#pragma unroll
            for (int j = 0; j < 3; ++j)
#pragma unroll
                for (int k = 0; k < 2; ++k) w[j][k] = *(const GAS v4u*)(OP + ((size_t)j * M + tq[g]) * 1024 + h * HD + k * 64 + 16 * fq);
            float lt = l[g]; float ls[3];
#pragma unroll
            for (int j = 0; j < 3; ++j) { ls[j] = j < nsel ? lp[j] * (1.0f / 16.0f) : 0.f; lt += j < nsel ? lp[j] : 0.f; }
            const float inv = 1.0f / lt;
#pragma unroll
            for (int k = 0; k < 2; ++k) {
                f32x4 o[4];
#pragma unroll
                for (int q = 0; q < 4; ++q) o[q] = O[4 * k + q][g];
#pragma unroll
                for (int j = 0; j < 3; ++j) if (j < nsel) { const unsigned xw[4] = {w[j][k].x, w[j][k].y, w[j][k].z, w[j][k].w};
#pragma unroll
                    for (int q = 0; q < 4; ++q) { const pg8::f32x2_t_ lo = __builtin_amdgcn_cvt_pk_f32_fp8((int)xw[q], false), hi = __builtin_amdgcn_cvt_pk_f32_fp8((int)xw[q], true);
                        o[q][0] += lo[0] * ls[j]; o[q][1] += lo[1] * ls[j]; o[q][2] += hi[0] * ls[j]; o[q][3] += hi[1] * ls[j]; } }
                bf16* dst = Oout + (size_t)tq[g] * 1024 + h * HD + k * 64 + 16 * fq;
                *(GAS v4u*)dst = pg8::pack8(o[0] * inv, o[1] * inv); *(GAS v4u*)(dst + 8) = pg8::pack8(o[2] * inv, o[3] * inv); }
        }
    }
    __syncthreads();
}

#ifndef MK_PER_PHASE
#define MK_PER_PHASE 0
#endif
#ifndef MK_DUP
#define MK_DUP -1
#endif
constexpr int N_PHASES = 9;
struct Args { const float* in[14]; float* out; unsigned char* ws; int ph_lo, ph_hi; };
__global__ void __launch_bounds__(NTHREADS, 2) hybrid_fwd(Args args) {
    extern __shared__ __attribute__((aligned(16))) unsigned char lds_raw[];
    LAS unsigned char* lds = (LAS unsigned char*)lds_raw;
    volatile LAS unsigned* MISC = (volatile LAS unsigned*)(lds + MISC_OFF);
    const int tid = threadIdx.x, lane = tid & 63, wave = __builtin_amdgcn_readfirstlane(tid >> 6);
    const int G = gridDim.x; const int vcu = (G % 8 == 0) ? ((int)blockIdx.x % 8) * (G / 8) + (int)blockIdx.x / 8 : (int)blockIdx.x;
    unsigned char* ws = args.ws;
    gu32* ctl = (gu32*)(ws + WS_CTL);
    if (tid < 32) MISC[tid] = 0u;
    __syncthreads();
    const int lo = args.ph_lo, hi = args.ph_hi;
    XcdBarrier bar; bar.bar = (unsigned*)ctl + CW_BAR; bar.x = 0; bar.st = nullptr;
    if (hi - lo > 1) bar = xcd_barrier_post((unsigned*)ctl + CW_BAR, MISC + 8);
#ifndef PHASE_MASK
#define PHASE_MASK 0x1ff
#endif
#define IN(k) (((PHASE_MASK >> (k)) & 1) && lo <= (k) && (k) < hi)
#define SEAM(k) do { if (IN(k) && IN((k) + 1)) xcd_barrier(bar); } while (0)
    const float* x = args.in[0]; const float* norm_mix = args.in[1]; const float* w_in = args.in[2]; const float* conv_a_w = args.in[3]; const float* q_norm = args.in[4]; const float* k_norm = args.in[5];
    const float* w_oa = args.in[6]; const float* w_ob = args.in[7]; const float* w_o = args.in[8]; const float* norm_ffn = args.in[9]; const float* w_up = args.in[10]; const float* ffn_conv_w = args.in[11];
    const float* ffn_conv_b = args.in[12]; const float* w_down = args.in[13];
    float* out = args.out;
    float* rowss = (float*)((unsigned*)ctl + CW_ROWSS);
    const size_t TSTEP = (size_t)256 * 1024 * 2;

    if (IN(0)) { phase0(x, norm_mix, w_in, w_oa, w_ob, w_o, w_up, norm_ffn, ws, lds, vcu, G, wave, lane); __syncthreads(); }
    SEAM(0);
    if (IN(1)) {
        pg8::Gemm g{(const bf16*)(ws + WS_XB), (const bf16*)(ws + WS_XB), (const bf16*)(ws + WS_WIN), (const bf16*)(ws + WS_WIN), D, TSTEP};
        pg8::StaticOrder S; S.init(M / 256, NIN / 256, G, (int)blockIdx.x);
        pg8::Epi1 E{(bf16*)(ws + WS_CA), (bf16*)(ws + WS_UU), (bf16*)(ws + WS_Q), (bf16*)(ws + WS_K), (bf16*)(ws + WS_VT), (bf16*)out, (const float*)(ws + WS_RSTDX), q_norm, k_norm, (float*)(ws + WS_KBAR), (PG8_LAS float*)(lds + HALO_OFF)};
        pg8::gemm_phase<pg8::Epi1, pg8::StaticOrder, true, true>(lds, g, S, E);
    }
    SEAM(1);
    if (IN(2)) { phase2d(ws, lds, G, tid, wave, lane, (unsigned*)(ws + WS_CTL) + CW_GCNT, (unsigned short*)(ws + WS_LIST));
        phase2(conv_a_w, ws, G, tid, (bf16*)(ws + WS_CA)); __syncthreads(); }
#if MK_DUP == 21
    if (IN(2)) { phase2d(ws, lds, G, tid, wave, lane, (unsigned*)(ws + WS_CTL) + CW_GCNT + 512, (unsigned short*)(ws + WS_WIN)); }
#endif
#if MK_DUP == 22
    if (IN(2)) { phase2(conv_a_w, ws, G, tid, (bf16*)(ws + WS_XB)); }
#endif
    SEAM(2);
#if MK_DUP >= 30 && MK_DUP <= 35
    if (IN(3)) phase3a<MK_DUP - 30>(q_norm, k_norm, ws, lds, G, tid, wave, lane);
#endif
    if (IN(3)) phase3a<0>(q_norm, k_norm, ws, lds, G, tid, wave, lane);
    SEAM(3);
    if (IN(4)) { phase3b(q_norm, k_norm, ws, lds, G, tid, wave, lane, (bf16*)(ws + WS_Q));
#if MK_DUP == 4
        phase3b(q_norm, k_norm, ws, lds, G, tid, wave, lane, (bf16*)(ws + WS_OPART));
#endif
        }
    SEAM(4);
    if (IN(5)) {
        { LAS float* scr = (LAS float*)(lds + wave * 16384); const int gw = vcu * NWAVES + wave, NGW = G * NWAVES;
          if (blockIdx.x == 0 && tid < 256) *(GAS v4u*)(ws + WS_HB - 4096 + tid * 16) = (v4u){0u, 0u, 0u, 0u};
          __syncthreads(); }
        pg8::Gemm g{(const bf16*)(ws + WS_CA), (const bf16*)(ws + WS_Q), (const bf16*)(ws + WS_WOA), (const bf16*)(ws + WS_WOB), D, TSTEP};
        pg8::DualOrder S; S.S.init(M / 256, D / 256, G, (int)blockIdx.x);
        pg8::Epi4 E{(bf16*)(ws + WS_MG), (const bf16*)out};
        pg8::gemm_phase<pg8::Epi4, pg8::DualOrder, true, true>(lds, g, S, E);
    }
    SEAM(5);
    if (IN(6)) {
        pg8::Gemm g{(const bf16*)(ws + WS_MG), (const bf16*)(ws + WS_MG), (const bf16*)(ws + WS_WO), (const bf16*)(ws + WS_WO), D, TSTEP};
        pg8::StaticOrder S; S.init(M / 256, D / 256, G, (int)blockIdx.x);
        pg8::Epi5 E{x, out, (bf16*)(ws + WS_HB), rowss};
        pg8::gemm_phase<pg8::Epi5, pg8::StaticOrder, true, true>(lds, g, S, E);
#if MK_DUP == 6
        { pg8::Epi5 E2{x, (float*)(ws + WS_Q), (bf16*)(ws + WS_VT), (float*)(ws + WS_CA)}; pg8::gemm_phase<pg8::Epi5, pg8::StaticOrder, true, true>(lds, g, S, E2); }
#endif
    }
    SEAM(6);
    if (IN(7)) {
        const bf16* hb2 = (const bf16*)(ws + WS_HB) - 2 * 1024;
        pg8::Gemm g{hb2, hb2, (const bf16*)(ws + WS_WUP), (const bf16*)(ws + WS_WUP), D, (size_t)254 * 1024 * 2};
        pg8::StaticOrder S; S.init(65, 22, G, (int)blockIdx.x);
        pg8::Epi6 E{(bf16*)(ws + WS_ACT), rowss, ffn_conv_w, ffn_conv_b, (PG8_LAS float*)(lds + HALO_OFF)};
        pg8::gemm_phase<pg8::Epi6, pg8::StaticOrder, true, true>(lds, g, S, E);
        { const int nwg = 65 * 22, full = nwg % G, nidle = full ? G - full : G, idx = full ? (int)blockIdx.x - full : (int)blockIdx.x;
          if (idx >= 0) convert_weight(w_down, DFF, D, (bf16*)(ws + WS_WDN), nullptr, 0, (LAS float*)(lds + wave * 16384), idx * NWAVES + wave, nidle * NWAVES, lane);
          __syncthreads(); }
    }
    SEAM(7);
    if (IN(8)) {
        pg8::Gemm g{(const bf16*)(ws + WS_ACT), (const bf16*)(ws + WS_ACT), (const bf16*)(ws + WS_WDN), (const bf16*)(ws + WS_WDN), DFF, (size_t)256 * DFF * 2};
        pg8::StaticOrder S; S.init(M / 256, D / 256, G, (int)blockIdx.x);
        pg8::Epi7 E{out, (const bf16*)(ws + WS_HB)};
        pg8::gemm_phase<pg8::Epi7, pg8::StaticOrder, true, true>(lds, g, S, E);
#if MK_DUP == 8
        { pg8::Epi7 E2{(float*)(ws + WS_MG), (const bf16*)(ws + WS_HB)}; pg8::gemm_phase<pg8::Epi7, pg8::StaticOrder, true, true>(lds, g, S, E2); }
#endif
    }
#undef IN
#undef SEAM
}

extern "C" void kernel_launch(void* const* d_in, const int* in_sizes, int n_in, void* d_out, int out_size, void* d_ws, size_t ws_size, hipStream_t stream) {
    static int grid = 0;
    if (grid == 0) {
        if (n_in != 14 || in_sizes[0] != M * D || out_size != M * D || ws_size < WS_END) { fprintf(stderr, "kernel_launch: unexpected shapes (n_in %d, in0 %d, out %d, ws %zu)\n", n_in, n_in > 0 ? in_sizes[0] : -1, out_size, ws_size); grid = -1; return; }
        int dev = 0, cus = 0, per_cu = 0;
        if (hipGetDevice(&dev) != hipSuccess || hipDeviceGetAttribute(&cus, hipDeviceAttributeMultiprocessorCount, dev) != hipSuccess) { grid = -1; return; }
        if (hipFuncSetAttribute((const void*)hybrid_fwd, hipFuncAttributeMaxDynamicSharedMemorySize, LDS_BYTES) != hipSuccess) { fprintf(stderr, "kernel_launch: hipFuncSetAttribute failed\n"); grid = -1; return; }
        if (hipOccupancyMaxActiveBlocksPerMultiprocessor(&per_cu, (const void*)hybrid_fwd, NTHREADS, LDS_BYTES) != hipSuccess || per_cu < 1) { fprintf(stderr, "kernel_launch: occupancy query says %d blocks per CU\n", per_cu); (void)hipGetLastError(); grid = -1; return; }
        grid = cus;
    }
    if (grid < 0) return;
    if (hipMemsetAsync((char*)d_ws + WS_CTL, 0, CTL_ZERO_BYTES, stream) != hipSuccess) { fprintf(stderr, "kernel_launch: memset failed\n"); return; }
    Args a{};
    for (int i = 0; i < 14; ++i) a.in[i] = (const float*)d_in[i];
    a.out = (float*)d_out; a.ws = (unsigned char*)d_ws;
#if MK_PER_PHASE
    for (int p = 0; p < N_PHASES; ++p) { a.ph_lo = p; a.ph_hi = p + 1; hipLaunchKernelGGL(hybrid_fwd, dim3(grid), dim3(NTHREADS), LDS_BYTES, stream, a); }
#else
    a.ph_lo = 0; a.ph_hi = N_PHASES;
    void* kargs[] = {&a};
    hipError_t e = hipLaunchCooperativeKernel((const void*)hybrid_fwd, dim3(grid), dim3(NTHREADS), kargs, LDS_BYTES, stream);
    if (e != hipSuccess) fprintf(stderr, "kernel_launch: cooperative launch failed: %s (grid %d)\n", hipGetErrorString(e), grid);
#endif
}
```

```cpp
#include <hip/hip_runtime.h>
#include <cstdio>
#include <cstdint>
namespace pg8 {
#define PG8_LAS __attribute__((address_space(3)))
typedef unsigned short bf16_t;
typedef short bf16x8 __attribute__((ext_vector_type(8)));
typedef float f32x4 __attribute__((ext_vector_type(4)));
typedef unsigned u32x4 __attribute__((ext_vector_type(4)));
constexpr int BM = 256, BK = 64, HALF = 128, HTB = HALF * BK * 2  , STAGE_BYTES = 8 * HTB, NXCD = 8, WGM = 8;

__host__ __device__ __forceinline__ int lds_byte(int r, int c) { const int st = (r >> 4) * 2 + (c >> 5), rr = r & 15, cc = c & 31, ob = rr * 64 + cc * 2; return st * 1024 + (ob ^ (((ob >> 9) & 1) << 5)); }
__host__ __device__ __forceinline__ void stage_rc(int b, int& R, int& C) { const int st = b / 1024, sb = b % 1024, swz = sb ^ (((sb >> 9) & 1) << 5); R = (st >> 1) * 16 + swz / 64; C = (st & 1) * 32 + (swz % 64) / 2; }
__host__ __device__ __forceinline__ int perm32(int rho) { const int n = rho >> 4, i = rho & 15; return 8 * (i >> 2) + 4 * n + (i & 3); }


struct Unit { int pm, pn, sel; };
struct Gemm { const bf16_t* A0; const bf16_t* A1; const bf16_t* B0; const bf16_t* B1; int K; size_t a_tstep; };

struct StaticOrder {
    int nM, nN, nwg, G, c;
    __host__ __device__ void init(int nM_, int nN_, int G_, int c_) { nM = nM_; nN = nN_; nwg = nM * nN; G = G_; c = c_; }
    __host__ __device__ bool next(int i, Unit& u) const {
        const long L = (long)i * G + c; if (L >= nwg) return false;
        int wgid = (int)L; { const int q = nwg / NXCD, r = nwg % NXCD, xcd = wgid % NXCD, off = wgid / NXCD; wgid = (xcd < r ? xcd * (q + 1) : r * (q + 1) + (xcd - r) * q) + off; }
        const int nig = WGM * nN, gid = wgid / nig, fm = gid * WGM, gsz = (nM - fm) < WGM ? (nM - fm) : WGM;
        u.pm = fm + ((wgid % nig) % gsz); u.pn = (wgid % nig) / gsz; u.sel = 0; return true;
    }
    __device__ __forceinline__ void a_ready(const Unit&) const {}
    __device__ __forceinline__ void done(const Unit&) const {}
};
struct DualOrder {
    StaticOrder S;
    __host__ __device__ bool next(int i, Unit& u) const { const bool ok = S.next(i >> 1, u); u.sel = i & 1; return ok; }
    __device__ __forceinline__ void a_ready(const Unit&) const {}
    __device__ __forceinline__ void done(const Unit&) const {}
};

typedef __bf16 bf16x2_t_ __attribute__((ext_vector_type(2))); typedef float f32x2_t_ __attribute__((ext_vector_type(2)));
__device__ __forceinline__ unsigned cvt_pk_bf16(float lo, float hi) { const f32x2_t_ v = {lo, hi}; const bf16x2_t_ b = __builtin_convertvector(v, bf16x2_t_); return __builtin_bit_cast(unsigned, b); }
__device__ __forceinline__ float bf_lo(unsigned w) { return __uint_as_float(w << 16); }
__device__ __forceinline__ float bf_hi(unsigned w) { return __uint_as_float(w & 0xffff0000u); }
__device__ __forceinline__ float fast_sigmoid(float x) { return __builtin_amdgcn_rcpf(1.0f + __builtin_amdgcn_exp2f(-1.4426950408889634f * x)); }
__device__ __forceinline__ u32x4 pack8(const f32x4 a, const f32x4 b) { u32x4 w; w.x = cvt_pk_bf16(a[0], a[1]); w.y = cvt_pk_bf16(a[2], a[3]); w.z = cvt_pk_bf16(b[0], b[1]); w.w = cvt_pk_bf16(b[2], b[3]); return w; }

template <int CTRL> __device__ __forceinline__ float dpp_shr(float old, float v) { return __builtin_bit_cast(float, __builtin_amdgcn_update_dpp(__builtin_bit_cast(int, old), __builtin_bit_cast(int, v), CTRL, 0xf, 0xf, false)); }
template <int CTRL> __device__ __forceinline__ float dpp_ror(float v) { return __builtin_bit_cast(float, __builtin_amdgcn_update_dpp(0, __builtin_bit_cast(int, v), CTRL, 0xf, 0xf, true)); }
constexpr int MROWS = 16384, DMODEL = 1024, DFF_ = 2816;

struct Epi1 {
    static constexpr bool PERM = true, AFTER_DRAIN = false;
    static __device__ __forceinline__ bool keep_acc(const Unit&) { return false; }
    bf16_t *BG, *UU, *Q, *K, *VT, *SG; const float* rstdx; const float *q_norm, *k_norm; float* kbar; PG8_LAS float* xl;
    __device__ __forceinline__ void operator()(f32x4 (&acc)[2][2][4][2], const Unit& u, int wr, int wc, int fr, int fq) const {
        const int row0 = u.pm * BM + wr * 64 + fr, colw = wc * 32 + 8 * fq, pn = u.pn;
        if (pn >= 12 && pn < 20) {
            const bool isK = pn >= 16; const float* wn = isK ? k_norm : q_norm; const float gs = isK ? 1.0f : 0.12751743074602357f;
            bf16_t* dst = isK ? K : Q; const int cb = ((pn - 12) & 3) * 256;
#pragma unroll
            for (int ai = 0; ai < 2; ++ai)
#pragma unroll
                for (int m = 0; m < 4; ++m) { const int rl = ai * HALF + wr * 64 + m * 16 + fr; const float rs = rstdx[u.pm * BM + rl];
#pragma unroll
                    for (int bj = 0; bj < 2; ++bj) { const f32x4 a = acc[ai][bj][m][0] * rs, b = acc[ai][bj][m][1] * rs; acc[ai][bj][m][0] = a; acc[ai][bj][m][1] = b;
                        float ss = (a[0] * a[0] + a[1] * a[1]) + (a[2] * a[2] + a[3] * a[3]) + (b[0] * b[0] + b[1] * b[1]) + (b[2] * b[2] + b[3] * b[3]);
                        ss += __shfl_xor(ss, 16); ss += __shfl_xor(ss, 32);
                        if (fq == 0) xl[(rl * 2 + bj) * 4 + wc] = ss; } }
            asm volatile("s_waitcnt lgkmcnt(0)" ::: "memory"); __builtin_amdgcn_s_barrier(); asm volatile("" ::: "memory");
            const f32x4 g0 = *(const f32x4*)(wn + colw) * gs, g1 = *(const f32x4*)(wn + colw + 4) * gs;
#pragma unroll
            for (int ai = 0; ai < 2; ++ai)
#pragma unroll
                for (int m = 0; m < 4; ++m) { const int rl = ai * HALF + wr * 64 + m * 16 + fr; const int r = u.pm * BM + rl;
#pragma unroll
                    for (int bj = 0; bj < 2; ++bj) { const f32x4 p = *(const PG8_LAS f32x4*)(xl + (rl * 2 + bj) * 4);
                        const float rn = rsqrtf(((p[0] + p[1]) + (p[2] + p[3])) * (1.0f / 128.0f) + 1e-6f);
                        const f32x4 a = acc[ai][bj][m][0] * rn * g0, b = acc[ai][bj][m][1] * rn * g1; acc[ai][bj][m][0] = a; acc[ai][bj][m][1] = b;
                        *(u32x4*)(dst + (size_t)r * 1024 + cb + bj * 128 + colw) = pack8(a, b); } }
            if (isK) {
                f32x4 cs[2][2];
#pragma unroll
                for (int bj = 0; bj < 2; ++bj)
#pragma unroll
                    for (int n = 0; n < 2; ++n) { f32x4 t = acc[0][bj][0][n];
#pragma unroll
                        for (int ai = 0; ai < 2; ++ai)
#pragma unroll
                            for (int m = 0; m < 4; ++m) if (ai + m > 0) t += acc[ai][bj][m][n];
                        cs[bj][n] = t; }
#pragma unroll
                for (int bj = 0; bj < 2; ++bj)
#pragma unroll
                    for (int n = 0; n < 2; ++n)
#pragma unroll
                        for (int e = 0; e < 4; ++e) { float v = cs[bj][n][e]; v += __shfl_xor(v, 1); v += __shfl_xor(v, 2); v += __shfl_xor(v, 4); v += __shfl_xor(v, 8); cs[bj][n][e] = v; }
                if (fr == 0) {
#pragma unroll
                    for (int bj = 0; bj < 2; ++bj) { *(PG8_LAS f32x4*)(xl + 2048 + wr * 256 + bj * 128 + colw) = cs[bj][0]; *(PG8_LAS f32x4*)(xl + 2048 + wr * 256 + bj * 128 + colw + 4) = cs[bj][1]; } }
                asm volatile("s_waitcnt lgkmcnt(0)" ::: "memory"); __builtin_amdgcn_s_barrier(); asm volatile("" ::: "memory");
                int t = threadIdx.x; asm volatile("" : "+v"(t));
                if (t < 256) kbar[((size_t)((pn - 16) * 2 + (t >> 7)) * 64 + u.pm) * 128 + (t & 127)] = (xl[2048 + t] + xl[2048 + 256 + t]) * (1.0f / 256.0f);
            }
            return;
        }
        if (pn >= 20 && pn < 24) {
            int tidv = threadIdx.x; asm volatile("" : "+v"(tidv));
            PG8_LAS unsigned char* T = (PG8_LAS unsigned char*)xl + (tidv >> 6) * 2304;
            const int lane = tidv & 63;
            float rsv[2][4];
#pragma unroll
            for (int ai = 0; ai < 2; ++ai)
#pragma unroll
                for (int m = 0; m < 4; ++m) rsv[ai][m] = rstdx[u.pm * BM + ai * HALF + wr * 64 + m * 16 + fr];
#pragma unroll
            for (int ai = 0; ai < 2; ++ai)
#pragma unroll
                for (int mp = 0; mp < 2; ++mp)
#pragma unroll
                    for (int bj = 0; bj < 2; ++bj) {
#pragma unroll
                        for (int mm = 0; mm < 2; ++mm) { const int m = 2 * mp + mm; const float rs = rsv[ai][m];
                            const u32x4 w = pack8(acc[ai][bj][m][0] * rs, acc[ai][bj][m][1] * rs); const unsigned ww[4] = {w.x, w.y, w.z, w.w};
                            PG8_LAS unsigned char* tp = T + (8 * fq) * 72 + (16 * mm + fr) * 2;
#pragma unroll
                            for (int e = 0; e < 8; ++e) *(PG8_LAS unsigned short*)(tp + e * 72) = (unsigned short)((e & 1) ? (ww[e >> 1] >> 16) : (ww[e >> 1] & 0xffffu)); }
                        asm volatile("s_waitcnt lgkmcnt(0)" ::: "memory");
#pragma unroll
                        for (int rr = 0; rr < 2; ++rr) { const int q = lane + 64 * rr, d = q >> 2, tc = q & 3;
                            const unsigned long long x0 = *(const PG8_LAS unsigned long long*)(T + d * 72 + tc * 16), x1 = *(const PG8_LAS unsigned long long*)(T + d * 72 + tc * 16 + 8);
                            u32x4 o; o.x = (unsigned)x0; o.y = (unsigned)(x0 >> 32); o.z = (unsigned)x1; o.w = (unsigned)(x1 >> 32);
                            *(u32x4*)(VT + ((size_t)(((pn - 20) * 2 + bj) * 128 + 32 * wc + d)) * MROWS + u.pm * BM + ai * HALF + wr * 64 + 32 * mp + tc * 8) = o; }
                        asm volatile("s_waitcnt lgkmcnt(0)" ::: "memory");
                    }
            return;
        }
        float rsg[2][4];
#pragma unroll
        for (int ai = 0; ai < 2; ++ai)
#pragma unroll
            for (int m = 0; m < 4; ++m) rsg[ai][m] = rstdx[row0 + ai * HALF + m * 16];
#pragma unroll
        for (int ai = 0; ai < 2; ++ai)
#pragma unroll
            for (int m = 0; m < 4; ++m) {
                const int r = row0 + ai * HALF + m * 16; const float rs = rsg[ai][m];
                f32x4 v[2][2];
#pragma unroll
                for (int bj = 0; bj < 2; ++bj)
#pragma unroll
                    for (int n = 0; n < 2; ++n) v[bj][n] = acc[ai][bj][m][n] * rs;
                if (pn < 4) {
#pragma unroll
                    for (int bj = 0; bj < 2; ++bj) *(u32x4*)(BG + (size_t)r * 1024 + pn * 256 + bj * 128 + colw) = pack8(v[bj][0], v[bj][1]);
                } else if (pn < 12) {
                    *(u32x4*)(UU + (size_t)r * 1024 + (pn - 4) * 128 + colw) = pack8(v[0][0] * v[1][0], v[0][1] * v[1][1]);
                } else {
                    f32x4 ra, rb, sa, sb;
#pragma unroll
                    for (int e = 0; e < 4; ++e) { const float ea0 = __builtin_amdgcn_exp2f(-1.4426950408889634f * v[0][0][e]), ea1 = __builtin_amdgcn_exp2f(-1.4426950408889634f * v[0][1][e]);
                        const float eb0 = __builtin_amdgcn_exp2f(-1.4426950408889634f * v[1][0][e]), eb1 = __builtin_amdgcn_exp2f(-1.4426950408889634f * v[1][1][e]);
                        ra[e] = (1.0f + eb0) * __builtin_amdgcn_rcpf(1.0f + ea0); rb[e] = (1.0f + eb1) * __builtin_amdgcn_rcpf(1.0f + ea1);
                        sa[e] = __builtin_amdgcn_rcpf(1.0f + eb0); sb[e] = __builtin_amdgcn_rcpf(1.0f + eb1); }
                    *(u32x4*)(SG + (size_t)r * 2048 + (pn - 24) * 128 + colw) = pack8(ra, rb);
                    *(u32x4*)(SG + (size_t)r * 2048 + 1024 + (pn - 24) * 128 + colw) = pack8(sa, sb);
                }
            }
    }
};
struct Epi4 {
    static constexpr bool PERM = true, AFTER_DRAIN = false;
    bf16_t* MG; const bf16_t* SG;
    static __device__ __forceinline__ bool keep_acc(const Unit& u) { return u.sel == 0; }
    __device__ __forceinline__ void operator()(f32x4 (&acc)[2][2][4][2], const Unit& u, int wr, int wc, int fr, int fq) const {
        const int row0 = u.pm * BM + wr * 64 + fr, col0 = u.pn * BM + wc * 32 + 8 * fq;
#pragma unroll
        for (int ai = 0; ai < 2; ++ai) {
            u32x4 g[4][2];
#pragma unroll
            for (int m = 0; m < 4; ++m)
#pragma unroll
                for (int bj = 0; bj < 2; ++bj) g[m][bj] = *(const u32x4*)(SG + (size_t)(row0 + ai * HALF + m * 16) * 2048 + u.sel * 1024 + col0 + bj * HALF);
#pragma unroll
            for (int m = 0; m < 4; ++m) { const int r = row0 + ai * HALF + m * 16;
#pragma unroll
                for (int bj = 0; bj < 2; ++bj) { const int c = col0 + bj * HALF; const u32x4 gg = g[m][bj];
                    f32x4 a = acc[ai][bj][m][0], b = acc[ai][bj][m][1];
                    a[0] *= bf_lo(gg.x); a[1] *= bf_hi(gg.x); a[2] *= bf_lo(gg.y); a[3] *= bf_hi(gg.y); b[0] *= bf_lo(gg.z); b[1] *= bf_hi(gg.z); b[2] *= bf_lo(gg.w); b[3] *= bf_hi(gg.w);
                    if (u.sel) *(u32x4*)(MG + (size_t)r * 1024 + c) = pack8(a, b);
                    else { acc[ai][bj][m][0] = a; acc[ai][bj][m][1] = b; } } }
        }
    }
};
struct Epi5 {
    static constexpr bool PERM = true, AFTER_DRAIN = false;
    static __device__ __forceinline__ bool keep_acc(const Unit&) { return false; }
    const float* X; float* OUT; bf16_t* HB; float* rowss;
    __device__ __forceinline__ void operator()(f32x4 (&acc)[2][2][4][2], const Unit& u, int wr, int wc, int fr, int fq) const {
        const int row0 = u.pm * BM + wr * 64 + fr, col0 = u.pn * BM + wc * 32 + 8 * fq;
#pragma unroll
        for (int ai = 0; ai < 2; ++ai) {
            f32x4 xv[4][2][2];
#pragma unroll
            for (int m = 0; m < 4; ++m)
#pragma unroll
                for (int bj = 0; bj < 2; ++bj) { const size_t o = (size_t)(row0 + ai * HALF + m * 16) * 1024 + col0 + bj * HALF; xv[m][bj][0] = *(const f32x4*)(X + o); xv[m][bj][1] = *(const f32x4*)(X + o + 4); }
#pragma unroll
            for (int m = 0; m < 4; ++m) { const int r = row0 + ai * HALF + m * 16; float ss = 0.f;
#pragma unroll
                for (int bj = 0; bj < 2; ++bj) { const size_t o = (size_t)r * 1024 + col0 + bj * HALF;
                    const f32x4 a = acc[ai][bj][m][0] + xv[m][bj][0], b = acc[ai][bj][m][1] + xv[m][bj][1];
                    *(u32x4*)(HB + o) = pack8(a, b);
                    ss += (a[0] * a[0] + a[1] * a[1]) + (a[2] * a[2] + a[3] * a[3]) + (b[0] * b[0] + b[1] * b[1]) + (b[2] * b[2] + b[3] * b[3]); }
                ss += __shfl_xor(ss, 16); ss += __shfl_xor(ss, 32);
                if (fq == 0) atomicAdd(rowss + r, ss); }
        }
    }
};
struct Epi6 {
    static constexpr bool PERM = true, AFTER_DRAIN = false;
    static __device__ __forceinline__ bool keep_acc(const Unit&) { return false; }
    bf16_t* ACT; const float* rowss; const float* cw; const float* cb; PG8_LAS float* halo;
    __device__ __forceinline__ void operator()(f32x4 (&acc)[2][2][4][2], const Unit& u, int wr, int wc, int fr, int fq) const {
        const int r0 = u.pm * 254 - 2, colw = wc * 32 + 8 * fq;
#pragma unroll
        for (int ai = 0; ai < 2; ++ai)
#pragma unroll
            for (int m = 0; m < 4; ++m) { int gr = r0 + ai * HALF + wr * 64 + m * 16 + fr; gr = gr < 0 ? 0 : (gr > MROWS - 1 ? MROWS - 1 : gr);
                const float rs = rsqrtf(rowss[gr] * (1.0f / 1024.0f) + 1e-6f);
#pragma unroll
                for (int bj = 0; bj < 2; ++bj)
#pragma unroll
                    for (int n = 0; n < 2; ++n) acc[ai][bj][m][n] *= rs; }
        if (fr >= 14) {
#pragma unroll
            for (int ai = 0; ai < 2; ++ai)
#pragma unroll
                for (int bj = 0; bj < 2; ++bj)
#pragma unroll
                    for (int n = 0; n < 2; ++n) *(PG8_LAS f32x4*)(halo + (((2 * ai + wr) * 2 + (fr - 14)) * 256 + bj * 128 + colw + 4 * n)) = acc[ai][bj][3][n];
        }
        f32x4 wn0, wn1, wn2, wnb;
        { const int col = u.pn * 128 + colw; wn0 = *(const f32x4*)(cw + col); wn1 = *(const f32x4*)(cw + 2 * DFF_ + col); wn2 = *(const f32x4*)(cw + 4 * DFF_ + col); wnb = *(const f32x4*)(cb + col); }
        asm volatile("s_waitcnt lgkmcnt(0)" ::: "memory"); __builtin_amdgcn_s_barrier(); asm volatile("" ::: "memory");
#pragma unroll
        for (int bj = 0; bj < 2; ++bj)
#pragma unroll
            for (int n = 0; n < 2; ++n) {
                const f32x4 w0 = wn0, w1 = wn1, w2 = wn2, bb = wnb;
                if (bj * 2 + n < 3) { const int k2 = bj * 2 + n + 1, col = (k2 >> 1) * DFF_ + u.pn * 128 + colw + 4 * (k2 & 1);
                    wn0 = *(const f32x4*)(cw + col); wn1 = *(const f32x4*)(cw + 2 * DFF_ + col); wn2 = *(const f32x4*)(cw + 4 * DFF_ + col); wnb = *(const f32x4*)(cb + col); }
#pragma unroll
                for (int ai = 0; ai < 2; ++ai) {
                    const int s = 2 * ai + wr;
                    const int sm = s > 0 ? s - 1 : 0; const float hz = s > 0 ? 1.0f : 0.0f;
                    const f32x4 h2 = *(const PG8_LAS f32x4*)(halo + ((sm * 2 + 0) * 256 + bj * 128 + colw + 4 * n)) * hz, h1 = *(const PG8_LAS f32x4*)(halo + ((sm * 2 + 1) * 256 + bj * 128 + colw + 4 * n)) * hz;
#pragma unroll
                    for (int mm = 0; mm < 4; ++mm) { const int m = 3 - mm;
                        f32x4 cur = acc[ai][bj][m][n]; asm volatile("" : "+v"(cur)); f32x4 p1, p2;
                        if (m > 0) { f32x4 lo = acc[ai][bj][m > 0 ? m - 1 : 0][n]; asm volatile("" : "+v"(lo));
#pragma unroll
                            for (int e = 0; e < 4; ++e) { p1[e] = dpp_shr<0x111>(dpp_ror<0x121>(lo[e]), cur[e]); p2[e] = dpp_shr<0x112>(dpp_ror<0x122>(lo[e]), cur[e]); } }
                        else {
#pragma unroll
                            for (int e = 0; e < 4; ++e) { p1[e] = dpp_shr<0x111>(h1[e], cur[e]); p2[e] = dpp_shr<0x112>(fr == 0 ? h2[e] : h1[e], cur[e]); } }
                        { f32x4 r_ = w0 * p2 + w1 * p1 + w2 * cur + bb; asm volatile("" : "+v"(r_)); acc[ai][bj][m][n] = r_; } }
                }
            }
#pragma unroll
        for (int ai = 0; ai < 2; ++ai)
#pragma unroll
            for (int m = 0; m < 4; ++m) { const int i = ai * HALF + wr * 64 + m * 16 + fr, gr = r0 + i;
                f32x4 a, b;
#pragma unroll
                for (int e = 0; e < 4; ++e) { const float g0 = acc[ai][0][m][0][e], g1 = acc[ai][0][m][1][e];
                    a[e] = g0 * fast_sigmoid(g0) * acc[ai][1][m][0][e]; b[e] = g1 * fast_sigmoid(g1) * acc[ai][1][m][1][e]; }
                if (i >= 2 && gr < MROWS) *(u32x4*)(ACT + (size_t)gr * DFF_ + u.pn * 128 + colw) = pack8(a, b); }
    }
};
struct Epi7 {
    static constexpr bool PERM = true, AFTER_DRAIN = false;
    static __device__ __forceinline__ bool keep_acc(const Unit&) { return false; }
    float* OUT; const bf16_t* HB;
    __device__ __forceinline__ void operator()(f32x4 (&acc)[2][2][4][2], const Unit& u, int wr, int wc, int fr, int fq) const {
        const int row0 = u.pm * BM + wr * 64 + fr, col0 = u.pn * BM + wc * 32 + 8 * fq;
#pragma unroll
        for (int ai = 0; ai < 2; ++ai) {
            u32x4 hv[4][2];
#pragma unroll
            for (int m = 0; m < 4; ++m)
#pragma unroll
                for (int bj = 0; bj < 2; ++bj) hv[m][bj] = *(const u32x4*)(HB + (size_t)(row0 + ai * HALF + m * 16) * 1024 + col0 + bj * HALF);
#pragma unroll
            for (int m = 0; m < 4; ++m) { const int r = row0 + ai * HALF + m * 16;
#pragma unroll
                for (int bj = 0; bj < 2; ++bj) { const size_t o = (size_t)r * 1024 + col0 + bj * HALF; float* p = OUT + o; const u32x4 hw = hv[m][bj];
                    f32x4 a = acc[ai][bj][m][0], b = acc[ai][bj][m][1];
                    a[0] += bf_lo(hw.x); a[1] += bf_hi(hw.x); a[2] += bf_lo(hw.y); a[3] += bf_hi(hw.y); b[0] += bf_lo(hw.z); b[1] += bf_hi(hw.z); b[2] += bf_lo(hw.w); b[3] += bf_hi(hw.w);
                    *(f32x4*)p = a; *(f32x4*)(p + 4) = b; } }
        }
    }
};
template <class Epi, class Sched, bool ALIGN_EPI = false, bool SP2 = false>
__device__ __forceinline__ void gemm_phase(PG8_LAS unsigned char* lds, const Gemm g, const Sched& S, const Epi& E) {
    const int tid = threadIdx.x, wid = __builtin_amdgcn_readfirstlane(tid >> 6), lane = tid & 63, wr = wid >> 2, wc = wid & 3, fr = lane & 15, fq = lane >> 4;
    const int K = g.K, nt = K / BK;
    unsigned voffA[2], voffB[2];
#pragma unroll
    for (int i = 0; i < 2; ++i) { int R, C; stage_rc(tid * 16 + i * 8192, R, C); const int Rb = Epi::PERM ? ((R & ~31) + perm32(R & 31)) : R;
        voffA[i] = (unsigned)(R * K + C) * 2u; voffB[i] = (unsigned)(Rb * K + C) * 2u; }
    const size_t kstep = (size_t)(BK * 2);
    const size_t hstep = (size_t)HALF * K * 2;
    const size_t tstep = 2 * hstep;
    const unsigned ldsw = (unsigned)wid * 1024u;
    const int aoff = lds_byte(wr * 64 + fr, fq * 8), boff = lds_byte(wc * 32 + fr, fq * 8);
#define PG8_SA(b, h) (((b) * 2 + (h)) * HTB)
#define PG8_SB(b, h) ((4 + (b) * 2 + (h)) * HTB)
#define PG8_STAGE(bufoff, gbase, voff) do { _Pragma("unroll") for (int _i = 0; _i < 2; ++_i) \
        __builtin_amdgcn_global_load_lds((const unsigned*)((const char*)(gbase) + (voff)[_i]), (PG8_LAS unsigned*)(lds + (bufoff) + ldsw + _i * 8192), 16, 0, 0); } while (0)
#define PG8_LDA(dst, b, h) do { _Pragma("unroll") for (int m = 0; m < 4; ++m) _Pragma("unroll") for (int k = 0; k < 2; ++k) dst[m][k] = *(const PG8_LAS bf16x8*)(lds + PG8_SA(b, h) + aoff + m * 2048 + k * 1024); } while (0)
#define PG8_LDB(dst, b, h) do { _Pragma("unroll") for (int n = 0; n < 2; ++n) _Pragma("unroll") for (int k = 0; k < 2; ++k) dst[n][k] = *(const PG8_LAS bf16x8*)(lds + PG8_SB(b, h) + boff + n * 2048 + k * 1024); } while (0)
#define PG8_MMA(ai, bj, At, Bt) do { __builtin_amdgcn_s_setprio(1); _Pragma("unroll") for (int m = 0; m < 4; ++m) _Pragma("unroll") for (int n = 0; n < 2; ++n) _Pragma("unroll") for (int k = 0; k < 2; ++k) \
        acc[ai][bj][m][n] = __builtin_amdgcn_mfma_f32_16x16x32_bf16(Bt[n][k], At[m][k], acc[ai][bj][m][n], 0, 0, 0); __builtin_amdgcn_s_setprio(0); } while (0)
#define PG8_WAIT_V(n) asm volatile("s_waitcnt vmcnt(" #n ")" ::: "memory")
#define PG8_WAIT_L(n) asm volatile("s_waitcnt lgkmcnt(" #n ")" ::: "memory")
#define PG8_BAR __builtin_amdgcn_s_barrier()
#define PG8_SCHED __builtin_amdgcn_sched_barrier(0)
    Unit cur, nxt; int ui = 0;
    if (!S.next(0, cur)) return;
    f32x4 acc[2][2][4][2];
#pragma unroll
    for (int a = 0; a < 2; ++a)
#pragma unroll
        for (int b = 0; b < 2; ++b)
#pragma unroll
            for (int m = 0; m < 4; ++m)
#pragma unroll
                for (int n = 0; n < 2; ++n) acc[a][b][m][n] = (f32x4){0.f, 0.f, 0.f, 0.f};
    bf16x8 At[4][2], B0[2][2], B1[2][2];
    const char* cA = (const char*)(cur.sel ? g.A1 : g.A0) + (size_t)cur.pm * g.a_tstep; const char* cB = (const char*)(cur.sel ? g.B1 : g.B0) + (size_t)cur.pn * tstep;
    S.a_ready(cur);
    if constexpr (SP2) {
        PG8_STAGE(PG8_SB(0, 0), cB, voffB); PG8_STAGE(PG8_SB(0, 1), cB + hstep, voffB); PG8_STAGE(PG8_SA(0, 0), cA, voffA); PG8_STAGE(PG8_SA(0, 1), cA + hstep, voffA);
        if (wr == 1) PG8_BAR;
        PG8_WAIT_V(2); PG8_BAR;
        PG8_STAGE(PG8_SB(1, 0), cB + kstep, voffB); PG8_STAGE(PG8_SA(1, 0), cA + kstep, voffA); PG8_STAGE(PG8_SB(1, 1), cB + hstep + kstep, voffB);
        PG8_WAIT_V(6); PG8_BAR;
    } else {
        PG8_STAGE(PG8_SB(0, 0), cB, voffB); PG8_STAGE(PG8_SA(0, 0), cA, voffA); PG8_STAGE(PG8_SB(0, 1), cB + hstep, voffB); PG8_STAGE(PG8_SA(0, 1), cA + hstep, voffA);
        if (wr == 1) PG8_BAR;
        PG8_WAIT_V(4); PG8_BAR;
        PG8_STAGE(PG8_SB(1, 0), cB + kstep, voffB); PG8_STAGE(PG8_SA(1, 0), cA + kstep, voffA); PG8_STAGE(PG8_SB(1, 1), cB + hstep + kstep, voffB);
        PG8_WAIT_V(6); PG8_BAR;
    }
    for (;;) {
        const bool has_next = S.next(ui + 1, nxt);
        const char* nA = has_next ? (const char*)(nxt.sel ? g.A1 : g.A0) + (size_t)nxt.pm * g.a_tstep : cA; const char* nB = has_next ? (const char*)(nxt.sel ? g.B1 : g.B0) + (size_t)nxt.pn * tstep : cB;
        for (int t = 0; t < nt; t += 2) {
            const bool last = (t == nt - 2);
            const char* a1 = cA + (size_t)(t + 1) * kstep;
            const char* a2 = last ? nA : cA + (size_t)(t + 2) * kstep; const char* b2 = last ? nB : cB + (size_t)(t + 2) * kstep;
            const char* a3 = a2 + kstep; const char* b3 = b2 + kstep;
            if (last && has_next) S.a_ready(nxt);
            if constexpr (SP2) {
            PG8_LDB(B0, 0, 0); PG8_LDB(B1, 0, 1); PG8_SCHED; PG8_LDA(At, 0, 0); PG8_STAGE(PG8_SA(1, 1), a1 + hstep, voffA);
            PG8_WAIT_V(8); PG8_WAIT_L(0); PG8_BAR; PG8_MMA(0, 0, At, B0); PG8_MMA(0, 1, At, B1); PG8_BAR; PG8_SCHED;
            PG8_LDA(At, 0, 1); PG8_STAGE(PG8_SB(0, 0), b2, voffB); PG8_STAGE(PG8_SB(0, 1), b2 + hstep, voffB); PG8_STAGE(PG8_SA(0, 0), a2, voffA);
            PG8_WAIT_V(8); PG8_WAIT_L(0); PG8_BAR; PG8_MMA(1, 0, At, B0); PG8_MMA(1, 1, At, B1); PG8_BAR; PG8_SCHED;
            PG8_LDB(B0, 1, 0); PG8_LDB(B1, 1, 1); PG8_SCHED; PG8_LDA(At, 1, 0); PG8_STAGE(PG8_SA(0, 1), a2 + hstep, voffA);
            PG8_WAIT_V(8); PG8_WAIT_L(0); PG8_BAR; PG8_MMA(0, 0, At, B0); PG8_MMA(0, 1, At, B1); PG8_BAR; PG8_SCHED;
            PG8_LDA(At, 1, 1); PG8_STAGE(PG8_SB(1, 0), b3, voffB); PG8_STAGE(PG8_SB(1, 1), b3 + hstep, voffB); PG8_STAGE(PG8_SA(1, 0), a3, voffA);
            PG8_WAIT_V(8); PG8_WAIT_L(0); PG8_BAR; PG8_MMA(1, 0, At, B0); PG8_MMA(1, 1, At, B1); PG8_BAR; PG8_SCHED;
            } else {
            PG8_LDB(B0, 0, 0); PG8_SCHED; PG8_LDA(At, 0, 0); PG8_STAGE(PG8_SA(1, 1), a1 + hstep, voffA);
            PG8_WAIT_L(8); PG8_BAR; PG8_WAIT_L(0); PG8_MMA(0, 0, At, B0); PG8_BAR; PG8_SCHED;
            PG8_LDB(B1, 0, 1); PG8_STAGE(PG8_SB(0, 0), b2, voffB);
            PG8_BAR; PG8_WAIT_L(0); PG8_MMA(0, 1, At, B1); PG8_BAR;
            PG8_LDA(At, 0, 1); PG8_STAGE(PG8_SA(0, 0), a2, voffA);
            PG8_BAR; PG8_WAIT_L(0); PG8_MMA(1, 0, At, B0); PG8_BAR; PG8_SCHED;
            PG8_STAGE(PG8_SB(0, 1), b2 + hstep, voffB);
            PG8_WAIT_V(6); PG8_BAR; PG8_MMA(1, 1, At, B1); PG8_BAR;
            PG8_LDB(B0, 1, 0); PG8_SCHED; PG8_LDA(At, 1, 0); PG8_STAGE(PG8_SA(0, 1), a2 + hstep, voffA);
            PG8_WAIT_L(8); PG8_BAR; PG8_WAIT_L(0); PG8_MMA(0, 0, At, B0); PG8_BAR; PG8_SCHED;
            PG8_LDB(B1, 1, 1); PG8_STAGE(PG8_SB(1, 0), b3, voffB);
            PG8_BAR; PG8_WAIT_L(0); PG8_MMA(0, 1, At, B1); PG8_BAR;
            PG8_LDA(At, 1, 1); PG8_STAGE(PG8_SA(1, 0), a3, voffA);
            PG8_BAR; PG8_WAIT_L(0); PG8_MMA(1, 0, At, B0); PG8_BAR; PG8_SCHED;
            PG8_STAGE(PG8_SB(1, 1), b3 + hstep, voffB);
            PG8_WAIT_V(6); PG8_BAR; PG8_MMA(1, 1, At, B1); PG8_BAR;
            }
        }
        if constexpr (ALIGN_EPI) { if (wr == 0) PG8_BAR; }
        if constexpr (!Epi::AFTER_DRAIN) { E(acc, cur, wr, wc, fr, fq); S.done(cur); }
        if (!has_next) break;
        if (!Epi::keep_acc(cur)) {
#pragma unroll
        for (int a = 0; a < 2; ++a)
#pragma unroll
            for (int b = 0; b < 2; ++b)
#pragma unroll
                for (int m = 0; m < 4; ++m)
#pragma unroll
                    for (int n = 0; n < 2; ++n) acc[a][b][m][n] = (f32x4){0.f, 0.f, 0.f, 0.f}; }
        cur = nxt; cA = nA; cB = nB; ++ui;
        if constexpr (ALIGN_EPI) { if (wr == 1) PG8_BAR; }
    }
    PG8_WAIT_V(0);
    if constexpr (!ALIGN_EPI) { if (wr == 0) PG8_BAR; }
    PG8_BAR;
    if constexpr (Epi::AFTER_DRAIN) { E.fused(acc, cur, wr, wc, fr, fq, lds, wid, lane); S.done(cur); }
#undef PG8_SA
#undef PG8_SB
#undef PG8_STAGE
#undef PG8_LDA
#undef PG8_LDB
#undef PG8_MMA
#undef PG8_WAIT_V
#undef PG8_WAIT_L
#undef PG8_BAR
#undef PG8_SCHED
}
}
#define GAS __attribute__((address_space(1)))
#define LAS __attribute__((address_space(3)))
typedef unsigned short bf16;
typedef unsigned v4u __attribute__((ext_vector_type(4)));
typedef float f32x4 __attribute__((ext_vector_type(4)));
typedef short bf16x8 __attribute__((ext_vector_type(8)));
typedef GAS unsigned gu32;
typedef GAS unsigned long long gu64;
#define RLX_AGENT __ATOMIC_RELAXED, __HIP_MEMORY_SCOPE_AGENT
#define LDS_WAIT() asm volatile("s_waitcnt lgkmcnt(0)" ::: "memory")
#define VM_WAIT() asm volatile("s_waitcnt vmcnt(0)" ::: "memory")
__device__ __forceinline__ unsigned long long rt() { return __builtin_amdgcn_s_memrealtime(); }
__device__ __forceinline__ unsigned f2bf(float f) { unsigned u = __builtin_bit_cast(unsigned, f); return (u + 0x7fffu + ((u >> 16) & 1u)) >> 16; }
__device__ __forceinline__ unsigned pk2(float lo, float hi) { return f2bf(lo) | (f2bf(hi) << 16); }

#define XB_TMO      128
#define XB_XCNT(j)  (256  + 64 * (j))
#define XB_XSUB(j)  (1280 + 64 * (j))
#define XB_XGEN(j)  (2304 + 64 * (j))
#define XB_TOP      3328
#define XB_TOPGEN   3392
#define XCD_BAR_WORDS 3456
#define XB_SPIN_CAP (1u << 18)

__device__ __forceinline__ unsigned xb_ld(unsigned* p)              { return __hip_atomic_load(p, __ATOMIC_RELAXED, __HIP_MEMORY_SCOPE_AGENT); }
__device__ __forceinline__ unsigned xb_add(unsigned* p, unsigned v) { return __hip_atomic_fetch_add(p, v, __ATOMIC_RELAXED, __HIP_MEMORY_SCOPE_AGENT); }
__device__ __forceinline__ unsigned xb_xcc_id() { return (unsigned)__builtin_amdgcn_s_getreg((3 << 11) | 20) & 0xFu; }
#define XB_SPIN(cond, bar) do { unsigned _sp = 0; while (cond) { __builtin_amdgcn_s_sleep(1); \
    if ((++_sp & 255u) == 0u) { if (xb_ld(&(bar)[XB_TMO])) break; if (_sp > XB_SPIN_CAP) { atomicAdd(&(bar)[XB_TMO], 1u); break; } } } } while (0)

struct XcdBarrier {
    unsigned* bar; unsigned x;
    volatile LAS unsigned* st;
};

__device__ __forceinline__ XcdBarrier xcd_barrier_post(unsigned* bar, volatile LAS unsigned* st) {
    XcdBarrier b; b.bar = bar; b.x = xb_xcc_id(); b.st = st;
    if (threadIdx.x == 0) (void)xb_add(&bar[XB_XCNT(b.x)], 1u);
    return b;
}
__device__ __forceinline__ void xcd_barrier_complete(unsigned* bar, unsigned x, unsigned& nloc, unsigned& nx) {
    const unsigned G = gridDim.x * gridDim.y * gridDim.z;
    unsigned sum, cnt, mine, sp = 0u;
    for (;;) {
        sum = 0u; cnt = 0u; mine = 0u;
#pragma unroll
        for (unsigned j = 0; j < 16; ++j) { const unsigned c = xb_ld(&bar[XB_XCNT(j)]); sum += c; cnt += (c > 0u) ? 1u : 0u; mine = (j == x) ? c : mine; }
        if (sum == G) break;
        __builtin_amdgcn_s_sleep(1);
        if ((++sp & 255u) == 0u) { if (xb_ld(&bar[XB_TMO])) break; if (sp > XB_SPIN_CAP) { atomicAdd(&bar[XB_TMO], 1u); break; } }
    }
    nloc = mine > 0u ? mine : 1u; nx = cnt > 0u ? cnt : 1u;
}

__device__ __forceinline__ void xcd_barrier(const XcdBarrier& b) {
    asm volatile("s_waitcnt vmcnt(0)" ::: "memory");
    __syncthreads();
    if (threadIdx.x == 0) {
        unsigned* bar = b.bar;
        __builtin_amdgcn_s_waitcnt(0);
        unsigned nloc = b.st[0], nx = b.st[1];
        if (nloc == 0u) { xcd_barrier_complete(bar, b.x, nloc, nx); b.st[0] = nloc; b.st[1] = nx; }
        const unsigned old = xb_add(&bar[XB_XSUB(b.x)], 1u);
        const unsigned gen = old / nloc;
        if (old + 1u == (gen + 1u) * nloc) {
            __builtin_amdgcn_fence(__ATOMIC_RELEASE, "agent");
            asm volatile("s_waitcnt vmcnt(0)" ::: "memory");
            const unsigned og = xb_add(&bar[XB_TOP], 1u);
            const unsigned tg = og / nx;
            if (og + 1u == (tg + 1u) * nx) xb_add(&bar[XB_TOPGEN], 1u);
            else XB_SPIN(xb_ld(&bar[XB_TOPGEN]) == tg, bar);
            __builtin_amdgcn_fence(__ATOMIC_ACQUIRE, "agent");
            xb_add(&bar[XB_XGEN(b.x)], 1u);
            asm volatile("s_waitcnt vmcnt(0)" ::: "memory");
        } else {
            XB_SPIN(xb_ld(&bar[XB_XGEN(b.x)]) == gen, bar);
            __builtin_amdgcn_fence(__ATOMIC_ACQUIRE, "agent");
            asm volatile("s_waitcnt vmcnt(0)" ::: "memory");
        }
    }
    __syncthreads();
}


constexpr int NWAVES = 8, NTHREADS = 512;
constexpr int M = 16384, D = 1024, NIN = 8192, DFF = 2816, NH = 8, HD = 128, NBLK = 64, BLK = 256;
constexpr float EPS = 1e-6f;
constexpr float C2 = 0.08838834764831845f * 1.4426950408889634f;
constexpr size_t MiB = 1u << 20;
constexpr size_t WS_CTL = 0, CTL_ZERO_BYTES = 256 * 1024;
constexpr int CW_BAR = 4096, CW_GCNT = 8192, CW_ROWSS = 16384;
constexpr size_t WS_KBAR = 1 * MiB, WS_RSTDX = 1 * MiB + 512 * 1024, WS_LPART = 2 * MiB;
constexpr size_t WS_WOA = 4 * MiB, WS_WOB = 6 * MiB, WS_WO = 8 * MiB;
constexpr size_t WS_Q = 10 * MiB, WS_K = 42 * MiB, WS_VT = 74 * MiB, WS_CA = 106 * MiB, WS_LIST = 138 * MiB, WS_WIN = 147 * MiB, WS_XB = 163 * MiB, WS_UU = 195 * MiB;
constexpr size_t WS_OPART = 147 * MiB;
constexpr size_t WS_WUP = 243 * MiB, WS_WDN = 138 * MiB, WS_MG = 165 * MiB, WS_HB = 198 * MiB;
constexpr size_t WS_ACT = 10 * MiB;
constexpr size_t WS_END = 256 * MiB;
constexpr int LDS_BYTES = 163840, MISC_OFF = 131072 + 320, HALO_OFF = 131072 + 1024, SCAN_OFF = 131072 + 1024;
__device__ __forceinline__ int list_off(int n) { return 256 * (63 * n - (n * (n - 1)) / 2); }
constexpr int LIST_PER_HEAD = 256 * 2016;

__device__ __forceinline__ float wave_sum(float v) {
#pragma unroll
    for (int o = 1; o < 64; o <<= 1) v += __shfl_xor(v, o);
    return v;
}
__device__ __forceinline__ void transpose_item(const float* W, int N, bf16* WT, int K, int k0, int col0, int row0, const float* ks, LAS float* scr, int lane) {
    float wv[32];
#pragma unroll
    for (int i = 0; i < 32; ++i) wv[i] = W[(size_t)(k0 + 2 * i + (lane >> 5)) * N + col0 + (lane & 31)];
#pragma unroll
    for (int i = 0; i < 32; ++i) { const int kk = 2 * i + (lane >> 5); const float s = ks ? ks[k0 + kk] : 1.0f; scr[kk * 33 + (lane & 31)] = s * wv[i]; }
    LDS_WAIT(); asm volatile("" ::: "memory");
    const int c = lane & 7;
#pragma unroll
    for (int j = 0; j < 4; ++j) { const int n = (lane >> 3) + 8 * j; const LAS float* s = scr + (8 * c) * 33 + n;
        v4u o; o.x = pk2(s[0 * 33], s[1 * 33]); o.y = pk2(s[2 * 33], s[3 * 33]); o.z = pk2(s[4 * 33], s[5 * 33]); o.w = pk2(s[6 * 33], s[7 * 33]);
        *(GAS v4u*)(WT + (size_t)(row0 + n) * K + k0 + 8 * c) = o; }
    LDS_WAIT(); asm volatile("" ::: "memory");
}
__device__ __forceinline__ int map_col(int mode, int R) {
    if (mode == 1) { if (R >= 1024 && R < 3072) { const int q = R - 1024; return 1024 + ((q >> 7) & 1) * 1024 + (q >> 8) * 128 + (q & 127); }
                     if (R >= 6144) { const int q = R - 6144; return 6144 + ((q >> 7) & 1) * 1024 + (q >> 8) * 128 + (q & 127); } return R; }
    if (mode == 2) return ((R >> 7) & 1) * DFF + (R >> 8) * 128 + (R & 127);
    return R;
}
__device__ __forceinline__ void convert_weight(const float* W, int K, int N, bf16* WT, const float* ks, int mode, LAS float* scr, int gw, int NGW, int lane) {
    const int nblk = N / 32, nitems = (K / 64) * nblk;
    for (int it = gw; it < nitems; it += NGW) { const int kb = it / nblk, nb = it % nblk; transpose_item(W, N, WT, K, 64 * kb, map_col(mode, 32 * nb), 32 * nb, ks, scr, lane); }
}

__device__ __forceinline__ void phase0(const float* x, const float* norm_mix, const float* w_in, const float* w_oa, const float* w_ob, const float* w_o, const float* w_up, const float* norm_ffn, unsigned char* ws, LAS unsigned char* lds, int vcu, int G, int wave, int lane) {
    LAS float* scr = (LAS float*)(lds + wave * 16384);
    const int gw = vcu * NWAVES + wave, NGW = G * NWAVES;
    convert_weight(w_in, D, NIN, (bf16*)(ws + WS_WIN), norm_mix, 1, scr, gw, NGW, lane);
    convert_weight(w_oa, D, D, (bf16*)(ws + WS_WOA), nullptr, 0, scr, gw, NGW, lane);
    convert_weight(w_ob, D, D, (bf16*)(ws + WS_WOB), nullptr, 0, scr, gw, NGW, lane);
    convert_weight(w_o, D, D, (bf16*)(ws + WS_WO), nullptr, 0, scr, gw, NGW, lane);
    convert_weight(w_up, D, 2 * DFF, (bf16*)(ws + WS_WUP), norm_ffn, 2, scr, gw, NGW, lane);
    bf16* XB = (bf16*)(ws + WS_XB); float* rstdx = (float*)(ws + WS_RSTDX);
    for (int m = gw; m < M; m += NGW) {
        const GAS f32x4* xr = (const GAS f32x4*)(x + (size_t)m * D) + lane; f32x4 v[4]; float s = 0.f;
#pragma unroll
        for (int j = 0; j < 4; ++j) { v[j] = xr[64 * j]; s += (v[j].x * v[j].x + v[j].y * v[j].y) + (v[j].z * v[j].z + v[j].w * v[j].w); }
        s = wave_sum(s); if (lane == 0) rstdx[m] = rsqrtf(s * (1.f / D) + EPS);
        GAS unsigned long long* o8 = (GAS unsigned long long*)(XB + (size_t)m * D) + lane;
#pragma unroll
        for (int j = 0; j < 4; ++j) o8[64 * j] = (unsigned long long)pk2(v[j].x, v[j].y) | ((unsigned long long)pk2(v[j].z, v[j].w) << 32);
    }
}
__device__ __forceinline__ void phase2(const float* conv_a_w, unsigned char* ws, int G, int tid, bf16* __restrict__ CAout) {
    const bf16* __restrict__ BG = (const bf16*)(ws + WS_CA); const bf16* __restrict__ UU = (const bf16*)(ws + WS_UU);
    for (int item = blockIdx.x * NTHREADS + tid; item < 128 * (M / 16); item += G * NTHREADS) {
        const int cc = (item & 127) * 8, t0 = (item >> 7) * 16;
        float w0[8], w1[8], w2[8], um2[8], um1[8];
#pragma unroll
        for (int j = 0; j < 2; ++j) { const f32x4 a = *(const GAS f32x4*)(conv_a_w + cc + 4 * j), b = *(const GAS f32x4*)(conv_a_w + 1024 + cc + 4 * j), c = *(const GAS f32x4*)(conv_a_w + 2048 + cc + 4 * j);
#pragma unroll
            for (int e = 0; e < 4; ++e) { w0[4 * j + e] = a[e]; w1[4 * j + e] = b[e]; w2[4 * j + e] = c[e]; } }
        { v4u a = (v4u){0u, 0u, 0u, 0u}, b = a; if (t0 >= 2) { a = *(const GAS v4u*)(UU + (size_t)(t0 - 2) * 1024 + cc); b = *(const GAS v4u*)(UU + (size_t)(t0 - 1) * 1024 + cc); }
          const unsigned aw[4] = {a.x, a.y, a.z, a.w}, bw[4] = {b.x, b.y, b.z, b.w};
#pragma unroll
          for (int j = 0; j < 4; ++j) { um2[2 * j] = pg8::bf_lo(aw[j]); um2[2 * j + 1] = pg8::bf_hi(aw[j]); um1[2 * j] = pg8::bf_lo(bw[j]); um1[2 * j + 1] = pg8::bf_hi(bw[j]); } }
#pragma unroll 4
        for (int i = 0; i < 16; ++i) { const size_t o = (size_t)(t0 + i) * 1024 + cc;
            const v4u u = *(const GAS v4u*)(UU + o), b = *(const GAS v4u*)(BG + o); const unsigned uw[4] = {u.x, u.y, u.z, u.w}, bw[4] = {b.x, b.y, b.z, b.w};
            float r[8];
#pragma unroll
            for (int j = 0; j < 4; ++j) { const float u0 = pg8::bf_lo(uw[j]), u1 = pg8::bf_hi(uw[j]);
                r[2 * j] = pg8::bf_lo(bw[j]) * (w0[2 * j] * um2[2 * j] + w1[2 * j] * um1[2 * j] + w2[2 * j] * u0);
                r[2 * j + 1] = pg8::bf_hi(bw[j]) * (w0[2 * j + 1] * um2[2 * j + 1] + w1[2 * j + 1] * um1[2 * j + 1] + w2[2 * j + 1] * u1);
                um2[2 * j] = um1[2 * j]; um2[2 * j + 1] = um1[2 * j + 1]; um1[2 * j] = u0; um1[2 * j + 1] = u1; }
            v4u o4; o4.x = pk2(r[0], r[1]); o4.y = pk2(r[2], r[3]); o4.z = pk2(r[4], r[5]); o4.w = pk2(r[6], r[7]);
            *(GAS v4u*)(CAout + o) = o4; }
    }
}
__device__ __forceinline__ bool top_better(float v, int n, float cv, int cn) { return v > cv || (v == cv && n < cn); }
__device__ __forceinline__ void top3_insert(float v, int n, float (&tv)[3], int (&ti)[3]) {
    if (top_better(v, n, tv[0], ti[0])) { tv[2] = tv[1]; ti[2] = ti[1]; tv[1] = tv[0]; ti[1] = ti[0]; tv[0] = v; ti[0] = n; }
    else if (top_better(v, n, tv[1], ti[1])) { tv[2] = tv[1]; ti[2] = ti[1]; tv[1] = v; ti[1] = n; }
    else if (top_better(v, n, tv[2], ti[2])) { tv[2] = v; ti[2] = n; }
}
__device__ __forceinline__ void phase2d(unsigned char* ws, LAS unsigned char* lds, int G, int tid, int wave, int lane, unsigned* gcnt, unsigned short* glist) {
    LAS unsigned* lcnt = (LAS unsigned*)(lds + 32768); LAS unsigned* lbase = lcnt + 64; LAS unsigned short* llist = (LAS unsigned short*)lds;
    const bf16* Q = (const bf16*)(ws + WS_Q); const float* kbar = (const float*)(ws + WS_KBAR);
    const int fr = lane & 15, fq = lane >> 4;
    for (int unit = blockIdx.x; unit < NH * 63; unit += G) {
        const int h = unit / 63, c = 1 + unit % 63;
        if (tid < 64) lcnt[tid] = 0u;
        __syncthreads();
        bf16x8 qf[2][4];
#pragma unroll
        for (int g = 0; g < 2; ++g)
#pragma unroll
            for (int ks = 0; ks < 4; ++ks) qf[g][ks] = *(const GAS bf16x8*)(Q + (size_t)(c * BLK + wave * 32 + g * 16 + fr) * 1024 + h * HD + ks * 32 + fq * 8);
        float tv[2][3]; int ti[2][3];
#pragma unroll
        for (int g = 0; g < 2; ++g)
#pragma unroll
            for (int j = 0; j < 3; ++j) { tv[g][j] = -__builtin_inff(); ti[g][j] = 1 << 20; }
        const int ntile = (c + 15) >> 4;
        for (int tile = 0; tile < ntile; ++tile) {
            f32x4 s0 = (f32x4){0.f, 0.f, 0.f, 0.f}, s1 = s0;
#pragma unroll
            for (int ks = 0; ks < 4; ++ks) {
                const float* kp = kbar + ((size_t)(h * NBLK + tile * 16 + fr) * HD + ks * 32 + fq * 8);
                const f32x4 a = *(const GAS f32x4*)kp, b = *(const GAS f32x4*)(kp + 4);
                const v4u hw = pg8::pack8(a, b);
                f32x4 ra, rb; ra[0] = a[0] - pg8::bf_lo(hw.x); ra[1] = a[1] - pg8::bf_hi(hw.x); ra[2] = a[2] - pg8::bf_lo(hw.y); ra[3] = a[3] - pg8::bf_hi(hw.y);
                rb[0] = b[0] - pg8::bf_lo(hw.z); rb[1] = b[1] - pg8::bf_hi(hw.z); rb[2] = b[2] - pg8::bf_lo(hw.w); rb[3] = b[3] - pg8::bf_hi(hw.w);
                const v4u lw = pg8::pack8(ra, rb);
                const bf16x8 hi = __builtin_bit_cast(bf16x8, hw), lo = __builtin_bit_cast(bf16x8, lw);
                s0 = __builtin_amdgcn_mfma_f32_16x16x32_bf16(hi, qf[0][ks], s0, 0, 0, 0); s0 = __builtin_amdgcn_mfma_f32_16x16x32_bf16(lo, qf[0][ks], s0, 0, 0, 0);
                s1 = __builtin_amdgcn_mfma_f32_16x16x32_bf16(hi, qf[1][ks], s1, 0, 0, 0); s1 = __builtin_amdgcn_mfma_f32_16x16x32_bf16(lo, qf[1][ks], s1, 0, 0, 0);
            }
#pragma unroll
            for (int i = 0; i < 4; ++i) { const int n = tile * 16 + 4 * fq + i;
                top3_insert(n < c ? s0[i] : -__builtin_inff(), n, tv[0], ti[0]); top3_insert(n < c ? s1[i] : -__builtin_inff(), n, tv[1], ti[1]); }
        }
#pragma unroll
        for (int off = 16; off <= 32; off <<= 1)
#pragma unroll
            for (int g = 0; g < 2; ++g) { float pv[3]; int pi[3];
#pragma unroll
                for (int j = 0; j < 3; ++j) { pv[j] = __shfl_xor(tv[g][j], off); pi[j] = __shfl_xor(ti[g][j], off); }
#pragma unroll
                for (int j = 0; j < 3; ++j) top3_insert(pv[j], pi[j], tv[g], ti[g]); }
        const int nsel = c < 3 ? c : 3;
        if (fq == 0) {
#pragma unroll
            for (int g = 0; g < 2; ++g) { const int tl = wave * 32 + g * 16 + fr;
#pragma unroll
                for (int j = 0; j < 3; ++j) if (j < nsel) { const int n = ti[g][j]; const unsigned pp = __hip_atomic_fetch_add(&lcnt[n], 1u, __ATOMIC_RELAXED, __HIP_MEMORY_SCOPE_WORKGROUP); llist[n * 256 + pp] = (unsigned short)((tl << 2) | j); } }
        }
        __syncthreads();
        if (tid < c) { const unsigned k = lcnt[tid]; lbase[tid] = k ? atomicAdd(gcnt + h * NBLK + tid, k) : 0u; }
        __syncthreads();
        for (int n = wave; n < c; n += NWAVES) { const unsigned k = lcnt[n], base = lbase[n];
            unsigned short* dst = glist + (size_t)h * LIST_PER_HEAD + list_off(n) + base;
            for (unsigned i = lane; i < k; i += 64) { const unsigned e = llist[n * 256 + i]; dst[i] = (unsigned short)((((unsigned)c * BLK + (e >> 2)) << 2) | (e & 3u)); } }
        __syncthreads();
    }
}
__device__ __forceinline__ void stage_kv(const bf16* Kg, const bf16* Vt, int h, int n, LAS unsigned char* lds, int tid) {
    v4u kw[8], vw[8];
#pragma unroll
    for (int i = 0; i < 8; ++i) { const int row = (tid >> 4) + 32 * i, ch = tid & 15; kw[i] = *(const GAS v4u*)(Kg + (size_t)(n * BLK + row) * 1024 + h * HD + ch * 8); }
#pragma unroll
    for (int i = 0; i < 8; ++i) { const int row = (tid >> 5) + 16 * i, ch = tid & 31; vw[i] = *(const GAS v4u*)(Vt + (size_t)(h * HD + row) * M + n * BLK + ch * 8); }
#pragma unroll
    for (int i = 0; i < 8; ++i) { const int row = (tid >> 4) + 32 * i, ch = tid & 15; const int sw = (((row >> 3) & 3) << 2) | (row & 3);
        *(LAS v4u*)(lds + row * 256 + ((ch ^ sw) << 4)) = kw[i]; }
#pragma unroll
    for (int i = 0; i < 8; ++i) { const int row = (tid >> 5) + 16 * i, ch = tid & 31;
        *(LAS v4u*)(lds + 65536 + row * 512 + ((ch ^ ((((row >> 4) & 3) << 2) | (row & 3))) << 4)) = vw[i]; }
}
__device__ __forceinline__ void load_q(bf16x8 (&qf)[2][4], const bf16* Q, int h, const int (&tq)[2], int fq) {
#pragma unroll
    for (int g = 0; g < 2; ++g)
#pragma unroll
        for (int ks = 0; ks < 4; ++ks) qf[g][ks] = *(const GAS bf16x8*)(Q + (size_t)tq[g] * 1024 + h * HD + ks * 32 + fq * 8);
}
template <bool CAUSAL, int MODE = 0>
__device__ __forceinline__ void attn_core(const LAS unsigned char* lds, const bf16x8 (&qf)[2][4], int wave, int fr, int fq, float B2, f32x4 (&O)[8][2], float (&l)[2]) {
#pragma unroll
    for (int dt = 0; dt < 8; ++dt) { O[dt][0] = (f32x4){0.f, 0.f, 0.f, 0.f}; O[dt][1] = O[dt][0]; }
    l[0] = 0.f; l[1] = 0.f;
    const int nch = CAUSAL ? wave + 1 : 8;
    const int krow = (fr >> 2) * 8 + (fr & 3);
    bf16x8 kf[4][2];
#pragma unroll
    for (int ks = 0; ks < 4; ++ks)
#pragma unroll
        for (int t = 0; t < 2; ++t) kf[ks][t] = *(const LAS bf16x8*)(lds + (krow + t * 4) * 256 + (((ks * 4 + fq) ^ fr) << 4));
#pragma unroll 2
    for (int c = 0; c < nch; ++c) {
        f32x4 s[2][2];
#pragma unroll
        for (int t = 0; t < 2; ++t) { s[t][0] = (f32x4){-B2, -B2, -B2, -B2}; s[t][1] = s[t][0]; }
        bf16x8 vf[8];
#pragma unroll
        for (int dt = 0; dt < 8; ++dt) vf[dt] = *(const LAS bf16x8*)(lds + 65536 + ((dt >> 2) * 64 + (fr >> 2) * 16 + (dt & 3) * 4 + (fr & 3)) * 512 + (((c * 4 + fq) ^ fr) << 4));
#pragma unroll
        for (int ks = 0; ks < 4; ++ks)
#pragma unroll
            for (int t = 0; t < 2; ++t) {
                if (MODE != 2 || ks == 0) {
                s[t][0] = __builtin_amdgcn_mfma_f32_16x16x32_bf16(kf[ks][t], qf[0][ks], s[t][0], 0, 0, 0);
                s[t][1] = __builtin_amdgcn_mfma_f32_16x16x32_bf16(kf[ks][t], qf[1][ks], s[t][1], 0, 0, 0); }
            }
        __builtin_amdgcn_sched_barrier(0);
        { const int cn = (c + 1 < nch) ? c + 1 : c;
#pragma unroll
          for (int ks = 0; ks < 4; ++ks)
#pragma unroll
              for (int t = 0; t < 2; ++t) kf[ks][t] = *(const LAS bf16x8*)(lds + (cn * 32 + krow + t * 4) * 256 + (((ks * 4 + fq) ^ fr) << 4)); }
        bf16x8 pf[2];
#pragma unroll
        for (int g = 0; g < 2; ++g) {
            float p[8];
#pragma unroll
            for (int t = 0; t < 2; ++t)
#pragma unroll
                for (int i = 0; i < 4; ++i) { float e = MODE == 1 ? s[t][g][i] : __builtin_amdgcn_exp2f(s[t][g][i]);
                    if (CAUSAL && c == wave) { const int kl = c * 32 + fq * 8 + t * 4 + i, ql = wave * 32 + g * 16 + fr; if (kl > ql) e = 0.f; }
                    p[t * 4 + i] = e; }
            l[g] += ((p[0] + p[1]) + (p[2] + p[3])) + ((p[4] + p[5]) + (p[6] + p[7]));
            v4u w; w.x = pg8::cvt_pk_bf16(p[0], p[1]); w.y = pg8::cvt_pk_bf16(p[2], p[3]); w.z = pg8::cvt_pk_bf16(p[4], p[5]); w.w = pg8::cvt_pk_bf16(p[6], p[7]);
            pf[g] = __builtin_bit_cast(bf16x8, w);
        }
#pragma unroll
        for (int dt = 0; dt < 8; ++dt) {
            if (MODE != 3 || dt == 0) {
            O[dt][0] = __builtin_amdgcn_mfma_f32_16x16x32_bf16(vf[dt], pf[0], O[dt][0], 0, 0, 0);
            O[dt][1] = __builtin_amdgcn_mfma_f32_16x16x32_bf16(vf[dt], pf[1], O[dt][1], 0, 0, 0); }
        }
    }
    l[0] += __shfl_xor(l[0], 16); l[0] += __shfl_xor(l[0], 32); l[1] += __shfl_xor(l[1], 16); l[1] += __shfl_xor(l[1], 32);
}
__device__ __forceinline__ float score_bound(const float* q_norm, const float* k_norm, int lane) {
    float a = fmaxf(fabsf(q_norm[lane]), fabsf(q_norm[lane + 64])), b = fmaxf(fabsf(k_norm[lane]), fabsf(k_norm[lane + 64]));
#pragma unroll
    for (int o = 1; o < 64; o <<= 1) { a = fmaxf(a, __shfl_xor(a, o)); b = fmaxf(b, __shfl_xor(b, o)); }
    return 128.0f * a * b * C2 * 1.001f + 0.01f;
}
template <int MODE>
__device__ __forceinline__ void phase3a(const float* q_norm, const float* k_norm, unsigned char* ws, LAS unsigned char* lds, int G, int tid, int wave, int lane) {
    const int fr = lane & 15, fq = lane >> 4;
    LAS int* pre = (LAS int*)(lds + SCAN_OFF);
    LAS int* cntl = (LAS int*)(lds + SCAN_OFF + 2080);
    const unsigned* gcnt = (const unsigned*)(ws + WS_CTL) + CW_GCNT; const unsigned short* glist = (const unsigned short*)(ws + WS_LIST);
    const bf16* Q = (const bf16*)(ws + WS_Q); const bf16* Kg = (const bf16*)(ws + WS_K); const bf16* Vt = (const bf16*)(ws + WS_VT);
    unsigned char* OP = ws + WS_OPART; float* LP = (float*)(ws + WS_LPART);
    const float B2 = score_bound(q_norm, k_norm, lane);
    { const int cnt = (int)__hip_atomic_load(gcnt + tid, __ATOMIC_RELAXED, __HIP_MEMORY_SCOPE_AGENT); pre[tid + 1] = (cnt + 255) >> 8; cntl[tid] = cnt; if (tid == 0) pre[0] = 0; }
    __syncthreads();
    for (int o = 1; o < 512; o <<= 1) { const int v = pre[tid + 1] + ((tid + 1 - o) >= 1 ? pre[tid + 1 - o] : 0); __syncthreads(); pre[tid + 1] = v; __syncthreads(); }
    const int T = pre[512];
    const int i_lo = (int)(((long)blockIdx.x * T) / G), i_hi = (int)(((long)(blockIdx.x + 1) * T) / G);
    int staged = -1;
#define P3A_DECODE(IT, HN, TILE) do { int lo_ = 0, hi_ = 511; while (lo_ < hi_) { const int mid_ = (lo_ + hi_ + 1) >> 1; if (pre[mid_] <= (IT)) lo_ = mid_; else hi_ = mid_ - 1; } HN = lo_; TILE = (IT) - pre[lo_]; } while (0)
    unsigned en[2] = {0u, 0u}; bool okn[2] = {false, false};
    bf16x8 qf[2][4]; int hnn = 0;
    if (i_lo < i_hi) { int hn, tile; P3A_DECODE(i_lo, hn, tile); const int cnt = cntl[hn]; const unsigned short* lst = glist + (size_t)(hn >> 6) * LIST_PER_HEAD + list_off(hn & 63) + tile * 256;
#pragma unroll
        for (int g = 0; g < 2; ++g) { const int qi = wave * 32 + g * 16 + fr; okn[g] = tile * 256 + qi < cnt; en[g] = okn[g] ? lst[qi] : 0u; }
        { const int tq0[2] = {(int)(en[0] >> 2), (int)(en[1] >> 2)}; load_q(qf, Q, hn >> 6, tq0, fq); } }
    for (int it = i_lo; it < i_hi; ++it) {
        int hn, tile; P3A_DECODE(it, hn, tile); const int h = hn >> 6, n = hn & 63;
        int tq[2], sj[2]; bool ok[2];
#pragma unroll
        for (int g = 0; g < 2; ++g) { ok[g] = okn[g]; tq[g] = (int)(en[g] >> 2); sj[g] = (int)(en[g] & 3u); }
        if (it + 1 < i_hi) { int hn2, tile2; P3A_DECODE(it + 1, hn2, tile2); hnn = hn2; const int cnt2 = cntl[hn2]; const unsigned short* lst2 = glist + (size_t)(hn2 >> 6) * LIST_PER_HEAD + list_off(hn2 & 63) + tile2 * 256;
#pragma unroll
            for (int g = 0; g < 2; ++g) { const int qi = wave * 32 + g * 16 + fr; okn[g] = tile2 * 256 + qi < cnt2; en[g] = okn[g] ? lst2[qi] : 0u; } }
        if (hn != staged) { __syncthreads(); stage_kv(Kg, Vt, h, n, lds, tid); LDS_WAIT(); __syncthreads(); staged = hn; }
        f32x4 O[8][2]; float l[2];
        attn_core<false, MODE>(lds, qf, wave, fr, fq, B2, O, l);
        if (it + 1 < i_hi) { const int tqn[2] = {(int)(en[0] >> 2), (int)(en[1] >> 2)}; load_q(qf, Q, hnn >> 6, tqn, fq); }
#pragma unroll
        for (int g = 0; g < 2; ++g) if (ok[g]) {
            unsigned char* op = OP + ((size_t)sj[g] * M + tq[g]) * 1024 + h * HD + 16 * fq;
            const float sc = 16.0f / l[g];
#pragma unroll
            for (int j = 0; j < 2; ++j) { v4u w;
                { int t = 0; t = __builtin_amdgcn_cvt_pk_fp8_f32(O[4 * j][g][0] * sc, O[4 * j][g][1] * sc, t, false); t = __builtin_amdgcn_cvt_pk_fp8_f32(O[4 * j][g][2] * sc, O[4 * j][g][3] * sc, t, true); w.x = (unsigned)t; }
                { int t = 0; t = __builtin_amdgcn_cvt_pk_fp8_f32(O[4 * j + 1][g][0] * sc, O[4 * j + 1][g][1] * sc, t, false); t = __builtin_amdgcn_cvt_pk_fp8_f32(O[4 * j + 1][g][2] * sc, O[4 * j + 1][g][3] * sc, t, true); w.y = (unsigned)t; }
                { int t = 0; t = __builtin_amdgcn_cvt_pk_fp8_f32(O[4 * j + 2][g][0] * sc, O[4 * j + 2][g][1] * sc, t, false); t = __builtin_amdgcn_cvt_pk_fp8_f32(O[4 * j + 2][g][2] * sc, O[4 * j + 2][g][3] * sc, t, true); w.z = (unsigned)t; }
                { int t = 0; t = __builtin_amdgcn_cvt_pk_fp8_f32(O[4 * j + 3][g][0] * sc, O[4 * j + 3][g][1] * sc, t, false); t = __builtin_amdgcn_cvt_pk_fp8_f32(O[4 * j + 3][g][2] * sc, O[4 * j + 3][g][3] * sc, t, true); w.w = (unsigned)t; }
                *(GAS v4u*)(op + j * 64) = w; }
            if (fq == 0) LP[((size_t)sj[g] * M + tq[g]) * NH + h] = l[g];
        }
    }
#undef P3A_DECODE
    __syncthreads();
}
__device__ __forceinline__ void phase3b(const float* q_norm, const float* k_norm, unsigned char* ws, LAS unsigned char* lds, int G, int tid, int wave, int lane, bf16* Oout) {
    const int fr = lane & 15, fq = lane >> 4;
    bf16* Q = (bf16*)(ws + WS_Q); const bf16* Kg = (const bf16*)(ws + WS_K); const bf16* Vt = (const bf16*)(ws + WS_VT);
    const unsigned char* OP = ws + WS_OPART; const float* LP = (const float*)(ws + WS_LPART);
    const float B2 = score_bound(q_norm, k_norm, lane);
    bf16x8 qf[2][4];
    if ((int)blockIdx.x < NH * NBLK) { const int u0 = blockIdx.x; const int tq0[2] = {(u0 & 63) * BLK + wave * 32 + fr, (u0 & 63) * BLK + wave * 32 + 16 + fr}; load_q(qf, Q, u0 >> 6, tq0, fq); }
    for (int unit = blockIdx.x; unit < NH * NBLK; unit += G) {
        const int h = unit >> 6, c = unit & 63;
        __syncthreads(); stage_kv(Kg, Vt, h, c, lds, tid); LDS_WAIT(); __syncthreads();
        int tq[2];
#pragma unroll
        for (int g = 0; g < 2; ++g) tq[g] = c * BLK + wave * 32 + g * 16 + fr;
        f32x4 O[8][2]; float l[2];
        attn_core<true>(lds, qf, wave, fr, fq, B2, O, l);
        if (unit + G < NH * NBLK) { const int u1 = unit + G; const int tqn[2] = {(u1 & 63) * BLK + wave * 32 + fr, (u1 & 63) * BLK + wave * 32 + 16 + fr}; load_q(qf, Q, u1 >> 6, tqn, fq); }
        const int nsel = c < 3 ? c : 3;
#pragma unroll
        for (int g = 0; g < 2; ++g) {
            float lp[3];
#pragma unroll
            for (int j = 0; j < 3; ++j) lp[j] = LP[((size_t)j * M + tq[g]) * NH + h];
            v4u w[3][2];
#pragma unroll
            for (int j = 0; j < 3; ++j)
#pragma unroll
                for (int k = 0; k < 2; ++k) w[j][k] = *(const GAS v4u*)(OP + ((size_t)j * M + tq[g]) * 1024 + h * HD + k * 64 + 16 * fq);
            float lt = l[g]; float ls[3];
#pragma unroll
            for (int j = 0; j < 3; ++j) { ls[j] = j < nsel ? lp[j] * (1.0f / 16.0f) : 0.f; lt += j < nsel ? lp[j] : 0.f; }
            const float inv = 1.0f / lt;
#pragma unroll
            for (int k = 0; k < 2; ++k) {
                f32x4 o[4];
#pragma unroll
                for (int q = 0; q < 4; ++q) o[q] = O[4 * k + q][g];
#pragma unroll
                for (int j = 0; j < 3; ++j) if (j < nsel) { const unsigned xw[4] = {w[j][k].x, w[j][k].y, w[j][k].z, w[j][k].w};
#pragma unroll
                    for (int q = 0; q < 4; ++q) { const pg8::f32x2_t_ lo = __builtin_amdgcn_cvt_pk_f32_fp8((int)xw[q], false), hi = __builtin_amdgcn_cvt_pk_f32_fp8((int)xw[q], true);
                        o[q][0] += lo[0] * ls[j]; o[q][1] += lo[1] * ls[j]; o[q][2] += hi[0] * ls[j]; o[q][3] += hi[1] * ls[j]; } }
                bf16* dst = Oout + (size_t)tq[g] * 1024 + h * HD + k * 64 + 16 * fq;
                *(GAS v4u*)dst = pg8::pack8(o[0] * inv, o[1] * inv); *(GAS v4u*)(dst + 8) = pg8::pack8(o[2] * inv, o[3] * inv); }
        }
    }
    __syncthreads();
}

#ifndef MK_PER_PHASE
#define MK_PER_PHASE 0
#endif
#ifndef MK_DUP
#define MK_DUP -1
#endif
constexpr int N_PHASES = 9;
struct Args { const float* in[14]; float* out; unsigned char* ws; int ph_lo, ph_hi; };
__global__ void __launch_bounds__(NTHREADS, 2) hybrid_fwd(Args args) {
    extern __shared__ __attribute__((aligned(16))) unsigned char lds_raw[];
    LAS unsigned char* lds = (LAS unsigned char*)lds_raw;
    volatile LAS unsigned* MISC = (volatile LAS unsigned*)(lds + MISC_OFF);
    const int tid = threadIdx.x, lane = tid & 63, wave = __builtin_amdgcn_readfirstlane(tid >> 6);
    const int G = gridDim.x; const int vcu = (G % 8 == 0) ? ((int)blockIdx.x % 8) * (G / 8) + (int)blockIdx.x / 8 : (int)blockIdx.x;
    unsigned char* ws = args.ws;
    gu32* ctl = (gu32*)(ws + WS_CTL);
    if (tid < 32) MISC[tid] = 0u;
    __syncthreads();
    const int lo = args.ph_lo, hi = args.ph_hi;
    XcdBarrier bar; bar.bar = (unsigned*)ctl + CW_BAR; bar.x = 0; bar.st = nullptr;
    if (hi - lo > 1) bar = xcd_barrier_post((unsigned*)ctl + CW_BAR, MISC + 8);
#ifndef PHASE_MASK
#define PHASE_MASK 0x1ff
#endif
#define IN(k) (((PHASE_MASK >> (k)) & 1) && lo <= (k) && (k) < hi)
#define SEAM(k) do { if (IN(k) && IN((k) + 1)) xcd_barrier(bar); } while (0)
    const float* x = args.in[0]; const float* norm_mix = args.in[1]; const float* w_in = args.in[2]; const float* conv_a_w = args.in[3]; const float* q_norm = args.in[4]; const float* k_norm = args.in[5];
    const float* w_oa = args.in[6]; const float* w_ob = args.in[7]; const float* w_o = args.in[8]; const float* norm_ffn = args.in[9]; const float* w_up = args.in[10]; const float* ffn_conv_w = args.in[11];
    const float* ffn_conv_b = args.in[12]; const float* w_down = args.in[13];
    float* out = args.out;
    float* rowss = (float*)((unsigned*)ctl + CW_ROWSS);
    const size_t TSTEP = (size_t)256 * 1024 * 2;

    if (IN(0)) { phase0(x, norm_mix, w_in, w_oa, w_ob, w_o, w_up, norm_ffn, ws, lds, vcu, G, wave, lane); __syncthreads(); }
    SEAM(0);
    if (IN(1)) {
        pg8::Gemm g{(const bf16*)(ws + WS_XB), (const bf16*)(ws + WS_XB), (const bf16*)(ws + WS_WIN), (const bf16*)(ws + WS_WIN), D, TSTEP};
        pg8::StaticOrder S; S.init(M / 256, NIN / 256, G, (int)blockIdx.x);
        pg8::Epi1 E{(bf16*)(ws + WS_CA), (bf16*)(ws + WS_UU), (bf16*)(ws + WS_Q), (bf16*)(ws + WS_K), (bf16*)(ws + WS_VT), (bf16*)out, (const float*)(ws + WS_RSTDX), q_norm, k_norm, (float*)(ws + WS_KBAR), (PG8_LAS float*)(lds + HALO_OFF)};
        pg8::gemm_phase<pg8::Epi1, pg8::StaticOrder, true, true>(lds, g, S, E);
    }
    SEAM(1);
    if (IN(2)) { phase2d(ws, lds, G, tid, wave, lane, (unsigned*)(ws + WS_CTL) + CW_GCNT, (unsigned short*)(ws + WS_LIST));
        phase2(conv_a_w, ws, G, tid, (bf16*)(ws + WS_CA)); __syncthreads(); }
#if MK_DUP == 21
    if (IN(2)) { phase2d(ws, lds, G, tid, wave, lane, (unsigned*)(ws + WS_CTL) + CW_GCNT + 512, (unsigned short*)(ws + WS_WIN)); }
#endif
#if MK_DUP == 22
    if (IN(2)) { phase2(conv_a_w, ws, G, tid, (bf16*)(ws + WS_XB)); }
#endif
    SEAM(2);
#if MK_DUP >= 30 && MK_DUP <= 35
    if (IN(3)) phase3a<MK_DUP - 30>(q_norm, k_norm, ws, lds, G, tid, wave, lane);
#endif
    if (IN(3)) phase3a<0>(q_norm, k_norm, ws, lds, G, tid, wave, lane);
    SEAM(3);
    if (IN(4)) { phase3b(q_norm, k_norm, ws, lds, G, tid, wave, lane, (bf16*)(ws + WS_Q));
#if MK_DUP == 4
        phase3b(q_norm, k_norm, ws, lds, G, tid, wave, lane, (bf16*)(ws + WS_OPART));
#endif
        }
    SEAM(4);
    if (IN(5)) {
        { LAS float* scr = (LAS float*)(lds + wave * 16384); const int gw = vcu * NWAVES + wave, NGW = G * NWAVES;
          if (blockIdx.x == 0 && tid < 256) *(GAS v4u*)(ws + WS_HB - 4096 + tid * 16) = (v4u){0u, 0u, 0u, 0u};
          __syncthreads(); }
        pg8::Gemm g{(const bf16*)(ws + WS_CA), (const bf16*)(ws + WS_Q), (const bf16*)(ws + WS_WOA), (const bf16*)(ws + WS_WOB), D, TSTEP};
        pg8::DualOrder S; S.S.init(M / 256, D / 256, G, (int)blockIdx.x);
        pg8::Epi4 E{(bf16*)(ws + WS_MG), (const bf16*)out};
        pg8::gemm_phase<pg8::Epi4, pg8::DualOrder, true, true>(lds, g, S, E);
    }
    SEAM(5);
    if (IN(6)) {
        pg8::Gemm g{(const bf16*)(ws + WS_MG), (const bf16*)(ws + WS_MG), (const bf16*)(ws + WS_WO), (const bf16*)(ws + WS_WO), D, TSTEP};
        pg8::StaticOrder S; S.init(M / 256, D / 256, G, (int)blockIdx.x);
        pg8::Epi5 E{x, out, (bf16*)(ws + WS_HB), rowss};
        pg8::gemm_phase<pg8::Epi5, pg8::StaticOrder, true, true>(lds, g, S, E);
#if MK_DUP == 6
        { pg8::Epi5 E2{x, (float*)(ws + WS_Q), (bf16*)(ws + WS_VT), (float*)(ws + WS_CA)}; pg8::gemm_phase<pg8::Epi5, pg8::StaticOrder, true, true>(lds, g, S, E2); }
#endif
    }
    SEAM(6);
    if (IN(7)) {
        const bf16* hb2 = (const bf16*)(ws + WS_HB) - 2 * 1024;
        pg8::Gemm g{hb2, hb2, (const bf16*)(ws + WS_WUP), (const bf16*)(ws + WS_WUP), D, (size_t)254 * 1024 * 2};
        pg8::StaticOrder S; S.init(65, 22, G, (int)blockIdx.x);
        pg8::Epi6 E{(bf16*)(ws + WS_ACT), rowss, ffn_conv_w, ffn_conv_b, (PG8_LAS float*)(lds + HALO_OFF)};
        pg8::gemm_phase<pg8::Epi6, pg8::StaticOrder, true, true>(lds, g, S, E);
        { const int nwg = 65 * 22, full = nwg % G, nidle = full ? G - full : G, idx = full ? (int)blockIdx.x - full : (int)blockIdx.x;
          if (idx >= 0) convert_weight(w_down, DFF, D, (bf16*)(ws + WS_WDN), nullptr, 0, (LAS float*)(lds + wave * 16384), idx * NWAVES + wave, nidle * NWAVES, lane);
          __syncthreads(); }
    }
    SEAM(7);
    if (IN(8)) {
        pg8::Gemm g{(const bf16*)(ws + WS_ACT), (const bf16*)(ws + WS_ACT), (const bf16*)(ws + WS_WDN), (const bf16*)(ws + WS_WDN), DFF, (size_t)256 * DFF * 2};
        pg8::StaticOrder S; S.init(M / 256, D / 256, G, (int)blockIdx.x);
        pg8::Epi7 E{out, (const bf16*)(ws + WS_HB)};
        pg8::gemm_phase<pg8::Epi7, pg8::StaticOrder, true, true>(lds, g, S, E);
#if MK_DUP == 8
        { pg8::Epi7 E2{(float*)(ws + WS_MG), (const bf16*)(ws + WS_HB)}; pg8::gemm_phase<pg8::Epi7, pg8::StaticOrder, true, true>(lds, g, S, E2); }
#endif
    }
#undef IN
#undef SEAM
}

extern "C" void kernel_launch(void* const* d_in, const int* in_sizes, int n_in, void* d_out, int out_size, void* d_ws, size_t ws_size, hipStream_t stream) {
    static int grid = 0;
    if (grid == 0) {
        if (n_in != 14 || in_sizes[0] != M * D || out_size != M * D || ws_size < WS_END) { fprintf(stderr, "kernel_launch: unexpected shapes (n_in %d, in0 %d, out %d, ws %zu)\n", n_in, n_in > 0 ? in_sizes[0] : -1, out_size, ws_size); grid = -1; return; }
        int dev = 0, cus = 0, per_cu = 0;
        if (hipGetDevice(&dev) != hipSuccess || hipDeviceGetAttribute(&cus, hipDeviceAttributeMultiprocessorCount, dev) != hipSuccess) { grid = -1; return; }
        if (hipFuncSetAttribute((const void*)hybrid_fwd, hipFuncAttributeMaxDynamicSharedMemorySize, LDS_BYTES) != hipSuccess) { fprintf(stderr, "kernel_launch: hipFuncSetAttribute failed\n"); grid = -1; return; }
        if (hipOccupancyMaxActiveBlocksPerMultiprocessor(&per_cu, (const void*)hybrid_fwd, NTHREADS, LDS_BYTES) != hipSuccess || per_cu < 1) { fprintf(stderr, "kernel_launch: occupancy query says %d blocks per CU\n", per_cu); (void)hipGetLastError(); grid = -1; return; }
        grid = cus;
    }
    if (grid < 0) return;
    if (hipMemsetAsync((char*)d_ws + WS_CTL, 0, CTL_ZERO_BYTES, stream) != hipSuccess) { fprintf(stderr, "kernel_launch: memset failed\n"); return; }
    Args a{};
    for (int i = 0; i < 14; ++i) a.in[i] = (const float*)d_in[i];
    a.out = (float*)d_out; a.ws = (unsigned char*)d_ws;
#if MK_PER_PHASE
    for (int p = 0; p < N_PHASES; ++p) { a.ph_lo = p; a.ph_hi = p + 1; hipLaunchKernelGGL(hybrid_fwd, dim3(grid), dim3(NTHREADS), LDS_BYTES, stream, a); }
#else
    a.ph_lo = 0; a.ph_hi = N_PHASES;
    void* kargs[] = {&a};
    hipError_t e = hipLaunchCooperativeKernel((const void*)hybrid_fwd, dim3(grid), dim3(NTHREADS), kargs, LDS_BYTES, stream);
    if (e != hipSuccess) fprintf(stderr, "kernel_launch: cooperative launch failed: %s (grid %d)\n", hipGetErrorString(e), grid);
#endif
}
```

```cpp
#include <hip/hip_runtime.h>
#include <cstdio>
#include <cstdint>
namespace pg8 {
#define PG8_LAS __attribute__((address_space(3)))
typedef unsigned short bf16_t;
typedef short bf16x8 __attribute__((ext_vector_type(8)));
typedef float f32x4 __attribute__((ext_vector_type(4)));
typedef unsigned u32x4 __attribute__((ext_vector_type(4)));
constexpr int BM = 256, BK = 64, HALF = 128, HTB = HALF * BK * 2  , STAGE_BYTES = 8 * HTB, NXCD = 8, WGM = 8;

__host__ __device__ __forceinline__ int lds_byte(int r, int c) { const int st = (r >> 4) * 2 + (c >> 5), rr = r & 15, cc = c & 31, ob = rr * 64 + cc * 2; return st * 1024 + (ob ^ (((ob >> 9) & 1) << 5)); }
__host__ __device__ __forceinline__ void stage_rc(int b, int& R, int& C) { const int st = b / 1024, sb = b % 1024, swz = sb ^ (((sb >> 9) & 1) << 5); R = (st >> 1) * 16 + swz / 64; C = (st & 1) * 32 + (swz % 64) / 2; }
__host__ __device__ __forceinline__ int perm32(int rho) { const int n = rho >> 4, i = rho & 15; return 8 * (i >> 2) + 4 * n + (i & 3); }


struct Unit { int pm, pn, sel; };
struct Gemm { const bf16_t* A0; const bf16_t* A1; const bf16_t* B0; const bf16_t* B1; int K; size_t a_tstep; };

struct StaticOrder {
    int nM, nN, nwg, G, c;
    __host__ __device__ void init(int nM_, int nN_, int G_, int c_) { nM = nM_; nN = nN_; nwg = nM * nN; G = G_; c = c_; }
    __host__ __device__ bool next(int i, Unit& u) const {
        const long L = (long)i * G + c; if (L >= nwg) return false;
        int wgid = (int)L; { const int q = nwg / NXCD, r = nwg % NXCD, xcd = wgid % NXCD, off = wgid / NXCD; wgid = (xcd < r ? xcd * (q + 1) : r * (q + 1) + (xcd - r) * q) + off; }
        const int nig = WGM * nN, gid = wgid / nig, fm = gid * WGM, gsz = (nM - fm) < WGM ? (nM - fm) : WGM;
        u.pm = fm + ((wgid % nig) % gsz); u.pn = (wgid % nig) / gsz; u.sel = 0; return true;
    }
    __device__ __forceinline__ void a_ready(const Unit&) const {}
    __device__ __forceinline__ void done(const Unit&) const {}
};
struct DualOrder {
    StaticOrder S;
    __host__ __device__ bool next(int i, Unit& u) const { const bool ok = S.next(i >> 1, u); u.sel = i & 1; return ok; }
    __device__ __forceinline__ void a_ready(const Unit&) const {}
    __device__ __forceinline__ void done(const Unit&) const {}
};

typedef __bf16 bf16x2_t_ __attribute__((ext_vector_type(2))); typedef float f32x2_t_ __attribute__((ext_vector_type(2)));
__device__ __forceinline__ unsigned cvt_pk_bf16(float lo, float hi) { const f32x2_t_ v = {lo, hi}; const bf16x2_t_ b = __builtin_convertvector(v, bf16x2_t_); return __builtin_bit_cast(unsigned, b); }
__device__ __forceinline__ float bf_lo(unsigned w) { return __uint_as_float(w << 16); }
__device__ __forceinline__ float bf_hi(unsigned w) { return __uint_as_float(w & 0xffff0000u); }
__device__ __forceinline__ float fast_sigmoid(float x) { return __builtin_amdgcn_rcpf(1.0f + __builtin_amdgcn_exp2f(-1.4426950408889634f * x)); }
__device__ __forceinline__ u32x4 pack8(const f32x4 a, const f32x4 b) { u32x4 w; w.x = cvt_pk_bf16(a[0], a[1]); w.y = cvt_pk_bf16(a[2], a[3]); w.z = cvt_pk_bf16(b[0], b[1]); w.w = cvt_pk_bf16(b[2], b[3]); return w; }

template <int CTRL> __device__ __forceinline__ float dpp_shr(float old, float v) { return __builtin_bit_cast(float, __builtin_amdgcn_update_dpp(__builtin_bit_cast(int, old), __builtin_bit_cast(int, v), CTRL, 0xf, 0xf, false)); }
template <int CTRL> __device__ __forceinline__ float dpp_ror(float v) { return __builtin_bit_cast(float, __builtin_amdgcn_update_dpp(0, __builtin_bit_cast(int, v), CTRL, 0xf, 0xf, true)); }
constexpr int MROWS = 16384, DMODEL = 1024, DFF_ = 2816;

struct Epi1 {
    static constexpr bool PERM = true, AFTER_DRAIN = false;
    static __device__ __forceinline__ bool keep_acc(const Unit&) { return false; }
    bf16_t *BG, *UU, *Q, *K, *VT, *SG; const float* rstdx; const float *q_norm, *k_norm; float* kbar; PG8_LAS float* xl;
    __device__ __forceinline__ void operator()(f32x4 (&acc)[2][2][4][2], const Unit& u, int wr, int wc, int fr, int fq) const {
        const int row0 = u.pm * BM + wr * 64 + fr, colw = wc * 32 + 8 * fq, pn = u.pn;
        if (pn >= 12 && pn < 20) {
            const bool isK = pn >= 16; const float* wn = isK ? k_norm : q_norm; const float gs = isK ? 1.0f : 0.12751743074602357f;
            bf16_t* dst = isK ? K : Q; const int cb = ((pn - 12) & 3) * 256;
#pragma unroll
            for (int ai = 0; ai < 2; ++ai)
#pragma unroll
                for (int m = 0; m < 4; ++m) { const int rl = ai * HALF + wr * 64 + m * 16 + fr; const float rs = rstdx[u.pm * BM + rl];
#pragma unroll
                    for (int bj = 0; bj < 2; ++bj) { const f32x4 a = acc[ai][bj][m][0] * rs, b = acc[ai][bj][m][1] * rs; acc[ai][bj][m][0] = a; acc[ai][bj][m][1] = b;
                        float ss = (a[0] * a[0] + a[1] * a[1]) + (a[2] * a[2] + a[3] * a[3]) + (b[0] * b[0] + b[1] * b[1]) + (b[2] * b[2] + b[3] * b[3]);
                        ss += __shfl_xor(ss, 16); ss += __shfl_xor(ss, 32);
                        if (fq == 0) xl[(rl * 2 + bj) * 4 + wc] = ss; } }
            asm volatile("s_waitcnt lgkmcnt(0)" ::: "memory"); __builtin_amdgcn_s_barrier(); asm volatile("" ::: "memory");
            const f32x4 g0 = *(const f32x4*)(wn + colw) * gs, g1 = *(const f32x4*)(wn + colw + 4) * gs;
#pragma unroll
            for (int ai = 0; ai < 2; ++ai)
#pragma unroll
                for (int m = 0; m < 4; ++m) { const int rl = ai * HALF + wr * 64 + m * 16 + fr; const int r = u.pm * BM + rl;
#pragma unroll
                    for (int bj = 0; bj < 2; ++bj) { const f32x4 p = *(const PG8_LAS f32x4*)(xl + (rl * 2 + bj) * 4);
                        const float rn = rsqrtf(((p[0] + p[1]) + (p[2] + p[3])) * (1.0f / 128.0f) + 1e-6f);
                        const f32x4 a = acc[ai][bj][m][0] * rn * g0, b = acc[ai][bj][m][1] * rn * g1; acc[ai][bj][m][0] = a; acc[ai][bj][m][1] = b;
                        *(u32x4*)(dst + (size_t)r * 1024 + cb + bj * 128 + colw) = pack8(a, b); } }
            if (isK) {
                f32x4 cs[2][2];
#pragma unroll
                for (int bj = 0; bj < 2; ++bj)
#pragma unroll
                    for (int n = 0; n < 2; ++n) { f32x4 t = acc[0][bj][0][n];
#pragma unroll
                        for (int ai = 0; ai < 2; ++ai)
#pragma unroll
                            for (int m = 0; m < 4; ++m) if (ai + m > 0) t += acc[ai][bj][m][n];
                        cs[bj][n] = t; }
#pragma unroll
                for (int bj = 0; bj < 2; ++bj)
#pragma unroll
                    for (int n = 0; n < 2; ++n)
#pragma unroll
                        for (int e = 0; e < 4; ++e) { float v = cs[bj][n][e]; v += __shfl_xor(v, 1); v += __shfl_xor(v, 2); v += __shfl_xor(v, 4); v += __shfl_xor(v, 8); cs[bj][n][e] = v; }
                if (fr == 0) {
#pragma unroll
                    for (int bj = 0; bj < 2; ++bj) { *(PG8_LAS f32x4*)(xl + 2048 + wr * 256 + bj * 128 + colw) = cs[bj][0]; *(PG8_LAS f32x4*)(xl + 2048 + wr * 256 + bj * 128 + colw + 4) = cs[bj][1]; } }
                asm volatile("s_waitcnt lgkmcnt(0)" ::: "memory"); __builtin_amdgcn_s_barrier(); asm volatile("" ::: "memory");
                int t = threadIdx.x; asm volatile("" : "+v"(t));
                if (t < 256) kbar[((size_t)((pn - 16) * 2 + (t >> 7)) * 64 + u.pm) * 128 + (t & 127)] = (xl[2048 + t] + xl[2048 + 256 + t]) * (1.0f / 256.0f);
            }
            return;
        }
        if (pn >= 20 && pn < 24) {
            int tidv = threadIdx.x; asm volatile("" : "+v"(tidv));
            PG8_LAS unsigned char* T = (PG8_LAS unsigned char*)xl + (tidv >> 6) * 2304;
            const int lane = tidv & 63;
            float rsv[2][4];
#pragma unroll
            for (int ai = 0; ai < 2; ++ai)
#pragma unroll
                for (int m = 0; m < 4; ++m) rsv[ai][m] = rstdx[u.pm * BM + ai * HALF + wr * 64 + m * 16 + fr];
#pragma unroll
            for (int ai = 0; ai < 2; ++ai)
#pragma unroll
                for (int mp = 0; mp < 2; ++mp)
#pragma unroll
                    for (int bj = 0; bj < 2; ++bj) {
#pragma unroll
                        for (int mm = 0; mm < 2; ++mm) { const int m = 2 * mp + mm; const float rs = rsv[ai][m];
                            const u32x4 w = pack8(acc[ai][bj][m][0] * rs, acc[ai][bj][m][1] * rs); const unsigned ww[4] = {w.x, w.y, w.z, w.w};
                            PG8_LAS unsigned char* tp = T + (8 * fq) * 72 + (16 * mm + fr) * 2;
#pragma unroll
                            for (int e = 0; e < 8; ++e) *(PG8_LAS unsigned short*)(tp + e * 72) = (unsigned short)((e & 1) ? (ww[e >> 1] >> 16) : (ww[e >> 1] & 0xffffu)); }
                        asm volatile("s_waitcnt lgkmcnt(0)" ::: "memory");
#pragma unroll
                        for (int rr = 0; rr < 2; ++rr) { const int q = lane + 64 * rr, d = q >> 2, tc = q & 3;
                            const unsigned long long x0 = *(const PG8_LAS unsigned long long*)(T + d * 72 + tc * 16), x1 = *(const PG8_LAS unsigned long long*)(T + d * 72 + tc * 16 + 8);
                            u32x4 o; o.x = (unsigned)x0; o.y = (unsigned)(x0 >> 32); o.z = (unsigned)x1; o.w = (unsigned)(x1 >> 32);
                            *(u32x4*)(VT + ((size_t)(((pn - 20) * 2 + bj) * 128 + 32 * wc + d)) * MROWS + u.pm * BM + ai * HALF + wr * 64 + 32 * mp + tc * 8) = o; }
                        asm volatile("s_waitcnt lgkmcnt(0)" ::: "memory");
                    }
            return;
        }
        float rsg[2][4];
#pragma unroll
        for (int ai = 0; ai < 2; ++ai)
#pragma unroll
            for (int m = 0; m < 4; ++m) rsg[ai][m] = rstdx[row0 + ai * HALF + m * 16];
#pragma unroll
        for (int ai = 0; ai < 2; ++ai)
#pragma unroll
            for (int m = 0; m < 4; ++m) {
                const int r = row0 + ai * HALF + m * 16; const float rs = rsg[ai][m];
                f32x4 v[2][2];
#pragma unroll
                for (int bj = 0; bj < 2; ++bj)
#pragma unroll
                    for (int n = 0; n < 2; ++n) v[bj][n] = acc[ai][bj][m][n] * rs;
                if (pn < 4) {
#pragma unroll
                    for (int bj = 0; bj < 2; ++bj) *(u32x4*)(BG + (size_t)r * 1024 + pn * 256 + bj * 128 + colw) = pack8(v[bj][0], v[bj][1]);
                } else if (pn < 12) {
                    *(u32x4*)(UU + (size_t)r * 1024 + (pn - 4) * 128 + colw) = pack8(v[0][0] * v[1][0], v[0][1] * v[1][1]);
                } else {
                    f32x4 ra, rb, sa, sb;
#pragma unroll
                    for (int e = 0; e < 4; ++e) { const float ea0 = __builtin_amdgcn_exp2f(-1.4426950408889634f * v[0][0][e]), ea1 = __builtin_amdgcn_exp2f(-1.4426950408889634f * v[0][1][e]);
                        const float eb0 = __builtin_amdgcn_exp2f(-1.4426950408889634f * v[1][0][e]), eb1 = __builtin_amdgcn_exp2f(-1.4426950408889634f * v[1][1][e]);
                        ra[e] = (1.0f + eb0) * __builtin_amdgcn_rcpf(1.0f + ea0); rb[e] = (1.0f + eb1) * __builtin_amdgcn_rcpf(1.0f + ea1);
                        sa[e] = __builtin_amdgcn_rcpf(1.0f + eb0); sb[e] = __builtin_amdgcn_rcpf(1.0f + eb1); }
                    *(u32x4*)(SG + (size_t)r * 2048 + (pn - 24) * 128 + colw) = pack8(ra, rb);
                    *(u32x4*)(SG + (size_t)r * 2048 + 1024 + (pn - 24) * 128 + colw) = pack8(sa, sb);
                }
            }
    }
};
struct Epi4 {
    static constexpr bool PERM = true, AFTER_DRAIN = false;
    bf16_t* MG; const bf16_t* SG;
    static __device__ __forceinline__ bool keep_acc(const Unit& u) { return u.sel == 0; }
    __device__ __forceinline__ void operator()(f32x4 (&acc)[2][2][4][2], const Unit& u, int wr, int wc, int fr, int fq) const {
        const int row0 = u.pm * BM + wr * 64 + fr, col0 = u.pn * BM + wc * 32 + 8 * fq;
#pragma unroll
        for (int ai = 0; ai < 2; ++ai) {
            u32x4 g[4][2];
#pragma unroll
            for (int m = 0; m < 4; ++m)
#pragma unroll
                for (int bj = 0; bj < 2; ++bj) g[m][bj] = *(const u32x4*)(SG + (size_t)(row0 + ai * HALF + m * 16) * 2048 + u.sel * 1024 + col0 + bj * HALF);
#pragma unroll
            for (int m = 0; m < 4; ++m) { const int r = row0 + ai * HALF + m * 16;
#pragma unroll
                for (int bj = 0; bj < 2; ++bj) { const int c = col0 + bj * HALF; const u32x4 gg = g[m][bj];
                    f32x4 a = acc[ai][bj][m][0], b = acc[ai][bj][m][1];
                    a[0] *= bf_lo(gg.x); a[1] *= bf_hi(gg.x); a[2] *= bf_lo(gg.y); a[3] *= bf_hi(gg.y); b[0] *= bf_lo(gg.z); b[1] *= bf_hi(gg.z); b[2] *= bf_lo(gg.w); b[3] *= bf_hi(gg.w);
                    if (u.sel) *(u32x4*)(MG + (size_t)r * 1024 + c) = pack8(a, b);
                    else { acc[ai][bj][m][0] = a; acc[ai][bj][m][1] = b; } } }
        }
    }
};
struct Epi5 {
    static constexpr bool PERM = true, AFTER_DRAIN = false;
    static __device__ __forceinline__ bool keep_acc(const Unit&) { return false; }
    const float* X; float* OUT; bf16_t* HB; float* rowss;
    __device__ __forceinline__ void operator()(f32x4 (&acc)[2][2][4][2], const Unit& u, int wr, int wc, int fr, int fq) const {
        const int row0 = u.pm * BM + wr * 64 + fr, col0 = u.pn * BM + wc * 32 + 8 * fq;
#pragma unroll
        for (int ai = 0; ai < 2; ++ai) {
            f32x4 xv[4][2][2];
#pragma unroll
            for (int m = 0; m < 4; ++m)
#pragma unroll
                for (int bj = 0; bj < 2; ++bj) { const size_t o = (size_t)(row0 + ai * HALF + m * 16) * 1024 + col0 + bj * HALF; xv[m][bj][0] = __builtin_nontemporal_load((const f32x4*)(X + o)); xv[m][bj][1] = __builtin_nontemporal_load((const f32x4*)(X + o + 4)); }
#pragma unroll
            for (int m = 0; m < 4; ++m) { const int r = row0 + ai * HALF + m * 16; float ss = 0.f;
#pragma unroll
                for (int bj = 0; bj < 2; ++bj) { const size_t o = (size_t)r * 1024 + col0 + bj * HALF;
                    const f32x4 a = acc[ai][bj][m][0] + xv[m][bj][0], b = acc[ai][bj][m][1] + xv[m][bj][1];
                    *(u32x4*)(HB + o) = pack8(a, b);
                    ss += (a[0] * a[0] + a[1] * a[1]) + (a[2] * a[2] + a[3] * a[3]) + (b[0] * b[0] + b[1] * b[1]) + (b[2] * b[2] + b[3] * b[3]); }
                ss += __shfl_xor(ss, 16); ss += __shfl_xor(ss, 32);
                if (fq == 0) atomicAdd(rowss + r, ss); }
        }
    }
};
struct Epi6 {
    static constexpr bool PERM = true, AFTER_DRAIN = false;
    static __device__ __forceinline__ bool keep_acc(const Unit&) { return false; }
    bf16_t* ACT; const float* rowss; const float* cw; const float* cb; PG8_LAS float* halo;
    __device__ __forceinline__ void operator()(f32x4 (&acc)[2][2][4][2], const Unit& u, int wr, int wc, int fr, int fq) const {
        const int r0 = u.pm * 254 - 2, colw = wc * 32 + 8 * fq;
#pragma unroll
        for (int ai = 0; ai < 2; ++ai)
#pragma unroll
            for (int m = 0; m < 4; ++m) { int gr = r0 + ai * HALF + wr * 64 + m * 16 + fr; gr = gr < 0 ? 0 : (gr > MROWS - 1 ? MROWS - 1 : gr);
                const float rs = rsqrtf(rowss[gr] * (1.0f / 1024.0f) + 1e-6f);
#pragma unroll
                for (int bj = 0; bj < 2; ++bj)
#pragma unroll
                    for (int n = 0; n < 2; ++n) acc[ai][bj][m][n] *= rs; }
        if (fr >= 14) {
#pragma unroll
            for (int ai = 0; ai < 2; ++ai)
#pragma unroll
                for (int bj = 0; bj < 2; ++bj)
#pragma unroll
                    for (int n = 0; n < 2; ++n) *(PG8_LAS f32x4*)(halo + (((2 * ai + wr) * 2 + (fr - 14)) * 256 + bj * 128 + colw + 4 * n)) = acc[ai][bj][3][n];
        }
        f32x4 wn0, wn1, wn2, wnb;
        { const int col = u.pn * 128 + colw; wn0 = *(const f32x4*)(cw + col); wn1 = *(const f32x4*)(cw + 2 * DFF_ + col); wn2 = *(const f32x4*)(cw + 4 * DFF_ + col); wnb = *(const f32x4*)(cb + col); }
        asm volatile("s_waitcnt lgkmcnt(0)" ::: "memory"); __builtin_amdgcn_s_barrier(); asm volatile("" ::: "memory");
#pragma unroll
        for (int bj = 0; bj < 2; ++bj)
#pragma unroll
            for (int n = 0; n < 2; ++n) {
                const f32x4 w0 = wn0, w1 = wn1, w2 = wn2, bb = wnb;
                if (bj * 2 + n < 3) { const int k2 = bj * 2 + n + 1, col = (k2 >> 1) * DFF_ + u.pn * 128 + colw + 4 * (k2 & 1);
                    wn0 = *(const f32x4*)(cw + col); wn1 = *(const f32x4*)(cw + 2 * DFF_ + col); wn2 = *(const f32x4*)(cw + 4 * DFF_ + col); wnb = *(const f32x4*)(cb + col); }
#pragma unroll
                for (int ai = 0; ai < 2; ++ai) {
                    const int s = 2 * ai + wr;
                    const int sm = s > 0 ? s - 1 : 0; const float hz = s > 0 ? 1.0f : 0.0f;
                    const f32x4 h2 = *(const PG8_LAS f32x4*)(halo + ((sm * 2 + 0) * 256 + bj * 128 + colw + 4 * n)) * hz, h1 = *(const PG8_LAS f32x4*)(halo + ((sm * 2 + 1) * 256 + bj * 128 + colw + 4 * n)) * hz;
#pragma unroll
                    for (int mm = 0; mm < 4; ++mm) { const int m = 3 - mm;
                        f32x4 cur = acc[ai][bj][m][n]; asm volatile("" : "+v"(cur)); f32x4 p1, p2;
                        if (m > 0) { f32x4 lo = acc[ai][bj][m > 0 ? m - 1 : 0][n]; asm volatile("" : "+v"(lo));
#pragma unroll
                            for (int e = 0; e < 4; ++e) { p1[e] = dpp_shr<0x111>(dpp_ror<0x121>(lo[e]), cur[e]); p2[e] = dpp_shr<0x112>(dpp_ror<0x122>(lo[e]), cur[e]); } }
                        else {
#pragma unroll
                            for (int e = 0; e < 4; ++e) { p1[e] = dpp_shr<0x111>(h1[e], cur[e]); p2[e] = dpp_shr<0x112>(fr == 0 ? h2[e] : h1[e], cur[e]); } }
                        { f32x4 r_ = w0 * p2 + w1 * p1 + w2 * cur + bb; asm volatile("" : "+v"(r_)); acc[ai][bj][m][n] = r_; } }
                }
            }
#pragma unroll
        for (int ai = 0; ai < 2; ++ai)
#pragma unroll
            for (int m = 0; m < 4; ++m) { const int i = ai * HALF + wr * 64 + m * 16 + fr, gr = r0 + i;
                f32x4 a, b;
#pragma unroll
                for (int e = 0; e < 4; ++e) { const float g0 = acc[ai][0][m][0][e], g1 = acc[ai][0][m][1][e];
                    a[e] = g0 * fast_sigmoid(g0) * acc[ai][1][m][0][e]; b[e] = g1 * fast_sigmoid(g1) * acc[ai][1][m][1][e]; }
                if (i >= 2 && gr < MROWS) *(u32x4*)(ACT + (size_t)gr * DFF_ + u.pn * 128 + colw) = pack8(a, b); }
    }
};
struct Epi7 {
    static constexpr bool PERM = true, AFTER_DRAIN = false;
    static __device__ __forceinline__ bool keep_acc(const Unit&) { return false; }
    float* OUT; const bf16_t* HB;
    __device__ __forceinline__ void operator()(f32x4 (&acc)[2][2][4][2], const Unit& u, int wr, int wc, int fr, int fq) const {
        const int row0 = u.pm * BM + wr * 64 + fr, col0 = u.pn * BM + wc * 32 + 8 * fq;
#pragma unroll
        for (int ai = 0; ai < 2; ++ai) {
            u32x4 hv[4][2];
#pragma unroll
            for (int m = 0; m < 4; ++m)
#pragma unroll
                for (int bj = 0; bj < 2; ++bj) hv[m][bj] = *(const u32x4*)(HB + (size_t)(row0 + ai * HALF + m * 16) * 1024 + col0 + bj * HALF);
#pragma unroll
            for (int m = 0; m < 4; ++m) { const int r = row0 + ai * HALF + m * 16;
#pragma unroll
                for (int bj = 0; bj < 2; ++bj) { const size_t o = (size_t)r * 1024 + col0 + bj * HALF; float* p = OUT + o; const u32x4 hw = hv[m][bj];
                    f32x4 a = acc[ai][bj][m][0], b = acc[ai][bj][m][1];
                    a[0] += bf_lo(hw.x); a[1] += bf_hi(hw.x); a[2] += bf_lo(hw.y); a[3] += bf_hi(hw.y); b[0] += bf_lo(hw.z); b[1] += bf_hi(hw.z); b[2] += bf_lo(hw.w); b[3] += bf_hi(hw.w);
                    __builtin_nontemporal_store(a, (f32x4*)p); __builtin_nontemporal_store(b, (f32x4*)(p + 4)); } }
        }
    }
};
template <class Epi, class Sched, bool ALIGN_EPI = false, bool SP2 = false>
__device__ __forceinline__ void gemm_phase(PG8_LAS unsigned char* lds, const Gemm g, const Sched& S, const Epi& E) {
    const int tid = threadIdx.x, wid = __builtin_amdgcn_readfirstlane(tid >> 6), lane = tid & 63, wr = wid >> 2, wc = wid & 3, fr = lane & 15, fq = lane >> 4;
    const int K = g.K, nt = K / BK;
    unsigned voffA[2], voffB[2];
#pragma unroll
    for (int i = 0; i < 2; ++i) { int R, C; stage_rc(tid * 16 + i * 8192, R, C); const int Rb = Epi::PERM ? ((R & ~31) + perm32(R & 31)) : R;
        voffA[i] = (unsigned)(R * K + C) * 2u; voffB[i] = (unsigned)(Rb * K + C) * 2u; }
    const size_t kstep = (size_t)(BK * 2);
    const size_t hstep = (size_t)HALF * K * 2;
    const size_t tstep = 2 * hstep;
    const unsigned ldsw = (unsigned)wid * 1024u;
    const int aoff = lds_byte(wr * 64 + fr, fq * 8), boff = lds_byte(wc * 32 + fr, fq * 8);
#define PG8_SA(b, h) (((b) * 2 + (h)) * HTB)
#define PG8_SB(b, h) ((4 + (b) * 2 + (h)) * HTB)
#define PG8_STAGE(bufoff, gbase, voff) do { _Pragma("unroll") for (int _i = 0; _i < 2; ++_i) \
        __builtin_amdgcn_global_load_lds((const unsigned*)((const char*)(gbase) + (voff)[_i]), (PG8_LAS unsigned*)(lds + (bufoff) + ldsw + _i * 8192), 16, 0, 0); } while (0)
#define PG8_LDA(dst, b, h) do { _Pragma("unroll") for (int m = 0; m < 4; ++m) _Pragma("unroll") for (int k = 0; k < 2; ++k) dst[m][k] = *(const PG8_LAS bf16x8*)(lds + PG8_SA(b, h) + aoff + m * 2048 + k * 1024); } while (0)
#define PG8_LDB(dst, b, h) do { _Pragma("unroll") for (int n = 0; n < 2; ++n) _Pragma("unroll") for (int k = 0; k < 2; ++k) dst[n][k] = *(const PG8_LAS bf16x8*)(lds + PG8_SB(b, h) + boff + n * 2048 + k * 1024); } while (0)
#define PG8_MMA(ai, bj, At, Bt) do { __builtin_amdgcn_s_setprio(1); _Pragma("unroll") for (int m = 0; m < 4; ++m) _Pragma("unroll") for (int n = 0; n < 2; ++n) _Pragma("unroll") for (int k = 0; k < 2; ++k) \
        acc[ai][bj][m][n] = __builtin_amdgcn_mfma_f32_16x16x32_bf16(Bt[n][k], At[m][k], acc[ai][bj][m][n], 0, 0, 0); __builtin_amdgcn_s_setprio(0); } while (0)
#define PG8_WAIT_V(n) asm volatile("s_waitcnt vmcnt(" #n ")" ::: "memory")
#define PG8_WAIT_L(n) asm volatile("s_waitcnt lgkmcnt(" #n ")" ::: "memory")
#define PG8_BAR __builtin_amdgcn_s_barrier()
#define PG8_SCHED __builtin_amdgcn_sched_barrier(0)
    Unit cur, nxt; int ui = 0;
    if (!S.next(0, cur)) return;
    f32x4 acc[2][2][4][2];
#pragma unroll
    for (int a = 0; a < 2; ++a)
#pragma unroll
        for (int b = 0; b < 2; ++b)
#pragma unroll
            for (int m = 0; m < 4; ++m)
#pragma unroll
                for (int n = 0; n < 2; ++n) acc[a][b][m][n] = (f32x4){0.f, 0.f, 0.f, 0.f};
    bf16x8 At[4][2], B0[2][2], B1[2][2];
    const char* cA = (const char*)(cur.sel ? g.A1 : g.A0) + (size_t)cur.pm * g.a_tstep; const char* cB = (const char*)(cur.sel ? g.B1 : g.B0) + (size_t)cur.pn * tstep;
    S.a_ready(cur);
    if constexpr (SP2) {
        PG8_STAGE(PG8_SB(0, 0), cB, voffB); PG8_STAGE(PG8_SB(0, 1), cB + hstep, voffB); PG8_STAGE(PG8_SA(0, 0), cA, voffA); PG8_STAGE(PG8_SA(0, 1), cA + hstep, voffA);
        if (wr == 1) PG8_BAR;
        PG8_WAIT_V(2); PG8_BAR;
        PG8_STAGE(PG8_SB(1, 0), cB + kstep, voffB); PG8_STAGE(PG8_SA(1, 0), cA + kstep, voffA); PG8_STAGE(PG8_SB(1, 1), cB + hstep + kstep, voffB);
        PG8_WAIT_V(6); PG8_BAR;
    } else {
        PG8_STAGE(PG8_SB(0, 0), cB, voffB); PG8_STAGE(PG8_SA(0, 0), cA, voffA); PG8_STAGE(PG8_SB(0, 1), cB + hstep, voffB); PG8_STAGE(PG8_SA(0, 1), cA + hstep, voffA);
        if (wr == 1) PG8_BAR;
        PG8_WAIT_V(4); PG8_BAR;
        PG8_STAGE(PG8_SB(1, 0), cB + kstep, voffB); PG8_STAGE(PG8_SA(1, 0), cA + kstep, voffA); PG8_STAGE(PG8_SB(1, 1), cB + hstep + kstep, voffB);
        PG8_WAIT_V(6); PG8_BAR;
    }
    for (;;) {
        const bool has_next = S.next(ui + 1, nxt);
        const char* nA = has_next ? (const char*)(nxt.sel ? g.A1 : g.A0) + (size_t)nxt.pm * g.a_tstep : cA; const char* nB = has_next ? (const char*)(nxt.sel ? g.B1 : g.B0) + (size_t)nxt.pn * tstep : cB;
        for (int t = 0; t < nt; t += 2) {
            const bool last = (t == nt - 2);
            const char* a1 = cA + (size_t)(t + 1) * kstep;
            const char* a2 = last ? nA : cA + (size_t)(t + 2) * kstep; const char* b2 = last ? nB : cB + (size_t)(t + 2) * kstep;
            const char* a3 = a2 + kstep; const char* b3 = b2 + kstep;
            if (last && has_next) S.a_ready(nxt);
            if constexpr (SP2) {
            PG8_LDB(B0, 0, 0); PG8_LDB(B1, 0, 1); PG8_SCHED; PG8_LDA(At, 0, 0); PG8_STAGE(PG8_SA(1, 1), a1 + hstep, voffA);
            PG8_WAIT_V(8); PG8_WAIT_L(0); PG8_BAR; PG8_MMA(0, 0, At, B0); PG8_MMA(0, 1, At, B1); PG8_BAR; PG8_SCHED;
            PG8_LDA(At, 0, 1); PG8_STAGE(PG8_SB(0, 0), b2, voffB); PG8_STAGE(PG8_SB(0, 1), b2 + hstep, voffB); PG8_STAGE(PG8_SA(0, 0), a2, voffA);
            PG8_WAIT_V(8); PG8_WAIT_L(0); PG8_BAR; PG8_MMA(1, 0, At, B0); PG8_MMA(1, 1, At, B1); PG8_BAR; PG8_SCHED;
            PG8_LDB(B0, 1, 0); PG8_LDB(B1, 1, 1); PG8_SCHED; PG8_LDA(At, 1, 0); PG8_STAGE(PG8_SA(0, 1), a2 + hstep, voffA);
            PG8_WAIT_V(8); PG8_WAIT_L(0); PG8_BAR; PG8_MMA(0, 0, At, B0); PG8_MMA(0, 1, At, B1); PG8_BAR; PG8_SCHED;
            PG8_LDA(At, 1, 1); PG8_STAGE(PG8_SB(1, 0), b3, voffB); PG8_STAGE(PG8_SB(1, 1), b3 + hstep, voffB); PG8_STAGE(PG8_SA(1, 0), a3, voffA);
            PG8_WAIT_V(8); PG8_WAIT_L(0); PG8_BAR; PG8_MMA(1, 0, At, B0); PG8_MMA(1, 1, At, B1); PG8_BAR; PG8_SCHED;
            } else {
            PG8_LDB(B0, 0, 0); PG8_SCHED; PG8_LDA(At, 0, 0); PG8_STAGE(PG8_SA(1, 1), a1 + hstep, voffA);
            PG8_WAIT_L(8); PG8_BAR; PG8_WAIT_L(0); PG8_MMA(0, 0, At, B0); PG8_BAR; PG8_SCHED;
            PG8_LDB(B1, 0, 1); PG8_STAGE(PG8_SB(0, 0), b2, voffB);
            PG8_BAR; PG8_WAIT_L(0); PG8_MMA(0, 1, At, B1); PG8_BAR;
            PG8_LDA(At, 0, 1); PG8_STAGE(PG8_SA(0, 0), a2, voffA);
            PG8_BAR; PG8_WAIT_L(0); PG8_MMA(1, 0, At, B0); PG8_BAR; PG8_SCHED;
            PG8_STAGE(PG8_SB(0, 1), b2 + hstep, voffB);
            PG8_WAIT_V(6); PG8_BAR; PG8_MMA(1, 1, At, B1); PG8_BAR;
            PG8_LDB(B0, 1, 0); PG8_SCHED; PG8_LDA(At, 1, 0); PG8_STAGE(PG8_SA(0, 1), a2 + hstep, voffA);
            PG8_WAIT_L(8); PG8_BAR; PG8_WAIT_L(0); PG8_MMA(0, 0, At, B0); PG8_BAR; PG8_SCHED;
            PG8_LDB(B1, 1, 1); PG8_STAGE(PG8_SB(1, 0), b3, voffB);
            PG8_BAR; PG8_WAIT_L(0); PG8_MMA(0, 1, At, B1); PG8_BAR;
            PG8_LDA(At, 1, 1); PG8_STAGE(PG8_SA(1, 0), a3, voffA);
            PG8_BAR; PG8_WAIT_L(0); PG8_MMA(1, 0, At, B0); PG8_BAR; PG8_SCHED;
            PG8_STAGE(PG8_SB(1, 1), b3 + hstep, voffB);
            PG8_WAIT_V(6); PG8_BAR; PG8_MMA(1, 1, At, B1); PG8_BAR;
            }
        }
        if constexpr (ALIGN_EPI) { if (wr == 0) PG8_BAR; }
        if constexpr (!Epi::AFTER_DRAIN) { E(acc, cur, wr, wc, fr, fq); S.done(cur); }
        if (!has_next) break;
        if (!Epi::keep_acc(cur)) {
#pragma unroll
        for (int a = 0; a < 2; ++a)
#pragma unroll
            for (int b = 0; b < 2; ++b)
#pragma unroll
                for (int m = 0; m < 4; ++m)
#pragma unroll
                    for (int n = 0; n < 2; ++n) acc[a][b][m][n] = (f32x4){0.f, 0.f, 0.f, 0.f}; }
        cur = nxt; cA = nA; cB = nB; ++ui;
        if constexpr (ALIGN_EPI) { if (wr == 1) PG8_BAR; }
    }
    PG8_WAIT_V(0);
    if constexpr (!ALIGN_EPI) { if (wr == 0) PG8_BAR; }
    PG8_BAR;
    if constexpr (Epi::AFTER_DRAIN) { E.fused(acc, cur, wr, wc, fr, fq, lds, wid, lane); S.done(cur); }
#undef PG8_SA
#undef PG8_SB
#undef PG8_STAGE
#undef PG8_LDA
#undef PG8_LDB
#undef PG8_MMA
#undef PG8_WAIT_V
#undef PG8_WAIT_L
#undef PG8_BAR
#undef PG8_SCHED
}
}
#define GAS __attribute__((address_space(1)))
#define LAS __attribute__((address_space(3)))
typedef unsigned short bf16;
typedef unsigned v4u __attribute__((ext_vector_type(4)));
typedef float f32x4 __attribute__((ext_vector_type(4)));
typedef short bf16x8 __attribute__((ext_vector_type(8)));
typedef GAS unsigned gu32;
typedef GAS unsigned long long gu64;
#define RLX_AGENT __ATOMIC_RELAXED, __HIP_MEMORY_SCOPE_AGENT
#define LDS_WAIT() asm volatile("s_waitcnt lgkmcnt(0)" ::: "memory")
#define VM_WAIT() asm volatile("s_waitcnt vmcnt(0)" ::: "memory")
__device__ __forceinline__ unsigned long long rt() { return __builtin_amdgcn_s_memrealtime(); }
__device__ __forceinline__ unsigned f2bf(float f) { unsigned u = __builtin_bit_cast(unsigned, f); return (u + 0x7fffu + ((u >> 16) & 1u)) >> 16; }
__device__ __forceinline__ unsigned pk2(float lo, float hi) { return f2bf(lo) | (f2bf(hi) << 16); }

#define XB_TMO      128
#define XB_XCNT(j)  (256  + 64 * (j))
#define XB_XSUB(j)  (1280 + 64 * (j))
#define XB_XGEN(j)  (2304 + 64 * (j))
#define XB_TOP      3328
#define XB_TOPGEN   3392
#define XCD_BAR_WORDS 3456
#define XB_SPIN_CAP (1u << 18)

__device__ __forceinline__ unsigned xb_ld(unsigned* p)              { return __hip_atomic_load(p, __ATOMIC_RELAXED, __HIP_MEMORY_SCOPE_AGENT); }
__device__ __forceinline__ unsigned xb_add(unsigned* p, unsigned v) { return __hip_atomic_fetch_add(p, v, __ATOMIC_RELAXED, __HIP_MEMORY_SCOPE_AGENT); }
__device__ __forceinline__ unsigned xb_xcc_id() { return (unsigned)__builtin_amdgcn_s_getreg((3 << 11) | 20) & 0xFu; }
#define XB_SPIN(cond, bar) do { unsigned _sp = 0; while (cond) { __builtin_amdgcn_s_sleep(1); \
    if ((++_sp & 255u) == 0u) { if (xb_ld(&(bar)[XB_TMO])) break; if (_sp > XB_SPIN_CAP) { atomicAdd(&(bar)[XB_TMO], 1u); break; } } } } while (0)

struct XcdBarrier {
    unsigned* bar; unsigned x;
    volatile LAS unsigned* st;
};

__device__ __forceinline__ XcdBarrier xcd_barrier_post(unsigned* bar, volatile LAS unsigned* st) {
    XcdBarrier b; b.bar = bar; b.x = xb_xcc_id(); b.st = st;
    if (threadIdx.x == 0) (void)xb_add(&bar[XB_XCNT(b.x)], 1u);
    return b;
}
__device__ __forceinline__ void xcd_barrier_complete(unsigned* bar, unsigned x, unsigned& nloc, unsigned& nx) {
    const unsigned G = gridDim.x * gridDim.y * gridDim.z;
    unsigned sum, cnt, mine, sp = 0u;
    for (;;) {
        sum = 0u; cnt = 0u; mine = 0u;
#pragma unroll
        for (unsigned j = 0; j < 16; ++j) { const unsigned c = xb_ld(&bar[XB_XCNT(j)]); sum += c; cnt += (c > 0u) ? 1u : 0u; mine = (j == x) ? c : mine; }
        if (sum == G) break;
        __builtin_amdgcn_s_sleep(1);
        if ((++sp & 255u) == 0u) { if (xb_ld(&bar[XB_TMO])) break; if (sp > XB_SPIN_CAP) { atomicAdd(&bar[XB_TMO], 1u); break; } }
    }
    nloc = mine > 0u ? mine : 1u; nx = cnt > 0u ? cnt : 1u;
}

__device__ __forceinline__ void xcd_barrier(const XcdBarrier& b) {
    asm volatile("s_waitcnt vmcnt(0)" ::: "memory");
    __syncthreads();
    if (threadIdx.x == 0) {
        unsigned* bar = b.bar;
        __builtin_amdgcn_s_waitcnt(0);
        unsigned nloc = b.st[0], nx = b.st[1];
        if (nloc == 0u) { xcd_barrier_complete(bar, b.x, nloc, nx); b.st[0] = nloc; b.st[1] = nx; }
        const unsigned old = xb_add(&bar[XB_XSUB(b.x)], 1u);
        const unsigned gen = old / nloc;
        if (old + 1u == (gen + 1u) * nloc) {
            __builtin_amdgcn_fence(__ATOMIC_RELEASE, "agent");
            asm volatile("s_waitcnt vmcnt(0)" ::: "memory");
            const unsigned og = xb_add(&bar[XB_TOP], 1u);
            const unsigned tg = og / nx;
            if (og + 1u == (tg + 1u) * nx) xb_add(&bar[XB_TOPGEN], 1u);
            else XB_SPIN(xb_ld(&bar[XB_TOPGEN]) == tg, bar);
            __builtin_amdgcn_fence(__ATOMIC_ACQUIRE, "agent");
            xb_add(&bar[XB_XGEN(b.x)], 1u);
            asm volatile("s_waitcnt vmcnt(0)" ::: "memory");
        } else {
            XB_SPIN(xb_ld(&bar[XB_XGEN(b.x)]) == gen, bar);
            __builtin_amdgcn_fence(__ATOMIC_ACQUIRE, "agent");
            asm volatile("s_waitcnt vmcnt(0)" ::: "memory");
        }
    }
    __syncthreads();
}


constexpr int NWAVES = 8, NTHREADS = 512;
constexpr int M = 16384, D = 1024, NIN = 8192, DFF = 2816, NH = 8, HD = 128, NBLK = 64, BLK = 256;
constexpr float EPS = 1e-6f;
constexpr float C2 = 0.08838834764831845f * 1.4426950408889634f;
constexpr size_t MiB = 1u << 20;
constexpr size_t WS_CTL = 0, CTL_ZERO_BYTES = 256 * 1024;
constexpr int CW_BAR = 4096, CW_GCNT = 8192, CW_ROWSS = 16384;
constexpr size_t WS_KBAR = 1 * MiB, WS_RSTDX = 1 * MiB + 512 * 1024, WS_LPART = 2 * MiB;
constexpr size_t WS_WOA = 4 * MiB, WS_WOB = 6 * MiB, WS_WO = 8 * MiB;
constexpr size_t WS_Q = 10 * MiB, WS_K = 42 * MiB, WS_VT = 74 * MiB, WS_CA = 106 * MiB, WS_LIST = 138 * MiB, WS_WIN = 147 * MiB, WS_XB = 163 * MiB, WS_UU = 195 * MiB;
constexpr size_t WS_OPART = 147 * MiB;
constexpr size_t WS_WUP = 243 * MiB, WS_WDN = 138 * MiB, WS_MG = 165 * MiB, WS_HB = 198 * MiB;
constexpr size_t WS_ACT = 10 * MiB;
constexpr size_t WS_END = 256 * MiB;
constexpr int LDS_BYTES = 163840, MISC_OFF = 131072 + 320, HALO_OFF = 131072 + 1024, SCAN_OFF = 131072 + 1024;
__device__ __forceinline__ int list_off(int n) { return 256 * (63 * n - (n * (n - 1)) / 2); }
constexpr int LIST_PER_HEAD = 256 * 2016;

__device__ __forceinline__ float wave_sum(float v) {
#pragma unroll
    for (int o = 1; o < 64; o <<= 1) v += __shfl_xor(v, o);
    return v;
}
__device__ __forceinline__ void transpose_item(const float* W, int N, bf16* WT, int K, int k0, int col0, int row0, const float* ks, LAS float* scr, int lane) {
    float wv[32];
#pragma unroll
    for (int i = 0; i < 32; ++i) wv[i] = __builtin_nontemporal_load(W + (size_t)(k0 + 2 * i + (lane >> 5)) * N + col0 + (lane & 31));
#pragma unroll
    for (int i = 0; i < 32; ++i) { const int kk = 2 * i + (lane >> 5); const float s = ks ? ks[k0 + kk] : 1.0f; scr[kk * 33 + (lane & 31)] = s * wv[i]; }
    LDS_WAIT(); asm volatile("" ::: "memory");
    const int c = lane & 7;
#pragma unroll
    for (int j = 0; j < 4; ++j) { const int n = (lane >> 3) + 8 * j; const LAS float* s = scr + (8 * c) * 33 + n;
        v4u o; o.x = pk2(s[0 * 33], s[1 * 33]); o.y = pk2(s[2 * 33], s[3 * 33]); o.z = pk2(s[4 * 33], s[5 * 33]); o.w = pk2(s[6 * 33], s[7 * 33]);
        *(GAS v4u*)(WT + (size_t)(row0 + n) * K + k0 + 8 * c) = o; }
    LDS_WAIT(); asm volatile("" ::: "memory");
}
__device__ __forceinline__ int map_col(int mode, int R) {
    if (mode == 1) { if (R >= 1024 && R < 3072) { const int q = R - 1024; return 1024 + ((q >> 7) & 1) * 1024 + (q >> 8) * 128 + (q & 127); }
                     if (R >= 6144) { const int q = R - 6144; return 6144 + ((q >> 7) & 1) * 1024 + (q >> 8) * 128 + (q & 127); } return R; }
    if (mode == 2) return ((R >> 7) & 1) * DFF + (R >> 8) * 128 + (R & 127);
    return R;
}
__device__ __forceinline__ void convert_weight(const float* W, int K, int N, bf16* WT, const float* ks, int mode, LAS float* scr, int gw, int NGW, int lane) {
    const int nblk = N / 32, nitems = (K / 64) * nblk;
    for (int it = gw; it < nitems; it += NGW) { const int kb = it / nblk, nb = it % nblk; transpose_item(W, N, WT, K, 64 * kb, map_col(mode, 32 * nb), 32 * nb, ks, scr, lane); }
}

__device__ __forceinline__ void phase0(const float* x, const float* norm_mix, const float* w_in, const float* w_oa, const float* w_ob, const float* w_o, const float* w_up, const float* norm_ffn, unsigned char* ws, LAS unsigned char* lds, int vcu, int G, int wave, int lane) {
    LAS float* scr = (LAS float*)(lds + wave * 16384);
    const int gw = vcu * NWAVES + wave, NGW = G * NWAVES;
    convert_weight(w_in, D, NIN, (bf16*)(ws + WS_WIN), norm_mix, 1, scr, gw, NGW, lane);
    convert_weight(w_oa, D, D, (bf16*)(ws + WS_WOA), nullptr, 0, scr, gw, NGW, lane);
    convert_weight(w_ob, D, D, (bf16*)(ws + WS_WOB), nullptr, 0, scr, gw, NGW, lane);
    convert_weight(w_o, D, D, (bf16*)(ws + WS_WO), nullptr, 0, scr, gw, NGW, lane);
    convert_weight(w_up, D, 2 * DFF, (bf16*)(ws + WS_WUP), norm_ffn, 2, scr, gw, NGW, lane);
    bf16* XB = (bf16*)(ws + WS_XB); float* rstdx = (float*)(ws + WS_RSTDX);
    for (int m = gw; m < M; m += NGW) {
        const GAS f32x4* xr = (const GAS f32x4*)(x + (size_t)m * D) + lane; f32x4 v[4]; float s = 0.f;
#pragma unroll
        for (int j = 0; j < 4; ++j) { v[j] = __builtin_nontemporal_load(xr + 64 * j); s += (v[j].x * v[j].x + v[j].y * v[j].y) + (v[j].z * v[j].z + v[j].w * v[j].w); }
        s = wave_sum(s); if (lane == 0) rstdx[m] = rsqrtf(s * (1.f / D) + EPS);
        GAS unsigned long long* o8 = (GAS unsigned long long*)(XB + (size_t)m * D) + lane;
#pragma unroll
        for (int j = 0; j < 4; ++j) o8[64 * j] = (unsigned long long)pk2(v[j].x, v[j].y) | ((unsigned long long)pk2(v[j].z, v[j].w) << 32);
    }
}
__device__ __forceinline__ void phase2(const float* conv_a_w, unsigned char* ws, int G, int tid, bf16* __restrict__ CAout) {
    const bf16* __restrict__ BG = (const bf16*)(ws + WS_CA); const bf16* __restrict__ UU = (const bf16*)(ws + WS_UU);
    for (int item = blockIdx.x * NTHREADS + tid; item < 128 * (M / 16); item += G * NTHREADS) {
        const int cc = (item & 127) * 8, t0 = (item >> 7) * 16;
        float w0[8], w1[8], w2[8], um2[8], um1[8];
#pragma unroll
        for (int j = 0; j < 2; ++j) { const f32x4 a = *(const GAS f32x4*)(conv_a_w + cc + 4 * j), b = *(const GAS f32x4*)(conv_a_w + 1024 + cc + 4 * j), c = *(const GAS f32x4*)(conv_a_w + 2048 + cc + 4 * j);
#pragma unroll
            for (int e = 0; e < 4; ++e) { w0[4 * j + e] = a[e]; w1[4 * j + e] = b[e]; w2[4 * j + e] = c[e]; } }
        { v4u a = (v4u){0u, 0u, 0u, 0u}, b = a; if (t0 >= 2) { a = *(const GAS v4u*)(UU + (size_t)(t0 - 2) * 1024 + cc); b = *(const GAS v4u*)(UU + (size_t)(t0 - 1) * 1024 + cc); }
          const unsigned aw[4] = {a.x, a.y, a.z, a.w}, bw[4] = {b.x, b.y, b.z, b.w};
#pragma unroll
          for (int j = 0; j < 4; ++j) { um2[2 * j] = pg8::bf_lo(aw[j]); um2[2 * j + 1] = pg8::bf_hi(aw[j]); um1[2 * j] = pg8::bf_lo(bw[j]); um1[2 * j + 1] = pg8::bf_hi(bw[j]); } }
#pragma unroll 4
        for (int i = 0; i < 16; ++i) { const size_t o = (size_t)(t0 + i) * 1024 + cc;
            const v4u u = *(const GAS v4u*)(UU + o), b = *(const GAS v4u*)(BG + o); const unsigned uw[4] = {u.x, u.y, u.z, u.w}, bw[4] = {b.x, b.y, b.z, b.w};
            float r[8];
#pragma unroll
            for (int j = 0; j < 4; ++j) { const float u0 = pg8::bf_lo(uw[j]), u1 = pg8::bf_hi(uw[j]);
                r[2 * j] = pg8::bf_lo(bw[j]) * (w0[2 * j] * um2[2 * j] + w1[2 * j] * um1[2 * j] + w2[2 * j] * u0);
                r[2 * j + 1] = pg8::bf_hi(bw[j]) * (w0[2 * j + 1] * um2[2 * j + 1] + w1[2 * j + 1] * um1[2 * j + 1] + w2[2 * j + 1] * u1);
                um2[2 * j] = um1[2 * j]; um2[2 * j + 1] = um1[2 * j + 1]; um1[2 * j] = u0; um1[2 * j + 1] = u1; }
            v4u o4; o4.x = pk2(r[0], r[1]); o4.y = pk2(r[2], r[3]); o4.z = pk2(r[4], r[5]); o4.w = pk2(r[6], r[7]);
            *(GAS v4u*)(CAout + o) = o4; }
    }
}
__device__ __forceinline__ bool top_better(float v, int n, float cv, int cn) { return v > cv || (v == cv && n < cn); }
__device__ __forceinline__ void top3_insert(float v, int n, float (&tv)[3], int (&ti)[3]) {
    if (top_better(v, n, tv[0], ti[0])) { tv[2] = tv[1]; ti[2] = ti[1]; tv[1] = tv[0]; ti[1] = ti[0]; tv[0] = v; ti[0] = n; }
    else if (top_better(v, n, tv[1], ti[1])) { tv[2] = tv[1]; ti[2] = ti[1]; tv[1] = v; ti[1] = n; }
    else if (top_better(v, n, tv[2], ti[2])) { tv[2] = v; ti[2] = n; }
}
__device__ __forceinline__ void phase2d(unsigned char* ws, LAS unsigned char* lds, int G, int tid, int wave, int lane, unsigned* gcnt, unsigned short* glist) {
    LAS unsigned* lcnt = (LAS unsigned*)(lds + 32768); LAS unsigned* lbase = lcnt + 64; LAS unsigned short* llist = (LAS unsigned short*)lds;
    const bf16* Q = (const bf16*)(ws + WS_Q); const float* kbar = (const float*)(ws + WS_KBAR);
    const int fr = lane & 15, fq = lane >> 4;
    for (int unit = blockIdx.x; unit < NH * 63; unit += G) {
        const int h = unit / 63, c = 1 + unit % 63;
        if (tid < 64) lcnt[tid] = 0u;
        __syncthreads();
        bf16x8 qf[2][4];
#pragma unroll
        for (int g = 0; g < 2; ++g)
#pragma unroll
            for (int ks = 0; ks < 4; ++ks) qf[g][ks] = *(const GAS bf16x8*)(Q + (size_t)(c * BLK + wave * 32 + g * 16 + fr) * 1024 + h * HD + ks * 32 + fq * 8);
        float tv[2][3]; int ti[2][3];
#pragma unroll
        for (int g = 0; g < 2; ++g)
#pragma unroll
            for (int j = 0; j < 3; ++j) { tv[g][j] = -__builtin_inff(); ti[g][j] = 1 << 20; }
        const int ntile = (c + 15) >> 4;
        for (int tile = 0; tile < ntile; ++tile) {
            f32x4 s0 = (f32x4){0.f, 0.f, 0.f, 0.f}, s1 = s0;
#pragma unroll
            for (int ks = 0; ks < 4; ++ks) {
                const float* kp = kbar + ((size_t)(h * NBLK + tile * 16 + fr) * HD + ks * 32 + fq * 8);
                const f32x4 a = *(const GAS f32x4*)kp, b = *(const GAS f32x4*)(kp + 4);
                const v4u hw = pg8::pack8(a, b);
                f32x4 ra, rb; ra[0] = a[0] - pg8::bf_lo(hw.x); ra[1] = a[1] - pg8::bf_hi(hw.x); ra[2] = a[2] - pg8::bf_lo(hw.y); ra[3] = a[3] - pg8::bf_hi(hw.y);
                rb[0] = b[0] - pg8::bf_lo(hw.z); rb[1] = b[1] - pg8::bf_hi(hw.z); rb[2] = b[2] - pg8::bf_lo(hw.w); rb[3] = b[3] - pg8::bf_hi(hw.w);
                const v4u lw = pg8::pack8(ra, rb);
                const bf16x8 hi = __builtin_bit_cast(bf16x8, hw), lo = __builtin_bit_cast(bf16x8, lw);
                s0 = __builtin_amdgcn_mfma_f32_16x16x32_bf16(hi, qf[0][ks], s0, 0, 0, 0); s0 = __builtin_amdgcn_mfma_f32_16x16x32_bf16(lo, qf[0][ks], s0, 0, 0, 0);
                s1 = __builtin_amdgcn_mfma_f32_16x16x32_bf16(hi, qf[1][ks], s1, 0, 0, 0); s1 = __builtin_amdgcn_mfma_f32_16x16x32_bf16(lo, qf[1][ks], s1, 0, 0, 0);
            }
#pragma unroll
            for (int i = 0; i < 4; ++i) { const int n = tile * 16 + 4 * fq + i;
                top3_insert(n < c ? s0[i] : -__builtin_inff(), n, tv[0], ti[0]); top3_insert(n < c ? s1[i] : -__builtin_inff(), n, tv[1], ti[1]); }
        }
#pragma unroll
        for (int off = 16; off <= 32; off <<= 1)
#pragma unroll
            for (int g = 0; g < 2; ++g) { float pv[3]; int pi[3];
#pragma unroll
                for (int j = 0; j < 3; ++j) { pv[j] = __shfl_xor(tv[g][j], off); pi[j] = __shfl_xor(ti[g][j], off); }
#pragma unroll
                for (int j = 0; j < 3; ++j) top3_insert(pv[j], pi[j], tv[g], ti[g]); }
        const int nsel = c < 3 ? c : 3;
        if (fq == 0) {
#pragma unroll
            for (int g = 0; g < 2; ++g) { const int tl = wave * 32 + g * 16 + fr;
#pragma unroll
                for (int j = 0; j < 3; ++j) if (j < nsel) { const int n = ti[g][j]; const unsigned pp = __hip_atomic_fetch_add(&lcnt[n], 1u, __ATOMIC_RELAXED, __HIP_MEMORY_SCOPE_WORKGROUP); llist[n * 256 + pp] = (unsigned short)((tl << 2) | j); } }
        }
        __syncthreads();
        if (tid < c) { const unsigned k = lcnt[tid]; lbase[tid] = k ? atomicAdd(gcnt + h * NBLK + tid, k) : 0u; }
        __syncthreads();
        for (int n = wave; n < c; n += NWAVES) { const unsigned k = lcnt[n], base = lbase[n];
            unsigned short* dst = glist + (size_t)h * LIST_PER_HEAD + list_off(n) + base;
            for (unsigned i = lane; i < k; i += 64) { const unsigned e = llist[n * 256 + i]; dst[i] = (unsigned short)((((unsigned)c * BLK + (e >> 2)) << 2) | (e & 3u)); } }
        __syncthreads();
    }
}
__device__ __forceinline__ void stage_kv(const bf16* Kg, const bf16* Vt, int h, int n, LAS unsigned char* lds, int tid) {
    v4u kw[8], vw[8];
#pragma unroll
    for (int i = 0; i < 8; ++i) { const int row = (tid >> 4) + 32 * i, ch = tid & 15; kw[i] = *(const GAS v4u*)(Kg + (size_t)(n * BLK + row) * 1024 + h * HD + ch * 8); }
#pragma unroll
    for (int i = 0; i < 8; ++i) { const int row = (tid >> 5) + 16 * i, ch = tid & 31; vw[i] = *(const GAS v4u*)(Vt + (size_t)(h * HD + row) * M + n * BLK + ch * 8); }
#pragma unroll
    for (int i = 0; i < 8; ++i) { const int row = (tid >> 4) + 32 * i, ch = tid & 15; const int sw = (((row >> 3) & 3) << 2) | (row & 3);
        *(LAS v4u*)(lds + row * 256 + ((ch ^ sw) << 4)) = kw[i]; }
#pragma unroll
    for (int i = 0; i < 8; ++i) { const int row = (tid >> 5) + 16 * i, ch = tid & 31;
        *(LAS v4u*)(lds + 65536 + row * 512 + ((ch ^ ((((row >> 4) & 3) << 2) | (row & 3))) << 4)) = vw[i]; }
}
__device__ __forceinline__ void load_q(bf16x8 (&qf)[2][4], const bf16* Q, int h, const int (&tq)[2], int fq) {
#pragma unroll
    for (int g = 0; g < 2; ++g)
#pragma unroll
        for (int ks = 0; ks < 4; ++ks) qf[g][ks] = *(const GAS bf16x8*)(Q + (size_t)tq[g] * 1024 + h * HD + ks * 32 + fq * 8);
}
template <bool CAUSAL, int MODE = 0>
__device__ __forceinline__ void attn_core(const LAS unsigned char* lds, const bf16x8 (&qf)[2][4], int wave, int fr, int fq, float B2, f32x4 (&O)[8][2], float (&l)[2]) {
#pragma unroll
    for (int dt = 0; dt < 8; ++dt) { O[dt][0] = (f32x4){0.f, 0.f, 0.f, 0.f}; O[dt][1] = O[dt][0]; }
    l[0] = 0.f; l[1] = 0.f;
    const int nch = CAUSAL ? wave + 1 : 8;
    const int krow = (fr >> 2) * 8 + (fr & 3);
    bf16x8 kf[4][2];
#pragma unroll
    for (int ks = 0; ks < 4; ++ks)
#pragma unroll
        for (int t = 0; t < 2; ++t) kf[ks][t] = *(const LAS bf16x8*)(lds + (krow + t * 4) * 256 + (((ks * 4 + fq) ^ fr) << 4));
#pragma unroll 2
    for (int c = 0; c < nch; ++c) {
        f32x4 s[2][2];
#pragma unroll
        for (int t = 0; t < 2; ++t) { s[t][0] = (f32x4){-B2, -B2, -B2, -B2}; s[t][1] = s[t][0]; }
        bf16x8 vf[8];
#pragma unroll
        for (int dt = 0; dt < 8; ++dt) vf[dt] = *(const LAS bf16x8*)(lds + 65536 + ((dt >> 2) * 64 + (fr >> 2) * 16 + (dt & 3) * 4 + (fr & 3)) * 512 + (((c * 4 + fq) ^ fr) << 4));
#pragma unroll
        for (int ks = 0; ks < 4; ++ks)
#pragma unroll
            for (int t = 0; t < 2; ++t) {
                if (MODE != 2 || ks == 0) {
                s[t][0] = __builtin_amdgcn_mfma_f32_16x16x32_bf16(kf[ks][t], qf[0][ks], s[t][0], 0, 0, 0);
                s[t][1] = __builtin_amdgcn_mfma_f32_16x16x32_bf16(kf[ks][t], qf[1][ks], s[t][1], 0, 0, 0); }
            }
        __builtin_amdgcn_sched_barrier(0);
        { const int cn = (c + 1 < nch) ? c + 1 : c;
#pragma unroll
          for (int ks = 0; ks < 4; ++ks)
#pragma unroll
              for (int t = 0; t < 2; ++t) kf[ks][t] = *(const LAS bf16x8*)(lds + (cn * 32 + krow + t * 4) * 256 + (((ks * 4 + fq) ^ fr) << 4)); }
        bf16x8 pf[2];
#pragma unroll
        for (int g = 0; g < 2; ++g) {
            float p[8];
#pragma unroll
            for (int t = 0; t < 2; ++t)
#pragma unroll
                for (int i = 0; i < 4; ++i) { float e = MODE == 1 ? s[t][g][i] : __builtin_amdgcn_exp2f(s[t][g][i]);
                    if (CAUSAL && c == wave) { const int kl = c * 32 + fq * 8 + t * 4 + i, ql = wave * 32 + g * 16 + fr; if (kl > ql) e = 0.f; }
                    p[t * 4 + i] = e; }
            l[g] += ((p[0] + p[1]) + (p[2] + p[3])) + ((p[4] + p[5]) + (p[6] + p[7]));
            v4u w; w.x = pg8::cvt_pk_bf16(p[0], p[1]); w.y = pg8::cvt_pk_bf16(p[2], p[3]); w.z = pg8::cvt_pk_bf16(p[4], p[5]); w.w = pg8::cvt_pk_bf16(p[6], p[7]);
            pf[g] = __builtin_bit_cast(bf16x8, w);
        }
#pragma unroll
        for (int dt = 0; dt < 8; ++dt) {
            if (MODE != 3 || dt == 0) {
            O[dt][0] = __builtin_amdgcn_mfma_f32_16x16x32_bf16(vf[dt], pf[0], O[dt][0], 0, 0, 0);
            O[dt][1] = __builtin_amdgcn_mfma_f32_16x16x32_bf16(vf[dt], pf[1], O[dt][1], 0, 0, 0); }
        }
    }
    l[0] += __shfl_xor(l[0], 16); l[0] += __shfl_xor(l[0], 32); l[1] += __shfl_xor(l[1], 16); l[1] += __shfl_xor(l[1], 32);
}
__device__ __forceinline__ float score_bound(const float* q_norm, const float* k_norm, int lane) {
    float a = fmaxf(fabsf(q_norm[lane]), fabsf(q_norm[lane + 64])), b = fmaxf(fabsf(k_norm[lane]), fabsf(k_norm[lane + 64]));
#pragma unroll
    for (int o = 1; o < 64; o <<= 1) { a = fmaxf(a, __shfl_xor(a, o)); b = fmaxf(b, __shfl_xor(b, o)); }
    return 128.0f * a * b * C2 * 1.001f + 0.01f;
}
template <int MODE>
__device__ __forceinline__ void phase3a(const float* q_norm, const float* k_norm, unsigned char* ws, LAS unsigned char* lds, int G, int tid, int wave, int lane) {
    const int fr = lane & 15, fq = lane >> 4;
    LAS int* pre = (LAS int*)(lds + SCAN_OFF);
    LAS int* cntl = (LAS int*)(lds + SCAN_OFF + 2080);
    const unsigned* gcnt = (const unsigned*)(ws + WS_CTL) + CW_GCNT; const unsigned short* glist = (const unsigned short*)(ws + WS_LIST);
    const bf16* Q = (const bf16*)(ws + WS_Q); const bf16* Kg = (const bf16*)(ws + WS_K); const bf16* Vt = (const bf16*)(ws + WS_VT);
    unsigned char* OP = ws + WS_OPART; float* LP = (float*)(ws + WS_LPART);
    const float B2 = score_bound(q_norm, k_norm, lane);
    { const int cnt = (int)__hip_atomic_load(gcnt + tid, __ATOMIC_RELAXED, __HIP_MEMORY_SCOPE_AGENT); pre[tid + 1] = (cnt + 255) >> 8; cntl[tid] = cnt; if (tid == 0) pre[0] = 0; }
    __syncthreads();
    for (int o = 1; o < 512; o <<= 1) { const int v = pre[tid + 1] + ((tid + 1 - o) >= 1 ? pre[tid + 1 - o] : 0); __syncthreads(); pre[tid + 1] = v; __syncthreads(); }
    const int T = pre[512];
    const int i_lo = (int)(((long)blockIdx.x * T) / G), i_hi = (int)(((long)(blockIdx.x + 1) * T) / G);
    int staged = -1;
#define P3A_DECODE(IT, HN, TILE) do { int lo_ = 0, hi_ = 511; while (lo_ < hi_) { const int mid_ = (lo_ + hi_ + 1) >> 1; if (pre[mid_] <= (IT)) lo_ = mid_; else hi_ = mid_ - 1; } HN = lo_; TILE = (IT) - pre[lo_]; } while (0)
    unsigned en[2] = {0u, 0u}; bool okn[2] = {false, false};
    bf16x8 qf[2][4]; int hnn = 0;
    if (i_lo < i_hi) { int hn, tile; P3A_DECODE(i_lo, hn, tile); const int cnt = cntl[hn]; const unsigned short* lst = glist + (size_t)(hn >> 6) * LIST_PER_HEAD + list_off(hn & 63) + tile * 256;
#pragma unroll
        for (int g = 0; g < 2; ++g) { const int qi = wave * 32 + g * 16 + fr; okn[g] = tile * 256 + qi < cnt; en[g] = okn[g] ? lst[qi] : 0u; }
        { const int tq0[2] = {(int)(en[0] >> 2), (int)(en[1] >> 2)}; load_q(qf, Q, hn >> 6, tq0, fq); } }
    for (int it = i_lo; it < i_hi; ++it) {
        int hn, tile; P3A_DECODE(it, hn, tile); const int h = hn >> 6, n = hn & 63;
        int tq[2], sj[2]; bool ok[2];
#pragma unroll
        for (int g = 0; g < 2; ++g) { ok[g] = okn[g]; tq[g] = (int)(en[g] >> 2); sj[g] = (int)(en[g] & 3u); }
        if (it + 1 < i_hi) { int hn2, tile2; P3A_DECODE(it + 1, hn2, tile2); hnn = hn2; const int cnt2 = cntl[hn2]; const unsigned short* lst2 = glist + (size_t)(hn2 >> 6) * LIST_PER_HEAD + list_off(hn2 & 63) + tile2 * 256;
#pragma unroll
            for (int g = 0; g < 2; ++g) { const int qi = wave * 32 + g * 16 + fr; okn[g] = tile2 * 256 + qi < cnt2; en[g] = okn[g] ? lst2[qi] : 0u; } }
        if (hn != staged) { __syncthreads(); stage_kv(Kg, Vt, h, n, lds, tid); LDS_WAIT(); __syncthreads(); staged = hn; }
        f32x4 O[8][2]; float l[2];
        attn_core<false, MODE>(lds, qf, wave, fr, fq, B2, O, l);
        if (it + 1 < i_hi) { const int tqn[2] = {(int)(en[0] >> 2), (int)(en[1] >> 2)}; load_q(qf, Q, hnn >> 6, tqn, fq); }
#pragma unroll
        for (int g = 0; g < 2; ++g) if (ok[g]) {
            unsigned char* op = OP + ((size_t)sj[g] * M + tq[g]) * 1024 + h * HD + 16 * fq;
            const float sc = 16.0f / l[g];
#pragma unroll
            for (int j = 0; j < 2; ++j) { v4u w;
                { int t = 0; t = __builtin_amdgcn_cvt_pk_fp8_f32(O[4 * j][g][0] * sc, O[4 * j][g][1] * sc, t, false); t = __builtin_amdgcn_cvt_pk_fp8_f32(O[4 * j][g][2] * sc, O[4 * j][g][3] * sc, t, true); w.x = (unsigned)t; }
                { int t = 0; t = __builtin_amdgcn_cvt_pk_fp8_f32(O[4 * j + 1][g][0] * sc, O[4 * j + 1][g][1] * sc, t, false); t = __builtin_amdgcn_cvt_pk_fp8_f32(O[4 * j + 1][g][2] * sc, O[4 * j + 1][g][3] * sc, t, true); w.y = (unsigned)t; }
                { int t = 0; t = __builtin_amdgcn_cvt_pk_fp8_f32(O[4 * j + 2][g][0] * sc, O[4 * j + 2][g][1] * sc, t, false); t = __builtin_amdgcn_cvt_pk_fp8_f32(O[4 * j + 2][g][2] * sc, O[4 * j + 2][g][3] * sc, t, true); w.z = (unsigned)t; }
                { int t = 0; t = __builtin_amdgcn_cvt_pk_fp8_f32(O[4 * j + 3][g][0] * sc, O[4 * j + 3][g][1] * sc, t, false); t = __builtin_amdgcn_cvt_pk_fp8_f32(O[4 * j + 3][g][2] * sc, O[4 * j + 3][g][3] * sc, t, true); w.w = (unsigned)t; }
                *(GAS v4u*)(op + j * 64) = w; }
            if (fq == 0) LP[((size_t)sj[g] * M + tq[g]) * NH + h] = l[g];
        }
    }
#undef P3A_DECODE
    __syncthreads();
}
__device__ __forceinline__ void phase3b(const float* q_norm, const float* k_norm, unsigned char* ws, LAS unsigned char* lds, int G, int tid, int wave, int lane, bf16* Oout) {
    const int fr = lane & 15, fq = lane >> 4;
    bf16* Q = (bf16*)(ws + WS_Q); const bf16* Kg = (const bf16*)(ws + WS_K); const bf16* Vt = (const bf16*)(ws + WS_VT);
    const unsigned char* OP = ws + WS_OPART; const float* LP = (const float*)(ws + WS_LPART);
    const float B2 = score_bound(q_norm, k_norm, lane);
    bf16x8 qf[2][4];
    if ((int)blockIdx.x < NH * NBLK) { const int u0 = blockIdx.x; const int tq0[2] = {(u0 & 63) * BLK + wave * 32 + fr, (u0 & 63) * BLK + wave * 32 + 16 + fr}; load_q(qf, Q, u0 >> 6, tq0, fq); }
    for (int unit = blockIdx.x; unit < NH * NBLK; unit += G) {
        const int h = unit >> 6, c = unit & 63;
        __syncthreads(); stage_kv(Kg, Vt, h, c, lds, tid); LDS_WAIT(); __syncthreads();
        int tq[2];
#pragma unroll
        for (int g = 0; g < 2; ++g) tq[g] = c * BLK + wave * 32 + g * 16 + fr;
        f32x4 O[8][2]; float l[2];
        attn_core<true>(lds, qf, wave, fr, fq, B2, O, l);
        if (unit + G < NH * NBLK) { const int u1 = unit + G; const int tqn[2] = {(u1 & 63) * BLK + wave * 32 + fr, (u1 & 63) * BLK + wave * 32 + 16 + fr}; load_q(qf, Q, u1 >> 6, tqn, fq); }
        const int nsel = c < 3 ? c : 3;
#pragma unroll
        for (int g = 0; g < 2; ++g) {
            float lp[3];
#pragma unroll
            for (int j = 0; j < 3; ++j) lp[j] = LP[((size_t)j * M + tq[g]) * NH + h];
            v4u w[3][2];
#pragma unroll
            for (int j = 0; j < 3; ++j)
#pragma unroll
                for (int k = 0; k < 2; ++k) w[j][k] = *(const GAS v4u*)(OP + ((size_t)j * M + tq[g]) * 1024 + h * HD + k * 64 + 16 * fq);
            float lt = l[g]; float ls[3];
#pragma unroll
            for (int j = 0; j < 3; ++j) { ls[j] = j < nsel ? lp[j] * (1.0f / 16.0f) : 0.f; lt += j < nsel ? lp[j] : 0.f; }
            const float inv = 1.0f / lt;
#pragma unroll
            for (int k = 0; k < 2; ++k) {
                f32x4 o[4];
#pragma unroll
                for (int q = 0; q < 4; ++q) o[q] = O[4 * k + q][g];
#pragma unroll
                for (int j = 0; j < 3; ++j) if (j < nsel) { const unsigned xw[4] = {w[j][k].x, w[j][k].y, w[j][k].z, w[j][k].w};
#pragma unroll
                    for (int q = 0; q < 4; ++q) { const pg8::f32x2_t_ lo = __builtin_amdgcn_cvt_pk_f32_fp8((int)xw[q], false), hi = __builtin_amdgcn_cvt_pk_f32_fp8((int)xw[q], true);
                        o[q][0] += lo[0] * ls[j]; o[q][1] += lo[1] * ls[j]; o[q][2] += hi[0] * ls[j]; o[q][3] += hi[1] * ls[j]; } }
                bf16* dst = Oout + (size_t)tq[g] * 1024 + h * HD + k * 64 + 16 * fq;
                *(GAS v4u*)dst = pg8::pack8(o[0] * inv, o[1] * inv); *(GAS v4u*)(dst + 8) = pg8::pack8(o[2] * inv, o[3] * inv); }
        }
    }
    __syncthreads();
}

#ifndef MK_PER_PHASE
#define MK_PER_PHASE 0
#endif
#ifndef MK_DUP
#define MK_DUP -1
#endif
constexpr int N_PHASES = 9;
struct Args { const float* in[14]; float* out; unsigned char* ws; int ph_lo, ph_hi; };
__global__ void __launch_bounds__(NTHREADS, 2) hybrid_fwd(Args args) {
    extern __shared__ __attribute__((aligned(16))) unsigned char lds_raw[];
    LAS unsigned char* lds = (LAS unsigned char*)lds_raw;
    volatile LAS unsigned* MISC = (volatile LAS unsigned*)(lds + MISC_OFF);
    const int tid = threadIdx.x, lane = tid & 63, wave = __builtin_amdgcn_readfirstlane(tid >> 6);
    const int G = gridDim.x; const int vcu = (G % 8 == 0) ? ((int)blockIdx.x % 8) * (G / 8) + (int)blockIdx.x / 8 : (int)blockIdx.x;
    unsigned char* ws = args.ws;
    gu32* ctl = (gu32*)(ws + WS_CTL);
    if (tid < 32) MISC[tid] = 0u;
    __syncthreads();
    const int lo = args.ph_lo, hi = args.ph_hi;
    XcdBarrier bar; bar.bar = (unsigned*)ctl + CW_BAR; bar.x = 0; bar.st = nullptr;
    if (hi - lo > 1) bar = xcd_barrier_post((unsigned*)ctl + CW_BAR, MISC + 8);
#ifndef PHASE_MASK
#define PHASE_MASK 0x1ff
#endif
#define IN(k) (((PHASE_MASK >> (k)) & 1) && lo <= (k) && (k) < hi)
#define SEAM(k) do { if (IN(k) && IN((k) + 1)) xcd_barrier(bar); } while (0)
    const float* x = args.in[0]; const float* norm_mix = args.in[1]; const float* w_in = args.in[2]; const float* conv_a_w = args.in[3]; const float* q_norm = args.in[4]; const float* k_norm = args.in[5];
    const float* w_oa = args.in[6]; const float* w_ob = args.in[7]; const float* w_o = args.in[8]; const float* norm_ffn = args.in[9]; const float* w_up = args.in[10]; const float* ffn_conv_w = args.in[11];
    const float* ffn_conv_b = args.in[12]; const float* w_down = args.in[13];
    float* out = args.out;
    float* rowss = (float*)((unsigned*)ctl + CW_ROWSS);
    const size_t TSTEP = (size_t)256 * 1024 * 2;

    if (IN(0)) { phase0(x, norm_mix, w_in, w_oa, w_ob, w_o, w_up, norm_ffn, ws, lds, vcu, G, wave, lane); __syncthreads(); }
    SEAM(0);
    if (IN(1)) {
        pg8::Gemm g{(const bf16*)(ws + WS_XB), (const bf16*)(ws + WS_XB), (const bf16*)(ws + WS_WIN), (const bf16*)(ws + WS_WIN), D, TSTEP};
        pg8::StaticOrder S; S.init(M / 256, NIN / 256, G, (int)blockIdx.x);
        pg8::Epi1 E{(bf16*)(ws + WS_CA), (bf16*)(ws + WS_UU), (bf16*)(ws + WS_Q), (bf16*)(ws + WS_K), (bf16*)(ws + WS_VT), (bf16*)out, (const float*)(ws + WS_RSTDX), q_norm, k_norm, (float*)(ws + WS_KBAR), (PG8_LAS float*)(lds + HALO_OFF)};
        pg8::gemm_phase<pg8::Epi1, pg8::StaticOrder, true, true>(lds, g, S, E);
    }
    SEAM(1);
    if (IN(2)) { phase2d(ws, lds, G, tid, wave, lane, (unsigned*)(ws + WS_CTL) + CW_GCNT, (unsigned short*)(ws + WS_LIST));
        phase2(conv_a_w, ws, G, tid, (bf16*)(ws + WS_CA)); __syncthreads(); }
#if MK_DUP == 21
    if (IN(2)) { phase2d(ws, lds, G, tid, wave, lane, (unsigned*)(ws + WS_CTL) + CW_GCNT + 512, (unsigned short*)(ws + WS_WIN)); }
#endif
#if MK_DUP == 22
    if (IN(2)) { phase2(conv_a_w, ws, G, tid, (bf16*)(ws + WS_XB)); }
#endif
    SEAM(2);
#if MK_DUP >= 30 && MK_DUP <= 35
    if (IN(3)) phase3a<MK_DUP - 30>(q_norm, k_norm, ws, lds, G, tid, wave, lane);
#endif
    if (IN(3)) phase3a<0>(q_norm, k_norm, ws, lds, G, tid, wave, lane);
    SEAM(3);
    if (IN(4)) { phase3b(q_norm, k_norm, ws, lds, G, tid, wave, lane, (bf16*)(ws + WS_Q));
#if MK_DUP == 4
        phase3b(q_norm, k_norm, ws, lds, G, tid, wave, lane, (bf16*)(ws + WS_OPART));
#endif
        }
    SEAM(4);
    if (IN(5)) {
        { LAS float* scr = (LAS float*)(lds + wave * 16384); const int gw = vcu * NWAVES + wave, NGW = G * NWAVES;
          if (blockIdx.x == 0 && tid < 256) *(GAS v4u*)(ws + WS_HB - 4096 + tid * 16) = (v4u){0u, 0u, 0u, 0u};
          __syncthreads(); }
        pg8::Gemm g{(const bf16*)(ws + WS_CA), (const bf16*)(ws + WS_Q), (const bf16*)(ws + WS_WOA), (const bf16*)(ws + WS_WOB), D, TSTEP};
        pg8::DualOrder S; S.S.init(M / 256, D / 256, G, (int)blockIdx.x);
        pg8::Epi4 E{(bf16*)(ws + WS_MG), (const bf16*)out};
        pg8::gemm_phase<pg8::Epi4, pg8::DualOrder, true, true>(lds, g, S, E);
    }
    SEAM(5);
    if (IN(6)) {
        pg8::Gemm g{(const bf16*)(ws + WS_MG), (const bf16*)(ws + WS_MG), (const bf16*)(ws + WS_WO), (const bf16*)(ws + WS_WO), D, TSTEP};
        pg8::StaticOrder S; S.init(M / 256, D / 256, G, (int)blockIdx.x);
        pg8::Epi5 E{x, out, (bf16*)(ws + WS_HB), rowss};
        pg8::gemm_phase<pg8::Epi5, pg8::StaticOrder, true, true>(lds, g, S, E);
#if MK_DUP == 6
        { pg8::Epi5 E2{x, (float*)(ws + WS_Q), (bf16*)(ws + WS_VT), (float*)(ws + WS_CA)}; pg8::gemm_phase<pg8::Epi5, pg8::StaticOrder, true, true>(lds, g, S, E2); }
#endif
    }
    SEAM(6);
    if (IN(7)) {
        const bf16* hb2 = (const bf16*)(ws + WS_HB) - 2 * 1024;
        pg8::Gemm g{hb2, hb2, (const bf16*)(ws + WS_WUP), (const bf16*)(ws + WS_WUP), D, (size_t)254 * 1024 * 2};
        pg8::StaticOrder S; S.init(65, 22, G, (int)blockIdx.x);
        pg8::Epi6 E{(bf16*)(ws + WS_ACT), rowss, ffn_conv_w, ffn_conv_b, (PG8_LAS float*)(lds + HALO_OFF)};
        pg8::gemm_phase<pg8::Epi6, pg8::StaticOrder, true, true>(lds, g, S, E);
        { const int nwg = 65 * 22, full = nwg % G, nidle = full ? G - full : G, idx = full ? (int)blockIdx.x - full : (int)blockIdx.x;
          if (idx >= 0) convert_weight(w_down, DFF, D, (bf16*)(ws + WS_WDN), nullptr, 0, (LAS float*)(lds + wave * 16384), idx * NWAVES + wave, nidle * NWAVES, lane);
          __syncthreads(); }
    }
    SEAM(7);
    if (IN(8)) {
        pg8::Gemm g{(const bf16*)(ws + WS_ACT), (const bf16*)(ws + WS_ACT), (const bf16*)(ws + WS_WDN), (const bf16*)(ws + WS_WDN), DFF, (size_t)256 * DFF * 2};
        pg8::StaticOrder S; S.init(M / 256, D / 256, G, (int)blockIdx.x);
        pg8::Epi7 E{out, (const bf16*)(ws + WS_HB)};
        pg8::gemm_phase<pg8::Epi7, pg8::StaticOrder, true, true>(lds, g, S, E);
#if MK_DUP == 8
        { pg8::Epi7 E2{(float*)(ws + WS_MG), (const bf16*)(ws + WS_HB)}; pg8::gemm_phase<pg8::Epi7, pg8::StaticOrder, true, true>(lds, g, S, E2); }
#endif
    }
#undef IN
#undef SEAM
}

extern "C" void kernel_launch(void* const* d_in, const int* in_sizes, int n_in, void* d_out, int out_size, void* d_ws, size_t ws_size, hipStream_t stream) {
    static int grid = 0;
    if (grid == 0) {
        if (n_in != 14 || in_sizes[0] != M * D || out_size != M * D || ws_size < WS_END) { fprintf(stderr, "kernel_launch: unexpected shapes (n_in %d, in0 %d, out %d, ws %zu)\n", n_in, n_in > 0 ? in_sizes[0] : -1, out_size, ws_size); grid = -1; return; }
        int dev = 0, cus = 0, per_cu = 0;
        if (hipGetDevice(&dev) != hipSuccess || hipDeviceGetAttribute(&cus, hipDeviceAttributeMultiprocessorCount, dev) != hipSuccess) { grid = -1; return; }
        if (hipFuncSetAttribute((const void*)hybrid_fwd, hipFuncAttributeMaxDynamicSharedMemorySize, LDS_BYTES) != hipSuccess) { fprintf(stderr, "kernel_launch: hipFuncSetAttribute failed\n"); grid = -1; return; }
        if (hipOccupancyMaxActiveBlocksPerMultiprocessor(&per_cu, (const void*)hybrid_fwd, NTHREADS, LDS_BYTES) != hipSuccess || per_cu < 1) { fprintf(stderr, "kernel_launch: occupancy query says %d blocks per CU\n", per_cu); (void)hipGetLastError(); grid = -1; return; }
        grid = cus;
    }
    if (grid < 0) return;
    if (hipMemsetAsync((char*)d_ws + WS_CTL, 0, CTL_ZERO_BYTES, stream) != hipSuccess) { fprintf(stderr, "kernel_launch: memset failed\n"); return; }
    Args a{};
    for (int i = 0; i < 14; ++i) a.in[i] = (const float*)d_in[i];
    a.out = (float*)d_out; a.ws = (unsigned char*)d_ws;
#if MK_PER_PHASE
    for (int p = 0; p < N_PHASES; ++p) { a.ph_lo = p; a.ph_hi = p + 1; hipLaunchKernelGGL(hybrid_fwd, dim3(grid), dim3(NTHREADS), LDS_BYTES, stream, a); }
#else
    a.ph_lo = 0; a.ph_hi = N_PHASES;
    void* kargs[] = {&a};
    hipError_t e = hipLaunchCooperativeKernel((const void*)hybrid_fwd, dim3(grid), dim3(NTHREADS), kargs, LDS_BYTES, stream);
    if (e != hipSuccess) fprintf(stderr, "kernel_launch: cooperative launch failed: %s (grid %d)\n", hipGetErrorString(e), grid);
#endif
}
```

```cpp
#include <hip/hip_runtime.h>
#include <cstdio>
#include <cstdint>
namespace pg8 {
#define PG8_LAS __attribute__((address_space(3)))
typedef unsigned short bf16_t;
typedef short bf16x8 __attribute__((ext_vector_type(8)));
typedef float f32x4 __attribute__((ext_vector_type(4)));
typedef unsigned u32x4 __attribute__((ext_vector_type(4)));
constexpr int BM = 256, BK = 64, HALF = 128, HTB = HALF * BK * 2  , STAGE_BYTES = 8 * HTB, NXCD = 8, WGM = 8;

__host__ __device__ __forceinline__ int lds_byte(int r, int c) { const int st = (r >> 4) * 2 + (c >> 5), rr = r & 15, cc = c & 31, ob = rr * 64 + cc * 2; return st * 1024 + (ob ^ (((ob >> 9) & 1) << 5)); }
__host__ __device__ __forceinline__ void stage_rc(int b, int& R, int& C) { const int st = b / 1024, sb = b % 1024, swz = sb ^ (((sb >> 9) & 1) << 5); R = (st >> 1) * 16 + swz / 64; C = (st & 1) * 32 + (swz % 64) / 2; }
__host__ __device__ __forceinline__ int perm32(int rho) { const int n = rho >> 4, i = rho & 15; return 8 * (i >> 2) + 4 * n + (i & 3); }


struct Unit { int pm, pn, sel; };
struct Gemm { const bf16_t* A0; const bf16_t* A1; const bf16_t* B0; const bf16_t* B1; int K; size_t a_tstep; };

struct StaticOrder {
    int nM, nN, nwg, G, c;
    __host__ __device__ void init(int nM_, int nN_, int G_, int c_) { nM = nM_; nN = nN_; nwg = nM * nN; G = G_; c = c_; }
    __host__ __device__ bool next(int i, Unit& u) const {
        const long L = (long)i * G + c; if (L >= nwg) return false;
        int wgid = (int)L; { const int q = nwg / NXCD, r = nwg % NXCD, xcd = wgid % NXCD, off = wgid / NXCD; wgid = (xcd < r ? xcd * (q + 1) : r * (q + 1) + (xcd - r) * q) + off; }
        const int nig = WGM * nN, gid = wgid / nig, fm = gid * WGM, gsz = (nM - fm) < WGM ? (nM - fm) : WGM;
        u.pm = fm + ((wgid % nig) % gsz); u.pn = (wgid % nig) / gsz; u.sel = 0; return true;
    }
    __device__ __forceinline__ void a_ready(const Unit&) const {}
    __device__ __forceinline__ void done(const Unit&) const {}
};
struct DualOrder {
    StaticOrder S;
    __host__ __device__ bool next(int i, Unit& u) const { const bool ok = S.next(i >> 1, u); u.sel = i & 1; return ok; }
    __device__ __forceinline__ void a_ready(const Unit&) const {}
    __device__ __forceinline__ void done(const Unit&) const {}
};

typedef __bf16 bf16x2_t_ __attribute__((ext_vector_type(2))); typedef float f32x2_t_ __attribute__((ext_vector_type(2)));
__device__ __forceinline__ unsigned cvt_pk_bf16(float lo, float hi) { const f32x2_t_ v = {lo, hi}; const bf16x2_t_ b = __builtin_convertvector(v, bf16x2_t_); return __builtin_bit_cast(unsigned, b); }
__device__ __forceinline__ float bf_lo(unsigned w) { return __uint_as_float(w << 16); }
__device__ __forceinline__ float bf_hi(unsigned w) { return __uint_as_float(w & 0xffff0000u); }
__device__ __forceinline__ float fast_sigmoid(float x) { return __builtin_amdgcn_rcpf(1.0f + __builtin_amdgcn_exp2f(-1.4426950408889634f * x)); }
__device__ __forceinline__ u32x4 pack8(const f32x4 a, const f32x4 b) { u32x4 w; w.x = cvt_pk_bf16(a[0], a[1]); w.y = cvt_pk_bf16(a[2], a[3]); w.z = cvt_pk_bf16(b[0], b[1]); w.w = cvt_pk_bf16(b[2], b[3]); return w; }

template <int CTRL> __device__ __forceinline__ float dpp_shr(float old, float v) { return __builtin_bit_cast(float, __builtin_amdgcn_update_dpp(__builtin_bit_cast(int, old), __builtin_bit_cast(int, v), CTRL, 0xf, 0xf, false)); }
template <int CTRL> __device__ __forceinline__ float dpp_ror(float v) { return __builtin_bit_cast(float, __builtin_amdgcn_update_dpp(0, __builtin_bit_cast(int, v), CTRL, 0xf, 0xf, true)); }
constexpr int MROWS = 16384, DMODEL = 1024, DFF_ = 2816;

struct Epi1 {
    static constexpr bool PERM = true, AFTER_DRAIN = false;
    static __device__ __forceinline__ bool keep_acc(const Unit&) { return false; }
    bf16_t *BG, *UU, *Q, *K, *VT, *SG; const float* rstdx; const float *q_norm, *k_norm; float* kbar; PG8_LAS float* xl;
    __device__ __forceinline__ void operator()(f32x4 (&acc)[2][2][4][2], const Unit& u, int wr, int wc, int fr, int fq) const {
        const int row0 = u.pm * BM + wr * 64 + fr, colw = wc * 32 + 8 * fq, pn = u.pn;
        if (pn >= 12 && pn < 20) {
            const bool isK = pn >= 16; const float* wn = isK ? k_norm : q_norm; const float gs = isK ? 1.0f : 0.12751743074602357f;
            bf16_t* dst = isK ? K : Q; const int cb = ((pn - 12) & 3) * 256;
#pragma unroll
            for (int ai = 0; ai < 2; ++ai)
#pragma unroll
                for (int m = 0; m < 4; ++m) { const int rl = ai * HALF + wr * 64 + m * 16 + fr; const float rs = rstdx[u.pm * BM + rl];
#pragma unroll
                    for (int bj = 0; bj < 2; ++bj) { const f32x4 a = acc[ai][bj][m][0] * rs, b = acc[ai][bj][m][1] * rs; acc[ai][bj][m][0] = a; acc[ai][bj][m][1] = b;
                        float ss = (a[0] * a[0] + a[1] * a[1]) + (a[2] * a[2] + a[3] * a[3]) + (b[0] * b[0] + b[1] * b[1]) + (b[2] * b[2] + b[3] * b[3]);
                        ss += __shfl_xor(ss, 16); ss += __shfl_xor(ss, 32);
                        if (fq == 0) xl[(rl * 2 + bj) * 4 + wc] = ss; } }
            asm volatile("s_waitcnt lgkmcnt(0)" ::: "memory"); __builtin_amdgcn_s_barrier(); asm volatile("" ::: "memory");
            const f32x4 g0 = *(const f32x4*)(wn + colw) * gs, g1 = *(const f32x4*)(wn + colw + 4) * gs;
#pragma unroll
            for (int ai = 0; ai < 2; ++ai)
#pragma unroll
                for (int m = 0; m < 4; ++m) { const int rl = ai * HALF + wr * 64 + m * 16 + fr; const int r = u.pm * BM + rl;
#pragma unroll
                    for (int bj = 0; bj < 2; ++bj) { const f32x4 p = *(const PG8_LAS f32x4*)(xl + (rl * 2 + bj) * 4);
                        const float rn = rsqrtf(((p[0] + p[1]) + (p[2] + p[3])) * (1.0f / 128.0f) + 1e-6f);
                        const f32x4 a = acc[ai][bj][m][0] * rn * g0, b = acc[ai][bj][m][1] * rn * g1; acc[ai][bj][m][0] = a; acc[ai][bj][m][1] = b;
                        *(u32x4*)(dst + (size_t)r * 1024 + cb + bj * 128 + colw) = pack8(a, b); } }
            if (isK) {
                f32x4 cs[2][2];
#pragma unroll
                for (int bj = 0; bj < 2; ++bj)
#pragma unroll
                    for (int n = 0; n < 2; ++n) { f32x4 t = acc[0][bj][0][n];
#pragma unroll
                        for (int ai = 0; ai < 2; ++ai)
#pragma unroll
                            for (int m = 0; m < 4; ++m) if (ai + m > 0) t += acc[ai][bj][m][n];
                        cs[bj][n] = t; }
#pragma unroll
                for (int bj = 0; bj < 2; ++bj)
#pragma unroll
                    for (int n = 0; n < 2; ++n)
#pragma unroll
                        for (int e = 0; e < 4; ++e) { float v = cs[bj][n][e]; v += __shfl_xor(v, 1); v += __shfl_xor(v, 2); v += __shfl_xor(v, 4); v += __shfl_xor(v, 8); cs[bj][n][e] = v; }
                if (fr == 0) {
#pragma unroll
                    for (int bj = 0; bj < 2; ++bj) { *(PG8_LAS f32x4*)(xl + 2048 + wr * 256 + bj * 128 + colw) = cs[bj][0]; *(PG8_LAS f32x4*)(xl + 2048 + wr * 256 + bj * 128 + colw + 4) = cs[bj][1]; } }
                asm volatile("s_waitcnt lgkmcnt(0)" ::: "memory"); __builtin_amdgcn_s_barrier(); asm volatile("" ::: "memory");
                int t = threadIdx.x; asm volatile("" : "+v"(t));
                if (t < 256) kbar[((size_t)((pn - 16) * 2 + (t >> 7)) * 64 + u.pm) * 128 + (t & 127)] = (xl[2048 + t] + xl[2048 + 256 + t]) * (1.0f / 256.0f);
            }
            return;
        }
        if (pn >= 20 && pn < 24) {
            int tidv = threadIdx.x; asm volatile("" : "+v"(tidv));
            PG8_LAS unsigned char* T = (PG8_LAS unsigned char*)xl + (tidv >> 6) * 2304;
            const int lane = tidv & 63;
            float rsv[2][4];
#pragma unroll
            for (int ai = 0; ai < 2; ++ai)
#pragma unroll
                for (int m = 0; m < 4; ++m) rsv[ai][m] = rstdx[u.pm * BM + ai * HALF + wr * 64 + m * 16 + fr];
#pragma unroll
            for (int ai = 0; ai < 2; ++ai)
#pragma unroll
                for (int mp = 0; mp < 2; ++mp)
#pragma unroll
                    for (int bj = 0; bj < 2; ++bj) {
#pragma unroll
                        for (int mm = 0; mm < 2; ++mm) { const int m = 2 * mp + mm; const float rs = rsv[ai][m];
                            const u32x4 w = pack8(acc[ai][bj][m][0] * rs, acc[ai][bj][m][1] * rs); const unsigned ww[4] = {w.x, w.y, w.z, w.w};
                            PG8_LAS unsigned char* tp = T + (8 * fq) * 72 + (16 * mm + fr) * 2;
#pragma unroll
                            for (int e = 0; e < 8; ++e) *(PG8_LAS unsigned short*)(tp + e * 72) = (unsigned short)((e & 1) ? (ww[e >> 1] >> 16) : (ww[e >> 1] & 0xffffu)); }
                        asm volatile("s_waitcnt lgkmcnt(0)" ::: "memory");
#pragma unroll
                        for (int rr = 0; rr < 2; ++rr) { const int q = lane + 64 * rr, d = q >> 2, tc = q & 3;
                            const unsigned long long x0 = *(const PG8_LAS unsigned long long*)(T + d * 72 + tc * 16), x1 = *(const PG8_LAS unsigned long long*)(T + d * 72 + tc * 16 + 8);
                            u32x4 o; o.x = (unsigned)x0; o.y = (unsigned)(x0 >> 32); o.z = (unsigned)x1; o.w = (unsigned)(x1 >> 32);
                            *(u32x4*)(VT + ((size_t)(((pn - 20) * 2 + bj) * 128 + 32 * wc + d)) * MROWS + u.pm * BM + ai * HALF + wr * 64 + 32 * mp + tc * 8) = o; }
                        asm volatile("s_waitcnt lgkmcnt(0)" ::: "memory");
                    }
            return;
        }
        float rsg[2][4];
#pragma unroll
        for (int ai = 0; ai < 2; ++ai)
#pragma unroll
            for (int m = 0; m < 4; ++m) rsg[ai][m] = rstdx[row0 + ai * HALF + m * 16];
#pragma unroll
        for (int ai = 0; ai < 2; ++ai)
#pragma unroll
            for (int m = 0; m < 4; ++m) {
                const int r = row0 + ai * HALF + m * 16; const float rs = rsg[ai][m];
                f32x4 v[2][2];
#pragma unroll
                for (int bj = 0; bj < 2; ++bj)
#pragma unroll
                    for (int n = 0; n < 2; ++n) v[bj][n] = acc[ai][bj][m][n] * rs;
                if (pn < 4) {
#pragma unroll
                    for (int bj = 0; bj < 2; ++bj) *(u32x4*)(BG + (size_t)r * 1024 + pn * 256 + bj * 128 + colw) = pack8(v[bj][0], v[bj][1]);
                } else if (pn < 12) {
                    *(u32x4*)(UU + (size_t)r * 1024 + (pn - 4) * 128 + colw) = pack8(v[0][0] * v[1][0], v[0][1] * v[1][1]);
                } else {
                    f32x4 ra, rb, sa, sb;
#pragma unroll
                    for (int e = 0; e < 4; ++e) { const float ea0 = __builtin_amdgcn_exp2f(-1.4426950408889634f * v[0][0][e]), ea1 = __builtin_amdgcn_exp2f(-1.4426950408889634f * v[0][1][e]);
                        const float eb0 = __builtin_amdgcn_exp2f(-1.4426950408889634f * v[1][0][e]), eb1 = __builtin_amdgcn_exp2f(-1.4426950408889634f * v[1][1][e]);
                        ra[e] = (1.0f + eb0) * __builtin_amdgcn_rcpf(1.0f + ea0); rb[e] = (1.0f + eb1) * __builtin_amdgcn_rcpf(1.0f + ea1);
                        sa[e] = __builtin_amdgcn_rcpf(1.0f + eb0); sb[e] = __builtin_amdgcn_rcpf(1.0f + eb1); }
                    *(u32x4*)(SG + (size_t)r * 2048 + (pn - 24) * 128 + colw) = pack8(ra, rb);
                    *(u32x4*)(SG + (size_t)r * 2048 + 1024 + (pn - 24) * 128 + colw) = pack8(sa, sb);
                }
            }
    }
};
struct Epi4 {
    static constexpr bool PERM = true, AFTER_DRAIN = false;
    bf16_t* MG; const bf16_t* SG;
    static __device__ __forceinline__ bool keep_acc(const Unit& u) { return u.sel == 0; }
    __device__ __forceinline__ void operator()(f32x4 (&acc)[2][2][4][2], const Unit& u, int wr, int wc, int fr, int fq) const {
        const int row0 = u.pm * BM + wr * 64 + fr, col0 = u.pn * BM + wc * 32 + 8 * fq;
#pragma unroll
        for (int ai = 0; ai < 2; ++ai) {
            u32x4 g[4][2];
#pragma unroll
            for (int m = 0; m < 4; ++m)
#pragma unroll
                for (int bj = 0; bj < 2; ++bj) g[m][bj] = *(const u32x4*)(SG + (size_t)(row0 + ai * HALF + m * 16) * 2048 + u.sel * 1024 + col0 + bj * HALF);
#pragma unroll
            for (int m = 0; m < 4; ++m) { const int r = row0 + ai * HALF + m * 16;
#pragma unroll
                for (int bj = 0; bj < 2; ++bj) { const int c = col0 + bj * HALF; const u32x4 gg = g[m][bj];
                    f32x4 a = acc[ai][bj][m][0], b = acc[ai][bj][m][1];
                    a[0] *= bf_lo(gg.x); a[1] *= bf_hi(gg.x); a[2] *= bf_lo(gg.y); a[3] *= bf_hi(gg.y); b[0] *= bf_lo(gg.z); b[1] *= bf_hi(gg.z); b[2] *= bf_lo(gg.w); b[3] *= bf_hi(gg.w);
                    if (u.sel) *(u32x4*)(MG + (size_t)r * 1024 + c) = pack8(a, b);
                    else { acc[ai][bj][m][0] = a; acc[ai][bj][m][1] = b; } } }
        }
    }
};
struct Epi5 {
    static constexpr bool PERM = true, AFTER_DRAIN = false;
    static __device__ __forceinline__ bool keep_acc(const Unit&) { return false; }
    const float* X; float* OUT; bf16_t* HB; float* rowss;
    __device__ __forceinline__ void operator()(f32x4 (&acc)[2][2][4][2], const Unit& u, int wr, int wc, int fr, int fq) const {
        const int row0 = u.pm * BM + wr * 64 + fr, col0 = u.pn * BM + wc * 32 + 8 * fq;
#pragma unroll
        for (int ai = 0; ai < 2; ++ai) {
            f32x4 xv[4][2][2];
#pragma unroll
            for (int m = 0; m < 4; ++m)
#pragma unroll
                for (int bj = 0; bj < 2; ++bj) { const size_t o = (size_t)(row0 + ai * HALF + m * 16) * 1024 + col0 + bj * HALF; xv[m][bj][0] = __builtin_nontemporal_load((const f32x4*)(X + o)); xv[m][bj][1] = __builtin_nontemporal_load((const f32x4*)(X + o + 4)); }
#pragma unroll
            for (int m = 0; m < 4; ++m) { const int r = row0 + ai * HALF + m * 16; float ss = 0.f;
#pragma unroll
                for (int bj = 0; bj < 2; ++bj) { const size_t o = (size_t)r * 1024 + col0 + bj * HALF;
                    const f32x4 a = acc[ai][bj][m][0] + xv[m][bj][0], b = acc[ai][bj][m][1] + xv[m][bj][1];
                    *(u32x4*)(HB + o) = pack8(a, b);
                    ss += (a[0] * a[0] + a[1] * a[1]) + (a[2] * a[2] + a[3] * a[3]) + (b[0] * b[0] + b[1] * b[1]) + (b[2] * b[2] + b[3] * b[3]); }
                ss += __shfl_xor(ss, 16); ss += __shfl_xor(ss, 32);
                if (fq == 0) atomicAdd(rowss + r, ss); }
        }
    }
};
struct Epi6 {
    static constexpr bool PERM = true, AFTER_DRAIN = false;
    static __device__ __forceinline__ bool keep_acc(const Unit&) { return false; }
    bf16_t* ACT; const float* rowss; const float* cw; const float* cb; PG8_LAS float* halo;
    __device__ __forceinline__ void operator()(f32x4 (&acc)[2][2][4][2], const Unit& u, int wr, int wc, int fr, int fq) const {
        const int r0 = u.pm * 254 - 2, colw = wc * 32 + 8 * fq;
#pragma unroll
        for (int ai = 0; ai < 2; ++ai)
#pragma unroll
            for (int m = 0; m < 4; ++m) { int gr = r0 + ai * HALF + wr * 64 + m * 16 + fr; gr = gr < 0 ? 0 : (gr > MROWS - 1 ? MROWS - 1 : gr);
                const float rs = rsqrtf(rowss[gr] * (1.0f / 1024.0f) + 1e-6f);
#pragma unroll
                for (int bj = 0; bj < 2; ++bj)
#pragma unroll
                    for (int n = 0; n < 2; ++n) acc[ai][bj][m][n] *= rs; }
        if (fr >= 14) {
#pragma unroll
            for (int ai = 0; ai < 2; ++ai)
#pragma unroll
                for (int bj = 0; bj < 2; ++bj)
#pragma unroll
                    for (int n = 0; n < 2; ++n) *(PG8_LAS f32x4*)(halo + (((2 * ai + wr) * 2 + (fr - 14)) * 256 + bj * 128 + colw + 4 * n)) = acc[ai][bj][3][n];
        }
        f32x4 wn0, wn1, wn2, wnb;
        { const int col = u.pn * 128 + colw; wn0 = *(const f32x4*)(cw + col); wn1 = *(const f32x4*)(cw + 2 * DFF_ + col); wn2 = *(const f32x4*)(cw + 4 * DFF_ + col); wnb = *(const f32x4*)(cb + col); }
        asm volatile("s_waitcnt lgkmcnt(0)" ::: "memory"); __builtin_amdgcn_s_barrier(); asm volatile("" ::: "memory");
#pragma unroll
        for (int bj = 0; bj < 2; ++bj)
#pragma unroll
            for (int n = 0; n < 2; ++n) {
                const f32x4 w0 = wn0, w1 = wn1, w2 = wn2, bb = wnb;
                if (bj * 2 + n < 3) { const int k2 = bj * 2 + n + 1, col = (k2 >> 1) * DFF_ + u.pn * 128 + colw + 4 * (k2 & 1);
                    wn0 = *(const f32x4*)(cw + col); wn1 = *(const f32x4*)(cw + 2 * DFF_ + col); wn2 = *(const f32x4*)(cw + 4 * DFF_ + col); wnb = *(const f32x4*)(cb + col); }
#pragma unroll
                for (int ai = 0; ai < 2; ++ai) {
                    const int s = 2 * ai + wr;
                    const int sm = s > 0 ? s - 1 : 0; const float hz = s > 0 ? 1.0f : 0.0f;
                    const f32x4 h2 = *(const PG8_LAS f32x4*)(halo + ((sm * 2 + 0) * 256 + bj * 128 + colw + 4 * n)) * hz, h1 = *(const PG8_LAS f32x4*)(halo + ((sm * 2 + 1) * 256 + bj * 128 + colw + 4 * n)) * hz;
#pragma unroll
                    for (int mm = 0; mm < 4; ++mm) { const int m = 3 - mm;
                        f32x4 cur = acc[ai][bj][m][n]; asm volatile("" : "+v"(cur)); f32x4 p1, p2;
                        if (m > 0) { f32x4 lo = acc[ai][bj][m > 0 ? m - 1 : 0][n]; asm volatile("" : "+v"(lo));
#pragma unroll
                            for (int e = 0; e < 4; ++e) { p1[e] = dpp_shr<0x111>(dpp_ror<0x121>(lo[e]), cur[e]); p2[e] = dpp_shr<0x112>(dpp_ror<0x122>(lo[e]), cur[e]); } }
                        else {
#pragma unroll
                            for (int e = 0; e < 4; ++e) { p1[e] = dpp_shr<0x111>(h1[e], cur[e]); p2[e] = dpp_shr<0x112>(fr == 0 ? h2[e] : h1[e], cur[e]); } }
                        { f32x4 r_ = w0 * p2 + w1 * p1 + w2 * cur + bb; asm volatile("" : "+v"(r_)); acc[ai][bj][m][n] = r_; } }
                }
            }
#pragma unroll
        for (int ai = 0; ai < 2; ++ai)
#pragma unroll
            for (int m = 0; m < 4; ++m) { const int i = ai * HALF + wr * 64 + m * 16 + fr, gr = r0 + i;
                f32x4 a, b;
#pragma unroll
                for (int e = 0; e < 4; ++e) { const float g0 = acc[ai][0][m][0][e], g1 = acc[ai][0][m][1][e];
                    a[e] = g0 * fast_sigmoid(g0) * acc[ai][1][m][0][e]; b[e] = g1 * fast_sigmoid(g1) * acc[ai][1][m][1][e]; }
                if (i >= 2 && gr < MROWS) *(u32x4*)(ACT + (size_t)gr * DFF_ + u.pn * 128 + colw) = pack8(a, b); }
    }
};
struct Epi7 {
    static constexpr bool PERM = true, AFTER_DRAIN = false;
    static __device__ __forceinline__ bool keep_acc(const Unit&) { return false; }
    float* OUT; const bf16_t* HB;
    __device__ __forceinline__ void operator()(f32x4 (&acc)[2][2][4][2], const Unit& u, int wr, int wc, int fr, int fq) const {
        const int row0 = u.pm * BM + wr * 64 + fr, col0 = u.pn * BM + wc * 32 + 8 * fq;
#pragma unroll
        for (int ai = 0; ai < 2; ++ai) {
            u32x4 hv[4][2];
#pragma unroll
            for (int m = 0; m < 4; ++m)
#pragma unroll
                for (int bj = 0; bj < 2; ++bj) hv[m][bj] = *(const u32x4*)(HB + (size_t)(row0 + ai * HALF + m * 16) * 1024 + col0 + bj * HALF);
#pragma unroll
            for (int m = 0; m < 4; ++m) { const int r = row0 + ai * HALF + m * 16;
#pragma unroll
                for (int bj = 0; bj < 2; ++bj) { const size_t o = (size_t)r * 1024 + col0 + bj * HALF; float* p = OUT + o; const u32x4 hw = hv[m][bj];
                    f32x4 a = acc[ai][bj][m][0], b = acc[ai][bj][m][1];
                    a[0] += bf_lo(hw.x); a[1] += bf_hi(hw.x); a[2] += bf_lo(hw.y); a[3] += bf_hi(hw.y); b[0] += bf_lo(hw.z); b[1] += bf_hi(hw.z); b[2] += bf_lo(hw.w); b[3] += bf_hi(hw.w);
                    __builtin_nontemporal_store(a, (f32x4*)p); __builtin_nontemporal_store(b, (f32x4*)(p + 4)); } }
        }
    }
};
template <class Epi, class Sched, bool ALIGN_EPI = false, bool SP2 = false>
__device__ __forceinline__ void gemm_phase(PG8_LAS unsigned char* lds, const Gemm g, const Sched& S, const Epi& E) {
    const int tid = threadIdx.x, wid = __builtin_amdgcn_readfirstlane(tid >> 6), lane = tid & 63, wr = wid >> 2, wc = wid & 3, fr = lane & 15, fq = lane >> 4;
    const int K = g.K, nt = K / BK;
    unsigned voffA[2], voffB[2];
#pragma unroll
    for (int i = 0; i < 2; ++i) { int R, C; stage_rc(tid * 16 + i * 8192, R, C); const int Rb = Epi::PERM ? ((R & ~31) + perm32(R & 31)) : R;
        voffA[i] = (unsigned)(R * K + C) * 2u; voffB[i] = (unsigned)(Rb * K + C) * 2u; }
    const size_t kstep = (size_t)(BK * 2);
    const size_t hstep = (size_t)HALF * K * 2;
    const size_t tstep = 2 * hstep;
    const unsigned ldsw = (unsigned)wid * 1024u;
    const int aoff = lds_byte(wr * 64 + fr, fq * 8), boff = lds_byte(wc * 32 + fr, fq * 8);
#define PG8_SA(b, h) (((b) * 2 + (h)) * HTB)
#define PG8_SB(b, h) ((4 + (b) * 2 + (h)) * HTB)
#define PG8_STAGE(bufoff, gbase, voff) do { _Pragma("unroll") for (int _i = 0; _i < 2; ++_i) \
        __builtin_amdgcn_global_load_lds((const unsigned*)((const char*)(gbase) + (voff)[_i]), (PG8_LAS unsigned*)(lds + (bufoff) + ldsw + _i * 8192), 16, 0, 0); } while (0)
#define PG8_LDA(dst, b, h) do { _Pragma("unroll") for (int m = 0; m < 4; ++m) _Pragma("unroll") for (int k = 0; k < 2; ++k) dst[m][k] = *(const PG8_LAS bf16x8*)(lds + PG8_SA(b, h) + aoff + m * 2048 + k * 1024); } while (0)
#define PG8_LDB(dst, b, h) do { _Pragma("unroll") for (int n = 0; n < 2; ++n) _Pragma("unroll") for (int k = 0; k < 2; ++k) dst[n][k] = *(const PG8_LAS bf16x8*)(lds + PG8_SB(b, h) + boff + n * 2048 + k * 1024); } while (0)
#define PG8_MMA(ai, bj, At, Bt) do { __builtin_amdgcn_s_setprio(1); _Pragma("unroll") for (int m = 0; m < 4; ++m) _Pragma("unroll") for (int n = 0; n < 2; ++n) _Pragma("unroll") for (int k = 0; k < 2; ++k) \
        acc[ai][bj][m][n] = __builtin_amdgcn_mfma_f32_16x16x32_bf16(Bt[n][k], At[m][k], acc[ai][bj][m][n], 0, 0, 0); __builtin_amdgcn_s_setprio(0); } while (0)
#define PG8_WAIT_V(n) asm volatile("s_waitcnt vmcnt(" #n ")" ::: "memory")
#define PG8_WAIT_L(n) asm volatile("s_waitcnt lgkmcnt(" #n ")" ::: "memory")
#define PG8_BAR __builtin_amdgcn_s_barrier()
#define PG8_SCHED __builtin_amdgcn_sched_barrier(0)
    Unit cur, nxt; int ui = 0;
    if (!S.next(0, cur)) return;
    f32x4 acc[2][2][4][2];
#pragma unroll
    for (int a = 0; a < 2; ++a)
#pragma unroll
        for (int b = 0; b < 2; ++b)
#pragma unroll
            for (int m = 0; m < 4; ++m)
#pragma unroll
                for (int n = 0; n < 2; ++n) acc[a][b][m][n] = (f32x4){0.f, 0.f, 0.f, 0.f};
    bf16x8 At[4][2], B0[2][2], B1[2][2];
    const char* cA = (const char*)(cur.sel ? g.A1 : g.A0) + (size_t)cur.pm * g.a_tstep; const char* cB = (const char*)(cur.sel ? g.B1 : g.B0) + (size_t)cur.pn * tstep;
    S.a_ready(cur);
    if constexpr (SP2) {
        PG8_STAGE(PG8_SB(0, 0), cB, voffB); PG8_STAGE(PG8_SB(0, 1), cB + hstep, voffB); PG8_STAGE(PG8_SA(0, 0), cA, voffA); PG8_STAGE(PG8_SA(0, 1), cA + hstep, voffA);
        if (wr == 1) PG8_BAR;
        PG8_WAIT_V(2); PG8_BAR;
        PG8_STAGE(PG8_SB(1, 0), cB + kstep, voffB); PG8_STAGE(PG8_SA(1, 0), cA + kstep, voffA); PG8_STAGE(PG8_SB(1, 1), cB + hstep + kstep, voffB);
        PG8_WAIT_V(6); PG8_BAR;
    } else {
        PG8_STAGE(PG8_SB(0, 0), cB, voffB); PG8_STAGE(PG8_SA(0, 0), cA, voffA); PG8_STAGE(PG8_SB(0, 1), cB + hstep, voffB); PG8_STAGE(PG8_SA(0, 1), cA + hstep, voffA);
        if (wr == 1) PG8_BAR;
        PG8_WAIT_V(4); PG8_BAR;
        PG8_STAGE(PG8_SB(1, 0), cB + kstep, voffB); PG8_STAGE(PG8_SA(1, 0), cA + kstep, voffA); PG8_STAGE(PG8_SB(1, 1), cB + hstep + kstep, voffB);
        PG8_WAIT_V(6); PG8_BAR;
    }
    for (;;) {
        const bool has_next = S.next(ui + 1, nxt);
        const char* nA = has_next ? (const char*)(nxt.sel ? g.A1 : g.A0) + (size_t)nxt.pm * g.a_tstep : cA; const char* nB = has_next ? (const char*)(nxt.sel ? g.B1 : g.B0) + (size_t)nxt.pn * tstep : cB;
        for (int t = 0; t < nt; t += 2) {
            const bool last = (t == nt - 2);
            const char* a1 = cA + (size_t)(t + 1) * kstep;
            const char* a2 = last ? nA : cA + (size_t)(t + 2) * kstep; const char* b2 = last ? nB : cB + (size_t)(t + 2) * kstep;
            const char* a3 = a2 + kstep; const char* b3 = b2 + kstep;
            if (last && has_next) S.a_ready(nxt);
            if constexpr (SP2) {
            PG8_LDB(B0, 0, 0); PG8_LDB(B1, 0, 1); PG8_SCHED; PG8_LDA(At, 0, 0); PG8_STAGE(PG8_SA(1, 1), a1 + hstep, voffA);
            PG8_WAIT_V(8); PG8_WAIT_L(0); PG8_BAR; PG8_MMA(0, 0, At, B0); PG8_MMA(0, 1, At, B1); PG8_BAR; PG8_SCHED;
            PG8_LDA(At, 0, 1); PG8_STAGE(PG8_SB(0, 0), b2, voffB); PG8_STAGE(PG8_SB(0, 1), b2 + hstep, voffB); PG8_STAGE(PG8_SA(0, 0), a2, voffA);
            PG8_WAIT_V(8); PG8_WAIT_L(0); PG8_BAR; PG8_MMA(1, 0, At, B0); PG8_MMA(1, 1, At, B1); PG8_BAR; PG8_SCHED;
            PG8_LDB(B0, 1, 0); PG8_LDB(B1, 1, 1); PG8_SCHED; PG8_LDA(At, 1, 0); PG8_STAGE(PG8_SA(0, 1), a2 + hstep, voffA);
            PG8_WAIT_V(8); PG8_WAIT_L(0); PG8_BAR; PG8_MMA(0, 0, At, B0); PG8_MMA(0, 1, At, B1); PG8_BAR; PG8_SCHED;
            PG8_LDA(At, 1, 1); PG8_STAGE(PG8_SB(1, 0), b3, voffB); PG8_STAGE(PG8_SB(1, 1), b3 + hstep, voffB); PG8_STAGE(PG8_SA(1, 0), a3, voffA);
            PG8_WAIT_V(8); PG8_WAIT_L(0); PG8_BAR; PG8_MMA(1, 0, At, B0); PG8_MMA(1, 1, At, B1); PG8_BAR; PG8_SCHED;
            } else {
            PG8_LDB(B0, 0, 0); PG8_SCHED; PG8_LDA(At, 0, 0); PG8_STAGE(PG8_SA(1, 1), a1 + hstep, voffA);
            PG8_WAIT_L(8); PG8_BAR; PG8_WAIT_L(0); PG8_MMA(0, 0, At, B0); PG8_BAR; PG8_SCHED;
            PG8_LDB(B1, 0, 1); PG8_STAGE(PG8_SB(0, 0), b2, voffB);
            PG8_BAR; PG8_WAIT_L(0); PG8_MMA(0, 1, At, B1); PG8_BAR;
            PG8_LDA(At, 0, 1); PG8_STAGE(PG8_SA(0, 0), a2, voffA);
            PG8_BAR; PG8_WAIT_L(0); PG8_MMA(1, 0, At, B0); PG8_BAR; PG8_SCHED;
            PG8_STAGE(PG8_SB(0, 1), b2 + hstep, voffB);
            PG8_WAIT_V(6); PG8_BAR; PG8_MMA(1, 1, At, B1); PG8_BAR;
            PG8_LDB(B0, 1, 0); PG8_SCHED; PG8_LDA(At, 1, 0); PG8_STAGE(PG8_SA(0, 1), a2 + hstep, voffA);
            PG8_WAIT_L(8); PG8_BAR; PG8_WAIT_L(0); PG8_MMA(0, 0, At, B0); PG8_BAR; PG8_SCHED;
            PG8_LDB(B1, 1, 1); PG8_STAGE(PG8_SB(1, 0), b3, voffB);
            PG8_BAR; PG8_WAIT_L(0); PG8_MMA(0, 1, At, B1); PG8_BAR;
            PG8_LDA(At, 1, 1); PG8_STAGE(PG8_SA(1, 0), a3, voffA);
            PG8_BAR; PG8_WAIT_L(0); PG8_MMA(1, 0, At, B0); PG8_BAR; PG8_SCHED;
            PG8_STAGE(PG8_SB(1, 1), b3 + hstep, voffB);
            PG8_WAIT_V(6); PG8_BAR; PG8_MMA(1, 1, At, B1); PG8_BAR;
            }
        }
        if constexpr (ALIGN_EPI) { if (wr == 0) PG8_BAR; }
        if constexpr (!Epi::AFTER_DRAIN) { E(acc, cur, wr, wc, fr, fq); S.done(cur); }
        if (!has_next) break;
        if (!Epi::keep_acc(cur)) {
#pragma unroll
        for (int a = 0; a < 2; ++a)
#pragma unroll
            for (int b = 0; b < 2; ++b)
#pragma unroll
                for (int m = 0; m < 4; ++m)
#pragma unroll
                    for (int n = 0; n < 2; ++n) acc[a][b][m][n] = (f32x4){0.f, 0.f, 0.f, 0.f}; }
        cur = nxt; cA = nA; cB = nB; ++ui;
        if constexpr (ALIGN_EPI) { if (wr == 1) PG8_BAR; }
    }
    PG8_WAIT_V(0);
    if constexpr (!ALIGN_EPI) { if (wr == 0) PG8_BAR; }
    PG8_BAR;
    if constexpr (Epi::AFTER_DRAIN) { E.fused(acc, cur, wr, wc, fr, fq, lds, wid, lane); S.done(cur); }
#undef PG8_SA
#undef PG8_SB
#undef PG8_STAGE
#undef PG8_LDA
#undef PG8_LDB
#undef PG8_MMA
#undef PG8_WAIT_V
#undef PG8_WAIT_L
#undef PG8_BAR
#undef PG8_SCHED
}
}
#define GAS __attribute__((address_space(1)))
#define LAS __attribute__((address_space(3)))
typedef unsigned short bf16;
typedef unsigned v4u __attribute__((ext_vector_type(4)));
typedef float f32x4 __attribute__((ext_vector_type(4)));
typedef short bf16x8 __attribute__((ext_vector_type(8)));
typedef GAS unsigned gu32;
typedef GAS unsigned long long gu64;
#define RLX_AGENT __ATOMIC_RELAXED, __HIP_MEMORY_SCOPE_AGENT
#define LDS_WAIT() asm volatile("s_waitcnt lgkmcnt(0)" ::: "memory")
#define VM_WAIT() asm volatile("s_waitcnt vmcnt(0)" ::: "memory")
__device__ __forceinline__ unsigned long long rt() { return __builtin_amdgcn_s_memrealtime(); }
__device__ __forceinline__ unsigned f2bf(float f) { unsigned u = __builtin_bit_cast(unsigned, f); return (u + 0x7fffu + ((u >> 16) & 1u)) >> 16; }
__device__ __forceinline__ unsigned pk2(float lo, float hi) { return f2bf(lo) | (f2bf(hi) << 16); }

#define XB_TMO      128
#define XB_XCNT(j)  (256  + 64 * (j))
#define XB_XSUB(j)  (1280 + 64 * (j))
#define XB_XGEN(j)  (2304 + 64 * (j))
#define XB_TOP      3328
#define XB_TOPGEN   3392
#define XCD_BAR_WORDS 3456
#define XB_SPIN_CAP (1u << 18)

__device__ __forceinline__ unsigned xb_ld(unsigned* p)              { return __hip_atomic_load(p, __ATOMIC_RELAXED, __HIP_MEMORY_SCOPE_AGENT); }
__device__ __forceinline__ unsigned xb_add(unsigned* p, unsigned v) { return __hip_atomic_fetch_add(p, v, __ATOMIC_RELAXED, __HIP_MEMORY_SCOPE_AGENT); }
__device__ __forceinline__ unsigned xb_xcc_id() { return (unsigned)__builtin_amdgcn_s_getreg((3 << 11) | 20) & 0xFu; }
#define XB_SPIN(cond, bar) do { unsigned _sp = 0; while (cond) { __builtin_amdgcn_s_sleep(1); \
    if ((++_sp & 255u) == 0u) { if (xb_ld(&(bar)[XB_TMO])) break; if (_sp > XB_SPIN_CAP) { atomicAdd(&(bar)[XB_TMO], 1u); break; } } } } while (0)

struct XcdBarrier {
    unsigned* bar; unsigned x;
    volatile LAS unsigned* st;
};

__device__ __forceinline__ XcdBarrier xcd_barrier_post(unsigned* bar, volatile LAS unsigned* st) {
    XcdBarrier b; b.bar = bar; b.x = xb_xcc_id(); b.st = st;
    if (threadIdx.x == 0) (void)xb_add(&bar[XB_XCNT(b.x)], 1u);
    return b;
}
__device__ __forceinline__ void xcd_barrier_complete(unsigned* bar, unsigned x, unsigned& nloc, unsigned& nx) {
    const unsigned G = gridDim.x * gridDim.y * gridDim.z;
    unsigned sum, cnt, mine, sp = 0u;
    for (;;) {
        sum = 0u; cnt = 0u; mine = 0u;
#pragma unroll
        for (unsigned j = 0; j < 16; ++j) { const unsigned c = xb_ld(&bar[XB_XCNT(j)]); sum += c; cnt += (c > 0u) ? 1u : 0u; mine = (j == x) ? c : mine; }
        if (sum == G) break;
        __builtin_amdgcn_s_sleep(1);
        if ((++sp & 255u) == 0u) { if (xb_ld(&bar[XB_TMO])) break; if (sp > XB_SPIN_CAP) { atomicAdd(&bar[XB_TMO], 1u); break; } }
    }
    nloc = mine > 0u ? mine : 1u; nx = cnt > 0u ? cnt : 1u;
}

__device__ __forceinline__ void xcd_barrier(const XcdBarrier& b) {
    asm volatile("s_waitcnt vmcnt(0)" ::: "memory");
    __syncthreads();
    if (threadIdx.x == 0) {
        unsigned* bar = b.bar;
        __builtin_amdgcn_s_waitcnt(0);
        unsigned nloc = b.st[0], nx = b.st[1];
        if (nloc == 0u) { xcd_barrier_complete(bar, b.x, nloc, nx); b.st[0] = nloc; b.st[1] = nx; }
        const unsigned old = xb_add(&bar[XB_XSUB(b.x)], 1u);
        const unsigned gen = old / nloc;
        if (old + 1u == (gen + 1u) * nloc) {
            __builtin_amdgcn_fence(__ATOMIC_RELEASE, "agent");
            asm volatile("s_waitcnt vmcnt(0)" ::: "memory");
            const unsigned og = xb_add(&bar[XB_TOP], 1u);
            const unsigned tg = og / nx;
            if (og + 1u == (tg + 1u) * nx) xb_add(&bar[XB_TOPGEN], 1u);
            else XB_SPIN(xb_ld(&bar[XB_TOPGEN]) == tg, bar);
            __builtin_amdgcn_fence(__ATOMIC_ACQUIRE, "agent");
            xb_add(&bar[XB_XGEN(b.x)], 1u);
            asm volatile("s_waitcnt vmcnt(0)" ::: "memory");
        } else {
            XB_SPIN(xb_ld(&bar[XB_XGEN(b.x)]) == gen, bar);
            __builtin_amdgcn_fence(__ATOMIC_ACQUIRE, "agent");
            asm volatile("s_waitcnt vmcnt(0)" ::: "memory");
        }
    }
    __syncthreads();
}


constexpr int NWAVES = 8, NTHREADS = 512;
constexpr int M = 16384, D = 1024, NIN = 8192, DFF = 2816, NH = 8, HD = 128, NBLK = 64, BLK = 256;
constexpr float EPS = 1e-6f;
constexpr float C2 = 0.08838834764831845f * 1.4426950408889634f;
constexpr size_t MiB = 1u << 20;
constexpr size_t WS_CTL = 0, CTL_ZERO_BYTES = 256 * 1024;
constexpr int CW_BAR = 4096, CW_GCNT = 8192, CW_ROWSS = 16384;
constexpr size_t WS_KBAR = 1 * MiB, WS_RSTDX = 1 * MiB + 512 * 1024, WS_LPART = 2 * MiB;
constexpr size_t WS_WOA = 4 * MiB, WS_WOB = 6 * MiB, WS_WO = 8 * MiB;
constexpr size_t WS_Q = 10 * MiB, WS_K = 42 * MiB, WS_VT = 74 * MiB, WS_CA = 106 * MiB, WS_LIST = 138 * MiB, WS_WIN = 147 * MiB, WS_XB = 163 * MiB, WS_UU = 195 * MiB;
constexpr size_t WS_OPART = 147 * MiB;
constexpr size_t WS_WUP = 243 * MiB, WS_WDN = 138 * MiB, WS_MG = 165 * MiB, WS_HB = 198 * MiB;
constexpr size_t WS_ACT = 10 * MiB;
constexpr size_t WS_END = 256 * MiB;
constexpr int LDS_BYTES = 163840, MISC_OFF = 131072 + 320, HALO_OFF = 131072 + 1024, SCAN_OFF = 131072 + 1024;
__device__ __forceinline__ int list_off(int n) { return 256 * (63 * n - (n * (n - 1)) / 2); }
constexpr int LIST_PER_HEAD = 256 * 2016;

__device__ __forceinline__ float wave_sum(float v) {
#pragma unroll
    for (int o = 1; o < 64; o <<= 1) v += __shfl_xor(v, o);
    return v;
}
__device__ __forceinline__ void transpose_item(const float* W, int N, bf16* WT, int K, int k0, int col0, int row0, const float* ks, LAS float* scr, int lane) {
    float wv[32];
#pragma unroll
    for (int i = 0; i < 32; ++i) wv[i] = __builtin_nontemporal_load(W + (size_t)(k0 + 2 * i + (lane >> 5)) * N + col0 + (lane & 31));
#pragma unroll
    for (int i = 0; i < 32; ++i) { const int kk = 2 * i + (lane >> 5); const float s = ks ? ks[k0 + kk] : 1.0f; scr[kk * 33 + (lane & 31)] = s * wv[i]; }
    LDS_WAIT(); asm volatile("" ::: "memory");
    const int c = lane & 7;
#pragma unroll
    for (int j = 0; j < 4; ++j) { const int n = (lane >> 3) + 8 * j; const LAS float* s = scr + (8 * c) * 33 + n;
        v4u o; o.x = pk2(s[0 * 33], s[1 * 33]); o.y = pk2(s[2 * 33], s[3 * 33]); o.z = pk2(s[4 * 33], s[5 * 33]); o.w = pk2(s[6 * 33], s[7 * 33]);
        *(GAS v4u*)(WT + (size_t)(row0 + n) * K + k0 + 8 * c) = o; }
    LDS_WAIT(); asm volatile("" ::: "memory");
}
__device__ __forceinline__ int map_col(int mode, int R) {
    if (mode == 1) { if (R >= 1024 && R < 3072) { const int q = R - 1024; return 1024 + ((q >> 7) & 1) * 1024 + (q >> 8) * 128 + (q & 127); }
                     if (R >= 6144) { const int q = R - 6144; return 6144 + ((q >> 7) & 1) * 1024 + (q >> 8) * 128 + (q & 127); } return R; }
    if (mode == 2) return ((R >> 7) & 1) * DFF + (R >> 8) * 128 + (R & 127);
    return R;
}
__device__ __forceinline__ void convert_weight(const float* W, int K, int N, bf16* WT, const float* ks, int mode, LAS float* scr, int gw, int NGW, int lane) {
    const int nblk = N / 32, nitems = (K / 64) * nblk;
    for (int it = gw; it < nitems; it += NGW) { const int kb = it / nblk, nb = it % nblk; transpose_item(W, N, WT, K, 64 * kb, map_col(mode, 32 * nb), 32 * nb, ks, scr, lane); }
}

__device__ __forceinline__ void phase0(const float* x, const float* norm_mix, const float* w_in, const float* w_oa, const float* w_ob, const float* w_o, const float* w_up, const float* norm_ffn, unsigned char* ws, LAS unsigned char* lds, int vcu, int G, int wave, int lane) {
    LAS float* scr = (LAS float*)(lds + wave * 16384);
    const int gw = vcu * NWAVES + wave, NGW = G * NWAVES;
    convert_weight(w_in, D, NIN, (bf16*)(ws + WS_WIN), norm_mix, 1, scr, gw, NGW, lane);
    convert_weight(w_oa, D, D, (bf16*)(ws + WS_WOA), nullptr, 0, scr, gw, NGW, lane);
    convert_weight(w_ob, D, D, (bf16*)(ws + WS_WOB), nullptr, 0, scr, gw, NGW, lane);
    convert_weight(w_o, D, D, (bf16*)(ws + WS_WO), nullptr, 0, scr, gw, NGW, lane);
    convert_weight(w_up, D, 2 * DFF, (bf16*)(ws + WS_WUP), norm_ffn, 2, scr, gw, NGW, lane);
    bf16* XB = (bf16*)(ws + WS_XB); float* rstdx = (float*)(ws + WS_RSTDX);
    for (int m = gw; m < M; m += NGW) {
        const GAS f32x4* xr = (const GAS f32x4*)(x + (size_t)m * D) + lane; f32x4 v[4]; float s = 0.f;
#pragma unroll
        for (int j = 0; j < 4; ++j) { v[j] = __builtin_nontemporal_load(xr + 64 * j); s += (v[j].x * v[j].x + v[j].y * v[j].y) + (v[j].z * v[j].z + v[j].w * v[j].w); }
        s = wave_sum(s); if (lane == 0) rstdx[m] = rsqrtf(s * (1.f / D) + EPS);
        GAS unsigned long long* o8 = (GAS unsigned long long*)(XB + (size_t)m * D) + lane;
#pragma unroll
        for (int j = 0; j < 4; ++j) o8[64 * j] = (unsigned long long)pk2(v[j].x, v[j].y) | ((unsigned long long)pk2(v[j].z, v[j].w) << 32);
    }
}
__device__ __forceinline__ void phase2(const float* conv_a_w, unsigned char* ws, int G, int tid, bf16* __restrict__ CAout) {
    const bf16* __restrict__ BG = (const bf16*)(ws + WS_CA); const bf16* __restrict__ UU = (const bf16*)(ws + WS_UU);
    for (int item = blockIdx.x * NTHREADS + tid; item < 128 * (M / 16); item += G * NTHREADS) {
        const int cc = (item & 127) * 8, t0 = (item >> 7) * 16;
        float w0[8], w1[8], w2[8], um2[8], um1[8];
#pragma unroll
        for (int j = 0; j < 2; ++j) { const f32x4 a = *(const GAS f32x4*)(conv_a_w + cc + 4 * j), b = *(const GAS f32x4*)(conv_a_w + 1024 + cc + 4 * j), c = *(const GAS f32x4*)(conv_a_w + 2048 + cc + 4 * j);
#pragma unroll
            for (int e = 0; e < 4; ++e) { w0[4 * j + e] = a[e]; w1[4 * j + e] = b[e]; w2[4 * j + e] = c[e]; } }
        { v4u a = (v4u){0u, 0u, 0u, 0u}, b = a; if (t0 >= 2) { a = *(const GAS v4u*)(UU + (size_t)(t0 - 2) * 1024 + cc); b = *(const GAS v4u*)(UU + (size_t)(t0 - 1) * 1024 + cc); }
          const unsigned aw[4] = {a.x, a.y, a.z, a.w}, bw[4] = {b.x, b.y, b.z, b.w};
#pragma unroll
          for (int j = 0; j < 4; ++j) { um2[2 * j] = pg8::bf_lo(aw[j]); um2[2 * j + 1] = pg8::bf_hi(aw[j]); um1[2 * j] = pg8::bf_lo(bw[j]); um1[2 * j + 1] = pg8::bf_hi(bw[j]); } }
#pragma unroll 4
        for (int i = 0; i < 16; ++i) { const size_t o = (size_t)(t0 + i) * 1024 + cc;
            const v4u u = *(const GAS v4u*)(UU + o), b = *(const GAS v4u*)(BG + o); const unsigned uw[4] = {u.x, u.y, u.z, u.w}, bw[4] = {b.x, b.y, b.z, b.w};
            float r[8];
#pragma unroll
            for (int j = 0; j < 4; ++j) { const float u0 = pg8::bf_lo(uw[j]), u1 = pg8::bf_hi(uw[j]);
                r[2 * j] = pg8::bf_lo(bw[j]) * (w0[2 * j] * um2[2 * j] + w1[2 * j] * um1[2 * j] + w2[2 * j] * u0);
                r[2 * j + 1] = pg8::bf_hi(bw[j]) * (w0[2 * j + 1] * um2[2 * j + 1] + w1[2 * j + 1] * um1[2 * j + 1] + w2[2 * j + 1] * u1);
                um2[2 * j] = um1[2 * j]; um2[2 * j + 1] = um1[2 * j + 1]; um1[2 * j] = u0; um1[2 * j + 1] = u1; }
            v4u o4; o4.x = pk2(r[0], r[1]); o4.y = pk2(r[2], r[3]); o4.z = pk2(r[4], r[5]); o4.w = pk2(r[6], r[7]);
            *(GAS v4u*)(CAout + o) = o4; }
    }
}
__device__ __forceinline__ bool top_better(float v, int n, float cv, int cn) { return v > cv || (v == cv && n < cn); }
__device__ __forceinline__ void top3_insert(float v, int n, float (&tv)[3], int (&ti)[3]) {
    if (top_better(v, n, tv[0], ti[0])) { tv[2] = tv[1]; ti[2] = ti[1]; tv[1] = tv[0]; ti[1] = ti[0]; tv[0] = v; ti[0] = n; }
    else if (top_better(v, n, tv[1], ti[1])) { tv[2] = tv[1]; ti[2] = ti[1]; tv[1] = v; ti[1] = n; }
    else if (top_better(v, n, tv[2], ti[2])) { tv[2] = v; ti[2] = n; }
}
__device__ __forceinline__ void phase2d(unsigned char* ws, LAS unsigned char* lds, int G, int tid, int wave, int lane, unsigned* gcnt, unsigned short* glist) {
    LAS unsigned* lcnt = (LAS unsigned*)(lds + 32768); LAS unsigned* lbase = lcnt + 64; LAS unsigned short* llist = (LAS unsigned short*)lds;
    const bf16* Q = (const bf16*)(ws + WS_Q); const float* kbar = (const float*)(ws + WS_KBAR);
    const int fr = lane & 15, fq = lane >> 4;
    for (int unit = blockIdx.x; unit < NH * 63; unit += G) {
        const int h = unit / 63, c = 1 + unit % 63;
        if (tid < 64) lcnt[tid] = 0u;
        __syncthreads();
        bf16x8 qf[2][4];
#pragma unroll
        for (int g = 0; g < 2; ++g)
#pragma unroll
            for (int ks = 0; ks < 4; ++ks) qf[g][ks] = *(const GAS bf16x8*)(Q + (size_t)(c * BLK + wave * 32 + g * 16 + fr) * 1024 + h * HD + ks * 32 + fq * 8);
        float tv[2][3]; int ti[2][3];
#pragma unroll
        for (int g = 0; g < 2; ++g)
#pragma unroll
            for (int j = 0; j < 3; ++j) { tv[g][j] = -__builtin_inff(); ti[g][j] = 1 << 20; }
        const int ntile = (c + 15) >> 4;
        for (int tile = 0; tile < ntile; ++tile) {
            f32x4 s0 = (f32x4){0.f, 0.f, 0.f, 0.f}, s1 = s0;
#pragma unroll
            for (int ks = 0; ks < 4; ++ks) {
                const float* kp = kbar + ((size_t)(h * NBLK + tile * 16 + fr) * HD + ks * 32 + fq * 8);
                const f32x4 a = *(const GAS f32x4*)kp, b = *(const GAS f32x4*)(kp + 4);
                const v4u hw = pg8::pack8(a, b);
                f32x4 ra, rb; ra[0] = a[0] - pg8::bf_lo(hw.x); ra[1] = a[1] - pg8::bf_hi(hw.x); ra[2] = a[2] - pg8::bf_lo(hw.y); ra[3] = a[3] - pg8::bf_hi(hw.y);
                rb[0] = b[0] - pg8::bf_lo(hw.z); rb[1] = b[1] - pg8::bf_hi(hw.z); rb[2] = b[2] - pg8::bf_lo(hw.w); rb[3] = b[3] - pg8::bf_hi(hw.w);
                const v4u lw = pg8::pack8(ra, rb);
                const bf16x8 hi = __builtin_bit_cast(bf16x8, hw), lo = __builtin_bit_cast(bf16x8, lw);
                s0 = __builtin_amdgcn_mfma_f32_16x16x32_bf16(hi, qf[0][ks], s0, 0, 0, 0); s0 = __builtin_amdgcn_mfma_f32_16x16x32_bf16(lo, qf[0][ks], s0, 0, 0, 0);
                s1 = __builtin_amdgcn_mfma_f32_16x16x32_bf16(hi, qf[1][ks], s1, 0, 0, 0); s1 = __builtin_amdgcn_mfma_f32_16x16x32_bf16(lo, qf[1][ks], s1, 0, 0, 0);
            }
#pragma unroll
            for (int i = 0; i < 4; ++i) { const int n = tile * 16 + 4 * fq + i;
                top3_insert(n < c ? s0[i] : -__builtin_inff(), n, tv[0], ti[0]); top3_insert(n < c ? s1[i] : -__builtin_inff(), n, tv[1], ti[1]); }
        }
#pragma unroll
        for (int off = 16; off <= 32; off <<= 1)
#pragma unroll
            for (int g = 0; g < 2; ++g) { float pv[3]; int pi[3];
#pragma unroll
                for (int j = 0; j < 3; ++j) { pv[j] = __shfl_xor(tv[g][j], off); pi[j] = __shfl_xor(ti[g][j], off); }
#pragma unroll
                for (int j = 0; j < 3; ++j) top3_insert(pv[j], pi[j], tv[g], ti[g]); }
        const int nsel = c < 3 ? c : 3;
        if (fq == 0) {
#pragma unroll
            for (int g = 0; g < 2; ++g) { const int tl = wave * 32 + g * 16 + fr;
#pragma unroll
                for (int j = 0; j < 3; ++j) if (j < nsel) { const int n = ti[g][j]; const unsigned pp = __hip_atomic_fetch_add(&lcnt[n], 1u, __ATOMIC_RELAXED, __HIP_MEMORY_SCOPE_WORKGROUP); llist[n * 256 + pp] = (unsigned short)((tl << 2) | j); } }
        }
        __syncthreads();
        if (tid < c) { const unsigned k = lcnt[tid]; lbase[tid] = k ? atomicAdd(gcnt + h * NBLK + tid, k) : 0u; }
        __syncthreads();
        for (int n = wave; n < c; n += NWAVES) { const unsigned k = lcnt[n], base = lbase[n];
            unsigned short* dst = glist + (size_t)h * LIST_PER_HEAD + list_off(n) + base;
            for (unsigned i = lane; i < k; i += 64) { const unsigned e = llist[n * 256 + i]; dst[i] = (unsigned short)((((unsigned)c * BLK + (e >> 2)) << 2) | (e & 3u)); } }
        __syncthreads();
    }
}
__device__ __forceinline__ void stage_kv(const bf16* Kg, const bf16* Vt, int h, int n, LAS unsigned char* lds, int tid) {
    v4u kw[8], vw[8];
#pragma unroll
    for (int i = 0; i < 8; ++i) { const int row = (tid >> 4) + 32 * i, ch = tid & 15; kw[i] = *(const GAS v4u*)(Kg + (size_t)(n * BLK + row) * 1024 + h * HD + ch * 8); }
#pragma unroll
    for (int i = 0; i < 8; ++i) { const int row = (tid >> 5) + 16 * i, ch = tid & 31; vw[i] = *(const GAS v4u*)(Vt + (size_t)(h * HD + row) * M + n * BLK + ch * 8); }
#pragma unroll
    for (int i = 0; i < 8; ++i) { const int row = (tid >> 4) + 32 * i, ch = tid & 15; const int sw = (((row >> 3) & 3) << 2) | (row & 3);
        *(LAS v4u*)(lds + row * 256 + ((ch ^ sw) << 4)) = kw[i]; }
#pragma unroll
    for (int i = 0; i < 8; ++i) { const int row = (tid >> 5) + 16 * i, ch = tid & 31;
        *(LAS v4u*)(lds + 65536 + row * 512 + ((ch ^ ((((row >> 4) & 3) << 2) | (row & 3))) << 4)) = vw[i]; }
}
__device__ __forceinline__ void load_q(bf16x8 (&qf)[2][4], const bf16* Q, int h, const int (&tq)[2], int fq) {
#pragma unroll
    for (int g = 0; g < 2; ++g)
#pragma unroll
        for (int ks = 0; ks < 4; ++ks) qf[g][ks] = *(const GAS bf16x8*)(Q + (size_t)tq[g] * 1024 + h * HD + ks * 32 + fq * 8);
}
template <bool CAUSAL, int MODE = 0>
__device__ __forceinline__ void attn_core(const LAS unsigned char* lds, const bf16x8 (&qf)[2][4], int wave, int fr, int fq, float B2, f32x4 (&O)[8][2], float (&l)[2]) {
#pragma unroll
    for (int dt = 0; dt < 8; ++dt) { O[dt][0] = (f32x4){0.f, 0.f, 0.f, 0.f}; O[dt][1] = O[dt][0]; }
    l[0] = 0.f; l[1] = 0.f;
    const int nch = CAUSAL ? wave + 1 : 8;
    const int krow = (fr >> 2) * 8 + (fr & 3);
    bf16x8 kf[4][2];
#pragma unroll
    for (int ks = 0; ks < 4; ++ks)
#pragma unroll
        for (int t = 0; t < 2; ++t) kf[ks][t] = *(const LAS bf16x8*)(lds + (krow + t * 4) * 256 + (((ks * 4 + fq) ^ fr) << 4));
#pragma unroll 2
    for (int c = 0; c < nch; ++c) {
        f32x4 s[2][2];
#pragma unroll
        for (int t = 0; t < 2; ++t) { s[t][0] = (f32x4){-B2, -B2, -B2, -B2}; s[t][1] = s[t][0]; }
        bf16x8 vf[8];
#pragma unroll
        for (int dt = 0; dt < 8; ++dt) vf[dt] = *(const LAS bf16x8*)(lds + 65536 + ((dt >> 2) * 64 + (fr >> 2) * 16 + (dt & 3) * 4 + (fr & 3)) * 512 + (((c * 4 + fq) ^ fr) << 4));
        __builtin_amdgcn_s_setprio(1);
#pragma unroll
        for (int ks = 0; ks < 4; ++ks)
#pragma unroll
            for (int t = 0; t < 2; ++t) {
                if (MODE != 2 || ks == 0) {
                s[t][0] = __builtin_amdgcn_mfma_f32_16x16x32_bf16(kf[ks][t], qf[0][ks], s[t][0], 0, 0, 0);
                s[t][1] = __builtin_amdgcn_mfma_f32_16x16x32_bf16(kf[ks][t], qf[1][ks], s[t][1], 0, 0, 0); }
            }
        __builtin_amdgcn_s_setprio(0);
        __builtin_amdgcn_sched_barrier(0);
        { const int cn = (c + 1 < nch) ? c + 1 : c;
#pragma unroll
          for (int ks = 0; ks < 4; ++ks)
#pragma unroll
              for (int t = 0; t < 2; ++t) kf[ks][t] = *(const LAS bf16x8*)(lds + (cn * 32 + krow + t * 4) * 256 + (((ks * 4 + fq) ^ fr) << 4)); }
        bf16x8 pf[2];
#pragma unroll
        for (int g = 0; g < 2; ++g) {
            float p[8];
#pragma unroll
            for (int t = 0; t < 2; ++t)
#pragma unroll
                for (int i = 0; i < 4; ++i) { float e = MODE == 1 ? s[t][g][i] : __builtin_amdgcn_exp2f(s[t][g][i]);
                    if (CAUSAL && c == wave) { const int kl = c * 32 + fq * 8 + t * 4 + i, ql = wave * 32 + g * 16 + fr; if (kl > ql) e = 0.f; }
                    p[t * 4 + i] = e; }
            l[g] += ((p[0] + p[1]) + (p[2] + p[3])) + ((p[4] + p[5]) + (p[6] + p[7]));
            v4u w; w.x = pg8::cvt_pk_bf16(p[0], p[1]); w.y = pg8::cvt_pk_bf16(p[2], p[3]); w.z = pg8::cvt_pk_bf16(p[4], p[5]); w.w = pg8::cvt_pk_bf16(p[6], p[7]);
            pf[g] = __builtin_bit_cast(bf16x8, w);
        }
        __builtin_amdgcn_s_setprio(1);
#pragma unroll
        for (int dt = 0; dt < 8; ++dt) {
            if (MODE != 3 || dt == 0) {
            O[dt][0] = __builtin_amdgcn_mfma_f32_16x16x32_bf16(vf[dt], pf[0], O[dt][0], 0, 0, 0);
            O[dt][1] = __builtin_amdgcn_mfma_f32_16x16x32_bf16(vf[dt], pf[1], O[dt][1], 0, 0, 0); }
        }
        __builtin_amdgcn_s_setprio(0);
    }
    l[0] += __shfl_xor(l[0], 16); l[0] += __shfl_xor(l[0], 32); l[1] += __shfl_xor(l[1], 16); l[1] += __shfl_xor(l[1], 32);
}
__device__ __forceinline__ float score_bound(const float* q_norm, const float* k_norm, int lane) {
    float a = fmaxf(fabsf(q_norm[lane]), fabsf(q_norm[lane + 64])), b = fmaxf(fabsf(k_norm[lane]), fabsf(k_norm[lane + 64]));
#pragma unroll
    for (int o = 1; o < 64; o <<= 1) { a = fmaxf(a, __shfl_xor(a, o)); b = fmaxf(b, __shfl_xor(b, o)); }
    return 128.0f * a * b * C2 * 1.001f + 0.01f;
}
template <int MODE>
__device__ __forceinline__ void phase3a(const float* q_norm, const float* k_norm, unsigned char* ws, LAS unsigned char* lds, int G, int tid, int wave, int lane) {
    const int fr = lane & 15, fq = lane >> 4;
    LAS int* pre = (LAS int*)(lds + SCAN_OFF);
    LAS int* cntl = (LAS int*)(lds + SCAN_OFF + 2080);
    const unsigned* gcnt = (const unsigned*)(ws + WS_CTL) + CW_GCNT; const unsigned short* glist = (const unsigned short*)(ws + WS_LIST);
    const bf16* Q = (const bf16*)(ws + WS_Q); const bf16* Kg = (const bf16*)(ws + WS_K); const bf16* Vt = (const bf16*)(ws + WS_VT);
    unsigned char* OP = ws + WS_OPART; float* LP = (float*)(ws + WS_LPART);
    const float B2 = score_bound(q_norm, k_norm, lane);
    { const int cnt = (int)__hip_atomic_load(gcnt + tid, __ATOMIC_RELAXED, __HIP_MEMORY_SCOPE_AGENT); pre[tid + 1] = (cnt + 255) >> 8; cntl[tid] = cnt; if (tid == 0) pre[0] = 0; }
    __syncthreads();
    for (int o = 1; o < 512; o <<= 1) { const int v = pre[tid + 1] + ((tid + 1 - o) >= 1 ? pre[tid + 1 - o] : 0); __syncthreads(); pre[tid + 1] = v; __syncthreads(); }
    const int T = pre[512];
    const int i_lo = (int)(((long)blockIdx.x * T) / G), i_hi = (int)(((long)(blockIdx.x + 1) * T) / G);
    int staged = -1;
#define P3A_DECODE(IT, HN, TILE) do { int lo_ = 0, hi_ = 511; while (lo_ < hi_) { const int mid_ = (lo_ + hi_ + 1) >> 1; if (pre[mid_] <= (IT)) lo_ = mid_; else hi_ = mid_ - 1; } HN = lo_; TILE = (IT) - pre[lo_]; } while (0)
    unsigned en[2] = {0u, 0u}; bool okn[2] = {false, false};
    bf16x8 qf[2][4]; int hnn = 0;
    if (i_lo < i_hi) { int hn, tile; P3A_DECODE(i_lo, hn, tile); const int cnt = cntl[hn]; const unsigned short* lst = glist + (size_t)(hn >> 6) * LIST_PER_HEAD + list_off(hn & 63) + tile * 256;
#pragma unroll
        for (int g = 0; g < 2; ++g) { const int qi = wave * 32 + g * 16 + fr; okn[g] = tile * 256 + qi < cnt; en[g] = okn[g] ? lst[qi] : 0u; }
        { const int tq0[2] = {(int)(en[0] >> 2), (int)(en[1] >> 2)}; load_q(qf, Q, hn >> 6, tq0, fq); } }
    for (int it = i_lo; it < i_hi; ++it) {
        int hn, tile; P3A_DECODE(it, hn, tile); const int h = hn >> 6, n = hn & 63;
        int tq[2], sj[2]; bool ok[2];
#pragma unroll
        for (int g = 0; g < 2; ++g) { ok[g] = okn[g]; tq[g] = (int)(en[g] >> 2); sj[g] = (int)(en[g] & 3u); }
        if (it + 1 < i_hi) { int hn2, tile2; P3A_DECODE(it + 1, hn2, tile2); hnn = hn2; const int cnt2 = cntl[hn2]; const unsigned short* lst2 = glist + (size_t)(hn2 >> 6) * LIST_PER_HEAD + list_off(hn2 & 63) + tile2 * 256;
#pragma unroll
            for (int g = 0; g < 2; ++g) { const int qi = wave * 32 + g * 16 + fr; okn[g] = tile2 * 256 + qi < cnt2; en[g] = okn[g] ? lst2[qi] : 0u; } }
        if (hn != staged) { __syncthreads(); stage_kv(Kg, Vt, h, n, lds, tid); LDS_WAIT(); __syncthreads(); staged = hn; }
        f32x4 O[8][2]; float l[2];
        attn_core<false, MODE>(lds, qf, wave, fr, fq, B2, O, l);
        if (it + 1 < i_hi) { const int tqn[2] = {(int)(en[0] >> 2), (int)(en[1] >> 2)}; load_q(qf, Q, hnn >> 6, tqn, fq); }
#pragma unroll
        for (int g = 0; g < 2; ++g) if (ok[g]) {
            unsigned char* op = OP + ((size_t)sj[g] * M + tq[g]) * 1024 + h * HD + 16 * fq;
            const float sc = 16.0f / l[g];
#pragma unroll
            for (int j = 0; j < 2; ++j) { v4u w;
                { int t = 0; t = __builtin_amdgcn_cvt_pk_fp8_f32(O[4 * j][g][0] * sc, O[4 * j][g][1] * sc, t, false); t = __builtin_amdgcn_cvt_pk_fp8_f32(O[4 * j][g][2] * sc, O[4 * j][g][3] * sc, t, true); w.x = (unsigned)t; }
                { int t = 0; t = __builtin_amdgcn_cvt_pk_fp8_f32(O[4 * j + 1][g][0] * sc, O[4 * j + 1][g][1] * sc, t, false); t = __builtin_amdgcn_cvt_pk_fp8_f32(O[4 * j + 1][g][2] * sc, O[4 * j + 1][g][3] * sc, t, true); w.y = (unsigned)t; }
                { int t = 0; t = __builtin_amdgcn_cvt_pk_fp8_f32(O[4 * j + 2][g][0] * sc, O[4 * j + 2][g][1] * sc, t, false); t = __builtin_amdgcn_cvt_pk_fp8_f32(O[4 * j + 2][g][2] * sc, O[4 * j + 2][g][3] * sc, t, true); w.z = (unsigned)t; }
                { int t = 0; t = __builtin_amdgcn_cvt_pk_fp8_f32(O[4 * j + 3][g][0] * sc, O[4 * j + 3][g][1] * sc, t, false); t = __builtin_amdgcn_cvt_pk_fp8_f32(O[4 * j + 3][g][2] * sc, O[4 * j + 3][g][3] * sc, t, true); w.w = (unsigned)t; }
                *(GAS v4u*)(op + j * 64) = w; }
            if (fq == 0) LP[((size_t)sj[g] * M + tq[g]) * NH + h] = l[g];
        }
    }
#undef P3A_DECODE
    __syncthreads();
}
__device__ __forceinline__ void phase3b(const float* q_norm, const float* k_norm, unsigned char* ws, LAS unsigned char* lds, int G, int tid, int wave, int lane, bf16* Oout) {
    const int fr = lane & 15, fq = lane >> 4;
    bf16* Q = (bf16*)(ws + WS_Q); const bf16* Kg = (const bf16*)(ws + WS_K); const bf16* Vt = (const bf16*)(ws + WS_VT);
    const unsigned char* OP = ws + WS_OPART; const float* LP = (const float*)(ws + WS_LPART);
    const float B2 = score_bound(q_norm, k_norm, lane);
    bf16x8 qf[2][4];
    if ((int)blockIdx.x < NH * NBLK) { const int u0 = blockIdx.x; const int tq0[2] = {(u0 & 63) * BLK + wave * 32 + fr, (u0 & 63) * BLK + wave * 32 + 16 + fr}; load_q(qf, Q, u0 >> 6, tq0, fq); }
    for (int unit = blockIdx.x; unit < NH * NBLK; unit += G) {
        const int h = unit >> 6, c = unit & 63;
        __syncthreads(); stage_kv(Kg, Vt, h, c, lds, tid); LDS_WAIT(); __syncthreads();
        int tq[2];
#pragma unroll
        for (int g = 0; g < 2; ++g) tq[g] = c * BLK + wave * 32 + g * 16 + fr;
        f32x4 O[8][2]; float l[2];
        attn_core<true>(lds, qf, wave, fr, fq, B2, O, l);
        if (unit + G < NH * NBLK) { const int u1 = unit + G; const int tqn[2] = {(u1 & 63) * BLK + wave * 32 + fr, (u1 & 63) * BLK + wave * 32 + 16 + fr}; load_q(qf, Q, u1 >> 6, tqn, fq); }
        const int nsel = c < 3 ? c : 3;
#pragma unroll
        for (int g = 0; g < 2; ++g) {
            float lp[3];
#pragma unroll
            for (int j = 0; j < 3; ++j) lp[j] = LP[((size_t)j * M + tq[g]) * NH + h];
            v4u w[3][2];
#pragma unroll
            for (int j = 0; j < 3; ++j)
#pragma unroll
                for (int k = 0; k < 2; ++k) w[j][k] = *(const GAS v4u*)(OP + ((size_t)j * M + tq[g]) * 1024 + h * HD + k * 64 + 16 * fq);
            float lt = l[g]; float ls[3];
#pragma unroll
            for (int j = 0; j < 3; ++j) { ls[j] = j < nsel ? lp[j] * (1.0f / 16.0f) : 0.f; lt += j < nsel ? lp[j] : 0.f; }
            const float inv = 1.0f / lt;
#pragma unroll
            for (int k = 0; k < 2; ++k) {
                f32x4 o[4];
#pragma unroll
                for (int q = 0; q < 4; ++q) o[q] = O[4 * k + q][g];
#pragma unroll
                for (int j = 0; j < 3; ++j) if (j < nsel) { const unsigned xw[4] = {w[j][k].x, w[j][k].y, w[j][k].z, w[j][k].w};
#pragma unroll
                    for (int q = 0; q < 4; ++q) { const pg8::f32x2_t_ lo = __builtin_amdgcn_cvt_pk_f32_fp8((int)xw[q], false), hi = __builtin_amdgcn_cvt_pk_f32_fp8((int)xw[q], true);
                        o[q][0] += lo[0] * ls[j]; o[q][1] += lo[1] * ls[j]; o[q][2] += hi[0] * ls[j]; o[q][3] += hi[1] * ls[j]; } }
                bf16* dst = Oout + (size_t)tq[g] * 1024 + h * HD + k * 64 + 16 * fq;
                *(GAS v4u*)dst = pg8::pack8(o[0] * inv, o[1] * inv); *(GAS v4u*)(dst + 8) = pg8::pack8(o[2] * inv, o[3] * inv); }
        }
    }
    __syncthreads();
}

#ifndef MK_PER_PHASE
#define MK_PER_PHASE 0
#endif
#ifndef MK_DUP
#define MK_DUP -1
#endif
constexpr int N_PHASES = 9;
struct Args { const float* in[14]; float* out; unsigned char* ws; int ph_lo, ph_hi; };
__global__ void __launch_bounds__(NTHREADS, 2) hybrid_fwd(Args args) {
    extern __shared__ __attribute__((aligned(16))) unsigned char lds_raw[];
    LAS unsigned char* lds = (LAS unsigned char*)lds_raw;
    volatile LAS unsigned* MISC = (volatile LAS unsigned*)(lds + MISC_OFF);
    const int tid = threadIdx.x, lane = tid & 63, wave = __builtin_amdgcn_readfirstlane(tid >> 6);
    const int G = gridDim.x; const int vcu = (G % 8 == 0) ? ((int)blockIdx.x % 8) * (G / 8) + (int)blockIdx.x / 8 : (int)blockIdx.x;
    unsigned char* ws = args.ws;
    gu32* ctl = (gu32*)(ws + WS_CTL);
    if (tid < 32) MISC[tid] = 0u;
    __syncthreads();
    const int lo = args.ph_lo, hi = args.ph_hi;
    XcdBarrier bar; bar.bar = (unsigned*)ctl + CW_BAR; bar.x = 0; bar.st = nullptr;
    if (hi - lo > 1) bar = xcd_barrier_post((unsigned*)ctl + CW_BAR, MISC + 8);
#ifndef PHASE_MASK
#define PHASE_MASK 0x1ff
#endif
#define IN(k) (((PHASE_MASK >> (k)) & 1) && lo <= (k) && (k) < hi)
#define SEAM(k) do { if (IN(k) && IN((k) + 1)) xcd_barrier(bar); } while (0)
    const float* x = args.in[0]; const float* norm_mix = args.in[1]; const float* w_in = args.in[2]; const float* conv_a_w = args.in[3]; const float* q_norm = args.in[4]; const float* k_norm = args.in[5];
    const float* w_oa = args.in[6]; const float* w_ob = args.in[7]; const float* w_o = args.in[8]; const float* norm_ffn = args.in[9]; const float* w_up = args.in[10]; const float* ffn_conv_w = args.in[11];
    const float* ffn_conv_b = args.in[12]; const float* w_down = args.in[13];
    float* out = args.out;
    float* rowss = (float*)((unsigned*)ctl + CW_ROWSS);
    const size_t TSTEP = (size_t)256 * 1024 * 2;

    if (IN(0)) { phase0(x, norm_mix, w_in, w_oa, w_ob, w_o, w_up, norm_ffn, ws, lds, vcu, G, wave, lane); __syncthreads(); }
    SEAM(0);
    if (IN(1)) {
        pg8::Gemm g{(const bf16*)(ws + WS_XB), (const bf16*)(ws + WS_XB), (const bf16*)(ws + WS_WIN), (const bf16*)(ws + WS_WIN), D, TSTEP};
        pg8::StaticOrder S; S.init(M / 256, NIN / 256, G, (int)blockIdx.x);
        pg8::Epi1 E{(bf16*)(ws + WS_CA), (bf16*)(ws + WS_UU), (bf16*)(ws + WS_Q), (bf16*)(ws + WS_K), (bf16*)(ws + WS_VT), (bf16*)out, (const float*)(ws + WS_RSTDX), q_norm, k_norm, (float*)(ws + WS_KBAR), (PG8_LAS float*)(lds + HALO_OFF)};
        pg8::gemm_phase<pg8::Epi1, pg8::StaticOrder, true, true>(lds, g, S, E);
    }
    SEAM(1);
    if (IN(2)) { phase2d(ws, lds, G, tid, wave, lane, (unsigned*)(ws + WS_CTL) + CW_GCNT, (unsigned short*)(ws + WS_LIST));
        phase2(conv_a_w, ws, G, tid, (bf16*)(ws + WS_CA)); __syncthreads(); }
#if MK_DUP == 21
    if (IN(2)) { phase2d(ws, lds, G, tid, wave, lane, (unsigned*)(ws + WS_CTL) + CW_GCNT + 512, (unsigned short*)(ws + WS_WIN)); }
#endif
#if MK_DUP == 22
    if (IN(2)) { phase2(conv_a_w, ws, G, tid, (bf16*)(ws + WS_XB)); }
#endif
    SEAM(2);
#if MK_DUP >= 30 && MK_DUP <= 35
    if (IN(3)) phase3a<MK_DUP - 30>(q_norm, k_norm, ws, lds, G, tid, wave, lane);
#endif
    if (IN(3)) phase3a<0>(q_norm, k_norm, ws, lds, G, tid, wave, lane);
    SEAM(3);
    if (IN(4)) { phase3b(q_norm, k_norm, ws, lds, G, tid, wave, lane, (bf16*)(ws + WS_Q));
#if MK_DUP == 4
        phase3b(q_norm, k_norm, ws, lds, G, tid, wave, lane, (bf16*)(ws + WS_OPART));
#endif
        }
    SEAM(4);
    if (IN(5)) {
        { LAS float* scr = (LAS float*)(lds + wave * 16384); const int gw = vcu * NWAVES + wave, NGW = G * NWAVES;
          if (blockIdx.x == 0 && tid < 256) *(GAS v4u*)(ws + WS_HB - 4096 + tid * 16) = (v4u){0u, 0u, 0u, 0u};
          __syncthreads(); }
        pg8::Gemm g{(const bf16*)(ws + WS_CA), (const bf16*)(ws + WS_Q), (const bf16*)(ws + WS_WOA), (const bf16*)(ws + WS_WOB), D, TSTEP};
        pg8::DualOrder S; S.S.init(M / 256, D / 256, G, (int)blockIdx.x);
        pg8::Epi4 E{(bf16*)(ws + WS_MG), (const bf16*)out};
        pg8::gemm_phase<pg8::Epi4, pg8::DualOrder, true, true>(lds, g, S, E);
    }
    SEAM(5);
    if (IN(6)) {
        pg8::Gemm g{(const bf16*)(ws + WS_MG), (const bf16*)(ws + WS_MG), (const bf16*)(ws + WS_WO), (const bf16*)(ws + WS_WO), D, TSTEP};
        pg8::StaticOrder S; S.init(M / 256, D / 256, G, (int)blockIdx.x);
        pg8::Epi5 E{x, out, (bf16*)(ws + WS_HB), rowss};
        pg8::gemm_phase<pg8::Epi5, pg8::StaticOrder, true, true>(lds, g, S, E);
#if MK_DUP == 6
        { pg8::Epi5 E2{x, (float*)(ws + WS_Q), (bf16*)(ws + WS_VT), (float*)(ws + WS_CA)}; pg8::gemm_phase<pg8::Epi5, pg8::StaticOrder, true, true>(lds, g, S, E2); }
#endif
    }
    SEAM(6);
    if (IN(7)) {
        const bf16* hb2 = (const bf16*)(ws + WS_HB) - 2 * 1024;
        pg8::Gemm g{hb2, hb2, (const bf16*)(ws + WS_WUP), (const bf16*)(ws + WS_WUP), D, (size_t)254 * 1024 * 2};
        pg8::StaticOrder S; S.init(65, 22, G, (int)blockIdx.x);
        pg8::Epi6 E{(bf16*)(ws + WS_ACT), rowss, ffn_conv_w, ffn_conv_b, (PG8_LAS float*)(lds + HALO_OFF)};
        pg8::gemm_phase<pg8::Epi6, pg8::StaticOrder, true, true>(lds, g, S, E);
        { const int nwg = 65 * 22, full = nwg % G, nidle = full ? G - full : G, idx = full ? (int)blockIdx.x - full : (int)blockIdx.x;
          if (idx >= 0) convert_weight(w_down, DFF, D, (bf16*)(ws + WS_WDN), nullptr, 0, (LAS float*)(lds + wave * 16384), idx * NWAVES + wave, nidle * NWAVES, lane);
          __syncthreads(); }
    }
    SEAM(7);
    if (IN(8)) {
        pg8::Gemm g{(const bf16*)(ws + WS_ACT), (const bf16*)(ws + WS_ACT), (const bf16*)(ws + WS_WDN), (const bf16*)(ws + WS_WDN), DFF, (size_t)256 * DFF * 2};
        pg8::StaticOrder S; S.init(M / 256, D / 256, G, (int)blockIdx.x);
        pg8::Epi7 E{out, (const bf16*)(ws + WS_HB)};
        pg8::gemm_phase<pg8::Epi7, pg8::StaticOrder, true, true>(lds, g, S, E);
#if MK_DUP == 8
        { pg8::Epi7 E2{(float*)(ws + WS_MG), (const bf16*)(ws + WS_HB)}; pg8::gemm_phase<pg8::Epi7, pg8::StaticOrder, true, true>(lds, g, S, E2); }
#endif
    }
#undef IN
#undef SEAM
}

extern "C" void kernel_launch(void* const* d_in, const int* in_sizes, int n_in, void* d_out, int out_size, void* d_ws, size_t ws_size, hipStream_t stream) {
    static int grid = 0;
    if (grid == 0) {
        if (n_in != 14 || in_sizes[0] != M * D || out_size != M * D || ws_size < WS_END) { fprintf(stderr, "kernel_launch: unexpected shapes (n_in %d, in0 %d, out %d, ws %zu)\n", n_in, n_in > 0 ? in_sizes[0] : -1, out_size, ws_size); grid = -1; return; }
        int dev = 0, cus = 0, per_cu = 0;
        if (hipGetDevice(&dev) != hipSuccess || hipDeviceGetAttribute(&cus, hipDeviceAttributeMultiprocessorCount, dev) != hipSuccess) { grid = -1; return; }
        if (hipFuncSetAttribute((const void*)hybrid_fwd, hipFuncAttributeMaxDynamicSharedMemorySize, LDS_BYTES) != hipSuccess) { fprintf(stderr, "kernel_launch: hipFuncSetAttribute failed\n"); grid = -1; return; }
        if (hipOccupancyMaxActiveBlocksPerMultiprocessor(&per_cu, (const void*)hybrid_fwd, NTHREADS, LDS_BYTES) != hipSuccess || per_cu < 1) { fprintf(stderr, "kernel_launch: occupancy query says %d blocks per CU\n", per_cu); (void)hipGetLastError(); grid = -1; return; }
        grid = cus;
    }
    if (grid < 0) return;
    if (hipMemsetAsync((char*)d_ws + WS_CTL, 0, CTL_ZERO_BYTES, stream) != hipSuccess) { fprintf(stderr, "kernel_launch: memset failed\n"); return; }
    Args a{};
    for (int i = 0; i < 14; ++i) a.in[i] = (const float*)d_in[i];
    a.out = (float*)d_out; a.ws = (unsigned char*)d_ws;
#if MK_PER_PHASE
    for (int p = 0; p < N_PHASES; ++p) { a.ph_lo = p; a.ph_hi = p + 1; hipLaunchKernelGGL(hybrid_fwd, dim3(grid), dim3(NTHREADS), LDS_BYTES, stream, a); }
#else
    a.ph_lo = 0; a.ph_hi = N_PHASES;
    void* kargs[] = {&a};
    hipError_t e = hipLaunchCooperativeKernel((const void*)hybrid_fwd, dim3(grid), dim3(NTHREADS), kargs, LDS_BYTES, stream);
    if (e != hipSuccess) fprintf(stderr, "kernel_launch: cooperative launch failed: %s (grid %d)\n", hipGetErrorString(e), grid);
#endif
}
```

```cpp
#include <hip/hip_runtime.h>
#include <cstdio>
#include <cstdint>
namespace pg8 {
#define PG8_LAS __attribute__((address_space(3)))
typedef unsigned short bf16_t;
typedef short bf16x8 __attribute__((ext_vector_type(8)));
typedef float f32x4 __attribute__((ext_vector_type(4)));
typedef unsigned u32x4 __attribute__((ext_vector_type(4)));
constexpr int BM = 256, BK = 64, HALF = 128, HTB = HALF * BK * 2  , STAGE_BYTES = 8 * HTB, NXCD = 8, WGM = 8;

__host__ __device__ __forceinline__ int lds_byte(int r, int c) { const int st = (r >> 4) * 2 + (c >> 5), rr = r & 15, cc = c & 31, ob = rr * 64 + cc * 2; return st * 1024 + (ob ^ (((ob >> 9) & 1) << 5)); }
__host__ __device__ __forceinline__ void stage_rc(int b, int& R, int& C) { const int st = b / 1024, sb = b % 1024, swz = sb ^ (((sb >> 9) & 1) << 5); R = (st >> 1) * 16 + swz / 64; C = (st & 1) * 32 + (swz % 64) / 2; }
__host__ __device__ __forceinline__ int perm32(int rho) { const int n = rho >> 4, i = rho & 15; return 8 * (i >> 2) + 4 * n + (i & 3); }


struct Unit { int pm, pn, sel; };
struct Gemm { const bf16_t* A0; const bf16_t* A1; const bf16_t* B0; const bf16_t* B1; int K; size_t a_tstep; };

struct StaticOrder {
    int nM, nN, nwg, G, c;
    __host__ __device__ void init(int nM_, int nN_, int G_, int c_) { nM = nM_; nN = nN_; nwg = nM * nN; G = G_; c = c_; }
    __host__ __device__ bool next(int i, Unit& u) const {
        const long L = (long)i * G + c; if (L >= nwg) return false;
        int wgid = (int)L; { const int q = nwg / NXCD, r = nwg % NXCD, xcd = wgid % NXCD, off = wgid / NXCD; wgid = (xcd < r ? xcd * (q + 1) : r * (q + 1) + (xcd - r) * q) + off; }
        const int nig = WGM * nN, gid = wgid / nig, fm = gid * WGM, gsz = (nM - fm) < WGM ? (nM - fm) : WGM;
        u.pm = fm + ((wgid % nig) % gsz); u.pn = (wgid % nig) / gsz; u.sel = 0; return true;
    }
    __device__ __forceinline__ void a_ready(const Unit&) const {}
    __device__ __forceinline__ void done(const Unit&) const {}
};
struct DualOrder {
    StaticOrder S;
    __host__ __device__ bool next(int i, Unit& u) const { const bool ok = S.next(i >> 1, u); u.sel = i & 1; return ok; }
    __device__ __forceinline__ void a_ready(const Unit&) const {}
    __device__ __forceinline__ void done(const Unit&) const {}
};

typedef __bf16 bf16x2_t_ __attribute__((ext_vector_type(2))); typedef float f32x2_t_ __attribute__((ext_vector_type(2)));
__device__ __forceinline__ unsigned cvt_pk_bf16(float lo, float hi) { const f32x2_t_ v = {lo, hi}; const bf16x2_t_ b = __builtin_convertvector(v, bf16x2_t_); return __builtin_bit_cast(unsigned, b); }
__device__ __forceinline__ float bf_lo(unsigned w) { return __uint_as_float(w << 16); }
__device__ __forceinline__ float bf_hi(unsigned w) { return __uint_as_float(w & 0xffff0000u); }
__device__ __forceinline__ float fast_sigmoid(float x) { return __builtin_amdgcn_rcpf(1.0f + __builtin_amdgcn_exp2f(-1.4426950408889634f * x)); }
__device__ __forceinline__ u32x4 pack8(const f32x4 a, const f32x4 b) { u32x4 w; w.x = cvt_pk_bf16(a[0], a[1]); w.y = cvt_pk_bf16(a[2], a[3]); w.z = cvt_pk_bf16(b[0], b[1]); w.w = cvt_pk_bf16(b[2], b[3]); return w; }

template <int CTRL> __device__ __forceinline__ float dpp_shr(float old, float v) { return __builtin_bit_cast(float, __builtin_amdgcn_update_dpp(__builtin_bit_cast(int, old), __builtin_bit_cast(int, v), CTRL, 0xf, 0xf, false)); }
template <int CTRL> __device__ __forceinline__ float dpp_ror(float v) { return __builtin_bit_cast(float, __builtin_amdgcn_update_dpp(0, __builtin_bit_cast(int, v), CTRL, 0xf, 0xf, true)); }
constexpr int MROWS = 16384, DMODEL = 1024, DFF_ = 2816;

struct Epi1 {
    static constexpr bool PERM = true, AFTER_DRAIN = false, APERM = false;
    static __device__ __forceinline__ bool keep_acc(const Unit&) { return false; }
    bf16_t *BG, *UU, *Q, *K, *VT, *SG; const float* rstdx; const float *q_norm, *k_norm; float* kbar; PG8_LAS float* xl;
    __device__ __forceinline__ void operator()(f32x4 (&acc)[2][2][4][2], const Unit& u, int wr, int wc, int fr, int fq) const {
        const int row0 = u.pm * BM + wr * 64 + fr, colw = wc * 32 + 8 * fq, pn = u.pn;
        if (pn >= 12 && pn < 20) {
            const bool isK = pn >= 16; const float* wn = isK ? k_norm : q_norm; const float gs = isK ? 1.0f : 0.12751743074602357f;
            bf16_t* dst = isK ? K : Q; const int cb = ((pn - 12) & 3) * 256;
#pragma unroll
            for (int ai = 0; ai < 2; ++ai)
#pragma unroll
                for (int m = 0; m < 4; ++m) { const int rl = ai * HALF + wr * 64 + m * 16 + fr; const float rs = rstdx[u.pm * BM + rl];
#pragma unroll
                    for (int bj = 0; bj < 2; ++bj) { const f32x4 a = acc[ai][bj][m][0] * rs, b = acc[ai][bj][m][1] * rs; acc[ai][bj][m][0] = a; acc[ai][bj][m][1] = b;
                        float ss = (a[0] * a[0] + a[1] * a[1]) + (a[2] * a[2] + a[3] * a[3]) + (b[0] * b[0] + b[1] * b[1]) + (b[2] * b[2] + b[3] * b[3]);
                        ss += __shfl_xor(ss, 16); ss += __shfl_xor(ss, 32);
                        if (fq == 0) xl[(rl * 2 + bj) * 4 + wc] = ss; } }
            asm volatile("s_waitcnt lgkmcnt(0)" ::: "memory"); __builtin_amdgcn_s_barrier(); asm volatile("" ::: "memory");
            const f32x4 g0 = *(const f32x4*)(wn + colw) * gs, g1 = *(const f32x4*)(wn + colw + 4) * gs;
#pragma unroll
            for (int ai = 0; ai < 2; ++ai)
#pragma unroll
                for (int m = 0; m < 4; ++m) { const int rl = ai * HALF + wr * 64 + m * 16 + fr; const int r = u.pm * BM + rl;
#pragma unroll
                    for (int bj = 0; bj < 2; ++bj) { const f32x4 p = *(const PG8_LAS f32x4*)(xl + (rl * 2 + bj) * 4);
                        const float rn = rsqrtf(((p[0] + p[1]) + (p[2] + p[3])) * (1.0f / 128.0f) + 1e-6f);
                        const f32x4 a = acc[ai][bj][m][0] * rn * g0, b = acc[ai][bj][m][1] * rn * g1; acc[ai][bj][m][0] = a; acc[ai][bj][m][1] = b;
                        *(u32x4*)(dst + (size_t)r * 1024 + cb + bj * 128 + colw) = pack8(a, b); } }
            if (isK) {
                f32x4 cs[2][2];
#pragma unroll
                for (int bj = 0; bj < 2; ++bj)
#pragma unroll
                    for (int n = 0; n < 2; ++n) { f32x4 t = acc[0][bj][0][n];
#pragma unroll
                        for (int ai = 0; ai < 2; ++ai)
#pragma unroll
                            for (int m = 0; m < 4; ++m) if (ai + m > 0) t += acc[ai][bj][m][n];
                        cs[bj][n] = t; }
#pragma unroll
                for (int bj = 0; bj < 2; ++bj)
#pragma unroll
                    for (int n = 0; n < 2; ++n)
#pragma unroll
                        for (int e = 0; e < 4; ++e) { float v = cs[bj][n][e]; v += __shfl_xor(v, 1); v += __shfl_xor(v, 2); v += __shfl_xor(v, 4); v += __shfl_xor(v, 8); cs[bj][n][e] = v; }
                if (fr == 0) {
#pragma unroll
                    for (int bj = 0; bj < 2; ++bj) { *(PG8_LAS f32x4*)(xl + 2048 + wr * 256 + bj * 128 + colw) = cs[bj][0]; *(PG8_LAS f32x4*)(xl + 2048 + wr * 256 + bj * 128 + colw + 4) = cs[bj][1]; } }
                asm volatile("s_waitcnt lgkmcnt(0)" ::: "memory"); __builtin_amdgcn_s_barrier(); asm volatile("" ::: "memory");
                int t = threadIdx.x; asm volatile("" : "+v"(t));
                if (t < 256) kbar[((size_t)((pn - 16) * 2 + (t >> 7)) * 64 + u.pm) * 128 + (t & 127)] = (xl[2048 + t] + xl[2048 + 256 + t]) * (1.0f / 256.0f);
            }
            return;
        }
        if (pn >= 20 && pn < 24) {
            int tidv = threadIdx.x; asm volatile("" : "+v"(tidv));
            PG8_LAS unsigned char* T = (PG8_LAS unsigned char*)xl + (tidv >> 6) * 2304;
            const int lane = tidv & 63;
            float rsv[2][4];
#pragma unroll
            for (int ai = 0; ai < 2; ++ai)
#pragma unroll
                for (int m = 0; m < 4; ++m) rsv[ai][m] = rstdx[u.pm * BM + ai * HALF + wr * 64 + m * 16 + fr];
#pragma unroll
            for (int ai = 0; ai < 2; ++ai)
#pragma unroll
                for (int mp = 0; mp < 2; ++mp)
#pragma unroll
                    for (int bj = 0; bj < 2; ++bj) {
#pragma unroll
                        for (int mm = 0; mm < 2; ++mm) { const int m = 2 * mp + mm; const float rs = rsv[ai][m];
                            const u32x4 w = pack8(acc[ai][bj][m][0] * rs, acc[ai][bj][m][1] * rs); const unsigned ww[4] = {w.x, w.y, w.z, w.w};
                            PG8_LAS unsigned char* tp = T + (8 * fq) * 72 + (16 * mm + fr) * 2;
#pragma unroll
                            for (int e = 0; e < 8; ++e) *(PG8_LAS unsigned short*)(tp + e * 72) = (unsigned short)((e & 1) ? (ww[e >> 1] >> 16) : (ww[e >> 1] & 0xffffu)); }
                        asm volatile("s_waitcnt lgkmcnt(0)" ::: "memory");
#pragma unroll
                        for (int rr = 0; rr < 2; ++rr) { const int q = lane + 64 * rr, d = q >> 2, tc = q & 3;
                            const unsigned long long x0 = *(const PG8_LAS unsigned long long*)(T + d * 72 + tc * 16), x1 = *(const PG8_LAS unsigned long long*)(T + d * 72 + tc * 16 + 8);
                            u32x4 o; o.x = (unsigned)x0; o.y = (unsigned)(x0 >> 32); o.z = (unsigned)x1; o.w = (unsigned)(x1 >> 32);
                            *(u32x4*)(VT + ((size_t)(((pn - 20) * 2 + bj) * 128 + 32 * wc + d)) * MROWS + u.pm * BM + ai * HALF + wr * 64 + 32 * mp + tc * 8) = o; }
                        asm volatile("s_waitcnt lgkmcnt(0)" ::: "memory");
                    }
            return;
        }
        float rsg[2][4];
#pragma unroll
        for (int ai = 0; ai < 2; ++ai)
#pragma unroll
            for (int m = 0; m < 4; ++m) rsg[ai][m] = rstdx[row0 + ai * HALF + m * 16];
#pragma unroll
        for (int ai = 0; ai < 2; ++ai)
#pragma unroll
            for (int m = 0; m < 4; ++m) {
                const int r = row0 + ai * HALF + m * 16; const float rs = rsg[ai][m];
                f32x4 v[2][2];
#pragma unroll
                for (int bj = 0; bj < 2; ++bj)
#pragma unroll
                    for (int n = 0; n < 2; ++n) v[bj][n] = acc[ai][bj][m][n] * rs;
                if (pn < 4) {
#pragma unroll
                    for (int bj = 0; bj < 2; ++bj) *(u32x4*)(BG + (size_t)r * 1024 + pn * 256 + bj * 128 + colw) = pack8(v[bj][0], v[bj][1]);
                } else if (pn < 12) {
                    *(u32x4*)(UU + (size_t)r * 1024 + (pn - 4) * 128 + colw) = pack8(v[0][0] * v[1][0], v[0][1] * v[1][1]);
                } else {
                    f32x4 ra, rb, sa, sb;
#pragma unroll
                    for (int e = 0; e < 4; ++e) { const float ea0 = __builtin_amdgcn_exp2f(-1.4426950408889634f * v[0][0][e]), ea1 = __builtin_amdgcn_exp2f(-1.4426950408889634f * v[0][1][e]);
                        const float eb0 = __builtin_amdgcn_exp2f(-1.4426950408889634f * v[1][0][e]), eb1 = __builtin_amdgcn_exp2f(-1.4426950408889634f * v[1][1][e]);
                        ra[e] = (1.0f + eb0) * __builtin_amdgcn_rcpf(1.0f + ea0); rb[e] = (1.0f + eb1) * __builtin_amdgcn_rcpf(1.0f + ea1);
                        sa[e] = __builtin_amdgcn_rcpf(1.0f + eb0); sb[e] = __builtin_amdgcn_rcpf(1.0f + eb1); }
                    *(u32x4*)(SG + (size_t)r * 2048 + (pn - 24) * 128 + colw) = pack8(ra, rb);
                    *(u32x4*)(SG + (size_t)r * 2048 + 1024 + (pn - 24) * 128 + colw) = pack8(sa, sb);
                }
            }
    }
};
struct Epi4 {
    static constexpr bool PERM = true, AFTER_DRAIN = false, APERM = false;
    bf16_t* MG; const bf16_t* SG;
    static __device__ __forceinline__ bool keep_acc(const Unit& u) { return u.sel == 0; }
    __device__ __forceinline__ void operator()(f32x4 (&acc)[2][2][4][2], const Unit& u, int wr, int wc, int fr, int fq) const {
        const int row0 = u.pm * BM + wr * 64 + fr, col0 = u.pn * BM + wc * 32 + 8 * fq;
#pragma unroll
        for (int ai = 0; ai < 2; ++ai) {
            u32x4 g[4][2];
#pragma unroll
            for (int m = 0; m < 4; ++m)
#pragma unroll
                for (int bj = 0; bj < 2; ++bj) g[m][bj] = *(const u32x4*)(SG + (size_t)(row0 + ai * HALF + m * 16) * 2048 + u.sel * 1024 + col0 + bj * HALF);
#pragma unroll
            for (int m = 0; m < 4; ++m) { const int r = row0 + ai * HALF + m * 16;
#pragma unroll
                for (int bj = 0; bj < 2; ++bj) { const int c = col0 + bj * HALF; const u32x4 gg = g[m][bj];
                    f32x4 a = acc[ai][bj][m][0], b = acc[ai][bj][m][1];
                    a[0] *= bf_lo(gg.x); a[1] *= bf_hi(gg.x); a[2] *= bf_lo(gg.y); a[3] *= bf_hi(gg.y); b[0] *= bf_lo(gg.z); b[1] *= bf_hi(gg.z); b[2] *= bf_lo(gg.w); b[3] *= bf_hi(gg.w);
                    if (u.sel) *(u32x4*)(MG + (size_t)r * 1024 + c) = pack8(a, b);
                    else { acc[ai][bj][m][0] = a; acc[ai][bj][m][1] = b; } } }
        }
    }
};
struct Epi5 {
    static constexpr bool PERM = true, AFTER_DRAIN = false, APERM = false;
    static __device__ __forceinline__ bool keep_acc(const Unit&) { return false; }
    const float* X; float* OUT; bf16_t* HB; float* rowss;
    __device__ __forceinline__ void operator()(f32x4 (&acc)[2][2][4][2], const Unit& u, int wr, int wc, int fr, int fq) const {
        const int row0 = u.pm * BM + wr * 64 + fr, col0 = u.pn * BM + wc * 32 + 8 * fq;
#pragma unroll
        for (int ai = 0; ai < 2; ++ai) {
            f32x4 xv[4][2][2];
#pragma unroll
            for (int m = 0; m < 4; ++m)
#pragma unroll
                for (int bj = 0; bj < 2; ++bj) { const size_t o = (size_t)(row0 + ai * HALF + m * 16) * 1024 + col0 + bj * HALF; xv[m][bj][0] = __builtin_nontemporal_load((const f32x4*)(X + o)); xv[m][bj][1] = __builtin_nontemporal_load((const f32x4*)(X + o + 4)); }
#pragma unroll
            for (int m = 0; m < 4; ++m) { const int r = row0 + ai * HALF + m * 16; float ss = 0.f;
#pragma unroll
                for (int bj = 0; bj < 2; ++bj) { const size_t o = (size_t)r * 1024 + col0 + bj * HALF;
                    const f32x4 a = acc[ai][bj][m][0] + xv[m][bj][0], b = acc[ai][bj][m][1] + xv[m][bj][1];
                    *(u32x4*)(HB + o) = pack8(a, b);
                    ss += (a[0] * a[0] + a[1] * a[1]) + (a[2] * a[2] + a[3] * a[3]) + (b[0] * b[0] + b[1] * b[1]) + (b[2] * b[2] + b[3] * b[3]); }
                ss += __shfl_xor(ss, 16); ss += __shfl_xor(ss, 32);
                if (fq == 0) atomicAdd(rowss + r, ss); }
        }
    }
};
struct Epi6 {
    static constexpr bool PERM = true, AFTER_DRAIN = false, APERM = true;
    static __device__ __forceinline__ bool keep_acc(const Unit&) { return false; }
    bf16_t* ACT; const float* rowss; const float* cw; const float* cb; PG8_LAS float* halo;
    __device__ __forceinline__ void operator()(f32x4 (&acc)[2][2][4][2], const Unit& u, int wr, int wc, int fr, int fq) const {
        const int r0 = u.pm * 254 - 2, colw = wc * 32 + 8 * fq;
#pragma unroll
        for (int ai = 0; ai < 2; ++ai)
#pragma unroll
            for (int m = 0; m < 4; ++m) { int gr = r0 + ai * HALF + wr * 64 + 4 * fr + m; gr = gr < 0 ? 0 : (gr > MROWS - 1 ? MROWS - 1 : gr);
                const float rs = rsqrtf(rowss[gr] * (1.0f / 1024.0f) + 1e-6f);
#pragma unroll
                for (int bj = 0; bj < 2; ++bj)
#pragma unroll
                    for (int n = 0; n < 2; ++n) acc[ai][bj][m][n] *= rs; }
        if (fr == 15) {
#pragma unroll
            for (int ai = 0; ai < 2; ++ai)
#pragma unroll
                for (int bj = 0; bj < 2; ++bj)
#pragma unroll
                    for (int n = 0; n < 2; ++n) { *(PG8_LAS f32x4*)(halo + (((2 * ai + wr) * 2 + 0) * 256 + bj * 128 + colw + 4 * n)) = acc[ai][bj][2][n];
                                                  *(PG8_LAS f32x4*)(halo + (((2 * ai + wr) * 2 + 1) * 256 + bj * 128 + colw + 4 * n)) = acc[ai][bj][3][n]; }
        }
        f32x4 wn0, wn1, wn2, wnb;
        { const int col = u.pn * 128 + colw; wn0 = *(const f32x4*)(cw + col); wn1 = *(const f32x4*)(cw + 2 * DFF_ + col); wn2 = *(const f32x4*)(cw + 4 * DFF_ + col); wnb = *(const f32x4*)(cb + col); }
        asm volatile("s_waitcnt lgkmcnt(0)" ::: "memory"); __builtin_amdgcn_s_barrier(); asm volatile("" ::: "memory");
#pragma unroll
        for (int bj = 0; bj < 2; ++bj)
#pragma unroll
            for (int n = 0; n < 2; ++n) {
                const f32x4 w0 = wn0, w1 = wn1, w2 = wn2, bb = wnb;
                if (bj * 2 + n < 3) { const int k2 = bj * 2 + n + 1, col = (k2 >> 1) * DFF_ + u.pn * 128 + colw + 4 * (k2 & 1);
                    wn0 = *(const f32x4*)(cw + col); wn1 = *(const f32x4*)(cw + 2 * DFF_ + col); wn2 = *(const f32x4*)(cw + 4 * DFF_ + col); wnb = *(const f32x4*)(cb + col); }
#pragma unroll
                for (int ai = 0; ai < 2; ++ai) {
                    const int s = 2 * ai + wr;
                    const int sm = s > 0 ? s - 1 : 0; const float hz = s > 0 ? 1.0f : 0.0f;
                    const f32x4 h2 = *(const PG8_LAS f32x4*)(halo + ((sm * 2 + 0) * 256 + bj * 128 + colw + 4 * n)) * hz, h1 = *(const PG8_LAS f32x4*)(halo + ((sm * 2 + 1) * 256 + bj * 128 + colw + 4 * n)) * hz;
                    const f32x4 raw0 = acc[ai][bj][0][n], raw1 = acc[ai][bj][1][n]; f32x4 raw2 = acc[ai][bj][2][n], raw3 = acc[ai][bj][3][n];
                    asm volatile("" : "+v"(raw2), "+v"(raw3));
                    f32x4 s3, s2;
#pragma unroll
                    for (int e = 0; e < 4; ++e) { s3[e] = dpp_shr<0x111>(h1[e], raw3[e]); s2[e] = dpp_shr<0x111>(h2[e], raw2[e]); }
                    { f32x4 y3 = w0 * raw1 + w1 * raw2 + w2 * raw3 + bb, y2 = w0 * raw0 + w1 * raw1 + w2 * raw2 + bb, y1 = w0 * s3 + w1 * raw0 + w2 * raw1 + bb, y0 = w0 * s2 + w1 * s3 + w2 * raw0 + bb;
                      asm volatile("" : "+v"(y0), "+v"(y1), "+v"(y2), "+v"(y3));
                      acc[ai][bj][3][n] = y3; acc[ai][bj][2][n] = y2; acc[ai][bj][1][n] = y1; acc[ai][bj][0][n] = y0; }
                }
            }
#pragma unroll
        for (int ai = 0; ai < 2; ++ai)
#pragma unroll
            for (int m = 0; m < 4; ++m) { const int i = ai * HALF + wr * 64 + 4 * fr + m, gr = r0 + i;
                f32x4 a, b;
#pragma unroll
                for (int e = 0; e < 4; ++e) { const float g0 = acc[ai][0][m][0][e], g1 = acc[ai][0][m][1][e];
                    a[e] = g0 * fast_sigmoid(g0) * acc[ai][1][m][0][e]; b[e] = g1 * fast_sigmoid(g1) * acc[ai][1][m][1][e]; }
                if (i >= 2 && gr < MROWS) *(u32x4*)(ACT + (size_t)gr * DFF_ + u.pn * 128 + colw) = pack8(a, b); }
    }
};
struct Epi7 {
    static constexpr bool PERM = true, AFTER_DRAIN = false, APERM = false;
    static __device__ __forceinline__ bool keep_acc(const Unit&) { return false; }
    float* OUT; const bf16_t* HB;
    __device__ __forceinline__ void operator()(f32x4 (&acc)[2][2][4][2], const Unit& u, int wr, int wc, int fr, int fq) const {
        const int row0 = u.pm * BM + wr * 64 + fr, col0 = u.pn * BM + wc * 32 + 8 * fq;
#pragma unroll
        for (int ai = 0; ai < 2; ++ai) {
            u32x4 hv[4][2];
#pragma unroll
            for (int m = 0; m < 4; ++m)
#pragma unroll
                for (int bj = 0; bj < 2; ++bj) hv[m][bj] = *(const u32x4*)(HB + (size_t)(row0 + ai * HALF + m * 16) * 1024 + col0 + bj * HALF);
#pragma unroll
            for (int m = 0; m < 4; ++m) { const int r = row0 + ai * HALF + m * 16;
#pragma unroll
                for (int bj = 0; bj < 2; ++bj) { const size_t o = (size_t)r * 1024 + col0 + bj * HALF; float* p = OUT + o; const u32x4 hw = hv[m][bj];
                    f32x4 a = acc[ai][bj][m][0], b = acc[ai][bj][m][1];
                    a[0] += bf_lo(hw.x); a[1] += bf_hi(hw.x); a[2] += bf_lo(hw.y); a[3] += bf_hi(hw.y); b[0] += bf_lo(hw.z); b[1] += bf_hi(hw.z); b[2] += bf_lo(hw.w); b[3] += bf_hi(hw.w);
                    __builtin_nontemporal_store(a, (f32x4*)p); __builtin_nontemporal_store(b, (f32x4*)(p + 4)); } }
        }
    }
};
template <class Epi, class Sched, bool ALIGN_EPI = false, bool SP2 = false>
__device__ __forceinline__ void gemm_phase(PG8_LAS unsigned char* lds, const Gemm g, const Sched& S, const Epi& E) {
    const int tid = threadIdx.x, wid = __builtin_amdgcn_readfirstlane(tid >> 6), lane = tid & 63, wr = wid >> 2, wc = wid & 3, fr = lane & 15, fq = lane >> 4;
    const int K = g.K, nt = K / BK;
    unsigned voffA[2], voffB[2];
#pragma unroll
    for (int i = 0; i < 2; ++i) { int R, C; stage_rc(tid * 16 + i * 8192, R, C); const int Rb = Epi::PERM ? ((R & ~31) + perm32(R & 31)) : R;
        const int Ra = Epi::APERM ? ((R & ~63) | (4 * (R & 15) + ((R >> 4) & 3))) : R;
        voffA[i] = (unsigned)(Ra * K + C) * 2u; voffB[i] = (unsigned)(Rb * K + C) * 2u; }
    const size_t kstep = (size_t)(BK * 2);
    const size_t hstep = (size_t)HALF * K * 2;
    const size_t tstep = 2 * hstep;
    const unsigned ldsw = (unsigned)wid * 1024u;
    const int aoff = lds_byte(wr * 64 + fr, fq * 8), boff = lds_byte(wc * 32 + fr, fq * 8);
#define PG8_SA(b, h) (((b) * 2 + (h)) * HTB)
#define PG8_SB(b, h) ((4 + (b) * 2 + (h)) * HTB)
#define PG8_STAGE(bufoff, gbase, voff) do { _Pragma("unroll") for (int _i = 0; _i < 2; ++_i) \
        __builtin_amdgcn_global_load_lds((const unsigned*)((const char*)(gbase) + (voff)[_i]), (PG8_LAS unsigned*)(lds + (bufoff) + ldsw + _i * 8192), 16, 0, 0); } while (0)
#define PG8_LDA(dst, b, h) do { _Pragma("unroll") for (int m = 0; m < 4; ++m) _Pragma("unroll") for (int k = 0; k < 2; ++k) dst[m][k] = *(const PG8_LAS bf16x8*)(lds + PG8_SA(b, h) + aoff + m * 2048 + k * 1024); } while (0)
#define PG8_LDB(dst, b, h) do { _Pragma("unroll") for (int n = 0; n < 2; ++n) _Pragma("unroll") for (int k = 0; k < 2; ++k) dst[n][k] = *(const PG8_LAS bf16x8*)(lds + PG8_SB(b, h) + boff + n * 2048 + k * 1024); } while (0)
#define PG8_MMA(ai, bj, At, Bt) do { __builtin_amdgcn_s_setprio(1); _Pragma("unroll") for (int m = 0; m < 4; ++m) _Pragma("unroll") for (int n = 0; n < 2; ++n) _Pragma("unroll") for (int k = 0; k < 2; ++k) \
        acc[ai][bj][m][n] = __builtin_amdgcn_mfma_f32_16x16x32_bf16(Bt[n][k], At[m][k], acc[ai][bj][m][n], 0, 0, 0); __builtin_amdgcn_s_setprio(0); } while (0)
#define PG8_WAIT_V(n) asm volatile("s_waitcnt vmcnt(" #n ")" ::: "memory")
#define PG8_WAIT_L(n) asm volatile("s_waitcnt lgkmcnt(" #n ")" ::: "memory")
#define PG8_BAR __builtin_amdgcn_s_barrier()
#define PG8_SCHED __builtin_amdgcn_sched_barrier(0)
    Unit cur, nxt; int ui = 0;
    if (!S.next(0, cur)) return;
    f32x4 acc[2][2][4][2];
#pragma unroll
    for (int a = 0; a < 2; ++a)
#pragma unroll
        for (int b = 0; b < 2; ++b)
#pragma unroll
            for (int m = 0; m < 4; ++m)
#pragma unroll
                for (int n = 0; n < 2; ++n) acc[a][b][m][n] = (f32x4){0.f, 0.f, 0.f, 0.f};
    bf16x8 At[4][2], B0[2][2], B1[2][2];
    const char* cA = (const char*)(cur.sel ? g.A1 : g.A0) + (size_t)cur.pm * g.a_tstep; const char* cB = (const char*)(cur.sel ? g.B1 : g.B0) + (size_t)cur.pn * tstep;
    S.a_ready(cur);
    if constexpr (SP2) {
        PG8_STAGE(PG8_SB(0, 0), cB, voffB); PG8_STAGE(PG8_SB(0, 1), cB + hstep, voffB); PG8_STAGE(PG8_SA(0, 0), cA, voffA); PG8_STAGE(PG8_SA(0, 1), cA + hstep, voffA);
        if (wr == 1) PG8_BAR;
        PG8_WAIT_V(2); PG8_BAR;
        PG8_STAGE(PG8_SB(1, 0), cB + kstep, voffB); PG8_STAGE(PG8_SA(1, 0), cA + kstep, voffA); PG8_STAGE(PG8_SB(1, 1), cB + hstep + kstep, voffB);
        PG8_WAIT_V(6); PG8_BAR;
    } else {
        PG8_STAGE(PG8_SB(0, 0), cB, voffB); PG8_STAGE(PG8_SA(0, 0), cA, voffA); PG8_STAGE(PG8_SB(0, 1), cB + hstep, voffB); PG8_STAGE(PG8_SA(0, 1), cA + hstep, voffA);
        if (wr == 1) PG8_BAR;
        PG8_WAIT_V(4); PG8_BAR;
        PG8_STAGE(PG8_SB(1, 0), cB + kstep, voffB); PG8_STAGE(PG8_SA(1, 0), cA + kstep, voffA); PG8_STAGE(PG8_SB(1, 1), cB + hstep + kstep, voffB);
        PG8_WAIT_V(6); PG8_BAR;
    }
    for (;;) {
        const bool has_next = S.next(ui + 1, nxt);
        const char* nA = has_next ? (const char*)(nxt.sel ? g.A1 : g.A0) + (size_t)nxt.pm * g.a_tstep : cA; const char* nB = has_next ? (const char*)(nxt.sel ? g.B1 : g.B0) + (size_t)nxt.pn * tstep : cB;
        for (int t = 0; t < nt; t += 2) {
            const bool last = (t == nt - 2);
            const char* a1 = cA + (size_t)(t + 1) * kstep;
            const char* a2 = last ? nA : cA + (size_t)(t + 2) * kstep; const char* b2 = last ? nB : cB + (size_t)(t + 2) * kstep;
            const char* a3 = a2 + kstep; const char* b3 = b2 + kstep;
            if (last && has_next) S.a_ready(nxt);
            if constexpr (SP2) {
            PG8_LDB(B0, 0, 0); PG8_LDB(B1, 0, 1); PG8_SCHED; PG8_LDA(At, 0, 0); PG8_STAGE(PG8_SA(1, 1), a1 + hstep, voffA);
            PG8_WAIT_V(8); PG8_WAIT_L(0); PG8_BAR; PG8_MMA(0, 0, At, B0); PG8_MMA(0, 1, At, B1); PG8_BAR; PG8_SCHED;
            PG8_LDA(At, 0, 1); PG8_STAGE(PG8_SB(0, 0), b2, voffB); PG8_STAGE(PG8_SB(0, 1), b2 + hstep, voffB); PG8_STAGE(PG8_SA(0, 0), a2, voffA);
            PG8_WAIT_V(8); PG8_WAIT_L(0); PG8_BAR; PG8_MMA(1, 0, At, B0); PG8_MMA(1, 1, At, B1); PG8_BAR; PG8_SCHED;
            PG8_LDB(B0, 1, 0); PG8_LDB(B1, 1, 1); PG8_SCHED; PG8_LDA(At, 1, 0); PG8_STAGE(PG8_SA(0, 1), a2 + hstep, voffA);
            PG8_WAIT_V(8); PG8_WAIT_L(0); PG8_BAR; PG8_MMA(0, 0, At, B0); PG8_MMA(0, 1, At, B1); PG8_BAR; PG8_SCHED;
            PG8_LDA(At, 1, 1); PG8_STAGE(PG8_SB(1, 0), b3, voffB); PG8_STAGE(PG8_SB(1, 1), b3 + hstep, voffB); PG8_STAGE(PG8_SA(1, 0), a3, voffA);
            PG8_WAIT_V(8); PG8_WAIT_L(0); PG8_BAR; PG8_MMA(1, 0, At, B0); PG8_MMA(1, 1, At, B1); PG8_BAR; PG8_SCHED;
            } else {
            PG8_LDB(B0, 0, 0); PG8_SCHED; PG8_LDA(At, 0, 0); PG8_STAGE(PG8_SA(1, 1), a1 + hstep, voffA);
            PG8_WAIT_L(8); PG8_BAR; PG8_WAIT_L(0); PG8_MMA(0, 0, At, B0); PG8_BAR; PG8_SCHED;
            PG8_LDB(B1, 0, 1); PG8_STAGE(PG8_SB(0, 0), b2, voffB);
            PG8_BAR; PG8_WAIT_L(0); PG8_MMA(0, 1, At, B1); PG8_BAR;
            PG8_LDA(At, 0, 1); PG8_STAGE(PG8_SA(0, 0), a2, voffA);
            PG8_BAR; PG8_WAIT_L(0); PG8_MMA(1, 0, At, B0); PG8_BAR; PG8_SCHED;
            PG8_STAGE(PG8_SB(0, 1), b2 + hstep, voffB);
            PG8_WAIT_V(6); PG8_BAR; PG8_MMA(1, 1, At, B1); PG8_BAR;
            PG8_LDB(B0, 1, 0); PG8_SCHED; PG8_LDA(At, 1, 0); PG8_STAGE(PG8_SA(0, 1), a2 + hstep, voffA);
            PG8_WAIT_L(8); PG8_BAR; PG8_WAIT_L(0); PG8_MMA(0, 0, At, B0); PG8_BAR; PG8_SCHED;
            PG8_LDB(B1, 1, 1); PG8_STAGE(PG8_SB(1, 0), b3, voffB);
            PG8_BAR; PG8_WAIT_L(0); PG8_MMA(0, 1, At, B1); PG8_BAR;
            PG8_LDA(At, 1, 1); PG8_STAGE(PG8_SA(1, 0), a3, voffA);
            PG8_BAR; PG8_WAIT_L(0); PG8_MMA(1, 0, At, B0); PG8_BAR; PG8_SCHED;
            PG8_STAGE(PG8_SB(1, 1), b3 + hstep, voffB);
            PG8_WAIT_V(6); PG8_BAR; PG8_MMA(1, 1, At, B1); PG8_BAR;
            }
        }
        if constexpr (ALIGN_EPI) { if (wr == 0) PG8_BAR; }
        if constexpr (!Epi::AFTER_DRAIN) { E(acc, cur, wr, wc, fr, fq); S.done(cur); }
        if (!has_next) break;
        if (!Epi::keep_acc(cur)) {
#pragma unroll
        for (int a = 0; a < 2; ++a)
#pragma unroll
            for (int b = 0; b < 2; ++b)
#pragma unroll
                for (int m = 0; m < 4; ++m)
#pragma unroll
                    for (int n = 0; n < 2; ++n) acc[a][b][m][n] = (f32x4){0.f, 0.f, 0.f, 0.f}; }
        cur = nxt; cA = nA; cB = nB; ++ui;
        if constexpr (ALIGN_EPI) { if (wr == 1) PG8_BAR; }
    }
    PG8_WAIT_V(0);
    if constexpr (!ALIGN_EPI) { if (wr == 0) PG8_BAR; }
    PG8_BAR;
    if constexpr (Epi::AFTER_DRAIN) { E.fused(acc, cur, wr, wc, fr, fq, lds, wid, lane); S.done(cur); }
#undef PG8_SA
#undef PG8_SB
#undef PG8_STAGE
#undef PG8_LDA
#undef PG8_LDB
#undef PG8_MMA
#undef PG8_WAIT_V
#undef PG8_WAIT_L
#undef PG8_BAR
#undef PG8_SCHED
}
}
#define GAS __attribute__((address_space(1)))
#define LAS __attribute__((address_space(3)))
typedef unsigned short bf16;
typedef unsigned v4u __attribute__((ext_vector_type(4)));
typedef float f32x4 __attribute__((ext_vector_type(4)));
typedef short bf16x8 __attribute__((ext_vector_type(8)));
typedef GAS unsigned gu32;
typedef GAS unsigned long long gu64;
#define RLX_AGENT __ATOMIC_RELAXED, __HIP_MEMORY_SCOPE_AGENT
#define LDS_WAIT() asm volatile("s_waitcnt lgkmcnt(0)" ::: "memory")
#define VM_WAIT() asm volatile("s_waitcnt vmcnt(0)" ::: "memory")
__device__ __forceinline__ unsigned long long rt() { return __builtin_amdgcn_s_memrealtime(); }
__device__ __forceinline__ unsigned f2bf(float f) { unsigned u = __builtin_bit_cast(unsigned, f); return (u + 0x7fffu + ((u >> 16) & 1u)) >> 16; }
__device__ __forceinline__ unsigned pk2(float lo, float hi) { return f2bf(lo) | (f2bf(hi) << 16); }

#define XB_TMO      128
#define XB_XCNT(j)  (256  + 64 * (j))
#define XB_XSUB(j)  (1280 + 64 * (j))
#define XB_XGEN(j)  (2304 + 64 * (j))
#define XB_TOP      3328
#define XB_TOPGEN   3392
#define XCD_BAR_WORDS 3456
#define XB_SPIN_CAP (1u << 18)

__device__ __forceinline__ unsigned xb_ld(unsigned* p)              { return __hip_atomic_load(p, __ATOMIC_RELAXED, __HIP_MEMORY_SCOPE_AGENT); }
__device__ __forceinline__ unsigned xb_add(unsigned* p, unsigned v) { return __hip_atomic_fetch_add(p, v, __ATOMIC_RELAXED, __HIP_MEMORY_SCOPE_AGENT); }
__device__ __forceinline__ unsigned xb_xcc_id() { return (unsigned)__builtin_amdgcn_s_getreg((3 << 11) | 20) & 0xFu; }
#define XB_SPIN(cond, bar) do { unsigned _sp = 0; while (cond) { __builtin_amdgcn_s_sleep(1); \
    if ((++_sp & 255u) == 0u) { if (xb_ld(&(bar)[XB_TMO])) break; if (_sp > XB_SPIN_CAP) { atomicAdd(&(bar)[XB_TMO], 1u); break; } } } } while (0)

struct XcdBarrier {
    unsigned* bar; unsigned x;
    volatile LAS unsigned* st;
};

__device__ __forceinline__ XcdBarrier xcd_barrier_post(unsigned* bar, volatile LAS unsigned* st) {
    XcdBarrier b; b.bar = bar; b.x = xb_xcc_id(); b.st = st;
    if (threadIdx.x == 0) (void)xb_add(&bar[XB_XCNT(b.x)], 1u);
    return b;
}
__device__ __forceinline__ void xcd_barrier_complete(unsigned* bar, unsigned x, unsigned& nloc, unsigned& nx) {
    const unsigned G = gridDim.x * gridDim.y * gridDim.z;
    unsigned sum, cnt, mine, sp = 0u;
    for (;;) {
        sum = 0u; cnt = 0u; mine = 0u;
#pragma unroll
        for (unsigned j = 0; j < 16; ++j) { const unsigned c = xb_ld(&bar[XB_XCNT(j)]); sum += c; cnt += (c > 0u) ? 1u : 0u; mine = (j == x) ? c : mine; }
        if (sum == G) break;
        __builtin_amdgcn_s_sleep(1);
        if ((++sp & 255u) == 0u) { if (xb_ld(&bar[XB_TMO])) break; if (sp > XB_SPIN_CAP) { atomicAdd(&bar[XB_TMO], 1u); break; } }
    }
    nloc = mine > 0u ? mine : 1u; nx = cnt > 0u ? cnt : 1u;
}

__device__ __forceinline__ void xcd_barrier(const XcdBarrier& b) {
    asm volatile("s_waitcnt vmcnt(0)" ::: "memory");
    __syncthreads();
    if (threadIdx.x == 0) {
        unsigned* bar = b.bar;
        __builtin_amdgcn_s_waitcnt(0);
        unsigned nloc = b.st[0], nx = b.st[1];
        if (nloc == 0u) { xcd_barrier_complete(bar, b.x, nloc, nx); b.st[0] = nloc; b.st[1] = nx; }
        const unsigned old = xb_add(&bar[XB_XSUB(b.x)], 1u);
        const unsigned gen = old / nloc;
        if (old + 1u == (gen + 1u) * nloc) {
            __builtin_amdgcn_fence(__ATOMIC_RELEASE, "agent");
            asm volatile("s_waitcnt vmcnt(0)" ::: "memory");
            const unsigned og = xb_add(&bar[XB_TOP], 1u);
            const unsigned tg = og / nx;
            if (og + 1u == (tg + 1u) * nx) xb_add(&bar[XB_TOPGEN], 1u);
            else XB_SPIN(xb_ld(&bar[XB_TOPGEN]) == tg, bar);
            __builtin_amdgcn_fence(__ATOMIC_ACQUIRE, "agent");
            xb_add(&bar[XB_XGEN(b.x)], 1u);
            asm volatile("s_waitcnt vmcnt(0)" ::: "memory");
        } else {
            XB_SPIN(xb_ld(&bar[XB_XGEN(b.x)]) == gen, bar);
            __builtin_amdgcn_fence(__ATOMIC_ACQUIRE, "agent");
            asm volatile("s_waitcnt vmcnt(0)" ::: "memory");
        }
    }
    __syncthreads();
}


constexpr int NWAVES = 8, NTHREADS = 512;
constexpr int M = 16384, D = 1024, NIN = 8192, DFF = 2816, NH = 8, HD = 128, NBLK = 64, BLK = 256;
constexpr float EPS = 1e-6f;
constexpr float C2 = 0.08838834764831845f * 1.4426950408889634f;
constexpr size_t MiB = 1u << 20;
constexpr size_t WS_CTL = 0, CTL_ZERO_BYTES = 256 * 1024;
constexpr int CW_BAR = 4096, CW_GCNT = 8192, CW_ROWSS = 16384;
constexpr size_t WS_KBAR = 1 * MiB, WS_RSTDX = 1 * MiB + 512 * 1024, WS_LPART = 2 * MiB;
constexpr size_t WS_WOA = 4 * MiB, WS_WOB = 6 * MiB, WS_WO = 8 * MiB;
constexpr size_t WS_Q = 10 * MiB, WS_K = 42 * MiB, WS_VT = 74 * MiB, WS_CA = 106 * MiB, WS_LIST = 138 * MiB, WS_WIN = 147 * MiB, WS_XB = 163 * MiB, WS_UU = 195 * MiB;
constexpr size_t WS_OPART = 147 * MiB;
constexpr size_t WS_WUP = 243 * MiB, WS_WDN = 138 * MiB, WS_MG = 165 * MiB, WS_HB = 198 * MiB;
constexpr size_t WS_ACT = 10 * MiB;
constexpr size_t WS_END = 256 * MiB;
constexpr int LDS_BYTES = 163840, MISC_OFF = 131072 + 320, HALO_OFF = 131072 + 1024, SCAN_OFF = 131072 + 1024;
__device__ __forceinline__ int list_off(int n) { return 256 * (63 * n - (n * (n - 1)) / 2); }
constexpr int LIST_PER_HEAD = 256 * 2016;

__device__ __forceinline__ float wave_sum(float v) {
#pragma unroll
    for (int o = 1; o < 64; o <<= 1) v += __shfl_xor(v, o);
    return v;
}
__device__ __forceinline__ void transpose_item(const float* W, int N, bf16* WT, int K, int k0, int col0, int row0, const float* ks, LAS float* scr, int lane) {
    float wv[32];
#pragma unroll
    for (int i = 0; i < 32; ++i) wv[i] = __builtin_nontemporal_load(W + (size_t)(k0 + 2 * i + (lane >> 5)) * N + col0 + (lane & 31));
#pragma unroll
    for (int i = 0; i < 32; ++i) { const int kk = 2 * i + (lane >> 5); const float s = ks ? ks[k0 + kk] : 1.0f; scr[kk * 33 + (lane & 31)] = s * wv[i]; }
    LDS_WAIT(); asm volatile("" ::: "memory");
    const int c = lane & 7;
#pragma unroll
    for (int j = 0; j < 4; ++j) { const int n = (lane >> 3) + 8 * j; const LAS float* s = scr + (8 * c) * 33 + n;
        v4u o; o.x = pk2(s[0 * 33], s[1 * 33]); o.y = pk2(s[2 * 33], s[3 * 33]); o.z = pk2(s[4 * 33], s[5 * 33]); o.w = pk2(s[6 * 33], s[7 * 33]);
        *(GAS v4u*)(WT + (size_t)(row0 + n) * K + k0 + 8 * c) = o; }
    LDS_WAIT(); asm volatile("" ::: "memory");
}
__device__ __forceinline__ int map_col(int mode, int R) {
    if (mode == 1) { if (R >= 1024 && R < 3072) { const int q = R - 1024; return 1024 + ((q >> 7) & 1) * 1024 + (q >> 8) * 128 + (q & 127); }
                     if (R >= 6144) { const int q = R - 6144; return 6144 + ((q >> 7) & 1) * 1024 + (q >> 8) * 128 + (q & 127); } return R; }
    if (mode == 2) return ((R >> 7) & 1) * DFF + (R >> 8) * 128 + (R & 127);
    return R;
}
__device__ __forceinline__ void convert_weight(const float* W, int K, int N, bf16* WT, const float* ks, int mode, LAS float* scr, int gw, int NGW, int lane) {
    const int nblk = N / 32, nitems = (K / 64) * nblk;
    for (int it = gw; it < nitems; it += NGW) { const int kb = it / nblk, nb = it % nblk; transpose_item(W, N, WT, K, 64 * kb, map_col(mode, 32 * nb), 32 * nb, ks, scr, lane); }
}

__device__ __forceinline__ void phase0(const float* x, const float* norm_mix, const float* w_in, const float* w_oa, const float* w_ob, const float* w_o, const float* w_up, const float* norm_ffn, unsigned char* ws, LAS unsigned char* lds, int vcu, int G, int wave, int lane) {
    LAS float* scr = (LAS float*)(lds + wave * 16384);
    const int gw = vcu * NWAVES + wave, NGW = G * NWAVES;
    convert_weight(w_in, D, NIN, (bf16*)(ws + WS_WIN), norm_mix, 1, scr, gw, NGW, lane);
    convert_weight(w_oa, D, D, (bf16*)(ws + WS_WOA), nullptr, 0, scr, gw, NGW, lane);
    convert_weight(w_ob, D, D, (bf16*)(ws + WS_WOB), nullptr, 0, scr, gw, NGW, lane);
    convert_weight(w_o, D, D, (bf16*)(ws + WS_WO), nullptr, 0, scr, gw, NGW, lane);
    convert_weight(w_up, D, 2 * DFF, (bf16*)(ws + WS_WUP), norm_ffn, 2, scr, gw, NGW, lane);
    bf16* XB = (bf16*)(ws + WS_XB); float* rstdx = (float*)(ws + WS_RSTDX);
    for (int m = gw; m < M; m += NGW) {
        const GAS f32x4* xr = (const GAS f32x4*)(x + (size_t)m * D) + lane; f32x4 v[4]; float s = 0.f;
#pragma unroll
        for (int j = 0; j < 4; ++j) { v[j] = __builtin_nontemporal_load(xr + 64 * j); s += (v[j].x * v[j].x + v[j].y * v[j].y) + (v[j].z * v[j].z + v[j].w * v[j].w); }
        s = wave_sum(s); if (lane == 0) rstdx[m] = rsqrtf(s * (1.f / D) + EPS);
        GAS unsigned long long* o8 = (GAS unsigned long long*)(XB + (size_t)m * D) + lane;
#pragma unroll
        for (int j = 0; j < 4; ++j) o8[64 * j] = (unsigned long long)pk2(v[j].x, v[j].y) | ((unsigned long long)pk2(v[j].z, v[j].w) << 32);
    }
}
__device__ __forceinline__ void phase2(const float* conv_a_w, unsigned char* ws, int G, int tid, bf16* __restrict__ CAout) {
    const bf16* __restrict__ BG = (const bf16*)(ws + WS_CA); const bf16* __restrict__ UU = (const bf16*)(ws + WS_UU);
    for (int item = blockIdx.x * NTHREADS + tid; item < 128 * (M / 16); item += G * NTHREADS) {
        const int cc = (item & 127) * 8, t0 = (item >> 7) * 16;
        float w0[8], w1[8], w2[8], um2[8], um1[8];
#pragma unroll
        for (int j = 0; j < 2; ++j) { const f32x4 a = *(const GAS f32x4*)(conv_a_w + cc + 4 * j), b = *(const GAS f32x4*)(conv_a_w + 1024 + cc + 4 * j), c = *(const GAS f32x4*)(conv_a_w + 2048 + cc + 4 * j);
#pragma unroll
            for (int e = 0; e < 4; ++e) { w0[4 * j + e] = a[e]; w1[4 * j + e] = b[e]; w2[4 * j + e] = c[e]; } }
        { v4u a = (v4u){0u, 0u, 0u, 0u}, b = a; if (t0 >= 2) { a = *(const GAS v4u*)(UU + (size_t)(t0 - 2) * 1024 + cc); b = *(const GAS v4u*)(UU + (size_t)(t0 - 1) * 1024 + cc); }
          const unsigned aw[4] = {a.x, a.y, a.z, a.w}, bw[4] = {b.x, b.y, b.z, b.w};
#pragma unroll
          for (int j = 0; j < 4; ++j) { um2[2 * j] = pg8::bf_lo(aw[j]); um2[2 * j + 1] = pg8::bf_hi(aw[j]); um1[2 * j] = pg8::bf_lo(bw[j]); um1[2 * j + 1] = pg8::bf_hi(bw[j]); } }
#pragma unroll 4
        for (int i = 0; i < 16; ++i) { const size_t o = (size_t)(t0 + i) * 1024 + cc;
            const v4u u = *(const GAS v4u*)(UU + o), b = *(const GAS v4u*)(BG + o); const unsigned uw[4] = {u.x, u.y, u.z, u.w}, bw[4] = {b.x, b.y, b.z, b.w};
            float r[8];
#pragma unroll
            for (int j = 0; j < 4; ++j) { const float u0 = pg8::bf_lo(uw[j]), u1 = pg8::bf_hi(uw[j]);
                r[2 * j] = pg8::bf_lo(bw[j]) * (w0[2 * j] * um2[2 * j] + w1[2 * j] * um1[2 * j] + w2[2 * j] * u0);
                r[2 * j + 1] = pg8::bf_hi(bw[j]) * (w0[2 * j + 1] * um2[2 * j + 1] + w1[2 * j + 1] * um1[2 * j + 1] + w2[2 * j + 1] * u1);
                um2[2 * j] = um1[2 * j]; um2[2 * j + 1] = um1[2 * j + 1]; um1[2 * j] = u0; um1[2 * j + 1] = u1; }
            v4u o4; o4.x = pk2(r[0], r[1]); o4.y = pk2(r[2], r[3]); o4.z = pk2(r[4], r[5]); o4.w = pk2(r[6], r[7]);
            *(GAS v4u*)(CAout + o) = o4; }
    }
}
__device__ __forceinline__ bool top_better(float v, int n, float cv, int cn) { return v > cv || (v == cv && n < cn); }
__device__ __forceinline__ void top3_insert(float v, int n, float (&tv)[3], int (&ti)[3]) {
    if (top_better(v, n, tv[0], ti[0])) { tv[2] = tv[1]; ti[2] = ti[1]; tv[1] = tv[0]; ti[1] = ti[0]; tv[0] = v; ti[0] = n; }
    else if (top_better(v, n, tv[1], ti[1])) { tv[2] = tv[1]; ti[2] = ti[1]; tv[1] = v; ti[1] = n; }
    else if (top_better(v, n, tv[2], ti[2])) { tv[2] = v; ti[2] = n; }
}
__device__ __forceinline__ void phase2d(unsigned char* ws, LAS unsigned char* lds, int G, int tid, int wave, int lane, unsigned* gcnt, unsigned short* glist) {
    LAS unsigned* lcnt = (LAS unsigned*)(lds + 32768); LAS unsigned* lbase = lcnt + 64; LAS unsigned short* llist = (LAS unsigned short*)lds;
    const bf16* Q = (const bf16*)(ws + WS_Q); const float* kbar = (const float*)(ws + WS_KBAR);
    const int fr = lane & 15, fq = lane >> 4;
    for (int unit = blockIdx.x; unit < NH * 63; unit += G) {
        const int h = unit / 63, c = 1 + unit % 63;
        if (tid < 64) lcnt[tid] = 0u;
        __syncthreads();
        bf16x8 qf[2][4];
#pragma unroll
        for (int g = 0; g < 2; ++g)
#pragma unroll
            for (int ks = 0; ks < 4; ++ks) qf[g][ks] = *(const GAS bf16x8*)(Q + (size_t)(c * BLK + wave * 32 + g * 16 + fr) * 1024 + h * HD + ks * 32 + fq * 8);
        float tv[2][3]; int ti[2][3];
#pragma unroll
        for (int g = 0; g < 2; ++g)
#pragma unroll
            for (int j = 0; j < 3; ++j) { tv[g][j] = -__builtin_inff(); ti[g][j] = 1 << 20; }
        const int ntile = (c + 15) >> 4;
        for (int tile = 0; tile < ntile; ++tile) {
            f32x4 s0 = (f32x4){0.f, 0.f, 0.f, 0.f}, s1 = s0;
#pragma unroll
            for (int ks = 0; ks < 4; ++ks) {
                const float* kp = kbar + ((size_t)(h * NBLK + tile * 16 + fr) * HD + ks * 32 + fq * 8);
                const f32x4 a = *(const GAS f32x4*)kp, b = *(const GAS f32x4*)(kp + 4);
                const v4u hw = pg8::pack8(a, b);
                f32x4 ra, rb; ra[0] = a[0] - pg8::bf_lo(hw.x); ra[1] = a[1] - pg8::bf_hi(hw.x); ra[2] = a[2] - pg8::bf_lo(hw.y); ra[3] = a[3] - pg8::bf_hi(hw.y);
                rb[0] = b[0] - pg8::bf_lo(hw.z); rb[1] = b[1] - pg8::bf_hi(hw.z); rb[2] = b[2] - pg8::bf_lo(hw.w); rb[3] = b[3] - pg8::bf_hi(hw.w);
                const v4u lw = pg8::pack8(ra, rb);
                const bf16x8 hi = __builtin_bit_cast(bf16x8, hw), lo = __builtin_bit_cast(bf16x8, lw);
                s0 = __builtin_amdgcn_mfma_f32_16x16x32_bf16(hi, qf[0][ks], s0, 0, 0, 0); s0 = __builtin_amdgcn_mfma_f32_16x16x32_bf16(lo, qf[0][ks], s0, 0, 0, 0);
                s1 = __builtin_amdgcn_mfma_f32_16x16x32_bf16(hi, qf[1][ks], s1, 0, 0, 0); s1 = __builtin_amdgcn_mfma_f32_16x16x32_bf16(lo, qf[1][ks], s1, 0, 0, 0);
            }
#pragma unroll
            for (int i = 0; i < 4; ++i) { const int n = tile * 16 + 4 * fq + i;
                top3_insert(n < c ? s0[i] : -__builtin_inff(), n, tv[0], ti[0]); top3_insert(n < c ? s1[i] : -__builtin_inff(), n, tv[1], ti[1]); }
        }
#pragma unroll
        for (int off = 16; off <= 32; off <<= 1)
#pragma unroll
            for (int g = 0; g < 2; ++g) { float pv[3]; int pi[3];
#pragma unroll
                for (int j = 0; j < 3; ++j) { pv[j] = __shfl_xor(tv[g][j], off); pi[j] = __shfl_xor(ti[g][j], off); }
#pragma unroll
                for (int j = 0; j < 3; ++j) top3_insert(pv[j], pi[j], tv[g], ti[g]); }
        const int nsel = c < 3 ? c : 3;
        if (fq == 0) {
#pragma unroll
            for (int g = 0; g < 2; ++g) { const int tl = wave * 32 + g * 16 + fr;
#pragma unroll
                for (int j = 0; j < 3; ++j) if (j < nsel) { const int n = ti[g][j]; const unsigned pp = __hip_atomic_fetch_add(&lcnt[n], 1u, __ATOMIC_RELAXED, __HIP_MEMORY_SCOPE_WORKGROUP); llist[n * 256 + pp] = (unsigned short)((tl << 2) | j); } }
        }
        __syncthreads();
        if (tid < c) { const unsigned k = lcnt[tid]; lbase[tid] = k ? atomicAdd(gcnt + h * NBLK + tid, k) : 0u; }
        __syncthreads();
        for (int n = wave; n < c; n += NWAVES) { const unsigned k = lcnt[n], base = lbase[n];
            unsigned short* dst = glist + (size_t)h * LIST_PER_HEAD + list_off(n) + base;
            for (unsigned i = lane; i < k; i += 64) { const unsigned e = llist[n * 256 + i]; dst[i] = (unsigned short)((((unsigned)c * BLK + (e >> 2)) << 2) | (e & 3u)); } }
        __syncthreads();
    }
}
__device__ __forceinline__ void stage_kv(const bf16* Kg, const bf16* Vt, int h, int n, LAS unsigned char* lds, int tid) {
    v4u kw[8], vw[8];
#pragma unroll
    for (int i = 0; i < 8; ++i) { const int row = (tid >> 4) + 32 * i, ch = tid & 15; kw[i] = *(const GAS v4u*)(Kg + (size_t)(n * BLK + row) * 1024 + h * HD + ch * 8); }
#pragma unroll
    for (int i = 0; i < 8; ++i) { const int row = (tid >> 5) + 16 * i, ch = tid & 31; vw[i] = *(const GAS v4u*)(Vt + (size_t)(h * HD + row) * M + n * BLK + ch * 8); }
    __syncthreads();
#pragma unroll
    for (int i = 0; i < 8; ++i) { const int row = (tid >> 4) + 32 * i, ch = tid & 15; const int sw = (((row >> 3) & 3) << 2) | (row & 3);
        *(LAS v4u*)(lds + row * 256 + ((ch ^ sw) << 4)) = kw[i]; }
#pragma unroll
    for (int i = 0; i < 8; ++i) { const int row = (tid >> 5) + 16 * i, ch = tid & 31;
        *(LAS v4u*)(lds + 65536 + row * 512 + ((ch ^ ((((row >> 4) & 3) << 2) | (row & 3))) << 4)) = vw[i]; }
}
__device__ __forceinline__ void load_q(bf16x8 (&qf)[2][4], const bf16* Q, int h, const int (&tq)[2], int fq) {
#pragma unroll
    for (int g = 0; g < 2; ++g)
#pragma unroll
        for (int ks = 0; ks < 4; ++ks) qf[g][ks] = *(const GAS bf16x8*)(Q + (size_t)tq[g] * 1024 + h * HD + ks * 32 + fq * 8);
}
template <bool CAUSAL, int MODE = 0>
__device__ __forceinline__ void attn_core(const LAS unsigned char* lds, const bf16x8 (&qf)[2][4], int wave, int fr, int fq, float B2, f32x4 (&O)[8][2], float (&l)[2]) {
#pragma unroll
    for (int dt = 0; dt < 8; ++dt) { O[dt][0] = (f32x4){0.f, 0.f, 0.f, 0.f}; O[dt][1] = O[dt][0]; }
    l[0] = 0.f; l[1] = 0.f;
    const int nch = CAUSAL ? wave + 1 : 8;
    const int krow = (fr >> 2) * 8 + (fr & 3);
    bf16x8 kf[4][2];
#pragma unroll
    for (int ks = 0; ks < 4; ++ks)
#pragma unroll
        for (int t = 0; t < 2; ++t) kf[ks][t] = *(const LAS bf16x8*)(lds + (krow + t * 4) * 256 + (((ks * 4 + fq) ^ fr) << 4));
#pragma unroll 2
    for (int c = 0; c < nch; ++c) {
        f32x4 s[2][2];
#pragma unroll
        for (int t = 0; t < 2; ++t) { s[t][0] = (f32x4){-B2, -B2, -B2, -B2}; s[t][1] = s[t][0]; }
        bf16x8 vf[8];
#pragma unroll
        for (int dt = 0; dt < 8; ++dt) vf[dt] = *(const LAS bf16x8*)(lds + 65536 + ((dt >> 2) * 64 + (fr >> 2) * 16 + (dt & 3) * 4 + (fr & 3)) * 512 + (((c * 4 + fq) ^ fr) << 4));
        __builtin_amdgcn_s_setprio(1);
#pragma unroll
        for (int ks = 0; ks < 4; ++ks)
#pragma unroll
            for (int t = 0; t < 2; ++t) {
                if (MODE != 2 || ks == 0) {
                s[t][0] = __builtin_amdgcn_mfma_f32_16x16x32_bf16(kf[ks][t], qf[0][ks], s[t][0], 0, 0, 0);
                s[t][1] = __builtin_amdgcn_mfma_f32_16x16x32_bf16(kf[ks][t], qf[1][ks], s[t][1], 0, 0, 0); }
            }
        __builtin_amdgcn_s_setprio(0);
        __builtin_amdgcn_sched_barrier(0);
        { const int cn = (c + 1 < nch) ? c + 1 : c;
#pragma unroll
          for (int ks = 0; ks < 4; ++ks)
#pragma unroll
              for (int t = 0; t < 2; ++t) kf[ks][t] = *(const LAS bf16x8*)(lds + (cn * 32 + krow + t * 4) * 256 + (((ks * 4 + fq) ^ fr) << 4)); }
        bf16x8 pf[2];
#pragma unroll
        for (int g = 0; g < 2; ++g) {
            float p[8];
#pragma unroll
            for (int t = 0; t < 2; ++t)
#pragma unroll
                for (int i = 0; i < 4; ++i) { float e = MODE == 1 ? s[t][g][i] : __builtin_amdgcn_exp2f(s[t][g][i]);
                    if (CAUSAL && c == wave) { const int kl = c * 32 + fq * 8 + t * 4 + i, ql = wave * 32 + g * 16 + fr; if (kl > ql) e = 0.f; }
                    p[t * 4 + i] = e; }
            l[g] += ((p[0] + p[1]) + (p[2] + p[3])) + ((p[4] + p[5]) + (p[6] + p[7]));
            v4u w; w.x = pg8::cvt_pk_bf16(p[0], p[1]); w.y = pg8::cvt_pk_bf16(p[2], p[3]); w.z = pg8::cvt_pk_bf16(p[4], p[5]); w.w = pg8::cvt_pk_bf16(p[6], p[7]);
            pf[g] = __builtin_bit_cast(bf16x8, w);
        }
        __builtin_amdgcn_s_setprio(1);
#pragma unroll
        for (int dt = 0; dt < 8; ++dt) {
            if (MODE != 3 || dt == 0) {
            O[dt][0] = __builtin_amdgcn_mfma_f32_16x16x32_bf16(vf[dt], pf[0], O[dt][0], 0, 0, 0);
            O[dt][1] = __builtin_amdgcn_mfma_f32_16x16x32_bf16(vf[dt], pf[1], O[dt][1], 0, 0, 0); }
        }
        __builtin_amdgcn_s_setprio(0);
    }
    l[0] += __shfl_xor(l[0], 16); l[0] += __shfl_xor(l[0], 32); l[1] += __shfl_xor(l[1], 16); l[1] += __shfl_xor(l[1], 32);
}
__device__ __forceinline__ float score_bound(const float* q_norm, const float* k_norm, int lane) {
    float a = fmaxf(fabsf(q_norm[lane]), fabsf(q_norm[lane + 64])), b = fmaxf(fabsf(k_norm[lane]), fabsf(k_norm[lane + 64]));
#pragma unroll
    for (int o = 1; o < 64; o <<= 1) { a = fmaxf(a, __shfl_xor(a, o)); b = fmaxf(b, __shfl_xor(b, o)); }
    return 128.0f * a * b * C2 * 1.001f + 0.01f;
}
template <int MODE>
__device__ __forceinline__ void phase3a(const float* q_norm, const float* k_norm, unsigned char* ws, LAS unsigned char* lds, int G, int tid, int wave, int lane) {
    const int fr = lane & 15, fq = lane >> 4;
    LAS int* pre = (LAS int*)(lds + SCAN_OFF);
    LAS int* cntl = (LAS int*)(lds + SCAN_OFF + 2080);
    const unsigned* gcnt = (const unsigned*)(ws + WS_CTL) + CW_GCNT; const unsigned short* glist = (const unsigned short*)(ws + WS_LIST);
    const bf16* Q = (const bf16*)(ws + WS_Q); const bf16* Kg = (const bf16*)(ws + WS_K); const bf16* Vt = (const bf16*)(ws + WS_VT);
    unsigned char* OP = ws + WS_OPART; float* LP = (float*)(ws + WS_LPART);
    const float B2 = score_bound(q_norm, k_norm, lane);
    { const int cnt = (int)__hip_atomic_load(gcnt + tid, __ATOMIC_RELAXED, __HIP_MEMORY_SCOPE_AGENT); pre[tid + 1] = (cnt + 255) >> 8; cntl[tid] = cnt; if (tid == 0) pre[0] = 0; }
    __syncthreads();
    for (int o = 1; o < 512; o <<= 1) { const int v = pre[tid + 1] + ((tid + 1 - o) >= 1 ? pre[tid + 1 - o] : 0); __syncthreads(); pre[tid + 1] = v; __syncthreads(); }
    const int T = pre[512];
    const int i_lo = (int)(((long)blockIdx.x * T) / G), i_hi = (int)(((long)(blockIdx.x + 1) * T) / G);
    int staged = -1;
#define P3A_DECODE(IT, HN, TILE) do { int lo_ = 0, hi_ = 511; while (lo_ < hi_) { const int mid_ = (lo_ + hi_ + 1) >> 1; if (pre[mid_] <= (IT)) lo_ = mid_; else hi_ = mid_ - 1; } HN = lo_; TILE = (IT) - pre[lo_]; } while (0)
    unsigned en[2] = {0u, 0u}; bool okn[2] = {false, false};
    bf16x8 qf[2][4]; int hnn = 0;
    if (i_lo < i_hi) { int hn, tile; P3A_DECODE(i_lo, hn, tile); const int cnt = cntl[hn]; const unsigned short* lst = glist + (size_t)(hn >> 6) * LIST_PER_HEAD + list_off(hn & 63) + tile * 256;
#pragma unroll
        for (int g = 0; g < 2; ++g) { const int qi = wave * 32 + g * 16 + fr; okn[g] = tile * 256 + qi < cnt; en[g] = okn[g] ? lst[qi] : 0u; }
        { const int tq0[2] = {(int)(en[0] >> 2), (int)(en[1] >> 2)}; load_q(qf, Q, hn >> 6, tq0, fq); } }
    for (int it = i_lo; it < i_hi; ++it) {
        int hn, tile; P3A_DECODE(it, hn, tile); const int h = hn >> 6, n = hn & 63;
        int tq[2], sj[2]; bool ok[2];
#pragma unroll
        for (int g = 0; g < 2; ++g) { ok[g] = okn[g]; tq[g] = (int)(en[g] >> 2); sj[g] = (int)(en[g] & 3u); }
        if (it + 1 < i_hi) { int hn2, tile2; P3A_DECODE(it + 1, hn2, tile2); hnn = hn2; const int cnt2 = cntl[hn2]; const unsigned short* lst2 = glist + (size_t)(hn2 >> 6) * LIST_PER_HEAD + list_off(hn2 & 63) + tile2 * 256;
#pragma unroll
            for (int g = 0; g < 2; ++g) { const int qi = wave * 32 + g * 16 + fr; okn[g] = tile2 * 256 + qi < cnt2; en[g] = okn[g] ? lst2[qi] : 0u; } }
        if (hn != staged) { stage_kv(Kg, Vt, h, n, lds, tid); LDS_WAIT(); __syncthreads(); staged = hn; }
        f32x4 O[8][2]; float l[2];
        attn_core<false, MODE>(lds, qf, wave, fr, fq, B2, O, l);
        if (it + 1 < i_hi) { const int tqn[2] = {(int)(en[0] >> 2), (int)(en[1] >> 2)}; load_q(qf, Q, hnn >> 6, tqn, fq); }
#pragma unroll
        for (int g = 0; g < 2; ++g) if (ok[g]) {
            unsigned char* op = OP + ((size_t)sj[g] * M + tq[g]) * 1024 + h * HD + 16 * fq;
            const float sc = 16.0f / l[g];
#pragma unroll
            for (int j = 0; j < 2; ++j) { v4u w;
                { int t = 0; t = __builtin_amdgcn_cvt_pk_fp8_f32(O[4 * j][g][0] * sc, O[4 * j][g][1] * sc, t, false); t = __builtin_amdgcn_cvt_pk_fp8_f32(O[4 * j][g][2] * sc, O[4 * j][g][3] * sc, t, true); w.x = (unsigned)t; }
                { int t = 0; t = __builtin_amdgcn_cvt_pk_fp8_f32(O[4 * j + 1][g][0] * sc, O[4 * j + 1][g][1] * sc, t, false); t = __builtin_amdgcn_cvt_pk_fp8_f32(O[4 * j + 1][g][2] * sc, O[4 * j + 1][g][3] * sc, t, true); w.y = (unsigned)t; }
                { int t = 0; t = __builtin_amdgcn_cvt_pk_fp8_f32(O[4 * j + 2][g][0] * sc, O[4 * j + 2][g][1] * sc, t, false); t = __builtin_amdgcn_cvt_pk_fp8_f32(O[4 * j + 2][g][2] * sc, O[4 * j + 2][g][3] * sc, t, true); w.z = (unsigned)t; }
                { int t = 0; t = __builtin_amdgcn_cvt_pk_fp8_f32(O[4 * j + 3][g][0] * sc, O[4 * j + 3][g][1] * sc, t, false); t = __builtin_amdgcn_cvt_pk_fp8_f32(O[4 * j + 3][g][2] * sc, O[4 * j + 3][g][3] * sc, t, true); w.w = (unsigned)t; }
                *(GAS v4u*)(op + j * 64) = w; }
            if (fq == 0) LP[((size_t)sj[g] * M + tq[g]) * NH + h] = l[g];
        }
    }
#undef P3A_DECODE
    __syncthreads();
}
__device__ __forceinline__ void phase3b(const float* q_norm, const float* k_norm, unsigned char* ws, LAS unsigned char* lds, int G, int tid, int wave, int lane, bf16* Oout) {
    const int fr = lane & 15, fq = lane >> 4;
    bf16* Q = (bf16*)(ws + WS_Q); const bf16* Kg = (const bf16*)(ws + WS_K); const bf16* Vt = (const bf16*)(ws + WS_VT);
    const unsigned char* OP = ws + WS_OPART; const float* LP = (const float*)(ws + WS_LPART);
    const float B2 = score_bound(q_norm, k_norm, lane);
    bf16x8 qf[2][4];
    if ((int)blockIdx.x < NH * NBLK) { const int u0 = blockIdx.x; const int tq0[2] = {(u0 & 63) * BLK + wave * 32 + fr, (u0 & 63) * BLK + wave * 32 + 16 + fr}; load_q(qf, Q, u0 >> 6, tq0, fq); }
    for (int unit = blockIdx.x; unit < NH * NBLK; unit += G) {
        const int h = unit >> 6, c = unit & 63;
        stage_kv(Kg, Vt, h, c, lds, tid); LDS_WAIT(); __syncthreads();
        int tq[2];
#pragma unroll
        for (int g = 0; g < 2; ++g) tq[g] = c * BLK + wave * 32 + g * 16 + fr;
        f32x4 O[8][2]; float l[2];
        attn_core<true>(lds, qf, wave, fr, fq, B2, O, l);
        if (unit + G < NH * NBLK) { const int u1 = unit + G; const int tqn[2] = {(u1 & 63) * BLK + wave * 32 + fr, (u1 & 63) * BLK + wave * 32 + 16 + fr}; load_q(qf, Q, u1 >> 6, tqn, fq); }
        const int nsel = c < 3 ? c : 3;
#pragma unroll
        for (int g = 0; g < 2; ++g) {
            float lp[3];
#pragma unroll
            for (int j = 0; j < 3; ++j) lp[j] = LP[((size_t)j * M + tq[g]) * NH + h];
            v4u w[3][2];
#pragma unroll
            for (int j = 0; j < 3; ++j)
#pragma unroll
                for (int k = 0; k < 2; ++k) w[j][k] = *(const GAS v4u*)(OP + ((size_t)j * M + tq[g]) * 1024 + h * HD + k * 64 + 16 * fq);
            float lt = l[g]; float ls[3];
#pragma unroll
            for (int j = 0; j < 3; ++j) { ls[j] = j < nsel ? lp[j] * (1.0f / 16.0f) : 0.f; lt += j < nsel ? lp[j] : 0.f; }
            const float inv = 1.0f / lt;
#pragma unroll
            for (int k = 0; k < 2; ++k) {
                f32x4 o[4];
#pragma unroll
                for (int q = 0; q < 4; ++q) o[q] = O[4 * k + q][g];
#pragma unroll
                for (int j = 0; j < 3; ++j) if (j < nsel) { const unsigned xw[4] = {w[j][k].x, w[j][k].y, w[j][k].z, w[j][k].w};
#pragma unroll
                    for (int q = 0; q < 4; ++q) { const pg8::f32x2_t_ lo = __builtin_amdgcn_cvt_pk_f32_fp8((int)xw[q], false), hi = __builtin_amdgcn_cvt_pk_f32_fp8((int)xw[q], true);
                        o[q][0] += lo[0] * ls[j]; o[q][1] += lo[1] * ls[j]; o[q][2] += hi[0] * ls[j]; o[q][3] += hi[1] * ls[j]; } }
                bf16* dst = Oout + (size_t)tq[g] * 1024 + h * HD + k * 64 + 16 * fq;
                *(GAS v4u*)dst = pg8::pack8(o[0] * inv, o[1] * inv); *(GAS v4u*)(dst + 8) = pg8::pack8(o[2] * inv, o[3] * inv); }
        }
    }
    __syncthreads();
}

#ifndef MK_PER_PHASE
#define MK_PER_PHASE 0
#endif
#ifndef MK_DUP
#define MK_DUP -1
#endif
constexpr int N_PHASES = 9;
struct Args { const float* in[14]; float* out; unsigned char* ws; int ph_lo, ph_hi; };
__global__ void __launch_bounds__(NTHREADS, 2) hybrid_fwd(Args args) {
    extern __shared__ __attribute__((aligned(16))) unsigned char lds_raw[];
    LAS unsigned char* lds = (LAS unsigned char*)lds_raw;
    volatile LAS unsigned* MISC = (volatile LAS unsigned*)(lds + MISC_OFF);
    const int tid = threadIdx.x, lane = tid & 63, wave = __builtin_amdgcn_readfirstlane(tid >> 6);
    const int G = gridDim.x; const int vcu = (G % 8 == 0) ? ((int)blockIdx.x % 8) * (G / 8) + (int)blockIdx.x / 8 : (int)blockIdx.x;
    unsigned char* ws = args.ws;
    gu32* ctl = (gu32*)(ws + WS_CTL);
    if (tid < 32) MISC[tid] = 0u;
    __syncthreads();
    const int lo = args.ph_lo, hi = args.ph_hi;
    XcdBarrier bar; bar.bar = (unsigned*)ctl + CW_BAR; bar.x = 0; bar.st = nullptr;
    if (hi - lo > 1) bar = xcd_barrier_post((unsigned*)ctl + CW_BAR, MISC + 8);
#ifndef PHASE_MASK
#define PHASE_MASK 0x1ff
#endif
#define IN(k) (((PHASE_MASK >> (k)) & 1) && lo <= (k) && (k) < hi)
#define SEAM(k) do { if (IN(k) && IN((k) + 1)) xcd_barrier(bar); } while (0)
    const float* x = args.in[0]; const float* norm_mix = args.in[1]; const float* w_in = args.in[2]; const float* conv_a_w = args.in[3]; const float* q_norm = args.in[4]; const float* k_norm = args.in[5];
    const float* w_oa = args.in[6]; const float* w_ob = args.in[7]; const float* w_o = args.in[8]; const float* norm_ffn = args.in[9]; const float* w_up = args.in[10]; const float* ffn_conv_w = args.in[11];
    const float* ffn_conv_b = args.in[12]; const float* w_down = args.in[13];
    float* out = args.out;
    float* rowss = (float*)((unsigned*)ctl + CW_ROWSS);
    const size_t TSTEP = (size_t)256 * 1024 * 2;

    if (IN(0)) { phase0(x, norm_mix, w_in, w_oa, w_ob, w_o, w_up, norm_ffn, ws, lds, vcu, G, wave, lane); __syncthreads(); }
    SEAM(0);
    if (IN(1)) {
        pg8::Gemm g{(const bf16*)(ws + WS_XB), (const bf16*)(ws + WS_XB), (const bf16*)(ws + WS_WIN), (const bf16*)(ws + WS_WIN), D, TSTEP};
        pg8::StaticOrder S; S.init(M / 256, NIN / 256, G, (int)blockIdx.x);
        pg8::Epi1 E{(bf16*)(ws + WS_CA), (bf16*)(ws + WS_UU), (bf16*)(ws + WS_Q), (bf16*)(ws + WS_K), (bf16*)(ws + WS_VT), (bf16*)out, (const float*)(ws + WS_RSTDX), q_norm, k_norm, (float*)(ws + WS_KBAR), (PG8_LAS float*)(lds + HALO_OFF)};
        pg8::gemm_phase<pg8::Epi1, pg8::StaticOrder, true, true>(lds, g, S, E);
    }
    SEAM(1);
    if (IN(2)) { phase2d(ws, lds, G, tid, wave, lane, (unsigned*)(ws + WS_CTL) + CW_GCNT, (unsigned short*)(ws + WS_LIST));
        phase2(conv_a_w, ws, G, tid, (bf16*)(ws + WS_CA)); __syncthreads(); }
#if MK_DUP == 21
    if (IN(2)) { phase2d(ws, lds, G, tid, wave, lane, (unsigned*)(ws + WS_CTL) + CW_GCNT + 512, (unsigned short*)(ws + WS_WIN)); }
#endif
#if MK_DUP == 22
    if (IN(2)) { phase2(conv_a_w, ws, G, tid, (bf16*)(ws + WS_XB)); }
#endif
    SEAM(2);
#if MK_DUP >= 30 && MK_DUP <= 35
    if (IN(3)) phase3a<MK_DUP - 30>(q_norm, k_norm, ws, lds, G, tid, wave, lane);
#endif
    if (IN(3)) phase3a<0>(q_norm, k_norm, ws, lds, G, tid, wave, lane);
    SEAM(3);
    if (IN(4)) { phase3b(q_norm, k_norm, ws, lds, G, tid, wave, lane, (bf16*)(ws + WS_Q));
#if MK_DUP == 4
        phase3b(q_norm, k_norm, ws, lds, G, tid, wave, lane, (bf16*)(ws + WS_OPART));
#endif
        }
    SEAM(4);
    if (IN(5)) {
        { LAS float* scr = (LAS float*)(lds + wave * 16384); const int gw = vcu * NWAVES + wave, NGW = G * NWAVES;
          if (blockIdx.x == 0 && tid < 256) *(GAS v4u*)(ws + WS_HB - 4096 + tid * 16) = (v4u){0u, 0u, 0u, 0u};
          __syncthreads(); }
        pg8::Gemm g{(const bf16*)(ws + WS_CA), (const bf16*)(ws + WS_Q), (const bf16*)(ws + WS_WOA), (const bf16*)(ws + WS_WOB), D, TSTEP};
        pg8::DualOrder S; S.S.init(M / 256, D / 256, G, (int)blockIdx.x);
        pg8::Epi4 E{(bf16*)(ws + WS_MG), (const bf16*)out};
        pg8::gemm_phase<pg8::Epi4, pg8::DualOrder, true, true>(lds, g, S, E);
    }
    SEAM(5);
    if (IN(6)) {
        pg8::Gemm g{(const bf16*)(ws + WS_MG), (const bf16*)(ws + WS_MG), (const bf16*)(ws + WS_WO), (const bf16*)(ws + WS_WO), D, TSTEP};
        pg8::StaticOrder S; S.init(M / 256, D / 256, G, (int)blockIdx.x);
        pg8::Epi5 E{x, out, (bf16*)(ws + WS_HB), rowss};
        pg8::gemm_phase<pg8::Epi5, pg8::StaticOrder, true, true>(lds, g, S, E);
#if MK_DUP == 6
        { pg8::Epi5 E2{x, (float*)(ws + WS_Q), (bf16*)(ws + WS_VT), (float*)(ws + WS_CA)}; pg8::gemm_phase<pg8::Epi5, pg8::StaticOrder, true, true>(lds, g, S, E2); }
#endif
    }
    SEAM(6);
    if (IN(7)) {
        const bf16* hb2 = (const bf16*)(ws + WS_HB) - 2 * 1024;
        pg8::Gemm g{hb2, hb2, (const bf16*)(ws + WS_WUP), (const bf16*)(ws + WS_WUP), D, (size_t)254 * 1024 * 2};
        pg8::StaticOrder S; S.init(65, 22, G, (int)blockIdx.x);
        pg8::Epi6 E{(bf16*)(ws + WS_ACT), rowss, ffn_conv_w, ffn_conv_b, (PG8_LAS float*)(lds + HALO_OFF)};
        pg8::gemm_phase<pg8::Epi6, pg8::StaticOrder, true, true>(lds, g, S, E);
        { const int nwg = 65 * 22, full = nwg % G, nidle = full ? G - full : G, idx = full ? (int)blockIdx.x - full : (int)blockIdx.x;
          if (idx >= 0) convert_weight(w_down, DFF, D, (bf16*)(ws + WS_WDN), nullptr, 0, (LAS float*)(lds + wave * 16384), idx * NWAVES + wave, nidle * NWAVES, lane);
          __syncthreads(); }
    }
    SEAM(7);
    if (IN(8)) {
        pg8::Gemm g{(const bf16*)(ws + WS_ACT), (const bf16*)(ws + WS_ACT), (const bf16*)(ws + WS_WDN), (const bf16*)(ws + WS_WDN), DFF, (size_t)256 * DFF * 2};
        pg8::StaticOrder S; S.init(M / 256, D / 256, G, (int)blockIdx.x);
        pg8::Epi7 E{out, (const bf16*)(ws + WS_HB)};
        pg8::gemm_phase<pg8::Epi7, pg8::StaticOrder, true, true>(lds, g, S, E);
#if MK_DUP == 8
        { pg8::Epi7 E2{(float*)(ws + WS_MG), (const bf16*)(ws + WS_HB)}; pg8::gemm_phase<pg8::Epi7, pg8::StaticOrder, true, true>(lds, g, S, E2); }
#endif
    }
#undef IN
#undef SEAM
}

extern "C" void kernel_launch(void* const* d_in, const int* in_sizes, int n_in, void* d_out, int out_size, void* d_ws, size_t ws_size, hipStream_t stream) {
    static int grid = 0;
    if (grid == 0) {
        if (n_in != 14 || in_sizes[0] != M * D || out_size != M * D || ws_size < WS_END) { fprintf(stderr, "kernel_launch: unexpected shapes (n_in %d, in0 %d, out %d, ws %zu)\n", n_in, n_in > 0 ? in_sizes[0] : -1, out_size, ws_size); grid = -1; return; }
        int dev = 0, cus = 0, per_cu = 0;
        if (hipGetDevice(&dev) != hipSuccess || hipDeviceGetAttribute(&cus, hipDeviceAttributeMultiprocessorCount, dev) != hipSuccess) { grid = -1; return; }
        if (hipFuncSetAttribute((const void*)hybrid_fwd, hipFuncAttributeMaxDynamicSharedMemorySize, LDS_BYTES) != hipSuccess) { fprintf(stderr, "kernel_launch: hipFuncSetAttribute failed\n"); grid = -1; return; }
        if (hipOccupancyMaxActiveBlocksPerMultiprocessor(&per_cu, (const void*)hybrid_fwd, NTHREADS, LDS_BYTES) != hipSuccess || per_cu < 1) { fprintf(stderr, "kernel_launch: occupancy query says %d blocks per CU\n", per_cu); (void)hipGetLastError(); grid = -1; return; }
        grid = cus;
    }
    if (grid < 0) return;
    if (hipMemsetAsync((char*)d_ws + WS_CTL, 0, CTL_ZERO_BYTES, stream) != hipSuccess) { fprintf(stderr, "kernel_launch: memset failed\n"); return; }
    Args a{};
    for (int i = 0; i < 14; ++i) a.in[i] = (const float*)d_in[i];
    a.out = (float*)d_out; a.ws = (unsigned char*)d_ws;
#if MK_PER_PHASE
    for (int p = 0; p < N_PHASES; ++p) { a.ph_lo = p; a.ph_hi = p + 1; hipLaunchKernelGGL(hybrid_fwd, dim3(grid), dim3(NTHREADS), LDS_BYTES, stream, a); }
#else
    a.ph_lo = 0; a.ph_hi = N_PHASES;
    void* kargs[] = {&a};
    hipError_t e = hipLaunchCooperativeKernel((const void*)hybrid_fwd, dim3(grid), dim3(NTHREADS), kargs, LDS_BYTES, stream);
    if (e != hipSuccess) fprintf(stderr, "kernel_launch: cooperative launch failed: %s (grid %d)\n", hipGetErrorString(e), grid);
#endif
}
```

```cpp
#include <hip/hip_runtime.h>
#include <cstdio>
#include <cstdint>
namespace pg8 {
#define PG8_LAS __attribute__((address_space(3)))
typedef unsigned short bf16_t;
typedef short bf16x8 __attribute__((ext_vector_type(8)));
typedef float f32x4 __attribute__((ext_vector_type(4)));
typedef unsigned u32x4 __attribute__((ext_vector_type(4)));
constexpr int BM = 256, BK = 64, HALF = 128, HTB = HALF * BK * 2  , STAGE_BYTES = 8 * HTB, NXCD = 8, WGM = 8;

__host__ __device__ __forceinline__ int lds_byte(int r, int c) { const int st = (r >> 4) * 2 + (c >> 5), rr = r & 15, cc = c & 31, ob = rr * 64 + cc * 2; return st * 1024 + (ob ^ (((ob >> 9) & 1) << 5)); }
__host__ __device__ __forceinline__ void stage_rc(int b, int& R, int& C) { const int st = b / 1024, sb = b % 1024, swz = sb ^ (((sb >> 9) & 1) << 5); R = (st >> 1) * 16 + swz / 64; C = (st & 1) * 32 + (swz % 64) / 2; }
__host__ __device__ __forceinline__ int perm32(int rho) { const int n = rho >> 4, i = rho & 15; return 8 * (i >> 2) + 4 * n + (i & 3); }


struct Unit { int pm, pn, sel; };
struct Gemm { const bf16_t* A0; const bf16_t* A1; const bf16_t* B0; const bf16_t* B1; int K; size_t a_tstep; };

struct StaticOrder {
    int nM, nN, nwg, G, c;
    __host__ __device__ void init(int nM_, int nN_, int G_, int c_) { nM = nM_; nN = nN_; nwg = nM * nN; G = G_; c = c_; }
    __host__ __device__ bool next(int i, Unit& u) const {
        const long L = (long)i * G + c; if (L >= nwg) return false;
        int wgid = (int)L; { const int q = nwg / NXCD, r = nwg % NXCD, xcd = wgid % NXCD, off = wgid / NXCD; wgid = (xcd < r ? xcd * (q + 1) : r * (q + 1) + (xcd - r) * q) + off; }
        const int nig = WGM * nN, gid = wgid / nig, fm = gid * WGM, gsz = (nM - fm) < WGM ? (nM - fm) : WGM;
        u.pm = fm + ((wgid % nig) % gsz); u.pn = (wgid % nig) / gsz; u.sel = 0; return true;
    }
    __device__ __forceinline__ void a_ready(const Unit&) const {}
    __device__ __forceinline__ void done(const Unit&) const {}
};
struct DualOrder {
    StaticOrder S;
    __host__ __device__ bool next(int i, Unit& u) const { const bool ok = S.next(i >> 1, u); u.sel = i & 1; return ok; }
    __device__ __forceinline__ void a_ready(const Unit&) const {}
    __device__ __forceinline__ void done(const Unit&) const {}
};

typedef __bf16 bf16x2_t_ __attribute__((ext_vector_type(2))); typedef float f32x2_t_ __attribute__((ext_vector_type(2)));
__device__ __forceinline__ unsigned cvt_pk_bf16(float lo, float hi) { const f32x2_t_ v = {lo, hi}; const bf16x2_t_ b = __builtin_convertvector(v, bf16x2_t_); return __builtin_bit_cast(unsigned, b); }
__device__ __forceinline__ float bf_lo(unsigned w) { return __uint_as_float(w << 16); }
__device__ __forceinline__ float bf_hi(unsigned w) { return __uint_as_float(w & 0xffff0000u); }
__device__ __forceinline__ float fast_sigmoid(float x) { return __builtin_amdgcn_rcpf(1.0f + __builtin_amdgcn_exp2f(-1.4426950408889634f * x)); }
__device__ __forceinline__ u32x4 pack8(const f32x4 a, const f32x4 b) { u32x4 w; w.x = cvt_pk_bf16(a[0], a[1]); w.y = cvt_pk_bf16(a[2], a[3]); w.z = cvt_pk_bf16(b[0], b[1]); w.w = cvt_pk_bf16(b[2], b[3]); return w; }

template <int CTRL> __device__ __forceinline__ float dpp_shr(float old, float v) { return __builtin_bit_cast(float, __builtin_amdgcn_update_dpp(__builtin_bit_cast(int, old), __builtin_bit_cast(int, v), CTRL, 0xf, 0xf, false)); }
template <int CTRL> __device__ __forceinline__ float dpp_ror(float v) { return __builtin_bit_cast(float, __builtin_amdgcn_update_dpp(0, __builtin_bit_cast(int, v), CTRL, 0xf, 0xf, true)); }
constexpr int MROWS = 16384, DMODEL = 1024, DFF_ = 2816;

struct Epi1 {
    static constexpr bool PERM = true, AFTER_DRAIN = false, APERM = false;
    static __device__ __forceinline__ bool keep_acc(const Unit&) { return false; }
    bf16_t *BG, *UU, *Q, *K, *VT, *SG; const float* rstdx; const float *q_norm, *k_norm; float* kbar; PG8_LAS float* xl;
    __device__ __forceinline__ void operator()(f32x4 (&acc)[2][2][4][2], const Unit& u, int wr, int wc, int fr, int fq) const {
        const int row0 = u.pm * BM + wr * 64 + fr, colw = wc * 32 + 8 * fq, pn = u.pn;
        if (pn >= 12 && pn < 20) {
            const bool isK = pn >= 16; const float* wn = isK ? k_norm : q_norm; const float gs = isK ? 1.0f : 0.12751743074602357f;
            bf16_t* dst = isK ? K : Q; const int cb = ((pn - 12) & 3) * 256;
#pragma unroll
            for (int ai = 0; ai < 2; ++ai)
#pragma unroll
                for (int m = 0; m < 4; ++m) { const int rl = ai * HALF + wr * 64 + m * 16 + fr; const float rs = rstdx[u.pm * BM + rl];
#pragma unroll
                    for (int bj = 0; bj < 2; ++bj) { const f32x4 a = acc[ai][bj][m][0] * rs, b = acc[ai][bj][m][1] * rs; acc[ai][bj][m][0] = a; acc[ai][bj][m][1] = b;
                        float ss = (a[0] * a[0] + a[1] * a[1]) + (a[2] * a[2] + a[3] * a[3]) + (b[0] * b[0] + b[1] * b[1]) + (b[2] * b[2] + b[3] * b[3]);
                        ss += __shfl_xor(ss, 16); ss += __shfl_xor(ss, 32);
                        if (fq == 0) xl[(rl * 2 + bj) * 4 + wc] = ss; } }
            asm volatile("s_waitcnt lgkmcnt(0)" ::: "memory"); __builtin_amdgcn_s_barrier(); asm volatile("" ::: "memory");
            const f32x4 g0 = *(const f32x4*)(wn + colw) * gs, g1 = *(const f32x4*)(wn + colw + 4) * gs;
#pragma unroll
            for (int ai = 0; ai < 2; ++ai)
#pragma unroll
                for (int m = 0; m < 4; ++m) { const int rl = ai * HALF + wr * 64 + m * 16 + fr; const int r = u.pm * BM + rl;
#pragma unroll
                    for (int bj = 0; bj < 2; ++bj) { const f32x4 p = *(const PG8_LAS f32x4*)(xl + (rl * 2 + bj) * 4);
                        const float rn = rsqrtf(((p[0] + p[1]) + (p[2] + p[3])) * (1.0f / 128.0f) + 1e-6f);
                        const f32x4 a = acc[ai][bj][m][0] * rn * g0, b = acc[ai][bj][m][1] * rn * g1; acc[ai][bj][m][0] = a; acc[ai][bj][m][1] = b;
                        *(u32x4*)(dst + (size_t)r * 1024 + cb + bj * 128 + colw) = pack8(a, b); } }
            if (isK) {
                f32x4 cs[2][2];
#pragma unroll
                for (int bj = 0; bj < 2; ++bj)
#pragma unroll
                    for (int n = 0; n < 2; ++n) { f32x4 t = acc[0][bj][0][n];
#pragma unroll
                        for (int ai = 0; ai < 2; ++ai)
#pragma unroll
                            for (int m = 0; m < 4; ++m) if (ai + m > 0) t += acc[ai][bj][m][n];
                        cs[bj][n] = t; }
#pragma unroll
                for (int bj = 0; bj < 2; ++bj)
#pragma unroll
                    for (int n = 0; n < 2; ++n)
#pragma unroll
                        for (int e = 0; e < 4; ++e) { float v = cs[bj][n][e]; v += __shfl_xor(v, 1); v += __shfl_xor(v, 2); v += __shfl_xor(v, 4); v += __shfl_xor(v, 8); cs[bj][n][e] = v; }
                if (fr == 0) {
#pragma unroll
                    for (int bj = 0; bj < 2; ++bj) { *(PG8_LAS f32x4*)(xl + 2048 + wr * 256 + bj * 128 + colw) = cs[bj][0]; *(PG8_LAS f32x4*)(xl + 2048 + wr * 256 + bj * 128 + colw + 4) = cs[bj][1]; } }
                asm volatile("s_waitcnt lgkmcnt(0)" ::: "memory"); __builtin_amdgcn_s_barrier(); asm volatile("" ::: "memory");
                int t = threadIdx.x; asm volatile("" : "+v"(t));
                if (t < 256) kbar[((size_t)((pn - 16) * 2 + (t >> 7)) * 64 + u.pm) * 128 + (t & 127)] = (xl[2048 + t] + xl[2048 + 256 + t]) * (1.0f / 256.0f);
            }
            return;
        }
        if (pn >= 20 && pn < 24) {
            int tidv = threadIdx.x; asm volatile("" : "+v"(tidv));
            PG8_LAS unsigned char* T = (PG8_LAS unsigned char*)xl + (tidv >> 6) * 2304;
            const int lane = tidv & 63;
            float rsv[2][4];
#pragma unroll
            for (int ai = 0; ai < 2; ++ai)
#pragma unroll
                for (int m = 0; m < 4; ++m) rsv[ai][m] = rstdx[u.pm * BM + ai * HALF + wr * 64 + m * 16 + fr];
#pragma unroll
            for (int ai = 0; ai < 2; ++ai)
#pragma unroll
                for (int mp = 0; mp < 2; ++mp)
#pragma unroll
                    for (int bj = 0; bj < 2; ++bj) {
#pragma unroll
                        for (int mm = 0; mm < 2; ++mm) { const int m = 2 * mp + mm; const float rs = rsv[ai][m];
                            const u32x4 w = pack8(acc[ai][bj][m][0] * rs, acc[ai][bj][m][1] * rs); const unsigned ww[4] = {w.x, w.y, w.z, w.w};
                            PG8_LAS unsigned char* tp = T + (8 * fq) * 72 + (16 * mm + fr) * 2;
#pragma unroll
                            for (int e = 0; e < 8; ++e) *(PG8_LAS unsigned short*)(tp + e * 72) = (unsigned short)((e & 1) ? (ww[e >> 1] >> 16) : (ww[e >> 1] & 0xffffu)); }
                        asm volatile("s_waitcnt lgkmcnt(0)" ::: "memory");
#pragma unroll
                        for (int rr = 0; rr < 2; ++rr) { const int q = lane + 64 * rr, d = q >> 2, tc = q & 3;
                            const unsigned long long x0 = *(const PG8_LAS unsigned long long*)(T + d * 72 + tc * 16), x1 = *(const PG8_LAS unsigned long long*)(T + d * 72 + tc * 16 + 8);
                            u32x4 o; o.x = (unsigned)x0; o.y = (unsigned)(x0 >> 32); o.z = (unsigned)x1; o.w = (unsigned)(x1 >> 32);
                            *(u32x4*)(VT + ((size_t)(((pn - 20) * 2 + bj) * 128 + 32 * wc + d)) * MROWS + u.pm * BM + ai * HALF + wr * 64 + 32 * mp + tc * 8) = o; }
                        asm volatile("s_waitcnt lgkmcnt(0)" ::: "memory");
                    }
            return;
        }
        float rsg[2][4];
#pragma unroll
        for (int ai = 0; ai < 2; ++ai)
#pragma unroll
            for (int m = 0; m < 4; ++m) rsg[ai][m] = rstdx[row0 + ai * HALF + m * 16];
#pragma unroll
        for (int ai = 0; ai < 2; ++ai)
#pragma unroll
            for (int m = 0; m < 4; ++m) {
                const int r = row0 + ai * HALF + m * 16; const float rs = rsg[ai][m];
                f32x4 v[2][2];
#pragma unroll
                for (int bj = 0; bj < 2; ++bj)
#pragma unroll
                    for (int n = 0; n < 2; ++n) v[bj][n] = acc[ai][bj][m][n] * rs;
                if (pn < 4) {
#pragma unroll
                    for (int bj = 0; bj < 2; ++bj) *(u32x4*)(BG + (size_t)r * 1024 + pn * 256 + bj * 128 + colw) = pack8(v[bj][0], v[bj][1]);
                } else if (pn < 12) {
                    *(u32x4*)(UU + (size_t)r * 1024 + (pn - 4) * 128 + colw) = pack8(v[0][0] * v[1][0], v[0][1] * v[1][1]);
                } else {
                    f32x4 ra, rb, sa, sb;
#pragma unroll
                    for (int e = 0; e < 4; ++e) { const float ea0 = __builtin_amdgcn_exp2f(-1.4426950408889634f * v[0][0][e]), ea1 = __builtin_amdgcn_exp2f(-1.4426950408889634f * v[0][1][e]);
                        const float eb0 = __builtin_amdgcn_exp2f(-1.4426950408889634f * v[1][0][e]), eb1 = __builtin_amdgcn_exp2f(-1.4426950408889634f * v[1][1][e]);
                        ra[e] = (1.0f + eb0) * __builtin_amdgcn_rcpf(1.0f + ea0); rb[e] = (1.0f + eb1) * __builtin_amdgcn_rcpf(1.0f + ea1);
                        sa[e] = __builtin_amdgcn_rcpf(1.0f + eb0); sb[e] = __builtin_amdgcn_rcpf(1.0f + eb1); }
                    *(u32x4*)(SG + (size_t)r * 2048 + (pn - 24) * 128 + colw) = pack8(ra, rb);
                    *(u32x4*)(SG + (size_t)r * 2048 + 1024 + (pn - 24) * 128 + colw) = pack8(sa, sb);
                }
            }
    }
};
struct Epi4 {
    static constexpr bool PERM = true, AFTER_DRAIN = false, APERM = false;
    bf16_t* MG; const bf16_t* SG;
    static __device__ __forceinline__ bool keep_acc(const Unit& u) { return u.sel == 0; }
    __device__ __forceinline__ void operator()(f32x4 (&acc)[2][2][4][2], const Unit& u, int wr, int wc, int fr, int fq) const {
        const int row0 = u.pm * BM + wr * 64 + fr, col0 = u.pn * BM + wc * 32 + 8 * fq;
#pragma unroll
        for (int ai = 0; ai < 2; ++ai) {
            u32x4 g[4][2];
#pragma unroll
            for (int m = 0; m < 4; ++m)
#pragma unroll
                for (int bj = 0; bj < 2; ++bj) g[m][bj] = *(const u32x4*)(SG + (size_t)(row0 + ai * HALF + m * 16) * 2048 + u.sel * 1024 + col0 + bj * HALF);
#pragma unroll
            for (int m = 0; m < 4; ++m) { const int r = row0 + ai * HALF + m * 16;
#pragma unroll
                for (int bj = 0; bj < 2; ++bj) { const int c = col0 + bj * HALF; const u32x4 gg = g[m][bj];
                    f32x4 a = acc[ai][bj][m][0], b = acc[ai][bj][m][1];
                    a[0] *= bf_lo(gg.x); a[1] *= bf_hi(gg.x); a[2] *= bf_lo(gg.y); a[3] *= bf_hi(gg.y); b[0] *= bf_lo(gg.z); b[1] *= bf_hi(gg.z); b[2] *= bf_lo(gg.w); b[3] *= bf_hi(gg.w);
                    if (u.sel) *(u32x4*)(MG + (size_t)r * 1024 + c) = pack8(a, b);
                    else { acc[ai][bj][m][0] = a; acc[ai][bj][m][1] = b; } } }
        }
    }
};
struct Epi5 {
    static constexpr bool PERM = true, AFTER_DRAIN = false, APERM = false;
    static __device__ __forceinline__ bool keep_acc(const Unit&) { return false; }
    const bf16_t* X; float* OUT; bf16_t* HB; float* rowss;
    __device__ __forceinline__ void operator()(f32x4 (&acc)[2][2][4][2], const Unit& u, int wr, int wc, int fr, int fq) const {
        const int row0 = u.pm * BM + wr * 64 + fr, col0 = u.pn * BM + wc * 32 + 8 * fq;
#pragma unroll
        for (int ai = 0; ai < 2; ++ai) {
            u32x4 xw[4][2];
#pragma unroll
            for (int m = 0; m < 4; ++m)
#pragma unroll
                for (int bj = 0; bj < 2; ++bj) xw[m][bj] = __builtin_nontemporal_load((const u32x4*)(X + (size_t)(row0 + ai * HALF + m * 16) * 1024 + col0 + bj * HALF));
#pragma unroll
            for (int m = 0; m < 4; ++m) { const int r = row0 + ai * HALF + m * 16; float ss = 0.f;
#pragma unroll
                for (int bj = 0; bj < 2; ++bj) { const size_t o = (size_t)r * 1024 + col0 + bj * HALF;
                    const u32x4 xq = xw[m][bj];
                    const f32x4 a = acc[ai][bj][m][0] + (f32x4){bf_lo(xq.x), bf_hi(xq.x), bf_lo(xq.y), bf_hi(xq.y)}, b = acc[ai][bj][m][1] + (f32x4){bf_lo(xq.z), bf_hi(xq.z), bf_lo(xq.w), bf_hi(xq.w)};
                    *(u32x4*)(HB + o) = pack8(a, b);
                    ss += (a[0] * a[0] + a[1] * a[1]) + (a[2] * a[2] + a[3] * a[3]) + (b[0] * b[0] + b[1] * b[1]) + (b[2] * b[2] + b[3] * b[3]); }
                ss += __shfl_xor(ss, 16); ss += __shfl_xor(ss, 32);
                if (fq == 0) atomicAdd(rowss + r, ss); }
        }
    }
};
struct Epi6 {
    static constexpr bool PERM = true, AFTER_DRAIN = false, APERM = true;
    static __device__ __forceinline__ bool keep_acc(const Unit&) { return false; }
    bf16_t* ACT; const float* rowss; const float* cw; const float* cb; PG8_LAS float* halo;
    __device__ __forceinline__ void operator()(f32x4 (&acc)[2][2][4][2], const Unit& u, int wr, int wc, int fr, int fq) const {
        const int r0 = u.pm * 254 - 2, colw = wc * 32 + 8 * fq;
#pragma unroll
        for (int ai = 0; ai < 2; ++ai)
#pragma unroll
            for (int m = 0; m < 4; ++m) { int gr = r0 + ai * HALF + wr * 64 + 4 * fr + m; gr = gr < 0 ? 0 : (gr > MROWS - 1 ? MROWS - 1 : gr);
                const float rs = rsqrtf(rowss[gr] * (1.0f / 1024.0f) + 1e-6f);
#pragma unroll
                for (int bj = 0; bj < 2; ++bj)
#pragma unroll
                    for (int n = 0; n < 2; ++n) acc[ai][bj][m][n] *= rs; }
        if (fr == 15) {
#pragma unroll
            for (int ai = 0; ai < 2; ++ai)
#pragma unroll
                for (int bj = 0; bj < 2; ++bj)
#pragma unroll
                    for (int n = 0; n < 2; ++n) { *(PG8_LAS f32x4*)(halo + (((2 * ai + wr) * 2 + 0) * 256 + bj * 128 + colw + 4 * n)) = acc[ai][bj][2][n];
                                                  *(PG8_LAS f32x4*)(halo + (((2 * ai + wr) * 2 + 1) * 256 + bj * 128 + colw + 4 * n)) = acc[ai][bj][3][n]; }
        }
        f32x4 wn0, wn1, wn2, wnb;
        { const int col = u.pn * 128 + colw; wn0 = *(const f32x4*)(cw + col); wn1 = *(const f32x4*)(cw + 2 * DFF_ + col); wn2 = *(const f32x4*)(cw + 4 * DFF_ + col); wnb = *(const f32x4*)(cb + col); }
        asm volatile("s_waitcnt lgkmcnt(0)" ::: "memory"); __builtin_amdgcn_s_barrier(); asm volatile("" ::: "memory");
#pragma unroll
        for (int bj = 0; bj < 2; ++bj)
#pragma unroll
            for (int n = 0; n < 2; ++n) {
                const f32x4 w0 = wn0, w1 = wn1, w2 = wn2, bb = wnb;
                if (bj * 2 + n < 3) { const int k2 = bj * 2 + n + 1, col = (k2 >> 1) * DFF_ + u.pn * 128 + colw + 4 * (k2 & 1);
                    wn0 = *(const f32x4*)(cw + col); wn1 = *(const f32x4*)(cw + 2 * DFF_ + col); wn2 = *(const f32x4*)(cw + 4 * DFF_ + col); wnb = *(const f32x4*)(cb + col); }
#pragma unroll
                for (int ai = 0; ai < 2; ++ai) {
                    const int s = 2 * ai + wr;
                    const int sm = s > 0 ? s - 1 : 0; const float hz = s > 0 ? 1.0f : 0.0f;
                    const f32x4 h2 = *(const PG8_LAS f32x4*)(halo + ((sm * 2 + 0) * 256 + bj * 128 + colw + 4 * n)) * hz, h1 = *(const PG8_LAS f32x4*)(halo + ((sm * 2 + 1) * 256 + bj * 128 + colw + 4 * n)) * hz;
                    const f32x4 raw0 = acc[ai][bj][0][n], raw1 = acc[ai][bj][1][n]; f32x4 raw2 = acc[ai][bj][2][n], raw3 = acc[ai][bj][3][n];
                    asm volatile("" : "+v"(raw2), "+v"(raw3));
                    f32x4 s3, s2;
#pragma unroll
                    for (int e = 0; e < 4; ++e) { s3[e] = dpp_shr<0x111>(h1[e], raw3[e]); s2[e] = dpp_shr<0x111>(h2[e], raw2[e]); }
                    { f32x4 y3 = w0 * raw1 + w1 * raw2 + w2 * raw3 + bb, y2 = w0 * raw0 + w1 * raw1 + w2 * raw2 + bb, y1 = w0 * s3 + w1 * raw0 + w2 * raw1 + bb, y0 = w0 * s2 + w1 * s3 + w2 * raw0 + bb;
                      asm volatile("" : "+v"(y0), "+v"(y1), "+v"(y2), "+v"(y3));
                      acc[ai][bj][3][n] = y3; acc[ai][bj][2][n] = y2; acc[ai][bj][1][n] = y1; acc[ai][bj][0][n] = y0; }
                }
            }
#pragma unroll
        for (int ai = 0; ai < 2; ++ai)
#pragma unroll
            for (int m = 0; m < 4; ++m) { const int i = ai * HALF + wr * 64 + 4 * fr + m, gr = r0 + i;
                f32x4 a, b;
#pragma unroll
                for (int e = 0; e < 4; ++e) { const float g0 = acc[ai][0][m][0][e], g1 = acc[ai][0][m][1][e];
                    a[e] = g0 * fast_sigmoid(g0) * acc[ai][1][m][0][e]; b[e] = g1 * fast_sigmoid(g1) * acc[ai][1][m][1][e]; }
                if (i >= 2 && gr < MROWS) *(u32x4*)(ACT + (size_t)gr * DFF_ + u.pn * 128 + colw) = pack8(a, b); }
    }
};
struct Epi7 {
    static constexpr bool PERM = true, AFTER_DRAIN = false, APERM = false;
    static __device__ __forceinline__ bool keep_acc(const Unit&) { return false; }
    float* OUT; const bf16_t* HB;
    __device__ __forceinline__ void operator()(f32x4 (&acc)[2][2][4][2], const Unit& u, int wr, int wc, int fr, int fq) const {
        const int row0 = u.pm * BM + wr * 64 + fr, col0 = u.pn * BM + wc * 32 + 8 * fq;
#pragma unroll
        for (int ai = 0; ai < 2; ++ai) {
            u32x4 hv[4][2];
#pragma unroll
            for (int m = 0; m < 4; ++m)
#pragma unroll
                for (int bj = 0; bj < 2; ++bj) hv[m][bj] = *(const u32x4*)(HB + (size_t)(row0 + ai * HALF + m * 16) * 1024 + col0 + bj * HALF);
#pragma unroll
            for (int m = 0; m < 4; ++m) { const int r = row0 + ai * HALF + m * 16;
#pragma unroll
                for (int bj = 0; bj < 2; ++bj) { const size_t o = (size_t)r * 1024 + col0 + bj * HALF; float* p = OUT + o; const u32x4 hw = hv[m][bj];
                    f32x4 a = acc[ai][bj][m][0], b = acc[ai][bj][m][1];
                    a[0] += bf_lo(hw.x); a[1] += bf_hi(hw.x); a[2] += bf_lo(hw.y); a[3] += bf_hi(hw.y); b[0] += bf_lo(hw.z); b[1] += bf_hi(hw.z); b[2] += bf_lo(hw.w); b[3] += bf_hi(hw.w);
                    __builtin_nontemporal_store(a, (f32x4*)p); __builtin_nontemporal_store(b, (f32x4*)(p + 4)); } }
        }
    }
};
template <class Epi, class Sched, bool ALIGN_EPI = false, bool SP2 = false>
__device__ __forceinline__ void gemm_phase(PG8_LAS unsigned char* lds, const Gemm g, const Sched& S, const Epi& E) {
    const int tid = threadIdx.x, wid = __builtin_amdgcn_readfirstlane(tid >> 6), lane = tid & 63, wr = wid >> 2, wc = wid & 3, fr = lane & 15, fq = lane >> 4;
    const int K = g.K, nt = K / BK;
    unsigned voffA[2], voffB[2];
#pragma unroll
    for (int i = 0; i < 2; ++i) { int R, C; stage_rc(tid * 16 + i * 8192, R, C); const int Rb = Epi::PERM ? ((R & ~31) + perm32(R & 31)) : R;
        const int Ra = Epi::APERM ? ((R & ~63) | (4 * (R & 15) + ((R >> 4) & 3))) : R;
        voffA[i] = (unsigned)(Ra * K + C) * 2u; voffB[i] = (unsigned)(Rb * K + C) * 2u; }
    const size_t kstep = (size_t)(BK * 2);
    const size_t hstep = (size_t)HALF * K * 2;
    const size_t tstep = 2 * hstep;
    const unsigned ldsw = (unsigned)wid * 1024u;
    const int aoff = lds_byte(wr * 64 + fr, fq * 8), boff = lds_byte(wc * 32 + fr, fq * 8);
#define PG8_SA(b, h) (((b) * 2 + (h)) * HTB)
#define PG8_SB(b, h) ((4 + (b) * 2 + (h)) * HTB)
#define PG8_STAGE(bufoff, gbase, voff) do { _Pragma("unroll") for (int _i = 0; _i < 2; ++_i) \
        __builtin_amdgcn_global_load_lds((const unsigned*)((const char*)(gbase) + (voff)[_i]), (PG8_LAS unsigned*)(lds + (bufoff) + ldsw + _i * 8192), 16, 0, 0); } while (0)
#define PG8_LDA(dst, b, h) do { _Pragma("unroll") for (int m = 0; m < 4; ++m) _Pragma("unroll") for (int k = 0; k < 2; ++k) dst[m][k] = *(const PG8_LAS bf16x8*)(lds + PG8_SA(b, h) + aoff + m * 2048 + k * 1024); } while (0)
#define PG8_LDB(dst, b, h) do { _Pragma("unroll") for (int n = 0; n < 2; ++n) _Pragma("unroll") for (int k = 0; k < 2; ++k) dst[n][k] = *(const PG8_LAS bf16x8*)(lds + PG8_SB(b, h) + boff + n * 2048 + k * 1024); } while (0)
#define PG8_MMA(ai, bj, At, Bt) do { __builtin_amdgcn_s_setprio(1); _Pragma("unroll") for (int m = 0; m < 4; ++m) _Pragma("unroll") for (int n = 0; n < 2; ++n) _Pragma("unroll") for (int k = 0; k < 2; ++k) \
        acc[ai][bj][m][n] = __builtin_amdgcn_mfma_f32_16x16x32_bf16(Bt[n][k], At[m][k], acc[ai][bj][m][n], 0, 0, 0); __builtin_amdgcn_s_setprio(0); } while (0)
#define PG8_WAIT_V(n) asm volatile("s_waitcnt vmcnt(" #n ")" ::: "memory")
#define PG8_WAIT_L(n) asm volatile("s_waitcnt lgkmcnt(" #n ")" ::: "memory")
#define PG8_BAR __builtin_amdgcn_s_barrier()
#define PG8_SCHED __builtin_amdgcn_sched_barrier(0)
    Unit cur, nxt; int ui = 0;
    if (!S.next(0, cur)) return;
    f32x4 acc[2][2][4][2];
#pragma unroll
    for (int a = 0; a < 2; ++a)
#pragma unroll
        for (int b = 0; b < 2; ++b)
#pragma unroll
            for (int m = 0; m < 4; ++m)
#pragma unroll
                for (int n = 0; n < 2; ++n) acc[a][b][m][n] = (f32x4){0.f, 0.f, 0.f, 0.f};
    bf16x8 At[4][2], B0[2][2], B1[2][2];
    const char* cA = (const char*)(cur.sel ? g.A1 : g.A0) + (size_t)cur.pm * g.a_tstep; const char* cB = (const char*)(cur.sel ? g.B1 : g.B0) + (size_t)cur.pn * tstep;
    S.a_ready(cur);
    if constexpr (SP2) {
        PG8_STAGE(PG8_SB(0, 0), cB, voffB); PG8_STAGE(PG8_SB(0, 1), cB + hstep, voffB); PG8_STAGE(PG8_SA(0, 0), cA, voffA); PG8_STAGE(PG8_SA(0, 1), cA + hstep, voffA);
        if (wr == 1) PG8_BAR;
        PG8_WAIT_V(2); PG8_BAR;
        PG8_STAGE(PG8_SB(1, 0), cB + kstep, voffB); PG8_STAGE(PG8_SA(1, 0), cA + kstep, voffA); PG8_STAGE(PG8_SB(1, 1), cB + hstep + kstep, voffB);
        PG8_WAIT_V(6); PG8_BAR;
    } else {
        PG8_STAGE(PG8_SB(0, 0), cB, voffB); PG8_STAGE(PG8_SA(0, 0), cA, voffA); PG8_STAGE(PG8_SB(0, 1), cB + hstep, voffB); PG8_STAGE(PG8_SA(0, 1), cA + hstep, voffA);
        if (wr == 1) PG8_BAR;
        PG8_WAIT_V(4); PG8_BAR;
        PG8_STAGE(PG8_SB(1, 0), cB + kstep, voffB); PG8_STAGE(PG8_SA(1, 0), cA + kstep, voffA); PG8_STAGE(PG8_SB(1, 1), cB + hstep + kstep, voffB);
        PG8_WAIT_V(6); PG8_BAR;
    }
    for (;;) {
        const bool has_next = S.next(ui + 1, nxt);
        const char* nA = has_next ? (const char*)(nxt.sel ? g.A1 : g.A0) + (size_t)nxt.pm * g.a_tstep : cA; const char* nB = has_next ? (const char*)(nxt.sel ? g.B1 : g.B0) + (size_t)nxt.pn * tstep : cB;
        for (int t = 0; t < nt; t += 2) {
            const bool last = (t == nt - 2);
            const char* a1 = cA + (size_t)(t + 1) * kstep;
            const char* a2 = last ? nA : cA + (size_t)(t + 2) * kstep; const char* b2 = last ? nB : cB + (size_t)(t + 2) * kstep;
            const char* a3 = a2 + kstep; const char* b3 = b2 + kstep;
            if (last && has_next) S.a_ready(nxt);
            if constexpr (SP2) {
            PG8_LDB(B0, 0, 0); PG8_LDB(B1, 0, 1); PG8_SCHED; PG8_LDA(At, 0, 0); PG8_STAGE(PG8_SA(1, 1), a1 + hstep, voffA);
            PG8_WAIT_V(8); PG8_WAIT_L(0); PG8_BAR; PG8_MMA(0, 0, At, B0); PG8_MMA(0, 1, At, B1); PG8_BAR; PG8_SCHED;
            PG8_LDA(At, 0, 1); PG8_STAGE(PG8_SB(0, 0), b2, voffB); PG8_STAGE(PG8_SB(0, 1), b2 + hstep, voffB); PG8_STAGE(PG8_SA(0, 0), a2, voffA);
            PG8_WAIT_V(8); PG8_WAIT_L(0); PG8_BAR; PG8_MMA(1, 0, At, B0); PG8_MMA(1, 1, At, B1); PG8_BAR; PG8_SCHED;
            PG8_LDB(B0, 1, 0); PG8_LDB(B1, 1, 1); PG8_SCHED; PG8_LDA(At, 1, 0); PG8_STAGE(PG8_SA(0, 1), a2 + hstep, voffA);
            PG8_WAIT_V(8); PG8_WAIT_L(0); PG8_BAR; PG8_MMA(0, 0, At, B0); PG8_MMA(0, 1, At, B1); PG8_BAR; PG8_SCHED;
            PG8_LDA(At, 1, 1); PG8_STAGE(PG8_SB(1, 0), b3, voffB); PG8_STAGE(PG8_SB(1, 1), b3 + hstep, voffB); PG8_STAGE(PG8_SA(1, 0), a3, voffA);
            PG8_WAIT_V(8); PG8_WAIT_L(0); PG8_BAR; PG8_MMA(1, 0, At, B0); PG8_MMA(1, 1, At, B1); PG8_BAR; PG8_SCHED;
            } else {
            PG8_LDB(B0, 0, 0); PG8_SCHED; PG8_LDA(At, 0, 0); PG8_STAGE(PG8_SA(1, 1), a1 + hstep, voffA);
            PG8_WAIT_L(8); PG8_BAR; PG8_WAIT_L(0); PG8_MMA(0, 0, At, B0); PG8_BAR; PG8_SCHED;
            PG8_LDB(B1, 0, 1); PG8_STAGE(PG8_SB(0, 0), b2, voffB);
            PG8_BAR; PG8_WAIT_L(0); PG8_MMA(0, 1, At, B1); PG8_BAR;
            PG8_LDA(At, 0, 1); PG8_STAGE(PG8_SA(0, 0), a2, voffA);
            PG8_BAR; PG8_WAIT_L(0); PG8_MMA(1, 0, At, B0); PG8_BAR; PG8_SCHED;
            PG8_STAGE(PG8_SB(0, 1), b2 + hstep, voffB);
            PG8_WAIT_V(6); PG8_BAR; PG8_MMA(1, 1, At, B1); PG8_BAR;
            PG8_LDB(B0, 1, 0); PG8_SCHED; PG8_LDA(At, 1, 0); PG8_STAGE(PG8_SA(0, 1), a2 + hstep, voffA);
            PG8_WAIT_L(8); PG8_BAR; PG8_WAIT_L(0); PG8_MMA(0, 0, At, B0); PG8_BAR; PG8_SCHED;
            PG8_LDB(B1, 1, 1); PG8_STAGE(PG8_SB(1, 0), b3, voffB);
            PG8_BAR; PG8_WAIT_L(0); PG8_MMA(0, 1, At, B1); PG8_BAR;
            PG8_LDA(At, 1, 1); PG8_STAGE(PG8_SA(1, 0), a3, voffA);
            PG8_BAR; PG8_WAIT_L(0); PG8_MMA(1, 0, At, B0); PG8_BAR; PG8_SCHED;
            PG8_STAGE(PG8_SB(1, 1), b3 + hstep, voffB);
            PG8_WAIT_V(6); PG8_BAR; PG8_MMA(1, 1, At, B1); PG8_BAR;
            }
        }
        if constexpr (ALIGN_EPI) { if (wr == 0) PG8_BAR; }
        if constexpr (!Epi::AFTER_DRAIN) { E(acc, cur, wr, wc, fr, fq); S.done(cur); }
        if (!has_next) break;
        if (!Epi::keep_acc(cur)) {
#pragma unroll
        for (int a = 0; a < 2; ++a)
#pragma unroll
            for (int b = 0; b < 2; ++b)
#pragma unroll
                for (int m = 0; m < 4; ++m)
#pragma unroll
                    for (int n = 0; n < 2; ++n) acc[a][b][m][n] = (f32x4){0.f, 0.f, 0.f, 0.f}; }
        cur = nxt; cA = nA; cB = nB; ++ui;
        if constexpr (ALIGN_EPI) { if (wr == 1) PG8_BAR; }
    }
    PG8_WAIT_V(0);
    if constexpr (!ALIGN_EPI) { if (wr == 0) PG8_BAR; }
    PG8_BAR;
    if constexpr (Epi::AFTER_DRAIN) { E.fused(acc, cur, wr, wc, fr, fq, lds, wid, lane); S.done(cur); }
#undef PG8_SA
#undef PG8_SB
#undef PG8_STAGE
#undef PG8_LDA
#undef PG8_LDB
#undef PG8_MMA
#undef PG8_WAIT_V
#undef PG8_WAIT_L
#undef PG8_BAR
#undef PG8_SCHED
}
}
#define GAS __attribute__((address_space(1)))
#define LAS __attribute__((address_space(3)))
typedef unsigned short bf16;
typedef unsigned v4u __attribute__((ext_vector_type(4)));
typedef float f32x4 __attribute__((ext_vector_type(4)));
typedef short bf16x8 __attribute__((ext_vector_type(8)));
typedef GAS unsigned gu32;
typedef GAS unsigned long long gu64;
#define RLX_AGENT __ATOMIC_RELAXED, __HIP_MEMORY_SCOPE_AGENT
#define LDS_WAIT() asm volatile("s_waitcnt lgkmcnt(0)" ::: "memory")
#define VM_WAIT() asm volatile("s_waitcnt vmcnt(0)" ::: "memory")
__device__ __forceinline__ unsigned long long rt() { return __builtin_amdgcn_s_memrealtime(); }
__device__ __forceinline__ unsigned f2bf(float f) { unsigned u = __builtin_bit_cast(unsigned, f); return (u + 0x7fffu + ((u >> 16) & 1u)) >> 16; }
__device__ __forceinline__ unsigned pk2(float lo, float hi) { return f2bf(lo) | (f2bf(hi) << 16); }

#define XB_TMO      128
#define XB_XCNT(j)  (256  + 64 * (j))
#define XB_XSUB(j)  (1280 + 64 * (j))
#define XB_XGEN(j)  (2304 + 64 * (j))
#define XB_TOP      3328
#define XB_TOPGEN   3392
#define XCD_BAR_WORDS 3456
#define XB_SPIN_CAP (1u << 18)

__device__ __forceinline__ unsigned xb_ld(unsigned* p)              { return __hip_atomic_load(p, __ATOMIC_RELAXED, __HIP_MEMORY_SCOPE_AGENT); }
__device__ __forceinline__ unsigned xb_add(unsigned* p, unsigned v) { return __hip_atomic_fetch_add(p, v, __ATOMIC_RELAXED, __HIP_MEMORY_SCOPE_AGENT); }
__device__ __forceinline__ unsigned xb_xcc_id() { return (unsigned)__builtin_amdgcn_s_getreg((3 << 11) | 20) & 0xFu; }
#define XB_SPIN(cond, bar) do { unsigned _sp = 0; while (cond) { __builtin_amdgcn_s_sleep(1); \
    if ((++_sp & 255u) == 0u) { if (xb_ld(&(bar)[XB_TMO])) break; if (_sp > XB_SPIN_CAP) { atomicAdd(&(bar)[XB_TMO], 1u); break; } } } } while (0)

struct XcdBarrier {
    unsigned* bar; unsigned x;
    volatile LAS unsigned* st;
};

__device__ __forceinline__ XcdBarrier xcd_barrier_post(unsigned* bar, volatile LAS unsigned* st) {
    XcdBarrier b; b.bar = bar; b.x = xb_xcc_id(); b.st = st;
    if (threadIdx.x == 0) (void)xb_add(&bar[XB_XCNT(b.x)], 1u);
    return b;
}
__device__ __forceinline__ void xcd_barrier_complete(unsigned* bar, unsigned x, unsigned& nloc, unsigned& nx) {
    const unsigned G = gridDim.x * gridDim.y * gridDim.z;
    unsigned sum, cnt, mine, sp = 0u;
    for (;;) {
        sum = 0u; cnt = 0u; mine = 0u;
#pragma unroll
        for (unsigned j = 0; j < 16; ++j) { const unsigned c = xb_ld(&bar[XB_XCNT(j)]); sum += c; cnt += (c > 0u) ? 1u : 0u; mine = (j == x) ? c : mine; }
        if (sum == G) break;
        __builtin_amdgcn_s_sleep(1);
        if ((++sp & 255u) == 0u) { if (xb_ld(&bar[XB_TMO])) break; if (sp > XB_SPIN_CAP) { atomicAdd(&bar[XB_TMO], 1u); break; } }
    }
    nloc = mine > 0u ? mine : 1u; nx = cnt > 0u ? cnt : 1u;
}

__device__ __forceinline__ void xcd_barrier(const XcdBarrier& b) {
    asm volatile("s_waitcnt vmcnt(0)" ::: "memory");
    __syncthreads();
    if (threadIdx.x == 0) {
        unsigned* bar = b.bar;
        __builtin_amdgcn_s_waitcnt(0);
        unsigned nloc = b.st[0], nx = b.st[1];
        if (nloc == 0u) { xcd_barrier_complete(bar, b.x, nloc, nx); b.st[0] = nloc; b.st[1] = nx; }
        const unsigned old = xb_add(&bar[XB_XSUB(b.x)], 1u);
        const unsigned gen = old / nloc;
        if (old + 1u == (gen + 1u) * nloc) {
            __builtin_amdgcn_fence(__ATOMIC_RELEASE, "agent");
            asm volatile("s_waitcnt vmcnt(0)" ::: "memory");
            const unsigned og = xb_add(&bar[XB_TOP], 1u);
            const unsigned tg = og / nx;
            if (og + 1u == (tg + 1u) * nx) xb_add(&bar[XB_TOPGEN], 1u);
            else XB_SPIN(xb_ld(&bar[XB_TOPGEN]) == tg, bar);
            __builtin_amdgcn_fence(__ATOMIC_ACQUIRE, "agent");
            xb_add(&bar[XB_XGEN(b.x)], 1u);
            asm volatile("s_waitcnt vmcnt(0)" ::: "memory");
        } else {
            XB_SPIN(xb_ld(&bar[XB_XGEN(b.x)]) == gen, bar);
            __builtin_amdgcn_fence(__ATOMIC_ACQUIRE, "agent");
            asm volatile("s_waitcnt vmcnt(0)" ::: "memory");
        }
    }
    __syncthreads();
}


constexpr int NWAVES = 8, NTHREADS = 512;
constexpr int M = 16384, D = 1024, NIN = 8192, DFF = 2816, NH = 8, HD = 128, NBLK = 64, BLK = 256;
constexpr float EPS = 1e-6f;
constexpr float C2 = 0.08838834764831845f * 1.4426950408889634f;
constexpr size_t MiB = 1u << 20;
constexpr size_t WS_CTL = 0, CTL_ZERO_BYTES = 256 * 1024;
constexpr int CW_BAR = 4096, CW_GCNT = 8192, CW_ROWSS = 16384;
constexpr size_t WS_KBAR = 1 * MiB, WS_RSTDX = 1 * MiB + 512 * 1024, WS_LPART = 2 * MiB;
constexpr size_t WS_WOA = 4 * MiB, WS_WOB = 6 * MiB, WS_WO = 8 * MiB;
constexpr size_t WS_Q = 10 * MiB, WS_K = 42 * MiB, WS_VT = 74 * MiB, WS_CA = 106 * MiB, WS_LIST = 138 * MiB, WS_WIN = 147 * MiB, WS_XB = 163 * MiB, WS_UU = 195 * MiB;
constexpr size_t WS_OPART = 195 * MiB;
constexpr size_t WS_WUP = 243 * MiB, WS_WDN = 138 * MiB, WS_MG = 42 * MiB, WS_HB = 198 * MiB;
constexpr size_t WS_ACT = 10 * MiB;
constexpr size_t WS_END = 256 * MiB;
constexpr int LDS_BYTES = 163840, MISC_OFF = 131072 + 320, HALO_OFF = 131072 + 1024, SCAN_OFF = 131072 + 1024;
__device__ __forceinline__ int list_off(int n) { return 256 * (63 * n - (n * (n - 1)) / 2); }
constexpr int LIST_PER_HEAD = 256 * 2016;

__device__ __forceinline__ float wave_sum(float v) {
#pragma unroll
    for (int o = 1; o < 64; o <<= 1) v += __shfl_xor(v, o);
    return v;
}
__device__ __forceinline__ void transpose_item(const float* W, int N, bf16* WT, int K, int k0, int col0, int row0, const float* ks, LAS float* scr, int lane) {
    float wv[32];
#pragma unroll
    for (int i = 0; i < 32; ++i) wv[i] = __builtin_nontemporal_load(W + (size_t)(k0 + 2 * i + (lane >> 5)) * N + col0 + (lane & 31));
#pragma unroll
    for (int i = 0; i < 32; ++i) { const int kk = 2 * i + (lane >> 5); const float s = ks ? ks[k0 + kk] : 1.0f; scr[kk * 33 + (lane & 31)] = s * wv[i]; }
    LDS_WAIT(); asm volatile("" ::: "memory");
    const int c = lane & 7;
#pragma unroll
    for (int j = 0; j < 4; ++j) { const int n = (lane >> 3) + 8 * j; const LAS float* s = scr + (8 * c) * 33 + n;
        v4u o; o.x = pk2(s[0 * 33], s[1 * 33]); o.y = pk2(s[2 * 33], s[3 * 33]); o.z = pk2(s[4 * 33], s[5 * 33]); o.w = pk2(s[6 * 33], s[7 * 33]);
        *(GAS v4u*)(WT + (size_t)(row0 + n) * K + k0 + 8 * c) = o; }
    LDS_WAIT(); asm volatile("" ::: "memory");
}
__device__ __forceinline__ int map_col(int mode, int R) {
    if (mode == 1) { if (R >= 1024 && R < 3072) { const int q = R - 1024; return 1024 + ((q >> 7) & 1) * 1024 + (q >> 8) * 128 + (q & 127); }
                     if (R >= 6144) { const int q = R - 6144; return 6144 + ((q >> 7) & 1) * 1024 + (q >> 8) * 128 + (q & 127); } return R; }
    if (mode == 2) return ((R >> 7) & 1) * DFF + (R >> 8) * 128 + (R & 127);
    return R;
}
__device__ __forceinline__ void convert_weight(const float* W, int K, int N, bf16* WT, const float* ks, int mode, LAS float* scr, int gw, int NGW, int lane) {
    const int nblk = N / 32, nitems = (K / 64) * nblk;
    for (int it = gw; it < nitems; it += NGW) { const int kb = it / nblk, nb = it % nblk; transpose_item(W, N, WT, K, 64 * kb, map_col(mode, 32 * nb), 32 * nb, ks, scr, lane); }
}

__device__ __forceinline__ void phase0(const float* x, const float* norm_mix, const float* w_in, const float* w_oa, const float* w_ob, const float* w_o, const float* w_up, const float* norm_ffn, unsigned char* ws, LAS unsigned char* lds, int vcu, int G, int wave, int lane) {
    LAS float* scr = (LAS float*)(lds + wave * 16384);
    const int gw = vcu * NWAVES + wave, NGW = G * NWAVES;
    convert_weight(w_in, D, NIN, (bf16*)(ws + WS_WIN), norm_mix, 1, scr, gw, NGW, lane);
    convert_weight(w_oa, D, D, (bf16*)(ws + WS_WOA), nullptr, 0, scr, gw, NGW, lane);
    convert_weight(w_ob, D, D, (bf16*)(ws + WS_WOB), nullptr, 0, scr, gw, NGW, lane);
    convert_weight(w_o, D, D, (bf16*)(ws + WS_WO), nullptr, 0, scr, gw, NGW, lane);
    convert_weight(w_up, D, 2 * DFF, (bf16*)(ws + WS_WUP), norm_ffn, 2, scr, gw, NGW, lane);
    bf16* XB = (bf16*)(ws + WS_XB); float* rstdx = (float*)(ws + WS_RSTDX);
    for (int m = gw; m < M; m += NGW) {
        const GAS f32x4* xr = (const GAS f32x4*)(x + (size_t)m * D) + lane; f32x4 v[4]; float s = 0.f;
#pragma unroll
        for (int j = 0; j < 4; ++j) { v[j] = __builtin_nontemporal_load(xr + 64 * j); s += (v[j].x * v[j].x + v[j].y * v[j].y) + (v[j].z * v[j].z + v[j].w * v[j].w); }
        s = wave_sum(s); if (lane == 0) rstdx[m] = rsqrtf(s * (1.f / D) + EPS);
        GAS unsigned long long* o8 = (GAS unsigned long long*)(XB + (size_t)m * D) + lane;
#pragma unroll
        for (int j = 0; j < 4; ++j) o8[64 * j] = (unsigned long long)pk2(v[j].x, v[j].y) | ((unsigned long long)pk2(v[j].z, v[j].w) << 32);
    }
}
__device__ __forceinline__ void phase2(const float* conv_a_w, unsigned char* ws, int G, int tid, bf16* __restrict__ CAout) {
    const bf16* __restrict__ BG = (const bf16*)(ws + WS_CA); const bf16* __restrict__ UU = (const bf16*)(ws + WS_UU);
    for (int item = blockIdx.x * NTHREADS + tid; item < 128 * (M / 16); item += G * NTHREADS) {
        const int cc = (item & 127) * 8, t0 = (item >> 7) * 16;
        float w0[8], w1[8], w2[8], um2[8], um1[8];
#pragma unroll
        for (int j = 0; j < 2; ++j) { const f32x4 a = *(const GAS f32x4*)(conv_a_w + cc + 4 * j), b = *(const GAS f32x4*)(conv_a_w + 1024 + cc + 4 * j), c = *(const GAS f32x4*)(conv_a_w + 2048 + cc + 4 * j);
#pragma unroll
            for (int e = 0; e < 4; ++e) { w0[4 * j + e] = a[e]; w1[4 * j + e] = b[e]; w2[4 * j + e] = c[e]; } }
        { v4u a = (v4u){0u, 0u, 0u, 0u}, b = a; if (t0 >= 2) { a = *(const GAS v4u*)(UU + (size_t)(t0 - 2) * 1024 + cc); b = *(const GAS v4u*)(UU + (size_t)(t0 - 1) * 1024 + cc); }
          const unsigned aw[4] = {a.x, a.y, a.z, a.w}, bw[4] = {b.x, b.y, b.z, b.w};
#pragma unroll
          for (int j = 0; j < 4; ++j) { um2[2 * j] = pg8::bf_lo(aw[j]); um2[2 * j + 1] = pg8::bf_hi(aw[j]); um1[2 * j] = pg8::bf_lo(bw[j]); um1[2 * j + 1] = pg8::bf_hi(bw[j]); } }
#pragma unroll 4
        for (int i = 0; i < 16; ++i) { const size_t o = (size_t)(t0 + i) * 1024 + cc;
            const v4u u = *(const GAS v4u*)(UU + o), b = *(const GAS v4u*)(BG + o); const unsigned uw[4] = {u.x, u.y, u.z, u.w}, bw[4] = {b.x, b.y, b.z, b.w};
            float r[8];
#pragma unroll
            for (int j = 0; j < 4; ++j) { const float u0 = pg8::bf_lo(uw[j]), u1 = pg8::bf_hi(uw[j]);
                r[2 * j] = pg8::bf_lo(bw[j]) * (w0[2 * j] * um2[2 * j] + w1[2 * j] * um1[2 * j] + w2[2 * j] * u0);
                r[2 * j + 1] = pg8::bf_hi(bw[j]) * (w0[2 * j + 1] * um2[2 * j + 1] + w1[2 * j + 1] * um1[2 * j + 1] + w2[2 * j + 1] * u1);
                um2[2 * j] = um1[2 * j]; um2[2 * j + 1] = um1[2 * j + 1]; um1[2 * j] = u0; um1[2 * j + 1] = u1; }
            v4u o4; o4.x = pk2(r[0], r[1]); o4.y = pk2(r[2], r[3]); o4.z = pk2(r[4], r[5]); o4.w = pk2(r[6], r[7]);
            *(GAS v4u*)(CAout + o) = o4; }
    }
}
__device__ __forceinline__ bool top_better(float v, int n, float cv, int cn) { return v > cv || (v == cv && n < cn); }
__device__ __forceinline__ void top3_insert(float v, int n, float (&tv)[3], int (&ti)[3]) {
    if (top_better(v, n, tv[0], ti[0])) { tv[2] = tv[1]; ti[2] = ti[1]; tv[1] = tv[0]; ti[1] = ti[0]; tv[0] = v; ti[0] = n; }
    else if (top_better(v, n, tv[1], ti[1])) { tv[2] = tv[1]; ti[2] = ti[1]; tv[1] = v; ti[1] = n; }
    else if (top_better(v, n, tv[2], ti[2])) { tv[2] = v; ti[2] = n; }
}
__device__ __forceinline__ void phase2d(unsigned char* ws, LAS unsigned char* lds, int G, int tid, int wave, int lane, unsigned* gcnt, unsigned short* glist) {
    LAS unsigned* lcnt = (LAS unsigned*)(lds + 32768); LAS unsigned* lbase = lcnt + 64; LAS unsigned short* llist = (LAS unsigned short*)lds;
    const bf16* Q = (const bf16*)(ws + WS_Q); const float* kbar = (const float*)(ws + WS_KBAR);
    const int fr = lane & 15, fq = lane >> 4;
    for (int unit = blockIdx.x; unit < NH * 63; unit += G) {
        const int h = unit / 63, c = 1 + unit % 63;
        if (tid < 64) lcnt[tid] = 0u;
        __syncthreads();
        bf16x8 qf[2][4];
#pragma unroll
        for (int g = 0; g < 2; ++g)
#pragma unroll
            for (int ks = 0; ks < 4; ++ks) qf[g][ks] = *(const GAS bf16x8*)(Q + (size_t)(c * BLK + wave * 32 + g * 16 + fr) * 1024 + h * HD + ks * 32 + fq * 8);
        float tv[2][3]; int ti[2][3];
#pragma unroll
        for (int g = 0; g < 2; ++g)
#pragma unroll
            for (int j = 0; j < 3; ++j) { tv[g][j] = -__builtin_inff(); ti[g][j] = 1 << 20; }
        const int ntile = (c + 15) >> 4;
        for (int tile = 0; tile < ntile; ++tile) {
            f32x4 s0 = (f32x4){0.f, 0.f, 0.f, 0.f}, s1 = s0;
#pragma unroll
            for (int ks = 0; ks < 4; ++ks) {
                const float* kp = kbar + ((size_t)(h * NBLK + tile * 16 + fr) * HD + ks * 32 + fq * 8);
                const f32x4 a = *(const GAS f32x4*)kp, b = *(const GAS f32x4*)(kp + 4);
                const v4u hw = pg8::pack8(a, b);
                f32x4 ra, rb; ra[0] = a[0] - pg8::bf_lo(hw.x); ra[1] = a[1] - pg8::bf_hi(hw.x); ra[2] = a[2] - pg8::bf_lo(hw.y); ra[3] = a[3] - pg8::bf_hi(hw.y);
                rb[0] = b[0] - pg8::bf_lo(hw.z); rb[1] = b[1] - pg8::bf_hi(hw.z); rb[2] = b[2] - pg8::bf_lo(hw.w); rb[3] = b[3] - pg8::bf_hi(hw.w);
                const v4u lw = pg8::pack8(ra, rb);
                const bf16x8 hi = __builtin_bit_cast(bf16x8, hw), lo = __builtin_bit_cast(bf16x8, lw);
                s0 = __builtin_amdgcn_mfma_f32_16x16x32_bf16(hi, qf[0][ks], s0, 0, 0, 0); s0 = __builtin_amdgcn_mfma_f32_16x16x32_bf16(lo, qf[0][ks], s0, 0, 0, 0);
                s1 = __builtin_amdgcn_mfma_f32_16x16x32_bf16(hi, qf[1][ks], s1, 0, 0, 0); s1 = __builtin_amdgcn_mfma_f32_16x16x32_bf16(lo, qf[1][ks], s1, 0, 0, 0);
            }
#pragma unroll
            for (int i = 0; i < 4; ++i) { const int n = tile * 16 + 4 * fq + i;
                top3_insert(n < c ? s0[i] : -__builtin_inff(), n, tv[0], ti[0]); top3_insert(n < c ? s1[i] : -__builtin_inff(), n, tv[1], ti[1]); }
        }
#pragma unroll
        for (int off = 16; off <= 32; off <<= 1)
#pragma unroll
            for (int g = 0; g < 2; ++g) { float pv[3]; int pi[3];
#pragma unroll
                for (int j = 0; j < 3; ++j) { pv[j] = __shfl_xor(tv[g][j], off); pi[j] = __shfl_xor(ti[g][j], off); }
#pragma unroll
                for (int j = 0; j < 3; ++j) top3_insert(pv[j], pi[j], tv[g], ti[g]); }
        const int nsel = c < 3 ? c : 3;
        if (fq == 0) {
#pragma unroll
            for (int g = 0; g < 2; ++g) { const int tl = wave * 32 + g * 16 + fr;
#pragma unroll
                for (int j = 0; j < 3; ++j) if (j < nsel) { const int n = ti[g][j]; const unsigned pp = __hip_atomic_fetch_add(&lcnt[n], 1u, __ATOMIC_RELAXED, __HIP_MEMORY_SCOPE_WORKGROUP); llist[n * 256 + pp] = (unsigned short)((tl << 2) | j); } }
        }
        __syncthreads();
        if (tid < c) { const unsigned k = lcnt[tid]; lbase[tid] = k ? atomicAdd(gcnt + h * NBLK + tid, k) : 0u; }
        __syncthreads();
        for (int n = wave; n < c; n += NWAVES) { const unsigned k = lcnt[n], base = lbase[n];
            unsigned short* dst = glist + (size_t)h * LIST_PER_HEAD + list_off(n) + base;
            for (unsigned i = lane; i < k; i += 64) { const unsigned e = llist[n * 256 + i]; dst[i] = (unsigned short)((((unsigned)c * BLK + (e >> 2)) << 2) | (e & 3u)); } }
        __syncthreads();
    }
}
__device__ __forceinline__ void stage_kv(const bf16* Kg, const bf16* Vt, int h, int n, LAS unsigned char* lds, int tid) {
    v4u kw[8], vw[8];
#pragma unroll
    for (int i = 0; i < 8; ++i) { const int row = (tid >> 4) + 32 * i, ch = tid & 15; kw[i] = *(const GAS v4u*)(Kg + (size_t)(n * BLK + row) * 1024 + h * HD + ch * 8); }
#pragma unroll
    for (int i = 0; i < 8; ++i) { const int row = (tid >> 5) + 16 * i, ch = tid & 31; vw[i] = *(const GAS v4u*)(Vt + (size_t)(h * HD + row) * M + n * BLK + ch * 8); }
    __syncthreads();
#pragma unroll
    for (int i = 0; i < 8; ++i) { const int row = (tid >> 4) + 32 * i, ch = tid & 15; const int sw = (((row >> 3) & 3) << 2) | (row & 3);
        *(LAS v4u*)(lds + row * 256 + ((ch ^ sw) << 4)) = kw[i]; }
#pragma unroll
    for (int i = 0; i < 8; ++i) { const int row = (tid >> 5) + 16 * i, ch = tid & 31;
        *(LAS v4u*)(lds + 65536 + row * 512 + ((ch ^ ((((row >> 4) & 3) << 2) | (row & 3))) << 4)) = vw[i]; }
}
__device__ __forceinline__ void load_q(bf16x8 (&qf)[2][4], const bf16* Q, int h, const int (&tq)[2], int fq) {
#pragma unroll
    for (int g = 0; g < 2; ++g)
#pragma unroll
        for (int ks = 0; ks < 4; ++ks) qf[g][ks] = *(const GAS bf16x8*)(Q + (size_t)tq[g] * 1024 + h * HD + ks * 32 + fq * 8);
}
template <bool CAUSAL, int MODE = 0>
__device__ __forceinline__ void attn_core(const LAS unsigned char* lds, const bf16x8 (&qf)[2][4], int wave, int fr, int fq, float B2, f32x4 (&O)[8][2], float (&l)[2]) {
#pragma unroll
    for (int dt = 0; dt < 8; ++dt) { O[dt][0] = (f32x4){0.f, 0.f, 0.f, 0.f}; O[dt][1] = O[dt][0]; }
    l[0] = 0.f; l[1] = 0.f;
    const int nch = CAUSAL ? wave + 1 : 8;
    const int krow = (fr >> 2) * 8 + (fr & 3);
    bf16x8 kf[4][2];
#pragma unroll
    for (int ks = 0; ks < 4; ++ks)
#pragma unroll
        for (int t = 0; t < 2; ++t) kf[ks][t] = *(const LAS bf16x8*)(lds + (krow + t * 4) * 256 + (((ks * 4 + fq) ^ fr) << 4));
#pragma unroll 2
    for (int c = 0; c < nch; ++c) {
        f32x4 s[2][2];
#pragma unroll
        for (int t = 0; t < 2; ++t) { s[t][0] = (f32x4){-B2, -B2, -B2, -B2}; s[t][1] = s[t][0]; }
        bf16x8 vf[8];
#pragma unroll
        for (int dt = 0; dt < 8; ++dt) vf[dt] = *(const LAS bf16x8*)(lds + 65536 + ((dt >> 2) * 64 + (fr >> 2) * 16 + (dt & 3) * 4 + (fr & 3)) * 512 + (((c * 4 + fq) ^ fr) << 4));
        __builtin_amdgcn_s_setprio(1);
#pragma unroll
        for (int ks = 0; ks < 4; ++ks)
#pragma unroll
            for (int t = 0; t < 2; ++t) {
                if (MODE != 2 || ks == 0) {
                s[t][0] = __builtin_amdgcn_mfma_f32_16x16x32_bf16(kf[ks][t], qf[0][ks], s[t][0], 0, 0, 0);
                s[t][1] = __builtin_amdgcn_mfma_f32_16x16x32_bf16(kf[ks][t], qf[1][ks], s[t][1], 0, 0, 0); }
            }
        __builtin_amdgcn_s_setprio(0);
        __builtin_amdgcn_sched_barrier(0);
        { const int cn = (c + 1 < nch) ? c + 1 : c;
#pragma unroll
          for (int ks = 0; ks < 4; ++ks)
#pragma unroll
              for (int t = 0; t < 2; ++t) kf[ks][t] = *(const LAS bf16x8*)(lds + (cn * 32 + krow + t * 4) * 256 + (((ks * 4 + fq) ^ fr) << 4)); }
        bf16x8 pf[2];
#pragma unroll
        for (int g = 0; g < 2; ++g) {
            float p[8];
#pragma unroll
            for (int t = 0; t < 2; ++t)
#pragma unroll
                for (int i = 0; i < 4; ++i) { float e = MODE == 1 ? s[t][g][i] : __builtin_amdgcn_exp2f(s[t][g][i]);
                    if (CAUSAL && c == wave) { const int kl = c * 32 + fq * 8 + t * 4 + i, ql = wave * 32 + g * 16 + fr; if (kl > ql) e = 0.f; }
                    p[t * 4 + i] = e; }
            l[g] += ((p[0] + p[1]) + (p[2] + p[3])) + ((p[4] + p[5]) + (p[6] + p[7]));
            v4u w; w.x = pg8::cvt_pk_bf16(p[0], p[1]); w.y = pg8::cvt_pk_bf16(p[2], p[3]); w.z = pg8::cvt_pk_bf16(p[4], p[5]); w.w = pg8::cvt_pk_bf16(p[6], p[7]);
            pf[g] = __builtin_bit_cast(bf16x8, w);
        }
        __builtin_amdgcn_s_setprio(1);
#pragma unroll
        for (int dt = 0; dt < 8; ++dt) {
            if (MODE != 3 || dt == 0) {
            O[dt][0] = __builtin_amdgcn_mfma_f32_16x16x32_bf16(vf[dt], pf[0], O[dt][0], 0, 0, 0);
            O[dt][1] = __builtin_amdgcn_mfma_f32_16x16x32_bf16(vf[dt], pf[1], O[dt][1], 0, 0, 0); }
        }
        __builtin_amdgcn_s_setprio(0);
    }
    l[0] += __shfl_xor(l[0], 16); l[0] += __shfl_xor(l[0], 32); l[1] += __shfl_xor(l[1], 16); l[1] += __shfl_xor(l[1], 32);
}
__device__ __forceinline__ float score_bound(const float* q_norm, const float* k_norm, int lane) {
    float a = fmaxf(fabsf(q_norm[lane]), fabsf(q_norm[lane + 64])), b = fmaxf(fabsf(k_norm[lane]), fabsf(k_norm[lane + 64]));
#pragma unroll
    for (int o = 1; o < 64; o <<= 1) { a = fmaxf(a, __shfl_xor(a, o)); b = fmaxf(b, __shfl_xor(b, o)); }
    return 128.0f * a * b * C2 * 1.001f + 0.01f;
}
template <int MODE>
__device__ __forceinline__ void phase3a(const float* q_norm, const float* k_norm, unsigned char* ws, LAS unsigned char* lds, int G, int tid, int wave, int lane) {
    const int fr = lane & 15, fq = lane >> 4;
    LAS int* pre = (LAS int*)(lds + SCAN_OFF);
    LAS int* cntl = (LAS int*)(lds + SCAN_OFF + 2080);
    const unsigned* gcnt = (const unsigned*)(ws + WS_CTL) + CW_GCNT; const unsigned short* glist = (const unsigned short*)(ws + WS_LIST);
    const bf16* Q = (const bf16*)(ws + WS_Q); const bf16* Kg = (const bf16*)(ws + WS_K); const bf16* Vt = (const bf16*)(ws + WS_VT);
    unsigned char* OP = ws + WS_OPART; float* LP = (float*)(ws + WS_LPART);
    const float B2 = score_bound(q_norm, k_norm, lane);
    { const int cnt = (int)__hip_atomic_load(gcnt + tid, __ATOMIC_RELAXED, __HIP_MEMORY_SCOPE_AGENT); pre[tid + 1] = (cnt + 255) >> 8; cntl[tid] = cnt; if (tid == 0) pre[0] = 0; }
    __syncthreads();
    for (int o = 1; o < 512; o <<= 1) { const int v = pre[tid + 1] + ((tid + 1 - o) >= 1 ? pre[tid + 1 - o] : 0); __syncthreads(); pre[tid + 1] = v; __syncthreads(); }
    const int T = pre[512];
    const int i_lo = (int)(((long)blockIdx.x * T) / G), i_hi = (int)(((long)(blockIdx.x + 1) * T) / G);
    int staged = -1;
#define P3A_DECODE(IT, HN, TILE) do { int lo_ = 0, hi_ = 511; while (lo_ < hi_) { const int mid_ = (lo_ + hi_ + 1) >> 1; if (pre[mid_] <= (IT)) lo_ = mid_; else hi_ = mid_ - 1; } HN = lo_; TILE = (IT) - pre[lo_]; } while (0)
    unsigned en[2] = {0u, 0u}; bool okn[2] = {false, false};
    bf16x8 qf[2][4]; int hnn = 0;
    if (i_lo < i_hi) { int hn, tile; P3A_DECODE(i_lo, hn, tile); const int cnt = cntl[hn]; const unsigned short* lst = glist + (size_t)(hn >> 6) * LIST_PER_HEAD + list_off(hn & 63) + tile * 256;
#pragma unroll
        for (int g = 0; g < 2; ++g) { const int qi = wave * 32 + g * 16 + fr; okn[g] = tile * 256 + qi < cnt; en[g] = okn[g] ? lst[qi] : 0u; }
        { const int tq0[2] = {(int)(en[0] >> 2), (int)(en[1] >> 2)}; load_q(qf, Q, hn >> 6, tq0, fq); } }
    for (int it = i_lo; it < i_hi; ++it) {
        int hn, tile; P3A_DECODE(it, hn, tile); const int h = hn >> 6, n = hn & 63;
        int tq[2], sj[2]; bool ok[2];
#pragma unroll
        for (int g = 0; g < 2; ++g) { ok[g] = okn[g]; tq[g] = (int)(en[g] >> 2); sj[g] = (int)(en[g] & 3u); }
        if (it + 1 < i_hi) { int hn2, tile2; P3A_DECODE(it + 1, hn2, tile2); hnn = hn2; const int cnt2 = cntl[hn2]; const unsigned short* lst2 = glist + (size_t)(hn2 >> 6) * LIST_PER_HEAD + list_off(hn2 & 63) + tile2 * 256;
#pragma unroll
            for (int g = 0; g < 2; ++g) { const int qi = wave * 32 + g * 16 + fr; okn[g] = tile2 * 256 + qi < cnt2; en[g] = okn[g] ? lst2[qi] : 0u; } }
        if (hn != staged) { stage_kv(Kg, Vt, h, n, lds, tid); LDS_WAIT(); __syncthreads(); staged = hn; }
        f32x4 O[8][2]; float l[2];
        attn_core<false, MODE>(lds, qf, wave, fr, fq, B2, O, l);
        if (it + 1 < i_hi) { const int tqn[2] = {(int)(en[0] >> 2), (int)(en[1] >> 2)}; load_q(qf, Q, hnn >> 6, tqn, fq); }
#pragma unroll
        for (int g = 0; g < 2; ++g) if (ok[g]) {
            unsigned char* op = OP + ((size_t)sj[g] * M + tq[g]) * 1024 + h * HD + 16 * fq;
            const float sc = 16.0f / l[g];
#pragma unroll
            for (int j = 0; j < 2; ++j) { v4u w;
                { int t = 0; t = __builtin_amdgcn_cvt_pk_fp8_f32(O[4 * j][g][0] * sc, O[4 * j][g][1] * sc, t, false); t = __builtin_amdgcn_cvt_pk_fp8_f32(O[4 * j][g][2] * sc, O[4 * j][g][3] * sc, t, true); w.x = (unsigned)t; }
                { int t = 0; t = __builtin_amdgcn_cvt_pk_fp8_f32(O[4 * j + 1][g][0] * sc, O[4 * j + 1][g][1] * sc, t, false); t = __builtin_amdgcn_cvt_pk_fp8_f32(O[4 * j + 1][g][2] * sc, O[4 * j + 1][g][3] * sc, t, true); w.y = (unsigned)t; }
                { int t = 0; t = __builtin_amdgcn_cvt_pk_fp8_f32(O[4 * j + 2][g][0] * sc, O[4 * j + 2][g][1] * sc, t, false); t = __builtin_amdgcn_cvt_pk_fp8_f32(O[4 * j + 2][g][2] * sc, O[4 * j + 2][g][3] * sc, t, true); w.z = (unsigned)t; }
                { int t = 0; t = __builtin_amdgcn_cvt_pk_fp8_f32(O[4 * j + 3][g][0] * sc, O[4 * j + 3][g][1] * sc, t, false); t = __builtin_amdgcn_cvt_pk_fp8_f32(O[4 * j + 3][g][2] * sc, O[4 * j + 3][g][3] * sc, t, true); w.w = (unsigned)t; }
                *(GAS v4u*)(op + j * 64) = w; }
            if (fq == 0) LP[((size_t)sj[g] * M + tq[g]) * NH + h] = l[g];
        }
    }
#undef P3A_DECODE
    __syncthreads();
}
__device__ __forceinline__ void phase3b(const float* q_norm, const float* k_norm, unsigned char* ws, LAS unsigned char* lds, int G, int tid, int wave, int lane, bf16* Oout) {
    const int fr = lane & 15, fq = lane >> 4;
    bf16* Q = (bf16*)(ws + WS_Q); const bf16* Kg = (const bf16*)(ws + WS_K); const bf16* Vt = (const bf16*)(ws + WS_VT);
    const unsigned char* OP = ws + WS_OPART; const float* LP = (const float*)(ws + WS_LPART);
    const float B2 = score_bound(q_norm, k_norm, lane);
    bf16x8 qf[2][4];
    if ((int)blockIdx.x < NH * NBLK) { const int u0 = blockIdx.x; const int tq0[2] = {(u0 & 63) * BLK + wave * 32 + fr, (u0 & 63) * BLK + wave * 32 + 16 + fr}; load_q(qf, Q, u0 >> 6, tq0, fq); }
    for (int unit = blockIdx.x; unit < NH * NBLK; unit += G) {
        const int h = unit >> 6, c = unit & 63;
        stage_kv(Kg, Vt, h, c, lds, tid); LDS_WAIT(); __syncthreads();
        int tq[2];
#pragma unroll
        for (int g = 0; g < 2; ++g) tq[g] = c * BLK + wave * 32 + g * 16 + fr;
        f32x4 O[8][2]; float l[2];
        attn_core<true>(lds, qf, wave, fr, fq, B2, O, l);
        if (unit + G < NH * NBLK) { const int u1 = unit + G; const int tqn[2] = {(u1 & 63) * BLK + wave * 32 + fr, (u1 & 63) * BLK + wave * 32 + 16 + fr}; load_q(qf, Q, u1 >> 6, tqn, fq); }
        const int nsel = c < 3 ? c : 3;
#pragma unroll
        for (int g = 0; g < 2; ++g) {
            float lp[3];
#pragma unroll
            for (int j = 0; j < 3; ++j) lp[j] = LP[((size_t)j * M + tq[g]) * NH + h];
            v4u w[3][2];
#pragma unroll
            for (int j = 0; j < 3; ++j)
#pragma unroll
                for (int k = 0; k < 2; ++k) w[j][k] = *(const GAS v4u*)(OP + ((size_t)j * M + tq[g]) * 1024 + h * HD + k * 64 + 16 * fq);
            float lt = l[g]; float ls[3];
#pragma unroll
            for (int j = 0; j < 3; ++j) { ls[j] = j < nsel ? lp[j] * (1.0f / 16.0f) : 0.f; lt += j < nsel ? lp[j] : 0.f; }
            const float inv = 1.0f / lt;
#pragma unroll
            for (int k = 0; k < 2; ++k) {
                f32x4 o[4];
#pragma unroll
                for (int q = 0; q < 4; ++q) o[q] = O[4 * k + q][g];
#pragma unroll
                for (int j = 0; j < 3; ++j) if (j < nsel) { const unsigned xw[4] = {w[j][k].x, w[j][k].y, w[j][k].z, w[j][k].w};
#pragma unroll
                    for (int q = 0; q < 4; ++q) { const pg8::f32x2_t_ lo = __builtin_amdgcn_cvt_pk_f32_fp8((int)xw[q], false), hi = __builtin_amdgcn_cvt_pk_f32_fp8((int)xw[q], true);
                        o[q][0] += lo[0] * ls[j]; o[q][1] += lo[1] * ls[j]; o[q][2] += hi[0] * ls[j]; o[q][3] += hi[1] * ls[j]; } }
                bf16* dst = Oout + (size_t)tq[g] * 1024 + h * HD + k * 64 + 16 * fq;
                *(GAS v4u*)dst = pg8::pack8(o[0] * inv, o[1] * inv); *(GAS v4u*)(dst + 8) = pg8::pack8(o[2] * inv, o[3] * inv); }
        }
    }
    __syncthreads();
}

#ifndef MK_PER_PHASE
#define MK_PER_PHASE 0
#endif
#ifndef MK_DUP
#define MK_DUP -1
#endif
constexpr int N_PHASES = 9;
struct Args { const float* in[14]; float* out; unsigned char* ws; int ph_lo, ph_hi; };
__global__ void __launch_bounds__(NTHREADS, 2) hybrid_fwd(Args args) {
    extern __shared__ __attribute__((aligned(16))) unsigned char lds_raw[];
    LAS unsigned char* lds = (LAS unsigned char*)lds_raw;
    volatile LAS unsigned* MISC = (volatile LAS unsigned*)(lds + MISC_OFF);
    const int tid = threadIdx.x, lane = tid & 63, wave = __builtin_amdgcn_readfirstlane(tid >> 6);
    const int G = gridDim.x; const int vcu = (G % 8 == 0) ? ((int)blockIdx.x % 8) * (G / 8) + (int)blockIdx.x / 8 : (int)blockIdx.x;
    unsigned char* ws = args.ws;
    gu32* ctl = (gu32*)(ws + WS_CTL);
    if (tid < 32) MISC[tid] = 0u;
    __syncthreads();
    const int lo = args.ph_lo, hi = args.ph_hi;
    XcdBarrier bar; bar.bar = (unsigned*)ctl + CW_BAR; bar.x = 0; bar.st = nullptr;
    if (hi - lo > 1) bar = xcd_barrier_post((unsigned*)ctl + CW_BAR, MISC + 8);
#ifndef PHASE_MASK
#define PHASE_MASK 0x1ff
#endif
#define IN(k) (((PHASE_MASK >> (k)) & 1) && lo <= (k) && (k) < hi)
#define SEAM(k) do { if (IN(k) && IN((k) + 1)) xcd_barrier(bar); } while (0)
    const float* x = args.in[0]; const float* norm_mix = args.in[1]; const float* w_in = args.in[2]; const float* conv_a_w = args.in[3]; const float* q_norm = args.in[4]; const float* k_norm = args.in[5];
    const float* w_oa = args.in[6]; const float* w_ob = args.in[7]; const float* w_o = args.in[8]; const float* norm_ffn = args.in[9]; const float* w_up = args.in[10]; const float* ffn_conv_w = args.in[11];
    const float* ffn_conv_b = args.in[12]; const float* w_down = args.in[13];
    float* out = args.out;
    float* rowss = (float*)((unsigned*)ctl + CW_ROWSS);
    const size_t TSTEP = (size_t)256 * 1024 * 2;

    if (IN(0)) { phase0(x, norm_mix, w_in, w_oa, w_ob, w_o, w_up, norm_ffn, ws, lds, vcu, G, wave, lane); __syncthreads(); }
    SEAM(0);
    if (IN(1)) {
        pg8::Gemm g{(const bf16*)(ws + WS_XB), (const bf16*)(ws + WS_XB), (const bf16*)(ws + WS_WIN), (const bf16*)(ws + WS_WIN), D, TSTEP};
        pg8::StaticOrder S; S.init(M / 256, NIN / 256, G, (int)blockIdx.x);
        pg8::Epi1 E{(bf16*)(ws + WS_CA), (bf16*)(ws + WS_UU), (bf16*)(ws + WS_Q), (bf16*)(ws + WS_K), (bf16*)(ws + WS_VT), (bf16*)out, (const float*)(ws + WS_RSTDX), q_norm, k_norm, (float*)(ws + WS_KBAR), (PG8_LAS float*)(lds + HALO_OFF)};
        pg8::gemm_phase<pg8::Epi1, pg8::StaticOrder, true, true>(lds, g, S, E);
    }
    SEAM(1);
    if (IN(2)) { phase2d(ws, lds, G, tid, wave, lane, (unsigned*)(ws + WS_CTL) + CW_GCNT, (unsigned short*)(ws + WS_LIST));
        phase2(conv_a_w, ws, G, tid, (bf16*)(ws + WS_CA)); __syncthreads(); }
#if MK_DUP == 21
    if (IN(2)) { phase2d(ws, lds, G, tid, wave, lane, (unsigned*)(ws + WS_CTL) + CW_GCNT + 512, (unsigned short*)(ws + WS_WIN)); }
#endif
#if MK_DUP == 22
    if (IN(2)) { phase2(conv_a_w, ws, G, tid, (bf16*)(ws + WS_XB)); }
#endif
    SEAM(2);
#if MK_DUP >= 30 && MK_DUP <= 35
    if (IN(3)) phase3a<MK_DUP - 30>(q_norm, k_norm, ws, lds, G, tid, wave, lane);
#endif
    if (IN(3)) phase3a<0>(q_norm, k_norm, ws, lds, G, tid, wave, lane);
    SEAM(3);
    if (IN(4)) { phase3b(q_norm, k_norm, ws, lds, G, tid, wave, lane, (bf16*)(ws + WS_Q));
#if MK_DUP == 4
        phase3b(q_norm, k_norm, ws, lds, G, tid, wave, lane, (bf16*)(ws + WS_OPART));
#endif
        }
    SEAM(4);
    if (IN(5)) {
        { LAS float* scr = (LAS float*)(lds + wave * 16384); const int gw = vcu * NWAVES + wave, NGW = G * NWAVES;
          if (blockIdx.x == 0 && tid < 256) *(GAS v4u*)(ws + WS_HB - 4096 + tid * 16) = (v4u){0u, 0u, 0u, 0u};
          __syncthreads(); }
        pg8::Gemm g{(const bf16*)(ws + WS_CA), (const bf16*)(ws + WS_Q), (const bf16*)(ws + WS_WOA), (const bf16*)(ws + WS_WOB), D, TSTEP};
        pg8::DualOrder S; S.S.init(M / 256, D / 256, G, (int)blockIdx.x);
        pg8::Epi4 E{(bf16*)(ws + WS_MG), (const bf16*)out};
        pg8::gemm_phase<pg8::Epi4, pg8::DualOrder, true, true>(lds, g, S, E);
    }
    SEAM(5);
    if (IN(6)) {
        pg8::Gemm g{(const bf16*)(ws + WS_MG), (const bf16*)(ws + WS_MG), (const bf16*)(ws + WS_WO), (const bf16*)(ws + WS_WO), D, TSTEP};
        pg8::StaticOrder S; S.init(M / 256, D / 256, G, (int)blockIdx.x);
        pg8::Epi5 E{(const bf16*)(ws + WS_XB), out, (bf16*)(ws + WS_HB), rowss};
        pg8::gemm_phase<pg8::Epi5, pg8::StaticOrder, true, true>(lds, g, S, E);
#if MK_DUP == 6
        { pg8::Epi5 E2{(const bf16*)(ws + WS_XB), (float*)(ws + WS_Q), (bf16*)(ws + WS_VT), (float*)(ws + WS_CA)}; pg8::gemm_phase<pg8::Epi5, pg8::StaticOrder, true, true>(lds, g, S, E2); }
#endif
    }
    SEAM(6);
    if (IN(7)) {
        const bf16* hb2 = (const bf16*)(ws + WS_HB) - 2 * 1024;
        pg8::Gemm g{hb2, hb2, (const bf16*)(ws + WS_WUP), (const bf16*)(ws + WS_WUP), D, (size_t)254 * 1024 * 2};
        pg8::StaticOrder S; S.init(65, 22, G, (int)blockIdx.x);
        pg8::Epi6 E{(bf16*)(ws + WS_ACT), rowss, ffn_conv_w, ffn_conv_b, (PG8_LAS float*)(lds + HALO_OFF)};
        pg8::gemm_phase<pg8::Epi6, pg8::StaticOrder, true, true>(lds, g, S, E);
        { const int nwg = 65 * 22, full = nwg % G, nidle = full ? G - full : G, idx = full ? (int)blockIdx.x - full : (int)blockIdx.x;
          if (idx >= 0) convert_weight(w_down, DFF, D, (bf16*)(ws + WS_WDN), nullptr, 0, (LAS float*)(lds + wave * 16384), idx * NWAVES + wave, nidle * NWAVES, lane);
          __syncthreads(); }
    }
    SEAM(7);
    if (IN(8)) {
        pg8::Gemm g{(const bf16*)(ws + WS_ACT), (const bf16*)(ws + WS_ACT), (const bf16*)(ws + WS_WDN), (const bf16*)(ws + WS_WDN), DFF, (size_t)256 * DFF * 2};
        pg8::StaticOrder S; S.init(M / 256, D / 256, G, (int)blockIdx.x);
        pg8::Epi7 E{out, (const bf16*)(ws + WS_HB)};
        pg8::gemm_phase<pg8::Epi7, pg8::StaticOrder, true, true>(lds, g, S, E);
#if MK_DUP == 8
        { pg8::Epi7 E2{(float*)(ws + WS_MG), (const bf16*)(ws + WS_HB)}; pg8::gemm_phase<pg8::Epi7, pg8::StaticOrder, true, true>(lds, g, S, E2); }
#endif
    }
#undef IN
#undef SEAM
}

extern "C" void kernel_launch(void* const* d_in, const int* in_sizes, int n_in, void* d_out, int out_size, void* d_ws, size_t ws_size, hipStream_t stream) {
    static int grid = 0;
    if (grid == 0) {
        if (n_in != 14 || in_sizes[0] != M * D || out_size != M * D || ws_size < WS_END) { fprintf(stderr, "kernel_launch: unexpected shapes (n_in %d, in0 %d, out %d, ws %zu)\n", n_in, n_in > 0 ? in_sizes[0] : -1, out_size, ws_size); grid = -1; return; }
        int dev = 0, cus = 0, per_cu = 0;
        if (hipGetDevice(&dev) != hipSuccess || hipDeviceGetAttribute(&cus, hipDeviceAttributeMultiprocessorCount, dev) != hipSuccess) { grid = -1; return; }
        if (hipFuncSetAttribute((const void*)hybrid_fwd, hipFuncAttributeMaxDynamicSharedMemorySize, LDS_BYTES) != hipSuccess) { fprintf(stderr, "kernel_launch: hipFuncSetAttribute failed\n"); grid = -1; return; }
        if (hipOccupancyMaxActiveBlocksPerMultiprocessor(&per_cu, (const void*)hybrid_fwd, NTHREADS, LDS_BYTES) != hipSuccess || per_cu < 1) { fprintf(stderr, "kernel_launch: occupancy query says %d blocks per CU\n", per_cu); (void)hipGetLastError(); grid = -1; return; }
        grid = cus;
    }
    if (grid < 0) return;
    if (hipMemsetAsync((char*)d_ws + WS_CTL, 0, CTL_ZERO_BYTES, stream) != hipSuccess) { fprintf(stderr, "kernel_launch: memset failed\n"); return; }
    Args a{};
    for (int i = 0; i < 14; ++i) a.in[i] = (const float*)d_in[i];
    a.out = (float*)d_out; a.ws = (unsigned char*)d_ws;
#if MK_PER_PHASE
    for (int p = 0; p < N_PHASES; ++p) { a.ph_lo = p; a.ph_hi = p + 1; hipLaunchKernelGGL(hybrid_fwd, dim3(grid), dim3(NTHREADS), LDS_BYTES, stream, a); }
#else
    a.ph_lo = 0; a.ph_hi = N_PHASES;
    void* kargs[] = {&a};
    hipError_t e = hipLaunchCooperativeKernel((const void*)hybrid_fwd, dim3(grid), dim3(NTHREADS), kargs, LDS_BYTES, stream);
    if (e != hipSuccess) fprintf(stderr, "kernel_launch: cooperative launch failed: %s (grid %d)\n", hipGetErrorString(e), grid);
#endif
}
```

```cpp
#include <hip/hip_runtime.h>
#include <cstdio>
#include <cstdint>
namespace pg8 {
#define PG8_LAS __attribute__((address_space(3)))
typedef unsigned short bf16_t;
typedef short bf16x8 __attribute__((ext_vector_type(8)));
typedef float f32x4 __attribute__((ext_vector_type(4)));
typedef unsigned u32x4 __attribute__((ext_vector_type(4)));
constexpr int BM = 256, BK = 64, HALF = 128, HTB = HALF * BK * 2  , STAGE_BYTES = 8 * HTB, NXCD = 8, WGM = 8;

__host__ __device__ __forceinline__ int lds_byte(int r, int c) { const int st = (r >> 4) * 2 + (c >> 5), rr = r & 15, cc = c & 31, ob = rr * 64 + cc * 2; return st * 1024 + (ob ^ (((ob >> 9) & 1) << 5)); }
__host__ __device__ __forceinline__ void stage_rc(int b, int& R, int& C) { const int st = b / 1024, sb = b % 1024, swz = sb ^ (((sb >> 9) & 1) << 5); R = (st >> 1) * 16 + swz / 64; C = (st & 1) * 32 + (swz % 64) / 2; }
__host__ __device__ __forceinline__ int perm32(int rho) { const int n = rho >> 4, i = rho & 15; return 8 * (i >> 2) + 4 * n + (i & 3); }


struct Unit { int pm, pn, sel; };
struct Gemm { const bf16_t* A0; const bf16_t* A1; const bf16_t* B0; const bf16_t* B1; int K; size_t a_tstep; };

struct StaticOrder {
    int nM, nN, nwg, G, c;
    __host__ __device__ void init(int nM_, int nN_, int G_, int c_) { nM = nM_; nN = nN_; nwg = nM * nN; G = G_; c = c_; }
    __host__ __device__ bool next(int i, Unit& u) const {
        const long L = (long)i * G + c; if (L >= nwg) return false;
        int wgid = (int)L; { const int q = nwg / NXCD, r = nwg % NXCD, xcd = wgid % NXCD, off = wgid / NXCD; wgid = (xcd < r ? xcd * (q + 1) : r * (q + 1) + (xcd - r) * q) + off; }
        const int nig = WGM * nN, gid = wgid / nig, fm = gid * WGM, gsz = (nM - fm) < WGM ? (nM - fm) : WGM;
        u.pm = fm + ((wgid % nig) % gsz); u.pn = (wgid % nig) / gsz; u.sel = 0; return true;
    }
    __device__ __forceinline__ void a_ready(const Unit&) const {}
    __device__ __forceinline__ void done(const Unit&) const {}
};
struct DualOrder {
    StaticOrder S;
    __host__ __device__ bool next(int i, Unit& u) const { const bool ok = S.next(i >> 1, u); u.sel = i & 1; return ok; }
    __device__ __forceinline__ void a_ready(const Unit&) const {}
    __device__ __forceinline__ void done(const Unit&) const {}
};

typedef __bf16 bf16x2_t_ __attribute__((ext_vector_type(2))); typedef float f32x2_t_ __attribute__((ext_vector_type(2)));
__device__ __forceinline__ unsigned cvt_pk_bf16(float lo, float hi) { const f32x2_t_ v = {lo, hi}; const bf16x2_t_ b = __builtin_convertvector(v, bf16x2_t_); return __builtin_bit_cast(unsigned, b); }
__device__ __forceinline__ float bf_lo(unsigned w) { return __uint_as_float(w << 16); }
__device__ __forceinline__ float bf_hi(unsigned w) { return __uint_as_float(w & 0xffff0000u); }
__device__ __forceinline__ float fast_sigmoid(float x) { return __builtin_amdgcn_rcpf(1.0f + __builtin_amdgcn_exp2f(-1.4426950408889634f * x)); }
__device__ __forceinline__ u32x4 pack8(const f32x4 a, const f32x4 b) { u32x4 w; w.x = cvt_pk_bf16(a[0], a[1]); w.y = cvt_pk_bf16(a[2], a[3]); w.z = cvt_pk_bf16(b[0], b[1]); w.w = cvt_pk_bf16(b[2], b[3]); return w; }

template <int CTRL> __device__ __forceinline__ float dpp_shr(float old, float v) { return __builtin_bit_cast(float, __builtin_amdgcn_update_dpp(__builtin_bit_cast(int, old), __builtin_bit_cast(int, v), CTRL, 0xf, 0xf, false)); }
template <int CTRL> __device__ __forceinline__ float dpp_ror(float v) { return __builtin_bit_cast(float, __builtin_amdgcn_update_dpp(0, __builtin_bit_cast(int, v), CTRL, 0xf, 0xf, true)); }
constexpr int MROWS = 16384, DMODEL = 1024, DFF_ = 2816;

struct Epi1 {
    static constexpr bool PERM = true, AFTER_DRAIN = false, APERM = false;
    static __device__ __forceinline__ bool keep_acc(const Unit&) { return false; }
    bf16_t *BG, *UU, *Q, *K, *VT, *SG; const float* rstdx; const float *q_norm, *k_norm; float* kbar; PG8_LAS float* xl;
    __device__ __forceinline__ void operator()(f32x4 (&acc)[2][2][4][2], const Unit& u, int wr, int wc, int fr, int fq) const {
        const int row0 = u.pm * BM + wr * 64 + fr, colw = wc * 32 + 8 * fq, pn = u.pn;
        if (pn >= 12 && pn < 20) {
            const bool isK = pn >= 16; const float* wn = isK ? k_norm : q_norm; const float gs = isK ? 1.0f : 0.12751743074602357f;
            bf16_t* dst = isK ? K : Q; const int cb = ((pn - 12) & 3) * 256;
#pragma unroll
            for (int ai = 0; ai < 2; ++ai)
#pragma unroll
                for (int m = 0; m < 4; ++m) { const int rl = ai * HALF + wr * 64 + m * 16 + fr; const float rs = rstdx[u.pm * BM + rl];
#pragma unroll
                    for (int bj = 0; bj < 2; ++bj) { const f32x4 a = acc[ai][bj][m][0] * rs, b = acc[ai][bj][m][1] * rs; acc[ai][bj][m][0] = a; acc[ai][bj][m][1] = b;
                        float ss = (a[0] * a[0] + a[1] * a[1]) + (a[2] * a[2] + a[3] * a[3]) + (b[0] * b[0] + b[1] * b[1]) + (b[2] * b[2] + b[3] * b[3]);
                        ss += __shfl_xor(ss, 16); ss += __shfl_xor(ss, 32);
                        if (fq == 0) xl[(rl * 2 + bj) * 4 + wc] = ss; } }
            asm volatile("s_waitcnt lgkmcnt(0)" ::: "memory"); __builtin_amdgcn_s_barrier(); asm volatile("" ::: "memory");
            const f32x4 g0 = *(const f32x4*)(wn + colw) * gs, g1 = *(const f32x4*)(wn + colw + 4) * gs;
#pragma unroll
            for (int ai = 0; ai < 2; ++ai)
#pragma unroll
                for (int m = 0; m < 4; ++m) { const int rl = ai * HALF + wr * 64 + m * 16 + fr; const int r = u.pm * BM + rl;
#pragma unroll
                    for (int bj = 0; bj < 2; ++bj) { const f32x4 p = *(const PG8_LAS f32x4*)(xl + (rl * 2 + bj) * 4);
                        const float rn = rsqrtf(((p[0] + p[1]) + (p[2] + p[3])) * (1.0f / 128.0f) + 1e-6f);
                        const f32x4 a = acc[ai][bj][m][0] * rn * g0, b = acc[ai][bj][m][1] * rn * g1; acc[ai][bj][m][0] = a; acc[ai][bj][m][1] = b;
                        if (isK) { int t0 = 0, t1 = 0;
                            t0 = __builtin_amdgcn_cvt_pk_fp8_f32(a[0], a[1], t0, false); t0 = __builtin_amdgcn_cvt_pk_fp8_f32(a[2], a[3], t0, true);
                            t1 = __builtin_amdgcn_cvt_pk_fp8_f32(b[0], b[1], t1, false); t1 = __builtin_amdgcn_cvt_pk_fp8_f32(b[2], b[3], t1, true);
                            *(unsigned long long*)((unsigned char*)dst + (size_t)r * 1024 + cb + bj * 128 + colw) = (unsigned long long)(unsigned)t0 | ((unsigned long long)(unsigned)t1 << 32); }
                        else *(u32x4*)(dst + (size_t)r * 1024 + cb + bj * 128 + colw) = pack8(a, b); } }
            if (isK) {
                f32x4 cs[2][2];
#pragma unroll
                for (int bj = 0; bj < 2; ++bj)
#pragma unroll
                    for (int n = 0; n < 2; ++n) { f32x4 t = acc[0][bj][0][n];
#pragma unroll
                        for (int ai = 0; ai < 2; ++ai)
#pragma unroll
                            for (int m = 0; m < 4; ++m) if (ai + m > 0) t += acc[ai][bj][m][n];
                        cs[bj][n] = t; }
#pragma unroll
                for (int bj = 0; bj < 2; ++bj)
#pragma unroll
                    for (int n = 0; n < 2; ++n)
#pragma unroll
                        for (int e = 0; e < 4; ++e) { float v = cs[bj][n][e]; v += __shfl_xor(v, 1); v += __shfl_xor(v, 2); v += __shfl_xor(v, 4); v += __shfl_xor(v, 8); cs[bj][n][e] = v; }
                if (fr == 0) {
#pragma unroll
                    for (int bj = 0; bj < 2; ++bj) { *(PG8_LAS f32x4*)(xl + 2048 + wr * 256 + bj * 128 + colw) = cs[bj][0]; *(PG8_LAS f32x4*)(xl + 2048 + wr * 256 + bj * 128 + colw + 4) = cs[bj][1]; } }
                asm volatile("s_waitcnt lgkmcnt(0)" ::: "memory"); __builtin_amdgcn_s_barrier(); asm volatile("" ::: "memory");
                int t = threadIdx.x; asm volatile("" : "+v"(t));
                if (t < 256) kbar[((size_t)((pn - 16) * 2 + (t >> 7)) * 64 + u.pm) * 128 + (t & 127)] = (xl[2048 + t] + xl[2048 + 256 + t]) * (1.0f / 256.0f);
            }
            return;
        }
        if (pn >= 20 && pn < 24) {
            int tidv = threadIdx.x; asm volatile("" : "+v"(tidv));
            PG8_LAS unsigned char* T = (PG8_LAS unsigned char*)xl + (tidv >> 6) * 2304;
            const int lane = tidv & 63;
            float rsv[2][4];
#pragma unroll
            for (int ai = 0; ai < 2; ++ai)
#pragma unroll
                for (int m = 0; m < 4; ++m) rsv[ai][m] = rstdx[u.pm * BM + ai * HALF + wr * 64 + m * 16 + fr];
#pragma unroll
            for (int ai = 0; ai < 2; ++ai)
#pragma unroll
                for (int mp = 0; mp < 2; ++mp)
#pragma unroll
                    for (int bj = 0; bj < 2; ++bj) {
#pragma unroll
                        for (int mm = 0; mm < 2; ++mm) { const int m = 2 * mp + mm; const float rs = rsv[ai][m];
                            const u32x4 w = pack8(acc[ai][bj][m][0] * rs, acc[ai][bj][m][1] * rs); const unsigned ww[4] = {w.x, w.y, w.z, w.w};
                            PG8_LAS unsigned char* tp = T + (8 * fq) * 72 + (16 * mm + fr) * 2;
#pragma unroll
                            for (int e = 0; e < 8; ++e) *(PG8_LAS unsigned short*)(tp + e * 72) = (unsigned short)((e & 1) ? (ww[e >> 1] >> 16) : (ww[e >> 1] & 0xffffu)); }
                        asm volatile("s_waitcnt lgkmcnt(0)" ::: "memory");
#pragma unroll
                        for (int rr = 0; rr < 2; ++rr) { const int q = lane + 64 * rr, d = q >> 2, tc = q & 3;
                            const unsigned long long x0 = *(const PG8_LAS unsigned long long*)(T + d * 72 + tc * 16), x1 = *(const PG8_LAS unsigned long long*)(T + d * 72 + tc * 16 + 8);
                            u32x4 o; o.x = (unsigned)x0; o.y = (unsigned)(x0 >> 32); o.z = (unsigned)x1; o.w = (unsigned)(x1 >> 32);
                            *(u32x4*)(VT + ((size_t)(((pn - 20) * 2 + bj) * 128 + 32 * wc + d)) * MROWS + u.pm * BM + ai * HALF + wr * 64 + 32 * mp + tc * 8) = o; }
                        asm volatile("s_waitcnt lgkmcnt(0)" ::: "memory");
                    }
            return;
        }
        float rsg[2][4];
#pragma unroll
        for (int ai = 0; ai < 2; ++ai)
#pragma unroll
            for (int m = 0; m < 4; ++m) rsg[ai][m] = rstdx[row0 + ai * HALF + m * 16];
#pragma unroll
        for (int ai = 0; ai < 2; ++ai)
#pragma unroll
            for (int m = 0; m < 4; ++m) {
                const int r = row0 + ai * HALF + m * 16; const float rs = rsg[ai][m];
                f32x4 v[2][2];
#pragma unroll
                for (int bj = 0; bj < 2; ++bj)
#pragma unroll
                    for (int n = 0; n < 2; ++n) v[bj][n] = acc[ai][bj][m][n] * rs;
                if (pn < 4) {
#pragma unroll
                    for (int bj = 0; bj < 2; ++bj) *(u32x4*)(BG + (size_t)r * 1024 + pn * 256 + bj * 128 + colw) = pack8(v[bj][0], v[bj][1]);
                } else if (pn < 12) {
                    *(u32x4*)(UU + (size_t)r * 1024 + (pn - 4) * 128 + colw) = pack8(v[0][0] * v[1][0], v[0][1] * v[1][1]);
                } else {
                    f32x4 ra, rb, sa, sb;
#pragma unroll
                    for (int e = 0; e < 4; ++e) { const float ea0 = __builtin_amdgcn_exp2f(-1.4426950408889634f * v[0][0][e]), ea1 = __builtin_amdgcn_exp2f(-1.4426950408889634f * v[0][1][e]);
                        const float eb0 = __builtin_amdgcn_exp2f(-1.4426950408889634f * v[1][0][e]), eb1 = __builtin_amdgcn_exp2f(-1.4426950408889634f * v[1][1][e]);
                        ra[e] = (1.0f + eb0) * __builtin_amdgcn_rcpf(1.0f + ea0); rb[e] = (1.0f + eb1) * __builtin_amdgcn_rcpf(1.0f + ea1);
                        sa[e] = __builtin_amdgcn_rcpf(1.0f + eb0); sb[e] = __builtin_amdgcn_rcpf(1.0f + eb1); }
                    *(u32x4*)(SG + (size_t)r * 2048 + (pn - 24) * 128 + colw) = pack8(ra, rb);
                    *(u32x4*)(SG + (size_t)r * 2048 + 1024 + (pn - 24) * 128 + colw) = pack8(sa, sb);
                }
            }
    }
};
struct Epi4 {
    static constexpr bool PERM = true, AFTER_DRAIN = false, APERM = false;
    bf16_t* MG; const bf16_t* SG;
    static __device__ __forceinline__ bool keep_acc(const Unit& u) { return u.sel == 0; }
    __device__ __forceinline__ void operator()(f32x4 (&acc)[2][2][4][2], const Unit& u, int wr, int wc, int fr, int fq) const {
        const int row0 = u.pm * BM + wr * 64 + fr, col0 = u.pn * BM + wc * 32 + 8 * fq;
#pragma unroll
        for (int ai = 0; ai < 2; ++ai) {
            u32x4 g[4][2];
#pragma unroll
            for (int m = 0; m < 4; ++m)
#pragma unroll
                for (int bj = 0; bj < 2; ++bj) g[m][bj] = *(const u32x4*)(SG + (size_t)(row0 + ai * HALF + m * 16) * 2048 + u.sel * 1024 + col0 + bj * HALF);
#pragma unroll
            for (int m = 0; m < 4; ++m) { const int r = row0 + ai * HALF + m * 16;
#pragma unroll
                for (int bj = 0; bj < 2; ++bj) { const int c = col0 + bj * HALF; const u32x4 gg = g[m][bj];
                    f32x4 a = acc[ai][bj][m][0], b = acc[ai][bj][m][1];
                    a[0] *= bf_lo(gg.x); a[1] *= bf_hi(gg.x); a[2] *= bf_lo(gg.y); a[3] *= bf_hi(gg.y); b[0] *= bf_lo(gg.z); b[1] *= bf_hi(gg.z); b[2] *= bf_lo(gg.w); b[3] *= bf_hi(gg.w);
                    if (u.sel) *(u32x4*)(MG + (size_t)r * 1024 + c) = pack8(a, b);
                    else { acc[ai][bj][m][0] = a; acc[ai][bj][m][1] = b; } } }
        }
    }
};
struct Epi5 {
    static constexpr bool PERM = true, AFTER_DRAIN = false, APERM = false;
    static __device__ __forceinline__ bool keep_acc(const Unit&) { return false; }
    const bf16_t* X; float* OUT; bf16_t* HB; float* rowss;
    __device__ __forceinline__ void operator()(f32x4 (&acc)[2][2][4][2], const Unit& u, int wr, int wc, int fr, int fq) const {
        const int row0 = u.pm * BM + wr * 64 + fr, col0 = u.pn * BM + wc * 32 + 8 * fq;
#pragma unroll
        for (int ai = 0; ai < 2; ++ai) {
            u32x4 xw[4][2];
#pragma unroll
            for (int m = 0; m < 4; ++m)
#pragma unroll
                for (int bj = 0; bj < 2; ++bj) xw[m][bj] = __builtin_nontemporal_load((const u32x4*)(X + (size_t)(row0 + ai * HALF + m * 16) * 1024 + col0 + bj * HALF));
#pragma unroll
            for (int m = 0; m < 4; ++m) { const int r = row0 + ai * HALF + m * 16; float ss = 0.f;
#pragma unroll
                for (int bj = 0; bj < 2; ++bj) { const size_t o = (size_t)r * 1024 + col0 + bj * HALF;
                    const u32x4 xq = xw[m][bj];
                    const f32x4 a = acc[ai][bj][m][0] + (f32x4){bf_lo(xq.x), bf_hi(xq.x), bf_lo(xq.y), bf_hi(xq.y)}, b = acc[ai][bj][m][1] + (f32x4){bf_lo(xq.z), bf_hi(xq.z), bf_lo(xq.w), bf_hi(xq.w)};
                    *(u32x4*)(HB + o) = pack8(a, b);
                    ss += (a[0] * a[0] + a[1] * a[1]) + (a[2] * a[2] + a[3] * a[3]) + (b[0] * b[0] + b[1] * b[1]) + (b[2] * b[2] + b[3] * b[3]); }
                ss += __shfl_xor(ss, 16); ss += __shfl_xor(ss, 32);
                if (fq == 0) atomicAdd(rowss + r, ss); }
        }
    }
};
struct Epi6 {
    static constexpr bool PERM = true, AFTER_DRAIN = false, APERM = true;
    static __device__ __forceinline__ bool keep_acc(const Unit&) { return false; }
    bf16_t* ACT; const float* rowss; const float* cw; const float* cb; PG8_LAS float* halo;
    __device__ __forceinline__ void operator()(f32x4 (&acc)[2][2][4][2], const Unit& u, int wr, int wc, int fr, int fq) const {
        const int r0 = u.pm * 254 - 2, colw = wc * 32 + 8 * fq;
#pragma unroll
        for (int ai = 0; ai < 2; ++ai)
#pragma unroll
            for (int m = 0; m < 4; ++m) { int gr = r0 + ai * HALF + wr * 64 + 4 * fr + m; gr = gr < 0 ? 0 : (gr > MROWS - 1 ? MROWS - 1 : gr);
                const float rs = rsqrtf(rowss[gr] * (1.0f / 1024.0f) + 1e-6f);
#pragma unroll
                for (int bj = 0; bj < 2; ++bj)
#pragma unroll
                    for (int n = 0; n < 2; ++n) acc[ai][bj][m][n] *= rs; }
        if (fr == 15) {
#pragma unroll
            for (int ai = 0; ai < 2; ++ai)
#pragma unroll
                for (int bj = 0; bj < 2; ++bj)
#pragma unroll
                    for (int n = 0; n < 2; ++n) { *(PG8_LAS f32x4*)(halo + (((2 * ai + wr) * 2 + 0) * 256 + bj * 128 + colw + 4 * n)) = acc[ai][bj][2][n];
                                                  *(PG8_LAS f32x4*)(halo + (((2 * ai + wr) * 2 + 1) * 256 + bj * 128 + colw + 4 * n)) = acc[ai][bj][3][n]; }
        }
        f32x4 wn0, wn1, wn2, wnb;
        { const int col = u.pn * 128 + colw; wn0 = *(const f32x4*)(cw + col); wn1 = *(const f32x4*)(cw + 2 * DFF_ + col); wn2 = *(const f32x4*)(cw + 4 * DFF_ + col); wnb = *(const f32x4*)(cb + col); }
        asm volatile("s_waitcnt lgkmcnt(0)" ::: "memory"); __builtin_amdgcn_s_barrier(); asm volatile("" ::: "memory");
#pragma unroll
        for (int bj = 0; bj < 2; ++bj)
#pragma unroll
            for (int n = 0; n < 2; ++n) {
                const f32x4 w0 = wn0, w1 = wn1, w2 = wn2, bb = wnb;
                if (bj * 2 + n < 3) { const int k2 = bj * 2 + n + 1, col = (k2 >> 1) * DFF_ + u.pn * 128 + colw + 4 * (k2 & 1);
                    wn0 = *(const f32x4*)(cw + col); wn1 = *(const f32x4*)(cw + 2 * DFF_ + col); wn2 = *(const f32x4*)(cw + 4 * DFF_ + col); wnb = *(const f32x4*)(cb + col); }
#pragma unroll
                for (int ai = 0; ai < 2; ++ai) {
                    const int s = 2 * ai + wr;
                    const int sm = s > 0 ? s - 1 : 0; const float hz = s > 0 ? 1.0f : 0.0f;
                    const f32x4 h2 = *(const PG8_LAS f32x4*)(halo + ((sm * 2 + 0) * 256 + bj * 128 + colw + 4 * n)) * hz, h1 = *(const PG8_LAS f32x4*)(halo + ((sm * 2 + 1) * 256 + bj * 128 + colw + 4 * n)) * hz;
                    const f32x4 raw0 = acc[ai][bj][0][n], raw1 = acc[ai][bj][1][n]; f32x4 raw2 = acc[ai][bj][2][n], raw3 = acc[ai][bj][3][n];
                    asm volatile("" : "+v"(raw2), "+v"(raw3));
                    f32x4 s3, s2;
#pragma unroll
                    for (int e = 0; e < 4; ++e) { s3[e] = dpp_shr<0x111>(h1[e], raw3[e]); s2[e] = dpp_shr<0x111>(h2[e], raw2[e]); }
                    { f32x4 y3 = w0 * raw1 + w1 * raw2 + w2 * raw3 + bb, y2 = w0 * raw0 + w1 * raw1 + w2 * raw2 + bb, y1 = w0 * s3 + w1 * raw0 + w2 * raw1 + bb, y0 = w0 * s2 + w1 * s3 + w2 * raw0 + bb;
                      asm volatile("" : "+v"(y0), "+v"(y1), "+v"(y2), "+v"(y3));
                      acc[ai][bj][3][n] = y3; acc[ai][bj][2][n] = y2; acc[ai][bj][1][n] = y1; acc[ai][bj][0][n] = y0; }
                }
            }
#pragma unroll
        for (int ai = 0; ai < 2; ++ai)
#pragma unroll
            for (int m = 0; m < 4; ++m) { const int i = ai * HALF + wr * 64 + 4 * fr + m, gr = r0 + i;
                f32x4 a, b;
#pragma unroll
                for (int e = 0; e < 4; ++e) { const float g0 = acc[ai][0][m][0][e], g1 = acc[ai][0][m][1][e];
                    a[e] = g0 * fast_sigmoid(g0) * acc[ai][1][m][0][e]; b[e] = g1 * fast_sigmoid(g1) * acc[ai][1][m][1][e]; }
                if (i >= 2 && gr < MROWS) *(u32x4*)(ACT + (size_t)gr * DFF_ + u.pn * 128 + colw) = pack8(a, b); }
    }
};
struct Epi7 {
    static constexpr bool PERM = true, AFTER_DRAIN = false, APERM = false;
    static __device__ __forceinline__ bool keep_acc(const Unit&) { return false; }
    float* OUT; const bf16_t* HB;
    __device__ __forceinline__ void operator()(f32x4 (&acc)[2][2][4][2], const Unit& u, int wr, int wc, int fr, int fq) const {
        const int row0 = u.pm * BM + wr * 64 + fr, col0 = u.pn * BM + wc * 32 + 8 * fq;
#pragma unroll
        for (int ai = 0; ai < 2; ++ai) {
            u32x4 hv[4][2];
#pragma unroll
            for (int m = 0; m < 4; ++m)
#pragma unroll
                for (int bj = 0; bj < 2; ++bj) hv[m][bj] = *(const u32x4*)(HB + (size_t)(row0 + ai * HALF + m * 16) * 1024 + col0 + bj * HALF);
#pragma unroll
            for (int m = 0; m < 4; ++m) { const int r = row0 + ai * HALF + m * 16;
#pragma unroll
                for (int bj = 0; bj < 2; ++bj) { const size_t o = (size_t)r * 1024 + col0 + bj * HALF; float* p = OUT + o; const u32x4 hw = hv[m][bj];
                    f32x4 a = acc[ai][bj][m][0], b = acc[ai][bj][m][1];
                    a[0] += bf_lo(hw.x); a[1] += bf_hi(hw.x); a[2] += bf_lo(hw.y); a[3] += bf_hi(hw.y); b[0] += bf_lo(hw.z); b[1] += bf_hi(hw.z); b[2] += bf_lo(hw.w); b[3] += bf_hi(hw.w);
                    __builtin_nontemporal_store(a, (f32x4*)p); __builtin_nontemporal_store(b, (f32x4*)(p + 4)); } }
        }
    }
};
template <class Epi, class Sched, bool ALIGN_EPI = false, bool SP2 = false>
__device__ __forceinline__ void gemm_phase(PG8_LAS unsigned char* lds, const Gemm g, const Sched& S, const Epi& E) {
    const int tid = threadIdx.x, wid = __builtin_amdgcn_readfirstlane(tid >> 6), lane = tid & 63, wr = wid >> 2, wc = wid & 3, fr = lane & 15, fq = lane >> 4;
    const int K = g.K, nt = K / BK;
    unsigned voffA[2], voffB[2];
#pragma unroll
    for (int i = 0; i < 2; ++i) { int R, C; stage_rc(tid * 16 + i * 8192, R, C); const int Rb = Epi::PERM ? ((R & ~31) + perm32(R & 31)) : R;
        const int Ra = Epi::APERM ? ((R & ~63) | (4 * (R & 15) + ((R >> 4) & 3))) : R;
        voffA[i] = (unsigned)(Ra * K + C) * 2u; voffB[i] = (unsigned)(Rb * K + C) * 2u; }
    const size_t kstep = (size_t)(BK * 2);
    const size_t hstep = (size_t)HALF * K * 2;
    const size_t tstep = 2 * hstep;
    const unsigned ldsw = (unsigned)wid * 1024u;
    const int aoff = lds_byte(wr * 64 + fr, fq * 8), boff = lds_byte(wc * 32 + fr, fq * 8);
#define PG8_SA(b, h) (((b) * 2 + (h)) * HTB)
#define PG8_SB(b, h) ((4 + (b) * 2 + (h)) * HTB)
#define PG8_STAGE(bufoff, gbase, voff) do { _Pragma("unroll") for (int _i = 0; _i < 2; ++_i) \
        __builtin_amdgcn_global_load_lds((const unsigned*)((const char*)(gbase) + (voff)[_i]), (PG8_LAS unsigned*)(lds + (bufoff) + ldsw + _i * 8192), 16, 0, 0); } while (0)
#define PG8_LDA(dst, b, h) do { _Pragma("unroll") for (int m = 0; m < 4; ++m) _Pragma("unroll") for (int k = 0; k < 2; ++k) dst[m][k] = *(const PG8_LAS bf16x8*)(lds + PG8_SA(b, h) + aoff + m * 2048 + k * 1024); } while (0)
#define PG8_LDB(dst, b, h) do { _Pragma("unroll") for (int n = 0; n < 2; ++n) _Pragma("unroll") for (int k = 0; k < 2; ++k) dst[n][k] = *(const PG8_LAS bf16x8*)(lds + PG8_SB(b, h) + boff + n * 2048 + k * 1024); } while (0)
#define PG8_MMA(ai, bj, At, Bt) do { __builtin_amdgcn_s_setprio(1); _Pragma("unroll") for (int m = 0; m < 4; ++m) _Pragma("unroll") for (int n = 0; n < 2; ++n) _Pragma("unroll") for (int k = 0; k < 2; ++k) \
        acc[ai][bj][m][n] = __builtin_amdgcn_mfma_f32_16x16x32_bf16(Bt[n][k], At[m][k], acc[ai][bj][m][n], 0, 0, 0); __builtin_amdgcn_s_setprio(0); } while (0)
#define PG8_WAIT_V(n) asm volatile("s_waitcnt vmcnt(" #n ")" ::: "memory")
#define PG8_WAIT_L(n) asm volatile("s_waitcnt lgkmcnt(" #n ")" ::: "memory")
#define PG8_BAR __builtin_amdgcn_s_barrier()
#define PG8_SCHED __builtin_amdgcn_sched_barrier(0)
    Unit cur, nxt; int ui = 0;
    if (!S.next(0, cur)) return;
    f32x4 acc[2][2][4][2];
#pragma unroll
    for (int a = 0; a < 2; ++a)
#pragma unroll
        for (int b = 0; b < 2; ++b)
#pragma unroll
            for (int m = 0; m < 4; ++m)
#pragma unroll
                for (int n = 0; n < 2; ++n) acc[a][b][m][n] = (f32x4){0.f, 0.f, 0.f, 0.f};
    bf16x8 At[4][2], B0[2][2], B1[2][2];
    const char* cA = (const char*)(cur.sel ? g.A1 : g.A0) + (size_t)cur.pm * g.a_tstep; const char* cB = (const char*)(cur.sel ? g.B1 : g.B0) + (size_t)cur.pn * tstep;
    S.a_ready(cur);
    if constexpr (SP2) {
        PG8_STAGE(PG8_SB(0, 0), cB, voffB); PG8_STAGE(PG8_SB(0, 1), cB + hstep, voffB); PG8_STAGE(PG8_SA(0, 0), cA, voffA); PG8_STAGE(PG8_SA(0, 1), cA + hstep, voffA);
        if (wr == 1) PG8_BAR;
        PG8_WAIT_V(2); PG8_BAR;
        PG8_STAGE(PG8_SB(1, 0), cB + kstep, voffB); PG8_STAGE(PG8_SA(1, 0), cA + kstep, voffA); PG8_STAGE(PG8_SB(1, 1), cB + hstep + kstep, voffB);
        PG8_WAIT_V(6); PG8_BAR;
    } else {
        PG8_STAGE(PG8_SB(0, 0), cB, voffB); PG8_STAGE(PG8_SA(0, 0), cA, voffA); PG8_STAGE(PG8_SB(0, 1), cB + hstep, voffB); PG8_STAGE(PG8_SA(0, 1), cA + hstep, voffA);
        if (wr == 1) PG8_BAR;
        PG8_WAIT_V(4); PG8_BAR;
        PG8_STAGE(PG8_SB(1, 0), cB + kstep, voffB); PG8_STAGE(PG8_SA(1, 0), cA + kstep, voffA); PG8_STAGE(PG8_SB(1, 1), cB + hstep + kstep, voffB);
        PG8_WAIT_V(6); PG8_BAR;
    }
    for (;;) {
        const bool has_next = S.next(ui + 1, nxt);
        const char* nA = has_next ? (const char*)(nxt.sel ? g.A1 : g.A0) + (size_t)nxt.pm * g.a_tstep : cA; const char* nB = has_next ? (const char*)(nxt.sel ? g.B1 : g.B0) + (size_t)nxt.pn * tstep : cB;
        for (int t = 0; t < nt; t += 2) {
            const bool last = (t == nt - 2);
            const char* a1 = cA + (size_t)(t + 1) * kstep;
            const char* a2 = last ? nA : cA + (size_t)(t + 2) * kstep; const char* b2 = last ? nB : cB + (size_t)(t + 2) * kstep;
            const char* a3 = a2 + kstep; const char* b3 = b2 + kstep;
            if (last && has_next) S.a_ready(nxt);
            if constexpr (SP2) {
            PG8_LDB(B0, 0, 0); PG8_LDB(B1, 0, 1); PG8_SCHED; PG8_LDA(At, 0, 0); PG8_STAGE(PG8_SA(1, 1), a1 + hstep, voffA);
            PG8_WAIT_V(8); PG8_WAIT_L(0); PG8_BAR; PG8_MMA(0, 0, At, B0); PG8_MMA(0, 1, At, B1); PG8_BAR; PG8_SCHED;
            PG8_LDA(At, 0, 1); PG8_STAGE(PG8_SB(0, 0), b2, voffB); PG8_STAGE(PG8_SB(0, 1), b2 + hstep, voffB); PG8_STAGE(PG8_SA(0, 0), a2, voffA);
            PG8_WAIT_V(8); PG8_WAIT_L(0); PG8_BAR; PG8_MMA(1, 0, At, B0); PG8_MMA(1, 1, At, B1); PG8_BAR; PG8_SCHED;
            PG8_LDB(B0, 1, 0); PG8_LDB(B1, 1, 1); PG8_SCHED; PG8_LDA(At, 1, 0); PG8_STAGE(PG8_SA(0, 1), a2 + hstep, voffA);
            PG8_WAIT_V(8); PG8_WAIT_L(0); PG8_BAR; PG8_MMA(0, 0, At, B0); PG8_MMA(0, 1, At, B1); PG8_BAR; PG8_SCHED;
            PG8_LDA(At, 1, 1); PG8_STAGE(PG8_SB(1, 0), b3, voffB); PG8_STAGE(PG8_SB(1, 1), b3 + hstep, voffB); PG8_STAGE(PG8_SA(1, 0), a3, voffA);
            PG8_WAIT_V(8); PG8_WAIT_L(0); PG8_BAR; PG8_MMA(1, 0, At, B0); PG8_MMA(1, 1, At, B1); PG8_BAR; PG8_SCHED;
            } else {
            PG8_LDB(B0, 0, 0); PG8_SCHED; PG8_LDA(At, 0, 0); PG8_STAGE(PG8_SA(1, 1), a1 + hstep, voffA);
            PG8_WAIT_L(8); PG8_BAR; PG8_WAIT_L(0); PG8_MMA(0, 0, At, B0); PG8_BAR; PG8_SCHED;
            PG8_LDB(B1, 0, 1); PG8_STAGE(PG8_SB(0, 0), b2, voffB);
            PG8_BAR; PG8_WAIT_L(0); PG8_MMA(0, 1, At, B1); PG8_BAR;
            PG8_LDA(At, 0, 1); PG8_STAGE(PG8_SA(0, 0), a2, voffA);
            PG8_BAR; PG8_WAIT_L(0); PG8_MMA(1, 0, At, B0); PG8_BAR; PG8_SCHED;
            PG8_STAGE(PG8_SB(0, 1), b2 + hstep, voffB);
            PG8_WAIT_V(6); PG8_BAR; PG8_MMA(1, 1, At, B1); PG8_BAR;
            PG8_LDB(B0, 1, 0); PG8_SCHED; PG8_LDA(At, 1, 0); PG8_STAGE(PG8_SA(0, 1), a2 + hstep, voffA);
            PG8_WAIT_L(8); PG8_BAR; PG8_WAIT_L(0); PG8_MMA(0, 0, At, B0); PG8_BAR; PG8_SCHED;
            PG8_LDB(B1, 1, 1); PG8_STAGE(PG8_SB(1, 0), b3, voffB);
            PG8_BAR; PG8_WAIT_L(0); PG8_MMA(0, 1, At, B1); PG8_BAR;
            PG8_LDA(At, 1, 1); PG8_STAGE(PG8_SA(1, 0), a3, voffA);
            PG8_BAR; PG8_WAIT_L(0); PG8_MMA(1, 0, At, B0); PG8_BAR; PG8_SCHED;
            PG8_STAGE(PG8_SB(1, 1), b3 + hstep, voffB);
            PG8_WAIT_V(6); PG8_BAR; PG8_MMA(1, 1, At, B1); PG8_BAR;
            }
        }
        if constexpr (ALIGN_EPI) { if (wr == 0) PG8_BAR; }
        if constexpr (!Epi::AFTER_DRAIN) { E(acc, cur, wr, wc, fr, fq); S.done(cur); }
        if (!has_next) break;
        if (!Epi::keep_acc(cur)) {
#pragma unroll
        for (int a = 0; a < 2; ++a)
#pragma unroll
            for (int b = 0; b < 2; ++b)
#pragma unroll
                for (int m = 0; m < 4; ++m)
#pragma unroll
                    for (int n = 0; n < 2; ++n) acc[a][b][m][n] = (f32x4){0.f, 0.f, 0.f, 0.f}; }
        cur = nxt; cA = nA; cB = nB; ++ui;
        if constexpr (ALIGN_EPI) { if (wr == 1) PG8_BAR; }
    }
    PG8_WAIT_V(0);
    if constexpr (!ALIGN_EPI) { if (wr == 0) PG8_BAR; }
    PG8_BAR;
    if constexpr (Epi::AFTER_DRAIN) { E.fused(acc, cur, wr, wc, fr, fq, lds, wid, lane); S.done(cur); }
#undef PG8_SA
#undef PG8_SB
#undef PG8_STAGE
#undef PG8_LDA
#undef PG8_LDB
#undef PG8_MMA
#undef PG8_WAIT_V
#undef PG8_WAIT_L
#undef PG8_BAR
#undef PG8_SCHED
}
}
#define GAS __attribute__((address_space(1)))
#define LAS __attribute__((address_space(3)))
typedef unsigned short bf16;
typedef unsigned v4u __attribute__((ext_vector_type(4)));
typedef float f32x4 __attribute__((ext_vector_type(4)));
typedef short bf16x8 __attribute__((ext_vector_type(8)));
typedef GAS unsigned gu32;
typedef GAS unsigned long long gu64;
#define RLX_AGENT __ATOMIC_RELAXED, __HIP_MEMORY_SCOPE_AGENT
#define LDS_WAIT() asm volatile("s_waitcnt lgkmcnt(0)" ::: "memory")
#define VM_WAIT() asm volatile("s_waitcnt vmcnt(0)" ::: "memory")
__device__ __forceinline__ unsigned long long rt() { return __builtin_amdgcn_s_memrealtime(); }
__device__ __forceinline__ unsigned f2bf(float f) { unsigned u = __builtin_bit_cast(unsigned, f); return (u + 0x7fffu + ((u >> 16) & 1u)) >> 16; }
__device__ __forceinline__ unsigned pk2(float lo, float hi) { return f2bf(lo) | (f2bf(hi) << 16); }

#define XB_TMO      128
#define XB_XCNT(j)  (256  + 64 * (j))
#define XB_XSUB(j)  (1280 + 64 * (j))
#define XB_XGEN(j)  (2304 + 64 * (j))
#define XB_TOP      3328
#define XB_TOPGEN   3392
#define XCD_BAR_WORDS 3456
#define XB_SPIN_CAP (1u << 18)

__device__ __forceinline__ unsigned xb_ld(unsigned* p)              { return __hip_atomic_load(p, __ATOMIC_RELAXED, __HIP_MEMORY_SCOPE_AGENT); }
__device__ __forceinline__ unsigned xb_add(unsigned* p, unsigned v) { return __hip_atomic_fetch_add(p, v, __ATOMIC_RELAXED, __HIP_MEMORY_SCOPE_AGENT); }
__device__ __forceinline__ unsigned xb_xcc_id() { return (unsigned)__builtin_amdgcn_s_getreg((3 << 11) | 20) & 0xFu; }
#define XB_SPIN(cond, bar) do { unsigned _sp = 0; while (cond) { __builtin_amdgcn_s_sleep(1); \
    if ((++_sp & 255u) == 0u) { if (xb_ld(&(bar)[XB_TMO])) break; if (_sp > XB_SPIN_CAP) { atomicAdd(&(bar)[XB_TMO], 1u); break; } } } } while (0)

struct XcdBarrier {
    unsigned* bar; unsigned x;
    volatile LAS unsigned* st;
};

__device__ __forceinline__ XcdBarrier xcd_barrier_post(unsigned* bar, volatile LAS unsigned* st) {
    XcdBarrier b; b.bar = bar; b.x = xb_xcc_id(); b.st = st;
    if (threadIdx.x == 0) (void)xb_add(&bar[XB_XCNT(b.x)], 1u);
    return b;
}
__device__ __forceinline__ void xcd_barrier_complete(unsigned* bar, unsigned x, unsigned& nloc, unsigned& nx) {
    const unsigned G = gridDim.x * gridDim.y * gridDim.z;
    unsigned sum, cnt, mine, sp = 0u;
    for (;;) {
        sum = 0u; cnt = 0u; mine = 0u;
#pragma unroll
        for (unsigned j = 0; j < 16; ++j) { const unsigned c = xb_ld(&bar[XB_XCNT(j)]); sum += c; cnt += (c > 0u) ? 1u : 0u; mine = (j == x) ? c : mine; }
        if (sum == G) break;
        __builtin_amdgcn_s_sleep(1);
        if ((++sp & 255u) == 0u) { if (xb_ld(&bar[XB_TMO])) break; if (sp > XB_SPIN_CAP) { atomicAdd(&bar[XB_TMO], 1u); break; } }
    }
    nloc = mine > 0u ? mine : 1u; nx = cnt > 0u ? cnt : 1u;
}

__device__ __forceinline__ void xcd_barrier(const XcdBarrier& b) {
    asm volatile("s_waitcnt vmcnt(0)" ::: "memory");
    __syncthreads();
    if (threadIdx.x == 0) {
        unsigned* bar = b.bar;
        __builtin_amdgcn_s_waitcnt(0);
        unsigned nloc = b.st[0], nx = b.st[1];
        if (nloc == 0u) { xcd_barrier_complete(bar, b.x, nloc, nx); b.st[0] = nloc; b.st[1] = nx; }
        const unsigned old = xb_add(&bar[XB_XSUB(b.x)], 1u);
        const unsigned gen = old / nloc;
        if (old + 1u == (gen + 1u) * nloc) {
            __builtin_amdgcn_fence(__ATOMIC_RELEASE, "agent");
            asm volatile("s_waitcnt vmcnt(0)" ::: "memory");
            const unsigned og = xb_add(&bar[XB_TOP], 1u);
            const unsigned tg = og / nx;
            if (og + 1u == (tg + 1u) * nx) xb_add(&bar[XB_TOPGEN], 1u);
            else XB_SPIN(xb_ld(&bar[XB_TOPGEN]) == tg, bar);
            __builtin_amdgcn_fence(__ATOMIC_ACQUIRE, "agent");
            xb_add(&bar[XB_XGEN(b.x)], 1u);
            asm volatile("s_waitcnt vmcnt(0)" ::: "memory");
        } else {
            XB_SPIN(xb_ld(&bar[XB_XGEN(b.x)]) == gen, bar);
            __builtin_amdgcn_fence(__ATOMIC_ACQUIRE, "agent");
            asm volatile("s_waitcnt vmcnt(0)" ::: "memory");
        }
    }
    __syncthreads();
}


constexpr int NWAVES = 8, NTHREADS = 512;
constexpr int M = 16384, D = 1024, NIN = 8192, DFF = 2816, NH = 8, HD = 128, NBLK = 64, BLK = 256;
constexpr float EPS = 1e-6f;
constexpr float C2 = 0.08838834764831845f * 1.4426950408889634f;
constexpr size_t MiB = 1u << 20;
constexpr size_t WS_CTL = 0, CTL_ZERO_BYTES = 256 * 1024;
constexpr int CW_BAR = 4096, CW_GCNT = 8192, CW_ROWSS = 16384;
constexpr size_t WS_KBAR = 1 * MiB, WS_RSTDX = 1 * MiB + 512 * 1024, WS_LPART = 2 * MiB;
constexpr size_t WS_WOA = 4 * MiB, WS_WOB = 6 * MiB, WS_WO = 8 * MiB;
constexpr size_t WS_Q = 10 * MiB, WS_K = 42 * MiB, WS_VT = 74 * MiB, WS_CA = 106 * MiB, WS_LIST = 138 * MiB, WS_WIN = 147 * MiB, WS_XB = 163 * MiB, WS_UU = 195 * MiB;
constexpr size_t WS_OPART = 195 * MiB;
constexpr size_t WS_WUP = 243 * MiB, WS_WDN = 138 * MiB, WS_MG = 42 * MiB, WS_HB = 198 * MiB;
constexpr size_t WS_ACT = 10 * MiB;
constexpr size_t WS_END = 256 * MiB;
constexpr int LDS_BYTES = 163840, MISC_OFF = 131072 + 320, HALO_OFF = 131072 + 1024, SCAN_OFF = 131072 + 1024;
__device__ __forceinline__ int list_off(int n) { return 256 * (63 * n - (n * (n - 1)) / 2); }
constexpr int LIST_PER_HEAD = 256 * 2016;

__device__ __forceinline__ float wave_sum(float v) {
#pragma unroll
    for (int o = 1; o < 64; o <<= 1) v += __shfl_xor(v, o);
    return v;
}
__device__ __forceinline__ void transpose_item(const float* W, int N, bf16* WT, int K, int k0, int col0, int row0, const float* ks, LAS float* scr, int lane) {
    float wv[32];
#pragma unroll
    for (int i = 0; i < 32; ++i) wv[i] = __builtin_nontemporal_load(W + (size_t)(k0 + 2 * i + (lane >> 5)) * N + col0 + (lane & 31));
#pragma unroll
    for (int i = 0; i < 32; ++i) { const int kk = 2 * i + (lane >> 5); const float s = ks ? ks[k0 + kk] : 1.0f; scr[kk * 33 + (lane & 31)] = s * wv[i]; }
    LDS_WAIT(); asm volatile("" ::: "memory");
    const int c = lane & 7;
#pragma unroll
    for (int j = 0; j < 4; ++j) { const int n = (lane >> 3) + 8 * j; const LAS float* s = scr + (8 * c) * 33 + n;
        v4u o; o.x = pk2(s[0 * 33], s[1 * 33]); o.y = pk2(s[2 * 33], s[3 * 33]); o.z = pk2(s[4 * 33], s[5 * 33]); o.w = pk2(s[6 * 33], s[7 * 33]);
        *(GAS v4u*)(WT + (size_t)(row0 + n) * K + k0 + 8 * c) = o; }
    LDS_WAIT(); asm volatile("" ::: "memory");
}
__device__ __forceinline__ int map_col(int mode, int R) {
    if (mode == 1) { if (R >= 1024 && R < 3072) { const int q = R - 1024; return 1024 + ((q >> 7) & 1) * 1024 + (q >> 8) * 128 + (q & 127); }
                     if (R >= 6144) { const int q = R - 6144; return 6144 + ((q >> 7) & 1) * 1024 + (q >> 8) * 128 + (q & 127); } return R; }
    if (mode == 2) return ((R >> 7) & 1) * DFF + (R >> 8) * 128 + (R & 127);
    return R;
}
__device__ __forceinline__ void convert_weight(const float* W, int K, int N, bf16* WT, const float* ks, int mode, LAS float* scr, int gw, int NGW, int lane) {
    const int nblk = N / 32, nitems = (K / 64) * nblk;
    for (int it = gw; it < nitems; it += NGW) { const int kb = it / nblk, nb = it % nblk; transpose_item(W, N, WT, K, 64 * kb, map_col(mode, 32 * nb), 32 * nb, ks, scr, lane); }
}

__device__ __forceinline__ void phase0(const float* x, const float* norm_mix, const float* w_in, const float* w_oa, const float* w_ob, const float* w_o, const float* w_up, const float* norm_ffn, unsigned char* ws, LAS unsigned char* lds, int vcu, int G, int wave, int lane) {
    LAS float* scr = (LAS float*)(lds + wave * 16384);
    const int gw = vcu * NWAVES + wave, NGW = G * NWAVES;
    convert_weight(w_in, D, NIN, (bf16*)(ws + WS_WIN), norm_mix, 1, scr, gw, NGW, lane);
    convert_weight(w_oa, D, D, (bf16*)(ws + WS_WOA), nullptr, 0, scr, gw, NGW, lane);
    convert_weight(w_ob, D, D, (bf16*)(ws + WS_WOB), nullptr, 0, scr, gw, NGW, lane);
    convert_weight(w_o, D, D, (bf16*)(ws + WS_WO), nullptr, 0, scr, gw, NGW, lane);
    convert_weight(w_up, D, 2 * DFF, (bf16*)(ws + WS_WUP), norm_ffn, 2, scr, gw, NGW, lane);
    bf16* XB = (bf16*)(ws + WS_XB); float* rstdx = (float*)(ws + WS_RSTDX);
    for (int m = gw; m < M; m += NGW) {
        const GAS f32x4* xr = (const GAS f32x4*)(x + (size_t)m * D) + lane; f32x4 v[4]; float s = 0.f;
#pragma unroll
        for (int j = 0; j < 4; ++j) { v[j] = __builtin_nontemporal_load(xr + 64 * j); s += (v[j].x * v[j].x + v[j].y * v[j].y) + (v[j].z * v[j].z + v[j].w * v[j].w); }
        s = wave_sum(s); if (lane == 0) rstdx[m] = rsqrtf(s * (1.f / D) + EPS);
        GAS unsigned long long* o8 = (GAS unsigned long long*)(XB + (size_t)m * D) + lane;
#pragma unroll
        for (int j = 0; j < 4; ++j) o8[64 * j] = (unsigned long long)pk2(v[j].x, v[j].y) | ((unsigned long long)pk2(v[j].z, v[j].w) << 32);
    }
}
__device__ __forceinline__ void phase2(const float* conv_a_w, unsigned char* ws, int G, int tid, bf16* __restrict__ CAout) {
    const bf16* __restrict__ BG = (const bf16*)(ws + WS_CA); const bf16* __restrict__ UU = (const bf16*)(ws + WS_UU);
    for (int item = blockIdx.x * NTHREADS + tid; item < 128 * (M / 16); item += G * NTHREADS) {
        const int cc = (item & 127) * 8, t0 = (item >> 7) * 16;
        float w0[8], w1[8], w2[8], um2[8], um1[8];
#pragma unroll
        for (int j = 0; j < 2; ++j) { const f32x4 a = *(const GAS f32x4*)(conv_a_w + cc + 4 * j), b = *(const GAS f32x4*)(conv_a_w + 1024 + cc + 4 * j), c = *(const GAS f32x4*)(conv_a_w + 2048 + cc + 4 * j);
#pragma unroll
            for (int e = 0; e < 4; ++e) { w0[4 * j + e] = a[e]; w1[4 * j + e] = b[e]; w2[4 * j + e] = c[e]; } }
        { v4u a = (v4u){0u, 0u, 0u, 0u}, b = a; if (t0 >= 2) { a = *(const GAS v4u*)(UU + (size_t)(t0 - 2) * 1024 + cc); b = *(const GAS v4u*)(UU + (size_t)(t0 - 1) * 1024 + cc); }
          const unsigned aw[4] = {a.x, a.y, a.z, a.w}, bw[4] = {b.x, b.y, b.z, b.w};
#pragma unroll
          for (int j = 0; j < 4; ++j) { um2[2 * j] = pg8::bf_lo(aw[j]); um2[2 * j + 1] = pg8::bf_hi(aw[j]); um1[2 * j] = pg8::bf_lo(bw[j]); um1[2 * j + 1] = pg8::bf_hi(bw[j]); } }
#pragma unroll 4
        for (int i = 0; i < 16; ++i) { const size_t o = (size_t)(t0 + i) * 1024 + cc;
            const v4u u = *(const GAS v4u*)(UU + o), b = *(const GAS v4u*)(BG + o); const unsigned uw[4] = {u.x, u.y, u.z, u.w}, bw[4] = {b.x, b.y, b.z, b.w};
            float r[8];
#pragma unroll
            for (int j = 0; j < 4; ++j) { const float u0 = pg8::bf_lo(uw[j]), u1 = pg8::bf_hi(uw[j]);
                r[2 * j] = pg8::bf_lo(bw[j]) * (w0[2 * j] * um2[2 * j] + w1[2 * j] * um1[2 * j] + w2[2 * j] * u0);
                r[2 * j + 1] = pg8::bf_hi(bw[j]) * (w0[2 * j + 1] * um2[2 * j + 1] + w1[2 * j + 1] * um1[2 * j + 1] + w2[2 * j + 1] * u1);
                um2[2 * j] = um1[2 * j]; um2[2 * j + 1] = um1[2 * j + 1]; um1[2 * j] = u0; um1[2 * j + 1] = u1; }
            v4u o4; o4.x = pk2(r[0], r[1]); o4.y = pk2(r[2], r[3]); o4.z = pk2(r[4], r[5]); o4.w = pk2(r[6], r[7]);
            *(GAS v4u*)(CAout + o) = o4; }
    }
}
__device__ __forceinline__ bool top_better(float v, int n, float cv, int cn) { return v > cv || (v == cv && n < cn); }
__device__ __forceinline__ void top3_insert(float v, int n, float (&tv)[3], int (&ti)[3]) {
    if (top_better(v, n, tv[0], ti[0])) { tv[2] = tv[1]; ti[2] = ti[1]; tv[1] = tv[0]; ti[1] = ti[0]; tv[0] = v; ti[0] = n; }
    else if (top_better(v, n, tv[1], ti[1])) { tv[2] = tv[1]; ti[2] = ti[1]; tv[1] = v; ti[1] = n; }
    else if (top_better(v, n, tv[2], ti[2])) { tv[2] = v; ti[2] = n; }
}
__device__ __forceinline__ void phase2d(unsigned char* ws, LAS unsigned char* lds, int G, int tid, int wave, int lane, unsigned* gcnt, unsigned short* glist) {
    LAS unsigned* lcnt = (LAS unsigned*)(lds + 32768); LAS unsigned* lbase = lcnt + 64; LAS unsigned short* llist = (LAS unsigned short*)lds;
    const bf16* Q = (const bf16*)(ws + WS_Q); const float* kbar = (const float*)(ws + WS_KBAR);
    const int fr = lane & 15, fq = lane >> 4;
    for (int unit = blockIdx.x; unit < NH * 63; unit += G) {
        const int h = unit / 63, c = 1 + unit % 63;
        if (tid < 64) lcnt[tid] = 0u;
        __syncthreads();
        bf16x8 qf[2][4];
#pragma unroll
        for (int g = 0; g < 2; ++g)
#pragma unroll
            for (int ks = 0; ks < 4; ++ks) qf[g][ks] = *(const GAS bf16x8*)(Q + (size_t)(c * BLK + wave * 32 + g * 16 + fr) * 1024 + h * HD + ks * 32 + fq * 8);
        float tv[2][3]; int ti[2][3];
#pragma unroll
        for (int g = 0; g < 2; ++g)
#pragma unroll
            for (int j = 0; j < 3; ++j) { tv[g][j] = -__builtin_inff(); ti[g][j] = 1 << 20; }
        const int ntile = (c + 15) >> 4;
        for (int tile = 0; tile < ntile; ++tile) {
            f32x4 s0 = (f32x4){0.f, 0.f, 0.f, 0.f}, s1 = s0;
#pragma unroll
            for (int ks = 0; ks < 4; ++ks) {
                const float* kp = kbar + ((size_t)(h * NBLK + tile * 16 + fr) * HD + ks * 32 + fq * 8);
                const f32x4 a = *(const GAS f32x4*)kp, b = *(const GAS f32x4*)(kp + 4);
                const v4u hw = pg8::pack8(a, b);
                f32x4 ra, rb; ra[0] = a[0] - pg8::bf_lo(hw.x); ra[1] = a[1] - pg8::bf_hi(hw.x); ra[2] = a[2] - pg8::bf_lo(hw.y); ra[3] = a[3] - pg8::bf_hi(hw.y);
                rb[0] = b[0] - pg8::bf_lo(hw.z); rb[1] = b[1] - pg8::bf_hi(hw.z); rb[2] = b[2] - pg8::bf_lo(hw.w); rb[3] = b[3] - pg8::bf_hi(hw.w);
                const v4u lw = pg8::pack8(ra, rb);
                const bf16x8 hi = __builtin_bit_cast(bf16x8, hw), lo = __builtin_bit_cast(bf16x8, lw);
                s0 = __builtin_amdgcn_mfma_f32_16x16x32_bf16(hi, qf[0][ks], s0, 0, 0, 0); s0 = __builtin_amdgcn_mfma_f32_16x16x32_bf16(lo, qf[0][ks], s0, 0, 0, 0);
                s1 = __builtin_amdgcn_mfma_f32_16x16x32_bf16(hi, qf[1][ks], s1, 0, 0, 0); s1 = __builtin_amdgcn_mfma_f32_16x16x32_bf16(lo, qf[1][ks], s1, 0, 0, 0);
            }
#pragma unroll
            for (int i = 0; i < 4; ++i) { const int n = tile * 16 + 4 * fq + i;
                top3_insert(n < c ? s0[i] : -__builtin_inff(), n, tv[0], ti[0]); top3_insert(n < c ? s1[i] : -__builtin_inff(), n, tv[1], ti[1]); }
        }
#pragma unroll
        for (int off = 16; off <= 32; off <<= 1)
#pragma unroll
            for (int g = 0; g < 2; ++g) { float pv[3]; int pi[3];
#pragma unroll
                for (int j = 0; j < 3; ++j) { pv[j] = __shfl_xor(tv[g][j], off); pi[j] = __shfl_xor(ti[g][j], off); }
#pragma unroll
                for (int j = 0; j < 3; ++j) top3_insert(pv[j], pi[j], tv[g], ti[g]); }
        const int nsel = c < 3 ? c : 3;
        if (fq == 0) {
#pragma unroll
            for (int g = 0; g < 2; ++g) { const int tl = wave * 32 + g * 16 + fr;
#pragma unroll
                for (int j = 0; j < 3; ++j) if (j < nsel) { const int n = ti[g][j]; const unsigned pp = __hip_atomic_fetch_add(&lcnt[n], 1u, __ATOMIC_RELAXED, __HIP_MEMORY_SCOPE_WORKGROUP); llist[n * 256 + pp] = (unsigned short)((tl << 2) | j); } }
        }
        __syncthreads();
        if (tid < c) { const unsigned k = lcnt[tid]; lbase[tid] = k ? atomicAdd(gcnt + h * NBLK + tid, k) : 0u; }
        __syncthreads();
        for (int n = wave; n < c; n += NWAVES) { const unsigned k = lcnt[n], base = lbase[n];
            unsigned short* dst = glist + (size_t)h * LIST_PER_HEAD + list_off(n) + base;
            for (unsigned i = lane; i < k; i += 64) { const unsigned e = llist[n * 256 + i]; dst[i] = (unsigned short)((((unsigned)c * BLK + (e >> 2)) << 2) | (e & 3u)); } }
        __syncthreads();
    }
}
__device__ __forceinline__ v4u fp8x8_to_bf16x8(unsigned w0, unsigned w1) {
    const pg8::f32x2_t_ a = __builtin_amdgcn_cvt_pk_f32_fp8((int)w0, false), b = __builtin_amdgcn_cvt_pk_f32_fp8((int)w0, true), c = __builtin_amdgcn_cvt_pk_f32_fp8((int)w1, false), d = __builtin_amdgcn_cvt_pk_f32_fp8((int)w1, true);
    v4u o; o.x = pg8::cvt_pk_bf16(a[0], a[1]); o.y = pg8::cvt_pk_bf16(b[0], b[1]); o.z = pg8::cvt_pk_bf16(c[0], c[1]); o.w = pg8::cvt_pk_bf16(d[0], d[1]); return o;
}
__device__ __forceinline__ void stage_kv(const bf16* Kg, const bf16* Vt, int h, int n, LAS unsigned char* lds, int tid) {
    const unsigned char* Kb = (const unsigned char*)Kg;
    v4u kw[4], vw[8];
#pragma unroll
    for (int i = 0; i < 4; ++i) { const int row = (tid >> 3) + 64 * i, c16 = tid & 7; kw[i] = *(const GAS v4u*)(Kb + (size_t)(n * BLK + row) * 1024 + h * HD + c16 * 16); }
#pragma unroll
    for (int i = 0; i < 8; ++i) { const int row = (tid >> 5) + 16 * i, ch = tid & 31; vw[i] = *(const GAS v4u*)(Vt + (size_t)(h * HD + row) * M + n * BLK + ch * 8); }
    __syncthreads();
#pragma unroll
    for (int i = 0; i < 4; ++i) { const int row = (tid >> 3) + 64 * i, c16 = tid & 7; const int sw = (((row >> 3) & 3) << 2) | (row & 3);
        *(LAS v4u*)(lds + row * 256 + (((2 * c16) ^ sw) << 4)) = fp8x8_to_bf16x8(kw[i].x, kw[i].y);
        *(LAS v4u*)(lds + row * 256 + (((2 * c16 + 1) ^ sw) << 4)) = fp8x8_to_bf16x8(kw[i].z, kw[i].w); }
#pragma unroll
    for (int i = 0; i < 8; ++i) { const int row = (tid >> 5) + 16 * i, ch = tid & 31;
        *(LAS v4u*)(lds + 65536 + row * 512 + ((ch ^ ((((row >> 4) & 3) << 2) | (row & 3))) << 4)) = vw[i]; }
}
__device__ __forceinline__ void load_q(bf16x8 (&qf)[2][4], const bf16* Q, int h, const int (&tq)[2], int fq) {
#pragma unroll
    for (int g = 0; g < 2; ++g)
#pragma unroll
        for (int ks = 0; ks < 4; ++ks) qf[g][ks] = *(const GAS bf16x8*)(Q + (size_t)tq[g] * 1024 + h * HD + ks * 32 + fq * 8);
}
template <bool CAUSAL, int MODE = 0>
__device__ __forceinline__ void attn_core(const LAS unsigned char* lds, const bf16x8 (&qf)[2][4], int wave, int fr, int fq, float B2, f32x4 (&O)[8][2], float (&l)[2]) {
#pragma unroll
    for (int dt = 0; dt < 8; ++dt) { O[dt][0] = (f32x4){0.f, 0.f, 0.f, 0.f}; O[dt][1] = O[dt][0]; }
    l[0] = 0.f; l[1] = 0.f;
    const int nch = CAUSAL ? wave + 1 : 8;
    const int krow = (fr >> 2) * 8 + (fr & 3);
    bf16x8 kf[4][2];
#pragma unroll
    for (int ks = 0; ks < 4; ++ks)
#pragma unroll
        for (int t = 0; t < 2; ++t) kf[ks][t] = *(const LAS bf16x8*)(lds + (krow + t * 4) * 256 + (((ks * 4 + fq) ^ fr) << 4));
#pragma unroll 2
    for (int c = 0; c < nch; ++c) {
        f32x4 s[2][2];
#pragma unroll
        for (int t = 0; t < 2; ++t) { s[t][0] = (f32x4){-B2, -B2, -B2, -B2}; s[t][1] = s[t][0]; }
        bf16x8 vf[8];
#pragma unroll
        for (int dt = 0; dt < 8; ++dt) vf[dt] = *(const LAS bf16x8*)(lds + 65536 + ((dt >> 2) * 64 + (fr >> 2) * 16 + (dt & 3) * 4 + (fr & 3)) * 512 + (((c * 4 + fq) ^ fr) << 4));
        __builtin_amdgcn_s_setprio(1);
#pragma unroll
        for (int ks = 0; ks < 4; ++ks)
#pragma unroll
            for (int t = 0; t < 2; ++t) {
                if (MODE != 2 || ks == 0) {
                s[t][0] = __builtin_amdgcn_mfma_f32_16x16x32_bf16(kf[ks][t], qf[0][ks], s[t][0], 0, 0, 0);
                s[t][1] = __builtin_amdgcn_mfma_f32_16x16x32_bf16(kf[ks][t], qf[1][ks], s[t][1], 0, 0, 0); }
            }
        __builtin_amdgcn_s_setprio(0);
        __builtin_amdgcn_sched_barrier(0);
        { const int cn = (c + 1 < nch) ? c + 1 : c;
#pragma unroll
          for (int ks = 0; ks < 4; ++ks)
#pragma unroll
              for (int t = 0; t < 2; ++t) kf[ks][t] = *(const LAS bf16x8*)(lds + (cn * 32 + krow + t * 4) * 256 + (((ks * 4 + fq) ^ fr) << 4)); }
        bf16x8 pf[2];
#pragma unroll
        for (int g = 0; g < 2; ++g) {
            float p[8];
#pragma unroll
            for (int t = 0; t < 2; ++t)
#pragma unroll
                for (int i = 0; i < 4; ++i) { float e = MODE == 1 ? s[t][g][i] : __builtin_amdgcn_exp2f(s[t][g][i]);
                    if (CAUSAL && c == wave) { const int kl = c * 32 + fq * 8 + t * 4 + i, ql = wave * 32 + g * 16 + fr; if (kl > ql) e = 0.f; }
                    p[t * 4 + i] = e; }
            l[g] += ((p[0] + p[1]) + (p[2] + p[3])) + ((p[4] + p[5]) + (p[6] + p[7]));
            v4u w; w.x = pg8::cvt_pk_bf16(p[0], p[1]); w.y = pg8::cvt_pk_bf16(p[2], p[3]); w.z = pg8::cvt_pk_bf16(p[4], p[5]); w.w = pg8::cvt_pk_bf16(p[6], p[7]);
            pf[g] = __builtin_bit_cast(bf16x8, w);
        }
        __builtin_amdgcn_s_setprio(1);
#pragma unroll
        for (int dt = 0; dt < 8; ++dt) {
            if (MODE != 3 || dt == 0) {
            O[dt][0] = __builtin_amdgcn_mfma_f32_16x16x32_bf16(vf[dt], pf[0], O[dt][0], 0, 0, 0);
            O[dt][1] = __builtin_amdgcn_mfma_f32_16x16x32_bf16(vf[dt], pf[1], O[dt][1], 0, 0, 0); }
        }
        __builtin_amdgcn_s_setprio(0);
    }
    l[0] += __shfl_xor(l[0], 16); l[0] += __shfl_xor(l[0], 32); l[1] += __shfl_xor(l[1], 16); l[1] += __shfl_xor(l[1], 32);
}
__device__ __forceinline__ float score_bound(const float* q_norm, const float* k_norm, int lane) {
    float a = fmaxf(fabsf(q_norm[lane]), fabsf(q_norm[lane + 64])), b = fmaxf(fabsf(k_norm[lane]), fabsf(k_norm[lane + 64]));
#pragma unroll
    for (int o = 1; o < 64; o <<= 1) { a = fmaxf(a, __shfl_xor(a, o)); b = fmaxf(b, __shfl_xor(b, o)); }
    return 128.0f * a * b * C2 * 1.001f + 0.01f;
}
template <int MODE>
__device__ __forceinline__ void phase3a(const float* q_norm, const float* k_norm, unsigned char* ws, LAS unsigned char* lds, int G, int tid, int wave, int lane) {
    const int fr = lane & 15, fq = lane >> 4;
    LAS int* pre = (LAS int*)(lds + SCAN_OFF);
    LAS int* cntl = (LAS int*)(lds + SCAN_OFF + 2080);
    const unsigned* gcnt = (const unsigned*)(ws + WS_CTL) + CW_GCNT; const unsigned short* glist = (const unsigned short*)(ws + WS_LIST);
    const bf16* Q = (const bf16*)(ws + WS_Q); const bf16* Kg = (const bf16*)(ws + WS_K); const bf16* Vt = (const bf16*)(ws + WS_VT);
    unsigned char* OP = ws + WS_OPART; float* LP = (float*)(ws + WS_LPART);
    const float B2 = score_bound(q_norm, k_norm, lane);
    { const int cnt = (int)__hip_atomic_load(gcnt + tid, __ATOMIC_RELAXED, __HIP_MEMORY_SCOPE_AGENT); pre[tid + 1] = (cnt + 255) >> 8; cntl[tid] = cnt; if (tid == 0) pre[0] = 0; }
    __syncthreads();
    for (int o = 1; o < 512; o <<= 1) { const int v = pre[tid + 1] + ((tid + 1 - o) >= 1 ? pre[tid + 1 - o] : 0); __syncthreads(); pre[tid + 1] = v; __syncthreads(); }
    const int T = pre[512];
    const int i_lo = (int)(((long)blockIdx.x * T) / G), i_hi = (int)(((long)(blockIdx.x + 1) * T) / G);
    int staged = -1;
#define P3A_DECODE(IT, HN, TILE) do { int lo_ = 0, hi_ = 511; while (lo_ < hi_) { const int mid_ = (lo_ + hi_ + 1) >> 1; if (pre[mid_] <= (IT)) lo_ = mid_; else hi_ = mid_ - 1; } HN = lo_; TILE = (IT) - pre[lo_]; } while (0)
    unsigned en[2] = {0u, 0u}; bool okn[2] = {false, false};
    bf16x8 qf[2][4]; int hnn = 0;
    if (i_lo < i_hi) { int hn, tile; P3A_DECODE(i_lo, hn, tile); const int cnt = cntl[hn]; const unsigned short* lst = glist + (size_t)(hn >> 6) * LIST_PER_HEAD + list_off(hn & 63) + tile * 256;
#pragma unroll
        for (int g = 0; g < 2; ++g) { const int qi = wave * 32 + g * 16 + fr; okn[g] = tile * 256 + qi < cnt; en[g] = okn[g] ? lst[qi] : 0u; }
        { const int tq0[2] = {(int)(en[0] >> 2), (int)(en[1] >> 2)}; load_q(qf, Q, hn >> 6, tq0, fq); } }
    for (int it = i_lo; it < i_hi; ++it) {
        int hn, tile; P3A_DECODE(it, hn, tile); const int h = hn >> 6, n = hn & 63;
        int tq[2], sj[2]; bool ok[2];
#pragma unroll
        for (int g = 0; g < 2; ++g) { ok[g] = okn[g]; tq[g] = (int)(en[g] >> 2); sj[g] = (int)(en[g] & 3u); }
        if (it + 1 < i_hi) { int hn2, tile2; P3A_DECODE(it + 1, hn2, tile2); hnn = hn2; const int cnt2 = cntl[hn2]; const unsigned short* lst2 = glist + (size_t)(hn2 >> 6) * LIST_PER_HEAD + list_off(hn2 & 63) + tile2 * 256;
#pragma unroll
            for (int g = 0; g < 2; ++g) { const int qi = wave * 32 + g * 16 + fr; okn[g] = tile2 * 256 + qi < cnt2; en[g] = okn[g] ? lst2[qi] : 0u; } }
        if (hn != staged) { stage_kv(Kg, Vt, h, n, lds, tid); LDS_WAIT(); __syncthreads(); staged = hn; }
        f32x4 O[8][2]; float l[2];
        attn_core<false, MODE>(lds, qf, wave, fr, fq, B2, O, l);
        if (it + 1 < i_hi) { const int tqn[2] = {(int)(en[0] >> 2), (int)(en[1] >> 2)}; load_q(qf, Q, hnn >> 6, tqn, fq); }
#pragma unroll
        for (int g = 0; g < 2; ++g) if (ok[g]) {
            unsigned char* op = OP + ((size_t)sj[g] * M + tq[g]) * 1024 + h * HD + 16 * fq;
            const float sc = 16.0f / l[g];
#pragma unroll
            for (int j = 0; j < 2; ++j) { v4u w;
                { int t = 0; t = __builtin_amdgcn_cvt_pk_fp8_f32(O[4 * j][g][0] * sc, O[4 * j][g][1] * sc, t, false); t = __builtin_amdgcn_cvt_pk_fp8_f32(O[4 * j][g][2] * sc, O[4 * j][g][3] * sc, t, true); w.x = (unsigned)t; }
                { int t = 0; t = __builtin_amdgcn_cvt_pk_fp8_f32(O[4 * j + 1][g][0] * sc, O[4 * j + 1][g][1] * sc, t, false); t = __builtin_amdgcn_cvt_pk_fp8_f32(O[4 * j + 1][g][2] * sc, O[4 * j + 1][g][3] * sc, t, true); w.y = (unsigned)t; }
                { int t = 0; t = __builtin_amdgcn_cvt_pk_fp8_f32(O[4 * j + 2][g][0] * sc, O[4 * j + 2][g][1] * sc, t, false); t = __builtin_amdgcn_cvt_pk_fp8_f32(O[4 * j + 2][g][2] * sc, O[4 * j + 2][g][3] * sc, t, true); w.z = (unsigned)t; }
                { int t = 0; t = __builtin_amdgcn_cvt_pk_fp8_f32(O[4 * j + 3][g][0] * sc, O[4 * j + 3][g][1] * sc, t, false); t = __builtin_amdgcn_cvt_pk_fp8_f32(O[4 * j + 3][g][2] * sc, O[4 * j + 3][g][3] * sc, t, true); w.w = (unsigned)t; }
                *(GAS v4u*)(op + j * 64) = w; }
            if (fq == 0) LP[((size_t)sj[g] * M + tq[g]) * NH + h] = l[g];
        }
    }
#undef P3A_DECODE
    __syncthreads();
}
__device__ __forceinline__ void phase3b(const float* q_norm, const float* k_norm, unsigned char* ws, LAS unsigned char* lds, int G, int tid, int wave, int lane, bf16* Oout) {
    const int fr = lane & 15, fq = lane >> 4;
    bf16* Q = (bf16*)(ws + WS_Q); const bf16* Kg = (const bf16*)(ws + WS_K); const bf16* Vt = (const bf16*)(ws + WS_VT);
    const unsigned char* OP = ws + WS_OPART; const float* LP = (const float*)(ws + WS_LPART);
    const float B2 = score_bound(q_norm, k_norm, lane);
    bf16x8 qf[2][4];
    if ((int)blockIdx.x < NH * NBLK) { const int u0 = blockIdx.x; const int tq0[2] = {(u0 & 63) * BLK + wave * 32 + fr, (u0 & 63) * BLK + wave * 32 + 16 + fr}; load_q(qf, Q, u0 >> 6, tq0, fq); }
    for (int unit = blockIdx.x; unit < NH * NBLK; unit += G) {
        const int h = unit >> 6, c = unit & 63;
        stage_kv(Kg, Vt, h, c, lds, tid); LDS_WAIT(); __syncthreads();
        int tq[2];
#pragma unroll
        for (int g = 0; g < 2; ++g) tq[g] = c * BLK + wave * 32 + g * 16 + fr;
        f32x4 O[8][2]; float l[2];
        attn_core<true>(lds, qf, wave, fr, fq, B2, O, l);
        if (unit + G < NH * NBLK) { const int u1 = unit + G; const int tqn[2] = {(u1 & 63) * BLK + wave * 32 + fr, (u1 & 63) * BLK + wave * 32 + 16 + fr}; load_q(qf, Q, u1 >> 6, tqn, fq); }
        const int nsel = c < 3 ? c : 3;
#pragma unroll
        for (int g = 0; g < 2; ++g) {
            float lp[3];
#pragma unroll
            for (int j = 0; j < 3; ++j) lp[j] = LP[((size_t)j * M + tq[g]) * NH + h];
            v4u w[3][2];
#pragma unroll
            for (int j = 0; j < 3; ++j)
#pragma unroll
                for (int k = 0; k < 2; ++k) w[j][k] = *(const GAS v4u*)(OP + ((size_t)j * M + tq[g]) * 1024 + h * HD + k * 64 + 16 * fq);
            float lt = l[g]; float ls[3];
#pragma unroll
            for (int j = 0; j < 3; ++j) { ls[j] = j < nsel ? lp[j] * (1.0f / 16.0f) : 0.f; lt += j < nsel ? lp[j] : 0.f; }
            const float inv = 1.0f / lt;
#pragma unroll
            for (int k = 0; k < 2; ++k) {
                f32x4 o[4];
#pragma unroll
                for (int q = 0; q < 4; ++q) o[q] = O[4 * k + q][g];
#pragma unroll
                for (int j = 0; j < 3; ++j) if (j < nsel) { const unsigned xw[4] = {w[j][k].x, w[j][k].y, w[j][k].z, w[j][k].w};
#pragma unroll
                    for (int q = 0; q < 4; ++q) { const pg8::f32x2_t_ lo = __builtin_amdgcn_cvt_pk_f32_fp8((int)xw[q], false), hi = __builtin_amdgcn_cvt_pk_f32_fp8((int)xw[q], true);
                        o[q][0] += lo[0] * ls[j]; o[q][1] += lo[1] * ls[j]; o[q][2] += hi[0] * ls[j]; o[q][3] += hi[1] * ls[j]; } }
                bf16* dst = Oout + (size_t)tq[g] * 1024 + h * HD + k * 64 + 16 * fq;
                *(GAS v4u*)dst = pg8::pack8(o[0] * inv, o[1] * inv); *(GAS v4u*)(dst + 8) = pg8::pack8(o[2] * inv, o[3] * inv); }
        }
    }
    __syncthreads();
}

#ifndef MK_PER_PHASE
#define MK_PER_PHASE 0
#endif
#ifndef MK_DUP
#define MK_DUP -1
#endif
constexpr int N_PHASES = 9;
struct Args { const float* in[14]; float* out; unsigned char* ws; int ph_lo, ph_hi; };
__global__ void __launch_bounds__(NTHREADS, 2) hybrid_fwd(Args args) {
    extern __shared__ __attribute__((aligned(16))) unsigned char lds_raw[];
    LAS unsigned char* lds = (LAS unsigned char*)lds_raw;
    volatile LAS unsigned* MISC = (volatile LAS unsigned*)(lds + MISC_OFF);
    const int tid = threadIdx.x, lane = tid & 63, wave = __builtin_amdgcn_readfirstlane(tid >> 6);
    const int G = gridDim.x; const int vcu = (G % 8 == 0) ? ((int)blockIdx.x % 8) * (G / 8) + (int)blockIdx.x / 8 : (int)blockIdx.x;
    unsigned char* ws = args.ws;
    gu32* ctl = (gu32*)(ws + WS_CTL);
    if (tid < 32) MISC[tid] = 0u;
    __syncthreads();
    const int lo = args.ph_lo, hi = args.ph_hi;
    XcdBarrier bar; bar.bar = (unsigned*)ctl + CW_BAR; bar.x = 0; bar.st = nullptr;
    if (hi - lo > 1) bar = xcd_barrier_post((unsigned*)ctl + CW_BAR, MISC + 8);
#ifndef PHASE_MASK
#define PHASE_MASK 0x1ff
#endif
#define IN(k) (((PHASE_MASK >> (k)) & 1) && lo <= (k) && (k) < hi)
#define SEAM(k) do { if (IN(k) && IN((k) + 1)) xcd_barrier(bar); } while (0)
    const float* x = args.in[0]; const float* norm_mix = args.in[1]; const float* w_in = args.in[2]; const float* conv_a_w = args.in[3]; const float* q_norm = args.in[4]; const float* k_norm = args.in[5];
    const float* w_oa = args.in[6]; const float* w_ob = args.in[7]; const float* w_o = args.in[8]; const float* norm_ffn = args.in[9]; const float* w_up = args.in[10]; const float* ffn_conv_w = args.in[11];
    const float* ffn_conv_b = args.in[12]; const float* w_down = args.in[13];
    float* out = args.out;
    float* rowss = (float*)((unsigned*)ctl + CW_ROWSS);
    const size_t TSTEP = (size_t)256 * 1024 * 2;

    if (IN(0)) { phase0(x, norm_mix, w_in, w_oa, w_ob, w_o, w_up, norm_ffn, ws, lds, vcu, G, wave, lane); __syncthreads(); }
    SEAM(0);
    if (IN(1)) {
        pg8::Gemm g{(const bf16*)(ws + WS_XB), (const bf16*)(ws + WS_XB), (const bf16*)(ws + WS_WIN), (const bf16*)(ws + WS_WIN), D, TSTEP};
        pg8::StaticOrder S; S.init(M / 256, NIN / 256, G, (int)blockIdx.x);
        pg8::Epi1 E{(bf16*)(ws + WS_CA), (bf16*)(ws + WS_UU), (bf16*)(ws + WS_Q), (bf16*)(ws + WS_K), (bf16*)(ws + WS_VT), (bf16*)out, (const float*)(ws + WS_RSTDX), q_norm, k_norm, (float*)(ws + WS_KBAR), (PG8_LAS float*)(lds + HALO_OFF)};
        pg8::gemm_phase<pg8::Epi1, pg8::StaticOrder, true, true>(lds, g, S, E);
    }
    SEAM(1);
    if (IN(2)) { phase2d(ws, lds, G, tid, wave, lane, (unsigned*)(ws + WS_CTL) + CW_GCNT, (unsigned short*)(ws + WS_LIST));
        phase2(conv_a_w, ws, G, tid, (bf16*)(ws + WS_CA)); __syncthreads(); }
#if MK_DUP == 21
    if (IN(2)) { phase2d(ws, lds, G, tid, wave, lane, (unsigned*)(ws + WS_CTL) + CW_GCNT + 512, (unsigned short*)(ws + WS_WIN)); }
#endif
#if MK_DUP == 22
    if (IN(2)) { phase2(conv_a_w, ws, G, tid, (bf16*)(ws + WS_XB)); }
#endif
    SEAM(2);
#if MK_DUP >= 30 && MK_DUP <= 35
    if (IN(3)) phase3a<MK_DUP - 30>(q_norm, k_norm, ws, lds, G, tid, wave, lane);
#endif
    if (IN(3)) phase3a<0>(q_norm, k_norm, ws, lds, G, tid, wave, lane);
    SEAM(3);
    if (IN(4)) { phase3b(q_norm, k_norm, ws, lds, G, tid, wave, lane, (bf16*)(ws + WS_Q));
#if MK_DUP == 4
        phase3b(q_norm, k_norm, ws, lds, G, tid, wave, lane, (bf16*)(ws + WS_OPART));
#endif
        }
    SEAM(4);
    if (IN(5)) {
        { LAS float* scr = (LAS float*)(lds + wave * 16384); const int gw = vcu * NWAVES + wave, NGW = G * NWAVES;
          if (blockIdx.x == 0 && tid < 256) *(GAS v4u*)(ws + WS_HB - 4096 + tid * 16) = (v4u){0u, 0u, 0u, 0u};
          __syncthreads(); }
        pg8::Gemm g{(const bf16*)(ws + WS_CA), (const bf16*)(ws + WS_Q), (const bf16*)(ws + WS_WOA), (const bf16*)(ws + WS_WOB), D, TSTEP};
        pg8::DualOrder S; S.S.init(M / 256, D / 256, G, (int)blockIdx.x);
        pg8::Epi4 E{(bf16*)(ws + WS_MG), (const bf16*)out};
        pg8::gemm_phase<pg8::Epi4, pg8::DualOrder, true, true>(lds, g, S, E);
    }
    SEAM(5);
    if (IN(6)) {
        pg8::Gemm g{(const bf16*)(ws + WS_MG), (const bf16*)(ws + WS_MG), (const bf16*)(ws + WS_WO), (const bf16*)(ws + WS_WO), D, TSTEP};
        pg8::StaticOrder S; S.init(M / 256, D / 256, G, (int)blockIdx.x);
        pg8::Epi5 E{(const bf16*)(ws + WS_XB), out, (bf16*)(ws + WS_HB), rowss};
        pg8::gemm_phase<pg8::Epi5, pg8::StaticOrder, true, true>(lds, g, S, E);
#if MK_DUP == 6
        { pg8::Epi5 E2{(const bf16*)(ws + WS_XB), (float*)(ws + WS_Q), (bf16*)(ws + WS_VT), (float*)(ws + WS_CA)}; pg8::gemm_phase<pg8::Epi5, pg8::StaticOrder, true, true>(lds, g, S, E2); }
#endif
    }
    SEAM(6);
    if (IN(7)) {
        const bf16* hb2 = (const bf16*)(ws + WS_HB) - 2 * 1024;
        pg8::Gemm g{hb2, hb2, (const bf16*)(ws + WS_WUP), (const bf16*)(ws + WS_WUP), D, (size_t)254 * 1024 * 2};
        pg8::StaticOrder S; S.init(65, 22, G, (int)blockIdx.x);
        pg8::Epi6 E{(bf16*)(ws + WS_ACT), rowss, ffn_conv_w, ffn_conv_b, (PG8_LAS float*)(lds + HALO_OFF)};
        pg8::gemm_phase<pg8::Epi6, pg8::StaticOrder, true, true>(lds, g, S, E);
        { const int nwg = 65 * 22, full = nwg % G, nidle = full ? G - full : G, idx = full ? (int)blockIdx.x - full : (int)blockIdx.x;
          if (idx >= 0) convert_weight(w_down, DFF, D, (bf16*)(ws + WS_WDN), nullptr, 0, (LAS float*)(lds + wave * 16384), idx * NWAVES + wave, nidle * NWAVES, lane);
          __syncthreads(); }
    }
    SEAM(7);
    if (IN(8)) {
        pg8::Gemm g{(const bf16*)(ws + WS_ACT), (const bf16*)(ws + WS_ACT), (const bf16*)(ws + WS_WDN), (const bf16*)(ws + WS_WDN), DFF, (size_t)256 * DFF * 2};
        pg8::StaticOrder S; S.init(M / 256, D / 256, G, (int)blockIdx.x);
        pg8::Epi7 E{out, (const bf16*)(ws + WS_HB)};
        pg8::gemm_phase<pg8::Epi7, pg8::StaticOrder, true, true>(lds, g, S, E);
#if MK_DUP == 8
        { pg8::Epi7 E2{(float*)(ws + WS_MG), (const bf16*)(ws + WS_HB)}; pg8::gemm_phase<pg8::Epi7, pg8::StaticOrder, true, true>(lds, g, S, E2); }
#endif
    }
#undef IN
#undef SEAM
}

extern "C" void kernel_launch(void* const* d_in, const int* in_sizes, int n_in, void* d_out, int out_size, void* d_ws, size_t ws_size, hipStream_t stream) {
    static int grid = 0;
    if (grid == 0) {
        if (n_in != 14 || in_sizes[0] != M * D || out_size != M * D || ws_size < WS_END) { fprintf(stderr, "kernel_launch: unexpected shapes (n_in %d, in0 %d, out %d, ws %zu)\n", n_in, n_in > 0 ? in_sizes[0] : -1, out_size, ws_size); grid = -1; return; }
        int dev = 0, cus = 0, per_cu = 0;
        if (hipGetDevice(&dev) != hipSuccess || hipDeviceGetAttribute(&cus, hipDeviceAttributeMultiprocessorCount, dev) != hipSuccess) { grid = -1; return; }
        if (hipFuncSetAttribute((const void*)hybrid_fwd, hipFuncAttributeMaxDynamicSharedMemorySize, LDS_BYTES) != hipSuccess) { fprintf(stderr, "kernel_launch: hipFuncSetAttribute failed\n"); grid = -1; return; }
        if (hipOccupancyMaxActiveBlocksPerMultiprocessor(&per_cu, (const void*)hybrid_fwd, NTHREADS, LDS_BYTES) != hipSuccess || per_cu < 1) { fprintf(stderr, "kernel_launch: occupancy query says %d blocks per CU\n", per_cu); (void)hipGetLastError(); grid = -1; return; }
        grid = cus;
    }
    if (grid < 0) return;
    if (hipMemsetAsync((char*)d_ws + WS_CTL, 0, CTL_ZERO_BYTES, stream) != hipSuccess) { fprintf(stderr, "kernel_launch: memset failed\n"); return; }
    Args a{};
    for (int i = 0; i < 14; ++i) a.in[i] = (const float*)d_in[i];
    a.out = (float*)d_out; a.ws = (unsigned char*)d_ws;
#if MK_PER_PHASE
    for (int p = 0; p < N_PHASES; ++p) { a.ph_lo = p; a.ph_hi = p + 1; hipLaunchKernelGGL(hybrid_fwd, dim3(grid), dim3(NTHREADS), LDS_BYTES, stream, a); }
#else
    a.ph_lo = 0; a.ph_hi = N_PHASES;
    void* kargs[] = {&a};
    hipError_t e = hipLaunchCooperativeKernel((const void*)hybrid_fwd, dim3(grid), dim3(NTHREADS), kargs, LDS_BYTES, stream);
    if (e != hipSuccess) fprintf(stderr, "kernel_launch: cooperative launch failed: %s (grid %d)\n", hipGetErrorString(e), grid);
#endif
}
```

```cpp
#include <hip/hip_runtime.h>
#include <cstdio>
#include <cstdint>
namespace pg8 {
#define PG8_LAS __attribute__((address_space(3)))
typedef unsigned short bf16_t;
typedef short bf16x8 __attribute__((ext_vector_type(8)));
typedef float f32x4 __attribute__((ext_vector_type(4)));
typedef unsigned u32x4 __attribute__((ext_vector_type(4)));
constexpr int BM = 256, BK = 64, HALF = 128, HTB = HALF * BK * 2  , STAGE_BYTES = 8 * HTB, NXCD = 8, WGM = 8;

__host__ __device__ __forceinline__ int lds_byte(int r, int c) { const int st = (r >> 4) * 2 + (c >> 5), rr = r & 15, cc = c & 31, ob = rr * 64 + cc * 2; return st * 1024 + (ob ^ (((ob >> 9) & 1) << 5)); }
__host__ __device__ __forceinline__ void stage_rc(int b, int& R, int& C) { const int st = b / 1024, sb = b % 1024, swz = sb ^ (((sb >> 9) & 1) << 5); R = (st >> 1) * 16 + swz / 64; C = (st & 1) * 32 + (swz % 64) / 2; }
__host__ __device__ __forceinline__ int perm32(int rho) { const int n = rho >> 4, i = rho & 15; return 8 * (i >> 2) + 4 * n + (i & 3); }


struct Unit { int pm, pn, sel; };
struct Gemm { const bf16_t* A0; const bf16_t* A1; const bf16_t* B0; const bf16_t* B1; int K; size_t a_tstep; };

struct StaticOrder {
    int nM, nN, nwg, G, c;
    __host__ __device__ void init(int nM_, int nN_, int G_, int c_) { nM = nM_; nN = nN_; nwg = nM * nN; G = G_; c = c_; }
    __host__ __device__ bool next(int i, Unit& u) const {
        const long L = (long)i * G + c; if (L >= nwg) return false;
        int wgid = (int)L; { const int q = nwg / NXCD, r = nwg % NXCD, xcd = wgid % NXCD, off = wgid / NXCD; wgid = (xcd < r ? xcd * (q + 1) : r * (q + 1) + (xcd - r) * q) + off; }
        const int nig = WGM * nN, gid = wgid / nig, fm = gid * WGM, gsz = (nM - fm) < WGM ? (nM - fm) : WGM;
        u.pm = fm + ((wgid % nig) % gsz); u.pn = (wgid % nig) / gsz; u.sel = 0; return true;
    }
    __device__ __forceinline__ void a_ready(const Unit&) const {}
    __device__ __forceinline__ void done(const Unit&) const {}
};
struct DualOrder {
    StaticOrder S;
    __host__ __device__ bool next(int i, Unit& u) const { const bool ok = S.next(i >> 1, u); u.sel = i & 1; return ok; }
    __device__ __forceinline__ void a_ready(const Unit&) const {}
    __device__ __forceinline__ void done(const Unit&) const {}
};

typedef __bf16 bf16x2_t_ __attribute__((ext_vector_type(2))); typedef float f32x2_t_ __attribute__((ext_vector_type(2)));
__device__ __forceinline__ unsigned cvt_pk_bf16(float lo, float hi) { const f32x2_t_ v = {lo, hi}; const bf16x2_t_ b = __builtin_convertvector(v, bf16x2_t_); return __builtin_bit_cast(unsigned, b); }
__device__ __forceinline__ float bf_lo(unsigned w) { return __uint_as_float(w << 16); }
__device__ __forceinline__ float bf_hi(unsigned w) { return __uint_as_float(w & 0xffff0000u); }
__device__ __forceinline__ float fast_sigmoid(float x) { return __builtin_amdgcn_rcpf(1.0f + __builtin_amdgcn_exp2f(-1.4426950408889634f * x)); }
__device__ __forceinline__ u32x4 pack8(const f32x4 a, const f32x4 b) { u32x4 w; w.x = cvt_pk_bf16(a[0], a[1]); w.y = cvt_pk_bf16(a[2], a[3]); w.z = cvt_pk_bf16(b[0], b[1]); w.w = cvt_pk_bf16(b[2], b[3]); return w; }

template <int CTRL> __device__ __forceinline__ float dpp_shr(float old, float v) { return __builtin_bit_cast(float, __builtin_amdgcn_update_dpp(__builtin_bit_cast(int, old), __builtin_bit_cast(int, v), CTRL, 0xf, 0xf, false)); }
template <int CTRL> __device__ __forceinline__ float dpp_ror(float v) { return __builtin_bit_cast(float, __builtin_amdgcn_update_dpp(0, __builtin_bit_cast(int, v), CTRL, 0xf, 0xf, true)); }
constexpr int MROWS = 16384, DMODEL = 1024, DFF_ = 2816;

struct Epi1 {
    static constexpr bool PERM = true, AFTER_DRAIN = false, APERM = false;
    static __device__ __forceinline__ bool keep_acc(const Unit&) { return false; }
    bf16_t *BG, *UU, *Q, *K, *VT, *SG; const float* rstdx; const float *q_norm, *k_norm; float* kbar; PG8_LAS float* xl;
    __device__ __forceinline__ void operator()(f32x4 (&acc)[2][2][4][2], const Unit& u, int wr, int wc, int fr, int fq) const {
        const int row0 = u.pm * BM + wr * 64 + fr, colw = wc * 32 + 8 * fq, pn = u.pn;
        if (pn >= 12 && pn < 20) {
            const bool isK = pn >= 16; const float* wn = isK ? k_norm : q_norm; const float gs = isK ? 1.0f : 0.12751743074602357f;
            bf16_t* dst = isK ? K : Q; const int cb = ((pn - 12) & 3) * 256;
#pragma unroll
            for (int ai = 0; ai < 2; ++ai)
#pragma unroll
                for (int m = 0; m < 4; ++m) { const int rl = ai * HALF + wr * 64 + m * 16 + fr; const float rs = rstdx[u.pm * BM + rl];
#pragma unroll
                    for (int bj = 0; bj < 2; ++bj) { const f32x4 a = acc[ai][bj][m][0] * rs, b = acc[ai][bj][m][1] * rs; acc[ai][bj][m][0] = a; acc[ai][bj][m][1] = b;
                        float ss = (a[0] * a[0] + a[1] * a[1]) + (a[2] * a[2] + a[3] * a[3]) + (b[0] * b[0] + b[1] * b[1]) + (b[2] * b[2] + b[3] * b[3]);
                        ss += __shfl_xor(ss, 16); ss += __shfl_xor(ss, 32);
                        if (fq == 0) xl[(rl * 2 + bj) * 4 + wc] = ss; } }
            asm volatile("s_waitcnt lgkmcnt(0)" ::: "memory"); __builtin_amdgcn_s_barrier(); asm volatile("" ::: "memory");
            const f32x4 g0 = *(const f32x4*)(wn + colw) * gs, g1 = *(const f32x4*)(wn + colw + 4) * gs;
#pragma unroll
            for (int ai = 0; ai < 2; ++ai)
#pragma unroll
                for (int m = 0; m < 4; ++m) { const int rl = ai * HALF + wr * 64 + m * 16 + fr; const int r = u.pm * BM + rl;
#pragma unroll
                    for (int bj = 0; bj < 2; ++bj) { const f32x4 p = *(const PG8_LAS f32x4*)(xl + (rl * 2 + bj) * 4);
                        const float rn = rsqrtf(((p[0] + p[1]) + (p[2] + p[3])) * (1.0f / 128.0f) + 1e-6f);
                        const f32x4 a = acc[ai][bj][m][0] * rn * g0, b = acc[ai][bj][m][1] * rn * g1; acc[ai][bj][m][0] = a; acc[ai][bj][m][1] = b;
                        if (isK) { int t0 = 0, t1 = 0;
                            t0 = __builtin_amdgcn_cvt_pk_fp8_f32(a[0], a[1], t0, false); t0 = __builtin_amdgcn_cvt_pk_fp8_f32(a[2], a[3], t0, true);
                            t1 = __builtin_amdgcn_cvt_pk_fp8_f32(b[0], b[1], t1, false); t1 = __builtin_amdgcn_cvt_pk_fp8_f32(b[2], b[3], t1, true);
                            *(unsigned long long*)((unsigned char*)dst + (size_t)r * 1024 + cb + bj * 128 + colw) = (unsigned long long)(unsigned)t0 | ((unsigned long long)(unsigned)t1 << 32); }
                        else *(u32x4*)(dst + (size_t)r * 1024 + cb + bj * 128 + colw) = pack8(a, b); } }
            if (isK) {
                f32x4 cs[2][2];
#pragma unroll
                for (int bj = 0; bj < 2; ++bj)
#pragma unroll
                    for (int n = 0; n < 2; ++n) { f32x4 t = acc[0][bj][0][n];
#pragma unroll
                        for (int ai = 0; ai < 2; ++ai)
#pragma unroll
                            for (int m = 0; m < 4; ++m) if (ai + m > 0) t += acc[ai][bj][m][n];
                        cs[bj][n] = t; }
#pragma unroll
                for (int bj = 0; bj < 2; ++bj)
#pragma unroll
                    for (int n = 0; n < 2; ++n)
#pragma unroll
                        for (int e = 0; e < 4; ++e) { float v = cs[bj][n][e]; v += __shfl_xor(v, 1); v += __shfl_xor(v, 2); v += __shfl_xor(v, 4); v += __shfl_xor(v, 8); cs[bj][n][e] = v; }
                if (fr == 0) {
#pragma unroll
                    for (int bj = 0; bj < 2; ++bj) { *(PG8_LAS f32x4*)(xl + 2048 + wr * 256 + bj * 128 + colw) = cs[bj][0]; *(PG8_LAS f32x4*)(xl + 2048 + wr * 256 + bj * 128 + colw + 4) = cs[bj][1]; } }
                asm volatile("s_waitcnt lgkmcnt(0)" ::: "memory"); __builtin_amdgcn_s_barrier(); asm volatile("" ::: "memory");
                int t = threadIdx.x; asm volatile("" : "+v"(t));
                if (t < 256) kbar[((size_t)((pn - 16) * 2 + (t >> 7)) * 64 + u.pm) * 128 + (t & 127)] = (xl[2048 + t] + xl[2048 + 256 + t]) * (1.0f / 256.0f);
            }
            return;
        }
        if (pn >= 20 && pn < 24) {
            int tidv = threadIdx.x; asm volatile("" : "+v"(tidv));
            PG8_LAS unsigned char* T = (PG8_LAS unsigned char*)xl + (tidv >> 6) * 2304;
            const int lane = tidv & 63;
            float rsv[2][4];
#pragma unroll
            for (int ai = 0; ai < 2; ++ai)
#pragma unroll
                for (int m = 0; m < 4; ++m) rsv[ai][m] = rstdx[u.pm * BM + ai * HALF + wr * 64 + m * 16 + fr];
            unsigned char* VT8 = (unsigned char*)VT;
#pragma unroll
            for (int ai = 0; ai < 2; ++ai)
#pragma unroll
                for (int mp = 0; mp < 2; ++mp)
#pragma unroll
                    for (int bj = 0; bj < 2; ++bj) {
#pragma unroll
                        for (int mm = 0; mm < 2; ++mm) { const int m = 2 * mp + mm; const float rs = rsv[ai][m];
                            const f32x4 a = acc[ai][bj][m][0] * rs, b = acc[ai][bj][m][1] * rs; int t0 = 0, t1 = 0;
                            t0 = __builtin_amdgcn_cvt_pk_fp8_f32(a[0], a[1], t0, false); t0 = __builtin_amdgcn_cvt_pk_fp8_f32(a[2], a[3], t0, true);
                            t1 = __builtin_amdgcn_cvt_pk_fp8_f32(b[0], b[1], t1, false); t1 = __builtin_amdgcn_cvt_pk_fp8_f32(b[2], b[3], t1, true);
                            PG8_LAS unsigned char* tp = T + (8 * fq) * 40 + (16 * mm + fr);
#pragma unroll
                            for (int e = 0; e < 4; ++e) { tp[e * 40] = (unsigned char)(((unsigned)t0 >> (8 * e)) & 0xffu); tp[(4 + e) * 40] = (unsigned char)(((unsigned)t1 >> (8 * e)) & 0xffu); } }
                        asm volatile("s_waitcnt lgkmcnt(0)" ::: "memory");
                        { const int d = lane >> 1, tc = lane & 1;
                          const unsigned long long x0 = *(const PG8_LAS unsigned long long*)(T + d * 40 + tc * 16), x1 = *(const PG8_LAS unsigned long long*)(T + d * 40 + tc * 16 + 8);
                          u32x4 o; o.x = (unsigned)x0; o.y = (unsigned)(x0 >> 32); o.z = (unsigned)x1; o.w = (unsigned)(x1 >> 32);
                          *(u32x4*)(VT8 + ((size_t)(((pn - 20) * 2 + bj) * 128 + 32 * wc + d)) * MROWS + u.pm * BM + ai * HALF + wr * 64 + 32 * mp + tc * 16) = o; }
                        asm volatile("s_waitcnt lgkmcnt(0)" ::: "memory");
                    }
            return;
        }
        float rsg[2][4];
#pragma unroll
        for (int ai = 0; ai < 2; ++ai)
#pragma unroll
            for (int m = 0; m < 4; ++m) rsg[ai][m] = rstdx[row0 + ai * HALF + m * 16];
#pragma unroll
        for (int ai = 0; ai < 2; ++ai)
#pragma unroll
            for (int m = 0; m < 4; ++m) {
                const int r = row0 + ai * HALF + m * 16; const float rs = rsg[ai][m];
                f32x4 v[2][2];
#pragma unroll
                for (int bj = 0; bj < 2; ++bj)
#pragma unroll
                    for (int n = 0; n < 2; ++n) v[bj][n] = acc[ai][bj][m][n] * rs;
                if (pn < 4) {
#pragma unroll
                    for (int bj = 0; bj < 2; ++bj) *(u32x4*)(BG + (size_t)r * 1024 + pn * 256 + bj * 128 + colw) = pack8(v[bj][0], v[bj][1]);
                } else if (pn < 12) {
                    *(u32x4*)(UU + (size_t)r * 1024 + (pn - 4) * 128 + colw) = pack8(v[0][0] * v[1][0], v[0][1] * v[1][1]);
                } else {
                    f32x4 ra, rb, sa, sb;
#pragma unroll
                    for (int e = 0; e < 4; ++e) { const float ea0 = __builtin_amdgcn_exp2f(-1.4426950408889634f * v[0][0][e]), ea1 = __builtin_amdgcn_exp2f(-1.4426950408889634f * v[0][1][e]);
                        const float eb0 = __builtin_amdgcn_exp2f(-1.4426950408889634f * v[1][0][e]), eb1 = __builtin_amdgcn_exp2f(-1.4426950408889634f * v[1][1][e]);
                        ra[e] = (1.0f + eb0) * __builtin_amdgcn_rcpf(1.0f + ea0); rb[e] = (1.0f + eb1) * __builtin_amdgcn_rcpf(1.0f + ea1);
                        sa[e] = __builtin_amdgcn_rcpf(1.0f + eb0); sb[e] = __builtin_amdgcn_rcpf(1.0f + eb1); }
                    *(u32x4*)(SG + (size_t)r * 2048 + (pn - 24) * 128 + colw) = pack8(ra, rb);
                    *(u32x4*)(SG + (size_t)r * 2048 + 1024 + (pn - 24) * 128 + colw) = pack8(sa, sb);
                }
            }
    }
};
struct Epi4 {
    static constexpr bool PERM = true, AFTER_DRAIN = false, APERM = false;
    bf16_t* MG; const bf16_t* SG;
    static __device__ __forceinline__ bool keep_acc(const Unit& u) { return u.sel == 0; }
    __device__ __forceinline__ void operator()(f32x4 (&acc)[2][2][4][2], const Unit& u, int wr, int wc, int fr, int fq) const {
        const int row0 = u.pm * BM + wr * 64 + fr, col0 = u.pn * BM + wc * 32 + 8 * fq;
#pragma unroll
        for (int ai = 0; ai < 2; ++ai) {
            u32x4 g[4][2];
#pragma unroll
            for (int m = 0; m < 4; ++m)
#pragma unroll
                for (int bj = 0; bj < 2; ++bj) g[m][bj] = *(const u32x4*)(SG + (size_t)(row0 + ai * HALF + m * 16) * 2048 + u.sel * 1024 + col0 + bj * HALF);
#pragma unroll
            for (int m = 0; m < 4; ++m) { const int r = row0 + ai * HALF + m * 16;
#pragma unroll
                for (int bj = 0; bj < 2; ++bj) { const int c = col0 + bj * HALF; const u32x4 gg = g[m][bj];
                    f32x4 a = acc[ai][bj][m][0], b = acc[ai][bj][m][1];
                    a[0] *= bf_lo(gg.x); a[1] *= bf_hi(gg.x); a[2] *= bf_lo(gg.y); a[3] *= bf_hi(gg.y); b[0] *= bf_lo(gg.z); b[1] *= bf_hi(gg.z); b[2] *= bf_lo(gg.w); b[3] *= bf_hi(gg.w);
                    if (u.sel) *(u32x4*)(MG + (size_t)r * 1024 + c) = pack8(a, b);
                    else { acc[ai][bj][m][0] = a; acc[ai][bj][m][1] = b; } } }
        }
    }
};
struct Epi5 {
    static constexpr bool PERM = true, AFTER_DRAIN = false, APERM = false;
    static __device__ __forceinline__ bool keep_acc(const Unit&) { return false; }
    const bf16_t* X; float* OUT; bf16_t* HB; float* rowss;
    __device__ __forceinline__ void operator()(f32x4 (&acc)[2][2][4][2], const Unit& u, int wr, int wc, int fr, int fq) const {
        const int row0 = u.pm * BM + wr * 64 + fr, col0 = u.pn * BM + wc * 32 + 8 * fq;
#pragma unroll
        for (int ai = 0; ai < 2; ++ai) {
            u32x4 xw[4][2];
#pragma unroll
            for (int m = 0; m < 4; ++m)
#pragma unroll
                for (int bj = 0; bj < 2; ++bj) xw[m][bj] = __builtin_nontemporal_load((const u32x4*)(X + (size_t)(row0 + ai * HALF + m * 16) * 1024 + col0 + bj * HALF));
#pragma unroll
            for (int m = 0; m < 4; ++m) { const int r = row0 + ai * HALF + m * 16; float ss = 0.f;
#pragma unroll
                for (int bj = 0; bj < 2; ++bj) { const size_t o = (size_t)r * 1024 + col0 + bj * HALF;
                    const u32x4 xq = xw[m][bj];
                    const f32x4 a = acc[ai][bj][m][0] + (f32x4){bf_lo(xq.x), bf_hi(xq.x), bf_lo(xq.y), bf_hi(xq.y)}, b = acc[ai][bj][m][1] + (f32x4){bf_lo(xq.z), bf_hi(xq.z), bf_lo(xq.w), bf_hi(xq.w)};
                    *(u32x4*)(HB + o) = pack8(a, b);
                    ss += (a[0] * a[0] + a[1] * a[1]) + (a[2] * a[2] + a[3] * a[3]) + (b[0] * b[0] + b[1] * b[1]) + (b[2] * b[2] + b[3] * b[3]); }
                ss += __shfl_xor(ss, 16); ss += __shfl_xor(ss, 32);
                if (fq == 0) atomicAdd(rowss + r, ss); }
        }
    }
};
struct Epi6 {
    static constexpr bool PERM = true, AFTER_DRAIN = false, APERM = true;
    static __device__ __forceinline__ bool keep_acc(const Unit&) { return false; }
    bf16_t* ACT; const float* rowss; const float* cw; const float* cb; PG8_LAS float* halo;
    __device__ __forceinline__ void operator()(f32x4 (&acc)[2][2][4][2], const Unit& u, int wr, int wc, int fr, int fq) const {
        const int r0 = u.pm * 254 - 2, colw = wc * 32 + 8 * fq;
#pragma unroll
        for (int ai = 0; ai < 2; ++ai)
#pragma unroll
            for (int m = 0; m < 4; ++m) { int gr = r0 + ai * HALF + wr * 64 + 4 * fr + m; gr = gr < 0 ? 0 : (gr > MROWS - 1 ? MROWS - 1 : gr);
                const float rs = rsqrtf(rowss[gr] * (1.0f / 1024.0f) + 1e-6f);
#pragma unroll
                for (int bj = 0; bj < 2; ++bj)
#pragma unroll
                    for (int n = 0; n < 2; ++n) acc[ai][bj][m][n] *= rs; }
        if (fr == 15) {
#pragma unroll
            for (int ai = 0; ai < 2; ++ai)
#pragma unroll
                for (int bj = 0; bj < 2; ++bj)
#pragma unroll
                    for (int n = 0; n < 2; ++n) { *(PG8_LAS f32x4*)(halo + (((2 * ai + wr) * 2 + 0) * 256 + bj * 128 + colw + 4 * n)) = acc[ai][bj][2][n];
                                                  *(PG8_LAS f32x4*)(halo + (((2 * ai + wr) * 2 + 1) * 256 + bj * 128 + colw + 4 * n)) = acc[ai][bj][3][n]; }
        }
        f32x4 wn0, wn1, wn2, wnb;
        { const int col = u.pn * 128 + colw; wn0 = *(const f32x4*)(cw + col); wn1 = *(const f32x4*)(cw + 2 * DFF_ + col); wn2 = *(const f32x4*)(cw + 4 * DFF_ + col); wnb = *(const f32x4*)(cb + col); }
        asm volatile("s_waitcnt lgkmcnt(0)" ::: "memory"); __builtin_amdgcn_s_barrier(); asm volatile("" ::: "memory");
#pragma unroll
        for (int bj = 0; bj < 2; ++bj)
#pragma unroll
            for (int n = 0; n < 2; ++n) {
                const f32x4 w0 = wn0, w1 = wn1, w2 = wn2, bb = wnb;
                if (bj * 2 + n < 3) { const int k2 = bj * 2 + n + 1, col = (k2 >> 1) * DFF_ + u.pn * 128 + colw + 4 * (k2 & 1);
                    wn0 = *(const f32x4*)(cw + col); wn1 = *(const f32x4*)(cw + 2 * DFF_ + col); wn2 = *(const f32x4*)(cw + 4 * DFF_ + col); wnb = *(const f32x4*)(cb + col); }
#pragma unroll
                for (int ai = 0; ai < 2; ++ai) {
                    const int s = 2 * ai + wr;
                    const int sm = s > 0 ? s - 1 : 0; const float hz = s > 0 ? 1.0f : 0.0f;
                    const f32x4 h2 = *(const PG8_LAS f32x4*)(halo + ((sm * 2 + 0) * 256 + bj * 128 + colw + 4 * n)) * hz, h1 = *(const PG8_LAS f32x4*)(halo + ((sm * 2 + 1) * 256 + bj * 128 + colw + 4 * n)) * hz;
                    const f32x4 raw0 = acc[ai][bj][0][n], raw1 = acc[ai][bj][1][n]; f32x4 raw2 = acc[ai][bj][2][n], raw3 = acc[ai][bj][3][n];
                    asm volatile("" : "+v"(raw2), "+v"(raw3));
                    f32x4 s3, s2;
#pragma unroll
                    for (int e = 0; e < 4; ++e) { s3[e] = dpp_shr<0x111>(h1[e], raw3[e]); s2[e] = dpp_shr<0x111>(h2[e], raw2[e]); }
                    { f32x4 y3 = w0 * raw1 + w1 * raw2 + w2 * raw3 + bb, y2 = w0 * raw0 + w1 * raw1 + w2 * raw2 + bb, y1 = w0 * s3 + w1 * raw0 + w2 * raw1 + bb, y0 = w0 * s2 + w1 * s3 + w2 * raw0 + bb;
                      asm volatile("" : "+v"(y0), "+v"(y1), "+v"(y2), "+v"(y3));
                      acc[ai][bj][3][n] = y3; acc[ai][bj][2][n] = y2; acc[ai][bj][1][n] = y1; acc[ai][bj][0][n] = y0; }
                }
            }
#pragma unroll
        for (int ai = 0; ai < 2; ++ai)
#pragma unroll
            for (int m = 0; m < 4; ++m) { const int i = ai * HALF + wr * 64 + 4 * fr + m, gr = r0 + i;
                f32x4 a, b;
#pragma unroll
                for (int e = 0; e < 4; ++e) { const float g0 = acc[ai][0][m][0][e], g1 = acc[ai][0][m][1][e];
                    a[e] = g0 * fast_sigmoid(g0) * acc[ai][1][m][0][e]; b[e] = g1 * fast_sigmoid(g1) * acc[ai][1][m][1][e]; }
                if (i >= 2 && gr < MROWS) *(u32x4*)(ACT + (size_t)gr * DFF_ + u.pn * 128 + colw) = pack8(a, b); }
    }
};
struct Epi7 {
    static constexpr bool PERM = true, AFTER_DRAIN = false, APERM = false;
    static __device__ __forceinline__ bool keep_acc(const Unit&) { return false; }
    float* OUT; const bf16_t* HB;
    __device__ __forceinline__ void operator()(f32x4 (&acc)[2][2][4][2], const Unit& u, int wr, int wc, int fr, int fq) const {
        const int row0 = u.pm * BM + wr * 64 + fr, col0 = u.pn * BM + wc * 32 + 8 * fq;
#pragma unroll
        for (int ai = 0; ai < 2; ++ai) {
            u32x4 hv[4][2];
#pragma unroll
            for (int m = 0; m < 4; ++m)
#pragma unroll
                for (int bj = 0; bj < 2; ++bj) hv[m][bj] = *(const u32x4*)(HB + (size_t)(row0 + ai * HALF + m * 16) * 1024 + col0 + bj * HALF);
#pragma unroll
            for (int m = 0; m < 4; ++m) { const int r = row0 + ai * HALF + m * 16;
#pragma unroll
                for (int bj = 0; bj < 2; ++bj) { const size_t o = (size_t)r * 1024 + col0 + bj * HALF; float* p = OUT + o; const u32x4 hw = hv[m][bj];
                    f32x4 a = acc[ai][bj][m][0], b = acc[ai][bj][m][1];
                    a[0] += bf_lo(hw.x); a[1] += bf_hi(hw.x); a[2] += bf_lo(hw.y); a[3] += bf_hi(hw.y); b[0] += bf_lo(hw.z); b[1] += bf_hi(hw.z); b[2] += bf_lo(hw.w); b[3] += bf_hi(hw.w);
                    __builtin_nontemporal_store(a, (f32x4*)p); __builtin_nontemporal_store(b, (f32x4*)(p + 4)); } }
        }
    }
};
template <class Epi, class Sched, bool ALIGN_EPI = false, bool SP2 = false>
__device__ __forceinline__ void gemm_phase(PG8_LAS unsigned char* lds, const Gemm g, const Sched& S, const Epi& E) {
    const int tid = threadIdx.x, wid = __builtin_amdgcn_readfirstlane(tid >> 6), lane = tid & 63, wr = wid >> 2, wc = wid & 3, fr = lane & 15, fq = lane >> 4;
    const int K = g.K, nt = K / BK;
    unsigned voffA[2], voffB[2];
#pragma unroll
    for (int i = 0; i < 2; ++i) { int R, C; stage_rc(tid * 16 + i * 8192, R, C); const int Rb = Epi::PERM ? ((R & ~31) + perm32(R & 31)) : R;
        const int Ra = Epi::APERM ? ((R & ~63) | (4 * (R & 15) + ((R >> 4) & 3))) : R;
        voffA[i] = (unsigned)(Ra * K + C) * 2u; voffB[i] = (unsigned)(Rb * K + C) * 2u; }
    const size_t kstep = (size_t)(BK * 2);
    const size_t hstep = (size_t)HALF * K * 2;
    const size_t tstep = 2 * hstep;
    const unsigned ldsw = (unsigned)wid * 1024u;
    const int aoff = lds_byte(wr * 64 + fr, fq * 8), boff = lds_byte(wc * 32 + fr, fq * 8);
#define PG8_SA(b, h) (((b) * 2 + (h)) * HTB)
#define PG8_SB(b, h) ((4 + (b) * 2 + (h)) * HTB)
#define PG8_STAGE(bufoff, gbase, voff) do { _Pragma("unroll") for (int _i = 0; _i < 2; ++_i) \
        __builtin_amdgcn_global_load_lds((const unsigned*)((const char*)(gbase) + (voff)[_i]), (PG8_LAS unsigned*)(lds + (bufoff) + ldsw + _i * 8192), 16, 0, 0); } while (0)
#define PG8_LDA(dst, b, h) do { _Pragma("unroll") for (int m = 0; m < 4; ++m) _Pragma("unroll") for (int k = 0; k < 2; ++k) dst[m][k] = *(const PG8_LAS bf16x8*)(lds + PG8_SA(b, h) + aoff + m * 2048 + k * 1024); } while (0)
#define PG8_LDB(dst, b, h) do { _Pragma("unroll") for (int n = 0; n < 2; ++n) _Pragma("unroll") for (int k = 0; k < 2; ++k) dst[n][k] = *(const PG8_LAS bf16x8*)(lds + PG8_SB(b, h) + boff + n * 2048 + k * 1024); } while (0)
#define PG8_MMA(ai, bj, At, Bt) do { __builtin_amdgcn_s_setprio(1); _Pragma("unroll") for (int m = 0; m < 4; ++m) _Pragma("unroll") for (int n = 0; n < 2; ++n) _Pragma("unroll") for (int k = 0; k < 2; ++k) \
        acc[ai][bj][m][n] = __builtin_amdgcn_mfma_f32_16x16x32_bf16(Bt[n][k], At[m][k], acc[ai][bj][m][n], 0, 0, 0); __builtin_amdgcn_s_setprio(0); } while (0)
#define PG8_WAIT_V(n) asm volatile("s_waitcnt vmcnt(" #n ")" ::: "memory")
#define PG8_WAIT_L(n) asm volatile("s_waitcnt lgkmcnt(" #n ")" ::: "memory")
#define PG8_BAR __builtin_amdgcn_s_barrier()
#define PG8_SCHED __builtin_amdgcn_sched_barrier(0)
    Unit cur, nxt; int ui = 0;
    if (!S.next(0, cur)) return;
    f32x4 acc[2][2][4][2];
#pragma unroll
    for (int a = 0; a < 2; ++a)
#pragma unroll
        for (int b = 0; b < 2; ++b)
#pragma unroll
            for (int m = 0; m < 4; ++m)
#pragma unroll
                for (int n = 0; n < 2; ++n) acc[a][b][m][n] = (f32x4){0.f, 0.f, 0.f, 0.f};
    bf16x8 At[4][2], B0[2][2], B1[2][2];
    const char* cA = (const char*)(cur.sel ? g.A1 : g.A0) + (size_t)cur.pm * g.a_tstep; const char* cB = (const char*)(cur.sel ? g.B1 : g.B0) + (size_t)cur.pn * tstep;
    S.a_ready(cur);
    if constexpr (SP2) {
        PG8_STAGE(PG8_SB(0, 0), cB, voffB); PG8_STAGE(PG8_SB(0, 1), cB + hstep, voffB); PG8_STAGE(PG8_SA(0, 0), cA, voffA); PG8_STAGE(PG8_SA(0, 1), cA + hstep, voffA);
        if (wr == 1) PG8_BAR;
        PG8_WAIT_V(2); PG8_BAR;
        PG8_STAGE(PG8_SB(1, 0), cB + kstep, voffB); PG8_STAGE(PG8_SA(1, 0), cA + kstep, voffA); PG8_STAGE(PG8_SB(1, 1), cB + hstep + kstep, voffB);
        PG8_WAIT_V(6); PG8_BAR;
    } else {
        PG8_STAGE(PG8_SB(0, 0), cB, voffB); PG8_STAGE(PG8_SA(0, 0), cA, voffA); PG8_STAGE(PG8_SB(0, 1), cB + hstep, voffB); PG8_STAGE(PG8_SA(0, 1), cA + hstep, voffA);
        if (wr == 1) PG8_BAR;
        PG8_WAIT_V(4); PG8_BAR;
        PG8_STAGE(PG8_SB(1, 0), cB + kstep, voffB); PG8_STAGE(PG8_SA(1, 0), cA + kstep, voffA); PG8_STAGE(PG8_SB(1, 1), cB + hstep + kstep, voffB);
        PG8_WAIT_V(6); PG8_BAR;
    }
    for (;;) {
        const bool has_next = S.next(ui + 1, nxt);
        const char* nA = has_next ? (const char*)(nxt.sel ? g.A1 : g.A0) + (size_t)nxt.pm * g.a_tstep : cA; const char* nB = has_next ? (const char*)(nxt.sel ? g.B1 : g.B0) + (size_t)nxt.pn * tstep : cB;
        for (int t = 0; t < nt; t += 2) {
            const bool last = (t == nt - 2);
            const char* a1 = cA + (size_t)(t + 1) * kstep;
            const char* a2 = last ? nA : cA + (size_t)(t + 2) * kstep; const char* b2 = last ? nB : cB + (size_t)(t + 2) * kstep;
            const char* a3 = a2 + kstep; const char* b3 = b2 + kstep;
            if (last && has_next) S.a_ready(nxt);
            if constexpr (SP2) {
            PG8_LDB(B0, 0, 0); PG8_LDB(B1, 0, 1); PG8_SCHED; PG8_LDA(At, 0, 0); PG8_STAGE(PG8_SA(1, 1), a1 + hstep, voffA);
            PG8_WAIT_V(8); PG8_WAIT_L(0); PG8_BAR; PG8_MMA(0, 0, At, B0); PG8_MMA(0, 1, At, B1); PG8_BAR; PG8_SCHED;
            PG8_LDA(At, 0, 1); PG8_STAGE(PG8_SB(0, 0), b2, voffB); PG8_STAGE(PG8_SB(0, 1), b2 + hstep, voffB); PG8_STAGE(PG8_SA(0, 0), a2, voffA);
            PG8_WAIT_V(8); PG8_WAIT_L(0); PG8_BAR; PG8_MMA(1, 0, At, B0); PG8_MMA(1, 1, At, B1); PG8_BAR; PG8_SCHED;
            PG8_LDB(B0, 1, 0); PG8_LDB(B1, 1, 1); PG8_SCHED; PG8_LDA(At, 1, 0); PG8_STAGE(PG8_SA(0, 1), a2 + hstep, voffA);
            PG8_WAIT_V(8); PG8_WAIT_L(0); PG8_BAR; PG8_MMA(0, 0, At, B0); PG8_MMA(0, 1, At, B1); PG8_BAR; PG8_SCHED;
            PG8_LDA(At, 1, 1); PG8_STAGE(PG8_SB(1, 0), b3, voffB); PG8_STAGE(PG8_SB(1, 1), b3 + hstep, voffB); PG8_STAGE(PG8_SA(1, 0), a3, voffA);
            PG8_WAIT_V(8); PG8_WAIT_L(0); PG8_BAR; PG8_MMA(1, 0, At, B0); PG8_MMA(1, 1, At, B1); PG8_BAR; PG8_SCHED;
            } else {
            PG8_LDB(B0, 0, 0); PG8_SCHED; PG8_LDA(At, 0, 0); PG8_STAGE(PG8_SA(1, 1), a1 + hstep, voffA);
            PG8_WAIT_L(8); PG8_BAR; PG8_WAIT_L(0); PG8_MMA(0, 0, At, B0); PG8_BAR; PG8_SCHED;
            PG8_LDB(B1, 0, 1); PG8_STAGE(PG8_SB(0, 0), b2, voffB);
            PG8_BAR; PG8_WAIT_L(0); PG8_MMA(0, 1, At, B1); PG8_BAR;
            PG8_LDA(At, 0, 1); PG8_STAGE(PG8_SA(0, 0), a2, voffA);
            PG8_BAR; PG8_WAIT_L(0); PG8_MMA(1, 0, At, B0); PG8_BAR; PG8_SCHED;
            PG8_STAGE(PG8_SB(0, 1), b2 + hstep, voffB);
            PG8_WAIT_V(6); PG8_BAR; PG8_MMA(1, 1, At, B1); PG8_BAR;
            PG8_LDB(B0, 1, 0); PG8_SCHED; PG8_LDA(At, 1, 0); PG8_STAGE(PG8_SA(0, 1), a2 + hstep, voffA);
            PG8_WAIT_L(8); PG8_BAR; PG8_WAIT_L(0); PG8_MMA(0, 0, At, B0); PG8_BAR; PG8_SCHED;
            PG8_LDB(B1, 1, 1); PG8_STAGE(PG8_SB(1, 0), b3, voffB);
            PG8_BAR; PG8_WAIT_L(0); PG8_MMA(0, 1, At, B1); PG8_BAR;
            PG8_LDA(At, 1, 1); PG8_STAGE(PG8_SA(1, 0), a3, voffA);
            PG8_BAR; PG8_WAIT_L(0); PG8_MMA(1, 0, At, B0); PG8_BAR; PG8_SCHED;
            PG8_STAGE(PG8_SB(1, 1), b3 + hstep, voffB);
            PG8_WAIT_V(6); PG8_BAR; PG8_MMA(1, 1, At, B1); PG8_BAR;
            }
        }
        if constexpr (ALIGN_EPI) { if (wr == 0) PG8_BAR; }
        if constexpr (!Epi::AFTER_DRAIN) { E(acc, cur, wr, wc, fr, fq); S.done(cur); }
        if (!has_next) break;
        if (!Epi::keep_acc(cur)) {
#pragma unroll
        for (int a = 0; a < 2; ++a)
#pragma unroll
            for (int b = 0; b < 2; ++b)
#pragma unroll
                for (int m = 0; m < 4; ++m)
#pragma unroll
                    for (int n = 0; n < 2; ++n) acc[a][b][m][n] = (f32x4){0.f, 0.f, 0.f, 0.f}; }
        cur = nxt; cA = nA; cB = nB; ++ui;
        if constexpr (ALIGN_EPI) { if (wr == 1) PG8_BAR; }
    }
    PG8_WAIT_V(0);
    if constexpr (!ALIGN_EPI) { if (wr == 0) PG8_BAR; }
    PG8_BAR;
    if constexpr (Epi::AFTER_DRAIN) { E.fused(acc, cur, wr, wc, fr, fq, lds, wid, lane); S.done(cur); }
#undef PG8_SA
#undef PG8_SB
#undef PG8_STAGE
#undef PG8_LDA
#undef PG8_LDB
#undef PG8_MMA
#undef PG8_WAIT_V
#undef PG8_WAIT_L
#undef PG8_BAR
#undef PG8_SCHED
}
}
#define GAS __attribute__((address_space(1)))
#define LAS __attribute__((address_space(3)))
typedef unsigned short bf16;
typedef unsigned v4u __attribute__((ext_vector_type(4)));
typedef float f32x4 __attribute__((ext_vector_type(4)));
typedef short bf16x8 __attribute__((ext_vector_type(8)));
typedef GAS unsigned gu32;
typedef GAS unsigned long long gu64;
#define RLX_AGENT __ATOMIC_RELAXED, __HIP_MEMORY_SCOPE_AGENT
#define LDS_WAIT() asm volatile("s_waitcnt lgkmcnt(0)" ::: "memory")
#define VM_WAIT() asm volatile("s_waitcnt vmcnt(0)" ::: "memory")
__device__ __forceinline__ unsigned long long rt() { return __builtin_amdgcn_s_memrealtime(); }
__device__ __forceinline__ unsigned f2bf(float f) { unsigned u = __builtin_bit_cast(unsigned, f); return (u + 0x7fffu + ((u >> 16) & 1u)) >> 16; }
__device__ __forceinline__ unsigned pk2(float lo, float hi) { return f2bf(lo) | (f2bf(hi) << 16); }

#define XB_TMO      128
#define XB_XCNT(j)  (256  + 64 * (j))
#define XB_XSUB(j)  (1280 + 64 * (j))
#define XB_XGEN(j)  (2304 + 64 * (j))
#define XB_TOP      3328
#define XB_TOPGEN   3392
#define XCD_BAR_WORDS 3456
#define XB_SPIN_CAP (1u << 18)

__device__ __forceinline__ unsigned xb_ld(unsigned* p)              { return __hip_atomic_load(p, __ATOMIC_RELAXED, __HIP_MEMORY_SCOPE_AGENT); }
__device__ __forceinline__ unsigned xb_add(unsigned* p, unsigned v) { return __hip_atomic_fetch_add(p, v, __ATOMIC_RELAXED, __HIP_MEMORY_SCOPE_AGENT); }
__device__ __forceinline__ unsigned xb_xcc_id() { return (unsigned)__builtin_amdgcn_s_getreg((3 << 11) | 20) & 0xFu; }
#define XB_SPIN(cond, bar) do { unsigned _sp = 0; while (cond) { __builtin_amdgcn_s_sleep(1); \
    if ((++_sp & 255u) == 0u) { if (xb_ld(&(bar)[XB_TMO])) break; if (_sp > XB_SPIN_CAP) { atomicAdd(&(bar)[XB_TMO], 1u); break; } } } } while (0)

struct XcdBarrier {
    unsigned* bar; unsigned x;
    volatile LAS unsigned* st;
};

__device__ __forceinline__ XcdBarrier xcd_barrier_post(unsigned* bar, volatile LAS unsigned* st) {
    XcdBarrier b; b.bar = bar; b.x = xb_xcc_id(); b.st = st;
    if (threadIdx.x == 0) (void)xb_add(&bar[XB_XCNT(b.x)], 1u);
    return b;
}
__device__ __forceinline__ void xcd_barrier_complete(unsigned* bar, unsigned x, unsigned& nloc, unsigned& nx) {
    const unsigned G = gridDim.x * gridDim.y * gridDim.z;
    unsigned sum, cnt, mine, sp = 0u;
    for (;;) {
        sum = 0u; cnt = 0u; mine = 0u;
#pragma unroll
        for (unsigned j = 0; j < 16; ++j) { const unsigned c = xb_ld(&bar[XB_XCNT(j)]); sum += c; cnt += (c > 0u) ? 1u : 0u; mine = (j == x) ? c : mine; }
        if (sum == G) break;
        __builtin_amdgcn_s_sleep(1);
        if ((++sp & 255u) == 0u) { if (xb_ld(&bar[XB_TMO])) break; if (sp > XB_SPIN_CAP) { atomicAdd(&bar[XB_TMO], 1u); break; } }
    }
    nloc = mine > 0u ? mine : 1u; nx = cnt > 0u ? cnt : 1u;
}

__device__ __forceinline__ void xcd_barrier(const XcdBarrier& b) {
    asm volatile("s_waitcnt vmcnt(0)" ::: "memory");
    __syncthreads();
    if (threadIdx.x == 0) {
        unsigned* bar = b.bar;
        __builtin_amdgcn_s_waitcnt(0);
        unsigned nloc = b.st[0], nx = b.st[1];
        if (nloc == 0u) { xcd_barrier_complete(bar, b.x, nloc, nx); b.st[0] = nloc; b.st[1] = nx; }
        const unsigned old = xb_add(&bar[XB_XSUB(b.x)], 1u);
        const unsigned gen = old / nloc;
        if (old + 1u == (gen + 1u) * nloc) {
            __builtin_amdgcn_fence(__ATOMIC_RELEASE, "agent");
            asm volatile("s_waitcnt vmcnt(0)" ::: "memory");
            const unsigned og = xb_add(&bar[XB_TOP], 1u);
            const unsigned tg = og / nx;
            if (og + 1u == (tg + 1u) * nx) xb_add(&bar[XB_TOPGEN], 1u);
            else XB_SPIN(xb_ld(&bar[XB_TOPGEN]) == tg, bar);
            __builtin_amdgcn_fence(__ATOMIC_ACQUIRE, "agent");
            xb_add(&bar[XB_XGEN(b.x)], 1u);
            asm volatile("s_waitcnt vmcnt(0)" ::: "memory");
        } else {
            XB_SPIN(xb_ld(&bar[XB_XGEN(b.x)]) == gen, bar);
            __builtin_amdgcn_fence(__ATOMIC_ACQUIRE, "agent");
            asm volatile("s_waitcnt vmcnt(0)" ::: "memory");
        }
    }
    __syncthreads();
}


constexpr int NWAVES = 8, NTHREADS = 512;
constexpr int M = 16384, D = 1024, NIN = 8192, DFF = 2816, NH = 8, HD = 128, NBLK = 64, BLK = 256;
constexpr float EPS = 1e-6f;
constexpr float C2 = 0.08838834764831845f * 1.4426950408889634f;
constexpr size_t MiB = 1u << 20;
constexpr size_t WS_CTL = 0, CTL_ZERO_BYTES = 256 * 1024;
constexpr int CW_BAR = 4096, CW_GCNT = 8192, CW_ROWSS = 16384;
constexpr size_t WS_KBAR = 1 * MiB, WS_RSTDX = 1 * MiB + 512 * 1024, WS_LPART = 2 * MiB;
constexpr size_t WS_WOA = 4 * MiB, WS_WOB = 6 * MiB, WS_WO = 8 * MiB;
constexpr size_t WS_Q = 10 * MiB, WS_K = 42 * MiB, WS_VT = 74 * MiB, WS_CA = 106 * MiB, WS_LIST = 138 * MiB, WS_WIN = 147 * MiB, WS_XB = 163 * MiB, WS_UU = 195 * MiB;
constexpr size_t WS_OPART = 195 * MiB;
constexpr size_t WS_WUP = 243 * MiB, WS_WDN = 138 * MiB, WS_MG = 42 * MiB, WS_HB = 198 * MiB;
constexpr size_t WS_ACT = 10 * MiB;
constexpr size_t WS_END = 256 * MiB;
constexpr int LDS_BYTES = 163840, MISC_OFF = 131072 + 320, HALO_OFF = 131072 + 1024, SCAN_OFF = 131072 + 1024;
__device__ __forceinline__ int list_off(int n) { return 256 * (63 * n - (n * (n - 1)) / 2); }
constexpr int LIST_PER_HEAD = 256 * 2016;

__device__ __forceinline__ float wave_sum(float v) {
#pragma unroll
    for (int o = 1; o < 64; o <<= 1) v += __shfl_xor(v, o);
    return v;
}
__device__ __forceinline__ void transpose_item(const float* W, int N, bf16* WT, int K, int k0, int col0, int row0, const float* ks, LAS float* scr, int lane) {
    float wv[32];
#pragma unroll
    for (int i = 0; i < 32; ++i) wv[i] = __builtin_nontemporal_load(W + (size_t)(k0 + 2 * i + (lane >> 5)) * N + col0 + (lane & 31));
#pragma unroll
    for (int i = 0; i < 32; ++i) { const int kk = 2 * i + (lane >> 5); const float s = ks ? ks[k0 + kk] : 1.0f; scr[kk * 33 + (lane & 31)] = s * wv[i]; }
    LDS_WAIT(); asm volatile("" ::: "memory");
    const int c = lane & 7;
#pragma unroll
    for (int j = 0; j < 4; ++j) { const int n = (lane >> 3) + 8 * j; const LAS float* s = scr + (8 * c) * 33 + n;
        v4u o; o.x = pk2(s[0 * 33], s[1 * 33]); o.y = pk2(s[2 * 33], s[3 * 33]); o.z = pk2(s[4 * 33], s[5 * 33]); o.w = pk2(s[6 * 33], s[7 * 33]);
        *(GAS v4u*)(WT + (size_t)(row0 + n) * K + k0 + 8 * c) = o; }
    LDS_WAIT(); asm volatile("" ::: "memory");
}
__device__ __forceinline__ int map_col(int mode, int R) {
    if (mode == 1) { if (R >= 1024 && R < 3072) { const int q = R - 1024; return 1024 + ((q >> 7) & 1) * 1024 + (q >> 8) * 128 + (q & 127); }
                     if (R >= 6144) { const int q = R - 6144; return 6144 + ((q >> 7) & 1) * 1024 + (q >> 8) * 128 + (q & 127); } return R; }
    if (mode == 2) return ((R >> 7) & 1) * DFF + (R >> 8) * 128 + (R & 127);
    return R;
}
__device__ __forceinline__ void convert_weight(const float* W, int K, int N, bf16* WT, const float* ks, int mode, LAS float* scr, int gw, int NGW, int lane) {
    const int nblk = N / 32, nitems = (K / 64) * nblk;
    for (int it = gw; it < nitems; it += NGW) { const int kb = it / nblk, nb = it % nblk; transpose_item(W, N, WT, K, 64 * kb, map_col(mode, 32 * nb), 32 * nb, ks, scr, lane); }
}

__device__ __forceinline__ void phase0(const float* x, const float* norm_mix, const float* w_in, const float* w_oa, const float* w_ob, const float* w_o, const float* w_up, const float* norm_ffn, unsigned char* ws, LAS unsigned char* lds, int vcu, int G, int wave, int lane) {
    LAS float* scr = (LAS float*)(lds + wave * 16384);
    const int gw = vcu * NWAVES + wave, NGW = G * NWAVES;
    convert_weight(w_in, D, NIN, (bf16*)(ws + WS_WIN), norm_mix, 1, scr, gw, NGW, lane);
    convert_weight(w_oa, D, D, (bf16*)(ws + WS_WOA), nullptr, 0, scr, gw, NGW, lane);
    convert_weight(w_ob, D, D, (bf16*)(ws + WS_WOB), nullptr, 0, scr, gw, NGW, lane);
    convert_weight(w_o, D, D, (bf16*)(ws + WS_WO), nullptr, 0, scr, gw, NGW, lane);
    convert_weight(w_up, D, 2 * DFF, (bf16*)(ws + WS_WUP), norm_ffn, 2, scr, gw, NGW, lane);
    bf16* XB = (bf16*)(ws + WS_XB); float* rstdx = (float*)(ws + WS_RSTDX);
    for (int m = gw; m < M; m += NGW) {
        const GAS f32x4* xr = (const GAS f32x4*)(x + (size_t)m * D) + lane; f32x4 v[4]; float s = 0.f;
#pragma unroll
        for (int j = 0; j < 4; ++j) { v[j] = __builtin_nontemporal_load(xr + 64 * j); s += (v[j].x * v[j].x + v[j].y * v[j].y) + (v[j].z * v[j].z + v[j].w * v[j].w); }
        s = wave_sum(s); if (lane == 0) rstdx[m] = rsqrtf(s * (1.f / D) + EPS);
        GAS unsigned long long* o8 = (GAS unsigned long long*)(XB + (size_t)m * D) + lane;
#pragma unroll
        for (int j = 0; j < 4; ++j) o8[64 * j] = (unsigned long long)pk2(v[j].x, v[j].y) | ((unsigned long long)pk2(v[j].z, v[j].w) << 32);
    }
}
__device__ __forceinline__ void phase2(const float* conv_a_w, unsigned char* ws, int G, int tid, bf16* __restrict__ CAout) {
    const bf16* __restrict__ BG = (const bf16*)(ws + WS_CA); const bf16* __restrict__ UU = (const bf16*)(ws + WS_UU);
    for (int item = blockIdx.x * NTHREADS + tid; item < 128 * (M / 16); item += G * NTHREADS) {
        const int cc = (item & 127) * 8, t0 = (item >> 7) * 16;
        float w0[8], w1[8], w2[8], um2[8], um1[8];
#pragma unroll
        for (int j = 0; j < 2; ++j) { const f32x4 a = *(const GAS f32x4*)(conv_a_w + cc + 4 * j), b = *(const GAS f32x4*)(conv_a_w + 1024 + cc + 4 * j), c = *(const GAS f32x4*)(conv_a_w + 2048 + cc + 4 * j);
#pragma unroll
            for (int e = 0; e < 4; ++e) { w0[4 * j + e] = a[e]; w1[4 * j + e] = b[e]; w2[4 * j + e] = c[e]; } }
        { v4u a = (v4u){0u, 0u, 0u, 0u}, b = a; if (t0 >= 2) { a = *(const GAS v4u*)(UU + (size_t)(t0 - 2) * 1024 + cc); b = *(const GAS v4u*)(UU + (size_t)(t0 - 1) * 1024 + cc); }
          const unsigned aw[4] = {a.x, a.y, a.z, a.w}, bw[4] = {b.x, b.y, b.z, b.w};
#pragma unroll
          for (int j = 0; j < 4; ++j) { um2[2 * j] = pg8::bf_lo(aw[j]); um2[2 * j + 1] = pg8::bf_hi(aw[j]); um1[2 * j] = pg8::bf_lo(bw[j]); um1[2 * j + 1] = pg8::bf_hi(bw[j]); } }
#pragma unroll 4
        for (int i = 0; i < 16; ++i) { const size_t o = (size_t)(t0 + i) * 1024 + cc;
            const v4u u = *(const GAS v4u*)(UU + o), b = *(const GAS v4u*)(BG + o); const unsigned uw[4] = {u.x, u.y, u.z, u.w}, bw[4] = {b.x, b.y, b.z, b.w};
            float r[8];
#pragma unroll
            for (int j = 0; j < 4; ++j) { const float u0 = pg8::bf_lo(uw[j]), u1 = pg8::bf_hi(uw[j]);
                r[2 * j] = pg8::bf_lo(bw[j]) * (w0[2 * j] * um2[2 * j] + w1[2 * j] * um1[2 * j] + w2[2 * j] * u0);
                r[2 * j + 1] = pg8::bf_hi(bw[j]) * (w0[2 * j + 1] * um2[2 * j + 1] + w1[2 * j + 1] * um1[2 * j + 1] + w2[2 * j + 1] * u1);
                um2[2 * j] = um1[2 * j]; um2[2 * j + 1] = um1[2 * j + 1]; um1[2 * j] = u0; um1[2 * j + 1] = u1; }
            v4u o4; o4.x = pk2(r[0], r[1]); o4.y = pk2(r[2], r[3]); o4.z = pk2(r[4], r[5]); o4.w = pk2(r[6], r[7]);
            *(GAS v4u*)(CAout + o) = o4; }
    }
}
__device__ __forceinline__ bool top_better(float v, int n, float cv, int cn) { return v > cv || (v == cv && n < cn); }
__device__ __forceinline__ void top3_insert(float v, int n, float (&tv)[3], int (&ti)[3]) {
    if (top_better(v, n, tv[0], ti[0])) { tv[2] = tv[1]; ti[2] = ti[1]; tv[1] = tv[0]; ti[1] = ti[0]; tv[0] = v; ti[0] = n; }
    else if (top_better(v, n, tv[1], ti[1])) { tv[2] = tv[1]; ti[2] = ti[1]; tv[1] = v; ti[1] = n; }
    else if (top_better(v, n, tv[2], ti[2])) { tv[2] = v; ti[2] = n; }
}
__device__ __forceinline__ void phase2d(unsigned char* ws, LAS unsigned char* lds, int G, int tid, int wave, int lane, unsigned* gcnt, unsigned short* glist) {
    LAS unsigned* lcnt = (LAS unsigned*)(lds + 32768); LAS unsigned* lbase = lcnt + 64; LAS unsigned short* llist = (LAS unsigned short*)lds;
    const bf16* Q = (const bf16*)(ws + WS_Q); const float* kbar = (const float*)(ws + WS_KBAR);
    const int fr = lane & 15, fq = lane >> 4;
    for (int unit = blockIdx.x; unit < NH * 63; unit += G) {
        const int h = unit / 63, c = 1 + unit % 63;
        if (tid < 64) lcnt[tid] = 0u;
        __syncthreads();
        bf16x8 qf[2][4];
#pragma unroll
        for (int g = 0; g < 2; ++g)
#pragma unroll
            for (int ks = 0; ks < 4; ++ks) qf[g][ks] = *(const GAS bf16x8*)(Q + (size_t)(c * BLK + wave * 32 + g * 16 + fr) * 1024 + h * HD + ks * 32 + fq * 8);
        float tv[2][3]; int ti[2][3];
#pragma unroll
        for (int g = 0; g < 2; ++g)
#pragma unroll
            for (int j = 0; j < 3; ++j) { tv[g][j] = -__builtin_inff(); ti[g][j] = 1 << 20; }
        const int ntile = (c + 15) >> 4;
        for (int tile = 0; tile < ntile; ++tile) {
            f32x4 s0 = (f32x4){0.f, 0.f, 0.f, 0.f}, s1 = s0;
#pragma unroll
            for (int ks = 0; ks < 4; ++ks) {
                const float* kp = kbar + ((size_t)(h * NBLK + tile * 16 + fr) * HD + ks * 32 + fq * 8);
                const f32x4 a = *(const GAS f32x4*)kp, b = *(const GAS f32x4*)(kp + 4);
                const v4u hw = pg8::pack8(a, b);
                f32x4 ra, rb; ra[0] = a[0] - pg8::bf_lo(hw.x); ra[1] = a[1] - pg8::bf_hi(hw.x); ra[2] = a[2] - pg8::bf_lo(hw.y); ra[3] = a[3] - pg8::bf_hi(hw.y);
                rb[0] = b[0] - pg8::bf_lo(hw.z); rb[1] = b[1] - pg8::bf_hi(hw.z); rb[2] = b[2] - pg8::bf_lo(hw.w); rb[3] = b[3] - pg8::bf_hi(hw.w);
                const v4u lw = pg8::pack8(ra, rb);
                const bf16x8 hi = __builtin_bit_cast(bf16x8, hw), lo = __builtin_bit_cast(bf16x8, lw);
                s0 = __builtin_amdgcn_mfma_f32_16x16x32_bf16(hi, qf[0][ks], s0, 0, 0, 0); s0 = __builtin_amdgcn_mfma_f32_16x16x32_bf16(lo, qf[0][ks], s0, 0, 0, 0);
                s1 = __builtin_amdgcn_mfma_f32_16x16x32_bf16(hi, qf[1][ks], s1, 0, 0, 0); s1 = __builtin_amdgcn_mfma_f32_16x16x32_bf16(lo, qf[1][ks], s1, 0, 0, 0);
            }
#pragma unroll
            for (int i = 0; i < 4; ++i) { const int n = tile * 16 + 4 * fq + i;
                top3_insert(n < c ? s0[i] : -__builtin_inff(), n, tv[0], ti[0]); top3_insert(n < c ? s1[i] : -__builtin_inff(), n, tv[1], ti[1]); }
        }
#pragma unroll
        for (int off = 16; off <= 32; off <<= 1)
#pragma unroll
            for (int g = 0; g < 2; ++g) { float pv[3]; int pi[3];
#pragma unroll
                for (int j = 0; j < 3; ++j) { pv[j] = __shfl_xor(tv[g][j], off); pi[j] = __shfl_xor(ti[g][j], off); }
#pragma unroll
                for (int j = 0; j < 3; ++j) top3_insert(pv[j], pi[j], tv[g], ti[g]); }
        const int nsel = c < 3 ? c : 3;
        if (fq == 0) {
#pragma unroll
            for (int g = 0; g < 2; ++g) { const int tl = wave * 32 + g * 16 + fr;
#pragma unroll
                for (int j = 0; j < 3; ++j) if (j < nsel) { const int n = ti[g][j]; const unsigned pp = __hip_atomic_fetch_add(&lcnt[n], 1u, __ATOMIC_RELAXED, __HIP_MEMORY_SCOPE_WORKGROUP); llist[n * 256 + pp] = (unsigned short)((tl << 2) | j); } }
        }
        __syncthreads();
        if (tid < c) { const unsigned k = lcnt[tid]; lbase[tid] = k ? atomicAdd(gcnt + h * NBLK + tid, k) : 0u; }
        __syncthreads();
        for (int n = wave; n < c; n += NWAVES) { const unsigned k = lcnt[n], base = lbase[n];
            unsigned short* dst = glist + (size_t)h * LIST_PER_HEAD + list_off(n) + base;
            for (unsigned i = lane; i < k; i += 64) { const unsigned e = llist[n * 256 + i]; dst[i] = (unsigned short)((((unsigned)c * BLK + (e >> 2)) << 2) | (e & 3u)); } }
        __syncthreads();
    }
}
__device__ __forceinline__ v4u fp8x8_to_bf16x8(unsigned w0, unsigned w1) {
    const pg8::f32x2_t_ a = __builtin_amdgcn_cvt_pk_f32_fp8((int)w0, false), b = __builtin_amdgcn_cvt_pk_f32_fp8((int)w0, true), c = __builtin_amdgcn_cvt_pk_f32_fp8((int)w1, false), d = __builtin_amdgcn_cvt_pk_f32_fp8((int)w1, true);
    v4u o; o.x = pg8::cvt_pk_bf16(a[0], a[1]); o.y = pg8::cvt_pk_bf16(b[0], b[1]); o.z = pg8::cvt_pk_bf16(c[0], c[1]); o.w = pg8::cvt_pk_bf16(d[0], d[1]); return o;
}
__device__ __forceinline__ void stage_kv(const bf16* Kg, const bf16* Vt, int h, int n, LAS unsigned char* lds, int tid) {
    const unsigned char* Kb = (const unsigned char*)Kg;
    const unsigned char* Vb = (const unsigned char*)Vt;
    v4u kw[4], vw[4];
#pragma unroll
    for (int i = 0; i < 4; ++i) { const int row = (tid >> 3) + 64 * i, c16 = tid & 7; kw[i] = *(const GAS v4u*)(Kb + (size_t)(n * BLK + row) * 1024 + h * HD + c16 * 16); }
#pragma unroll
    for (int i = 0; i < 4; ++i) { const int row = (tid >> 4) + 32 * i, c16 = tid & 15; vw[i] = *(const GAS v4u*)(Vb + (size_t)(h * HD + row) * M + n * BLK + c16 * 16); }
    __syncthreads();
#pragma unroll
    for (int i = 0; i < 4; ++i) { const int row = (tid >> 3) + 64 * i, c16 = tid & 7; const int sw = (((row >> 3) & 3) << 2) | (row & 3);
        *(LAS v4u*)(lds + row * 256 + (((2 * c16) ^ sw) << 4)) = fp8x8_to_bf16x8(kw[i].x, kw[i].y);
        *(LAS v4u*)(lds + row * 256 + (((2 * c16 + 1) ^ sw) << 4)) = fp8x8_to_bf16x8(kw[i].z, kw[i].w); }
#pragma unroll
    for (int i = 0; i < 4; ++i) { const int row = (tid >> 4) + 32 * i, c16 = tid & 15; const int sv = (((row >> 4) & 3) << 2) | (row & 3);
        *(LAS v4u*)(lds + 65536 + row * 512 + (((2 * c16) ^ sv) << 4)) = fp8x8_to_bf16x8(vw[i].x, vw[i].y);
        *(LAS v4u*)(lds + 65536 + row * 512 + (((2 * c16 + 1) ^ sv) << 4)) = fp8x8_to_bf16x8(vw[i].z, vw[i].w); }
}
__device__ __forceinline__ void load_q(bf16x8 (&qf)[2][4], const bf16* Q, int h, const int (&tq)[2], int fq) {
#pragma unroll
    for (int g = 0; g < 2; ++g)
#pragma unroll
        for (int ks = 0; ks < 4; ++ks) qf[g][ks] = *(const GAS bf16x8*)(Q + (size_t)tq[g] * 1024 + h * HD + ks * 32 + fq * 8);
}
template <bool CAUSAL, int MODE = 0>
__device__ __forceinline__ void attn_core(const LAS unsigned char* lds, const bf16x8 (&qf)[2][4], int wave, int fr, int fq, float B2, f32x4 (&O)[8][2], float (&l)[2]) {
#pragma unroll
    for (int dt = 0; dt < 8; ++dt) { O[dt][0] = (f32x4){0.f, 0.f, 0.f, 0.f}; O[dt][1] = O[dt][0]; }
    l[0] = 0.f; l[1] = 0.f;
    const int nch = CAUSAL ? wave + 1 : 8;
    const int krow = (fr >> 2) * 8 + (fr & 3);
    bf16x8 kf[4][2];
#pragma unroll
    for (int ks = 0; ks < 4; ++ks)
#pragma unroll
        for (int t = 0; t < 2; ++t) kf[ks][t] = *(const LAS bf16x8*)(lds + (krow + t * 4) * 256 + (((ks * 4 + fq) ^ fr) << 4));
#pragma unroll 2
    for (int c = 0; c < nch; ++c) {
        f32x4 s[2][2];
#pragma unroll
        for (int t = 0; t < 2; ++t) { s[t][0] = (f32x4){-B2, -B2, -B2, -B2}; s[t][1] = s[t][0]; }
        bf16x8 vf[8];
#pragma unroll
        for (int dt = 0; dt < 8; ++dt) vf[dt] = *(const LAS bf16x8*)(lds + 65536 + ((dt >> 2) * 64 + (fr >> 2) * 16 + (dt & 3) * 4 + (fr & 3)) * 512 + (((c * 4 + fq) ^ fr) << 4));
        __builtin_amdgcn_s_setprio(1);
#pragma unroll
        for (int ks = 0; ks < 4; ++ks)
#pragma unroll
            for (int t = 0; t < 2; ++t) {
                if (MODE != 2 || ks == 0) {
                s[t][0] = __builtin_amdgcn_mfma_f32_16x16x32_bf16(kf[ks][t], qf[0][ks], s[t][0], 0, 0, 0);
                s[t][1] = __builtin_amdgcn_mfma_f32_16x16x32_bf16(kf[ks][t], qf[1][ks], s[t][1], 0, 0, 0); }
            }
        __builtin_amdgcn_s_setprio(0);
        __builtin_amdgcn_sched_barrier(0);
        { const int cn = (c + 1 < nch) ? c + 1 : c;
#pragma unroll
          for (int ks = 0; ks < 4; ++ks)
#pragma unroll
              for (int t = 0; t < 2; ++t) kf[ks][t] = *(const LAS bf16x8*)(lds + (cn * 32 + krow + t * 4) * 256 + (((ks * 4 + fq) ^ fr) << 4)); }
        bf16x8 pf[2];
#pragma unroll
        for (int g = 0; g < 2; ++g) {
            float p[8];
#pragma unroll
            for (int t = 0; t < 2; ++t)
#pragma unroll
                for (int i = 0; i < 4; ++i) { float e = MODE == 1 ? s[t][g][i] : __builtin_amdgcn_exp2f(s[t][g][i]);
                    if (CAUSAL && c == wave) { const int kl = c * 32 + fq * 8 + t * 4 + i, ql = wave * 32 + g * 16 + fr; if (kl > ql) e = 0.f; }
                    p[t * 4 + i] = e; }
            l[g] += ((p[0] + p[1]) + (p[2] + p[3])) + ((p[4] + p[5]) + (p[6] + p[7]));
            v4u w; w.x = pg8::cvt_pk_bf16(p[0], p[1]); w.y = pg8::cvt_pk_bf16(p[2], p[3]); w.z = pg8::cvt_pk_bf16(p[4], p[5]); w.w = pg8::cvt_pk_bf16(p[6], p[7]);
            pf[g] = __builtin_bit_cast(bf16x8, w);
        }
        __builtin_amdgcn_s_setprio(1);
#pragma unroll
        for (int dt = 0; dt < 8; ++dt) {
            if (MODE != 3 || dt == 0) {
            O[dt][0] = __builtin_amdgcn_mfma_f32_16x16x32_bf16(vf[dt], pf[0], O[dt][0], 0, 0, 0);
            O[dt][1] = __builtin_amdgcn_mfma_f32_16x16x32_bf16(vf[dt], pf[1], O[dt][1], 0, 0, 0); }
        }
        __builtin_amdgcn_s_setprio(0);
    }
    l[0] += __shfl_xor(l[0], 16); l[0] += __shfl_xor(l[0], 32); l[1] += __shfl_xor(l[1], 16); l[1] += __shfl_xor(l[1], 32);
}
__device__ __forceinline__ float score_bound(const float* q_norm, const float* k_norm, int lane) {
    float a = fmaxf(fabsf(q_norm[lane]), fabsf(q_norm[lane + 64])), b = fmaxf(fabsf(k_norm[lane]), fabsf(k_norm[lane + 64]));
#pragma unroll
    for (int o = 1; o < 64; o <<= 1) { a = fmaxf(a, __shfl_xor(a, o)); b = fmaxf(b, __shfl_xor(b, o)); }
    return 128.0f * a * b * C2 * 1.001f + 0.01f;
}
template <int MODE>
__device__ __forceinline__ void phase3a(const float* q_norm, const float* k_norm, unsigned char* ws, LAS unsigned char* lds, int G, int tid, int wave, int lane) {
    const int fr = lane & 15, fq = lane >> 4;
    LAS int* pre = (LAS int*)(lds + SCAN_OFF);
    LAS int* cntl = (LAS int*)(lds + SCAN_OFF + 2080);
    const unsigned* gcnt = (const unsigned*)(ws + WS_CTL) + CW_GCNT; const unsigned short* glist = (const unsigned short*)(ws + WS_LIST);
    const bf16* Q = (const bf16*)(ws + WS_Q); const bf16* Kg = (const bf16*)(ws + WS_K); const bf16* Vt = (const bf16*)(ws + WS_VT);
    unsigned char* OP = ws + WS_OPART; float* LP = (float*)(ws + WS_LPART);
    const float B2 = score_bound(q_norm, k_norm, lane);
    { const int cnt = (int)__hip_atomic_load(gcnt + tid, __ATOMIC_RELAXED, __HIP_MEMORY_SCOPE_AGENT); pre[tid + 1] = (cnt + 255) >> 8; cntl[tid] = cnt; if (tid == 0) pre[0] = 0; }
    __syncthreads();
    for (int o = 1; o < 512; o <<= 1) { const int v = pre[tid + 1] + ((tid + 1 - o) >= 1 ? pre[tid + 1 - o] : 0); __syncthreads(); pre[tid + 1] = v; __syncthreads(); }
    const int T = pre[512];
    const int i_lo = (int)(((long)blockIdx.x * T) / G), i_hi = (int)(((long)(blockIdx.x + 1) * T) / G);
    int staged = -1;
#define P3A_DECODE(IT, HN, TILE) do { int lo_ = 0, hi_ = 511; while (lo_ < hi_) { const int mid_ = (lo_ + hi_ + 1) >> 1; if (pre[mid_] <= (IT)) lo_ = mid_; else hi_ = mid_ - 1; } HN = lo_; TILE = (IT) - pre[lo_]; } while (0)
    unsigned en[2] = {0u, 0u}; bool okn[2] = {false, false};
    bf16x8 qf[2][4]; int hnn = 0;
    if (i_lo < i_hi) { int hn, tile; P3A_DECODE(i_lo, hn, tile); const int cnt = cntl[hn]; const unsigned short* lst = glist + (size_t)(hn >> 6) * LIST_PER_HEAD + list_off(hn & 63) + tile * 256;
#pragma unroll
        for (int g = 0; g < 2; ++g) { const int qi = wave * 32 + g * 16 + fr; okn[g] = tile * 256 + qi < cnt; en[g] = okn[g] ? lst[qi] : 0u; }
        { const int tq0[2] = {(int)(en[0] >> 2), (int)(en[1] >> 2)}; load_q(qf, Q, hn >> 6, tq0, fq); } }
    for (int it = i_lo; it < i_hi; ++it) {
        int hn, tile; P3A_DECODE(it, hn, tile); const int h = hn >> 6, n = hn & 63;
        int tq[2], sj[2]; bool ok[2];
#pragma unroll
        for (int g = 0; g < 2; ++g) { ok[g] = okn[g]; tq[g] = (int)(en[g] >> 2); sj[g] = (int)(en[g] & 3u); }
        if (it + 1 < i_hi) { int hn2, tile2; P3A_DECODE(it + 1, hn2, tile2); hnn = hn2; const int cnt2 = cntl[hn2]; const unsigned short* lst2 = glist + (size_t)(hn2 >> 6) * LIST_PER_HEAD + list_off(hn2 & 63) + tile2 * 256;
#pragma unroll
            for (int g = 0; g < 2; ++g) { const int qi = wave * 32 + g * 16 + fr; okn[g] = tile2 * 256 + qi < cnt2; en[g] = okn[g] ? lst2[qi] : 0u; } }
        if (hn != staged) { stage_kv(Kg, Vt, h, n, lds, tid); LDS_WAIT(); __syncthreads(); staged = hn; }
        f32x4 O[8][2]; float l[2];
        attn_core<false, MODE>(lds, qf, wave, fr, fq, B2, O, l);
        if (it + 1 < i_hi) { const int tqn[2] = {(int)(en[0] >> 2), (int)(en[1] >> 2)}; load_q(qf, Q, hnn >> 6, tqn, fq); }
#pragma unroll
        for (int g = 0; g < 2; ++g) if (ok[g]) {
            unsigned char* op = OP + ((size_t)sj[g] * M + tq[g]) * 1024 + h * HD + 16 * fq;
            const float sc = 16.0f / l[g];
#pragma unroll
            for (int j = 0; j < 2; ++j) { v4u w;
                { int t = 0; t = __builtin_amdgcn_cvt_pk_fp8_f32(O[4 * j][g][0] * sc, O[4 * j][g][1] * sc, t, false); t = __builtin_amdgcn_cvt_pk_fp8_f32(O[4 * j][g][2] * sc, O[4 * j][g][3] * sc, t, true); w.x = (unsigned)t; }
                { int t = 0; t = __builtin_amdgcn_cvt_pk_fp8_f32(O[4 * j + 1][g][0] * sc, O[4 * j + 1][g][1] * sc, t, false); t = __builtin_amdgcn_cvt_pk_fp8_f32(O[4 * j + 1][g][2] * sc, O[4 * j + 1][g][3] * sc, t, true); w.y = (unsigned)t; }
                { int t = 0; t = __builtin_amdgcn_cvt_pk_fp8_f32(O[4 * j + 2][g][0] * sc, O[4 * j + 2][g][1] * sc, t, false); t = __builtin_amdgcn_cvt_pk_fp8_f32(O[4 * j + 2][g][2] * sc, O[4 * j + 2][g][3] * sc, t, true); w.z = (unsigned)t; }
                { int t = 0; t = __builtin_amdgcn_cvt_pk_fp8_f32(O[4 * j + 3][g][0] * sc, O[4 * j + 3][g][1] * sc, t, false); t = __builtin_amdgcn_cvt_pk_fp8_f32(O[4 * j + 3][g][2] * sc, O[4 * j + 3][g][3] * sc, t, true); w.w = (unsigned)t; }
                *(GAS v4u*)(op + j * 64) = w; }
            if (fq == 0) LP[((size_t)sj[g] * M + tq[g]) * NH + h] = l[g];
        }
    }
#undef P3A_DECODE
    __syncthreads();
}
__device__ __forceinline__ void phase3b(const float* q_norm, const float* k_norm, unsigned char* ws, LAS unsigned char* lds, int G, int tid, int wave, int lane, bf16* Oout) {
    const int fr = lane & 15, fq = lane >> 4;
    bf16* Q = (bf16*)(ws + WS_Q); const bf16* Kg = (const bf16*)(ws + WS_K); const bf16* Vt = (const bf16*)(ws + WS_VT);
    const unsigned char* OP = ws + WS_OPART; const float* LP = (const float*)(ws + WS_LPART);
    const float B2 = score_bound(q_norm, k_norm, lane);
    bf16x8 qf[2][4];
    if ((int)blockIdx.x < NH * NBLK) { const int u0 = blockIdx.x; const int tq0[2] = {(u0 & 63) * BLK + wave * 32 + fr, (u0 & 63) * BLK + wave * 32 + 16 + fr}; load_q(qf, Q, u0 >> 6, tq0, fq); }
    for (int unit = blockIdx.x; unit < NH * NBLK; unit += G) {
        const int h = unit >> 6, c = unit & 63;
        stage_kv(Kg, Vt, h, c, lds, tid); LDS_WAIT(); __syncthreads();
        int tq[2];
#pragma unroll
        for (int g = 0; g < 2; ++g) tq[g] = c * BLK + wave * 32 + g * 16 + fr;
        f32x4 O[8][2]; float l[2];
        attn_core<true>(lds, qf, wave, fr, fq, B2, O, l);
        if (unit + G < NH * NBLK) { const int u1 = unit + G; const int tqn[2] = {(u1 & 63) * BLK + wave * 32 + fr, (u1 & 63) * BLK + wave * 32 + 16 + fr}; load_q(qf, Q, u1 >> 6, tqn, fq); }
        const int nsel = c < 3 ? c : 3;
#pragma unroll
        for (int g = 0; g < 2; ++g) {
            float lp[3];
#pragma unroll
            for (int j = 0; j < 3; ++j) lp[j] = LP[((size_t)j * M + tq[g]) * NH + h];
            v4u w[3][2];
#pragma unroll
            for (int j = 0; j < 3; ++j)
#pragma unroll
                for (int k = 0; k < 2; ++k) w[j][k] = *(const GAS v4u*)(OP + ((size_t)j * M + tq[g]) * 1024 + h * HD + k * 64 + 16 * fq);
            float lt = l[g]; float ls[3];
#pragma unroll
            for (int j = 0; j < 3; ++j) { ls[j] = j < nsel ? lp[j] * (1.0f / 16.0f) : 0.f; lt += j < nsel ? lp[j] : 0.f; }
            const float inv = 1.0f / lt;
#pragma unroll
            for (int k = 0; k < 2; ++k) {
                f32x4 o[4];
#pragma unroll
                for (int q = 0; q < 4; ++q) o[q] = O[4 * k + q][g];
#pragma unroll
                for (int j = 0; j < 3; ++j) if (j < nsel) { const unsigned xw[4] = {w[j][k].x, w[j][k].y, w[j][k].z, w[j][k].w};
#pragma unroll
                    for (int q = 0; q < 4; ++q) { const pg8::f32x2_t_ lo = __builtin_amdgcn_cvt_pk_f32_fp8((int)xw[q], false), hi = __builtin_amdgcn_cvt_pk_f32_fp8((int)xw[q], true);
                        o[q][0] += lo[0] * ls[j]; o[q][1] += lo[1] * ls[j]; o[q][2] += hi[0] * ls[j]; o[q][3] += hi[1] * ls[j]; } }
                bf16* dst = Oout + (size_t)tq[g] * 1024 + h * HD + k * 64 + 16 * fq;
                *(GAS v4u*)dst = pg8::pack8(o[0] * inv, o[1] * inv); *(GAS v4u*)(dst + 8) = pg8::pack8(o[2] * inv, o[3] * inv); }
        }
    }
    __syncthreads();
}

#ifndef MK_PER_PHASE
#define MK_PER_PHASE 0
#endif
#ifndef MK_DUP
#define MK_DUP -1
#endif
constexpr int N_PHASES = 9;
struct Args { const float* in[14]; float* out; unsigned char* ws; int ph_lo, ph_hi; };
__global__ void __launch_bounds__(NTHREADS, 2) hybrid_fwd(Args args) {
    extern __shared__ __attribute__((aligned(16))) unsigned char lds_raw[];
    LAS unsigned char* lds = (LAS unsigned char*)lds_raw;
    volatile LAS unsigned* MISC = (volatile LAS unsigned*)(lds + MISC_OFF);
    const int tid = threadIdx.x, lane = tid & 63, wave = __builtin_amdgcn_readfirstlane(tid >> 6);
    const int G = gridDim.x; const int vcu = (G % 8 == 0) ? ((int)blockIdx.x % 8) * (G / 8) + (int)blockIdx.x / 8 : (int)blockIdx.x;
    unsigned char* ws = args.ws;
    gu32* ctl = (gu32*)(ws + WS_CTL);
    if (tid < 32) MISC[tid] = 0u;
    __syncthreads();
    const int lo = args.ph_lo, hi = args.ph_hi;
    XcdBarrier bar; bar.bar = (unsigned*)ctl + CW_BAR; bar.x = 0; bar.st = nullptr;
    if (hi - lo > 1) bar = xcd_barrier_post((unsigned*)ctl + CW_BAR, MISC + 8);
#ifndef PHASE_MASK
#define PHASE_MASK 0x1ff
#endif
#define IN(k) (((PHASE_MASK >> (k)) & 1) && lo <= (k) && (k) < hi)
#define SEAM(k) do { if (IN(k) && IN((k) + 1)) xcd_barrier(bar); } while (0)
    const float* x = args.in[0]; const float* norm_mix = args.in[1]; const float* w_in = args.in[2]; const float* conv_a_w = args.in[3]; const float* q_norm = args.in[4]; const float* k_norm = args.in[5];
    const float* w_oa = args.in[6]; const float* w_ob = args.in[7]; const float* w_o = args.in[8]; const float* norm_ffn = args.in[9]; const float* w_up = args.in[10]; const float* ffn_conv_w = args.in[11];
    const float* ffn_conv_b = args.in[12]; const float* w_down = args.in[13];
    float* out = args.out;
    float* rowss = (float*)((unsigned*)ctl + CW_ROWSS);
    const size_t TSTEP = (size_t)256 * 1024 * 2;

    if (IN(0)) { phase0(x, norm_mix, w_in, w_oa, w_ob, w_o, w_up, norm_ffn, ws, lds, vcu, G, wave, lane); __syncthreads(); }
    SEAM(0);
    if (IN(1)) {
        pg8::Gemm g{(const bf16*)(ws + WS_XB), (const bf16*)(ws + WS_XB), (const bf16*)(ws + WS_WIN), (const bf16*)(ws + WS_WIN), D, TSTEP};
        pg8::StaticOrder S; S.init(M / 256, NIN / 256, G, (int)blockIdx.x);
        pg8::Epi1 E{(bf16*)(ws + WS_CA), (bf16*)(ws + WS_UU), (bf16*)(ws + WS_Q), (bf16*)(ws + WS_K), (bf16*)(ws + WS_VT), (bf16*)out, (const float*)(ws + WS_RSTDX), q_norm, k_norm, (float*)(ws + WS_KBAR), (PG8_LAS float*)(lds + HALO_OFF)};
        pg8::gemm_phase<pg8::Epi1, pg8::StaticOrder, true, true>(lds, g, S, E);
    }
    SEAM(1);
    if (IN(2)) { phase2d(ws, lds, G, tid, wave, lane, (unsigned*)(ws + WS_CTL) + CW_GCNT, (unsigned short*)(ws + WS_LIST));
        phase2(conv_a_w, ws, G, tid, (bf16*)(ws + WS_CA)); __syncthreads(); }
#if MK_DUP == 21
    if (IN(2)) { phase2d(ws, lds, G, tid, wave, lane, (unsigned*)(ws + WS_CTL) + CW_GCNT + 512, (unsigned short*)(ws + WS_WIN)); }
#endif
#if MK_DUP == 22
    if (IN(2)) { phase2(conv_a_w, ws, G, tid, (bf16*)(ws + WS_XB)); }
#endif
    SEAM(2);
#if MK_DUP >= 30 && MK_DUP <= 35
    if (IN(3)) phase3a<MK_DUP - 30>(q_norm, k_norm, ws, lds, G, tid, wave, lane);
#endif
    if (IN(3)) phase3a<0>(q_norm, k_norm, ws, lds, G, tid, wave, lane);
    SEAM(3);
    if (IN(4)) { phase3b(q_norm, k_norm, ws, lds, G, tid, wave, lane, (bf16*)(ws + WS_Q));
#if MK_DUP == 4
        phase3b(q_norm, k_norm, ws, lds, G, tid, wave, lane, (bf16*)(ws + WS_OPART));
#endif
        }
    SEAM(4);
    if (IN(5)) {
        { LAS float* scr = (LAS float*)(lds + wave * 16384); const int gw = vcu * NWAVES + wave, NGW = G * NWAVES;
          if (blockIdx.x == 0 && tid < 256) *(GAS v4u*)(ws + WS_HB - 4096 + tid * 16) = (v4u){0u, 0u, 0u, 0u};
          __syncthreads(); }
        pg8::Gemm g{(const bf16*)(ws + WS_CA), (const bf16*)(ws + WS_Q), (const bf16*)(ws + WS_WOA), (const bf16*)(ws + WS_WOB), D, TSTEP};
        pg8::DualOrder S; S.S.init(M / 256, D / 256, G, (int)blockIdx.x);
        pg8::Epi4 E{(bf16*)(ws + WS_MG), (const bf16*)out};
        pg8::gemm_phase<pg8::Epi4, pg8::DualOrder, true, true>(lds, g, S, E);
    }
    SEAM(5);
    if (IN(6)) {
        pg8::Gemm g{(const bf16*)(ws + WS_MG), (const bf16*)(ws + WS_MG), (const bf16*)(ws + WS_WO), (const bf16*)(ws + WS_WO), D, TSTEP};
        pg8::StaticOrder S; S.init(M / 256, D / 256, G, (int)blockIdx.x);
        pg8::Epi5 E{(const bf16*)(ws + WS_XB), out, (bf16*)(ws + WS_HB), rowss};
        pg8::gemm_phase<pg8::Epi5, pg8::StaticOrder, true, true>(lds, g, S, E);
#if MK_DUP == 6
        { pg8::Epi5 E2{(const bf16*)(ws + WS_XB), (float*)(ws + WS_Q), (bf16*)(ws + WS_VT), (float*)(ws + WS_CA)}; pg8::gemm_phase<pg8::Epi5, pg8::StaticOrder, true, true>(lds, g, S, E2); }
#endif
    }
    SEAM(6);
    if (IN(7)) {
        const bf16* hb2 = (const bf16*)(ws + WS_HB) - 2 * 1024;
        pg8::Gemm g{hb2, hb2, (const bf16*)(ws + WS_WUP), (const bf16*)(ws + WS_WUP), D, (size_t)254 * 1024 * 2};
        pg8::StaticOrder S; S.init(65, 22, G, (int)blockIdx.x);
        pg8::Epi6 E{(bf16*)(ws + WS_ACT), rowss, ffn_conv_w, ffn_conv_b, (PG8_LAS float*)(lds + HALO_OFF)};
        pg8::gemm_phase<pg8::Epi6, pg8::StaticOrder, true, true>(lds, g, S, E);
        { const int nwg = 65 * 22, full = nwg % G, nidle = full ? G - full : G, idx = full ? (int)blockIdx.x - full : (int)blockIdx.x;
          if (idx >= 0) convert_weight(w_down, DFF, D, (bf16*)(ws + WS_WDN), nullptr, 0, (LAS float*)(lds + wave * 16384), idx * NWAVES + wave, nidle * NWAVES, lane);
          __syncthreads(); }
    }
    SEAM(7);
    if (IN(8)) {
        pg8::Gemm g{(const bf16*)(ws + WS_ACT), (const bf16*)(ws + WS_ACT), (const bf16*)(ws + WS_WDN), (const bf16*)(ws + WS_WDN), DFF, (size_t)256 * DFF * 2};
        pg8::StaticOrder S; S.init(M / 256, D / 256, G, (int)blockIdx.x);
        pg8::Epi7 E{out, (const bf16*)(ws + WS_HB)};
        pg8::gemm_phase<pg8::Epi7, pg8::StaticOrder, true, true>(lds, g, S, E);
#if MK_DUP == 8
        { pg8::Epi7 E2{(float*)(ws + WS_MG), (const bf16*)(ws + WS_HB)}; pg8::gemm_phase<pg8::Epi7, pg8::StaticOrder, true, true>(lds, g, S, E2); }
#endif
    }
#undef IN
#undef SEAM
}

extern "C" void kernel_launch(void* const* d_in, const int* in_sizes, int n_in, void* d_out, int out_size, void* d_ws, size_t ws_size, hipStream_t stream) {
    static int grid = 0;
    if (grid == 0) {
        if (n_in != 14 || in_sizes[0] != M * D || out_size != M * D || ws_size < WS_END) { fprintf(stderr, "kernel_launch: unexpected shapes (n_in %d, in0 %d, out %d, ws %zu)\n", n_in, n_in > 0 ? in_sizes[0] : -1, out_size, ws_size); grid = -1; return; }
        int dev = 0, cus = 0, per_cu = 0;
        if (hipGetDevice(&dev) != hipSuccess || hipDeviceGetAttribute(&cus, hipDeviceAttributeMultiprocessorCount, dev) != hipSuccess) { grid = -1; return; }
        if (hipFuncSetAttribute((const void*)hybrid_fwd, hipFuncAttributeMaxDynamicSharedMemorySize, LDS_BYTES) != hipSuccess) { fprintf(stderr, "kernel_launch: hipFuncSetAttribute failed\n"); grid = -1; return; }
        if (hipOccupancyMaxActiveBlocksPerMultiprocessor(&per_cu, (const void*)hybrid_fwd, NTHREADS, LDS_BYTES) != hipSuccess || per_cu < 1) { fprintf(stderr, "kernel_launch: occupancy query says %d blocks per CU\n", per_cu); (void)hipGetLastError(); grid = -1; return; }
        grid = cus;
    }
    if (grid < 0) return;
    if (hipMemsetAsync((char*)d_ws + WS_CTL, 0, CTL_ZERO_BYTES, stream) != hipSuccess) { fprintf(stderr, "kernel_launch: memset failed\n"); return; }
    Args a{};
    for (int i = 0; i < 14; ++i) a.in[i] = (const float*)d_in[i];
    a.out = (float*)d_out; a.ws = (unsigned char*)d_ws;
#if MK_PER_PHASE
    for (int p = 0; p < N_PHASES; ++p) { a.ph_lo = p; a.ph_hi = p + 1; hipLaunchKernelGGL(hybrid_fwd, dim3(grid), dim3(NTHREADS), LDS_BYTES, stream, a); }
#else
    a.ph_lo = 0; a.ph_hi = N_PHASES;
    void* kargs[] = {&a};
    hipError_t e = hipLaunchCooperativeKernel((const void*)hybrid_fwd, dim3(grid), dim3(NTHREADS), kargs, LDS_BYTES, stream);
    if (e != hipSuccess) fprintf(stderr, "kernel_launch: cooperative launch failed: %s (grid %d)\n", hipGetErrorString(e), grid);
#endif
}
```
